# Optimizing an MI355X kernel written in HIP

```python
import jax, jax.numpy as jnp
from jax import lax
import numpy as np

D_MODEL = 1024
BATCH = 16
SEQ = 256
DEPTH = 2
DEC_BATCH = 2
DEC_SEQ = 1024
PAST_LEN = 256

GRID_W = 64
N_RET_HEADS = 4
RET_DK = 128
RET_DV = 256
RET_CHUNK = 128
N_GMLP_GROUPS = 4
GMLP_CH = 128
GMLP_CHUNK = 128
RET_QK_W = N_RET_HEADS * RET_DK
RET_V_W = N_RET_HEADS * RET_DV
GMLP_W = N_GMLP_GROUPS * GMLP_CH
EVEN_IN_W = 2 * RET_QK_W + 2 * RET_V_W + 2 * GMLP_W
EVEN_OUT_W = RET_V_W + GMLP_W
CONV_CH = D_MODEL
CONV_K = 3
D_FF = 4 * D_MODEL
N_MOD = 6
EPS = 1e-6

kernel_name = "hybrid_retention_gmlp_shortconv_diffusion_step"


def rms_norm(x, g):
    xf = x.astype(jnp.float32)
    y = xf * lax.rsqrt(jnp.mean(xf * xf, axis=-1, keepdims=True) + EPS)
    return (y * g.astype(jnp.float32)).astype(x.dtype)


def adaln(cond, w_mod, b_mod):
    m = (jax.nn.silu(cond) @ w_mod + b_mod)[:, None, :]
    return jnp.split(m, N_MOD, axis=-1)


def _retention_dir(q, k, v, log_gamma, s0):
    b, L, h, _ = q.shape
    dv = v.shape[-1]
    n = L // RET_CHUNK

    def to_chunks(t):
        return t.reshape(b, n, RET_CHUNK, h, t.shape[-1]).transpose(1, 0, 3, 2, 4)

    qc, kc, vc = to_chunks(q), to_chunks(k), to_chunks(v)
    pos = jnp.arange(RET_CHUNK, dtype=jnp.float32)
    diff = pos[:, None] - pos[None, :]
    decay_mask = jnp.where(diff >= 0, jnp.exp(jnp.maximum(diff, 0.0) * log_gamma[:, None, None]), 0.0)
    q_decay = jnp.exp((pos + 1.0) * log_gamma[:, None])[:, :, None]
    k_decay = jnp.exp((RET_CHUNK - 1.0 - pos) * log_gamma[:, None])[:, :, None]
    chunk_decay = jnp.exp(RET_CHUNK * log_gamma)[:, None, None]

    def step(s, inp):
        qi, ki, vi = inp
        scores = jnp.einsum("bhid,bhjd->bhij", qi, ki) * decay_mask
        inner = jnp.einsum("bhij,bhje->bhie", scores, vi)
        cross = jnp.einsum("bhid,bhde->bhie", qi, s) * q_decay
        s_new = chunk_decay * s + jnp.einsum("bhjd,bhje->bhde", ki * k_decay, vi)
        return s_new, inner + cross

    s_fin, out = lax.scan(step, s0, (qc, kc, vc))
    out = out.transpose(1, 0, 3, 2, 4).reshape(b, L, h, dv)
    return out, s_fin


def bidir_retention(q, k, v, log_gamma, s0):
    o_f, s_f = _retention_dir(q, k, v, log_gamma[0], s0[:, 0])
    o_b, s_b = _retention_dir(jnp.flip(q, 1), jnp.flip(k, 1), jnp.flip(v, 1), log_gamma[1], s0[:, 1])
    return o_f + jnp.flip(o_b, 1), jnp.stack([s_f, s_b], axis=1)


def even_mixer(h, s0, w_in, ret_decay_exp, gmlp_ws, gmlp_b, w_out):
    b, L, _ = h.shape
    proj = h @ w_in
    q, k, v, g, u, z = jnp.split(
        proj,
        [RET_QK_W, 2 * RET_QK_W, 2 * RET_QK_W + RET_V_W, 2 * RET_QK_W + 2 * RET_V_W,
         2 * RET_QK_W + 2 * RET_V_W + GMLP_W],
        axis=-1)
    qf = q.reshape(b, L, N_RET_HEADS, RET_DK).astype(jnp.float32)
    kf = k.reshape(b, L, N_RET_HEADS, RET_DK).astype(jnp.float32) * (RET_DK ** -0.5)
    vf = v.reshape(b, L, N_RET_HEADS, RET_DV).astype(jnp.float32)
    log_gamma = jnp.log1p(-jnp.exp2(-ret_decay_exp.astype(jnp.float32)))
    o, s_fin = bidir_retention(qf, kf, vf, log_gamma, s0.astype(jnp.float32))
    o = o * lax.rsqrt(jnp.mean(o * o, axis=-1, keepdims=True) + EPS)
    ret_out = (jax.nn.silu(g.astype(jnp.float32)) * o.reshape(b, L, RET_V_W)).astype(h.dtype)
    u = jax.nn.gelu(u)
    zf = jax.nn.gelu(z).astype(jnp.float32)
    mu = jnp.mean(zf, axis=-1, keepdims=True)
    zf = (zf - mu) * lax.rsqrt(jnp.mean((zf - mu) ** 2, axis=-1, keepdims=True) + EPS)
    zc = zf.astype(h.dtype).reshape(b, L // GMLP_CHUNK, GMLP_CHUNK, N_GMLP_GROUPS, GMLP_CH)
    sv = jnp.einsum("gpq,bnqgc->bnpgc", gmlp_ws, zc) + gmlp_b.T[None, None, :, :, None]
    gm_out = u * sv.reshape(b, L, GMLP_W)
    out = jnp.concatenate([ret_out, gm_out], axis=-1) @ w_out
    return out, s_fin.astype(h.dtype)


def conv3(x, w):
    pad = [(0, 0)] * (x.ndim - 2) + [(1, 1), (0, 0)]
    xp = jnp.pad(x, pad)
    return w[0] * xp[..., :-2, :] + w[1] * xp[..., 1:-1, :] + w[2] * xp[..., 2:, :]


def odd_mixer(h, w_in, conv_w, w_out, rows):
    b, L, _ = h.shape
    bg, cg, hv = jnp.split(h @ w_in, 3, axis=-1)
    xc = cg * hv
    if rows is None:
        yc = conv3(xc, conv_w)
    else:
        yc = conv3(xc.reshape(b, rows, GRID_W, CONV_CH), conv_w).reshape(b, L, CONV_CH)
    return (bg * yc) @ w_out


def channel_mlp(h, w1, w2):
    a = jax.nn.relu(h @ w1)
    return (a * a) @ w2


def trunk(x, cond, ret_states, layers, final_norm, rows):
    new_states = []
    for i in range(DEPTH):
        p = layers[i]
        sh1, sc1, g1, sh2, sc2, g2 = adaln(cond, p["w_mod"], p["b_mod"])
        hmod = rms_norm(x, p["norm1"]) * (1.0 + sc1) + sh1
        if i % 2 == 0:
            mix, s_new = even_mixer(hmod, ret_states[i // 2], p["w_in"], p["ret_decay_exp"],
                                    p["gmlp_ws"], p["gmlp_b"], p["w_out"])
            new_states.append(s_new)
        else:
            mix = odd_mixer(hmod, p["w_in"], p["conv_w"], p["w_out"], rows)
        x = x + g1 * mix
        hmod = rms_norm(x, p["norm2"]) * (1.0 + sc2) + sh2
        x = x + g2 * channel_mlp(hmod, p["ffn_w1"], p["ffn_w2"])
    return rms_norm(x, final_norm), new_states


def setup_inputs(seed: int = 0) -> dict:
    key = jax.random.key(seed)
    ks = jax.random.split(key, 32)
    nrm = lambda k, shape, s: jax.random.normal(k, shape, jnp.float32) * s
    d = D_MODEL
    inp = {}
    inp["x_prompt"] = nrm(ks[0], (BATCH, SEQ, d), 1.0)
    inp["x_sample"] = nrm(ks[1], (DEC_BATCH, DEC_SEQ, d), 1.0)
    inp["state_l0_ret"] = nrm(ks[2], (DEC_BATCH, 2, N_RET_HEADS, RET_DK, RET_DV), 0.5)
    inp["c"] = nrm(ks[3], (DEC_BATCH, d), 1.0)
    inp["c_ctx"] = nrm(ks[4], (d,), 1.0)
    inp["l0_norm1"] = 1.0 + nrm(ks[5], (d,), 0.1)
    inp["l0_w_in"] = nrm(ks[6], (d, EVEN_IN_W), d ** -0.5)
    inp["l0_ret_decay_exp"] = (5.0 + jnp.arange(N_RET_HEADS, dtype=jnp.float32))[None, :] + nrm(ks[7], (2, N_RET_HEADS), 0.1)
    inp["l0_gmlp_ws"] = nrm(ks[8], (N_GMLP_GROUPS, GMLP_CHUNK, GMLP_CHUNK), GMLP_CHUNK ** -0.5)
    inp["l0_gmlp_b"] = 1.0 + nrm(ks[9], (N_GMLP_GROUPS, GMLP_CHUNK), 0.1)
    inp["l0_w_out"] = nrm(ks[10], (EVEN_OUT_W, d), EVEN_OUT_W ** -0.5)
    inp["l0_norm2"] = 1.0 + nrm(ks[11], (d,), 0.1)
    inp["l0_w_mod"] = nrm(ks[12], (d, N_MOD * d), 0.5 * d ** -0.5)
    inp["l0_b_mod"] = nrm(ks[13], (N_MOD * d,), 0.02)
    inp["l0_ffn_w1"] = nrm(ks[14], (d, D_FF), d ** -0.5)
    inp["l0_ffn_w2"] = nrm(ks[15], (D_FF, d), D_FF ** -0.5)
    inp["l1_norm1"] = 1.0 + nrm(ks[16], (d,), 0.1)
    inp["l1_w_in"] = nrm(ks[17], (d, 3 * CONV_CH), d ** -0.5)
    inp["l1_conv_w"] = nrm(ks[18], (CONV_K, CONV_CH), CONV_K ** -0.5)
    inp["l1_w_out"] = nrm(ks[19], (CONV_CH, d), CONV_CH ** -0.5)
    inp["l1_norm2"] = 1.0 + nrm(ks[20], (d,), 0.1)
    inp["l1_w_mod"] = nrm(ks[21], (d, N_MOD * d), 0.5 * d ** -0.5)
    inp["l1_b_mod"] = nrm(ks[22], (N_MOD * d,), 0.02)
    inp["l1_ffn_w1"] = nrm(ks[23], (d, D_FF), d ** -0.5)
    inp["l1_ffn_w2"] = nrm(ks[24], (D_FF, d), D_FF ** -0.5)
    inp["final_norm"] = 1.0 + nrm(ks[25], (d,), 0.1)
    return inp


def reference(x_prompt, x_sample, state_l0_ret, c, c_ctx,
              l0_norm1, l0_w_in, l0_ret_decay_exp, l0_gmlp_ws, l0_gmlp_b, l0_w_out, l0_norm2,
              l0_w_mod, l0_b_mod, l0_ffn_w1, l0_ffn_w2,
              l1_norm1, l1_w_in, l1_conv_w, l1_w_out, l1_norm2, l1_w_mod, l1_b_mod, l1_ffn_w1, l1_ffn_w2,
              final_norm):
    layers = [
        {"norm1": l0_norm1, "w_in": l0_w_in, "ret_decay_exp": l0_ret_decay_exp, "gmlp_ws": l0_gmlp_ws,
         "gmlp_b": l0_gmlp_b, "w_out": l0_w_out, "norm2": l0_norm2, "w_mod": l0_w_mod, "b_mod": l0_b_mod,
         "ffn_w1": l0_ffn_w1, "ffn_w2": l0_ffn_w2},
        {"norm1": l1_norm1, "w_in": l1_w_in, "conv_w": l1_conv_w, "w_out": l1_w_out, "norm2": l1_norm2,
         "w_mod": l1_w_mod, "b_mod": l1_b_mod, "ffn_w1": l1_ffn_w1, "ffn_w2": l1_ffn_w2},
    ]
    zero_state = jnp.zeros((x_prompt.shape[0], 2, N_RET_HEADS, RET_DK, RET_DV), x_prompt.dtype)
    y_prompt, ctx_states = trunk(x_prompt, c_ctx[None, :], [zero_state], layers, final_norm, None)
    new_state_l0_ret = ctx_states[0]
    rows = x_sample.shape[1] // GRID_W
    y_sample, _ = trunk(x_sample, c, [state_l0_ret], layers, final_norm, rows)
    return (y_prompt, y_sample, new_state_l0_ret)
```

```cpp
#include <hip/hip_runtime.h>
#include <hip/hip_cooperative_groups.h>
#include <cstdio>
namespace cg = cooperative_groups;

typedef unsigned short u16;
typedef float f32x4 __attribute__((ext_vector_type(4)));
typedef unsigned u32x4 __attribute__((ext_vector_type(4)));
typedef unsigned u32x2 __attribute__((ext_vector_type(2)));

constexpr int NT = 6144, DM = 1024, NPROMPT_T = 4096;
constexpr float EPS = 1e-6f;
constexpr int NTHR = 512;

__device__ __forceinline__ float bf2f(u16 b) { return __uint_as_float(((unsigned)b) << 16); }
__device__ __forceinline__ u16 f2bf(float f) { unsigned u = __float_as_uint(f); u += 0x7FFFu + ((u >> 16) & 1u); return (u16)(u >> 16); }
__device__ __forceinline__ unsigned pk2(float a, float b) { return (unsigned)f2bf(a) | ((unsigned)f2bf(b) << 16); }
__device__ __forceinline__ float silu_f(float x) { return x / (1.f + __expf(-x)); }
__device__ __forceinline__ float gelu_f(float x) { float u = 0.7978845608028654f * (x + 0.044715f * x * x * x); return 0.5f * x * (1.f + tanhf(u)); }
__device__ __forceinline__ int cond_of(int t) { return t < NPROMPT_T ? 0 : 1 + ((t - NPROMPT_T) >> 10); }
__device__ __forceinline__ float wave_sum(float v) {
#pragma unroll
  for (int o = 32; o > 0; o >>= 1) v += __shfl_xor(v, o);
  return v;
}

struct P {
  const float *x_prompt, *x_sample, *state, *c, *c_ctx;
  const float *l0_norm1, *l0_w_in, *l0_decay, *l0_gws, *l0_gb, *l0_w_out, *l0_norm2, *l0_w_mod, *l0_b_mod, *l0_f1, *l0_f2;
  const float *l1_norm1, *l1_w_in, *l1_conv, *l1_w_out, *l1_norm2, *l1_w_mod, *l1_b_mod, *l1_f1, *l1_f2, *final_norm;
  float* out;
  u16 *wt0_in, *wt0_out, *wt0_f1, *wt0_f2, *wt1_in, *wt1_out, *wt1_f1, *wt1_f2;
  float* mod;
  u16* hA;
  u16* proj;
  u16* cat;
  float* part;
  float* xres;
};

__device__ void transpose_tile(const float* __restrict__ W, int K, int N, u16* __restrict__ Wt, int tile, float* lds) {
  const int tn = N / 64; const int k0 = (tile / tn) * 64, n0 = (tile % tn) * 64;
  const int tid = threadIdx.x;
  float (*T)[65] = (float (*)[65])lds;
  __syncthreads();
  {
    const int r = tid >> 4, c4 = (tid & 15) * 4;
#pragma unroll
    for (int i = 0; i < 2; ++i) {
      const f32x4 v = *(const f32x4*)(W + (size_t)(k0 + r + 32 * i) * N + n0 + c4);
      T[r + 32 * i][c4 + 0] = v[0]; T[r + 32 * i][c4 + 1] = v[1]; T[r + 32 * i][c4 + 2] = v[2]; T[r + 32 * i][c4 + 3] = v[3];
    }
  }
  __syncthreads();
  {
    const int nn = tid >> 3, kk = (tid & 7) * 8;
    u32x4 o;
    o[0] = pk2(T[kk + 0][nn], T[kk + 1][nn]); o[1] = pk2(T[kk + 2][nn], T[kk + 3][nn]);
    o[2] = pk2(T[kk + 4][nn], T[kk + 5][nn]); o[3] = pk2(T[kk + 6][nn], T[kk + 7][nn]);
    *(u32x4*)(Wt + (size_t)(n0 + nn) * K + k0 + kk) = o;
  }
}

__device__ void adaln_item(const P& p, int item, float* lds) {
  const int l = item / 96, n0 = (item % 96) * 64;
  const float* W = l ? p.l1_w_mod : p.l0_w_mod; const float* B = l ? p.l1_b_mod : p.l0_b_mod;
  const int tid = threadIdx.x;
  float* sc = lds;
  float* red = lds + 3072;
  __syncthreads();
  for (int i = tid; i < 3072; i += NTHR) {
    const int c = i >> 10, k = i & 1023;
    const float v = c == 0 ? p.c_ctx[k] : p.c[(c - 1) * 1024 + k];
    sc[i] = silu_f(v);
  }
  __syncthreads();
  const int cg4 = tid & 15, rg = tid >> 4;
  float acc[3][4] = {};
  for (int it = 0; it < 32; ++it) {
    const int k = it * 32 + rg;
    const f32x4 w = *(const f32x4*)(W + (size_t)k * 6144 + n0 + cg4 * 4);
#pragma unroll
    for (int c = 0; c < 3; ++c) { const float s = sc[c * 1024 + k];
#pragma unroll
      for (int e = 0; e < 4; ++e) acc[c][e] += s * w[e]; }
  }
#pragma unroll
  for (int c = 0; c < 3; ++c)
#pragma unroll
    for (int e = 0; e < 4; ++e) red[(rg * 3 + c) * 64 + cg4 * 4 + e] = acc[c][e];
  __syncthreads();
  if (tid < 192) {
    const int c = tid >> 6, n = tid & 63; float s = B[n0 + n];
    for (int r = 0; r < 32; ++r) s += red[(r * 3 + c) * 64 + n];
    p.mod[(size_t)(l * 3 + c) * 6144 + n0 + n] = s;
  }
}

__device__ void phase_prep(const P& p, float* lds) {
  const int nA = 192;
  const int t0 = 1024, t1 = 384, t2 = 1024, t3 = 1024, t4 = 768, t5 = 256, t6 = 1024, t7 = 1024;
  const int total = nA + t0 + t1 + t2 + t3 + t4 + t5 + t6 + t7;
  for (int it = blockIdx.x; it < total; it += gridDim.x) {
    int i = it;
    if (i < nA) { adaln_item(p, i, lds); continue; }
    i -= nA;
    if (i < t0) { transpose_tile(p.l0_w_in, 1024, 4096, p.wt0_in, i, lds); continue; } i -= t0;
    if (i < t1) { transpose_tile(p.l0_w_out, 1536, 1024, p.wt0_out, i, lds); continue; } i -= t1;
    if (i < t2) { transpose_tile(p.l0_f1, 1024, 4096, p.wt0_f1, i, lds); continue; } i -= t2;
    if (i < t3) { transpose_tile(p.l0_f2, 4096, 1024, p.wt0_f2, i, lds); continue; } i -= t3;
    if (i < t4) { transpose_tile(p.l1_w_in, 1024, 3072, p.wt1_in, i, lds); continue; } i -= t4;
    if (i < t5) { transpose_tile(p.l1_w_out, 1024, 1024, p.wt1_out, i, lds); continue; } i -= t5;
    if (i < t6) { transpose_tile(p.l1_f1, 1024, 4096, p.wt1_f1, i, lds); continue; } i -= t6;
    transpose_tile(p.l1_f2, 4096, 1024, p.wt1_f2, i, lds);
  }
}

struct NormArgs {
  const float* xin0; const float* xin1;
  const float* p0; const float* p1; const float* gate;
  float* xout; const float* nw; const float* sh; const float* sc;
  u16* hout; float* fout;
};
__device__ void phase_norm(const NormArgs& a) {
  const int wid = threadIdx.x >> 6, lane = threadIdx.x & 63;
  for (int t = blockIdx.x * 8 + wid; t < NT; t += gridDim.x * 8) {
    const int c = cond_of(t);
    const float* xr = t < NPROMPT_T ? a.xin0 + (size_t)t * DM : a.xin1 + (size_t)(t - NPROMPT_T) * DM;
    f32x4 x[4]; float ss = 0.f;
#pragma unroll
    for (int i = 0; i < 4; ++i) {
      const int col = lane * 4 + 256 * i;
      x[i] = *(const f32x4*)(xr + col);
      if (a.p0) {
        const f32x4 q0 = *(const f32x4*)(a.p0 + (size_t)t * DM + col), q1 = *(const f32x4*)(a.p1 + (size_t)t * DM + col);
        const f32x4 g = *(const f32x4*)(a.gate + (size_t)c * 6144 + col);
        x[i] = x[i] + g * (q0 + q1);
      }
      if (a.xout) *(f32x4*)(a.xout + (size_t)t * DM + col) = x[i];
      ss += x[i][0] * x[i][0] + x[i][1] * x[i][1] + x[i][2] * x[i][2] + x[i][3] * x[i][3];
    }
    ss = wave_sum(ss);
    const float r = rsqrtf(ss * (1.f / 1024.f) + EPS);
#pragma unroll
    for (int i = 0; i < 4; ++i) {
      const int col = lane * 4 + 256 * i;
      const f32x4 w = *(const f32x4*)(a.nw + col);
      f32x4 y = x[i] * r * w;
      if (a.fout) *(f32x4*)(a.fout + (size_t)t * DM + col) = y;
      if (a.hout) {
        const f32x4 sh = *(const f32x4*)(a.sh + (size_t)c * 6144 + col), sc = *(const f32x4*)(a.sc + (size_t)c * 6144 + col);
        y = y * (1.f + sc) + sh;
        u32x2 o; o[0] = pk2(y[0], y[1]); o[1] = pk2(y[2], y[3]);
        *(u32x2*)(a.hout + (size_t)t * DM + col) = o;
      }
    }
  }
}

struct EpiProj0 {
  u16* O;
  __device__ __forceinline__ void store4(int row, int col, f32x4 v, int) const {
    if (col >= 3072) { v[0] = gelu_f(v[0]); v[1] = gelu_f(v[1]); v[2] = gelu_f(v[2]); v[3] = gelu_f(v[3]); }
    else if (col >= 2048) { v[0] = silu_f(v[0]); v[1] = silu_f(v[1]); v[2] = silu_f(v[2]); v[3] = silu_f(v[3]); }
    else if (col >= 512 && col < 1024) v = v * 0.08838834764831845f;
    u32x2 o; o[0] = pk2(v[0], v[1]); o[1] = pk2(v[2], v[3]);
    *(u32x2*)(O + (size_t)row * 4096 + col) = o;
  }
};
struct EpiPart {
  float* Pp;
  __device__ __forceinline__ void store4(int row, int col, f32x4 v, int ks) const { *(f32x4*)(Pp + ((size_t)ks * NT + row) * DM + col) = v; }
};
struct EpiRelu2 {
  u16* O;
  __device__ __forceinline__ void store4(int row, int col, f32x4 v, int) const {
#pragma unroll
    for (int e = 0; e < 4; ++e) { const float r = fmaxf(v[e], 0.f); v[e] = r * r; }
    u32x2 o; o[0] = pk2(v[0], v[1]); o[1] = pk2(v[2], v[3]);
    *(u32x2*)(O + (size_t)row * 4096 + col) = o;
  }
};
struct EpiPlain {
  u16* O; int ld;
  __device__ __forceinline__ void store4(int row, int col, f32x4 v, int) const {
    u32x2 o; o[0] = pk2(v[0], v[1]); o[1] = pk2(v[2], v[3]);
    *(u32x2*)(O + (size_t)row * ld + col) = o;
  }
};

template <class Epi>
__device__ void phase_gemm_naive(const u16* __restrict__ A, const u16* __restrict__ Bt, int M, int N, int K, int ksplit, const Epi& E, float* lds) {
  float (*As)[33] = (float (*)[33])lds;
  float (*Bs)[33] = (float (*)[33])(lds + 128 * 33);
  const int tm = M / 128, tn = N / 64, total = tm * tn * ksplit, kper = K / ksplit;
  const int tid = threadIdx.x, r = tid >> 2, cq = tid & 3;
  for (int it = blockIdx.x; it < total; it += gridDim.x) {
    const int ks = it / (tm * tn), rem = it % (tm * tn), m0 = (rem / tn) * 128, n0 = (rem % tn) * 64;
    float acc[4][4] = {};
    for (int k0 = ks * kper; k0 < (ks + 1) * kper; k0 += 32) {
      __syncthreads();
      {
        const int kc = (tid & 3) * 8;
        const u32x4 va = *(const u32x4*)(A + (size_t)(m0 + r) * K + k0 + kc);
#pragma unroll
        for (int e = 0; e < 4; ++e) { As[r][kc + 2 * e] = __uint_as_float(va[e] << 16); As[r][kc + 2 * e + 1] = __uint_as_float(va[e] & 0xffff0000u); }
        if (tid < 256) {
          const u32x4 vb = *(const u32x4*)(Bt + (size_t)(n0 + r) * K + k0 + kc);
#pragma unroll
          for (int e = 0; e < 4; ++e) { Bs[r][kc + 2 * e] = __uint_as_float(vb[e] << 16); Bs[r][kc + 2 * e + 1] = __uint_as_float(vb[e] & 0xffff0000u); }
        }
      }
      __syncthreads();
#pragma unroll 4
      for (int k = 0; k < 32; ++k) {
        const float a = As[r][k];
#pragma unroll
        for (int jj = 0; jj < 4; ++jj)
#pragma unroll
          for (int e = 0; e < 4; ++e) acc[jj][e] += a * Bs[cq * 4 + 16 * jj + e][k];
      }
    }
#pragma unroll
    for (int jj = 0; jj < 4; ++jj) { f32x4 v = {acc[jj][0], acc[jj][1], acc[jj][2], acc[jj][3]}; E.store4(m0 + r, n0 + cq * 4 + 16 * jj, v, ks); }
  }
}

__device__ __forceinline__ void seq_of_token(int t, int& s0, int& L, int& sb) {
  if (t < NPROMPT_T) { s0 = t & ~255; L = 256; sb = -1; } else { sb = (t - NPROMPT_T) >> 10; s0 = NPROMPT_T + (sb << 10); L = 1024; }
}
__device__ void ret_item_naive(const P& p, int item, float* lds) {
  const int tg = item >> 2, h = item & 3, t0 = tg * 16, tid = threadIdx.x;
  int s0, L, sb; seq_of_token(t0, s0, L, sb);
  float* scr = lds;
  float* qs = lds + 16 * 1024;
  float* red = qs + 16 * 128;
  const float lgf = log1pf(-exp2f(-p.l0_decay[h])), lgb = log1pf(-exp2f(-p.l0_decay[4 + h]));
  __syncthreads();
  for (int i = tid; i < 16 * 128; i += NTHR) qs[i] = bf2f(p.proj[(size_t)(t0 + (i >> 7)) * 4096 + h * 128 + (i & 127)]);
  __syncthreads();
  for (int j = tid; j < L; j += NTHR) {
    float acc[16] = {};
    const u16* kr = p.proj + (size_t)(s0 + j) * 4096 + 512 + h * 128;
    for (int d0 = 0; d0 < 128; d0 += 8) {
      const u32x4 kv = *(const u32x4*)(kr + d0);
      float kf[8];
#pragma unroll
      for (int e = 0; e < 4; ++e) { kf[2 * e] = __uint_as_float(kv[e] << 16); kf[2 * e + 1] = __uint_as_float(kv[e] & 0xffff0000u); }
#pragma unroll
      for (int i = 0; i < 16; ++i)
#pragma unroll
        for (int e = 0; e < 8; ++e) acc[i] += qs[i * 128 + d0 + e] * kf[e];
    }
#pragma unroll
    for (int i = 0; i < 16; ++i) {
      const int d = (t0 + i - s0) - j;
      const float w = d > 0 ? __expf((float)d * lgf) : (d < 0 ? __expf((float)(-d) * lgb) : 2.f);
      scr[i * 1024 + j] = acc[i] * w;
    }
  }
  __syncthreads();
  const int dv = tid & 255, ig = tid >> 8;
  float o[8] = {};
  for (int j = 0; j < L; ++j) {
    const float v = bf2f(p.proj[(size_t)(s0 + j) * 4096 + 1024 + h * 256 + dv]);
#pragma unroll
    for (int e = 0; e < 8; ++e) o[e] += scr[(ig * 8 + e) * 1024 + j] * v;
  }
  if (sb >= 0) {
    const float* Sf = p.state + ((size_t)(sb * 2 + 0) * 4 + h) * 128 * 256;
    const float* Sb = p.state + ((size_t)(sb * 2 + 1) * 4 + h) * 128 * 256;
    float af[8] = {}, ab[8] = {};
    for (int dk = 0; dk < 128; ++dk) {
      const float sf = Sf[dk * 256 + dv], sbv = Sb[dk * 256 + dv];
#pragma unroll
      for (int e = 0; e < 8; ++e) { const float q = qs[(ig * 8 + e) * 128 + dk]; af[e] += q * sf; ab[e] += q * sbv; }
    }
#pragma unroll
    for (int e = 0; e < 8; ++e) {
      const int pos = t0 + ig * 8 + e - s0;
      o[e] += __expf((float)(pos + 1) * lgf) * af[e] + __expf((float)(L - pos) * lgb) * ab[e];
    }
  }
  const int wid = tid >> 6, lane = tid & 63;
#pragma unroll
  for (int e = 0; e < 8; ++e) { const float s = wave_sum(o[e] * o[e]); if (lane == 0) red[wid * 8 + e] = s; }
  __syncthreads();
#pragma unroll
  for (int e = 0; e < 8; ++e) {
    const float ss = red[(ig * 4 + 0) * 8 + e] + red[(ig * 4 + 1) * 8 + e] + red[(ig * 4 + 2) * 8 + e] + red[(ig * 4 + 3) * 8 + e];
    const float r = rsqrtf(ss * (1.f / 256.f) + EPS);
    const int t = t0 + ig * 8 + e;
    const float g = bf2f(p.proj[(size_t)t * 4096 + 2048 + h * 256 + dv]);
    p.cat[(size_t)t * 1536 + h * 256 + dv] = f2bf(o[e] * r * g);
  }
}
__device__ void state_item_naive(const P& p, int item) {
  const int b = item >> 3, h = (item >> 1) & 3, dir = item & 1, tid = threadIdx.x;
  const float lg = log1pf(-exp2f(-p.l0_decay[dir * 4 + h]));
  const int dv = tid & 255;
  float* o = p.out + (size_t)NT * DM + ((size_t)(b * 2 + dir) * 4 + h) * 128 * 256;
  for (int pass = 0; pass < 4; ++pass) {
    const int dk0 = (tid >> 8) * 64 + pass * 16;
    float acc[16] = {};
    for (int s = 0; s < 256; ++s) {
      const int t = b * 256 + s;
      const float w = dir == 0 ? __expf((float)(255 - s) * lg) : __expf((float)s * lg);
      const float v = bf2f(p.proj[(size_t)t * 4096 + 1024 + h * 256 + dv]) * w;
      const u16* kr = p.proj + (size_t)t * 4096 + 512 + h * 128 + dk0;
#pragma unroll
      for (int e = 0; e < 16; ++e) acc[e] += bf2f(kr[e]) * v;
    }
#pragma unroll
    for (int e = 0; e < 16; ++e) o[(dk0 + e) * 256 + dv] = acc[e];
  }
}
__device__ void gmlp_item_naive(const P& p, int item, float* lds) {
  const int ci = item >> 2, g = item & 3, tid = threadIdx.x, wid = tid >> 6, lane = tid & 63;
  float* zn = lds;
  float* mu = lds + 128 * 128;
  float* rs = mu + 128;
  __syncthreads();
  for (int q = wid; q < 128; q += 8) {
    const u32x4 v = *(const u32x4*)(p.proj + (size_t)(ci * 128 + q) * 4096 + 3584 + lane * 8);
    float s = 0.f, s2 = 0.f;
#pragma unroll
    for (int e = 0; e < 4; ++e) { const float a = __uint_as_float(v[e] << 16), b = __uint_as_float(v[e] & 0xffff0000u); s += a + b; s2 += a * a + b * b; }
    s = wave_sum(s); s2 = wave_sum(s2);
    if (lane == 0) { const float m = s * (1.f / 512.f); const float var = fmaxf(s2 * (1.f / 512.f) - m * m, 0.f); mu[q] = m; rs[q] = rsqrtf(var + EPS); }
  }
  __syncthreads();
  for (int i = tid; i < 128 * 128; i += NTHR) {
    const int q = i >> 7, c = i & 127;
    zn[i] = (bf2f(p.proj[(size_t)(ci * 128 + q) * 4096 + 3584 + g * 128 + c]) - mu[q]) * rs[q];
  }
  __syncthreads();
  const int c = tid & 127, p0 = (tid >> 7) * 32;
  float acc[32] = {};
  const float* W = p.l0_gws + (size_t)g * 128 * 128;
  for (int q = 0; q < 128; ++q) {
    const float z = zn[q * 128 + c];
#pragma unroll
    for (int e = 0; e < 32; ++e) acc[e] += W[(p0 + e) * 128 + q] * z;
  }
#pragma unroll
  for (int e = 0; e < 32; ++e) {
    const int t = ci * 128 + p0 + e;
    const float u = bf2f(p.proj[(size_t)t * 4096 + 3072 + g * 128 + c]);
    p.cat[(size_t)t * 1536 + 1024 + g * 128 + c] = f2bf((acc[e] + p.l0_gb[g * 128 + p0 + e]) * u);
  }
}
__device__ void phase_mixer_naive(const P& p, float* lds) {
  const int nR = 1536, nS = 128, nG = 192, total = nR + nS + nG;
  for (int it = blockIdx.x; it < total; it += gridDim.x) {
    if (it < nR) ret_item_naive(p, it, lds);
    else if (it < nR + nS) state_item_naive(p, it - nR);
    else gmlp_item_naive(p, it - nR - nS, lds);
  }
}

__device__ void phase_conv(const P& p) {
  const u16* pj = p.proj;
  for (size_t i = (size_t)blockIdx.x * NTHR + threadIdx.x; i < (size_t)NT * 256; i += (size_t)gridDim.x * NTHR) {
    const int t = (int)(i >> 8), c4 = (int)(i & 255) * 4;
    const int seg = t < NPROMPT_T ? 256 : 64;
    const int pos = t < NPROMPT_T ? (t & 255) : ((t - NPROMPT_T) & 63);
    f32x4 xc[3];
#pragma unroll
    for (int d = 0; d < 3; ++d) {
      const int pp = pos + d - 1;
      if (pp < 0 || pp >= seg) { xc[d] = (f32x4){0.f, 0.f, 0.f, 0.f}; continue; }
      const u16* r = pj + (size_t)(t + d - 1) * 3072;
      const u32x2 a = *(const u32x2*)(r + 1024 + c4), b = *(const u32x2*)(r + 2048 + c4);
      xc[d][0] = __uint_as_float(a[0] << 16) * __uint_as_float(b[0] << 16);
      xc[d][1] = __uint_as_float(a[0] & 0xffff0000u) * __uint_as_float(b[0] & 0xffff0000u);
      xc[d][2] = __uint_as_float(a[1] << 16) * __uint_as_float(b[1] << 16);
      xc[d][3] = __uint_as_float(a[1] & 0xffff0000u) * __uint_as_float(b[1] & 0xffff0000u);
    }
    const f32x4 w0 = *(const f32x4*)(p.l1_conv + c4), w1 = *(const f32x4*)(p.l1_conv + 1024 + c4), w2 = *(const f32x4*)(p.l1_conv + 2048 + c4);
    const u32x2 bgv = *(const u32x2*)(pj + (size_t)t * 3072 + c4);
    f32x4 bg = {__uint_as_float(bgv[0] << 16), __uint_as_float(bgv[0] & 0xffff0000u), __uint_as_float(bgv[1] << 16), __uint_as_float(bgv[1] & 0xffff0000u)};
    const f32x4 y = bg * (w0 * xc[0] + w1 * xc[1] + w2 * xc[2]);
    u32x2 o; o[0] = pk2(y[0], y[1]); o[1] = pk2(y[2], y[3]);
    *(u32x2*)(p.cat + (size_t)t * 1024 + c4) = o;
  }
}

constexpr int NPHASE = 16;
__global__ void __launch_bounds__(NTHR) mega(P p, int lo, int hi) {
  extern __shared__ __attribute__((aligned(16))) unsigned char smem[];
  float* lds = (float*)smem;
  cg::grid_group grid = cg::this_grid();
  const float* m0 = p.mod; const float* m1 = p.mod + 3 * 6144;
#define PH(n, ...) if (lo <= (n) && (n) < hi) { if ((n) > lo) grid.sync(); __VA_ARGS__ }
  PH(0, phase_prep(p, lds);)
  PH(1, { NormArgs a{p.x_prompt, p.x_sample, nullptr, nullptr, nullptr, nullptr, p.l0_norm1, m0 + 0, m0 + 1024, p.hA, nullptr}; phase_norm(a); })
  PH(2, { EpiProj0 e{p.proj}; phase_gemm_naive(p.hA, p.wt0_in, NT, 4096, 1024, 1, e, lds); })
  PH(3, phase_mixer_naive(p, lds);)
  PH(4, { EpiPart e{p.part}; phase_gemm_naive(p.cat, p.wt0_out, NT, 1024, 1536, 2, e, lds); })
  PH(5, { NormArgs a{p.x_prompt, p.x_sample, p.part, p.part + (size_t)NT * DM, m0 + 2048, p.xres, p.l0_norm2, m0 + 3072, m0 + 4096, p.hA, nullptr}; phase_norm(a); })
  PH(6, { EpiRelu2 e{p.proj}; phase_gemm_naive(p.hA, p.wt0_f1, NT, 4096, 1024, 1, e, lds); })
  PH(7, { EpiPart e{p.part}; phase_gemm_naive(p.proj, p.wt0_f2, NT, 1024, 4096, 2, e, lds); })
  PH(8, { NormArgs a{p.xres, p.xres + (size_t)NPROMPT_T * DM, p.part, p.part + (size_t)NT * DM, m0 + 5120, p.xres, p.l1_norm1, m1 + 0, m1 + 1024, p.hA, nullptr}; phase_norm(a); })
  PH(9, { EpiPlain e{p.proj, 3072}; phase_gemm_naive(p.hA, p.wt1_in, NT, 3072, 1024, 1, e, lds); })
  PH(10, phase_conv(p);)
  PH(11, { EpiPart e{p.part}; phase_gemm_naive(p.cat, p.wt1_out, NT, 1024, 1024, 2, e, lds); })
  PH(12, { NormArgs a{p.xres, p.xres + (size_t)NPROMPT_T * DM, p.part, p.part + (size_t)NT * DM, m1 + 2048, p.xres, p.l1_norm2, m1 + 3072, m1 + 4096, p.hA, nullptr}; phase_norm(a); })
  PH(13, { EpiRelu2 e{p.proj}; phase_gemm_naive(p.hA, p.wt1_f1, NT, 4096, 1024, 1, e, lds); })
  PH(14, { EpiPart e{p.part}; phase_gemm_naive(p.proj, p.wt1_f2, NT, 1024, 4096, 2, e, lds); })
  PH(15, { NormArgs a{p.xres, p.xres + (size_t)NPROMPT_T * DM, p.part, p.part + (size_t)NT * DM, m1 + 5120, nullptr, p.final_norm, nullptr, nullptr, nullptr, p.out}; phase_norm(a); })
#undef PH
}

constexpr size_t LDS_BYTES = 131072;
constexpr bool ONE_LAUNCH = true;

extern "C" void kernel_launch(void* const* d_in, const int* in_sizes, int n_in, void* d_out, int out_size, void* d_ws, size_t ws_size, hipStream_t stream) {
  static int grid_blocks = 0;
  if (!grid_blocks) {
    hipFuncSetAttribute((const void*)mega, hipFuncAttributeMaxDynamicSharedMemorySize, (int)LDS_BYTES);
    int dev = 0, cus = 0, per_cu = 0;
    hipGetDevice(&dev);
    hipDeviceGetAttribute(&cus, hipDeviceAttributeMultiprocessorCount, dev);
    hipOccupancyMaxActiveBlocksPerMultiprocessor(&per_cu, mega, NTHR, LDS_BYTES);
    if (per_cu < 1) per_cu = 1;
    if (per_cu > 1) per_cu = 1;
    grid_blocks = cus * per_cu;
  }
  P p{};
  const float* const* in = (const float* const*)d_in;
  p.x_prompt = in[0]; p.x_sample = in[1]; p.state = in[2]; p.c = in[3]; p.c_ctx = in[4];
  p.l0_norm1 = in[5]; p.l0_w_in = in[6]; p.l0_decay = in[7]; p.l0_gws = in[8]; p.l0_gb = in[9]; p.l0_w_out = in[10]; p.l0_norm2 = in[11];
  p.l0_w_mod = in[12]; p.l0_b_mod = in[13]; p.l0_f1 = in[14]; p.l0_f2 = in[15];
  p.l1_norm1 = in[16]; p.l1_w_in = in[17]; p.l1_conv = in[18]; p.l1_w_out = in[19]; p.l1_norm2 = in[20]; p.l1_w_mod = in[21]; p.l1_b_mod = in[22];
  p.l1_f1 = in[23]; p.l1_f2 = in[24]; p.final_norm = in[25];
  p.out = (float*)d_out;
  unsigned char* w = (unsigned char*)d_ws; size_t off = 0;
  auto take = [&](size_t bytes) { void* r = w + off; off += (bytes + 255) & ~(size_t)255; return r; };
  p.wt0_in = (u16*)take((size_t)4096 * 1024 * 2); p.wt0_out = (u16*)take((size_t)1024 * 1536 * 2);
  p.wt0_f1 = (u16*)take((size_t)4096 * 1024 * 2); p.wt0_f2 = (u16*)take((size_t)4096 * 1024 * 2);
  p.wt1_in = (u16*)take((size_t)3072 * 1024 * 2); p.wt1_out = (u16*)take((size_t)1024 * 1024 * 2);
  p.wt1_f1 = (u16*)take((size_t)4096 * 1024 * 2); p.wt1_f2 = (u16*)take((size_t)4096 * 1024 * 2);
  p.mod = (float*)take((size_t)2 * 3 * 6144 * 4);
  p.hA = (u16*)take((size_t)NT * 1024 * 2);
  p.proj = (u16*)take((size_t)NT * 4096 * 2);
  p.cat = (u16*)take((size_t)NT * 1536 * 2);
  p.part = (float*)take((size_t)2 * NT * 1024 * 4);
  p.xres = (float*)take((size_t)NT * 1024 * 4);
  if (ONE_LAUNCH) {
    int lo = 0, hi = NPHASE; void* args[] = {&p, &lo, &hi};
    hipError_t e = hipLaunchCooperativeKernel((void*)mega, dim3(grid_blocks), dim3(NTHR), args, LDS_BYTES, stream);
    if (e != hipSuccess) fprintf(stderr, "cooperative launch failed: %s (grid %d)\n", hipGetErrorString(e), grid_blocks);
  } else {
    for (int ph = 0; ph < NPHASE; ++ph) hipLaunchKernelGGL(mega, dim3(grid_blocks), dim3(NTHR), LDS_BYTES, stream, p, ph, ph + 1);
  }
}
```

```cpp
#include <hip/hip_runtime.h>
#include <hip/hip_cooperative_groups.h>
#include <cstdio>
namespace cg = cooperative_groups;

typedef unsigned short u16;
typedef float f32x4 __attribute__((ext_vector_type(4)));
typedef unsigned u32x4 __attribute__((ext_vector_type(4)));
typedef unsigned u32x2 __attribute__((ext_vector_type(2)));

constexpr int NT = 6144, DM = 1024, NPROMPT_T = 4096;
constexpr float EPS = 1e-6f;
constexpr int NTHR = 512;

__device__ __forceinline__ float bf2f(u16 b) { return __uint_as_float(((unsigned)b) << 16); }
__device__ __forceinline__ u16 f2bf(float f) { unsigned u = __float_as_uint(f); u += 0x7FFFu + ((u >> 16) & 1u); return (u16)(u >> 16); }
__device__ __forceinline__ unsigned pk2(float a, float b) { return (unsigned)f2bf(a) | ((unsigned)f2bf(b) << 16); }
__device__ __forceinline__ float silu_f(float x) { return x / (1.f + __expf(-x)); }
__device__ __forceinline__ float gelu_f(float x) { float u = 0.7978845608028654f * (x + 0.044715f * x * x * x); return 0.5f * x * (1.f + tanhf(u)); }
__device__ __forceinline__ int cond_of(int t) { return t < NPROMPT_T ? 0 : 1 + ((t - NPROMPT_T) >> 10); }
__device__ __forceinline__ float wave_sum(float v) {
#pragma unroll
  for (int o = 32; o > 0; o >>= 1) v += __shfl_xor(v, o);
  return v;
}

struct P {
  const float *x_prompt, *x_sample, *state, *c, *c_ctx;
  const float *l0_norm1, *l0_w_in, *l0_decay, *l0_gws, *l0_gb, *l0_w_out, *l0_norm2, *l0_w_mod, *l0_b_mod, *l0_f1, *l0_f2;
  const float *l1_norm1, *l1_w_in, *l1_conv, *l1_w_out, *l1_norm2, *l1_w_mod, *l1_b_mod, *l1_f1, *l1_f2, *final_norm;
  float* out;
  u16 *wt0_in, *wt0_out, *wt0_f1, *wt0_f2, *wt1_in, *wt1_out, *wt1_f1, *wt1_f2;
  float* mod;
  u16* hA;
  u16* proj;
  u16* cat;
  float* part;
  float* xres;
};

__device__ __forceinline__ void transpose_tile(const float* __restrict__ W, int K, int N, u16* __restrict__ Wt, int tile, float* lds) {
  const int tn = N / 64; const int k0 = (tile / tn) * 64, n0 = (tile % tn) * 64;
  const int tid = threadIdx.x;
  float (*T)[65] = (float (*)[65])lds;
  __syncthreads();
  {
    const int r = tid >> 4, c4 = (tid & 15) * 4;
#pragma unroll
    for (int i = 0; i < 2; ++i) {
      const f32x4 v = *(const f32x4*)(W + (size_t)(k0 + r + 32 * i) * N + n0 + c4);
      T[r + 32 * i][c4 + 0] = v[0]; T[r + 32 * i][c4 + 1] = v[1]; T[r + 32 * i][c4 + 2] = v[2]; T[r + 32 * i][c4 + 3] = v[3];
    }
  }
  __syncthreads();
  {
    const int nn = tid >> 3, kk = (tid & 7) * 8;
    u32x4 o;
    o[0] = pk2(T[kk + 0][nn], T[kk + 1][nn]); o[1] = pk2(T[kk + 2][nn], T[kk + 3][nn]);
    o[2] = pk2(T[kk + 4][nn], T[kk + 5][nn]); o[3] = pk2(T[kk + 6][nn], T[kk + 7][nn]);
    *(u32x4*)(Wt + (size_t)(n0 + nn) * K + k0 + kk) = o;
  }
}

__device__ __forceinline__ void adaln_item(const P& p, int item, float* lds) {
  const int l = item / 96, n0 = (item % 96) * 64;
  const float* W = l ? p.l1_w_mod : p.l0_w_mod; const float* B = l ? p.l1_b_mod : p.l0_b_mod;
  const int tid = threadIdx.x;
  float* sc = lds;
  float* red = lds + 3072;
  __syncthreads();
  for (int i = tid; i < 3072; i += NTHR) {
    const int c = i >> 10, k = i & 1023;
    const float v = c == 0 ? p.c_ctx[k] : p.c[(c - 1) * 1024 + k];
    sc[i] = silu_f(v);
  }
  __syncthreads();
  const int cg4 = tid & 15, rg = tid >> 4;
  float acc[3][4] = {};
  for (int it = 0; it < 32; ++it) {
    const int k = it * 32 + rg;
    const f32x4 w = *(const f32x4*)(W + (size_t)k * 6144 + n0 + cg4 * 4);
#pragma unroll
    for (int c = 0; c < 3; ++c) { const float s = sc[c * 1024 + k];
#pragma unroll
      for (int e = 0; e < 4; ++e) acc[c][e] += s * w[e]; }
  }
#pragma unroll
  for (int c = 0; c < 3; ++c)
#pragma unroll
    for (int e = 0; e < 4; ++e) red[(rg * 3 + c) * 64 + cg4 * 4 + e] = acc[c][e];
  __syncthreads();
  if (tid < 192) {
    const int c = tid >> 6, n = tid & 63; float s = B[n0 + n];
    for (int r = 0; r < 32; ++r) s += red[(r * 3 + c) * 64 + n];
    p.mod[(size_t)(l * 3 + c) * 6144 + n0 + n] = s;
  }
}

__device__ __forceinline__ void phase_prep(const P& p, float* lds) {
  const int nA = 192;
  const int t0 = 1024, t1 = 384, t2 = 1024, t3 = 1024, t4 = 768, t5 = 256, t6 = 1024, t7 = 1024;
  const int total = nA + t0 + t1 + t2 + t3 + t4 + t5 + t6 + t7;
  for (int it = blockIdx.x; it < total; it += gridDim.x) {
    int i = it;
    if (i < nA) { adaln_item(p, i, lds); continue; }
    i -= nA;
    if (i < t0) { transpose_tile(p.l0_w_in, 1024, 4096, p.wt0_in, i, lds); continue; } i -= t0;
    if (i < t1) { transpose_tile(p.l0_w_out, 1536, 1024, p.wt0_out, i, lds); continue; } i -= t1;
    if (i < t2) { transpose_tile(p.l0_f1, 1024, 4096, p.wt0_f1, i, lds); continue; } i -= t2;
    if (i < t3) { transpose_tile(p.l0_f2, 4096, 1024, p.wt0_f2, i, lds); continue; } i -= t3;
    if (i < t4) { transpose_tile(p.l1_w_in, 1024, 3072, p.wt1_in, i, lds); continue; } i -= t4;
    if (i < t5) { transpose_tile(p.l1_w_out, 1024, 1024, p.wt1_out, i, lds); continue; } i -= t5;
    if (i < t6) { transpose_tile(p.l1_f1, 1024, 4096, p.wt1_f1, i, lds); continue; } i -= t6;
    transpose_tile(p.l1_f2, 4096, 1024, p.wt1_f2, i, lds);
  }
}

struct NormArgs {
  const float* xin0; const float* xin1;
  const float* p0; const float* p1; const float* gate;
  float* xout; const float* nw; const float* sh; const float* sc;
  u16* hout; float* fout;
};
__device__ __forceinline__ void phase_norm(const NormArgs& a) {
  const int wid = threadIdx.x >> 6, lane = threadIdx.x & 63;
  for (int t = blockIdx.x * 8 + wid; t < NT; t += gridDim.x * 8) {
    const int c = cond_of(t);
    const float* xr = t < NPROMPT_T ? a.xin0 + (size_t)t * DM : a.xin1 + (size_t)(t - NPROMPT_T) * DM;
    f32x4 x[4]; float ss = 0.f;
#pragma unroll
    for (int i = 0; i < 4; ++i) {
      const int col = lane * 4 + 256 * i;
      x[i] = *(const f32x4*)(xr + col);
      if (a.p0) {
        const f32x4 q0 = *(const f32x4*)(a.p0 + (size_t)t * DM + col), q1 = *(const f32x4*)(a.p1 + (size_t)t * DM + col);
        const f32x4 g = *(const f32x4*)(a.gate + (size_t)c * 6144 + col);
        x[i] = x[i] + g * (q0 + q1);
      }
      if (a.xout) *(f32x4*)(a.xout + (size_t)t * DM + col) = x[i];
      ss += x[i][0] * x[i][0] + x[i][1] * x[i][1] + x[i][2] * x[i][2] + x[i][3] * x[i][3];
    }
    ss = wave_sum(ss);
    const float r = rsqrtf(ss * (1.f / 1024.f) + EPS);
#pragma unroll
    for (int i = 0; i < 4; ++i) {
      const int col = lane * 4 + 256 * i;
      const f32x4 w = *(const f32x4*)(a.nw + col);
      f32x4 y = x[i] * r * w;
      if (a.fout) *(f32x4*)(a.fout + (size_t)t * DM + col) = y;
      if (a.hout) {
        const f32x4 sh = *(const f32x4*)(a.sh + (size_t)c * 6144 + col), sc = *(const f32x4*)(a.sc + (size_t)c * 6144 + col);
        y = y * (1.f + sc) + sh;
        u32x2 o; o[0] = pk2(y[0], y[1]); o[1] = pk2(y[2], y[3]);
        *(u32x2*)(a.hout + (size_t)t * DM + col) = o;
      }
    }
  }
}

struct EpiProj0 {
  u16* O;
  __device__ __forceinline__ void store4(int row, int col, f32x4 v, int) const {
    if (col >= 3072) { v[0] = gelu_f(v[0]); v[1] = gelu_f(v[1]); v[2] = gelu_f(v[2]); v[3] = gelu_f(v[3]); }
    else if (col >= 2048) { v[0] = silu_f(v[0]); v[1] = silu_f(v[1]); v[2] = silu_f(v[2]); v[3] = silu_f(v[3]); }
    else if (col >= 512 && col < 1024) v = v * 0.08838834764831845f;
    u32x2 o; o[0] = pk2(v[0], v[1]); o[1] = pk2(v[2], v[3]);
    *(u32x2*)(O + (size_t)row * 4096 + col) = o;
  }
};
struct EpiPart {
  float* Pp;
  __device__ __forceinline__ void store4(int row, int col, f32x4 v, int ks) const { *(f32x4*)(Pp + ((size_t)ks * NT + row) * DM + col) = v; }
};
struct EpiRelu2 {
  u16* O;
  __device__ __forceinline__ void store4(int row, int col, f32x4 v, int) const {
#pragma unroll
    for (int e = 0; e < 4; ++e) { const float r = fmaxf(v[e], 0.f); v[e] = r * r; }
    u32x2 o; o[0] = pk2(v[0], v[1]); o[1] = pk2(v[2], v[3]);
    *(u32x2*)(O + (size_t)row * 4096 + col) = o;
  }
};
struct EpiPlain {
  u16* O; int ld;
  __device__ __forceinline__ void store4(int row, int col, f32x4 v, int) const {
    u32x2 o; o[0] = pk2(v[0], v[1]); o[1] = pk2(v[2], v[3]);
    *(u32x2*)(O + (size_t)row * ld + col) = o;
  }
};

template <class Epi>
__device__ __forceinline__ void phase_gemm_naive(const u16* __restrict__ A, const u16* __restrict__ Bt, int M, int N, int K, int ksplit, const Epi& E, float* lds) {
  float (*As)[33] = (float (*)[33])lds;
  float (*Bs)[33] = (float (*)[33])(lds + 128 * 33);
  const int tm = M / 128, tn = N / 64, total = tm * tn * ksplit, kper = K / ksplit;
  const int tid = threadIdx.x, r = tid >> 2, cq = tid & 3;
  for (int it = blockIdx.x; it < total; it += gridDim.x) {
    const int ks = it / (tm * tn), rem = it % (tm * tn), m0 = (rem / tn) * 128, n0 = (rem % tn) * 64;
    float acc[4][4] = {};
    for (int k0 = ks * kper; k0 < (ks + 1) * kper; k0 += 32) {
      __syncthreads();
      {
        const int kc = (tid & 3) * 8;
        const u32x4 va = *(const u32x4*)(A + (size_t)(m0 + r) * K + k0 + kc);
#pragma unroll
        for (int e = 0; e < 4; ++e) { As[r][kc + 2 * e] = __uint_as_float(va[e] << 16); As[r][kc + 2 * e + 1] = __uint_as_float(va[e] & 0xffff0000u); }
        if (tid < 256) {
          const u32x4 vb = *(const u32x4*)(Bt + (size_t)(n0 + r) * K + k0 + kc);
#pragma unroll
          for (int e = 0; e < 4; ++e) { Bs[r][kc + 2 * e] = __uint_as_float(vb[e] << 16); Bs[r][kc + 2 * e + 1] = __uint_as_float(vb[e] & 0xffff0000u); }
        }
      }
      __syncthreads();
#pragma unroll 4
      for (int k = 0; k < 32; ++k) {
        const float a = As[r][k];
#pragma unroll
        for (int jj = 0; jj < 4; ++jj)
#pragma unroll
          for (int e = 0; e < 4; ++e) acc[jj][e] += a * Bs[cq * 4 + 16 * jj + e][k];
      }
    }
#pragma unroll
    for (int jj = 0; jj < 4; ++jj) { f32x4 v = {acc[jj][0], acc[jj][1], acc[jj][2], acc[jj][3]}; E.store4(m0 + r, n0 + cq * 4 + 16 * jj, v, ks); }
  }
}


namespace pg8 {
#define PG8_LAS __attribute__((address_space(3)))
typedef short bf16x8 __attribute__((ext_vector_type(8)));
constexpr int BM = 256, BK = 64, HALF = 128, HTB = HALF * BK * 2, STAGE_BYTES = 8 * HTB, NXCD = 8, WGM = 8;
__device__ __forceinline__ int lds_byte(int r, int c) { const int st = (r >> 4) * 2 + (c >> 5), rr = r & 15, cc = c & 31, ob = rr * 64 + cc * 2; return st * 1024 + (ob ^ (((ob >> 9) & 1) << 5)); }
__device__ __forceinline__ void stage_rc(int b, int& R, int& C) { const int st = b / 1024, sb = b % 1024, swz = sb ^ (((sb >> 9) & 1) << 5); R = (st >> 1) * 16 + swz / 64; C = (st & 1) * 32 + (swz % 64) / 2; }
struct Unit { int pm, pn, ks; };
struct Gemm { const u16* A; const u16* Bt; int M, N, K, ksplit; };
struct Order {
  int nM, nN, ntile, nwg, G, c;
  __device__ void init(int M, int N, int ksplit, int G_, int c_) { nM = M / BM; nN = N / BM; ntile = nM * nN; nwg = ntile * ksplit; G = G_; c = c_; }
  __device__ bool next(int i, Unit& u) const {
    const int L = i * G + c; if (L >= nwg) return false;
    u.ks = L / ntile; int wgid = L % ntile;
    { const int q = ntile / NXCD, r = ntile % NXCD, xcd = wgid % NXCD, off = wgid / NXCD; wgid = (xcd < r ? xcd * (q + 1) : r * (q + 1) + (xcd - r) * q) + off; }
    const int nig = WGM * nN, gid = wgid / nig, fm = gid * WGM, gsz = (nM - fm) < WGM ? (nM - fm) : WGM;
    u.pm = fm + ((wgid % nig) % gsz); u.pn = (wgid % nig) / gsz; return true;
  }
};
template <class Epi>
__device__ __forceinline__ void run_epi(const Epi& E, const f32x4 (&acc)[2][2][4][2], const Unit& u, int wr, int wc, int fr, int fq) {
  const int row0 = u.pm * BM + wr * 64 + fr, col0 = u.pn * BM + wc * 32 + 4 * fq;
#pragma unroll
  for (int ai = 0; ai < 2; ++ai)
#pragma unroll
    for (int m = 0; m < 4; ++m)
#pragma unroll
      for (int bj = 0; bj < 2; ++bj)
#pragma unroll
        for (int n = 0; n < 2; ++n) E.store4(row0 + ai * HALF + m * 16, col0 + bj * HALF + n * 16, acc[ai][bj][m][n], u.ks);
}
template <class Epi>
__device__ __forceinline__ void gemm_phase(PG8_LAS unsigned char* lds, const Gemm g, const Order& S, const Epi& E) {
  const int tid = threadIdx.x, wid = __builtin_amdgcn_readfirstlane(tid >> 6), lane = tid & 63, wr = wid >> 2, wc = wid & 3, fr = lane & 15, fq = lane >> 4;
  const int K = g.K, kper = g.K / g.ksplit, nt = kper / BK;
  unsigned voffA[2];
#pragma unroll
  for (int i = 0; i < 2; ++i) { int R, C; stage_rc(tid * 16 + i * 8192, R, C); voffA[i] = (unsigned)(R * K + C) * 2u; }
  const size_t kstep = (size_t)(BK * 2);
  const size_t hstep = (size_t)HALF * K * 2;
  const size_t tstep = 2 * hstep;
  const size_t ksbytes = (size_t)kper * 2;
  const unsigned ldsw = (unsigned)wid * 1024u;
  const int aoff = lds_byte(wr * 64 + fr, fq * 8), boff = lds_byte(wc * 32 + fr, fq * 8);
#define PG8_SA(b, h) (((b) * 2 + (h)) * HTB)
#define PG8_SB(b, h) ((4 + (b) * 2 + (h)) * HTB)
#define PG8_STAGE(bufoff, gbase, voff) do { _Pragma("unroll") for (int _i = 0; _i < 2; ++_i) \
    __builtin_amdgcn_global_load_lds((const unsigned*)((const char*)(gbase) + (voff)[_i]), (PG8_LAS unsigned*)(lds + (bufoff) + ldsw + _i * 8192), 16, 0, 0); } while (0)
#define PG8_LDA(dst, b, h) do { _Pragma("unroll") for (int m = 0; m < 4; ++m) _Pragma("unroll") for (int k = 0; k < 2; ++k) dst[m][k] = *(const PG8_LAS bf16x8*)(lds + PG8_SA(b, h) + aoff + m * 2048 + k * 1024); } while (0)
#define PG8_LDB(dst, b, h) do { _Pragma("unroll") for (int n = 0; n < 2; ++n) _Pragma("unroll") for (int k = 0; k < 2; ++k) dst[n][k] = *(const PG8_LAS bf16x8*)(lds + PG8_SB(b, h) + boff + n * 2048 + k * 1024); } while (0)
#define PG8_MMA(ai, bj, At, Bt) do { __builtin_amdgcn_s_setprio(1); _Pragma("unroll") for (int m = 0; m < 4; ++m) _Pragma("unroll") for (int n = 0; n < 2; ++n) _Pragma("unroll") for (int k = 0; k < 2; ++k) \
    acc[ai][bj][m][n] = __builtin_amdgcn_mfma_f32_16x16x32_bf16(Bt[n][k], At[m][k], acc[ai][bj][m][n], 0, 0, 0); __builtin_amdgcn_s_setprio(0); } while (0)
#define PG8_WAIT_V(n) asm volatile("s_waitcnt vmcnt(" #n ")" ::: "memory")
#define PG8_WAIT_L(n) asm volatile("s_waitcnt lgkmcnt(" #n ")" ::: "memory")
#define PG8_BAR __builtin_amdgcn_s_barrier()
#define PG8_SCHED __builtin_amdgcn_sched_barrier(0)
  Unit cur, nxt; int ui = 0;
  if (!S.next(0, cur)) return;
  f32x4 acc[2][2][4][2];
#pragma unroll
  for (int a = 0; a < 2; ++a)
#pragma unroll
    for (int b = 0; b < 2; ++b)
#pragma unroll
      for (int m = 0; m < 4; ++m)
#pragma unroll
        for (int n = 0; n < 2; ++n) acc[a][b][m][n] = (f32x4){0.f, 0.f, 0.f, 0.f};
  bf16x8 At[4][2], B0[2][2], B1[2][2];
  const char* cA = (const char*)g.A + (size_t)cur.pm * tstep + (size_t)cur.ks * ksbytes; const char* cB = (const char*)g.Bt + (size_t)cur.pn * tstep + (size_t)cur.ks * ksbytes;
  PG8_STAGE(PG8_SB(0, 0), cB, voffA); PG8_STAGE(PG8_SA(0, 0), cA, voffA); PG8_STAGE(PG8_SB(0, 1), cB + hstep, voffA); PG8_STAGE(PG8_SA(0, 1), cA + hstep, voffA);
  if (wr == 1) PG8_BAR;
  PG8_WAIT_V(4); PG8_BAR;
  PG8_STAGE(PG8_SB(1, 0), cB + kstep, voffA); PG8_STAGE(PG8_SA(1, 0), cA + kstep, voffA); PG8_STAGE(PG8_SB(1, 1), cB + hstep + kstep, voffA);
  PG8_WAIT_V(6); PG8_BAR;
  for (;;) {
    const bool has_next = S.next(ui + 1, nxt);
    const char* nA = has_next ? (const char*)g.A + (size_t)nxt.pm * tstep + (size_t)nxt.ks * ksbytes : cA; const char* nB = has_next ? (const char*)g.Bt + (size_t)nxt.pn * tstep + (size_t)nxt.ks * ksbytes : cB;
    for (int t = 0; t < nt; t += 2) {
      const bool last = (t == nt - 2);
      const char* a1 = cA + (size_t)(t + 1) * kstep;
      const char* a2 = last ? nA : cA + (size_t)(t + 2) * kstep; const char* b2 = last ? nB : cB + (size_t)(t + 2) * kstep;
      const char* a3 = a2 + kstep; const char* b3 = b2 + kstep;
      PG8_LDB(B0, 0, 0); PG8_SCHED; PG8_LDA(At, 0, 0); PG8_STAGE(PG8_SA(1, 1), a1 + hstep, voffA);
      PG8_WAIT_L(8); PG8_BAR; PG8_WAIT_L(0); PG8_MMA(0, 0, At, B0); PG8_BAR; PG8_SCHED;
      PG8_LDB(B1, 0, 1); PG8_STAGE(PG8_SB(0, 0), b2, voffA);
      PG8_BAR; PG8_WAIT_L(0); PG8_MMA(0, 1, At, B1); PG8_BAR;
      PG8_LDA(At, 0, 1); PG8_STAGE(PG8_SA(0, 0), a2, voffA);
      PG8_BAR; PG8_WAIT_L(0); PG8_MMA(1, 0, At, B0); PG8_BAR; PG8_SCHED;
      PG8_STAGE(PG8_SB(0, 1), b2 + hstep, voffA);
      PG8_WAIT_V(6); PG8_BAR; PG8_MMA(1, 1, At, B1); PG8_BAR;
      PG8_LDB(B0, 1, 0); PG8_SCHED; PG8_LDA(At, 1, 0); PG8_STAGE(PG8_SA(0, 1), a2 + hstep, voffA);
      PG8_WAIT_L(8); PG8_BAR; PG8_WAIT_L(0); PG8_MMA(0, 0, At, B0); PG8_BAR; PG8_SCHED;
      PG8_LDB(B1, 1, 1); PG8_STAGE(PG8_SB(1, 0), b3, voffA);
      PG8_BAR; PG8_WAIT_L(0); PG8_MMA(0, 1, At, B1); PG8_BAR;
      PG8_LDA(At, 1, 1); PG8_STAGE(PG8_SA(1, 0), a3, voffA);
      PG8_BAR; PG8_WAIT_L(0); PG8_MMA(1, 0, At, B0); PG8_BAR; PG8_SCHED;
      PG8_STAGE(PG8_SB(1, 1), b3 + hstep, voffA);
      PG8_WAIT_V(6); PG8_BAR; PG8_MMA(1, 1, At, B1); PG8_BAR;
    }
    run_epi(E, acc, cur, wr, wc, fr, fq);
    if (!has_next) break;
#pragma unroll
    for (int a = 0; a < 2; ++a)
#pragma unroll
      for (int b = 0; b < 2; ++b)
#pragma unroll
        for (int m = 0; m < 4; ++m)
#pragma unroll
          for (int n = 0; n < 2; ++n) acc[a][b][m][n] = (f32x4){0.f, 0.f, 0.f, 0.f};
    cur = nxt; cA = nA; cB = nB; ++ui;
  }
  PG8_WAIT_V(0);
  if (wr == 0) PG8_BAR;
  PG8_BAR;
#undef PG8_SA
#undef PG8_SB
#undef PG8_STAGE
#undef PG8_LDA
#undef PG8_LDB
#undef PG8_MMA
#undef PG8_WAIT_V
#undef PG8_WAIT_L
#undef PG8_BAR
#undef PG8_SCHED
}
}
template <class Epi>
__device__ __forceinline__ void phase_gemm(const u16* A, const u16* Bt, int M, int N, int K, int ksplit, const Epi& E, float* lds) {
  __syncthreads();
  pg8::Gemm g{A, Bt, M, N, K, ksplit};
  pg8::Order S; S.init(M, N, ksplit, (int)gridDim.x, (int)blockIdx.x);
  pg8::gemm_phase(( __attribute__((address_space(3))) unsigned char*)lds, g, S, E);
  __syncthreads();
}

__device__ __forceinline__ void seq_of_token(int t, int& s0, int& L, int& sb) {
  if (t < NPROMPT_T) { s0 = t & ~255; L = 256; sb = -1; } else { sb = (t - NPROMPT_T) >> 10; s0 = NPROMPT_T + (sb << 10); L = 1024; }
}
__device__ __forceinline__ void ret_item_naive(const P& p, int item, float* lds) {
  const int tg = item >> 2, h = item & 3, t0 = tg * 16, tid = threadIdx.x;
  int s0, L, sb; seq_of_token(t0, s0, L, sb);
  float* scr = lds;
  float* qs = lds + 16 * 1024;
  float* red = qs + 16 * 128;
  const float lgf = log1pf(-exp2f(-p.l0_decay[h])), lgb = log1pf(-exp2f(-p.l0_decay[4 + h]));
  __syncthreads();
  for (int i = tid; i < 16 * 128; i += NTHR) qs[i] = bf2f(p.proj[(size_t)(t0 + (i >> 7)) * 4096 + h * 128 + (i & 127)]);
  __syncthreads();
  for (int j = tid; j < L; j += NTHR) {
    float acc[16] = {};
    const u16* kr = p.proj + (size_t)(s0 + j) * 4096 + 512 + h * 128;
    for (int d0 = 0; d0 < 128; d0 += 8) {
      const u32x4 kv = *(const u32x4*)(kr + d0);
      float kf[8];
#pragma unroll
      for (int e = 0; e < 4; ++e) { kf[2 * e] = __uint_as_float(kv[e] << 16); kf[2 * e + 1] = __uint_as_float(kv[e] & 0xffff0000u); }
#pragma unroll
      for (int i = 0; i < 16; ++i)
#pragma unroll
        for (int e = 0; e < 8; ++e) acc[i] += qs[i * 128 + d0 + e] * kf[e];
    }
#pragma unroll
    for (int i = 0; i < 16; ++i) {
      const int d = (t0 + i - s0) - j;
      const float w = d > 0 ? __expf((float)d * lgf) : (d < 0 ? __expf((float)(-d) * lgb) : 2.f);
      scr[i * 1024 + j] = acc[i] * w;
    }
  }
  __syncthreads();
  const int dv = tid & 255, ig = tid >> 8;
  float o[8] = {};
  for (int j = 0; j < L; ++j) {
    const float v = bf2f(p.proj[(size_t)(s0 + j) * 4096 + 1024 + h * 256 + dv]);
#pragma unroll
    for (int e = 0; e < 8; ++e) o[e] += scr[(ig * 8 + e) * 1024 + j] * v;
  }
  if (sb >= 0) {
    const float* Sf = p.state + ((size_t)(sb * 2 + 0) * 4 + h) * 128 * 256;
    const float* Sb = p.state + ((size_t)(sb * 2 + 1) * 4 + h) * 128 * 256;
    float af[8] = {}, ab[8] = {};
    for (int dk = 0; dk < 128; ++dk) {
      const float sf = Sf[dk * 256 + dv], sbv = Sb[dk * 256 + dv];
#pragma unroll
      for (int e = 0; e < 8; ++e) { const float q = qs[(ig * 8 + e) * 128 + dk]; af[e] += q * sf; ab[e] += q * sbv; }
    }
#pragma unroll
    for (int e = 0; e < 8; ++e) {
      const int pos = t0 + ig * 8 + e - s0;
      o[e] += __expf((float)(pos + 1) * lgf) * af[e] + __expf((float)(L - pos) * lgb) * ab[e];
    }
  }
  const int wid = tid >> 6, lane = tid & 63;
#pragma unroll
  for (int e = 0; e < 8; ++e) { const float s = wave_sum(o[e] * o[e]); if (lane == 0) red[wid * 8 + e] = s; }
  __syncthreads();
#pragma unroll
  for (int e = 0; e < 8; ++e) {
    const float ss = red[(ig * 4 + 0) * 8 + e] + red[(ig * 4 + 1) * 8 + e] + red[(ig * 4 + 2) * 8 + e] + red[(ig * 4 + 3) * 8 + e];
    const float r = rsqrtf(ss * (1.f / 256.f) + EPS);
    const int t = t0 + ig * 8 + e;
    const float g = bf2f(p.proj[(size_t)t * 4096 + 2048 + h * 256 + dv]);
    p.cat[(size_t)t * 1536 + h * 256 + dv] = f2bf(o[e] * r * g);
  }
}
__device__ __forceinline__ void state_item_naive(const P& p, int item) {
  const int b = item >> 3, h = (item >> 1) & 3, dir = item & 1, tid = threadIdx.x;
  const float lg = log1pf(-exp2f(-p.l0_decay[dir * 4 + h]));
  const int dv = tid & 255;
  float* o = p.out + (size_t)NT * DM + ((size_t)(b * 2 + dir) * 4 + h) * 128 * 256;
  for (int pass = 0; pass < 4; ++pass) {
    const int dk0 = (tid >> 8) * 64 + pass * 16;
    float acc[16] = {};
    for (int s = 0; s < 256; ++s) {
      const int t = b * 256 + s;
      const float w = dir == 0 ? __expf((float)(255 - s) * lg) : __expf((float)s * lg);
      const float v = bf2f(p.proj[(size_t)t * 4096 + 1024 + h * 256 + dv]) * w;
      const u16* kr = p.proj + (size_t)t * 4096 + 512 + h * 128 + dk0;
#pragma unroll
      for (int e = 0; e < 16; ++e) acc[e] += bf2f(kr[e]) * v;
    }
#pragma unroll
    for (int e = 0; e < 16; ++e) o[(dk0 + e) * 256 + dv] = acc[e];
  }
}
__device__ __forceinline__ void gmlp_item_naive(const P& p, int item, float* lds) {
  const int ci = item >> 2, g = item & 3, tid = threadIdx.x, wid = tid >> 6, lane = tid & 63;
  float* zn = lds;
  float* mu = lds + 128 * 128;
  float* rs = mu + 128;
  __syncthreads();
  for (int q = wid; q < 128; q += 8) {
    const u32x4 v = *(const u32x4*)(p.proj + (size_t)(ci * 128 + q) * 4096 + 3584 + lane * 8);
    float s = 0.f, s2 = 0.f;
#pragma unroll
    for (int e = 0; e < 4; ++e) { const float a = __uint_as_float(v[e] << 16), b = __uint_as_float(v[e] & 0xffff0000u); s += a + b; s2 += a * a + b * b; }
    s = wave_sum(s); s2 = wave_sum(s2);
    if (lane == 0) { const float m = s * (1.f / 512.f); const float var = fmaxf(s2 * (1.f / 512.f) - m * m, 0.f); mu[q] = m; rs[q] = rsqrtf(var + EPS); }
  }
  __syncthreads();
  for (int i = tid; i < 128 * 128; i += NTHR) {
    const int q = i >> 7, c = i & 127;
    zn[i] = (bf2f(p.proj[(size_t)(ci * 128 + q) * 4096 + 3584 + g * 128 + c]) - mu[q]) * rs[q];
  }
  __syncthreads();
  const int c = tid & 127, p0 = (tid >> 7) * 32;
  float acc[32] = {};
  const float* W = p.l0_gws + (size_t)g * 128 * 128;
  for (int q = 0; q < 128; ++q) {
    const float z = zn[q * 128 + c];
#pragma unroll
    for (int e = 0; e < 32; ++e) acc[e] += W[(p0 + e) * 128 + q] * z;
  }
#pragma unroll
  for (int e = 0; e < 32; ++e) {
    const int t = ci * 128 + p0 + e;
    const float u = bf2f(p.proj[(size_t)t * 4096 + 3072 + g * 128 + c]);
    p.cat[(size_t)t * 1536 + 1024 + g * 128 + c] = f2bf((acc[e] + p.l0_gb[g * 128 + p0 + e]) * u);
  }
}
__device__ __forceinline__ void phase_mixer_naive(const P& p, float* lds) {
  const int nR = 1536, nS = 128, nG = 192, total = nR + nS + nG;
  for (int it = blockIdx.x; it < total; it += gridDim.x) {
    if (it < nR) ret_item_naive(p, it, lds);
    else if (it < nR + nS) state_item_naive(p, it - nR);
    else gmlp_item_naive(p, it - nR - nS, lds);
  }
}

__device__ __forceinline__ void phase_conv(const P& p) {
  const u16* pj = p.proj;
  for (size_t i = (size_t)blockIdx.x * NTHR + threadIdx.x; i < (size_t)NT * 256; i += (size_t)gridDim.x * NTHR) {
    const int t = (int)(i >> 8), c4 = (int)(i & 255) * 4;
    const int seg = t < NPROMPT_T ? 256 : 64;
    const int pos = t < NPROMPT_T ? (t & 255) : ((t - NPROMPT_T) & 63);
    f32x4 xc[3];
#pragma unroll
    for (int d = 0; d < 3; ++d) {
      const int pp = pos + d - 1;
      if (pp < 0 || pp >= seg) { xc[d] = (f32x4){0.f, 0.f, 0.f, 0.f}; continue; }
      const u16* r = pj + (size_t)(t + d - 1) * 3072;
      const u32x2 a = *(const u32x2*)(r + 1024 + c4), b = *(const u32x2*)(r + 2048 + c4);
      xc[d][0] = __uint_as_float(a[0] << 16) * __uint_as_float(b[0] << 16);
      xc[d][1] = __uint_as_float(a[0] & 0xffff0000u) * __uint_as_float(b[0] & 0xffff0000u);
      xc[d][2] = __uint_as_float(a[1] << 16) * __uint_as_float(b[1] << 16);
      xc[d][3] = __uint_as_float(a[1] & 0xffff0000u) * __uint_as_float(b[1] & 0xffff0000u);
    }
    const f32x4 w0 = *(const f32x4*)(p.l1_conv + c4), w1 = *(const f32x4*)(p.l1_conv + 1024 + c4), w2 = *(const f32x4*)(p.l1_conv + 2048 + c4);
    const u32x2 bgv = *(const u32x2*)(pj + (size_t)t * 3072 + c4);
    f32x4 bg = {__uint_as_float(bgv[0] << 16), __uint_as_float(bgv[0] & 0xffff0000u), __uint_as_float(bgv[1] << 16), __uint_as_float(bgv[1] & 0xffff0000u)};
    const f32x4 y = bg * (w0 * xc[0] + w1 * xc[1] + w2 * xc[2]);
    u32x2 o; o[0] = pk2(y[0], y[1]); o[1] = pk2(y[2], y[3]);
    *(u32x2*)(p.cat + (size_t)t * 1024 + c4) = o;
  }
}

constexpr int NPHASE = 16;
__global__ void __launch_bounds__(NTHR) mega(P p, int lo, int hi) {
  extern __shared__ __attribute__((aligned(16))) unsigned char smem[];
  float* lds = (float*)smem;
  cg::grid_group grid = cg::this_grid();
  const float* m0 = p.mod; const float* m1 = p.mod + 3 * 6144;
#define PH(n, ...) if (lo <= (n) && (n) < hi) { if ((n) > lo) grid.sync(); __VA_ARGS__ }
  PH(0, phase_prep(p, lds);)
  PH(1, { NormArgs a{p.x_prompt, p.x_sample, nullptr, nullptr, nullptr, nullptr, p.l0_norm1, m0 + 0, m0 + 1024, p.hA, nullptr}; phase_norm(a); })
  PH(2, { EpiProj0 e{p.proj}; phase_gemm(p.hA, p.wt0_in, NT, 4096, 1024, 1, e, lds); })
  PH(3, phase_mixer_naive(p, lds);)
  PH(4, { EpiPart e{p.part}; phase_gemm(p.cat, p.wt0_out, NT, 1024, 1536, 2, e, lds); })
  PH(5, { NormArgs a{p.x_prompt, p.x_sample, p.part, p.part + (size_t)NT * DM, m0 + 2048, p.xres, p.l0_norm2, m0 + 3072, m0 + 4096, p.hA, nullptr}; phase_norm(a); })
  PH(6, { EpiRelu2 e{p.proj}; phase_gemm(p.hA, p.wt0_f1, NT, 4096, 1024, 1, e, lds); })
  PH(7, { EpiPart e{p.part}; phase_gemm(p.proj, p.wt0_f2, NT, 1024, 4096, 2, e, lds); })
  PH(8, { NormArgs a{p.xres, p.xres + (size_t)NPROMPT_T * DM, p.part, p.part + (size_t)NT * DM, m0 + 5120, p.xres, p.l1_norm1, m1 + 0, m1 + 1024, p.hA, nullptr}; phase_norm(a); })
  PH(9, { EpiPlain e{p.proj, 3072}; phase_gemm(p.hA, p.wt1_in, NT, 3072, 1024, 1, e, lds); })
  PH(10, phase_conv(p);)
  PH(11, { EpiPart e{p.part}; phase_gemm(p.cat, p.wt1_out, NT, 1024, 1024, 2, e, lds); })
  PH(12, { NormArgs a{p.xres, p.xres + (size_t)NPROMPT_T * DM, p.part, p.part + (size_t)NT * DM, m1 + 2048, p.xres, p.l1_norm2, m1 + 3072, m1 + 4096, p.hA, nullptr}; phase_norm(a); })
  PH(13, { EpiRelu2 e{p.proj}; phase_gemm(p.hA, p.wt1_f1, NT, 4096, 1024, 1, e, lds); })
  PH(14, { EpiPart e{p.part}; phase_gemm(p.proj, p.wt1_f2, NT, 1024, 4096, 2, e, lds); })
  PH(15, { NormArgs a{p.xres, p.xres + (size_t)NPROMPT_T * DM, p.part, p.part + (size_t)NT * DM, m1 + 5120, nullptr, p.final_norm, nullptr, nullptr, nullptr, p.out}; phase_norm(a); })
#undef PH
}

constexpr size_t LDS_BYTES = 131072;
constexpr bool ONE_LAUNCH = true;

extern "C" void kernel_launch(void* const* d_in, const int* in_sizes, int n_in, void* d_out, int out_size, void* d_ws, size_t ws_size, hipStream_t stream) {
  static int grid_blocks = 0;
  if (!grid_blocks) {
    hipFuncSetAttribute((const void*)mega, hipFuncAttributeMaxDynamicSharedMemorySize, (int)LDS_BYTES);
    int dev = 0, cus = 0, per_cu = 0;
    hipGetDevice(&dev);
    hipDeviceGetAttribute(&cus, hipDeviceAttributeMultiprocessorCount, dev);
    hipOccupancyMaxActiveBlocksPerMultiprocessor(&per_cu, mega, NTHR, LDS_BYTES);
    if (per_cu < 1) per_cu = 1;
    if (per_cu > 1) per_cu = 1;
    grid_blocks = cus * per_cu;
  }
  P p{};
  const float* const* in = (const float* const*)d_in;
  p.x_prompt = in[0]; p.x_sample = in[1]; p.state = in[2]; p.c = in[3]; p.c_ctx = in[4];
  p.l0_norm1 = in[5]; p.l0_w_in = in[6]; p.l0_decay = in[7]; p.l0_gws = in[8]; p.l0_gb = in[9]; p.l0_w_out = in[10]; p.l0_norm2 = in[11];
  p.l0_w_mod = in[12]; p.l0_b_mod = in[13]; p.l0_f1 = in[14]; p.l0_f2 = in[15];
  p.l1_norm1 = in[16]; p.l1_w_in = in[17]; p.l1_conv = in[18]; p.l1_w_out = in[19]; p.l1_norm2 = in[20]; p.l1_w_mod = in[21]; p.l1_b_mod = in[22];
  p.l1_f1 = in[23]; p.l1_f2 = in[24]; p.final_norm = in[25];
  p.out = (float*)d_out;
  unsigned char* w = (unsigned char*)d_ws; size_t off = 0;
  auto take = [&](size_t bytes) { void* r = w + off; off += (bytes + 255) & ~(size_t)255; return r; };
  p.wt0_in = (u16*)take((size_t)4096 * 1024 * 2); p.wt0_out = (u16*)take((size_t)1024 * 1536 * 2);
  p.wt0_f1 = (u16*)take((size_t)4096 * 1024 * 2); p.wt0_f2 = (u16*)take((size_t)4096 * 1024 * 2);
  p.wt1_in = (u16*)take((size_t)3072 * 1024 * 2); p.wt1_out = (u16*)take((size_t)1024 * 1024 * 2);
  p.wt1_f1 = (u16*)take((size_t)4096 * 1024 * 2); p.wt1_f2 = (u16*)take((size_t)4096 * 1024 * 2);
  p.mod = (float*)take((size_t)2 * 3 * 6144 * 4);
  p.hA = (u16*)take((size_t)NT * 1024 * 2);
  p.proj = (u16*)take((size_t)NT * 4096 * 2);
  p.cat = (u16*)take((size_t)NT * 1536 * 2);
  p.part = (float*)take((size_t)2 * NT * 1024 * 4);
  p.xres = (float*)take((size_t)NT * 1024 * 4);
  if (ONE_LAUNCH) {
    int lo = 0, hi = NPHASE; void* args[] = {&p, &lo, &hi};
    hipError_t e = hipLaunchCooperativeKernel((void*)mega, dim3(grid_blocks), dim3(NTHR), args, LDS_BYTES, stream);
    if (e != hipSuccess) fprintf(stderr, "cooperative launch failed: %s (grid %d)\n", hipGetErrorString(e), grid_blocks);
  } else {
    for (int ph = 0; ph < NPHASE; ++ph) hipLaunchKernelGGL(mega, dim3(grid_blocks), dim3(NTHR), LDS_BYTES, stream, p, ph, ph + 1);
  }
}
```

```cpp
#include <hip/hip_runtime.h>
#include <hip/hip_cooperative_groups.h>
#include <cstdio>
namespace cg = cooperative_groups;

typedef unsigned short u16;
typedef float f32x4 __attribute__((ext_vector_type(4)));
typedef unsigned u32x4 __attribute__((ext_vector_type(4)));
typedef unsigned u32x2 __attribute__((ext_vector_type(2)));

constexpr int NT = 6144, DM = 1024, NPROMPT_T = 4096;
constexpr float EPS = 1e-6f;
constexpr int NTHR = 512;

__device__ __forceinline__ float bf2f(u16 b) { return __uint_as_float(((unsigned)b) << 16); }
__device__ __forceinline__ u16 f2bf(float f) { unsigned u = __float_as_uint(f); u += 0x7FFFu + ((u >> 16) & 1u); return (u16)(u >> 16); }
__device__ __forceinline__ unsigned pk2(float a, float b) { return (unsigned)f2bf(a) | ((unsigned)f2bf(b) << 16); }
__device__ __forceinline__ float silu_f(float x) { return x / (1.f + __expf(-x)); }
__device__ __forceinline__ float gelu_f(float x) { float u = 0.7978845608028654f * (x + 0.044715f * x * x * x); return 0.5f * x * (1.f + tanhf(u)); }
__device__ __forceinline__ int cond_of(int t) { return t < NPROMPT_T ? 0 : 1 + ((t - NPROMPT_T) >> 10); }
__device__ __forceinline__ float wave_sum(float v) {
#pragma unroll
  for (int o = 32; o > 0; o >>= 1) v += __shfl_xor(v, o);
  return v;
}

struct P {
  const float *x_prompt, *x_sample, *state, *c, *c_ctx;
  const float *l0_norm1, *l0_w_in, *l0_decay, *l0_gws, *l0_gb, *l0_w_out, *l0_norm2, *l0_w_mod, *l0_b_mod, *l0_f1, *l0_f2;
  const float *l1_norm1, *l1_w_in, *l1_conv, *l1_w_out, *l1_norm2, *l1_w_mod, *l1_b_mod, *l1_f1, *l1_f2, *final_norm;
  float* out;
  u16 *wt0_in, *wt0_out, *wt0_f1, *wt0_f2, *wt1_in, *wt1_out, *wt1_f1, *wt1_f2;
  float* mod;
  u16* hA;
  u16* proj;
  u16* cat;
  float* part;
  float* xres;
};

__device__ __forceinline__ void transpose_tile(const float* __restrict__ W, int K, int N, u16* __restrict__ Wt, int tile, float* lds) {
  const int tn = N / 64; const int k0 = (tile / tn) * 64, n0 = (tile % tn) * 64;
  const int tid = threadIdx.x;
  float (*T)[65] = (float (*)[65])lds;
  __syncthreads();
  {
    const int r = tid >> 4, c4 = (tid & 15) * 4;
#pragma unroll
    for (int i = 0; i < 2; ++i) {
      const f32x4 v = *(const f32x4*)(W + (size_t)(k0 + r + 32 * i) * N + n0 + c4);
      T[r + 32 * i][c4 + 0] = v[0]; T[r + 32 * i][c4 + 1] = v[1]; T[r + 32 * i][c4 + 2] = v[2]; T[r + 32 * i][c4 + 3] = v[3];
    }
  }
  __syncthreads();
  {
    const int nn = tid >> 3, kk = (tid & 7) * 8;
    u32x4 o;
    o[0] = pk2(T[kk + 0][nn], T[kk + 1][nn]); o[1] = pk2(T[kk + 2][nn], T[kk + 3][nn]);
    o[2] = pk2(T[kk + 4][nn], T[kk + 5][nn]); o[3] = pk2(T[kk + 6][nn], T[kk + 7][nn]);
    *(u32x4*)(Wt + (size_t)(n0 + nn) * K + k0 + kk) = o;
  }
}

__device__ __forceinline__ void adaln_item(const P& p, int item, float* lds) {
  const int l = item / 96, n0 = (item % 96) * 64;
  const float* W = l ? p.l1_w_mod : p.l0_w_mod; const float* B = l ? p.l1_b_mod : p.l0_b_mod;
  const int tid = threadIdx.x;
  float* sc = lds;
  float* red = lds + 3072;
  __syncthreads();
  for (int i = tid; i < 3072; i += NTHR) {
    const int c = i >> 10, k = i & 1023;
    const float v = c == 0 ? p.c_ctx[k] : p.c[(c - 1) * 1024 + k];
    sc[i] = silu_f(v);
  }
  __syncthreads();
  const int cg4 = tid & 15, rg = tid >> 4;
  float acc[3][4] = {};
  for (int it = 0; it < 32; ++it) {
    const int k = it * 32 + rg;
    const f32x4 w = *(const f32x4*)(W + (size_t)k * 6144 + n0 + cg4 * 4);
#pragma unroll
    for (int c = 0; c < 3; ++c) { const float s = sc[c * 1024 + k];
#pragma unroll
      for (int e = 0; e < 4; ++e) acc[c][e] += s * w[e]; }
  }
#pragma unroll
  for (int c = 0; c < 3; ++c)
#pragma unroll
    for (int e = 0; e < 4; ++e) red[(rg * 3 + c) * 64 + cg4 * 4 + e] = acc[c][e];
  __syncthreads();
  if (tid < 192) {
    const int c = tid >> 6, n = tid & 63; float s = B[n0 + n];
    for (int r = 0; r < 32; ++r) s += red[(r * 3 + c) * 64 + n];
    p.mod[(size_t)(l * 3 + c) * 6144 + n0 + n] = s;
  }
}

__device__ __forceinline__ void phase_prep(const P& p, float* lds) {
  const int nA = 192;
  const int t0 = 1024, t1 = 384, t2 = 1024, t3 = 1024, t4 = 768, t5 = 256, t6 = 1024, t7 = 1024;
  const int total = nA + t0 + t1 + t2 + t3 + t4 + t5 + t6 + t7;
  for (int it = blockIdx.x; it < total; it += gridDim.x) {
    int i = it;
    if (i < nA) { adaln_item(p, i, lds); continue; }
    i -= nA;
    if (i < t0) { transpose_tile(p.l0_w_in, 1024, 4096, p.wt0_in, i, lds); continue; } i -= t0;
    if (i < t1) { transpose_tile(p.l0_w_out, 1536, 1024, p.wt0_out, i, lds); continue; } i -= t1;
    if (i < t2) { transpose_tile(p.l0_f1, 1024, 4096, p.wt0_f1, i, lds); continue; } i -= t2;
    if (i < t3) { transpose_tile(p.l0_f2, 4096, 1024, p.wt0_f2, i, lds); continue; } i -= t3;
    if (i < t4) { transpose_tile(p.l1_w_in, 1024, 3072, p.wt1_in, i, lds); continue; } i -= t4;
    if (i < t5) { transpose_tile(p.l1_w_out, 1024, 1024, p.wt1_out, i, lds); continue; } i -= t5;
    if (i < t6) { transpose_tile(p.l1_f1, 1024, 4096, p.wt1_f1, i, lds); continue; } i -= t6;
    transpose_tile(p.l1_f2, 4096, 1024, p.wt1_f2, i, lds);
  }
}

struct NormArgs {
  const float* xin0; const float* xin1;
  const float* p0; const float* p1; const float* gate;
  float* xout; const float* nw; const float* sh; const float* sc;
  u16* hout; float* fout;
};
__device__ __forceinline__ void phase_norm(const NormArgs& a) {
  const int wid = threadIdx.x >> 6, lane = threadIdx.x & 63;
  for (int t = blockIdx.x * 8 + wid; t < NT; t += gridDim.x * 8) {
    const int c = cond_of(t);
    const float* xr = t < NPROMPT_T ? a.xin0 + (size_t)t * DM : a.xin1 + (size_t)(t - NPROMPT_T) * DM;
    f32x4 x[4]; float ss = 0.f;
#pragma unroll
    for (int i = 0; i < 4; ++i) {
      const int col = lane * 4 + 256 * i;
      x[i] = *(const f32x4*)(xr + col);
      if (a.p0) {
        const f32x4 q0 = *(const f32x4*)(a.p0 + (size_t)t * DM + col), q1 = *(const f32x4*)(a.p1 + (size_t)t * DM + col);
        const f32x4 g = *(const f32x4*)(a.gate + (size_t)c * 6144 + col);
        x[i] = x[i] + g * (q0 + q1);
      }
      if (a.xout) *(f32x4*)(a.xout + (size_t)t * DM + col) = x[i];
      ss += x[i][0] * x[i][0] + x[i][1] * x[i][1] + x[i][2] * x[i][2] + x[i][3] * x[i][3];
    }
    ss = wave_sum(ss);
    const float r = rsqrtf(ss * (1.f / 1024.f) + EPS);
#pragma unroll
    for (int i = 0; i < 4; ++i) {
      const int col = lane * 4 + 256 * i;
      const f32x4 w = *(const f32x4*)(a.nw + col);
      f32x4 y = x[i] * r * w;
      if (a.fout) *(f32x4*)(a.fout + (size_t)t * DM + col) = y;
      if (a.hout) {
        const f32x4 sh = *(const f32x4*)(a.sh + (size_t)c * 6144 + col), sc = *(const f32x4*)(a.sc + (size_t)c * 6144 + col);
        y = y * (1.f + sc) + sh;
        u32x2 o; o[0] = pk2(y[0], y[1]); o[1] = pk2(y[2], y[3]);
        *(u32x2*)(a.hout + (size_t)t * DM + col) = o;
      }
    }
  }
}

struct EpiProj0 {
  u16* O;
  __device__ __forceinline__ void store4(int row, int col, f32x4 v, int) const {
    if (col >= 3072) { v[0] = gelu_f(v[0]); v[1] = gelu_f(v[1]); v[2] = gelu_f(v[2]); v[3] = gelu_f(v[3]); }
    else if (col >= 2048) { v[0] = silu_f(v[0]); v[1] = silu_f(v[1]); v[2] = silu_f(v[2]); v[3] = silu_f(v[3]); }
    else if (col >= 512 && col < 1024) v = v * 0.08838834764831845f;
    u32x2 o; o[0] = pk2(v[0], v[1]); o[1] = pk2(v[2], v[3]);
    *(u32x2*)(O + (size_t)row * 4096 + col) = o;
  }
};
struct EpiPart {
  float* Pp;
  __device__ __forceinline__ void store4(int row, int col, f32x4 v, int ks) const { *(f32x4*)(Pp + ((size_t)ks * NT + row) * DM + col) = v; }
};
struct EpiRelu2 {
  u16* O;
  __device__ __forceinline__ void store4(int row, int col, f32x4 v, int) const {
#pragma unroll
    for (int e = 0; e < 4; ++e) { const float r = fmaxf(v[e], 0.f); v[e] = r * r; }
    u32x2 o; o[0] = pk2(v[0], v[1]); o[1] = pk2(v[2], v[3]);
    *(u32x2*)(O + (size_t)row * 4096 + col) = o;
  }
};
struct EpiPlain {
  u16* O; int ld;
  __device__ __forceinline__ void store4(int row, int col, f32x4 v, int) const {
    u32x2 o; o[0] = pk2(v[0], v[1]); o[1] = pk2(v[2], v[3]);
    *(u32x2*)(O + (size_t)row * ld + col) = o;
  }
};

template <class Epi>
__device__ __forceinline__ void phase_gemm_naive(const u16* __restrict__ A, const u16* __restrict__ Bt, int M, int N, int K, int ksplit, const Epi& E, float* lds) {
  float (*As)[33] = (float (*)[33])lds;
  float (*Bs)[33] = (float (*)[33])(lds + 128 * 33);
  const int tm = M / 128, tn = N / 64, total = tm * tn * ksplit, kper = K / ksplit;
  const int tid = threadIdx.x, r = tid >> 2, cq = tid & 3;
  for (int it = blockIdx.x; it < total; it += gridDim.x) {
    const int ks = it / (tm * tn), rem = it % (tm * tn), m0 = (rem / tn) * 128, n0 = (rem % tn) * 64;
    float acc[4][4] = {};
    for (int k0 = ks * kper; k0 < (ks + 1) * kper; k0 += 32) {
      __syncthreads();
      {
        const int kc = (tid & 3) * 8;
        const u32x4 va = *(const u32x4*)(A + (size_t)(m0 + r) * K + k0 + kc);
#pragma unroll
        for (int e = 0; e < 4; ++e) { As[r][kc + 2 * e] = __uint_as_float(va[e] << 16); As[r][kc + 2 * e + 1] = __uint_as_float(va[e] & 0xffff0000u); }
        if (tid < 256) {
          const u32x4 vb = *(const u32x4*)(Bt + (size_t)(n0 + r) * K + k0 + kc);
#pragma unroll
          for (int e = 0; e < 4; ++e) { Bs[r][kc + 2 * e] = __uint_as_float(vb[e] << 16); Bs[r][kc + 2 * e + 1] = __uint_as_float(vb[e] & 0xffff0000u); }
        }
      }
      __syncthreads();
#pragma unroll 4
      for (int k = 0; k < 32; ++k) {
        const float a = As[r][k];
#pragma unroll
        for (int jj = 0; jj < 4; ++jj)
#pragma unroll
          for (int e = 0; e < 4; ++e) acc[jj][e] += a * Bs[cq * 4 + 16 * jj + e][k];
      }
    }
#pragma unroll
    for (int jj = 0; jj < 4; ++jj) { f32x4 v = {acc[jj][0], acc[jj][1], acc[jj][2], acc[jj][3]}; E.store4(m0 + r, n0 + cq * 4 + 16 * jj, v, ks); }
  }
}


namespace pg8 {
#define PG8_LAS __attribute__((address_space(3)))
typedef short bf16x8 __attribute__((ext_vector_type(8)));
constexpr int BM = 256, BK = 64, HALF = 128, HTB = HALF * BK * 2, STAGE_BYTES = 8 * HTB, NXCD = 8, WGM = 8;
__device__ __forceinline__ int lds_byte(int r, int c) { const int st = (r >> 4) * 2 + (c >> 5), rr = r & 15, cc = c & 31, ob = rr * 64 + cc * 2; return st * 1024 + (ob ^ (((ob >> 9) & 1) << 5)); }
__device__ __forceinline__ void stage_rc(int b, int& R, int& C) { const int st = b / 1024, sb = b % 1024, swz = sb ^ (((sb >> 9) & 1) << 5); R = (st >> 1) * 16 + swz / 64; C = (st & 1) * 32 + (swz % 64) / 2; }
struct Unit { int pm, pn, ks; };
struct Gemm { const u16* A; const u16* Bt; int M, N, K, ksplit; };
struct Order {
  int nM, nN, ntile, nwg, G, c;
  __device__ void init(int M, int N, int ksplit, int G_, int c_) { nM = M / BM; nN = N / BM; ntile = nM * nN; nwg = ntile * ksplit; G = G_; c = c_; }
  __device__ bool next(int i, Unit& u) const {
    const int L = i * G + c; if (L >= nwg) return false;
    u.ks = L / ntile; int wgid = L % ntile;
    { const int q = ntile / NXCD, r = ntile % NXCD, xcd = wgid % NXCD, off = wgid / NXCD; wgid = (xcd < r ? xcd * (q + 1) : r * (q + 1) + (xcd - r) * q) + off; }
    const int nig = WGM * nN, gid = wgid / nig, fm = gid * WGM, gsz = (nM - fm) < WGM ? (nM - fm) : WGM;
    u.pm = fm + ((wgid % nig) % gsz); u.pn = (wgid % nig) / gsz; return true;
  }
};
template <class Epi>
__device__ __forceinline__ void run_epi(const Epi& E, const f32x4 (&acc)[2][2][4][2], const Unit& u, int wr, int wc, int fr, int fq) {
  const int row0 = u.pm * BM + wr * 64 + fr, col0 = u.pn * BM + wc * 32 + 4 * fq;
#pragma unroll
  for (int ai = 0; ai < 2; ++ai)
#pragma unroll
    for (int m = 0; m < 4; ++m)
#pragma unroll
      for (int bj = 0; bj < 2; ++bj)
#pragma unroll
        for (int n = 0; n < 2; ++n) E.store4(row0 + ai * HALF + m * 16, col0 + bj * HALF + n * 16, acc[ai][bj][m][n], u.ks);
}
template <class Epi>
__device__ __forceinline__ void gemm_phase(PG8_LAS unsigned char* lds, const Gemm g, const Order& S, const Epi& E) {
  const int tid = threadIdx.x, wid = __builtin_amdgcn_readfirstlane(tid >> 6), lane = tid & 63, wr = wid >> 2, wc = wid & 3, fr = lane & 15, fq = lane >> 4;
  const int K = g.K, kper = g.K / g.ksplit, nt = kper / BK;
  unsigned voffA[2];
#pragma unroll
  for (int i = 0; i < 2; ++i) { int R, C; stage_rc(tid * 16 + i * 8192, R, C); voffA[i] = (unsigned)(R * K + C) * 2u; }
  const size_t kstep = (size_t)(BK * 2);
  const size_t hstep = (size_t)HALF * K * 2;
  const size_t tstep = 2 * hstep;
  const size_t ksbytes = (size_t)kper * 2;
  const unsigned ldsw = (unsigned)wid * 1024u;
  const int aoff = lds_byte(wr * 64 + fr, fq * 8), boff = lds_byte(wc * 32 + fr, fq * 8);
#define PG8_SA(b, h) (((b) * 2 + (h)) * HTB)
#define PG8_SB(b, h) ((4 + (b) * 2 + (h)) * HTB)
#define PG8_STAGE(bufoff, gbase, voff) do { _Pragma("unroll") for (int _i = 0; _i < 2; ++_i) \
    __builtin_amdgcn_global_load_lds((const unsigned*)((const char*)(gbase) + (voff)[_i]), (PG8_LAS unsigned*)(lds + (bufoff) + ldsw + _i * 8192), 16, 0, 0); } while (0)
#define PG8_LDA(dst, b, h) do { _Pragma("unroll") for (int m = 0; m < 4; ++m) _Pragma("unroll") for (int k = 0; k < 2; ++k) dst[m][k] = *(const PG8_LAS bf16x8*)(lds + PG8_SA(b, h) + aoff + m * 2048 + k * 1024); } while (0)
#define PG8_LDB(dst, b, h) do { _Pragma("unroll") for (int n = 0; n < 2; ++n) _Pragma("unroll") for (int k = 0; k < 2; ++k) dst[n][k] = *(const PG8_LAS bf16x8*)(lds + PG8_SB(b, h) + boff + n * 2048 + k * 1024); } while (0)
#define PG8_MMA(ai, bj, At, Bt) do { __builtin_amdgcn_s_setprio(1); _Pragma("unroll") for (int m = 0; m < 4; ++m) _Pragma("unroll") for (int n = 0; n < 2; ++n) _Pragma("unroll") for (int k = 0; k < 2; ++k) \
    acc[ai][bj][m][n] = __builtin_amdgcn_mfma_f32_16x16x32_bf16(Bt[n][k], At[m][k], acc[ai][bj][m][n], 0, 0, 0); __builtin_amdgcn_s_setprio(0); } while (0)
#define PG8_WAIT_V(n) asm volatile("s_waitcnt vmcnt(" #n ")" ::: "memory")
#define PG8_WAIT_L(n) asm volatile("s_waitcnt lgkmcnt(" #n ")" ::: "memory")
#define PG8_BAR __builtin_amdgcn_s_barrier()
#define PG8_SCHED __builtin_amdgcn_sched_barrier(0)
  Unit cur, nxt; int ui = 0;
  if (!S.next(0, cur)) return;
  f32x4 acc[2][2][4][2];
#pragma unroll
  for (int a = 0; a < 2; ++a)
#pragma unroll
    for (int b = 0; b < 2; ++b)
#pragma unroll
      for (int m = 0; m < 4; ++m)
#pragma unroll
        for (int n = 0; n < 2; ++n) acc[a][b][m][n] = (f32x4){0.f, 0.f, 0.f, 0.f};
  bf16x8 At[4][2], B0[2][2], B1[2][2];
  const char* cA = (const char*)g.A + (size_t)cur.pm * tstep + (size_t)cur.ks * ksbytes; const char* cB = (const char*)g.Bt + (size_t)cur.pn * tstep + (size_t)cur.ks * ksbytes;
  PG8_STAGE(PG8_SB(0, 0), cB, voffA); PG8_STAGE(PG8_SA(0, 0), cA, voffA); PG8_STAGE(PG8_SB(0, 1), cB + hstep, voffA); PG8_STAGE(PG8_SA(0, 1), cA + hstep, voffA);
  if (wr == 1) PG8_BAR;
  PG8_WAIT_V(4); PG8_BAR;
  PG8_STAGE(PG8_SB(1, 0), cB + kstep, voffA); PG8_STAGE(PG8_SA(1, 0), cA + kstep, voffA); PG8_STAGE(PG8_SB(1, 1), cB + hstep + kstep, voffA);
  PG8_WAIT_V(6); PG8_BAR;
  for (;;) {
    const bool has_next = S.next(ui + 1, nxt);
    const char* nA = has_next ? (const char*)g.A + (size_t)nxt.pm * tstep + (size_t)nxt.ks * ksbytes : cA; const char* nB = has_next ? (const char*)g.Bt + (size_t)nxt.pn * tstep + (size_t)nxt.ks * ksbytes : cB;
    for (int t = 0; t < nt; t += 2) {
      const bool last = (t == nt - 2);
      const char* a1 = cA + (size_t)(t + 1) * kstep;
      const char* a2 = last ? nA : cA + (size_t)(t + 2) * kstep; const char* b2 = last ? nB : cB + (size_t)(t + 2) * kstep;
      const char* a3 = a2 + kstep; const char* b3 = b2 + kstep;
      PG8_LDB(B0, 0, 0); PG8_SCHED; PG8_LDA(At, 0, 0); PG8_STAGE(PG8_SA(1, 1), a1 + hstep, voffA);
      PG8_WAIT_L(8); PG8_BAR; PG8_WAIT_L(0); PG8_MMA(0, 0, At, B0); PG8_BAR; PG8_SCHED;
      PG8_LDB(B1, 0, 1); PG8_STAGE(PG8_SB(0, 0), b2, voffA);
      PG8_BAR; PG8_WAIT_L(0); PG8_MMA(0, 1, At, B1); PG8_BAR;
      PG8_LDA(At, 0, 1); PG8_STAGE(PG8_SA(0, 0), a2, voffA);
      PG8_BAR; PG8_WAIT_L(0); PG8_MMA(1, 0, At, B0); PG8_BAR; PG8_SCHED;
      PG8_STAGE(PG8_SB(0, 1), b2 + hstep, voffA);
      PG8_WAIT_V(6); PG8_BAR; PG8_MMA(1, 1, At, B1); PG8_BAR;
      PG8_LDB(B0, 1, 0); PG8_SCHED; PG8_LDA(At, 1, 0); PG8_STAGE(PG8_SA(0, 1), a2 + hstep, voffA);
      PG8_WAIT_L(8); PG8_BAR; PG8_WAIT_L(0); PG8_MMA(0, 0, At, B0); PG8_BAR; PG8_SCHED;
      PG8_LDB(B1, 1, 1); PG8_STAGE(PG8_SB(1, 0), b3, voffA);
      PG8_BAR; PG8_WAIT_L(0); PG8_MMA(0, 1, At, B1); PG8_BAR;
      PG8_LDA(At, 1, 1); PG8_STAGE(PG8_SA(1, 0), a3, voffA);
      PG8_BAR; PG8_WAIT_L(0); PG8_MMA(1, 0, At, B0); PG8_BAR; PG8_SCHED;
      PG8_STAGE(PG8_SB(1, 1), b3 + hstep, voffA);
      PG8_WAIT_V(6); PG8_BAR; PG8_MMA(1, 1, At, B1); PG8_BAR;
    }
    run_epi(E, acc, cur, wr, wc, fr, fq);
    if (!has_next) break;
#pragma unroll
    for (int a = 0; a < 2; ++a)
#pragma unroll
      for (int b = 0; b < 2; ++b)
#pragma unroll
        for (int m = 0; m < 4; ++m)
#pragma unroll
          for (int n = 0; n < 2; ++n) acc[a][b][m][n] = (f32x4){0.f, 0.f, 0.f, 0.f};
    cur = nxt; cA = nA; cB = nB; ++ui;
  }
  PG8_WAIT_V(0);
  if (wr == 0) PG8_BAR;
  PG8_BAR;
#undef PG8_SA
#undef PG8_SB
#undef PG8_STAGE
#undef PG8_LDA
#undef PG8_LDB
#undef PG8_MMA
#undef PG8_WAIT_V
#undef PG8_WAIT_L
#undef PG8_BAR
#undef PG8_SCHED
}
}
template <class Epi>
__device__ __forceinline__ void phase_gemm(const u16* A, const u16* Bt, int M, int N, int K, int ksplit, const Epi& E, float* lds) {
  __syncthreads();
  pg8::Gemm g{A, Bt, M, N, K, ksplit};
  pg8::Order S; S.init(M, N, ksplit, (int)gridDim.x, (int)blockIdx.x);
  pg8::gemm_phase(( __attribute__((address_space(3))) unsigned char*)lds, g, S, E);
  __syncthreads();
}

__device__ __forceinline__ void seq_of_token(int t, int& s0, int& L, int& sb) {
  if (t < NPROMPT_T) { s0 = t & ~255; L = 256; sb = -1; } else { sb = (t - NPROMPT_T) >> 10; s0 = NPROMPT_T + (sb << 10); L = 1024; }
}
__device__ __forceinline__ void ret_item_naive(const P& p, int item, float* lds) {
  const int tg = item >> 2, h = item & 3, t0 = tg * 16, tid = threadIdx.x;
  int s0, L, sb; seq_of_token(t0, s0, L, sb);
  float* scr = lds;
  float* qs = lds + 16 * 1024;
  float* red = qs + 16 * 128;
  const float lgf = log1pf(-exp2f(-p.l0_decay[h])), lgb = log1pf(-exp2f(-p.l0_decay[4 + h]));
  __syncthreads();
  for (int i = tid; i < 16 * 128; i += NTHR) qs[i] = bf2f(p.proj[(size_t)(t0 + (i >> 7)) * 4096 + h * 128 + (i & 127)]);
  __syncthreads();
  for (int j = tid; j < L; j += NTHR) {
    float acc[16] = {};
    const u16* kr = p.proj + (size_t)(s0 + j) * 4096 + 512 + h * 128;
    for (int d0 = 0; d0 < 128; d0 += 8) {
      const u32x4 kv = *(const u32x4*)(kr + d0);
      float kf[8];
#pragma unroll
      for (int e = 0; e < 4; ++e) { kf[2 * e] = __uint_as_float(kv[e] << 16); kf[2 * e + 1] = __uint_as_float(kv[e] & 0xffff0000u); }
#pragma unroll
      for (int i = 0; i < 16; ++i)
#pragma unroll
        for (int e = 0; e < 8; ++e) acc[i] += qs[i * 128 + d0 + e] * kf[e];
    }
#pragma unroll
    for (int i = 0; i < 16; ++i) {
      const int d = (t0 + i - s0) - j;
      const float w = d > 0 ? __expf((float)d * lgf) : (d < 0 ? __expf((float)(-d) * lgb) : 2.f);
      scr[i * 1024 + j] = acc[i] * w;
    }
  }
  __syncthreads();
  const int dv = tid & 255, ig = tid >> 8;
  float o[8] = {};
  for (int j = 0; j < L; ++j) {
    const float v = bf2f(p.proj[(size_t)(s0 + j) * 4096 + 1024 + h * 256 + dv]);
#pragma unroll
    for (int e = 0; e < 8; ++e) o[e] += scr[(ig * 8 + e) * 1024 + j] * v;
  }
  if (sb >= 0) {
    const float* Sf = p.state + ((size_t)(sb * 2 + 0) * 4 + h) * 128 * 256;
    const float* Sb = p.state + ((size_t)(sb * 2 + 1) * 4 + h) * 128 * 256;
    float af[8] = {}, ab[8] = {};
    for (int dk = 0; dk < 128; ++dk) {
      const float sf = Sf[dk * 256 + dv], sbv = Sb[dk * 256 + dv];
#pragma unroll
      for (int e = 0; e < 8; ++e) { const float q = qs[(ig * 8 + e) * 128 + dk]; af[e] += q * sf; ab[e] += q * sbv; }
    }
#pragma unroll
    for (int e = 0; e < 8; ++e) {
      const int pos = t0 + ig * 8 + e - s0;
      o[e] += __expf((float)(pos + 1) * lgf) * af[e] + __expf((float)(L - pos) * lgb) * ab[e];
    }
  }
  const int wid = tid >> 6, lane = tid & 63;
#pragma unroll
  for (int e = 0; e < 8; ++e) { const float s = wave_sum(o[e] * o[e]); if (lane == 0) red[wid * 8 + e] = s; }
  __syncthreads();
#pragma unroll
  for (int e = 0; e < 8; ++e) {
    const float ss = red[(ig * 4 + 0) * 8 + e] + red[(ig * 4 + 1) * 8 + e] + red[(ig * 4 + 2) * 8 + e] + red[(ig * 4 + 3) * 8 + e];
    const float r = rsqrtf(ss * (1.f / 256.f) + EPS);
    const int t = t0 + ig * 8 + e;
    const float g = bf2f(p.proj[(size_t)t * 4096 + 2048 + h * 256 + dv]);
    p.cat[(size_t)t * 1536 + h * 256 + dv] = f2bf(o[e] * r * g);
  }
}
__device__ __forceinline__ void state_item_naive(const P& p, int item) {
  const int b = item >> 3, h = (item >> 1) & 3, dir = item & 1, tid = threadIdx.x;
  const float lg = log1pf(-exp2f(-p.l0_decay[dir * 4 + h]));
  const int dv = tid & 255;
  float* o = p.out + (size_t)NT * DM + ((size_t)(b * 2 + dir) * 4 + h) * 128 * 256;
  for (int pass = 0; pass < 4; ++pass) {
    const int dk0 = (tid >> 8) * 64 + pass * 16;
    float acc[16] = {};
    for (int s = 0; s < 256; ++s) {
      const int t = b * 256 + s;
      const float w = dir == 0 ? __expf((float)(255 - s) * lg) : __expf((float)s * lg);
      const float v = bf2f(p.proj[(size_t)t * 4096 + 1024 + h * 256 + dv]) * w;
      const u16* kr = p.proj + (size_t)t * 4096 + 512 + h * 128 + dk0;
#pragma unroll
      for (int e = 0; e < 16; ++e) acc[e] += bf2f(kr[e]) * v;
    }
#pragma unroll
    for (int e = 0; e < 16; ++e) o[(dk0 + e) * 256 + dv] = acc[e];
  }
}
__device__ __forceinline__ void gmlp_item_naive(const P& p, int item, float* lds) {
  const int ci = item >> 2, g = item & 3, tid = threadIdx.x, wid = tid >> 6, lane = tid & 63;
  float* zn = lds;
  float* mu = lds + 128 * 128;
  float* rs = mu + 128;
  __syncthreads();
  for (int q = wid; q < 128; q += 8) {
    const u32x4 v = *(const u32x4*)(p.proj + (size_t)(ci * 128 + q) * 4096 + 3584 + lane * 8);
    float s = 0.f, s2 = 0.f;
#pragma unroll
    for (int e = 0; e < 4; ++e) { const float a = __uint_as_float(v[e] << 16), b = __uint_as_float(v[e] & 0xffff0000u); s += a + b; s2 += a * a + b * b; }
    s = wave_sum(s); s2 = wave_sum(s2);
    if (lane == 0) { const float m = s * (1.f / 512.f); const float var = fmaxf(s2 * (1.f / 512.f) - m * m, 0.f); mu[q] = m; rs[q] = rsqrtf(var + EPS); }
  }
  __syncthreads();
  for (int i = tid; i < 128 * 128; i += NTHR) {
    const int q = i >> 7, c = i & 127;
    zn[i] = (bf2f(p.proj[(size_t)(ci * 128 + q) * 4096 + 3584 + g * 128 + c]) - mu[q]) * rs[q];
  }
  __syncthreads();
  const int c = tid & 127, p0 = (tid >> 7) * 32;
  float acc[32] = {};
  const float* W = p.l0_gws + (size_t)g * 128 * 128;
  for (int q = 0; q < 128; ++q) {
    const float z = zn[q * 128 + c];
#pragma unroll
    for (int e = 0; e < 32; ++e) acc[e] += W[(p0 + e) * 128 + q] * z;
  }
#pragma unroll
  for (int e = 0; e < 32; ++e) {
    const int t = ci * 128 + p0 + e;
    const float u = bf2f(p.proj[(size_t)t * 4096 + 3072 + g * 128 + c]);
    p.cat[(size_t)t * 1536 + 1024 + g * 128 + c] = f2bf((acc[e] + p.l0_gb[g * 128 + p0 + e]) * u);
  }
}
__device__ __forceinline__ void phase_mixer_naive(const P& p, float* lds) {
  const int nR = 1536, nS = 128, nG = 192, total = nR + nS + nG;
  for (int it = blockIdx.x; it < total; it += gridDim.x) {
    if (it < nR) ret_item_naive(p, it, lds);
    else if (it < nR + nS) state_item_naive(p, it - nR);
    else gmlp_item_naive(p, it - nR - nS, lds);
  }
}


#define LAS __attribute__((address_space(3)))
typedef short bf16x8 __attribute__((ext_vector_type(8)));
typedef short bf16x4 __attribute__((ext_vector_type(4)));
constexpr int PK = 136;
constexpr int PV = 264;
__device__ __forceinline__ bf16x8 frag_row(const LAS u16* base, int pitch, int r0, int k0, int fr, int fq) {
  return *(const LAS bf16x8*)(base + (r0 + fr) * pitch + k0 + fq * 8);
}
__device__ __forceinline__ bf16x8 frag_tr(const LAS u16* base, int pitch, int k0, int n0, int fr, int fq) {
  const LAS u16* a = base + (k0 + fq * 8 + (fr >> 2)) * pitch + n0 + 4 * (fr & 3);
  const bf16x4 lo = __builtin_amdgcn_ds_read_tr16_b64_v4i16((LAS bf16x4*)a);
  const bf16x4 hi = __builtin_amdgcn_ds_read_tr16_b64_v4i16((LAS bf16x4*)(a + 4 * pitch));
  bf16x8 r; r[0] = lo[0]; r[1] = lo[1]; r[2] = lo[2]; r[3] = lo[3]; r[4] = hi[0]; r[5] = hi[1]; r[6] = hi[2]; r[7] = hi[3];
  return r;
}
__device__ __forceinline__ f32x4 mfma16(bf16x8 a, bf16x8 b, f32x4 c) { return __builtin_amdgcn_mfma_f32_16x16x32_bf16(a, b, c, 0, 0, 0); }
__device__ __forceinline__ void tile_to_lds(const u16* __restrict__ g, size_t gp, LAS u16* l, int lp, int rows, int cols) {
  const int cpr = cols >> 3, total = rows * cpr;
  for (int i = threadIdx.x; i < total; i += NTHR) {
    const int r = i / cpr, c = (i % cpr) * 8;
    *(LAS u32x4*)(l + r * lp + c) = *(const u32x4*)(g + (size_t)r * gp + c);
  }
}

__device__ __forceinline__ void kv_item(const P& p, int item, LAS u16* lds) {
  const int ci = item >> 2, h = item & 3, tid = threadIdx.x, wid = tid >> 6, lane = tid & 63, fr = lane & 15, fq = lane >> 4;
  LAS u16* kbuf = lds; LAS u16* vbuf = lds + 128 * PK;
  __syncthreads();
  tile_to_lds(p.proj + (size_t)ci * 128 * 4096 + 512 + h * 128, 4096, kbuf, PK, 128, 128);
  tile_to_lds(p.proj + (size_t)ci * 128 * 4096 + 1024 + h * 256, 4096, vbuf, PV, 128, 256);
  __syncthreads();
  const int dir = wid >> 2, m0 = (wid & 3) * 32;
  const float lg = log1pf(-exp2f(-p.l0_decay[dir * 4 + h]));
#pragma unroll 1
  for (int nh = 0; nh < 2; ++nh) {
    f32x4 acc[2][8];
#pragma unroll
    for (int m = 0; m < 2; ++m)
#pragma unroll
      for (int n = 0; n < 8; ++n) acc[m][n] = (f32x4){0.f, 0.f, 0.f, 0.f};
#pragma unroll 1
    for (int ks = 0; ks < 4; ++ks) {
      bf16x8 a[2];
      a[0] = frag_tr(kbuf, PK, ks * 32, m0, fr, fq); a[1] = frag_tr(kbuf, PK, ks * 32, m0 + 16, fr, fq);
#pragma unroll
      for (int j = 0; j < 8; ++j) {
        const int tok = ks * 32 + fq * 8 + j;
        const float w = __expf((float)(dir == 0 ? 127 - tok : tok) * lg);
        a[0][j] = (short)f2bf(bf2f((u16)a[0][j]) * w); a[1][j] = (short)f2bf(bf2f((u16)a[1][j]) * w);
      }
#pragma unroll
      for (int n = 0; n < 8; ++n) {
        const bf16x8 b = frag_tr(vbuf, PV, ks * 32, nh * 128 + n * 16, fr, fq);
        acc[0][n] = mfma16(a[0], b, acc[0][n]); acc[1][n] = mfma16(a[1], b, acc[1][n]);
      }
    }
    float* o = p.part + ((size_t)(ci * 4 + h) * 2 + dir) * 128 * 256 + (size_t)(m0 + fq * 4) * 256 + nh * 128 + fr;
#pragma unroll
    for (int m = 0; m < 2; ++m)
#pragma unroll
      for (int j = 0; j < 4; ++j)
#pragma unroll
        for (int n = 0; n < 8; ++n) o[(m * 16 + j) * 256 + n * 16] = acc[m][n][j];
  }
}

__device__ __forceinline__ void gmlp_item(const P& p, int item, LAS u16* lds) {
  const int ci = item >> 2, g = item & 3, tid = threadIdx.x, wid = tid >> 6, lane = tid & 63, fr = lane & 15, fq = lane >> 4;
  LAS u16* zn = lds; LAS u16* wsb = lds + 128 * PK; LAS float* mu = (LAS float*)(lds + 2 * 128 * PK); LAS float* rs = mu + 128;
  __syncthreads();
  for (int q = wid; q < 128; q += 8) {
    const u32x4 v = *(const u32x4*)(p.proj + (size_t)(ci * 128 + q) * 4096 + 3584 + lane * 8);
    float s = 0.f, s2 = 0.f;
#pragma unroll
    for (int e = 0; e < 4; ++e) { const float a = __uint_as_float(v[e] << 16), b = __uint_as_float(v[e] & 0xffff0000u); s += a + b; s2 += a * a + b * b; }
    s = wave_sum(s); s2 = wave_sum(s2);
    if (lane == 0) { const float m = s * (1.f / 512.f); const float var = fmaxf(s2 * (1.f / 512.f) - m * m, 0.f); mu[q] = m; rs[q] = rsqrtf(var + EPS); }
  }
  {
    const float* W = p.l0_gws + (size_t)g * 128 * 128;
    for (int i = tid; i < 128 * 32; i += NTHR) {
      const int r = i >> 5, c = (i & 31) * 4;
      const f32x4 v = *(const f32x4*)(W + r * 128 + c);
      u32x2 o; o[0] = pk2(v[0], v[1]); o[1] = pk2(v[2], v[3]);
      *(LAS u32x2*)(wsb + r * PK + c) = o;
    }
  }
  __syncthreads();
  for (int i = tid; i < 128 * 16; i += NTHR) {
    const int q = i >> 4, c = (i & 15) * 8;
    const u32x4 v = *(const u32x4*)(p.proj + (size_t)(ci * 128 + q) * 4096 + 3584 + g * 128 + c);
    const float m = mu[q], r = rs[q];
    u32x4 o;
#pragma unroll
    for (int e = 0; e < 4; ++e) o[e] = pk2((__uint_as_float(v[e] << 16) - m) * r, (__uint_as_float(v[e] & 0xffff0000u) - m) * r);
    *(LAS u32x4*)(zn + q * PK + c) = o;
  }
  __syncthreads();
  f32x4 acc[8];
#pragma unroll
  for (int n = 0; n < 8; ++n) acc[n] = (f32x4){0.f, 0.f, 0.f, 0.f};
#pragma unroll
  for (int ks = 0; ks < 4; ++ks) {
    const bf16x8 a = frag_row(wsb, PK, wid * 16, ks * 32, fr, fq);
#pragma unroll
    for (int n = 0; n < 8; ++n) acc[n] = mfma16(a, frag_tr(zn, PK, ks * 32, n * 16, fr, fq), acc[n]);
  }
#pragma unroll
  for (int j = 0; j < 4; ++j) {
    const int pr = wid * 16 + fq * 4 + j, t = ci * 128 + pr;
    const float gb = p.l0_gb[g * 128 + pr];
#pragma unroll
    for (int n = 0; n < 8; ++n) {
      const int c = n * 16 + fr;
      const float u = bf2f(p.proj[(size_t)t * 4096 + 3072 + g * 128 + c]);
      p.cat[(size_t)t * 1536 + 1024 + g * 128 + c] = f2bf((acc[n][j] + gb) * u);
    }
  }
}
__device__ __forceinline__ void phase_mix_a(const P& p, LAS u16* lds) {
  for (int it = blockIdx.x; it < 384; it += gridDim.x) { if (it < 192) kv_item(p, it, lds); else gmlp_item(p, it - 192, lds); }
}

__device__ __forceinline__ void build_state(const P& p, LAS u16* bbuf, const float* S0, float w0, int cbase, int h, int dir, int c_lo, int c_hi, int c_ref, float lg128) {
  for (int i = threadIdx.x; i < 128 * 64; i += NTHR) {
    const int r = i >> 6, c = (i & 63) * 4;
    f32x4 a = {0.f, 0.f, 0.f, 0.f};
    if (S0) a = *(const f32x4*)(S0 + r * 256 + c) * w0;
    for (int cc = c_lo; cc < c_hi; ++cc) {
      const int e = dir == 0 ? (c_ref - 1 - cc) : (cc - c_ref - 1);
      const float w = __expf(lg128 * (float)e);
      a = a + *(const f32x4*)(p.part + ((size_t)((cbase + cc) * 4 + h) * 2 + dir) * 128 * 256 + r * 256 + c) * w;
    }
    u32x2 o; o[0] = pk2(a[0], a[1]); o[1] = pk2(a[2], a[3]);
    *(LAS u32x2*)(bbuf + r * PV + c) = o;
  }
}
__device__ __forceinline__ void ret_item(const P& p, int item, LAS u16* lds) {
  const int ci = item >> 2, h = item & 3, tid = threadIdx.x, wid = tid >> 6, lane = tid & 63, fr = lane & 15, fq = lane >> 4;
  int sb, lc, n;
  if (ci < 32) { sb = -1; lc = ci & 1; n = 2; } else { sb = (ci - 32) >> 3; lc = (ci - 32) & 7; n = 8; }
  const int cbase = ci - lc;
  const float lgf = log1pf(-exp2f(-p.l0_decay[h])), lgb = log1pf(-exp2f(-p.l0_decay[4 + h]));
  LAS u16* kbuf = lds; LAS u16* bbuf = lds + 128 * PK; LAS float* red = (LAS float*)(lds + 128 * PK + 128 * PV);
  const bool hasF = (sb >= 0) || lc > 0, hasB = (sb >= 0) || lc < n - 1;
  const u16* qg = p.proj + (size_t)ci * 128 * 4096 + h * 128;
  __syncthreads();
  tile_to_lds(p.proj + (size_t)ci * 128 * 4096 + 512 + h * 128, 4096, kbuf, PK, 128, 128);
  if (hasF) build_state(p, bbuf, sb >= 0 ? p.state + ((size_t)(sb * 2 + 0) * 4 + h) * 128 * 256 : nullptr, __expf(lgf * 128.f * (float)lc), cbase, h, 0, 0, lc, lc, lgf * 128.f);
  __syncthreads();
  {
    f32x4 s[8];
#pragma unroll
    for (int nn = 0; nn < 8; ++nn) s[nn] = (f32x4){0.f, 0.f, 0.f, 0.f};
#pragma unroll
    for (int ks = 0; ks < 4; ++ks) {
      const bf16x8 a = *(const bf16x8*)(qg + (size_t)(wid * 16 + fr) * 4096 + ks * 32 + fq * 8);
#pragma unroll
      for (int nn = 0; nn < 8; ++nn) s[nn] = mfma16(a, frag_row(kbuf, PK, nn * 16, ks * 32, fr, fq), s[nn]);
    }
    __syncthreads();
#pragma unroll
    for (int nn = 0; nn < 8; ++nn)
#pragma unroll
      for (int j = 0; j < 4; ++j) {
        const int i = wid * 16 + fq * 4 + j, jj = nn * 16 + fr, d = i - jj;
        const float w = d > 0 ? __expf((float)d * lgf) : (d < 0 ? __expf((float)(-d) * lgb) : 2.f);
        kbuf[i * PK + jj] = f2bf(s[nn][j] * w);
      }
  }
  const int m0 = (wid & 3) * 32, n0 = (wid >> 2) * 128;
  f32x4 acc[2][8];
#pragma unroll
  for (int m = 0; m < 2; ++m)
#pragma unroll
    for (int nn = 0; nn < 8; ++nn) acc[m][nn] = (f32x4){0.f, 0.f, 0.f, 0.f};
  const u16* qrow = qg + (size_t)(m0 + fr) * 4096 + fq * 8;
  if (hasF) {
#pragma unroll 1
    for (int ks = 0; ks < 4; ++ks) {
      const bf16x8 q0 = *(const bf16x8*)(qrow + ks * 32), q1 = *(const bf16x8*)(qrow + 16 * 4096 + ks * 32);
#pragma unroll
      for (int nn = 0; nn < 8; ++nn) {
        const bf16x8 b = frag_tr(bbuf, PV, ks * 32, n0 + nn * 16, fr, fq);
        acc[0][nn] = mfma16(q0, b, acc[0][nn]); acc[1][nn] = mfma16(q1, b, acc[1][nn]);
      }
    }
#pragma unroll
    for (int m = 0; m < 2; ++m)
#pragma unroll
      for (int j = 0; j < 4; ++j) {
        const int il = m0 + m * 16 + fq * 4 + j;
        const float sc = hasB ? __expf((float)(il + 1) * lgf - (float)(128 - il) * lgb) : __expf((float)(il + 1) * lgf);
#pragma unroll
        for (int nn = 0; nn < 8; ++nn) acc[m][nn][j] *= sc;
      }
  }
  if (hasB) {
    __syncthreads();
    build_state(p, bbuf, sb >= 0 ? p.state + ((size_t)(sb * 2 + 1) * 4 + h) * 128 * 256 : nullptr, __expf(lgb * 128.f * (float)(n - 1 - lc)), cbase, h, 1, lc + 1, n, lc, lgb * 128.f);
    __syncthreads();
#pragma unroll 1
    for (int ks = 0; ks < 4; ++ks) {
      const bf16x8 q0 = *(const bf16x8*)(qrow + ks * 32), q1 = *(const bf16x8*)(qrow + 16 * 4096 + ks * 32);
#pragma unroll
      for (int nn = 0; nn < 8; ++nn) {
        const bf16x8 b = frag_tr(bbuf, PV, ks * 32, n0 + nn * 16, fr, fq);
        acc[0][nn] = mfma16(q0, b, acc[0][nn]); acc[1][nn] = mfma16(q1, b, acc[1][nn]);
      }
    }
#pragma unroll
    for (int m = 0; m < 2; ++m)
#pragma unroll
      for (int j = 0; j < 4; ++j) {
        const int il = m0 + m * 16 + fq * 4 + j;
        const float sc = __expf((float)(128 - il) * lgb);
#pragma unroll
        for (int nn = 0; nn < 8; ++nn) acc[m][nn][j] *= sc;
      }
  }
  __syncthreads();
  tile_to_lds(p.proj + (size_t)ci * 128 * 4096 + 1024 + h * 256, 4096, bbuf, PV, 128, 256);
  __syncthreads();
#pragma unroll 1
  for (int ks = 0; ks < 4; ++ks) {
    const bf16x8 a0 = frag_row(kbuf, PK, m0, ks * 32, fr, fq), a1 = frag_row(kbuf, PK, m0 + 16, ks * 32, fr, fq);
#pragma unroll
    for (int nn = 0; nn < 8; ++nn) {
      const bf16x8 b = frag_tr(bbuf, PV, ks * 32, n0 + nn * 16, fr, fq);
      acc[0][nn] = mfma16(a0, b, acc[0][nn]); acc[1][nn] = mfma16(a1, b, acc[1][nn]);
    }
  }
#pragma unroll
  for (int m = 0; m < 2; ++m)
#pragma unroll
    for (int j = 0; j < 4; ++j) {
      float s = 0.f;
#pragma unroll
      for (int nn = 0; nn < 8; ++nn) s += acc[m][nn][j] * acc[m][nn][j];
      s += __shfl_xor(s, 1); s += __shfl_xor(s, 2); s += __shfl_xor(s, 4); s += __shfl_xor(s, 8);
      if (fr == 0) red[(wid >> 2) * 128 + m0 + m * 16 + fq * 4 + j] = s;
    }
  __syncthreads();
#pragma unroll
  for (int m = 0; m < 2; ++m)
#pragma unroll
    for (int j = 0; j < 4; ++j) {
      const int il = m0 + m * 16 + fq * 4 + j, t = ci * 128 + il;
      const float r = rsqrtf((red[il] + red[128 + il]) * (1.f / 256.f) + EPS);
#pragma unroll
      for (int nn = 0; nn < 8; ++nn) {
        const int dv = n0 + nn * 16 + fr;
        const float g = bf2f(p.proj[(size_t)t * 4096 + 2048 + h * 256 + dv]);
        p.cat[(size_t)t * 1536 + h * 256 + dv] = f2bf(acc[m][nn][j] * r * g);
      }
    }
}
__device__ __forceinline__ void state_item(const P& p, int item) {
  const int b = item >> 3, h = (item >> 1) & 3, dir = item & 1;
  const float w = __expf(128.f * log1pf(-exp2f(-p.l0_decay[dir * 4 + h])));
  const int c_old = dir == 0 ? 2 * b : 2 * b + 1, c_new = dir == 0 ? 2 * b + 1 : 2 * b;
  const float* A = p.part + ((size_t)(c_old * 4 + h) * 2 + dir) * 128 * 256;
  const float* B = p.part + ((size_t)(c_new * 4 + h) * 2 + dir) * 128 * 256;
  float* o = p.out + (size_t)NT * DM + ((size_t)(b * 2 + dir) * 4 + h) * 128 * 256;
  for (int i = threadIdx.x; i < 128 * 64; i += NTHR) *(f32x4*)(o + i * 4) = *(const f32x4*)(A + i * 4) * w + *(const f32x4*)(B + i * 4);
}
__device__ __forceinline__ void phase_mix_b(const P& p, LAS u16* lds) {
  for (int it = blockIdx.x; it < 320; it += gridDim.x) { if (it < 192) ret_item(p, it, lds); else state_item(p, it - 192); }
}

__device__ __forceinline__ void phase_conv(const P& p) {
  const u16* pj = p.proj;
  for (size_t i = (size_t)blockIdx.x * NTHR + threadIdx.x; i < (size_t)NT * 256; i += (size_t)gridDim.x * NTHR) {
    const int t = (int)(i >> 8), c4 = (int)(i & 255) * 4;
    const int seg = t < NPROMPT_T ? 256 : 64;
    const int pos = t < NPROMPT_T ? (t & 255) : ((t - NPROMPT_T) & 63);
    f32x4 xc[3];
#pragma unroll
    for (int d = 0; d < 3; ++d) {
      const int pp = pos + d - 1;
      if (pp < 0 || pp >= seg) { xc[d] = (f32x4){0.f, 0.f, 0.f, 0.f}; continue; }
      const u16* r = pj + (size_t)(t + d - 1) * 3072;
      const u32x2 a = *(const u32x2*)(r + 1024 + c4), b = *(const u32x2*)(r + 2048 + c4);
      xc[d][0] = __uint_as_float(a[0] << 16) * __uint_as_float(b[0] << 16);
      xc[d][1] = __uint_as_float(a[0] & 0xffff0000u) * __uint_as_float(b[0] & 0xffff0000u);
      xc[d][2] = __uint_as_float(a[1] << 16) * __uint_as_float(b[1] << 16);
      xc[d][3] = __uint_as_float(a[1] & 0xffff0000u) * __uint_as_float(b[1] & 0xffff0000u);
    }
    const f32x4 w0 = *(const f32x4*)(p.l1_conv + c4), w1 = *(const f32x4*)(p.l1_conv + 1024 + c4), w2 = *(const f32x4*)(p.l1_conv + 2048 + c4);
    const u32x2 bgv = *(const u32x2*)(pj + (size_t)t * 3072 + c4);
    f32x4 bg = {__uint_as_float(bgv[0] << 16), __uint_as_float(bgv[0] & 0xffff0000u), __uint_as_float(bgv[1] << 16), __uint_as_float(bgv[1] & 0xffff0000u)};
    const f32x4 y = bg * (w0 * xc[0] + w1 * xc[1] + w2 * xc[2]);
    u32x2 o; o[0] = pk2(y[0], y[1]); o[1] = pk2(y[2], y[3]);
    *(u32x2*)(p.cat + (size_t)t * 1024 + c4) = o;
  }
}

constexpr int NPHASE = 17;
__global__ void __launch_bounds__(NTHR) mega(P p, int lo, int hi) {
  extern __shared__ __attribute__((aligned(16))) unsigned char smem[];
  float* lds = (float*)smem;
  cg::grid_group grid = cg::this_grid();
  const float* m0 = p.mod; const float* m1 = p.mod + 3 * 6144;
#define PH(n, ...) if (lo <= (n) && (n) < hi) { if ((n) > lo) grid.sync(); __VA_ARGS__ }
  PH(0, phase_prep(p, lds);)
  PH(1, { NormArgs a{p.x_prompt, p.x_sample, nullptr, nullptr, nullptr, nullptr, p.l0_norm1, m0 + 0, m0 + 1024, p.hA, nullptr}; phase_norm(a); })
  PH(2, { EpiProj0 e{p.proj}; phase_gemm(p.hA, p.wt0_in, NT, 4096, 1024, 1, e, lds); })
  PH(3, phase_mix_a(p, (LAS u16*)smem);)
  PH(4, phase_mix_b(p, (LAS u16*)smem);)
  PH(5, { EpiPart e{p.part}; phase_gemm(p.cat, p.wt0_out, NT, 1024, 1536, 2, e, lds); })
  PH(6, { NormArgs a{p.x_prompt, p.x_sample, p.part, p.part + (size_t)NT * DM, m0 + 2048, p.xres, p.l0_norm2, m0 + 3072, m0 + 4096, p.hA, nullptr}; phase_norm(a); })
  PH(7, { EpiRelu2 e{p.proj}; phase_gemm(p.hA, p.wt0_f1, NT, 4096, 1024, 1, e, lds); })
  PH(8, { EpiPart e{p.part}; phase_gemm(p.proj, p.wt0_f2, NT, 1024, 4096, 2, e, lds); })
  PH(9, { NormArgs a{p.xres, p.xres + (size_t)NPROMPT_T * DM, p.part, p.part + (size_t)NT * DM, m0 + 5120, p.xres, p.l1_norm1, m1 + 0, m1 + 1024, p.hA, nullptr}; phase_norm(a); })
  PH(10, { EpiPlain e{p.proj, 3072}; phase_gemm(p.hA, p.wt1_in, NT, 3072, 1024, 1, e, lds); })
  PH(11, phase_conv(p);)
  PH(12, { EpiPart e{p.part}; phase_gemm(p.cat, p.wt1_out, NT, 1024, 1024, 2, e, lds); })
  PH(13, { NormArgs a{p.xres, p.xres + (size_t)NPROMPT_T * DM, p.part, p.part + (size_t)NT * DM, m1 + 2048, p.xres, p.l1_norm2, m1 + 3072, m1 + 4096, p.hA, nullptr}; phase_norm(a); })
  PH(14, { EpiRelu2 e{p.proj}; phase_gemm(p.hA, p.wt1_f1, NT, 4096, 1024, 1, e, lds); })
  PH(15, { EpiPart e{p.part}; phase_gemm(p.proj, p.wt1_f2, NT, 1024, 4096, 2, e, lds); })
  PH(16, { NormArgs a{p.xres, p.xres + (size_t)NPROMPT_T * DM, p.part, p.part + (size_t)NT * DM, m1 + 5120, nullptr, p.final_norm, nullptr, nullptr, nullptr, p.out}; phase_norm(a); })
#undef PH
}

constexpr size_t LDS_BYTES = 131072;
constexpr bool ONE_LAUNCH = true;

extern "C" void kernel_launch(void* const* d_in, const int* in_sizes, int n_in, void* d_out, int out_size, void* d_ws, size_t ws_size, hipStream_t stream) {
  static int grid_blocks = 0;
  if (!grid_blocks) {
    hipFuncSetAttribute((const void*)mega, hipFuncAttributeMaxDynamicSharedMemorySize, (int)LDS_BYTES);
    int dev = 0, cus = 0, per_cu = 0;
    hipGetDevice(&dev);
    hipDeviceGetAttribute(&cus, hipDeviceAttributeMultiprocessorCount, dev);
    hipOccupancyMaxActiveBlocksPerMultiprocessor(&per_cu, mega, NTHR, LDS_BYTES);
    if (per_cu < 1) per_cu = 1;
    if (per_cu > 1) per_cu = 1;
    grid_blocks = cus * per_cu;
  }
  P p{};
  const float* const* in = (const float* const*)d_in;
  p.x_prompt = in[0]; p.x_sample = in[1]; p.state = in[2]; p.c = in[3]; p.c_ctx = in[4];
  p.l0_norm1 = in[5]; p.l0_w_in = in[6]; p.l0_decay = in[7]; p.l0_gws = in[8]; p.l0_gb = in[9]; p.l0_w_out = in[10]; p.l0_norm2 = in[11];
  p.l0_w_mod = in[12]; p.l0_b_mod = in[13]; p.l0_f1 = in[14]; p.l0_f2 = in[15];
  p.l1_norm1 = in[16]; p.l1_w_in = in[17]; p.l1_conv = in[18]; p.l1_w_out = in[19]; p.l1_norm2 = in[20]; p.l1_w_mod = in[21]; p.l1_b_mod = in[22];
  p.l1_f1 = in[23]; p.l1_f2 = in[24]; p.final_norm = in[25];
  p.out = (float*)d_out;
  unsigned char* w = (unsigned char*)d_ws; size_t off = 0;
  auto take = [&](size_t bytes) { void* r = w + off; off += (bytes + 255) & ~(size_t)255; return r; };
  p.wt0_in = (u16*)take((size_t)4096 * 1024 * 2); p.wt0_out = (u16*)take((size_t)1024 * 1536 * 2);
  p.wt0_f1 = (u16*)take((size_t)4096 * 1024 * 2); p.wt0_f2 = (u16*)take((size_t)4096 * 1024 * 2);
  p.wt1_in = (u16*)take((size_t)3072 * 1024 * 2); p.wt1_out = (u16*)take((size_t)1024 * 1024 * 2);
  p.wt1_f1 = (u16*)take((size_t)4096 * 1024 * 2); p.wt1_f2 = (u16*)take((size_t)4096 * 1024 * 2);
  p.mod = (float*)take((size_t)2 * 3 * 6144 * 4);
  p.hA = (u16*)take((size_t)NT * 1024 * 2);
  p.proj = (u16*)take((size_t)NT * 4096 * 2);
  p.cat = (u16*)take((size_t)NT * 1536 * 2);
  p.part = (float*)take((size_t)2 * NT * 1024 * 4);
  p.xres = (float*)take((size_t)NT * 1024 * 4);
  if (ONE_LAUNCH) {
    int lo = 0, hi = NPHASE; void* args[] = {&p, &lo, &hi};
    hipError_t e = hipLaunchCooperativeKernel((void*)mega, dim3(grid_blocks), dim3(NTHR), args, LDS_BYTES, stream);
    if (e != hipSuccess) fprintf(stderr, "cooperative launch failed: %s (grid %d)\n", hipGetErrorString(e), grid_blocks);
  } else {
    for (int ph = 0; ph < NPHASE; ++ph) hipLaunchKernelGGL(mega, dim3(grid_blocks), dim3(NTHR), LDS_BYTES, stream, p, ph, ph + 1);
  }
}
```

```cpp
#include <hip/hip_runtime.h>
#include <hip/hip_cooperative_groups.h>
#include <cstdio>
namespace cg = cooperative_groups;

typedef unsigned short u16;
typedef float f32x4 __attribute__((ext_vector_type(4)));
typedef unsigned u32x4 __attribute__((ext_vector_type(4)));
typedef unsigned u32x2 __attribute__((ext_vector_type(2)));

constexpr int NT = 6144, DM = 1024, NPROMPT_T = 4096;
constexpr float EPS = 1e-6f;
constexpr int NTHR = 512;

__device__ __forceinline__ float bf2f(u16 b) { return __uint_as_float(((unsigned)b) << 16); }
typedef float f32x2 __attribute__((ext_vector_type(2)));
typedef __bf16 hbf16x2 __attribute__((ext_vector_type(2)));
__device__ __forceinline__ unsigned pk2(float a, float b) { const f32x2 v = {a, b}; const hbf16x2 r = __builtin_convertvector(v, hbf16x2); return __builtin_bit_cast(unsigned, r); }
__device__ __forceinline__ u16 f2bf(float f) { return (u16)(pk2(f, 0.f) & 0xffffu); }
__device__ __forceinline__ float silu_f(float x) { return x * __builtin_amdgcn_rcpf(1.f + __expf(-x)); }
__device__ __forceinline__ float gelu_f(float x) { const float u = -1.5957691216057308f * (x + 0.044715f * x * x * x); return x * __builtin_amdgcn_rcpf(1.f + __expf(u)); }
__device__ __forceinline__ int cond_of(int t) { return t < NPROMPT_T ? 0 : 1 + ((t - NPROMPT_T) >> 10); }
__device__ __forceinline__ float wave_sum(float v) {
#pragma unroll
  for (int o = 32; o > 0; o >>= 1) v += __shfl_xor(v, o);
  return v;
}

struct P {
  const float *x_prompt, *x_sample, *state, *c, *c_ctx;
  const float *l0_norm1, *l0_w_in, *l0_decay, *l0_gws, *l0_gb, *l0_w_out, *l0_norm2, *l0_w_mod, *l0_b_mod, *l0_f1, *l0_f2;
  const float *l1_norm1, *l1_w_in, *l1_conv, *l1_w_out, *l1_norm2, *l1_w_mod, *l1_b_mod, *l1_f1, *l1_f2, *final_norm;
  float* out;
  u16 *wt0_in, *wt0_out, *wt0_f1, *wt0_f2, *wt1_in, *wt1_out, *wt1_f1, *wt1_f2;
  float* mod;
  u16* hA;
  u16* proj;
  u16* cat;
  float* part;
  float* xres;
  unsigned* bar;
};

__device__ __forceinline__ void transpose_tile(const float* __restrict__ W, int K, int N, u16* __restrict__ Wt, int tile, float* lds) {
  const int tn = N / 64; const int k0 = (tile / tn) * 64, n0 = (tile % tn) * 64;
  const int tid = threadIdx.x;
  float (*T)[65] = (float (*)[65])lds;
  __syncthreads();
  {
    const int r = tid >> 4, c4 = (tid & 15) * 4;
#pragma unroll
    for (int i = 0; i < 2; ++i) {
      const f32x4 v = *(const f32x4*)(W + (size_t)(k0 + r + 32 * i) * N + n0 + c4);
      T[r + 32 * i][c4 + 0] = v[0]; T[r + 32 * i][c4 + 1] = v[1]; T[r + 32 * i][c4 + 2] = v[2]; T[r + 32 * i][c4 + 3] = v[3];
    }
  }
  __syncthreads();
  {
    const int nn = tid >> 3, kk = (tid & 7) * 8;
    u32x4 o;
    o[0] = pk2(T[kk + 0][nn], T[kk + 1][nn]); o[1] = pk2(T[kk + 2][nn], T[kk + 3][nn]);
    o[2] = pk2(T[kk + 4][nn], T[kk + 5][nn]); o[3] = pk2(T[kk + 6][nn], T[kk + 7][nn]);
    *(u32x4*)(Wt + (size_t)(n0 + nn) * K + k0 + kk) = o;
  }
}

__device__ __forceinline__ void adaln_item(const P& p, int item, float* lds) {
  const int l = item / 96, n0 = (item % 96) * 64;
  const float* W = l ? p.l1_w_mod : p.l0_w_mod; const float* B = l ? p.l1_b_mod : p.l0_b_mod;
  const int tid = threadIdx.x;
  float* sc = lds;
  float* red = lds + 3072;
  __syncthreads();
  for (int i = tid; i < 3072; i += NTHR) {
    const int c = i >> 10, k = i & 1023;
    const float v = c == 0 ? p.c_ctx[k] : p.c[(c - 1) * 1024 + k];
    sc[i] = silu_f(v);
  }
  __syncthreads();
  const int cg4 = tid & 15, rg = tid >> 4;
  float acc[3][4] = {};
  for (int it = 0; it < 32; ++it) {
    const int k = it * 32 + rg;
    const f32x4 w = *(const f32x4*)(W + (size_t)k * 6144 + n0 + cg4 * 4);
#pragma unroll
    for (int c = 0; c < 3; ++c) { const float s = sc[c * 1024 + k];
#pragma unroll
      for (int e = 0; e < 4; ++e) acc[c][e] += s * w[e]; }
  }
#pragma unroll
  for (int c = 0; c < 3; ++c)
#pragma unroll
    for (int e = 0; e < 4; ++e) red[(rg * 3 + c) * 64 + cg4 * 4 + e] = acc[c][e];
  __syncthreads();
  if (tid < 192) {
    const int c = tid >> 6, n = tid & 63; float s = B[n0 + n];
    for (int r = 0; r < 32; ++r) s += red[(r * 3 + c) * 64 + n];
    p.mod[(size_t)(l * 3 + c) * 6144 + n0 + n] = s;
  }
}

__device__ __forceinline__ void phase_prep(const P& p, float* lds) {
  const int nA = 192;
  const int t0 = 1024, t1 = 384, t2 = 1024, t3 = 1024, t4 = 768, t5 = 256, t6 = 1024, t7 = 1024;
  const int total = nA + t0 + t1 + t2 + t3 + t4 + t5 + t6 + t7;
  for (int it = blockIdx.x; it < total; it += gridDim.x) {
    int i = it;
    if (i < nA) { adaln_item(p, i, lds); continue; }
    i -= nA;
    if (i < t0) { transpose_tile(p.l0_w_in, 1024, 4096, p.wt0_in, i, lds); continue; } i -= t0;
    if (i < t1) { transpose_tile(p.l0_w_out, 1536, 1024, p.wt0_out, i, lds); continue; } i -= t1;
    if (i < t2) { transpose_tile(p.l0_f1, 1024, 4096, p.wt0_f1, i, lds); continue; } i -= t2;
    if (i < t3) { transpose_tile(p.l0_f2, 4096, 1024, p.wt0_f2, i, lds); continue; } i -= t3;
    if (i < t4) { transpose_tile(p.l1_w_in, 1024, 3072, p.wt1_in, i, lds); continue; } i -= t4;
    if (i < t5) { transpose_tile(p.l1_w_out, 1024, 1024, p.wt1_out, i, lds); continue; } i -= t5;
    if (i < t6) { transpose_tile(p.l1_f1, 1024, 4096, p.wt1_f1, i, lds); continue; } i -= t6;
    transpose_tile(p.l1_f2, 4096, 1024, p.wt1_f2, i, lds);
  }
}

struct NormArgs {
  const float* xin0; const float* xin1;
  const float* p0; const float* p1; const float* gate;
  float* xout; const float* nw; const float* sh; const float* sc;
  u16* hout; float* fout;
};
__device__ __forceinline__ void phase_norm(const NormArgs& a) {
  const int wid = threadIdx.x >> 6, lane = threadIdx.x & 63;
  for (int t = blockIdx.x * 8 + wid; t < NT; t += gridDim.x * 8) {
    const int c = cond_of(t);
    const float* xr = t < NPROMPT_T ? a.xin0 + (size_t)t * DM : a.xin1 + (size_t)(t - NPROMPT_T) * DM;
    f32x4 x[4]; float ss = 0.f;
#pragma unroll
    for (int i = 0; i < 4; ++i) {
      const int col = lane * 4 + 256 * i;
      x[i] = *(const f32x4*)(xr + col);
      if (a.p0) {
        const f32x4 q0 = *(const f32x4*)(a.p0 + (size_t)t * DM + col), q1 = *(const f32x4*)(a.p1 + (size_t)t * DM + col);
        const f32x4 g = *(const f32x4*)(a.gate + (size_t)c * 6144 + col);
        x[i] = x[i] + g * (q0 + q1);
      }
      if (a.xout) *(f32x4*)(a.xout + (size_t)t * DM + col) = x[i];
      ss += x[i][0] * x[i][0] + x[i][1] * x[i][1] + x[i][2] * x[i][2] + x[i][3] * x[i][3];
    }
    ss = wave_sum(ss);
    const float r = rsqrtf(ss * (1.f / 1024.f) + EPS);
#pragma unroll
    for (int i = 0; i < 4; ++i) {
      const int col = lane * 4 + 256 * i;
      const f32x4 w = *(const f32x4*)(a.nw + col);
      f32x4 y = x[i] * r * w;
      if (a.fout) *(f32x4*)(a.fout + (size_t)t * DM + col) = y;
      if (a.hout) {
        const f32x4 sh = *(const f32x4*)(a.sh + (size_t)c * 6144 + col), sc = *(const f32x4*)(a.sc + (size_t)c * 6144 + col);
        y = y * (1.f + sc) + sh;
        u32x2 o; o[0] = pk2(y[0], y[1]); o[1] = pk2(y[2], y[3]);
        *(u32x2*)(a.hout + (size_t)t * DM + col) = o;
      }
    }
  }
}

struct EpiProj0 {
  u16* O;
  __device__ __forceinline__ void store4(int row, int col, f32x4 v, int) const {
    if (col >= 3072) { v[0] = gelu_f(v[0]); v[1] = gelu_f(v[1]); v[2] = gelu_f(v[2]); v[3] = gelu_f(v[3]); }
    else if (col >= 2048) { v[0] = silu_f(v[0]); v[1] = silu_f(v[1]); v[2] = silu_f(v[2]); v[3] = silu_f(v[3]); }
    else if (col >= 512 && col < 1024) v = v * 0.08838834764831845f;
    u32x2 o; o[0] = pk2(v[0], v[1]); o[1] = pk2(v[2], v[3]);
    *(u32x2*)(O + (size_t)row * 4096 + col) = o;
  }
};
struct EpiPart {
  float* Pp;
  __device__ __forceinline__ void store4(int row, int col, f32x4 v, int ks) const { *(f32x4*)(Pp + ((size_t)ks * NT + row) * DM + col) = v; }
};
struct EpiRelu2 {
  u16* O;
  __device__ __forceinline__ void store4(int row, int col, f32x4 v, int) const {
#pragma unroll
    for (int e = 0; e < 4; ++e) { const float r = fmaxf(v[e], 0.f); v[e] = r * r; }
    u32x2 o; o[0] = pk2(v[0], v[1]); o[1] = pk2(v[2], v[3]);
    *(u32x2*)(O + (size_t)row * 4096 + col) = o;
  }
};
struct EpiPlain {
  u16* O; int ld;
  __device__ __forceinline__ void store4(int row, int col, f32x4 v, int) const {
    u32x2 o; o[0] = pk2(v[0], v[1]); o[1] = pk2(v[2], v[3]);
    *(u32x2*)(O + (size_t)row * ld + col) = o;
  }
};

template <class Epi>
__device__ __forceinline__ void phase_gemm_naive(const u16* __restrict__ A, const u16* __restrict__ Bt, int M, int N, int K, int ksplit, const Epi& E, float* lds) {
  float (*As)[33] = (float (*)[33])lds;
  float (*Bs)[33] = (float (*)[33])(lds + 128 * 33);
  const int tm = M / 128, tn = N / 64, total = tm * tn * ksplit, kper = K / ksplit;
  const int tid = threadIdx.x, r = tid >> 2, cq = tid & 3;
  for (int it = blockIdx.x; it < total; it += gridDim.x) {
    const int ks = it / (tm * tn), rem = it % (tm * tn), m0 = (rem / tn) * 128, n0 = (rem % tn) * 64;
    float acc[4][4] = {};
    for (int k0 = ks * kper; k0 < (ks + 1) * kper; k0 += 32) {
      __syncthreads();
      {
        const int kc = (tid & 3) * 8;
        const u32x4 va = *(const u32x4*)(A + (size_t)(m0 + r) * K + k0 + kc);
#pragma unroll
        for (int e = 0; e < 4; ++e) { As[r][kc + 2 * e] = __uint_as_float(va[e] << 16); As[r][kc + 2 * e + 1] = __uint_as_float(va[e] & 0xffff0000u); }
        if (tid < 256) {
          const u32x4 vb = *(const u32x4*)(Bt + (size_t)(n0 + r) * K + k0 + kc);
#pragma unroll
          for (int e = 0; e < 4; ++e) { Bs[r][kc + 2 * e] = __uint_as_float(vb[e] << 16); Bs[r][kc + 2 * e + 1] = __uint_as_float(vb[e] & 0xffff0000u); }
        }
      }
      __syncthreads();
#pragma unroll 4
      for (int k = 0; k < 32; ++k) {
        const float a = As[r][k];
#pragma unroll
        for (int jj = 0; jj < 4; ++jj)
#pragma unroll
          for (int e = 0; e < 4; ++e) acc[jj][e] += a * Bs[cq * 4 + 16 * jj + e][k];
      }
    }
#pragma unroll
    for (int jj = 0; jj < 4; ++jj) { f32x4 v = {acc[jj][0], acc[jj][1], acc[jj][2], acc[jj][3]}; E.store4(m0 + r, n0 + cq * 4 + 16 * jj, v, ks); }
  }
}


namespace pg8 {
#define PG8_LAS __attribute__((address_space(3)))
typedef short bf16x8 __attribute__((ext_vector_type(8)));
constexpr int BM = 256, BK = 64, HALF = 128, HTB = HALF * BK * 2, STAGE_BYTES = 8 * HTB, NXCD = 8, WGM = 8;
__device__ __forceinline__ int lds_byte(int r, int c) { const int st = (r >> 4) * 2 + (c >> 5), rr = r & 15, cc = c & 31, ob = rr * 64 + cc * 2; return st * 1024 + (ob ^ (((ob >> 9) & 1) << 5)); }
__device__ __forceinline__ void stage_rc(int b, int& R, int& C) { const int st = b / 1024, sb = b % 1024, swz = sb ^ (((sb >> 9) & 1) << 5); R = (st >> 1) * 16 + swz / 64; C = (st & 1) * 32 + (swz % 64) / 2; }
struct Unit { int pm, pn, ks; };
struct Gemm { const u16* A; const u16* Bt; int M, N, K, ksplit; };
struct Order {
  int nM, nN, ntile, nwg, G, c;
  __device__ void init(int M, int N, int ksplit, int G_, int c_) { nM = M / BM; nN = N / BM; ntile = nM * nN; nwg = ntile * ksplit; G = G_; c = c_; }
  __device__ bool next(int i, Unit& u) const {
    const int L = i * G + c; if (L >= nwg) return false;
    u.ks = L / ntile; int wgid = L % ntile;
    { const int q = ntile / NXCD, r = ntile % NXCD, xcd = wgid % NXCD, off = wgid / NXCD; wgid = (xcd < r ? xcd * (q + 1) : r * (q + 1) + (xcd - r) * q) + off; }
    const int nig = WGM * nN, gid = wgid / nig, fm = gid * WGM, gsz = (nM - fm) < WGM ? (nM - fm) : WGM;
    u.pm = fm + ((wgid % nig) % gsz); u.pn = (wgid % nig) / gsz; return true;
  }
};
template <class Epi>
__device__ __forceinline__ void run_epi(const Epi& E, const f32x4 (&acc)[2][2][4][2], const Unit& u, int wr, int wc, int fr, int fq) {
  const int row0 = u.pm * BM + wr * 64 + fr, col0 = u.pn * BM + wc * 32 + 4 * fq;
#pragma unroll
  for (int ai = 0; ai < 2; ++ai)
#pragma unroll
    for (int m = 0; m < 4; ++m)
#pragma unroll
      for (int bj = 0; bj < 2; ++bj)
#pragma unroll
        for (int n = 0; n < 2; ++n) E.store4(row0 + ai * HALF + m * 16, col0 + bj * HALF + n * 16, acc[ai][bj][m][n], u.ks);
}
template <class Epi>
__device__ __forceinline__ void gemm_phase(PG8_LAS unsigned char* lds, const Gemm g, const Order& S, const Epi& E) {
  const int tid = threadIdx.x, wid = __builtin_amdgcn_readfirstlane(tid >> 6), lane = tid & 63, wr = wid >> 2, wc = wid & 3, fr = lane & 15, fq = lane >> 4;
  const int K = g.K, kper = g.K / g.ksplit, nt = kper / BK;
  unsigned voffA[2];
#pragma unroll
  for (int i = 0; i < 2; ++i) { int R, C; stage_rc(tid * 16 + i * 8192, R, C); voffA[i] = (unsigned)(R * K + C) * 2u; }
  const size_t kstep = (size_t)(BK * 2);
  const size_t hstep = (size_t)HALF * K * 2;
  const size_t tstep = 2 * hstep;
  const size_t ksbytes = (size_t)kper * 2;
  const unsigned ldsw = (unsigned)wid * 1024u;
  const int aoff = lds_byte(wr * 64 + fr, fq * 8), boff = lds_byte(wc * 32 + fr, fq * 8);
#define PG8_SA(b, h) (((b) * 2 + (h)) * HTB)
#define PG8_SB(b, h) ((4 + (b) * 2 + (h)) * HTB)
#define PG8_STAGE(bufoff, gbase, voff) do { _Pragma("unroll") for (int _i = 0; _i < 2; ++_i) \
    __builtin_amdgcn_global_load_lds((const unsigned*)((const char*)(gbase) + (voff)[_i]), (PG8_LAS unsigned*)(lds + (bufoff) + ldsw + _i * 8192), 16, 0, 0); } while (0)
#define PG8_LDA(dst, b, h) do { _Pragma("unroll") for (int m = 0; m < 4; ++m) _Pragma("unroll") for (int k = 0; k < 2; ++k) dst[m][k] = *(const PG8_LAS bf16x8*)(lds + PG8_SA(b, h) + aoff + m * 2048 + k * 1024); } while (0)
#define PG8_LDB(dst, b, h) do { _Pragma("unroll") for (int n = 0; n < 2; ++n) _Pragma("unroll") for (int k = 0; k < 2; ++k) dst[n][k] = *(const PG8_LAS bf16x8*)(lds + PG8_SB(b, h) + boff + n * 2048 + k * 1024); } while (0)
#define PG8_MMA(ai, bj, At, Bt) do { __builtin_amdgcn_s_setprio(1); _Pragma("unroll") for (int m = 0; m < 4; ++m) _Pragma("unroll") for (int n = 0; n < 2; ++n) _Pragma("unroll") for (int k = 0; k < 2; ++k) \
    acc[ai][bj][m][n] = __builtin_amdgcn_mfma_f32_16x16x32_bf16(Bt[n][k], At[m][k], acc[ai][bj][m][n], 0, 0, 0); __builtin_amdgcn_s_setprio(0); } while (0)
#define PG8_WAIT_V(n) asm volatile("s_waitcnt vmcnt(" #n ")" ::: "memory")
#define PG8_WAIT_L(n) asm volatile("s_waitcnt lgkmcnt(" #n ")" ::: "memory")
#define PG8_BAR __builtin_amdgcn_s_barrier()
#define PG8_SCHED __builtin_amdgcn_sched_barrier(0)
  Unit cur, nxt; int ui = 0;
  if (!S.next(0, cur)) return;
  f32x4 acc[2][2][4][2];
#pragma unroll
  for (int a = 0; a < 2; ++a)
#pragma unroll
    for (int b = 0; b < 2; ++b)
#pragma unroll
      for (int m = 0; m < 4; ++m)
#pragma unroll
        for (int n = 0; n < 2; ++n) acc[a][b][m][n] = (f32x4){0.f, 0.f, 0.f, 0.f};
  bf16x8 At[4][2], B0[2][2], B1[2][2];
  const char* cA = (const char*)g.A + (size_t)cur.pm * tstep + (size_t)cur.ks * ksbytes; const char* cB = (const char*)g.Bt + (size_t)cur.pn * tstep + (size_t)cur.ks * ksbytes;
  PG8_STAGE(PG8_SB(0, 0), cB, voffA); PG8_STAGE(PG8_SA(0, 0), cA, voffA); PG8_STAGE(PG8_SB(0, 1), cB + hstep, voffA); PG8_STAGE(PG8_SA(0, 1), cA + hstep, voffA);
  if (wr == 1) PG8_BAR;
  PG8_WAIT_V(4); PG8_BAR;
  PG8_STAGE(PG8_SB(1, 0), cB + kstep, voffA); PG8_STAGE(PG8_SA(1, 0), cA + kstep, voffA); PG8_STAGE(PG8_SB(1, 1), cB + hstep + kstep, voffA);
  PG8_WAIT_V(6); PG8_BAR;
  for (;;) {
    const bool has_next = S.next(ui + 1, nxt);
    const char* nA = has_next ? (const char*)g.A + (size_t)nxt.pm * tstep + (size_t)nxt.ks * ksbytes : cA; const char* nB = has_next ? (const char*)g.Bt + (size_t)nxt.pn * tstep + (size_t)nxt.ks * ksbytes : cB;
    for (int t = 0; t < nt; t += 2) {
      const bool last = (t == nt - 2);
      const char* a1 = cA + (size_t)(t + 1) * kstep;
      const char* a2 = last ? nA : cA + (size_t)(t + 2) * kstep; const char* b2 = last ? nB : cB + (size_t)(t + 2) * kstep;
      const char* a3 = a2 + kstep; const char* b3 = b2 + kstep;
      PG8_LDB(B0, 0, 0); PG8_SCHED; PG8_LDA(At, 0, 0); PG8_STAGE(PG8_SA(1, 1), a1 + hstep, voffA);
      PG8_WAIT_L(8); PG8_BAR; PG8_WAIT_L(0); PG8_MMA(0, 0, At, B0); PG8_BAR; PG8_SCHED;
      PG8_LDB(B1, 0, 1); PG8_STAGE(PG8_SB(0, 0), b2, voffA);
      PG8_BAR; PG8_WAIT_L(0); PG8_MMA(0, 1, At, B1); PG8_BAR;
      PG8_LDA(At, 0, 1); PG8_STAGE(PG8_SA(0, 0), a2, voffA);
      PG8_BAR; PG8_WAIT_L(0); PG8_MMA(1, 0, At, B0); PG8_BAR; PG8_SCHED;
      PG8_STAGE(PG8_SB(0, 1), b2 + hstep, voffA);
      PG8_WAIT_V(6); PG8_BAR; PG8_MMA(1, 1, At, B1); PG8_BAR;
      PG8_LDB(B0, 1, 0); PG8_SCHED; PG8_LDA(At, 1, 0); PG8_STAGE(PG8_SA(0, 1), a2 + hstep, voffA);
      PG8_WAIT_L(8); PG8_BAR; PG8_WAIT_L(0); PG8_MMA(0, 0, At, B0); PG8_BAR; PG8_SCHED;
      PG8_LDB(B1, 1, 1); PG8_STAGE(PG8_SB(1, 0), b3, voffA);
      PG8_BAR; PG8_WAIT_L(0); PG8_MMA(0, 1, At, B1); PG8_BAR;
      PG8_LDA(At, 1, 1); PG8_STAGE(PG8_SA(1, 0), a3, voffA);
      PG8_BAR; PG8_WAIT_L(0); PG8_MMA(1, 0, At, B0); PG8_BAR; PG8_SCHED;
      PG8_STAGE(PG8_SB(1, 1), b3 + hstep, voffA);
      PG8_WAIT_V(6); PG8_BAR; PG8_MMA(1, 1, At, B1); PG8_BAR;
    }
    run_epi(E, acc, cur, wr, wc, fr, fq);
    if (!has_next) break;
#pragma unroll
    for (int a = 0; a < 2; ++a)
#pragma unroll
      for (int b = 0; b < 2; ++b)
#pragma unroll
        for (int m = 0; m < 4; ++m)
#pragma unroll
          for (int n = 0; n < 2; ++n) acc[a][b][m][n] = (f32x4){0.f, 0.f, 0.f, 0.f};
    cur = nxt; cA = nA; cB = nB; ++ui;
  }
  PG8_WAIT_V(0);
  if (wr == 0) PG8_BAR;
  PG8_BAR;
#undef PG8_SA
#undef PG8_SB
#undef PG8_STAGE
#undef PG8_LDA
#undef PG8_LDB
#undef PG8_MMA
#undef PG8_WAIT_V
#undef PG8_WAIT_L
#undef PG8_BAR
#undef PG8_SCHED
}
}
template <class Epi>
__device__ __forceinline__ void phase_gemm(const u16* A, const u16* Bt, int M, int N, int K, int ksplit, const Epi& E, float* lds) {
  __syncthreads();
  pg8::Gemm g{A, Bt, M, N, K, ksplit};
  pg8::Order S; S.init(M, N, ksplit, (int)gridDim.x, (int)blockIdx.x);
  pg8::gemm_phase(( __attribute__((address_space(3))) unsigned char*)lds, g, S, E);
  __syncthreads();
}

__device__ __forceinline__ void seq_of_token(int t, int& s0, int& L, int& sb) {
  if (t < NPROMPT_T) { s0 = t & ~255; L = 256; sb = -1; } else { sb = (t - NPROMPT_T) >> 10; s0 = NPROMPT_T + (sb << 10); L = 1024; }
}
__device__ __forceinline__ void ret_item_naive(const P& p, int item, float* lds) {
  const int tg = item >> 2, h = item & 3, t0 = tg * 16, tid = threadIdx.x;
  int s0, L, sb; seq_of_token(t0, s0, L, sb);
  float* scr = lds;
  float* qs = lds + 16 * 1024;
  float* red = qs + 16 * 128;
  const float lgf = log1pf(-exp2f(-p.l0_decay[h])), lgb = log1pf(-exp2f(-p.l0_decay[4 + h]));
  __syncthreads();
  for (int i = tid; i < 16 * 128; i += NTHR) qs[i] = bf2f(p.proj[(size_t)(t0 + (i >> 7)) * 4096 + h * 128 + (i & 127)]);
  __syncthreads();
  for (int j = tid; j < L; j += NTHR) {
    float acc[16] = {};
    const u16* kr = p.proj + (size_t)(s0 + j) * 4096 + 512 + h * 128;
    for (int d0 = 0; d0 < 128; d0 += 8) {
      const u32x4 kv = *(const u32x4*)(kr + d0);
      float kf[8];
#pragma unroll
      for (int e = 0; e < 4; ++e) { kf[2 * e] = __uint_as_float(kv[e] << 16); kf[2 * e + 1] = __uint_as_float(kv[e] & 0xffff0000u); }
#pragma unroll
      for (int i = 0; i < 16; ++i)
#pragma unroll
        for (int e = 0; e < 8; ++e) acc[i] += qs[i * 128 + d0 + e] * kf[e];
    }
#pragma unroll
    for (int i = 0; i < 16; ++i) {
      const int d = (t0 + i - s0) - j;
      const float w = d > 0 ? __expf((float)d * lgf) : (d < 0 ? __expf((float)(-d) * lgb) : 2.f);
      scr[i * 1024 + j] = acc[i] * w;
    }
  }
  __syncthreads();
  const int dv = tid & 255, ig = tid >> 8;
  float o[8] = {};
  for (int j = 0; j < L; ++j) {
    const float v = bf2f(p.proj[(size_t)(s0 + j) * 4096 + 1024 + h * 256 + dv]);
#pragma unroll
    for (int e = 0; e < 8; ++e) o[e] += scr[(ig * 8 + e) * 1024 + j] * v;
  }
  if (sb >= 0) {
    const float* Sf = p.state + ((size_t)(sb * 2 + 0) * 4 + h) * 128 * 256;
    const float* Sb = p.state + ((size_t)(sb * 2 + 1) * 4 + h) * 128 * 256;
    float af[8] = {}, ab[8] = {};
    for (int dk = 0; dk < 128; ++dk) {
      const float sf = Sf[dk * 256 + dv], sbv = Sb[dk * 256 + dv];
#pragma unroll
      for (int e = 0; e < 8; ++e) { const float q = qs[(ig * 8 + e) * 128 + dk]; af[e] += q * sf; ab[e] += q * sbv; }
    }
#pragma unroll
    for (int e = 0; e < 8; ++e) {
      const int pos = t0 + ig * 8 + e - s0;
      o[e] += __expf((float)(pos + 1) * lgf) * af[e] + __expf((float)(L - pos) * lgb) * ab[e];
    }
  }
  const int wid = tid >> 6, lane = tid & 63;
#pragma unroll
  for (int e = 0; e < 8; ++e) { const float s = wave_sum(o[e] * o[e]); if (lane == 0) red[wid * 8 + e] = s; }
  __syncthreads();
#pragma unroll
  for (int e = 0; e < 8; ++e) {
    const float ss = red[(ig * 4 + 0) * 8 + e] + red[(ig * 4 + 1) * 8 + e] + red[(ig * 4 + 2) * 8 + e] + red[(ig * 4 + 3) * 8 + e];
    const float r = rsqrtf(ss * (1.f / 256.f) + EPS);
    const int t = t0 + ig * 8 + e;
    const float g = bf2f(p.proj[(size_t)t * 4096 + 2048 + h * 256 + dv]);
    p.cat[(size_t)t * 1536 + h * 256 + dv] = f2bf(o[e] * r * g);
  }
}
__device__ __forceinline__ void state_item_naive(const P& p, int item) {
  const int b = item >> 3, h = (item >> 1) & 3, dir = item & 1, tid = threadIdx.x;
  const float lg = log1pf(-exp2f(-p.l0_decay[dir * 4 + h]));
  const int dv = tid & 255;
  float* o = p.out + (size_t)NT * DM + ((size_t)(b * 2 + dir) * 4 + h) * 128 * 256;
  for (int pass = 0; pass < 4; ++pass) {
    const int dk0 = (tid >> 8) * 64 + pass * 16;
    float acc[16] = {};
    for (int s = 0; s < 256; ++s) {
      const int t = b * 256 + s;
      const float w = dir == 0 ? __expf((float)(255 - s) * lg) : __expf((float)s * lg);
      const float v = bf2f(p.proj[(size_t)t * 4096 + 1024 + h * 256 + dv]) * w;
      const u16* kr = p.proj + (size_t)t * 4096 + 512 + h * 128 + dk0;
#pragma unroll
      for (int e = 0; e < 16; ++e) acc[e] += bf2f(kr[e]) * v;
    }
#pragma unroll
    for (int e = 0; e < 16; ++e) o[(dk0 + e) * 256 + dv] = acc[e];
  }
}
__device__ __forceinline__ void gmlp_item_naive(const P& p, int item, float* lds) {
  const int ci = item >> 2, g = item & 3, tid = threadIdx.x, wid = tid >> 6, lane = tid & 63;
  float* zn = lds;
  float* mu = lds + 128 * 128;
  float* rs = mu + 128;
  __syncthreads();
  for (int q = wid; q < 128; q += 8) {
    const u32x4 v = *(const u32x4*)(p.proj + (size_t)(ci * 128 + q) * 4096 + 3584 + lane * 8);
    float s = 0.f, s2 = 0.f;
#pragma unroll
    for (int e = 0; e < 4; ++e) { const float a = __uint_as_float(v[e] << 16), b = __uint_as_float(v[e] & 0xffff0000u); s += a + b; s2 += a * a + b * b; }
    s = wave_sum(s); s2 = wave_sum(s2);
    if (lane == 0) { const float m = s * (1.f / 512.f); const float var = fmaxf(s2 * (1.f / 512.f) - m * m, 0.f); mu[q] = m; rs[q] = rsqrtf(var + EPS); }
  }
  __syncthreads();
  for (int i = tid; i < 128 * 128; i += NTHR) {
    const int q = i >> 7, c = i & 127;
    zn[i] = (bf2f(p.proj[(size_t)(ci * 128 + q) * 4096 + 3584 + g * 128 + c]) - mu[q]) * rs[q];
  }
  __syncthreads();
  const int c = tid & 127, p0 = (tid >> 7) * 32;
  float acc[32] = {};
  const float* W = p.l0_gws + (size_t)g * 128 * 128;
  for (int q = 0; q < 128; ++q) {
    const float z = zn[q * 128 + c];
#pragma unroll
    for (int e = 0; e < 32; ++e) acc[e] += W[(p0 + e) * 128 + q] * z;
  }
#pragma unroll
  for (int e = 0; e < 32; ++e) {
    const int t = ci * 128 + p0 + e;
    const float u = bf2f(p.proj[(size_t)t * 4096 + 3072 + g * 128 + c]);
    p.cat[(size_t)t * 1536 + 1024 + g * 128 + c] = f2bf((acc[e] + p.l0_gb[g * 128 + p0 + e]) * u);
  }
}
__device__ __forceinline__ void phase_mixer_naive(const P& p, float* lds) {
  const int nR = 1536, nS = 128, nG = 192, total = nR + nS + nG;
  for (int it = blockIdx.x; it < total; it += gridDim.x) {
    if (it < nR) ret_item_naive(p, it, lds);
    else if (it < nR + nS) state_item_naive(p, it - nR);
    else gmlp_item_naive(p, it - nR - nS, lds);
  }
}


#define LAS __attribute__((address_space(3)))
typedef short bf16x8 __attribute__((ext_vector_type(8)));
typedef short bf16x4 __attribute__((ext_vector_type(4)));
constexpr int PK = 136;
constexpr int PV = 264;
__device__ __forceinline__ bf16x8 frag_row(const LAS u16* base, int pitch, int r0, int k0, int fr, int fq) {
  return *(const LAS bf16x8*)(base + (r0 + fr) * pitch + k0 + fq * 8);
}
__device__ __forceinline__ bf16x8 frag_tr(const LAS u16* base, int pitch, int k0, int n0, int fr, int fq) {
  const LAS u16* a = base + (k0 + fq * 8 + (fr >> 2)) * pitch + n0 + 4 * (fr & 3);
  const bf16x4 lo = __builtin_amdgcn_ds_read_tr16_b64_v4i16((LAS bf16x4*)a);
  const bf16x4 hi = __builtin_amdgcn_ds_read_tr16_b64_v4i16((LAS bf16x4*)(a + 4 * pitch));
  bf16x8 r; r[0] = lo[0]; r[1] = lo[1]; r[2] = lo[2]; r[3] = lo[3]; r[4] = hi[0]; r[5] = hi[1]; r[6] = hi[2]; r[7] = hi[3];
  return r;
}
__device__ __forceinline__ f32x4 mfma16(bf16x8 a, bf16x8 b, f32x4 c) { return __builtin_amdgcn_mfma_f32_16x16x32_bf16(a, b, c, 0, 0, 0); }
__device__ __forceinline__ void tile_to_lds(const u16* __restrict__ g, size_t gp, LAS u16* l, int lp, int rows, int cols) {
  const int cpr = cols >> 3, total = rows * cpr;
  for (int i = threadIdx.x; i < total; i += NTHR) {
    const int r = i / cpr, c = (i % cpr) * 8;
    *(LAS u32x4*)(l + r * lp + c) = *(const u32x4*)(g + (size_t)r * gp + c);
  }
}

__device__ __forceinline__ void kv_item(const P& p, int item, LAS u16* lds) {
  const int ci = item >> 2, h = item & 3, tid = threadIdx.x, wid = tid >> 6, lane = tid & 63, fr = lane & 15, fq = lane >> 4;
  LAS u16* kbuf = lds; LAS u16* vbuf = lds + 128 * PK;
  __syncthreads();
  tile_to_lds(p.proj + (size_t)ci * 128 * 4096 + 512 + h * 128, 4096, kbuf, PK, 128, 128);
  tile_to_lds(p.proj + (size_t)ci * 128 * 4096 + 1024 + h * 256, 4096, vbuf, PV, 128, 256);
  __syncthreads();
  const int dir = wid >> 2, m0 = (wid & 3) * 32;
  const float lg = log1pf(-exp2f(-p.l0_decay[dir * 4 + h]));
#pragma unroll 1
  for (int nh = 0; nh < 2; ++nh) {
    f32x4 acc[2][8];
#pragma unroll
    for (int m = 0; m < 2; ++m)
#pragma unroll
      for (int n = 0; n < 8; ++n) acc[m][n] = (f32x4){0.f, 0.f, 0.f, 0.f};
#pragma unroll 1
    for (int ks = 0; ks < 4; ++ks) {
      bf16x8 a[2];
      a[0] = frag_tr(kbuf, PK, ks * 32, m0, fr, fq); a[1] = frag_tr(kbuf, PK, ks * 32, m0 + 16, fr, fq);
#pragma unroll
      for (int j = 0; j < 8; ++j) {
        const int tok = ks * 32 + fq * 8 + j;
        const float w = __expf((float)(dir == 0 ? 127 - tok : tok) * lg);
        a[0][j] = (short)f2bf(bf2f((u16)a[0][j]) * w); a[1][j] = (short)f2bf(bf2f((u16)a[1][j]) * w);
      }
#pragma unroll
      for (int n = 0; n < 8; ++n) {
        const bf16x8 b = frag_tr(vbuf, PV, ks * 32, nh * 128 + n * 16, fr, fq);
        acc[0][n] = mfma16(a[0], b, acc[0][n]); acc[1][n] = mfma16(a[1], b, acc[1][n]);
      }
    }
    float* o = p.part + ((size_t)(ci * 4 + h) * 2 + dir) * 128 * 256 + (size_t)(m0 + fq * 4) * 256 + nh * 128 + fr;
#pragma unroll
    for (int m = 0; m < 2; ++m)
#pragma unroll
      for (int j = 0; j < 4; ++j)
#pragma unroll
        for (int n = 0; n < 8; ++n) o[(m * 16 + j) * 256 + n * 16] = acc[m][n][j];
  }
}

__device__ __forceinline__ void gmlp_item(const P& p, int item, LAS u16* lds) {
  const int ci = item >> 2, g = item & 3, tid = threadIdx.x, wid = tid >> 6, lane = tid & 63, fr = lane & 15, fq = lane >> 4;
  LAS u16* zn = lds; LAS u16* wsb = lds + 128 * PK; LAS float* mu = (LAS float*)(lds + 2 * 128 * PK); LAS float* rs = mu + 128;
  __syncthreads();
  for (int q = wid; q < 128; q += 8) {
    const u32x4 v = *(const u32x4*)(p.proj + (size_t)(ci * 128 + q) * 4096 + 3584 + lane * 8);
    float s = 0.f, s2 = 0.f;
#pragma unroll
    for (int e = 0; e < 4; ++e) { const float a = __uint_as_float(v[e] << 16), b = __uint_as_float(v[e] & 0xffff0000u); s += a + b; s2 += a * a + b * b; }
    s = wave_sum(s); s2 = wave_sum(s2);
    if (lane == 0) { const float m = s * (1.f / 512.f); const float var = fmaxf(s2 * (1.f / 512.f) - m * m, 0.f); mu[q] = m; rs[q] = rsqrtf(var + EPS); }
  }
  {
    const float* W = p.l0_gws + (size_t)g * 128 * 128;
    for (int i = tid; i < 128 * 32; i += NTHR) {
      const int r = i >> 5, c = (i & 31) * 4;
      const f32x4 v = *(const f32x4*)(W + r * 128 + c);
      u32x2 o; o[0] = pk2(v[0], v[1]); o[1] = pk2(v[2], v[3]);
      *(LAS u32x2*)(wsb + r * PK + c) = o;
    }
  }
  __syncthreads();
  for (int i = tid; i < 128 * 16; i += NTHR) {
    const int q = i >> 4, c = (i & 15) * 8;
    const u32x4 v = *(const u32x4*)(p.proj + (size_t)(ci * 128 + q) * 4096 + 3584 + g * 128 + c);
    const float m = mu[q], r = rs[q];
    u32x4 o;
#pragma unroll
    for (int e = 0; e < 4; ++e) o[e] = pk2((__uint_as_float(v[e] << 16) - m) * r, (__uint_as_float(v[e] & 0xffff0000u) - m) * r);
    *(LAS u32x4*)(zn + q * PK + c) = o;
  }
  __syncthreads();
  f32x4 acc[8];
#pragma unroll
  for (int n = 0; n < 8; ++n) acc[n] = (f32x4){0.f, 0.f, 0.f, 0.f};
#pragma unroll
  for (int ks = 0; ks < 4; ++ks) {
    const bf16x8 a = frag_row(wsb, PK, wid * 16, ks * 32, fr, fq);
#pragma unroll
    for (int n = 0; n < 8; ++n) acc[n] = mfma16(a, frag_tr(zn, PK, ks * 32, n * 16, fr, fq), acc[n]);
  }
#pragma unroll
  for (int j = 0; j < 4; ++j) {
    const int pr = wid * 16 + fq * 4 + j, t = ci * 128 + pr;
    const float gb = p.l0_gb[g * 128 + pr];
#pragma unroll
    for (int n = 0; n < 8; ++n) {
      const int c = n * 16 + fr;
      const float u = bf2f(p.proj[(size_t)t * 4096 + 3072 + g * 128 + c]);
      p.cat[(size_t)t * 1536 + 1024 + g * 128 + c] = f2bf((acc[n][j] + gb) * u);
    }
  }
}
__device__ __forceinline__ void phase_mix_a(const P& p, LAS u16* lds) {
  for (int it = blockIdx.x; it < 384; it += gridDim.x) { if (it < 192) kv_item(p, it, lds); else gmlp_item(p, it - 192, lds); }
}

__device__ __forceinline__ void build_state(const P& p, LAS u16* bbuf, const float* S0, float w0, int cbase, int h, int dir, int c_lo, int c_hi, int c_ref, float lg128) {
  for (int i = threadIdx.x; i < 128 * 64; i += NTHR) {
    const int r = i >> 6, c = (i & 63) * 4;
    f32x4 a = {0.f, 0.f, 0.f, 0.f};
    if (S0) a = *(const f32x4*)(S0 + r * 256 + c) * w0;
    for (int cc = c_lo; cc < c_hi; ++cc) {
      const int e = dir == 0 ? (c_ref - 1 - cc) : (cc - c_ref - 1);
      const float w = __expf(lg128 * (float)e);
      a = a + *(const f32x4*)(p.part + ((size_t)((cbase + cc) * 4 + h) * 2 + dir) * 128 * 256 + r * 256 + c) * w;
    }
    u32x2 o; o[0] = pk2(a[0], a[1]); o[1] = pk2(a[2], a[3]);
    *(LAS u32x2*)(bbuf + r * PV + c) = o;
  }
}
__device__ __forceinline__ void ret_item(const P& p, int item, LAS u16* lds) {
  const int ci = item >> 2, h = item & 3, tid = threadIdx.x, wid = tid >> 6, lane = tid & 63, fr = lane & 15, fq = lane >> 4;
  int sb, lc, n;
  if (ci < 32) { sb = -1; lc = ci & 1; n = 2; } else { sb = (ci - 32) >> 3; lc = (ci - 32) & 7; n = 8; }
  const int cbase = ci - lc;
  const float lgf = log1pf(-exp2f(-p.l0_decay[h])), lgb = log1pf(-exp2f(-p.l0_decay[4 + h]));
  LAS u16* kbuf = lds; LAS u16* bbuf = lds + 128 * PK; LAS float* red = (LAS float*)(lds + 128 * PK + 128 * PV);
  const bool hasF = (sb >= 0) || lc > 0, hasB = (sb >= 0) || lc < n - 1;
  const u16* qg = p.proj + (size_t)ci * 128 * 4096 + h * 128;
  __syncthreads();
  tile_to_lds(p.proj + (size_t)ci * 128 * 4096 + 512 + h * 128, 4096, kbuf, PK, 128, 128);
  if (hasF) build_state(p, bbuf, sb >= 0 ? p.state + ((size_t)(sb * 2 + 0) * 4 + h) * 128 * 256 : nullptr, __expf(lgf * 128.f * (float)lc), cbase, h, 0, 0, lc, lc, lgf * 128.f);
  __syncthreads();
  {
    f32x4 s[8];
#pragma unroll
    for (int nn = 0; nn < 8; ++nn) s[nn] = (f32x4){0.f, 0.f, 0.f, 0.f};
#pragma unroll
    for (int ks = 0; ks < 4; ++ks) {
      const bf16x8 a = *(const bf16x8*)(qg + (size_t)(wid * 16 + fr) * 4096 + ks * 32 + fq * 8);
#pragma unroll
      for (int nn = 0; nn < 8; ++nn) s[nn] = mfma16(a, frag_row(kbuf, PK, nn * 16, ks * 32, fr, fq), s[nn]);
    }
    __syncthreads();
#pragma unroll
    for (int nn = 0; nn < 8; ++nn)
#pragma unroll
      for (int j = 0; j < 4; ++j) {
        const int i = wid * 16 + fq * 4 + j, jj = nn * 16 + fr, d = i - jj;
        const float w = d > 0 ? __expf((float)d * lgf) : (d < 0 ? __expf((float)(-d) * lgb) : 2.f);
        kbuf[i * PK + jj] = f2bf(s[nn][j] * w);
      }
  }
  const int m0 = (wid & 3) * 32, n0 = (wid >> 2) * 128;
  f32x4 acc[2][8];
#pragma unroll
  for (int m = 0; m < 2; ++m)
#pragma unroll
    for (int nn = 0; nn < 8; ++nn) acc[m][nn] = (f32x4){0.f, 0.f, 0.f, 0.f};
  const u16* qrow = qg + (size_t)(m0 + fr) * 4096 + fq * 8;
  if (hasF) {
#pragma unroll 1
    for (int ks = 0; ks < 4; ++ks) {
      const bf16x8 q0 = *(const bf16x8*)(qrow + ks * 32), q1 = *(const bf16x8*)(qrow + 16 * 4096 + ks * 32);
#pragma unroll
      for (int nn = 0; nn < 8; ++nn) {
        const bf16x8 b = frag_tr(bbuf, PV, ks * 32, n0 + nn * 16, fr, fq);
        acc[0][nn] = mfma16(q0, b, acc[0][nn]); acc[1][nn] = mfma16(q1, b, acc[1][nn]);
      }
    }
#pragma unroll
    for (int m = 0; m < 2; ++m)
#pragma unroll
      for (int j = 0; j < 4; ++j) {
        const int il = m0 + m * 16 + fq * 4 + j;
        const float sc = hasB ? __expf((float)(il + 1) * lgf - (float)(128 - il) * lgb) : __expf((float)(il + 1) * lgf);
#pragma unroll
        for (int nn = 0; nn < 8; ++nn) acc[m][nn][j] *= sc;
      }
  }
  if (hasB) {
    __syncthreads();
    build_state(p, bbuf, sb >= 0 ? p.state + ((size_t)(sb * 2 + 1) * 4 + h) * 128 * 256 : nullptr, __expf(lgb * 128.f * (float)(n - 1 - lc)), cbase, h, 1, lc + 1, n, lc, lgb * 128.f);
    __syncthreads();
#pragma unroll 1
    for (int ks = 0; ks < 4; ++ks) {
      const bf16x8 q0 = *(const bf16x8*)(qrow + ks * 32), q1 = *(const bf16x8*)(qrow + 16 * 4096 + ks * 32);
#pragma unroll
      for (int nn = 0; nn < 8; ++nn) {
        const bf16x8 b = frag_tr(bbuf, PV, ks * 32, n0 + nn * 16, fr, fq);
        acc[0][nn] = mfma16(q0, b, acc[0][nn]); acc[1][nn] = mfma16(q1, b, acc[1][nn]);
      }
    }
#pragma unroll
    for (int m = 0; m < 2; ++m)
#pragma unroll
      for (int j = 0; j < 4; ++j) {
        const int il = m0 + m * 16 + fq * 4 + j;
        const float sc = __expf((float)(128 - il) * lgb);
#pragma unroll
        for (int nn = 0; nn < 8; ++nn) acc[m][nn][j] *= sc;
      }
  }
  __syncthreads();
  tile_to_lds(p.proj + (size_t)ci * 128 * 4096 + 1024 + h * 256, 4096, bbuf, PV, 128, 256);
  __syncthreads();
#pragma unroll 1
  for (int ks = 0; ks < 4; ++ks) {
    const bf16x8 a0 = frag_row(kbuf, PK, m0, ks * 32, fr, fq), a1 = frag_row(kbuf, PK, m0 + 16, ks * 32, fr, fq);
#pragma unroll
    for (int nn = 0; nn < 8; ++nn) {
      const bf16x8 b = frag_tr(bbuf, PV, ks * 32, n0 + nn * 16, fr, fq);
      acc[0][nn] = mfma16(a0, b, acc[0][nn]); acc[1][nn] = mfma16(a1, b, acc[1][nn]);
    }
  }
#pragma unroll
  for (int m = 0; m < 2; ++m)
#pragma unroll
    for (int j = 0; j < 4; ++j) {
      float s = 0.f;
#pragma unroll
      for (int nn = 0; nn < 8; ++nn) s += acc[m][nn][j] * acc[m][nn][j];
      s += __shfl_xor(s, 1); s += __shfl_xor(s, 2); s += __shfl_xor(s, 4); s += __shfl_xor(s, 8);
      if (fr == 0) red[(wid >> 2) * 128 + m0 + m * 16 + fq * 4 + j] = s;
    }
  __syncthreads();
#pragma unroll
  for (int m = 0; m < 2; ++m)
#pragma unroll
    for (int j = 0; j < 4; ++j) {
      const int il = m0 + m * 16 + fq * 4 + j, t = ci * 128 + il;
      const float r = rsqrtf((red[il] + red[128 + il]) * (1.f / 256.f) + EPS);
#pragma unroll
      for (int nn = 0; nn < 8; ++nn) {
        const int dv = n0 + nn * 16 + fr;
        const float g = bf2f(p.proj[(size_t)t * 4096 + 2048 + h * 256 + dv]);
        p.cat[(size_t)t * 1536 + h * 256 + dv] = f2bf(acc[m][nn][j] * r * g);
      }
    }
}
__device__ __forceinline__ void state_item(const P& p, int item) {
  const int b = item >> 3, h = (item >> 1) & 3, dir = item & 1;
  const float w = __expf(128.f * log1pf(-exp2f(-p.l0_decay[dir * 4 + h])));
  const int c_old = dir == 0 ? 2 * b : 2 * b + 1, c_new = dir == 0 ? 2 * b + 1 : 2 * b;
  const float* A = p.part + ((size_t)(c_old * 4 + h) * 2 + dir) * 128 * 256;
  const float* B = p.part + ((size_t)(c_new * 4 + h) * 2 + dir) * 128 * 256;
  float* o = p.out + (size_t)NT * DM + ((size_t)(b * 2 + dir) * 4 + h) * 128 * 256;
  for (int i = threadIdx.x; i < 128 * 64; i += NTHR) *(f32x4*)(o + i * 4) = *(const f32x4*)(A + i * 4) * w + *(const f32x4*)(B + i * 4);
}
__device__ __forceinline__ void phase_mix_b(const P& p, LAS u16* lds) {
  for (int it = blockIdx.x; it < 320; it += gridDim.x) { if (it < 192) ret_item(p, it, lds); else state_item(p, it - 192); }
}

__device__ __forceinline__ void phase_conv(const P& p) {
  const u16* pj = p.proj;
  for (size_t i = (size_t)blockIdx.x * NTHR + threadIdx.x; i < (size_t)NT * 256; i += (size_t)gridDim.x * NTHR) {
    const int t = (int)(i >> 8), c4 = (int)(i & 255) * 4;
    const int seg = t < NPROMPT_T ? 256 : 64;
    const int pos = t < NPROMPT_T ? (t & 255) : ((t - NPROMPT_T) & 63);
    f32x4 xc[3];
#pragma unroll
    for (int d = 0; d < 3; ++d) {
      const int pp = pos + d - 1;
      if (pp < 0 || pp >= seg) { xc[d] = (f32x4){0.f, 0.f, 0.f, 0.f}; continue; }
      const u16* r = pj + (size_t)(t + d - 1) * 3072;
      const u32x2 a = *(const u32x2*)(r + 1024 + c4), b = *(const u32x2*)(r + 2048 + c4);
      xc[d][0] = __uint_as_float(a[0] << 16) * __uint_as_float(b[0] << 16);
      xc[d][1] = __uint_as_float(a[0] & 0xffff0000u) * __uint_as_float(b[0] & 0xffff0000u);
      xc[d][2] = __uint_as_float(a[1] << 16) * __uint_as_float(b[1] << 16);
      xc[d][3] = __uint_as_float(a[1] & 0xffff0000u) * __uint_as_float(b[1] & 0xffff0000u);
    }
    const f32x4 w0 = *(const f32x4*)(p.l1_conv + c4), w1 = *(const f32x4*)(p.l1_conv + 1024 + c4), w2 = *(const f32x4*)(p.l1_conv + 2048 + c4);
    const u32x2 bgv = *(const u32x2*)(pj + (size_t)t * 3072 + c4);
    f32x4 bg = {__uint_as_float(bgv[0] << 16), __uint_as_float(bgv[0] & 0xffff0000u), __uint_as_float(bgv[1] << 16), __uint_as_float(bgv[1] & 0xffff0000u)};
    const f32x4 y = bg * (w0 * xc[0] + w1 * xc[1] + w2 * xc[2]);
    u32x2 o; o[0] = pk2(y[0], y[1]); o[1] = pk2(y[2], y[3]);
    *(u32x2*)(p.cat + (size_t)t * 1024 + c4) = o;
  }
}


#define XB_TMO      128
#define XB_XCNT(j)  (256  + 64 * (j))
#define XB_XSUB(j)  (1280 + 64 * (j))
#define XB_XGEN(j)  (2304 + 64 * (j))
#define XB_TOP      3328
#define XB_TOPGEN   3392
#define XCD_BAR_WORDS 3456
#define XB_SPIN_CAP (1u << 18)
__device__ __forceinline__ unsigned xb_ld(unsigned* p)              { return __hip_atomic_load(p, __ATOMIC_RELAXED, __HIP_MEMORY_SCOPE_AGENT); }
__device__ __forceinline__ unsigned xb_add(unsigned* p, unsigned v) { return __hip_atomic_fetch_add(p, v, __ATOMIC_RELAXED, __HIP_MEMORY_SCOPE_AGENT); }
__device__ __forceinline__ unsigned xb_xcc_id() { return (unsigned)__builtin_amdgcn_s_getreg((3 << 11) | 20) & 0xFu; }
#define XB_SPIN(cond, bar) do { unsigned _sp = 0; while (cond) { __builtin_amdgcn_s_sleep(1); \
    if ((++_sp & 255u) == 0u) { if (xb_ld(&(bar)[XB_TMO])) break; if (_sp > XB_SPIN_CAP) { atomicAdd(&(bar)[XB_TMO], 1u); break; } } } } while (0)
struct XcdBarrier { unsigned* bar; unsigned x; volatile __attribute__((address_space(3))) unsigned* st; };
__device__ __forceinline__ XcdBarrier xcd_barrier_post(unsigned* bar, volatile __attribute__((address_space(3))) unsigned* st) {
  XcdBarrier b; b.bar = bar; b.x = xb_xcc_id(); b.st = st;
  if (threadIdx.x == 0) (void)xb_add(&bar[XB_XCNT(b.x)], 1u);
  return b;
}
__device__ __forceinline__ void xcd_barrier_complete(unsigned* bar, unsigned x, unsigned& nloc, unsigned& nx) {
  const unsigned G = gridDim.x * gridDim.y * gridDim.z;
  unsigned sum, cnt, mine, sp = 0u;
  for (;;) {
    sum = 0u; cnt = 0u; mine = 0u;
#pragma unroll
    for (unsigned j = 0; j < 16; ++j) { const unsigned c = xb_ld(&bar[XB_XCNT(j)]); sum += c; cnt += (c > 0u) ? 1u : 0u; mine = (j == x) ? c : mine; }
    if (sum == G) break;
    __builtin_amdgcn_s_sleep(1);
    if ((++sp & 255u) == 0u) { if (xb_ld(&bar[XB_TMO])) break; if (sp > XB_SPIN_CAP) { atomicAdd(&bar[XB_TMO], 1u); break; } }
  }
  nloc = mine > 0u ? mine : 1u; nx = cnt > 0u ? cnt : 1u;
}
__device__ __forceinline__ void xcd_barrier(const XcdBarrier& b) {
  asm volatile("s_waitcnt vmcnt(0)" ::: "memory");
  __syncthreads();
  if (threadIdx.x == 0) {
    unsigned* bar = b.bar;
    __builtin_amdgcn_s_waitcnt(0);
    unsigned nloc = b.st[0], nx = b.st[1];
    if (nloc == 0u) { xcd_barrier_complete(bar, b.x, nloc, nx); b.st[0] = nloc; b.st[1] = nx; }
    const unsigned old = xb_add(&bar[XB_XSUB(b.x)], 1u);
    const unsigned gen = old / nloc;
    if (old + 1u == (gen + 1u) * nloc) {
      __builtin_amdgcn_fence(__ATOMIC_RELEASE, "agent");
      asm volatile("s_waitcnt vmcnt(0)" ::: "memory");
      const unsigned og = xb_add(&bar[XB_TOP], 1u);
      const unsigned tg = og / nx;
      if (og + 1u == (tg + 1u) * nx) xb_add(&bar[XB_TOPGEN], 1u);
      else XB_SPIN(xb_ld(&bar[XB_TOPGEN]) == tg, bar);
      __builtin_amdgcn_fence(__ATOMIC_ACQUIRE, "agent");
      xb_add(&bar[XB_XGEN(b.x)], 1u);
      asm volatile("s_waitcnt vmcnt(0)" ::: "memory");
    } else {
      XB_SPIN(xb_ld(&bar[XB_XGEN(b.x)]) == gen, bar);
      __builtin_amdgcn_fence(__ATOMIC_ACQUIRE, "agent");
      asm volatile("s_waitcnt vmcnt(0)" ::: "memory");
    }
  }
  __syncthreads();
}

constexpr int NPHASE = 17;
#ifndef REPMASK
#define REPMASK 0
#endif
__global__ void __launch_bounds__(NTHR) mega(P p, int lo, int hi) {
  extern __shared__ __attribute__((aligned(16))) unsigned char smem[];
  float* lds = (float*)smem;
  cg::grid_group grid = cg::this_grid();
  volatile LAS unsigned* xst = (volatile LAS unsigned*)(smem + 131072);
  if (threadIdx.x == 0) { xst[0] = 0u; xst[1] = 0u; }
  __syncthreads();
  const XcdBarrier xb = xcd_barrier_post(p.bar, xst);
  if (hi < 0) grid.sync();
  const float* m0 = p.mod; const float* m1 = p.mod + 3 * 6144;
#define PH(n, ...) if (lo <= (n) && (n) < hi) { if ((n) > lo) xcd_barrier(xb); __VA_ARGS__ if ((REPMASK >> (n)) & 1) { xcd_barrier(xb); __VA_ARGS__ } }
  PH(0, phase_prep(p, lds);)
  PH(1, { NormArgs a{p.x_prompt, p.x_sample, nullptr, nullptr, nullptr, nullptr, p.l0_norm1, m0 + 0, m0 + 1024, p.hA, nullptr}; phase_norm(a); })
  PH(2, { EpiProj0 e{p.proj}; phase_gemm(p.hA, p.wt0_in, NT, 4096, 1024, 1, e, lds); })
  PH(3, phase_mix_a(p, (LAS u16*)smem);)
  PH(4, phase_mix_b(p, (LAS u16*)smem);)
  PH(5, { EpiPart e{p.part}; phase_gemm(p.cat, p.wt0_out, NT, 1024, 1536, 2, e, lds); })
  PH(6, { NormArgs a{p.x_prompt, p.x_sample, p.part, p.part + (size_t)NT * DM, m0 + 2048, p.xres, p.l0_norm2, m0 + 3072, m0 + 4096, p.hA, nullptr}; phase_norm(a); })
  PH(7, { EpiRelu2 e{p.proj}; phase_gemm(p.hA, p.wt0_f1, NT, 4096, 1024, 1, e, lds); })
  PH(8, { EpiPart e{p.part}; phase_gemm(p.proj, p.wt0_f2, NT, 1024, 4096, 2, e, lds); })
  PH(9, { NormArgs a{p.xres, p.xres + (size_t)NPROMPT_T * DM, p.part, p.part + (size_t)NT * DM, m0 + 5120, p.xres, p.l1_norm1, m1 + 0, m1 + 1024, p.hA, nullptr}; phase_norm(a); })
  PH(10, { EpiPlain e{p.proj, 3072}; phase_gemm(p.hA, p.wt1_in, NT, 3072, 1024, 1, e, lds); })
  PH(11, phase_conv(p);)
  PH(12, { EpiPart e{p.part}; phase_gemm(p.cat, p.wt1_out, NT, 1024, 1024, 2, e, lds); })
  PH(13, { NormArgs a{p.xres, p.xres + (size_t)NPROMPT_T * DM, p.part, p.part + (size_t)NT * DM, m1 + 2048, p.xres, p.l1_norm2, m1 + 3072, m1 + 4096, p.hA, nullptr}; phase_norm(a); })
  PH(14, { EpiRelu2 e{p.proj}; phase_gemm(p.hA, p.wt1_f1, NT, 4096, 1024, 1, e, lds); })
  PH(15, { EpiPart e{p.part}; phase_gemm(p.proj, p.wt1_f2, NT, 1024, 4096, 2, e, lds); })
  PH(16, { NormArgs a{p.xres, p.xres + (size_t)NPROMPT_T * DM, p.part, p.part + (size_t)NT * DM, m1 + 5120, nullptr, p.final_norm, nullptr, nullptr, nullptr, p.out}; phase_norm(a); })
#undef PH
}

constexpr size_t LDS_BYTES = 131072 + 256;
constexpr bool ONE_LAUNCH = true;

extern "C" void kernel_launch(void* const* d_in, const int* in_sizes, int n_in, void* d_out, int out_size, void* d_ws, size_t ws_size, hipStream_t stream) {
  static int grid_blocks = 0;
  if (!grid_blocks) {
    hipFuncSetAttribute((const void*)mega, hipFuncAttributeMaxDynamicSharedMemorySize, (int)LDS_BYTES);
    int dev = 0, cus = 0, per_cu = 0;
    hipGetDevice(&dev);
    hipDeviceGetAttribute(&cus, hipDeviceAttributeMultiprocessorCount, dev);
    hipOccupancyMaxActiveBlocksPerMultiprocessor(&per_cu, mega, NTHR, LDS_BYTES);
    if (per_cu < 1) per_cu = 1;
    if (per_cu > 1) per_cu = 1;
    grid_blocks = cus * per_cu;
  }
  P p{};
  const float* const* in = (const float* const*)d_in;
  p.x_prompt = in[0]; p.x_sample = in[1]; p.state = in[2]; p.c = in[3]; p.c_ctx = in[4];
  p.l0_norm1 = in[5]; p.l0_w_in = in[6]; p.l0_decay = in[7]; p.l0_gws = in[8]; p.l0_gb = in[9]; p.l0_w_out = in[10]; p.l0_norm2 = in[11];
  p.l0_w_mod = in[12]; p.l0_b_mod = in[13]; p.l0_f1 = in[14]; p.l0_f2 = in[15];
  p.l1_norm1 = in[16]; p.l1_w_in = in[17]; p.l1_conv = in[18]; p.l1_w_out = in[19]; p.l1_norm2 = in[20]; p.l1_w_mod = in[21]; p.l1_b_mod = in[22];
  p.l1_f1 = in[23]; p.l1_f2 = in[24]; p.final_norm = in[25];
  p.out = (float*)d_out;
  unsigned char* w = (unsigned char*)d_ws; size_t off = 0;
  auto take = [&](size_t bytes) { void* r = w + off; off += (bytes + 255) & ~(size_t)255; return r; };
  p.wt0_in = (u16*)take((size_t)4096 * 1024 * 2); p.wt0_out = (u16*)take((size_t)1024 * 1536 * 2);
  p.wt0_f1 = (u16*)take((size_t)4096 * 1024 * 2); p.wt0_f2 = (u16*)take((size_t)4096 * 1024 * 2);
  p.wt1_in = (u16*)take((size_t)3072 * 1024 * 2); p.wt1_out = (u16*)take((size_t)1024 * 1024 * 2);
  p.wt1_f1 = (u16*)take((size_t)4096 * 1024 * 2); p.wt1_f2 = (u16*)take((size_t)4096 * 1024 * 2);
  p.mod = (float*)take((size_t)2 * 3 * 6144 * 4);
  p.hA = (u16*)take((size_t)NT * 1024 * 2);
  p.proj = (u16*)take((size_t)NT * 4096 * 2);
  p.cat = (u16*)take((size_t)NT * 1536 * 2);
  p.part = (float*)take((size_t)2 * NT * 1024 * 4);
  p.xres = (float*)take((size_t)NT * 1024 * 4);
  p.bar = (unsigned*)take((size_t)XCD_BAR_WORDS * 4);
  hipMemsetAsync(p.bar, 0, (size_t)XCD_BAR_WORDS * 4, stream);
  if (ONE_LAUNCH) {
    int lo = 0, hi = NPHASE; void* args[] = {&p, &lo, &hi};
    hipError_t e = hipLaunchCooperativeKernel((void*)mega, dim3(grid_blocks), dim3(NTHR), args, LDS_BYTES, stream);
    if (e != hipSuccess) fprintf(stderr, "cooperative launch failed: %s (grid %d)\n", hipGetErrorString(e), grid_blocks);
  } else {
    for (int ph = 0; ph < NPHASE; ++ph) hipLaunchKernelGGL(mega, dim3(grid_blocks), dim3(NTHR), LDS_BYTES, stream, p, ph, ph + 1);
  }
}
```

```cpp
#include <hip/hip_runtime.h>
#include <hip/hip_cooperative_groups.h>
#include <cstdio>
namespace cg = cooperative_groups;

typedef unsigned short u16;
typedef float f32x4 __attribute__((ext_vector_type(4)));
typedef unsigned u32x4 __attribute__((ext_vector_type(4)));
typedef unsigned u32x2 __attribute__((ext_vector_type(2)));

constexpr int NT = 6144, DM = 1024, NPROMPT_T = 4096;
constexpr float EPS = 1e-6f;
constexpr int NTHR = 512;

__device__ __forceinline__ float bf2f(u16 b) { return __uint_as_float(((unsigned)b) << 16); }
typedef float f32x2 __attribute__((ext_vector_type(2)));
typedef __bf16 hbf16x2 __attribute__((ext_vector_type(2)));
__device__ __forceinline__ unsigned pk2(float a, float b) { const f32x2 v = {a, b}; const hbf16x2 r = __builtin_convertvector(v, hbf16x2); return __builtin_bit_cast(unsigned, r); }
__device__ __forceinline__ u16 f2bf(float f) { return (u16)(pk2(f, 0.f) & 0xffffu); }
__device__ __forceinline__ float silu_f(float x) { return x * __builtin_amdgcn_rcpf(1.f + __expf(-x)); }
__device__ __forceinline__ float gelu_f(float x) { const float u = -1.5957691216057308f * (x + 0.044715f * x * x * x); return x * __builtin_amdgcn_rcpf(1.f + __expf(u)); }
__device__ __forceinline__ int cond_of(int t) { return t < NPROMPT_T ? 0 : 1 + ((t - NPROMPT_T) >> 10); }
__device__ __forceinline__ float wave_sum(float v) {
#pragma unroll
  for (int o = 32; o > 0; o >>= 1) v += __shfl_xor(v, o);
  return v;
}

struct P {
  const float *x_prompt, *x_sample, *state, *c, *c_ctx;
  const float *l0_norm1, *l0_w_in, *l0_decay, *l0_gws, *l0_gb, *l0_w_out, *l0_norm2, *l0_w_mod, *l0_b_mod, *l0_f1, *l0_f2;
  const float *l1_norm1, *l1_w_in, *l1_conv, *l1_w_out, *l1_norm2, *l1_w_mod, *l1_b_mod, *l1_f1, *l1_f2, *final_norm;
  float* out;
  u16 *wt0_in, *wt0_out, *wt0_f1, *wt0_f2, *wt1_in, *wt1_out, *wt1_f1, *wt1_f2;
  float* mod;
  u16* hA;
  u16* proj;
  u16* cat;
  float* part;
  float* xres;
  unsigned* bar;
};

__device__ __forceinline__ void transpose_tile(const float* __restrict__ W, int K, int N, u16* __restrict__ Wt, int tile, float* lds) {
  const int tn = N / 256; const int k0 = (tile / tn) * 64, n0 = (tile % tn) * 256;
  const int tid = threadIdx.x;
  float (*T)[257] = (float (*)[257])lds;
  __syncthreads();
  {
    const int r = tid >> 6, c4 = (tid & 63) * 4;
    f32x4 v[8];
#pragma unroll
    for (int i = 0; i < 8; ++i) v[i] = *(const f32x4*)(W + (size_t)(k0 + r + 8 * i) * N + n0 + c4);
#pragma unroll
    for (int i = 0; i < 8; ++i) { T[r + 8 * i][c4 + 0] = v[i][0]; T[r + 8 * i][c4 + 1] = v[i][1]; T[r + 8 * i][c4 + 2] = v[i][2]; T[r + 8 * i][c4 + 3] = v[i][3]; }
  }
  __syncthreads();
  {
    const int kk = (tid & 7) * 8;
#pragma unroll
    for (int ps = 0; ps < 4; ++ps) {
      const int nn = (tid >> 3) + 64 * ps;
      u32x4 o;
      o[0] = pk2(T[kk + 0][nn], T[kk + 1][nn]); o[1] = pk2(T[kk + 2][nn], T[kk + 3][nn]);
      o[2] = pk2(T[kk + 4][nn], T[kk + 5][nn]); o[3] = pk2(T[kk + 6][nn], T[kk + 7][nn]);
      *(u32x4*)(Wt + (size_t)(n0 + nn) * K + k0 + kk) = o;
    }
  }
}

__device__ __forceinline__ void adaln_item(const P& p, int item, float* lds) {
  const int l = item / 96, n0 = (item % 96) * 64;
  const float* W = l ? p.l1_w_mod : p.l0_w_mod; const float* B = l ? p.l1_b_mod : p.l0_b_mod;
  const int tid = threadIdx.x;
  float* sc = lds;
  float* red = lds + 3072;
  __syncthreads();
  for (int i = tid; i < 3072; i += NTHR) {
    const int c = i >> 10, k = i & 1023;
    const float v = c == 0 ? p.c_ctx[k] : p.c[(c - 1) * 1024 + k];
    sc[i] = silu_f(v);
  }
  __syncthreads();
  const int cg4 = tid & 15, rg = tid >> 4;
  float acc[3][4] = {};
#pragma unroll 8
  for (int it = 0; it < 32; ++it) {
    const int k = it * 32 + rg;
    const f32x4 w = *(const f32x4*)(W + (size_t)k * 6144 + n0 + cg4 * 4);
#pragma unroll
    for (int c = 0; c < 3; ++c) { const float s = sc[c * 1024 + k];
#pragma unroll
      for (int e = 0; e < 4; ++e) acc[c][e] += s * w[e]; }
  }
#pragma unroll
  for (int c = 0; c < 3; ++c)
#pragma unroll
    for (int e = 0; e < 4; ++e) red[(rg * 3 + c) * 64 + cg4 * 4 + e] = acc[c][e];
  __syncthreads();
  if (tid < 192) {
    const int c = tid >> 6, n = tid & 63; float s = B[n0 + n];
    for (int r = 0; r < 32; ++r) s += red[(r * 3 + c) * 64 + n];
    p.mod[(size_t)(l * 3 + c) * 6144 + n0 + n] = s;
  }
}

__device__ __forceinline__ void phase_prep(const P& p, float* lds) {
  for (int it = blockIdx.x; it < 96 + 256; it += gridDim.x) {
    if (it < 96) adaln_item(p, it, lds); else transpose_tile(p.l0_w_in, 1024, 4096, p.wt0_in, it - 96, lds);
  }
}
__device__ __forceinline__ void phase_prep2(const P& p, float* lds, int first, int nblk) {
  const int t1 = 96, t2 = 256, t3 = 256, t4 = 192, t5 = 64, t6 = 256, t7 = 256;
  const int total = 96 + t1 + t2 + t3 + t4 + t5 + t6 + t7;
  for (int it = (int)blockIdx.x - first; it < total; it += nblk) {
    int i = it;
    if (i < 96) { adaln_item(p, 96 + i, lds); continue; } i -= 96;
    if (i < t1) { transpose_tile(p.l0_w_out, 1536, 1024, p.wt0_out, i, lds); continue; } i -= t1;
    if (i < t2) { transpose_tile(p.l0_f1, 1024, 4096, p.wt0_f1, i, lds); continue; } i -= t2;
    if (i < t3) { transpose_tile(p.l0_f2, 4096, 1024, p.wt0_f2, i, lds); continue; } i -= t3;
    if (i < t4) { transpose_tile(p.l1_w_in, 1024, 3072, p.wt1_in, i, lds); continue; } i -= t4;
    if (i < t5) { transpose_tile(p.l1_w_out, 1024, 1024, p.wt1_out, i, lds); continue; } i -= t5;
    if (i < t6) { transpose_tile(p.l1_f1, 1024, 4096, p.wt1_f1, i, lds); continue; } i -= t6;
    transpose_tile(p.l1_f2, 4096, 1024, p.wt1_f2, i, lds);
  }
}

struct NormArgs {
  const float* xin0; const float* xin1;
  const float* p0; const float* p1; const float* gate;
  float* xout; const float* nw; const float* sh; const float* sc;
  u16* hout; float* fout;
};
__device__ __forceinline__ void phase_norm(const NormArgs& a) {
  const int wid = threadIdx.x >> 6, lane = threadIdx.x & 63;
  for (int t = blockIdx.x * 8 + wid; t < NT; t += gridDim.x * 8) {
    const int c = cond_of(t);
    const float* xr = t < NPROMPT_T ? a.xin0 + (size_t)t * DM : a.xin1 + (size_t)(t - NPROMPT_T) * DM;
    f32x4 x[4]; float ss = 0.f;
#pragma unroll
    for (int i = 0; i < 4; ++i) {
      const int col = lane * 4 + 256 * i;
      x[i] = *(const f32x4*)(xr + col);
      if (a.p0) {
        const f32x4 q0 = *(const f32x4*)(a.p0 + (size_t)t * DM + col), q1 = *(const f32x4*)(a.p1 + (size_t)t * DM + col);
        const f32x4 g = *(const f32x4*)(a.gate + (size_t)c * 6144 + col);
        x[i] = x[i] + g * (q0 + q1);
      }
      if (a.xout) *(f32x4*)(a.xout + (size_t)t * DM + col) = x[i];
      ss += x[i][0] * x[i][0] + x[i][1] * x[i][1] + x[i][2] * x[i][2] + x[i][3] * x[i][3];
    }
    ss = wave_sum(ss);
    const float r = rsqrtf(ss * (1.f / 1024.f) + EPS);
#pragma unroll
    for (int i = 0; i < 4; ++i) {
      const int col = lane * 4 + 256 * i;
      const f32x4 w = *(const f32x4*)(a.nw + col);
      f32x4 y = x[i] * r * w;
      if (a.fout) *(f32x4*)(a.fout + (size_t)t * DM + col) = y;
      if (a.hout) {
        const f32x4 sh = *(const f32x4*)(a.sh + (size_t)c * 6144 + col), sc = *(const f32x4*)(a.sc + (size_t)c * 6144 + col);
        y = y * (1.f + sc) + sh;
        u32x2 o; o[0] = pk2(y[0], y[1]); o[1] = pk2(y[2], y[3]);
        *(u32x2*)(a.hout + (size_t)t * DM + col) = o;
      }
    }
  }
}

struct EpiProj0 {
  u16* O;
  __device__ __forceinline__ void store8(int row, int col, f32x4 v0, f32x4 v1, int) const {
    if (col >= 3072) {
#pragma unroll
      for (int e = 0; e < 4; ++e) { v0[e] = gelu_f(v0[e]); v1[e] = gelu_f(v1[e]); }
    } else if (col >= 2048) {
#pragma unroll
      for (int e = 0; e < 4; ++e) { v0[e] = silu_f(v0[e]); v1[e] = silu_f(v1[e]); }
    } else if (col >= 512 && col < 1024) { v0 = v0 * 0.08838834764831845f; v1 = v1 * 0.08838834764831845f; }
    u32x4 o; o[0] = pk2(v0[0], v0[1]); o[1] = pk2(v0[2], v0[3]); o[2] = pk2(v1[0], v1[1]); o[3] = pk2(v1[2], v1[3]);
    *(u32x4*)(O + (size_t)row * 4096 + col) = o;
  }
  __device__ __forceinline__ void store4(int row, int col, f32x4 v, int) const {
    if (col >= 3072) { v[0] = gelu_f(v[0]); v[1] = gelu_f(v[1]); v[2] = gelu_f(v[2]); v[3] = gelu_f(v[3]); }
    else if (col >= 2048) { v[0] = silu_f(v[0]); v[1] = silu_f(v[1]); v[2] = silu_f(v[2]); v[3] = silu_f(v[3]); }
    else if (col >= 512 && col < 1024) v = v * 0.08838834764831845f;
    u32x2 o; o[0] = pk2(v[0], v[1]); o[1] = pk2(v[2], v[3]);
    *(u32x2*)(O + (size_t)row * 4096 + col) = o;
  }
};
struct EpiPart {
  float* Pp;
  __device__ __forceinline__ void store8(int row, int col, f32x4 v0, f32x4 v1, int ks) const { float* q = Pp + ((size_t)ks * NT + row) * DM + col; *(f32x4*)q = v0; *(f32x4*)(q + 4) = v1; }
  __device__ __forceinline__ void store4(int row, int col, f32x4 v, int ks) const { *(f32x4*)(Pp + ((size_t)ks * NT + row) * DM + col) = v; }
};
struct EpiRelu2 {
  u16* O;
  __device__ __forceinline__ void store8(int row, int col, f32x4 v0, f32x4 v1, int) const {
#pragma unroll
    for (int e = 0; e < 4; ++e) { const float r0 = fmaxf(v0[e], 0.f), r1 = fmaxf(v1[e], 0.f); v0[e] = r0 * r0; v1[e] = r1 * r1; }
    u32x4 o; o[0] = pk2(v0[0], v0[1]); o[1] = pk2(v0[2], v0[3]); o[2] = pk2(v1[0], v1[1]); o[3] = pk2(v1[2], v1[3]);
    *(u32x4*)(O + (size_t)row * 4096 + col) = o;
  }
  __device__ __forceinline__ void store4(int row, int col, f32x4 v, int) const {
#pragma unroll
    for (int e = 0; e < 4; ++e) { const float r = fmaxf(v[e], 0.f); v[e] = r * r; }
    u32x2 o; o[0] = pk2(v[0], v[1]); o[1] = pk2(v[2], v[3]);
    *(u32x2*)(O + (size_t)row * 4096 + col) = o;
  }
};
struct EpiPlain {
  u16* O; int ld;
  __device__ __forceinline__ void store8(int row, int col, f32x4 v0, f32x4 v1, int) const {
    u32x4 o; o[0] = pk2(v0[0], v0[1]); o[1] = pk2(v0[2], v0[3]); o[2] = pk2(v1[0], v1[1]); o[3] = pk2(v1[2], v1[3]);
    *(u32x4*)(O + (size_t)row * ld + col) = o;
  }
  __device__ __forceinline__ void store4(int row, int col, f32x4 v, int) const {
    u32x2 o; o[0] = pk2(v[0], v[1]); o[1] = pk2(v[2], v[3]);
    *(u32x2*)(O + (size_t)row * ld + col) = o;
  }
};

template <class Epi>
__device__ __forceinline__ void phase_gemm_naive(const u16* __restrict__ A, const u16* __restrict__ Bt, int M, int N, int K, int ksplit, const Epi& E, float* lds) {
  float (*As)[33] = (float (*)[33])lds;
  float (*Bs)[33] = (float (*)[33])(lds + 128 * 33);
  const int tm = M / 128, tn = N / 64, total = tm * tn * ksplit, kper = K / ksplit;
  const int tid = threadIdx.x, r = tid >> 2, cq = tid & 3;
  for (int it = blockIdx.x; it < total; it += gridDim.x) {
    const int ks = it / (tm * tn), rem = it % (tm * tn), m0 = (rem / tn) * 128, n0 = (rem % tn) * 64;
    float acc[4][4] = {};
    for (int k0 = ks * kper; k0 < (ks + 1) * kper; k0 += 32) {
      __syncthreads();
      {
        const int kc = (tid & 3) * 8;
        const u32x4 va = *(const u32x4*)(A + (size_t)(m0 + r) * K + k0 + kc);
#pragma unroll
        for (int e = 0; e < 4; ++e) { As[r][kc + 2 * e] = __uint_as_float(va[e] << 16); As[r][kc + 2 * e + 1] = __uint_as_float(va[e] & 0xffff0000u); }
        if (tid < 256) {
          const u32x4 vb = *(const u32x4*)(Bt + (size_t)(n0 + r) * K + k0 + kc);
#pragma unroll
          for (int e = 0; e < 4; ++e) { Bs[r][kc + 2 * e] = __uint_as_float(vb[e] << 16); Bs[r][kc + 2 * e + 1] = __uint_as_float(vb[e] & 0xffff0000u); }
        }
      }
      __syncthreads();
#pragma unroll 4
      for (int k = 0; k < 32; ++k) {
        const float a = As[r][k];
#pragma unroll
        for (int jj = 0; jj < 4; ++jj)
#pragma unroll
          for (int e = 0; e < 4; ++e) acc[jj][e] += a * Bs[cq * 4 + 16 * jj + e][k];
      }
    }
#pragma unroll
    for (int jj = 0; jj < 4; ++jj) { f32x4 v = {acc[jj][0], acc[jj][1], acc[jj][2], acc[jj][3]}; E.store4(m0 + r, n0 + cq * 4 + 16 * jj, v, ks); }
  }
}


namespace pg8 {
#define PG8_LAS __attribute__((address_space(3)))
typedef short bf16x8 __attribute__((ext_vector_type(8)));
constexpr int BM = 256, BK = 64, HALF = 128, HTB = HALF * BK * 2, STAGE_BYTES = 8 * HTB, NXCD = 8, WGM = 8;
__device__ __forceinline__ int lds_byte(int r, int c) { const int st = (r >> 4) * 2 + (c >> 5), rr = r & 15, cc = c & 31, ob = rr * 64 + cc * 2; return st * 1024 + (ob ^ (((ob >> 9) & 1) << 5)); }
__device__ __forceinline__ int perm32(int rho) { const int n = rho >> 4, i = rho & 15; return 8 * (i >> 2) + 4 * n + (i & 3); }
__device__ __forceinline__ void stage_rc(int b, int& R, int& C) { const int st = b / 1024, sb = b % 1024, swz = sb ^ (((sb >> 9) & 1) << 5); R = (st >> 1) * 16 + swz / 64; C = (st & 1) * 32 + (swz % 64) / 2; }
struct Unit { int pm, pn, ks; };
struct Gemm { const u16* A; const u16* Bt; int M, N, K, ksplit; };
struct Order {
  int nM, nN, ntile, nwg, G, c;
  __device__ void init(int M, int N, int ksplit, int G_, int c_) { nM = M / BM; nN = N / BM; ntile = nM * nN; nwg = ntile * ksplit; G = G_; c = c_; }
  __device__ bool next(int i, Unit& u) const {
    const int L = i * G + c; if (L >= nwg) return false;
    u.ks = L / ntile; int wgid = L % ntile;
    { const int q = ntile / NXCD, r = ntile % NXCD, xcd = wgid % NXCD, off = wgid / NXCD; wgid = (xcd < r ? xcd * (q + 1) : r * (q + 1) + (xcd - r) * q) + off; }
    const int nig = WGM * nN, gid = wgid / nig, fm = gid * WGM, gsz = (nM - fm) < WGM ? (nM - fm) : WGM;
    u.pm = fm + ((wgid % nig) % gsz); u.pn = (wgid % nig) / gsz; return true;
  }
};
template <class Epi>
__device__ __forceinline__ void run_epi(const Epi& E, const f32x4 (&acc)[2][2][4][2], const Unit& u, int wr, int wc, int fr, int fq) {
  const int row0 = u.pm * BM + wr * 64 + fr, col0 = u.pn * BM + wc * 32 + 8 * fq;
#pragma unroll
  for (int ai = 0; ai < 2; ++ai)
#pragma unroll
    for (int m = 0; m < 4; ++m)
#pragma unroll
      for (int bj = 0; bj < 2; ++bj) E.store8(row0 + ai * HALF + m * 16, col0 + bj * HALF, acc[ai][bj][m][0], acc[ai][bj][m][1], u.ks);
}
template <class Epi>
__device__ __forceinline__ void gemm_phase(PG8_LAS unsigned char* lds, const Gemm g, const Order& S, const Epi& E) {
  const int tid = threadIdx.x, wid = __builtin_amdgcn_readfirstlane(tid >> 6), lane = tid & 63, wr = wid >> 2, wc = wid & 3, fr = lane & 15, fq = lane >> 4;
  const int K = g.K, kper = g.K / g.ksplit, nt = kper / BK;
  unsigned voffA[2], voffB[2];
#pragma unroll
  for (int i = 0; i < 2; ++i) { int R, C; stage_rc(tid * 16 + i * 8192, R, C); const int Rb = (R & ~31) + perm32(R & 31);
    voffA[i] = (unsigned)(R * K + C) * 2u; voffB[i] = (unsigned)(Rb * K + C) * 2u; }
  const size_t kstep = (size_t)(BK * 2);
  const size_t hstep = (size_t)HALF * K * 2;
  const size_t tstep = 2 * hstep;
  const size_t ksbytes = (size_t)kper * 2;
  const unsigned ldsw = (unsigned)wid * 1024u;
  const int aoff = lds_byte(wr * 64 + fr, fq * 8), boff = lds_byte(wc * 32 + fr, fq * 8);
#define PG8_SA(b, h) (((b) * 2 + (h)) * HTB)
#define PG8_SB(b, h) ((4 + (b) * 2 + (h)) * HTB)
#define PG8_STAGE(bufoff, gbase, voff) do { _Pragma("unroll") for (int _i = 0; _i < 2; ++_i) \
    __builtin_amdgcn_global_load_lds((const unsigned*)((const char*)(gbase) + (voff)[_i]), (PG8_LAS unsigned*)(lds + (bufoff) + ldsw + _i * 8192), 16, 0, 0); } while (0)
#define PG8_LDA(dst, b, h) do { _Pragma("unroll") for (int m = 0; m < 4; ++m) _Pragma("unroll") for (int k = 0; k < 2; ++k) dst[m][k] = *(const PG8_LAS bf16x8*)(lds + PG8_SA(b, h) + aoff + m * 2048 + k * 1024); } while (0)
#define PG8_LDB(dst, b, h) do { _Pragma("unroll") for (int n = 0; n < 2; ++n) _Pragma("unroll") for (int k = 0; k < 2; ++k) dst[n][k] = *(const PG8_LAS bf16x8*)(lds + PG8_SB(b, h) + boff + n * 2048 + k * 1024); } while (0)
#define PG8_MMA(ai, bj, At, Bt) do { __builtin_amdgcn_s_setprio(1); _Pragma("unroll") for (int m = 0; m < 4; ++m) _Pragma("unroll") for (int n = 0; n < 2; ++n) _Pragma("unroll") for (int k = 0; k < 2; ++k) \
    acc[ai][bj][m][n] = __builtin_amdgcn_mfma_f32_16x16x32_bf16(Bt[n][k], At[m][k], acc[ai][bj][m][n], 0, 0, 0); __builtin_amdgcn_s_setprio(0); } while (0)
#define PG8_WAIT_V(n) asm volatile("s_waitcnt vmcnt(" #n ")" ::: "memory")
#define PG8_WAIT_L(n) asm volatile("s_waitcnt lgkmcnt(" #n ")" ::: "memory")
#define PG8_BAR __builtin_amdgcn_s_barrier()
#define PG8_SCHED __builtin_amdgcn_sched_barrier(0)
  Unit cur, nxt; int ui = 0;
  if (!S.next(0, cur)) return;
  f32x4 acc[2][2][4][2];
#pragma unroll
  for (int a = 0; a < 2; ++a)
#pragma unroll
    for (int b = 0; b < 2; ++b)
#pragma unroll
      for (int m = 0; m < 4; ++m)
#pragma unroll
        for (int n = 0; n < 2; ++n) acc[a][b][m][n] = (f32x4){0.f, 0.f, 0.f, 0.f};
  bf16x8 At[4][2], B0[2][2], B1[2][2];
  const char* cA = (const char*)g.A + (size_t)cur.pm * tstep + (size_t)cur.ks * ksbytes; const char* cB = (const char*)g.Bt + (size_t)cur.pn * tstep + (size_t)cur.ks * ksbytes;
  PG8_STAGE(PG8_SB(0, 0), cB, voffB); PG8_STAGE(PG8_SA(0, 0), cA, voffA); PG8_STAGE(PG8_SB(0, 1), cB + hstep, voffB); PG8_STAGE(PG8_SA(0, 1), cA + hstep, voffA);
  if (wr == 1) PG8_BAR;
  PG8_WAIT_V(4); PG8_BAR;
  PG8_STAGE(PG8_SB(1, 0), cB + kstep, voffB); PG8_STAGE(PG8_SA(1, 0), cA + kstep, voffA); PG8_STAGE(PG8_SB(1, 1), cB + hstep + kstep, voffB);
  PG8_WAIT_V(6); PG8_BAR;
  for (;;) {
    const bool has_next = S.next(ui + 1, nxt);
    const char* nA = has_next ? (const char*)g.A + (size_t)nxt.pm * tstep + (size_t)nxt.ks * ksbytes : cA; const char* nB = has_next ? (const char*)g.Bt + (size_t)nxt.pn * tstep + (size_t)nxt.ks * ksbytes : cB;
    for (int t = 0; t < nt; t += 2) {
      const bool last = (t == nt - 2);
      const char* a1 = cA + (size_t)(t + 1) * kstep;
      const char* a2 = last ? nA : cA + (size_t)(t + 2) * kstep; const char* b2 = last ? nB : cB + (size_t)(t + 2) * kstep;
      const char* a3 = a2 + kstep; const char* b3 = b2 + kstep;
      PG8_LDB(B0, 0, 0); PG8_SCHED; PG8_LDA(At, 0, 0); PG8_STAGE(PG8_SA(1, 1), a1 + hstep, voffA);
      PG8_WAIT_L(8); PG8_BAR; PG8_WAIT_L(0); PG8_MMA(0, 0, At, B0); PG8_BAR; PG8_SCHED;
      PG8_LDB(B1, 0, 1); PG8_STAGE(PG8_SB(0, 0), b2, voffB);
      PG8_BAR; PG8_WAIT_L(0); PG8_MMA(0, 1, At, B1); PG8_BAR;
      PG8_LDA(At, 0, 1); PG8_STAGE(PG8_SA(0, 0), a2, voffA);
      PG8_BAR; PG8_WAIT_L(0); PG8_MMA(1, 0, At, B0); PG8_BAR; PG8_SCHED;
      PG8_STAGE(PG8_SB(0, 1), b2 + hstep, voffB);
      PG8_WAIT_V(6); PG8_BAR; PG8_MMA(1, 1, At, B1); PG8_BAR;
      PG8_LDB(B0, 1, 0); PG8_SCHED; PG8_LDA(At, 1, 0); PG8_STAGE(PG8_SA(0, 1), a2 + hstep, voffA);
      PG8_WAIT_L(8); PG8_BAR; PG8_WAIT_L(0); PG8_MMA(0, 0, At, B0); PG8_BAR; PG8_SCHED;
      PG8_LDB(B1, 1, 1); PG8_STAGE(PG8_SB(1, 0), b3, voffB);
      PG8_BAR; PG8_WAIT_L(0); PG8_MMA(0, 1, At, B1); PG8_BAR;
      PG8_LDA(At, 1, 1); PG8_STAGE(PG8_SA(1, 0), a3, voffA);
      PG8_BAR; PG8_WAIT_L(0); PG8_MMA(1, 0, At, B0); PG8_BAR; PG8_SCHED;
      PG8_STAGE(PG8_SB(1, 1), b3 + hstep, voffB);
      PG8_WAIT_V(6); PG8_BAR; PG8_MMA(1, 1, At, B1); PG8_BAR;
    }
    run_epi(E, acc, cur, wr, wc, fr, fq);
    if (!has_next) break;
#pragma unroll
    for (int a = 0; a < 2; ++a)
#pragma unroll
      for (int b = 0; b < 2; ++b)
#pragma unroll
        for (int m = 0; m < 4; ++m)
#pragma unroll
          for (int n = 0; n < 2; ++n) acc[a][b][m][n] = (f32x4){0.f, 0.f, 0.f, 0.f};
    cur = nxt; cA = nA; cB = nB; ++ui;
  }
  PG8_WAIT_V(0);
  if (wr == 0) PG8_BAR;
  PG8_BAR;
#undef PG8_SA
#undef PG8_SB
#undef PG8_STAGE
#undef PG8_LDA
#undef PG8_LDB
#undef PG8_MMA
#undef PG8_WAIT_V
#undef PG8_WAIT_L
#undef PG8_BAR
#undef PG8_SCHED
}
}
template <class Epi>
__device__ __forceinline__ void phase_gemm(const u16* A, const u16* Bt, int M, int N, int K, int ksplit, const Epi& E, float* lds) {
  __syncthreads();
  pg8::Gemm g{A, Bt, M, N, K, ksplit};
  pg8::Order S; S.init(M, N, ksplit, (int)gridDim.x, (int)blockIdx.x);
  pg8::gemm_phase(( __attribute__((address_space(3))) unsigned char*)lds, g, S, E);
  __syncthreads();
}

__device__ __forceinline__ void seq_of_token(int t, int& s0, int& L, int& sb) {
  if (t < NPROMPT_T) { s0 = t & ~255; L = 256; sb = -1; } else { sb = (t - NPROMPT_T) >> 10; s0 = NPROMPT_T + (sb << 10); L = 1024; }
}
__device__ __forceinline__ void ret_item_naive(const P& p, int item, float* lds) {
  const int tg = item >> 2, h = item & 3, t0 = tg * 16, tid = threadIdx.x;
  int s0, L, sb; seq_of_token(t0, s0, L, sb);
  float* scr = lds;
  float* qs = lds + 16 * 1024;
  float* red = qs + 16 * 128;
  const float lgf = log1pf(-exp2f(-p.l0_decay[h])), lgb = log1pf(-exp2f(-p.l0_decay[4 + h]));
  __syncthreads();
  for (int i = tid; i < 16 * 128; i += NTHR) qs[i] = bf2f(p.proj[(size_t)(t0 + (i >> 7)) * 4096 + h * 128 + (i & 127)]);
  __syncthreads();
  for (int j = tid; j < L; j += NTHR) {
    float acc[16] = {};
    const u16* kr = p.proj + (size_t)(s0 + j) * 4096 + 512 + h * 128;
    for (int d0 = 0; d0 < 128; d0 += 8) {
      const u32x4 kv = *(const u32x4*)(kr + d0);
      float kf[8];
#pragma unroll
      for (int e = 0; e < 4; ++e) { kf[2 * e] = __uint_as_float(kv[e] << 16); kf[2 * e + 1] = __uint_as_float(kv[e] & 0xffff0000u); }
#pragma unroll
      for (int i = 0; i < 16; ++i)
#pragma unroll
        for (int e = 0; e < 8; ++e) acc[i] += qs[i * 128 + d0 + e] * kf[e];
    }
#pragma unroll
    for (int i = 0; i < 16; ++i) {
      const int d = (t0 + i - s0) - j;
      const float w = d > 0 ? __expf((float)d * lgf) : (d < 0 ? __expf((float)(-d) * lgb) : 2.f);
      scr[i * 1024 + j] = acc[i] * w;
    }
  }
  __syncthreads();
  const int dv = tid & 255, ig = tid >> 8;
  float o[8] = {};
  for (int j = 0; j < L; ++j) {
    const float v = bf2f(p.proj[(size_t)(s0 + j) * 4096 + 1024 + h * 256 + dv]);
#pragma unroll
    for (int e = 0; e < 8; ++e) o[e] += scr[(ig * 8 + e) * 1024 + j] * v;
  }
  if (sb >= 0) {
    const float* Sf = p.state + ((size_t)(sb * 2 + 0) * 4 + h) * 128 * 256;
    const float* Sb = p.state + ((size_t)(sb * 2 + 1) * 4 + h) * 128 * 256;
    float af[8] = {}, ab[8] = {};
    for (int dk = 0; dk < 128; ++dk) {
      const float sf = Sf[dk * 256 + dv], sbv = Sb[dk * 256 + dv];
#pragma unroll
      for (int e = 0; e < 8; ++e) { const float q = qs[(ig * 8 + e) * 128 + dk]; af[e] += q * sf; ab[e] += q * sbv; }
    }
#pragma unroll
    for (int e = 0; e < 8; ++e) {
      const int pos = t0 + ig * 8 + e - s0;
      o[e] += __expf((float)(pos + 1) * lgf) * af[e] + __expf((float)(L - pos) * lgb) * ab[e];
    }
  }
  const int wid = tid >> 6, lane = tid & 63;
#pragma unroll
  for (int e = 0; e < 8; ++e) { const float s = wave_sum(o[e] * o[e]); if (lane == 0) red[wid * 8 + e] = s; }
  __syncthreads();
#pragma unroll
  for (int e = 0; e < 8; ++e) {
    const float ss = red[(ig * 4 + 0) * 8 + e] + red[(ig * 4 + 1) * 8 + e] + red[(ig * 4 + 2) * 8 + e] + red[(ig * 4 + 3) * 8 + e];
    const float r = rsqrtf(ss * (1.f / 256.f) + EPS);
    const int t = t0 + ig * 8 + e;
    const float g = bf2f(p.proj[(size_t)t * 4096 + 2048 + h * 256 + dv]);
    p.cat[(size_t)t * 1536 + h * 256 + dv] = f2bf(o[e] * r * g);
  }
}
__device__ __forceinline__ void state_item_naive(const P& p, int item) {
  const int b = item >> 3, h = (item >> 1) & 3, dir = item & 1, tid = threadIdx.x;
  const float lg = log1pf(-exp2f(-p.l0_decay[dir * 4 + h]));
  const int dv = tid & 255;
  float* o = p.out + (size_t)NT * DM + ((size_t)(b * 2 + dir) * 4 + h) * 128 * 256;
  for (int pass = 0; pass < 4; ++pass) {
    const int dk0 = (tid >> 8) * 64 + pass * 16;
    float acc[16] = {};
    for (int s = 0; s < 256; ++s) {
      const int t = b * 256 + s;
      const float w = dir == 0 ? __expf((float)(255 - s) * lg) : __expf((float)s * lg);
      const float v = bf2f(p.proj[(size_t)t * 4096 + 1024 + h * 256 + dv]) * w;
      const u16* kr = p.proj + (size_t)t * 4096 + 512 + h * 128 + dk0;
#pragma unroll
      for (int e = 0; e < 16; ++e) acc[e] += bf2f(kr[e]) * v;
    }
#pragma unroll
    for (int e = 0; e < 16; ++e) o[(dk0 + e) * 256 + dv] = acc[e];
  }
}
__device__ __forceinline__ void gmlp_item_naive(const P& p, int item, float* lds) {
  const int ci = item >> 2, g = item & 3, tid = threadIdx.x, wid = tid >> 6, lane = tid & 63;
  float* zn = lds;
  float* mu = lds + 128 * 128;
  float* rs = mu + 128;
  __syncthreads();
  for (int q = wid; q < 128; q += 8) {
    const u32x4 v = *(const u32x4*)(p.proj + (size_t)(ci * 128 + q) * 4096 + 3584 + lane * 8);
    float s = 0.f, s2 = 0.f;
#pragma unroll
    for (int e = 0; e < 4; ++e) { const float a = __uint_as_float(v[e] << 16), b = __uint_as_float(v[e] & 0xffff0000u); s += a + b; s2 += a * a + b * b; }
    s = wave_sum(s); s2 = wave_sum(s2);
    if (lane == 0) { const float m = s * (1.f / 512.f); const float var = fmaxf(s2 * (1.f / 512.f) - m * m, 0.f); mu[q] = m; rs[q] = rsqrtf(var + EPS); }
  }
  __syncthreads();
  for (int i = tid; i < 128 * 128; i += NTHR) {
    const int q = i >> 7, c = i & 127;
    zn[i] = (bf2f(p.proj[(size_t)(ci * 128 + q) * 4096 + 3584 + g * 128 + c]) - mu[q]) * rs[q];
  }
  __syncthreads();
  const int c = tid & 127, p0 = (tid >> 7) * 32;
  float acc[32] = {};
  const float* W = p.l0_gws + (size_t)g * 128 * 128;
  for (int q = 0; q < 128; ++q) {
    const float z = zn[q * 128 + c];
#pragma unroll
    for (int e = 0; e < 32; ++e) acc[e] += W[(p0 + e) * 128 + q] * z;
  }
#pragma unroll
  for (int e = 0; e < 32; ++e) {
    const int t = ci * 128 + p0 + e;
    const float u = bf2f(p.proj[(size_t)t * 4096 + 3072 + g * 128 + c]);
    p.cat[(size_t)t * 1536 + 1024 + g * 128 + c] = f2bf((acc[e] + p.l0_gb[g * 128 + p0 + e]) * u);
  }
}
__device__ __forceinline__ void phase_mixer_naive(const P& p, float* lds) {
  const int nR = 1536, nS = 128, nG = 192, total = nR + nS + nG;
  for (int it = blockIdx.x; it < total; it += gridDim.x) {
    if (it < nR) ret_item_naive(p, it, lds);
    else if (it < nR + nS) state_item_naive(p, it - nR);
    else gmlp_item_naive(p, it - nR - nS, lds);
  }
}


#define LAS __attribute__((address_space(3)))
typedef short bf16x8 __attribute__((ext_vector_type(8)));
typedef short bf16x4 __attribute__((ext_vector_type(4)));
constexpr int PK = 136;
constexpr int PV = 264;
__device__ __forceinline__ bf16x8 frag_row(const LAS u16* base, int pitch, int r0, int k0, int fr, int fq) {
  return *(const LAS bf16x8*)(base + (r0 + fr) * pitch + k0 + fq * 8);
}
__device__ __forceinline__ bf16x8 frag_tr(const LAS u16* base, int pitch, int k0, int n0, int fr, int fq) {
  const LAS u16* a = base + (k0 + fq * 8 + (fr >> 2)) * pitch + n0 + 4 * (fr & 3);
  const bf16x4 lo = __builtin_amdgcn_ds_read_tr16_b64_v4i16((LAS bf16x4*)a);
  const bf16x4 hi = __builtin_amdgcn_ds_read_tr16_b64_v4i16((LAS bf16x4*)(a + 4 * pitch));
  bf16x8 r; r[0] = lo[0]; r[1] = lo[1]; r[2] = lo[2]; r[3] = lo[3]; r[4] = hi[0]; r[5] = hi[1]; r[6] = hi[2]; r[7] = hi[3];
  return r;
}
__device__ __forceinline__ f32x4 mfma16(bf16x8 a, bf16x8 b, f32x4 c) { return __builtin_amdgcn_mfma_f32_16x16x32_bf16(a, b, c, 0, 0, 0); }
__device__ __forceinline__ void tile_to_lds(const u16* __restrict__ g, size_t gp, LAS u16* l, int lp, int rows, int cols) {
  const int cpr = cols >> 3, total = rows * cpr;
  for (int i = threadIdx.x; i < total; i += NTHR) {
    const int r = i / cpr, c = (i % cpr) * 8;
    *(LAS u32x4*)(l + r * lp + c) = *(const u32x4*)(g + (size_t)r * gp + c);
  }
}

__device__ __forceinline__ void kv_item(const P& p, int item, LAS u16* lds) {
  const int ci = item >> 2, h = item & 3, tid = threadIdx.x, wid = tid >> 6, lane = tid & 63, fr = lane & 15, fq = lane >> 4;
  LAS u16* kbuf = lds; LAS u16* vbuf = lds + 128 * PK;
  __syncthreads();
  tile_to_lds(p.proj + (size_t)ci * 128 * 4096 + 512 + h * 128, 4096, kbuf, PK, 128, 128);
  tile_to_lds(p.proj + (size_t)ci * 128 * 4096 + 1024 + h * 256, 4096, vbuf, PV, 128, 256);
  __syncthreads();
  const int dir = wid >> 2, m0 = (wid & 3) * 32;
  const float lg = log1pf(-exp2f(-p.l0_decay[dir * 4 + h]));
#pragma unroll 1
  for (int nh = 0; nh < 2; ++nh) {
    f32x4 acc[2][8];
#pragma unroll
    for (int m = 0; m < 2; ++m)
#pragma unroll
      for (int n = 0; n < 8; ++n) acc[m][n] = (f32x4){0.f, 0.f, 0.f, 0.f};
#pragma unroll 1
    for (int ks = 0; ks < 4; ++ks) {
      bf16x8 a[2];
      a[0] = frag_tr(kbuf, PK, ks * 32, m0, fr, fq); a[1] = frag_tr(kbuf, PK, ks * 32, m0 + 16, fr, fq);
#pragma unroll
      for (int j = 0; j < 8; ++j) {
        const int tok = ks * 32 + fq * 8 + j;
        const float w = __expf((float)(dir == 0 ? 127 - tok : tok) * lg);
        a[0][j] = (short)f2bf(bf2f((u16)a[0][j]) * w); a[1][j] = (short)f2bf(bf2f((u16)a[1][j]) * w);
      }
#pragma unroll
      for (int n = 0; n < 8; ++n) {
        const bf16x8 b = frag_tr(vbuf, PV, ks * 32, nh * 128 + n * 16, fr, fq);
        acc[0][n] = mfma16(a[0], b, acc[0][n]); acc[1][n] = mfma16(a[1], b, acc[1][n]);
      }
    }
    float* o = p.part + ((size_t)(ci * 4 + h) * 2 + dir) * 128 * 256 + (size_t)(m0 + fq * 4) * 256 + nh * 128 + fr;
#pragma unroll
    for (int m = 0; m < 2; ++m)
#pragma unroll
      for (int j = 0; j < 4; ++j)
#pragma unroll
        for (int n = 0; n < 8; ++n) o[(m * 16 + j) * 256 + n * 16] = acc[m][n][j];
  }
}

__device__ __forceinline__ void gmlp_item(const P& p, int item, LAS u16* lds) {
  const int ci = item >> 2, g = item & 3, tid = threadIdx.x, wid = tid >> 6, lane = tid & 63, fr = lane & 15, fq = lane >> 4;
  LAS u16* zn = lds; LAS u16* wsb = lds + 128 * PK; LAS float* mu = (LAS float*)(lds + 2 * 128 * PK); LAS float* rs = mu + 128;
  __syncthreads();
  for (int q = wid; q < 128; q += 8) {
    const u32x4 v = *(const u32x4*)(p.proj + (size_t)(ci * 128 + q) * 4096 + 3584 + lane * 8);
    float s = 0.f, s2 = 0.f;
#pragma unroll
    for (int e = 0; e < 4; ++e) { const float a = __uint_as_float(v[e] << 16), b = __uint_as_float(v[e] & 0xffff0000u); s += a + b; s2 += a * a + b * b; }
    s = wave_sum(s); s2 = wave_sum(s2);
    if (lane == 0) { const float m = s * (1.f / 512.f); const float var = fmaxf(s2 * (1.f / 512.f) - m * m, 0.f); mu[q] = m; rs[q] = rsqrtf(var + EPS); }
  }
  {
    const float* W = p.l0_gws + (size_t)g * 128 * 128;
    for (int i = tid; i < 128 * 32; i += NTHR) {
      const int r = i >> 5, c = (i & 31) * 4;
      const f32x4 v = *(const f32x4*)(W + r * 128 + c);
      u32x2 o; o[0] = pk2(v[0], v[1]); o[1] = pk2(v[2], v[3]);
      *(LAS u32x2*)(wsb + r * PK + c) = o;
    }
  }
  __syncthreads();
  for (int i = tid; i < 128 * 16; i += NTHR) {
    const int q = i >> 4, c = (i & 15) * 8;
    const u32x4 v = *(const u32x4*)(p.proj + (size_t)(ci * 128 + q) * 4096 + 3584 + g * 128 + c);
    const float m = mu[q], r = rs[q];
    u32x4 o;
#pragma unroll
    for (int e = 0; e < 4; ++e) o[e] = pk2((__uint_as_float(v[e] << 16) - m) * r, (__uint_as_float(v[e] & 0xffff0000u) - m) * r);
    *(LAS u32x4*)(zn + q * PK + c) = o;
  }
  __syncthreads();
  f32x4 acc[8];
#pragma unroll
  for (int n = 0; n < 8; ++n) acc[n] = (f32x4){0.f, 0.f, 0.f, 0.f};
#pragma unroll
  for (int ks = 0; ks < 4; ++ks) {
    const bf16x8 a = frag_row(wsb, PK, wid * 16, ks * 32, fr, fq);
#pragma unroll
    for (int n = 0; n < 8; ++n) acc[n] = mfma16(a, frag_tr(zn, PK, ks * 32, n * 16, fr, fq), acc[n]);
  }
#pragma unroll
  for (int j = 0; j < 4; ++j) {
    const int pr = wid * 16 + fq * 4 + j, t = ci * 128 + pr;
    const float gb = p.l0_gb[g * 128 + pr];
#pragma unroll
    for (int n = 0; n < 8; ++n) {
      const int c = n * 16 + fr;
      const float u = bf2f(p.proj[(size_t)t * 4096 + 3072 + g * 128 + c]);
      p.cat[(size_t)t * 1536 + 1024 + g * 128 + c] = f2bf((acc[n][j] + gb) * u);
    }
  }
}
__device__ __forceinline__ void phase_mix_a(const P& p, LAS u16* lds) {
  for (int it = blockIdx.x; it < 384; it += gridDim.x) { if (it < 192) kv_item(p, it, lds); else gmlp_item(p, it - 192, lds); }
}

__device__ __forceinline__ void build_state(const P& p, LAS u16* bbuf, const float* S0, float w0, int cbase, int h, int dir, int c_lo, int c_hi, int c_ref, float lg128) {
  const int tid = threadIdx.x;
#pragma unroll 1
  for (int half = 0; half < 2; ++half) {
    f32x4 a[8];
    const int base = (tid + half * 4096) * 4;
    if (S0) {
#pragma unroll
      for (int k = 0; k < 8; ++k) a[k] = *(const f32x4*)(S0 + base + k * 2048);
#pragma unroll
      for (int k = 0; k < 8; ++k) a[k] = a[k] * w0;
    } else {
#pragma unroll
      for (int k = 0; k < 8; ++k) a[k] = (f32x4){0.f, 0.f, 0.f, 0.f};
    }
#pragma unroll 1
    for (int cc = c_lo; cc < c_hi; ++cc) {
      const int e = dir == 0 ? (c_ref - 1 - cc) : (cc - c_ref - 1);
      const float w = __expf(lg128 * (float)e);
      const float* src = p.part + ((size_t)((cbase + cc) * 4 + h) * 2 + dir) * 128 * 256 + base;
      f32x4 t[8];
#pragma unroll
      for (int k = 0; k < 8; ++k) t[k] = *(const f32x4*)(src + k * 2048);
#pragma unroll
      for (int k = 0; k < 8; ++k) a[k] = a[k] + t[k] * w;
    }
#pragma unroll
    for (int k = 0; k < 8; ++k) {
      const int i = tid + half * 4096 + k * 512, r = i >> 6, c = (i & 63) * 4;
      u32x2 o; o[0] = pk2(a[k][0], a[k][1]); o[1] = pk2(a[k][2], a[k][3]);
      *(LAS u32x2*)(bbuf + r * PV + c) = o;
    }
  }
}
__device__ __forceinline__ void ret_item(const P& p, int item, LAS u16* lds) {
  const int ci = item >> 2, h = item & 3, tid = threadIdx.x, wid = tid >> 6, lane = tid & 63, fr = lane & 15, fq = lane >> 4;
  int sb, lc, n;
  if (ci < 32) { sb = -1; lc = ci & 1; n = 2; } else { sb = (ci - 32) >> 3; lc = (ci - 32) & 7; n = 8; }
  const int cbase = ci - lc;
  const float lgf = log1pf(-exp2f(-p.l0_decay[h])), lgb = log1pf(-exp2f(-p.l0_decay[4 + h]));
  LAS u16* kbuf = lds; LAS u16* bbuf = lds + 128 * PK; LAS float* red = (LAS float*)(lds + 128 * PK + 128 * PV);
  const bool hasF = (sb >= 0) || lc > 0, hasB = (sb >= 0) || lc < n - 1;
  const u16* qg = p.proj + (size_t)ci * 128 * 4096 + h * 128;
  __syncthreads();
  tile_to_lds(p.proj + (size_t)ci * 128 * 4096 + 512 + h * 128, 4096, kbuf, PK, 128, 128);
  if (hasF) build_state(p, bbuf, sb >= 0 ? p.state + ((size_t)(sb * 2 + 0) * 4 + h) * 128 * 256 : nullptr, __expf(lgf * 128.f * (float)lc), cbase, h, 0, 0, lc, lc, lgf * 128.f);
  __syncthreads();
  {
    f32x4 s[8];
#pragma unroll
    for (int nn = 0; nn < 8; ++nn) s[nn] = (f32x4){0.f, 0.f, 0.f, 0.f};
#pragma unroll 1
    for (int ks = 0; ks < 4; ++ks) {
      const bf16x8 a = *(const bf16x8*)(qg + (size_t)(wid * 16 + fr) * 4096 + ks * 32 + fq * 8);
#pragma unroll
      for (int nn = 0; nn < 8; ++nn) s[nn] = mfma16(a, frag_row(kbuf, PK, nn * 16, ks * 32, fr, fq), s[nn]);
    }
    __syncthreads();
    int bd = wid * 16 + fq * 4 - fr;
    asm volatile("" : "+v"(bd));
    LAS u16* prow = kbuf + (wid * 16 + fq * 4) * PK + fr;
#pragma unroll
    for (int nn = 0; nn < 8; ++nn)
#pragma unroll
      for (int j = 0; j < 4; ++j) {
        const int d = bd + j - 16 * nn;
        const float w = d > 0 ? __expf((float)d * lgf) : (d < 0 ? __expf((float)(-d) * lgb) : 2.f);
        prow[j * PK + nn * 16] = f2bf(s[nn][j] * w);
      }
  }
  const int m0 = (wid & 3) * 32, n0 = (wid >> 2) * 128;
  f32x4 acc[2][8];
#pragma unroll
  for (int m = 0; m < 2; ++m)
#pragma unroll
    for (int nn = 0; nn < 8; ++nn) acc[m][nn] = (f32x4){0.f, 0.f, 0.f, 0.f};
  const u16* qrow = qg + (size_t)(m0 + fr) * 4096 + fq * 8;
  if (hasF) {
#pragma unroll 1
    for (int ks = 0; ks < 4; ++ks) {
      const bf16x8 q0 = *(const bf16x8*)(qrow + ks * 32), q1 = *(const bf16x8*)(qrow + 16 * 4096 + ks * 32);
#pragma unroll
      for (int nn = 0; nn < 8; ++nn) {
        const bf16x8 b = frag_tr(bbuf, PV, ks * 32, n0 + nn * 16, fr, fq);
        acc[0][nn] = mfma16(q0, b, acc[0][nn]); acc[1][nn] = mfma16(q1, b, acc[1][nn]);
      }
    }
#pragma unroll
    for (int m = 0; m < 2; ++m)
#pragma unroll
      for (int j = 0; j < 4; ++j) {
        const int il = m0 + m * 16 + fq * 4 + j;
        const float sc = hasB ? __expf((float)(il + 1) * lgf - (float)(128 - il) * lgb) : __expf((float)(il + 1) * lgf);
#pragma unroll
        for (int nn = 0; nn < 8; ++nn) acc[m][nn][j] *= sc;
      }
  }
  if (hasB) {
    __syncthreads();
    build_state(p, bbuf, sb >= 0 ? p.state + ((size_t)(sb * 2 + 1) * 4 + h) * 128 * 256 : nullptr, __expf(lgb * 128.f * (float)(n - 1 - lc)), cbase, h, 1, lc + 1, n, lc, lgb * 128.f);
    __syncthreads();
#pragma unroll 1
    for (int ks = 0; ks < 4; ++ks) {
      const bf16x8 q0 = *(const bf16x8*)(qrow + ks * 32), q1 = *(const bf16x8*)(qrow + 16 * 4096 + ks * 32);
#pragma unroll
      for (int nn = 0; nn < 8; ++nn) {
        const bf16x8 b = frag_tr(bbuf, PV, ks * 32, n0 + nn * 16, fr, fq);
        acc[0][nn] = mfma16(q0, b, acc[0][nn]); acc[1][nn] = mfma16(q1, b, acc[1][nn]);
      }
    }
#pragma unroll
    for (int m = 0; m < 2; ++m)
#pragma unroll
      for (int j = 0; j < 4; ++j) {
        const int il = m0 + m * 16 + fq * 4 + j;
        const float sc = __expf((float)(128 - il) * lgb);
#pragma unroll
        for (int nn = 0; nn < 8; ++nn) acc[m][nn][j] *= sc;
      }
  }
  __syncthreads();
  tile_to_lds(p.proj + (size_t)ci * 128 * 4096 + 1024 + h * 256, 4096, bbuf, PV, 128, 256);
  __syncthreads();
#pragma unroll 1
  for (int ks = 0; ks < 4; ++ks) {
    const bf16x8 a0 = frag_row(kbuf, PK, m0, ks * 32, fr, fq), a1 = frag_row(kbuf, PK, m0 + 16, ks * 32, fr, fq);
#pragma unroll
    for (int nn = 0; nn < 8; ++nn) {
      const bf16x8 b = frag_tr(bbuf, PV, ks * 32, n0 + nn * 16, fr, fq);
      acc[0][nn] = mfma16(a0, b, acc[0][nn]); acc[1][nn] = mfma16(a1, b, acc[1][nn]);
    }
  }
#pragma unroll
  for (int m = 0; m < 2; ++m)
#pragma unroll
    for (int j = 0; j < 4; ++j) {
      float s = 0.f;
#pragma unroll
      for (int nn = 0; nn < 8; ++nn) s += acc[m][nn][j] * acc[m][nn][j];
      s += __shfl_xor(s, 1); s += __shfl_xor(s, 2); s += __shfl_xor(s, 4); s += __shfl_xor(s, 8);
      if (fr == 0) red[(wid >> 2) * 128 + m0 + m * 16 + fq * 4 + j] = s;
    }
  __syncthreads();
#pragma unroll
  for (int m = 0; m < 2; ++m)
#pragma unroll
    for (int j = 0; j < 4; ++j) {
      const int il = m0 + m * 16 + fq * 4 + j;
      const float r = rsqrtf((red[il] + red[128 + il]) * (1.f / 256.f) + EPS);
      LAS u16* orow = bbuf + il * PV + n0 + fr;
#pragma unroll
      for (int nn = 0; nn < 8; ++nn) orow[nn * 16] = f2bf(acc[m][nn][j] * r);
    }
  __syncthreads();
  {
    const u16* gbase = p.proj + (size_t)ci * 128 * 4096 + 2048 + h * 256;
    u16* obase = p.cat + (size_t)ci * 128 * 1536 + h * 256;
#pragma unroll 2
    for (int i = tid; i < 128 * 32; i += NTHR) {
      const int r = i >> 5, c = (i & 31) * 8;
      const u32x4 ov = *(const LAS u32x4*)(bbuf + r * PV + c);
      const u32x4 gv = *(const u32x4*)(gbase + (size_t)r * 4096 + c);
      u32x4 o;
#pragma unroll
      for (int e = 0; e < 4; ++e) o[e] = pk2(__uint_as_float(ov[e] << 16) * __uint_as_float(gv[e] << 16), __uint_as_float(ov[e] & 0xffff0000u) * __uint_as_float(gv[e] & 0xffff0000u));
      *(u32x4*)(obase + (size_t)r * 1536 + c) = o;
    }
  }
}
__device__ __forceinline__ void state_item(const P& p, int item) {
  const int b = item >> 3, h = (item >> 1) & 3, dir = item & 1;
  const float w = __expf(128.f * log1pf(-exp2f(-p.l0_decay[dir * 4 + h])));
  const int c_old = dir == 0 ? 2 * b : 2 * b + 1, c_new = dir == 0 ? 2 * b + 1 : 2 * b;
  const float* A = p.part + ((size_t)(c_old * 4 + h) * 2 + dir) * 128 * 256;
  const float* B = p.part + ((size_t)(c_new * 4 + h) * 2 + dir) * 128 * 256;
  float* o = p.out + (size_t)NT * DM + ((size_t)(b * 2 + dir) * 4 + h) * 128 * 256;
  for (int i = threadIdx.x; i < 128 * 64; i += NTHR) *(f32x4*)(o + i * 4) = *(const f32x4*)(A + i * 4) * w + *(const f32x4*)(B + i * 4);
}
__device__ __forceinline__ void phase_mix_b(const P& p, LAS u16* lds) {
  for (int it = blockIdx.x; it < 320; it += gridDim.x) { if (it < 192) ret_item(p, it, lds); else state_item(p, it - 192); }
}

__device__ __forceinline__ void phase_conv(const P& p) {
  const u16* pj = p.proj;
  for (size_t i = (size_t)blockIdx.x * NTHR + threadIdx.x; i < (size_t)NT * 256; i += (size_t)gridDim.x * NTHR) {
    const int t = (int)(i >> 8), c4 = (int)(i & 255) * 4;
    const int seg = t < NPROMPT_T ? 256 : 64;
    const int pos = t < NPROMPT_T ? (t & 255) : ((t - NPROMPT_T) & 63);
    f32x4 xc[3];
#pragma unroll
    for (int d = 0; d < 3; ++d) {
      const int pp = pos + d - 1;
      if (pp < 0 || pp >= seg) { xc[d] = (f32x4){0.f, 0.f, 0.f, 0.f}; continue; }
      const u16* r = pj + (size_t)(t + d - 1) * 3072;
      const u32x2 a = *(const u32x2*)(r + 1024 + c4), b = *(const u32x2*)(r + 2048 + c4);
      xc[d][0] = __uint_as_float(a[0] << 16) * __uint_as_float(b[0] << 16);
      xc[d][1] = __uint_as_float(a[0] & 0xffff0000u) * __uint_as_float(b[0] & 0xffff0000u);
      xc[d][2] = __uint_as_float(a[1] << 16) * __uint_as_float(b[1] << 16);
      xc[d][3] = __uint_as_float(a[1] & 0xffff0000u) * __uint_as_float(b[1] & 0xffff0000u);
    }
    const f32x4 w0 = *(const f32x4*)(p.l1_conv + c4), w1 = *(const f32x4*)(p.l1_conv + 1024 + c4), w2 = *(const f32x4*)(p.l1_conv + 2048 + c4);
    const u32x2 bgv = *(const u32x2*)(pj + (size_t)t * 3072 + c4);
    f32x4 bg = {__uint_as_float(bgv[0] << 16), __uint_as_float(bgv[0] & 0xffff0000u), __uint_as_float(bgv[1] << 16), __uint_as_float(bgv[1] & 0xffff0000u)};
    const f32x4 y = bg * (w0 * xc[0] + w1 * xc[1] + w2 * xc[2]);
    u32x2 o; o[0] = pk2(y[0], y[1]); o[1] = pk2(y[2], y[3]);
    *(u32x2*)(p.cat + (size_t)t * 1024 + c4) = o;
  }
}


#define XB_TMO      128
#define XB_XCNT(j)  (256  + 64 * (j))
#define XB_XSUB(j)  (1280 + 64 * (j))
#define XB_XGEN(j)  (2304 + 64 * (j))
#define XB_TOP      3328
#define XB_TOPGEN   3392
#define XCD_BAR_WORDS 3456
#define XB_SPIN_CAP (1u << 18)
__device__ __forceinline__ unsigned xb_ld(unsigned* p)              { return __hip_atomic_load(p, __ATOMIC_RELAXED, __HIP_MEMORY_SCOPE_AGENT); }
__device__ __forceinline__ unsigned xb_add(unsigned* p, unsigned v) { return __hip_atomic_fetch_add(p, v, __ATOMIC_RELAXED, __HIP_MEMORY_SCOPE_AGENT); }
__device__ __forceinline__ unsigned xb_xcc_id() { return (unsigned)__builtin_amdgcn_s_getreg((3 << 11) | 20) & 0xFu; }
#define XB_SPIN(cond, bar) do { unsigned _sp = 0; while (cond) { __builtin_amdgcn_s_sleep(1); \
    if ((++_sp & 255u) == 0u) { if (xb_ld(&(bar)[XB_TMO])) break; if (_sp > XB_SPIN_CAP) { atomicAdd(&(bar)[XB_TMO], 1u); break; } } } } while (0)
struct XcdBarrier { unsigned* bar; unsigned x; volatile __attribute__((address_space(3))) unsigned* st; };
__device__ __forceinline__ XcdBarrier xcd_barrier_post(unsigned* bar, volatile __attribute__((address_space(3))) unsigned* st) {
  XcdBarrier b; b.bar = bar; b.x = xb_xcc_id(); b.st = st;
  if (threadIdx.x == 0) (void)xb_add(&bar[XB_XCNT(b.x)], 1u);
  return b;
}
__device__ __forceinline__ void xcd_barrier_complete(unsigned* bar, unsigned x, unsigned& nloc, unsigned& nx) {
  const unsigned G = gridDim.x * gridDim.y * gridDim.z;
  unsigned sum, cnt, mine, sp = 0u;
  for (;;) {
    sum = 0u; cnt = 0u; mine = 0u;
#pragma unroll
    for (unsigned j = 0; j < 16; ++j) { const unsigned c = xb_ld(&bar[XB_XCNT(j)]); sum += c; cnt += (c > 0u) ? 1u : 0u; mine = (j == x) ? c : mine; }
    if (sum == G) break;
    __builtin_amdgcn_s_sleep(1);
    if ((++sp & 255u) == 0u) { if (xb_ld(&bar[XB_TMO])) break; if (sp > XB_SPIN_CAP) { atomicAdd(&bar[XB_TMO], 1u); break; } }
  }
  nloc = mine > 0u ? mine : 1u; nx = cnt > 0u ? cnt : 1u;
}
__device__ __forceinline__ void xcd_barrier(const XcdBarrier& b) {
  asm volatile("s_waitcnt vmcnt(0)" ::: "memory");
  __syncthreads();
  if (threadIdx.x == 0) {
    unsigned* bar = b.bar;
    __builtin_amdgcn_s_waitcnt(0);
    unsigned nloc = b.st[0], nx = b.st[1];
    if (nloc == 0u) { xcd_barrier_complete(bar, b.x, nloc, nx); b.st[0] = nloc; b.st[1] = nx; }
    const unsigned old = xb_add(&bar[XB_XSUB(b.x)], 1u);
    const unsigned gen = old / nloc;
    if (old + 1u == (gen + 1u) * nloc) {
      __builtin_amdgcn_fence(__ATOMIC_RELEASE, "agent");
      asm volatile("s_waitcnt vmcnt(0)" ::: "memory");
      const unsigned og = xb_add(&bar[XB_TOP], 1u);
      const unsigned tg = og / nx;
      if (og + 1u == (tg + 1u) * nx) xb_add(&bar[XB_TOPGEN], 1u);
      else XB_SPIN(xb_ld(&bar[XB_TOPGEN]) == tg, bar);
      __builtin_amdgcn_fence(__ATOMIC_ACQUIRE, "agent");
      xb_add(&bar[XB_XGEN(b.x)], 1u);
      asm volatile("s_waitcnt vmcnt(0)" ::: "memory");
    } else {
      XB_SPIN(xb_ld(&bar[XB_XGEN(b.x)]) == gen, bar);
      __builtin_amdgcn_fence(__ATOMIC_ACQUIRE, "agent");
      asm volatile("s_waitcnt vmcnt(0)" ::: "memory");
    }
  }
  __syncthreads();
}

constexpr int NPHASE = 17;
#ifndef REPMASK
#define REPMASK 0
#endif
__global__ void __launch_bounds__(NTHR) mega(P p, int lo, int hi) {
  extern __shared__ __attribute__((aligned(16))) unsigned char smem[];
  float* lds = (float*)smem;
  cg::grid_group grid = cg::this_grid();
  volatile LAS unsigned* xst = (volatile LAS unsigned*)(smem + 131072);
  if (threadIdx.x == 0) { xst[0] = 0u; xst[1] = 0u; }
  __syncthreads();
  const XcdBarrier xb = xcd_barrier_post(p.bar, xst);
  if (hi < 0) grid.sync();
  const float* m0 = p.mod; const float* m1 = p.mod + 3 * 6144;
#define PH(n, ...) if (lo <= (n) && (n) < hi) { if ((n) > lo) xcd_barrier(xb); __VA_ARGS__ if ((REPMASK >> (n)) & 1) { xcd_barrier(xb); __VA_ARGS__ } }
  PH(0, phase_prep(p, lds);)
  PH(1, { NormArgs a{p.x_prompt, p.x_sample, nullptr, nullptr, nullptr, nullptr, p.l0_norm1, m0 + 0, m0 + 1024, p.hA, nullptr}; phase_norm(a); })
  PH(2, { EpiProj0 e{p.proj}; phase_gemm(p.hA, p.wt0_in, NT, 4096, 1024, 1, e, lds); if (gridDim.x >= 256) { if (blockIdx.x >= 128) phase_prep2(p, lds, 128, (int)gridDim.x - 128); } else phase_prep2(p, lds, 0, (int)gridDim.x); })
  PH(3, phase_mix_a(p, (LAS u16*)smem);)
  PH(4, phase_mix_b(p, (LAS u16*)smem);)
  PH(5, { EpiPart e{p.part}; phase_gemm(p.cat, p.wt0_out, NT, 1024, 1536, 2, e, lds); })
  PH(6, { NormArgs a{p.x_prompt, p.x_sample, p.part, p.part + (size_t)NT * DM, m0 + 2048, p.xres, p.l0_norm2, m0 + 3072, m0 + 4096, p.hA, nullptr}; phase_norm(a); })
  PH(7, { EpiRelu2 e{p.proj}; phase_gemm(p.hA, p.wt0_f1, NT, 4096, 1024, 1, e, lds); })
  PH(8, { EpiPart e{p.part}; phase_gemm(p.proj, p.wt0_f2, NT, 1024, 4096, 2, e, lds); })
  PH(9, { NormArgs a{p.xres, p.xres + (size_t)NPROMPT_T * DM, p.part, p.part + (size_t)NT * DM, m0 + 5120, p.xres, p.l1_norm1, m1 + 0, m1 + 1024, p.hA, nullptr}; phase_norm(a); })
  PH(10, { EpiPlain e{p.proj, 3072}; phase_gemm(p.hA, p.wt1_in, NT, 3072, 1024, 1, e, lds); })
  PH(11, phase_conv(p);)
  PH(12, { EpiPart e{p.part}; phase_gemm(p.cat, p.wt1_out, NT, 1024, 1024, 2, e, lds); })
  PH(13, { NormArgs a{p.xres, p.xres + (size_t)NPROMPT_T * DM, p.part, p.part + (size_t)NT * DM, m1 + 2048, p.xres, p.l1_norm2, m1 + 3072, m1 + 4096, p.hA, nullptr}; phase_norm(a); })
  PH(14, { EpiRelu2 e{p.proj}; phase_gemm(p.hA, p.wt1_f1, NT, 4096, 1024, 1, e, lds); })
  PH(15, { EpiPart e{p.part}; phase_gemm(p.proj, p.wt1_f2, NT, 1024, 4096, 2, e, lds); })
  PH(16, { NormArgs a{p.xres, p.xres + (size_t)NPROMPT_T * DM, p.part, p.part + (size_t)NT * DM, m1 + 5120, nullptr, p.final_norm, nullptr, nullptr, nullptr, p.out}; phase_norm(a); })
#undef PH
}

constexpr size_t LDS_BYTES = 131072 + 256;
constexpr bool ONE_LAUNCH = true;

extern "C" void kernel_launch(void* const* d_in, const int* in_sizes, int n_in, void* d_out, int out_size, void* d_ws, size_t ws_size, hipStream_t stream) {
  static int grid_blocks = 0;
  if (!grid_blocks) {
    hipFuncSetAttribute((const void*)mega, hipFuncAttributeMaxDynamicSharedMemorySize, (int)LDS_BYTES);
    int dev = 0, cus = 0, per_cu = 0;
    hipGetDevice(&dev);
    hipDeviceGetAttribute(&cus, hipDeviceAttributeMultiprocessorCount, dev);
    hipOccupancyMaxActiveBlocksPerMultiprocessor(&per_cu, mega, NTHR, LDS_BYTES);
    if (per_cu < 1) per_cu = 1;
    if (per_cu > 1) per_cu = 1;
    grid_blocks = cus * per_cu;
  }
  P p{};
  const float* const* in = (const float* const*)d_in;
  p.x_prompt = in[0]; p.x_sample = in[1]; p.state = in[2]; p.c = in[3]; p.c_ctx = in[4];
  p.l0_norm1 = in[5]; p.l0_w_in = in[6]; p.l0_decay = in[7]; p.l0_gws = in[8]; p.l0_gb = in[9]; p.l0_w_out = in[10]; p.l0_norm2 = in[11];
  p.l0_w_mod = in[12]; p.l0_b_mod = in[13]; p.l0_f1 = in[14]; p.l0_f2 = in[15];
  p.l1_norm1 = in[16]; p.l1_w_in = in[17]; p.l1_conv = in[18]; p.l1_w_out = in[19]; p.l1_norm2 = in[20]; p.l1_w_mod = in[21]; p.l1_b_mod = in[22];
  p.l1_f1 = in[23]; p.l1_f2 = in[24]; p.final_norm = in[25];
  p.out = (float*)d_out;
  unsigned char* w = (unsigned char*)d_ws; size_t off = 0;
  auto take = [&](size_t bytes) { void* r = w + off; off += (bytes + 255) & ~(size_t)255; return r; };
  p.wt0_in = (u16*)take((size_t)4096 * 1024 * 2); p.wt0_out = (u16*)take((size_t)1024 * 1536 * 2);
  p.wt0_f1 = (u16*)take((size_t)4096 * 1024 * 2); p.wt0_f2 = (u16*)take((size_t)4096 * 1024 * 2);
  p.wt1_in = (u16*)take((size_t)3072 * 1024 * 2); p.wt1_out = (u16*)take((size_t)1024 * 1024 * 2);
  p.wt1_f1 = (u16*)take((size_t)4096 * 1024 * 2); p.wt1_f2 = (u16*)take((size_t)4096 * 1024 * 2);
  p.mod = (float*)take((size_t)2 * 3 * 6144 * 4);
  p.hA = (u16*)take((size_t)NT * 1024 * 2);
  p.proj = (u16*)take((size_t)NT * 4096 * 2);
  p.cat = (u16*)take((size_t)NT * 1536 * 2);
  p.part = (float*)take((size_t)2 * NT * 1024 * 4);
  p.xres = (float*)take((size_t)NT * 1024 * 4);
  p.bar = (unsigned*)take((size_t)XCD_BAR_WORDS * 4);
  hipMemsetAsync(p.bar, 0, (size_t)XCD_BAR_WORDS * 4, stream);
  if (ONE_LAUNCH) {
    int lo = 0, hi = NPHASE; void* args[] = {&p, &lo, &hi};
    hipError_t e = hipLaunchCooperativeKernel((void*)mega, dim3(grid_blocks), dim3(NTHR), args, LDS_BYTES, stream);
    if (e != hipSuccess) fprintf(stderr, "cooperative launch failed: %s (grid %d)\n", hipGetErrorString(e), grid_blocks);
  } else {
    for (int ph = 0; ph < NPHASE; ++ph) hipLaunchKernelGGL(mega, dim3(grid_blocks), dim3(NTHR), LDS_BYTES, stream, p, ph, ph + 1);
  }
}
```

```cpp
#include <hip/hip_runtime.h>
#include <hip/hip_cooperative_groups.h>
#include <cstdio>
namespace cg = cooperative_groups;

typedef unsigned short u16;
typedef float f32x4 __attribute__((ext_vector_type(4)));
typedef unsigned u32x4 __attribute__((ext_vector_type(4)));
typedef unsigned u32x2 __attribute__((ext_vector_type(2)));

constexpr int NT = 6144, DM = 1024, NPROMPT_T = 4096;
constexpr float EPS = 1e-6f;
constexpr int NTHR = 512;

__device__ __forceinline__ float bf2f(u16 b) { return __uint_as_float(((unsigned)b) << 16); }
typedef float f32x2 __attribute__((ext_vector_type(2)));
typedef __bf16 hbf16x2 __attribute__((ext_vector_type(2)));
__device__ __forceinline__ unsigned pk2(float a, float b) { const f32x2 v = {a, b}; const hbf16x2 r = __builtin_convertvector(v, hbf16x2); return __builtin_bit_cast(unsigned, r); }
__device__ __forceinline__ u16 f2bf(float f) { return (u16)(pk2(f, 0.f) & 0xffffu); }
__device__ __forceinline__ float silu_f(float x) { return x * __builtin_amdgcn_rcpf(1.f + __expf(-x)); }
__device__ __forceinline__ float gelu_f(float x) { const float u = -1.5957691216057308f * (x + 0.044715f * x * x * x); return x * __builtin_amdgcn_rcpf(1.f + __expf(u)); }
__device__ __forceinline__ int cond_of(int t) { return t < NPROMPT_T ? 0 : 1 + ((t - NPROMPT_T) >> 10); }
__device__ __forceinline__ float wave_sum(float v) {
#pragma unroll
  for (int o = 32; o > 0; o >>= 1) v += __shfl_xor(v, o);
  return v;
}

struct P {
  const float *x_prompt, *x_sample, *state, *c, *c_ctx;
  const float *l0_norm1, *l0_w_in, *l0_decay, *l0_gws, *l0_gb, *l0_w_out, *l0_norm2, *l0_w_mod, *l0_b_mod, *l0_f1, *l0_f2;
  const float *l1_norm1, *l1_w_in, *l1_conv, *l1_w_out, *l1_norm2, *l1_w_mod, *l1_b_mod, *l1_f1, *l1_f2, *final_norm;
  float* out;
  u16 *wt0_in, *wt0_out, *wt0_f1, *wt0_f2, *wt1_in, *wt1_out, *wt1_f1, *wt1_f2;
  float* mod;
  u16* hA;
  u16* proj;
  u16* cat;
  float* part;
  float* xres;
  unsigned* bar;
};

__device__ __forceinline__ void transpose_tile(const float* __restrict__ W, int K, int N, u16* __restrict__ Wt, int tile, float* lds) {
  const int tn = N / 256; const int k0 = (tile / tn) * 64, n0 = (tile % tn) * 256;
  const int tid = threadIdx.x;
  float (*T)[257] = (float (*)[257])lds;
  __syncthreads();
  {
    const int r = tid >> 6, c4 = (tid & 63) * 4;
    f32x4 v[8];
#pragma unroll
    for (int i = 0; i < 8; ++i) v[i] = *(const f32x4*)(W + (size_t)(k0 + r + 8 * i) * N + n0 + c4);
#pragma unroll
    for (int i = 0; i < 8; ++i) { T[r + 8 * i][c4 + 0] = v[i][0]; T[r + 8 * i][c4 + 1] = v[i][1]; T[r + 8 * i][c4 + 2] = v[i][2]; T[r + 8 * i][c4 + 3] = v[i][3]; }
  }
  __syncthreads();
  {
    const int kk = (tid & 7) * 8;
#pragma unroll
    for (int ps = 0; ps < 4; ++ps) {
      const int nn = (tid >> 3) + 64 * ps;
      u32x4 o;
      o[0] = pk2(T[kk + 0][nn], T[kk + 1][nn]); o[1] = pk2(T[kk + 2][nn], T[kk + 3][nn]);
      o[2] = pk2(T[kk + 4][nn], T[kk + 5][nn]); o[3] = pk2(T[kk + 6][nn], T[kk + 7][nn]);
      *(u32x4*)(Wt + (size_t)(n0 + nn) * K + k0 + kk) = o;
    }
  }
}

__device__ __forceinline__ void adaln_item(const P& p, int item, float* lds) {
  const int l = item / 96, n0 = (item % 96) * 64;
  const float* W = l ? p.l1_w_mod : p.l0_w_mod; const float* B = l ? p.l1_b_mod : p.l0_b_mod;
  const int tid = threadIdx.x;
  float* sc = lds;
  float* red = lds + 3072;
  __syncthreads();
  for (int i = tid; i < 3072; i += NTHR) {
    const int c = i >> 10, k = i & 1023;
    const float v = c == 0 ? p.c_ctx[k] : p.c[(c - 1) * 1024 + k];
    sc[i] = silu_f(v);
  }
  __syncthreads();
  const int cg4 = tid & 15, rg = tid >> 4;
  float acc[3][4] = {};
#pragma unroll 8
  for (int it = 0; it < 32; ++it) {
    const int k = it * 32 + rg;
    const f32x4 w = *(const f32x4*)(W + (size_t)k * 6144 + n0 + cg4 * 4);
#pragma unroll
    for (int c = 0; c < 3; ++c) { const float s = sc[c * 1024 + k];
#pragma unroll
      for (int e = 0; e < 4; ++e) acc[c][e] += s * w[e]; }
  }
#pragma unroll
  for (int c = 0; c < 3; ++c)
#pragma unroll
    for (int e = 0; e < 4; ++e) red[(rg * 3 + c) * 64 + cg4 * 4 + e] = acc[c][e];
  __syncthreads();
  if (tid < 192) {
    const int c = tid >> 6, n = tid & 63; float s = B[n0 + n];
    for (int r = 0; r < 32; ++r) s += red[(r * 3 + c) * 64 + n];
    p.mod[(size_t)(l * 3 + c) * 6144 + n0 + n] = s;
  }
}

__device__ __forceinline__ void phase_prep(const P& p, float* lds) {
  for (int it = blockIdx.x; it < 96 + 256; it += gridDim.x) {
    if (it < 96) adaln_item(p, it, lds); else transpose_tile(p.l0_w_in, 1024, 4096, p.wt0_in, it - 96, lds);
  }
}
__device__ __forceinline__ void phase_prep2(const P& p, float* lds, int group, int first_want) {
  const int first = (int)gridDim.x >= 256 ? first_want : 0, nblk = (int)gridDim.x - first;
  if ((int)blockIdx.x < first) return;
  const int total = group == 0 ? 96 + 256 + 256 : (group == 1 ? 96 + 192 + 64 : 256 + 256);
  for (int it = (int)blockIdx.x - first; it < total; it += nblk) {
    int i = it;
    if (group == 0) {
      if (i < 96) { transpose_tile(p.l0_w_out, 1536, 1024, p.wt0_out, i, lds); continue; } i -= 96;
      if (i < 256) { transpose_tile(p.l0_f1, 1024, 4096, p.wt0_f1, i, lds); continue; } i -= 256;
      transpose_tile(p.l0_f2, 4096, 1024, p.wt0_f2, i, lds);
    } else if (group == 1) {
      if (i < 96) { adaln_item(p, 96 + i, lds); continue; } i -= 96;
      if (i < 192) { transpose_tile(p.l1_w_in, 1024, 3072, p.wt1_in, i, lds); continue; } i -= 192;
      transpose_tile(p.l1_w_out, 1024, 1024, p.wt1_out, i, lds);
    } else {
      if (i < 256) { transpose_tile(p.l1_f1, 1024, 4096, p.wt1_f1, i, lds); continue; } i -= 256;
      transpose_tile(p.l1_f2, 4096, 1024, p.wt1_f2, i, lds);
    }
  }
}

struct NormArgs {
  const float* xin0; const float* xin1;
  const float* p0; const float* p1; const float* gate;
  float* xout; const float* nw; const float* sh; const float* sc;
  u16* hout; float* fout;
};
__device__ __forceinline__ void phase_norm(const NormArgs& a) {
  const int wid = threadIdx.x >> 6, lane = threadIdx.x & 63;
  for (int t = blockIdx.x * 8 + wid; t < NT; t += gridDim.x * 8) {
    const int c = cond_of(t);
    const float* xr = t < NPROMPT_T ? a.xin0 + (size_t)t * DM : a.xin1 + (size_t)(t - NPROMPT_T) * DM;
    f32x4 x[4]; float ss = 0.f;
#pragma unroll
    for (int i = 0; i < 4; ++i) {
      const int col = lane * 4 + 256 * i;
      x[i] = *(const f32x4*)(xr + col);
      if (a.p0) {
        const u32x2 q0 = *(const u32x2*)((const u16*)a.p0 + (size_t)t * DM + col), q1 = *(const u32x2*)((const u16*)a.p0 + (size_t)(NT + t) * DM + col);
        const f32x4 g = *(const f32x4*)(a.gate + (size_t)c * 6144 + col);
        f32x4 ps;
        ps[0] = __uint_as_float(q0[0] << 16) + __uint_as_float(q1[0] << 16); ps[1] = __uint_as_float(q0[0] & 0xffff0000u) + __uint_as_float(q1[0] & 0xffff0000u);
        ps[2] = __uint_as_float(q0[1] << 16) + __uint_as_float(q1[1] << 16); ps[3] = __uint_as_float(q0[1] & 0xffff0000u) + __uint_as_float(q1[1] & 0xffff0000u);
        x[i] = x[i] + g * ps;
      }
      if (a.xout) *(f32x4*)(a.xout + (size_t)t * DM + col) = x[i];
      ss += x[i][0] * x[i][0] + x[i][1] * x[i][1] + x[i][2] * x[i][2] + x[i][3] * x[i][3];
    }
    ss = wave_sum(ss);
    const float r = rsqrtf(ss * (1.f / 1024.f) + EPS);
#pragma unroll
    for (int i = 0; i < 4; ++i) {
      const int col = lane * 4 + 256 * i;
      const f32x4 w = *(const f32x4*)(a.nw + col);
      f32x4 y = x[i] * r * w;
      if (a.fout) *(f32x4*)(a.fout + (size_t)t * DM + col) = y;
      if (a.hout) {
        const f32x4 sh = *(const f32x4*)(a.sh + (size_t)c * 6144 + col), sc = *(const f32x4*)(a.sc + (size_t)c * 6144 + col);
        y = y * (1.f + sc) + sh;
        u32x2 o; o[0] = pk2(y[0], y[1]); o[1] = pk2(y[2], y[3]);
        *(u32x2*)(a.hout + (size_t)t * DM + col) = o;
      }
    }
  }
}

struct EpiProj0 {
  u16* O;
  __device__ __forceinline__ void store8(int row, int col, f32x4 v0, f32x4 v1, int) const {
    if (col >= 3072) {
#pragma unroll
      for (int e = 0; e < 4; ++e) { v0[e] = gelu_f(v0[e]); v1[e] = gelu_f(v1[e]); }
    } else if (col >= 2048) {
#pragma unroll
      for (int e = 0; e < 4; ++e) { v0[e] = silu_f(v0[e]); v1[e] = silu_f(v1[e]); }
    } else if (col >= 512 && col < 1024) { v0 = v0 * 0.08838834764831845f; v1 = v1 * 0.08838834764831845f; }
    u32x4 o; o[0] = pk2(v0[0], v0[1]); o[1] = pk2(v0[2], v0[3]); o[2] = pk2(v1[0], v1[1]); o[3] = pk2(v1[2], v1[3]);
    *(u32x4*)(O + (size_t)row * 4096 + col) = o;
  }
  __device__ __forceinline__ void store4(int row, int col, f32x4 v, int) const {
    if (col >= 3072) { v[0] = gelu_f(v[0]); v[1] = gelu_f(v[1]); v[2] = gelu_f(v[2]); v[3] = gelu_f(v[3]); }
    else if (col >= 2048) { v[0] = silu_f(v[0]); v[1] = silu_f(v[1]); v[2] = silu_f(v[2]); v[3] = silu_f(v[3]); }
    else if (col >= 512 && col < 1024) v = v * 0.08838834764831845f;
    u32x2 o; o[0] = pk2(v[0], v[1]); o[1] = pk2(v[2], v[3]);
    *(u32x2*)(O + (size_t)row * 4096 + col) = o;
  }
};
struct EpiPart {
  float* Pp;
  __device__ __forceinline__ void store8(int row, int col, f32x4 v0, f32x4 v1, int ks) const {
    u32x4 o; o[0] = pk2(v0[0], v0[1]); o[1] = pk2(v0[2], v0[3]); o[2] = pk2(v1[0], v1[1]); o[3] = pk2(v1[2], v1[3]);
    *(u32x4*)((u16*)Pp + ((size_t)ks * NT + row) * DM + col) = o;
  }
};
struct EpiRelu2 {
  u16* O;
  __device__ __forceinline__ void store8(int row, int col, f32x4 v0, f32x4 v1, int) const {
#pragma unroll
    for (int e = 0; e < 4; ++e) { const float r0 = fmaxf(v0[e], 0.f), r1 = fmaxf(v1[e], 0.f); v0[e] = r0 * r0; v1[e] = r1 * r1; }
    u32x4 o; o[0] = pk2(v0[0], v0[1]); o[1] = pk2(v0[2], v0[3]); o[2] = pk2(v1[0], v1[1]); o[3] = pk2(v1[2], v1[3]);
    *(u32x4*)(O + (size_t)row * 4096 + col) = o;
  }
  __device__ __forceinline__ void store4(int row, int col, f32x4 v, int) const {
#pragma unroll
    for (int e = 0; e < 4; ++e) { const float r = fmaxf(v[e], 0.f); v[e] = r * r; }
    u32x2 o; o[0] = pk2(v[0], v[1]); o[1] = pk2(v[2], v[3]);
    *(u32x2*)(O + (size_t)row * 4096 + col) = o;
  }
};
struct EpiPlain {
  u16* O; int ld;
  __device__ __forceinline__ void store8(int row, int col, f32x4 v0, f32x4 v1, int) const {
    u32x4 o; o[0] = pk2(v0[0], v0[1]); o[1] = pk2(v0[2], v0[3]); o[2] = pk2(v1[0], v1[1]); o[3] = pk2(v1[2], v1[3]);
    *(u32x4*)(O + (size_t)row * ld + col) = o;
  }
  __device__ __forceinline__ void store4(int row, int col, f32x4 v, int) const {
    u32x2 o; o[0] = pk2(v[0], v[1]); o[1] = pk2(v[2], v[3]);
    *(u32x2*)(O + (size_t)row * ld + col) = o;
  }
};

template <class Epi>
__device__ __forceinline__ void phase_gemm_naive(const u16* __restrict__ A, const u16* __restrict__ Bt, int M, int N, int K, int ksplit, const Epi& E, float* lds) {
  float (*As)[33] = (float (*)[33])lds;
  float (*Bs)[33] = (float (*)[33])(lds + 128 * 33);
  const int tm = M / 128, tn = N / 64, total = tm * tn * ksplit, kper = K / ksplit;
  const int tid = threadIdx.x, r = tid >> 2, cq = tid & 3;
  for (int it = blockIdx.x; it < total; it += gridDim.x) {
    const int ks = it / (tm * tn), rem = it % (tm * tn), m0 = (rem / tn) * 128, n0 = (rem % tn) * 64;
    float acc[4][4] = {};
    for (int k0 = ks * kper; k0 < (ks + 1) * kper; k0 += 32) {
      __syncthreads();
      {
        const int kc = (tid & 3) * 8;
        const u32x4 va = *(const u32x4*)(A + (size_t)(m0 + r) * K + k0 + kc);
#pragma unroll
        for (int e = 0; e < 4; ++e) { As[r][kc + 2 * e] = __uint_as_float(va[e] << 16); As[r][kc + 2 * e + 1] = __uint_as_float(va[e] & 0xffff0000u); }
        if (tid < 256) {
          const u32x4 vb = *(const u32x4*)(Bt + (size_t)(n0 + r) * K + k0 + kc);
#pragma unroll
          for (int e = 0; e < 4; ++e) { Bs[r][kc + 2 * e] = __uint_as_float(vb[e] << 16); Bs[r][kc + 2 * e + 1] = __uint_as_float(vb[e] & 0xffff0000u); }
        }
      }
      __syncthreads();
#pragma unroll 4
      for (int k = 0; k < 32; ++k) {
        const float a = As[r][k];
#pragma unroll
        for (int jj = 0; jj < 4; ++jj)
#pragma unroll
          for (int e = 0; e < 4; ++e) acc[jj][e] += a * Bs[cq * 4 + 16 * jj + e][k];
      }
    }
#pragma unroll
    for (int jj = 0; jj < 4; ++jj) { f32x4 v = {acc[jj][0], acc[jj][1], acc[jj][2], acc[jj][3]}; E.store4(m0 + r, n0 + cq * 4 + 16 * jj, v, ks); }
  }
}


namespace pg8 {
#define PG8_LAS __attribute__((address_space(3)))
typedef short bf16x8 __attribute__((ext_vector_type(8)));
constexpr int BM = 256, BK = 64, HALF = 128, HTB = HALF * BK * 2, STAGE_BYTES = 8 * HTB, NXCD = 8, WGM = 8;
__device__ __forceinline__ int lds_byte(int r, int c) { const int st = (r >> 4) * 2 + (c >> 5), rr = r & 15, cc = c & 31, ob = rr * 64 + cc * 2; return st * 1024 + (ob ^ (((ob >> 9) & 1) << 5)); }
__device__ __forceinline__ int perm32(int rho) { const int n = rho >> 4, i = rho & 15; return 8 * (i >> 2) + 4 * n + (i & 3); }
__device__ __forceinline__ void stage_rc(int b, int& R, int& C) { const int st = b / 1024, sb = b % 1024, swz = sb ^ (((sb >> 9) & 1) << 5); R = (st >> 1) * 16 + swz / 64; C = (st & 1) * 32 + (swz % 64) / 2; }
struct Unit { int pm, pn, ks; };
struct Gemm { const u16* A; const u16* Bt; int M, N, K, ksplit; };
struct Order {
  int nM, nN, ntile, nwg, G, c;
  __device__ void init(int M, int N, int ksplit, int G_, int c_) { nM = M / BM; nN = N / BM; ntile = nM * nN; nwg = ntile * ksplit; G = G_; c = c_; }
  __device__ bool next(int i, Unit& u) const {
    const int L = i * G + c; if (L >= nwg) return false;
    u.ks = L / ntile; int wgid = L % ntile;
    { const int q = ntile / NXCD, r = ntile % NXCD, xcd = wgid % NXCD, off = wgid / NXCD; wgid = (xcd < r ? xcd * (q + 1) : r * (q + 1) + (xcd - r) * q) + off; }
    const int nig = WGM * nN, gid = wgid / nig, fm = gid * WGM, gsz = (nM - fm) < WGM ? (nM - fm) : WGM;
    u.pm = fm + ((wgid % nig) % gsz); u.pn = (wgid % nig) / gsz; return true;
  }
};
template <class Epi>
__device__ __forceinline__ void run_epi(const Epi& E, const f32x4 (&acc)[2][2][4][2], const Unit& u, int wr, int wc, int fr, int fq) {
  const int row0 = u.pm * BM + wr * 64 + fr, col0 = u.pn * BM + wc * 32 + 8 * fq;
#pragma unroll
  for (int ai = 0; ai < 2; ++ai)
#pragma unroll
    for (int m = 0; m < 4; ++m)
#pragma unroll
      for (int bj = 0; bj < 2; ++bj) E.store8(row0 + ai * HALF + m * 16, col0 + bj * HALF, acc[ai][bj][m][0], acc[ai][bj][m][1], u.ks);
}
template <class Epi>
__device__ __forceinline__ void gemm_phase(PG8_LAS unsigned char* lds, const Gemm g, const Order& S, const Epi& E) {
  const int tid = threadIdx.x, wid = __builtin_amdgcn_readfirstlane(tid >> 6), lane = tid & 63, wr = wid >> 2, wc = wid & 3, fr = lane & 15, fq = lane >> 4;
  const int K = g.K, kper = g.K / g.ksplit, nt = kper / BK;
  unsigned voffA[2], voffB[2];
#pragma unroll
  for (int i = 0; i < 2; ++i) { int R, C; stage_rc(tid * 16 + i * 8192, R, C); const int Rb = (R & ~31) + perm32(R & 31);
    voffA[i] = (unsigned)(R * K + C) * 2u; voffB[i] = (unsigned)(Rb * K + C) * 2u; }
  const size_t kstep = (size_t)(BK * 2);
  const size_t hstep = (size_t)HALF * K * 2;
  const size_t tstep = 2 * hstep;
  const size_t ksbytes = (size_t)kper * 2;
  const unsigned ldsw = (unsigned)wid * 1024u;
  const int aoff = lds_byte(wr * 64 + fr, fq * 8), boff = lds_byte(wc * 32 + fr, fq * 8);
#define PG8_SA(b, h) (((b) * 2 + (h)) * HTB)
#define PG8_SB(b, h) ((4 + (b) * 2 + (h)) * HTB)
#define PG8_STAGE(bufoff, gbase, voff) do { _Pragma("unroll") for (int _i = 0; _i < 2; ++_i) \
    __builtin_amdgcn_global_load_lds((const unsigned*)((const char*)(gbase) + (voff)[_i]), (PG8_LAS unsigned*)(lds + (bufoff) + ldsw + _i * 8192), 16, 0, 0); } while (0)
#define PG8_LDA(dst, b, h) do { _Pragma("unroll") for (int m = 0; m < 4; ++m) _Pragma("unroll") for (int k = 0; k < 2; ++k) dst[m][k] = *(const PG8_LAS bf16x8*)(lds + PG8_SA(b, h) + aoff + m * 2048 + k * 1024); } while (0)
#define PG8_LDB(dst, b, h) do { _Pragma("unroll") for (int n = 0; n < 2; ++n) _Pragma("unroll") for (int k = 0; k < 2; ++k) dst[n][k] = *(const PG8_LAS bf16x8*)(lds + PG8_SB(b, h) + boff + n * 2048 + k * 1024); } while (0)
#define PG8_MMA(ai, bj, At, Bt) do { __builtin_amdgcn_s_setprio(1); _Pragma("unroll") for (int m = 0; m < 4; ++m) _Pragma("unroll") for (int n = 0; n < 2; ++n) _Pragma("unroll") for (int k = 0; k < 2; ++k) \
    acc[ai][bj][m][n] = __builtin_amdgcn_mfma_f32_16x16x32_bf16(Bt[n][k], At[m][k], acc[ai][bj][m][n], 0, 0, 0); __builtin_amdgcn_s_setprio(0); } while (0)
#define PG8_WAIT_V(n) asm volatile("s_waitcnt vmcnt(" #n ")" ::: "memory")
#define PG8_WAIT_L(n) asm volatile("s_waitcnt lgkmcnt(" #n ")" ::: "memory")
#define PG8_BAR __builtin_amdgcn_s_barrier()
#define PG8_SCHED __builtin_amdgcn_sched_barrier(0)
  Unit cur, nxt; int ui = 0;
  if (!S.next(0, cur)) return;
  f32x4 acc[2][2][4][2];
#pragma unroll
  for (int a = 0; a < 2; ++a)
#pragma unroll
    for (int b = 0; b < 2; ++b)
#pragma unroll
      for (int m = 0; m < 4; ++m)
#pragma unroll
        for (int n = 0; n < 2; ++n) acc[a][b][m][n] = (f32x4){0.f, 0.f, 0.f, 0.f};
  bf16x8 At[4][2], B0[2][2], B1[2][2];
  const char* cA = (const char*)g.A + (size_t)cur.pm * tstep + (size_t)cur.ks * ksbytes; const char* cB = (const char*)g.Bt + (size_t)cur.pn * tstep + (size_t)cur.ks * ksbytes;
  PG8_STAGE(PG8_SB(0, 0), cB, voffB); PG8_STAGE(PG8_SA(0, 0), cA, voffA); PG8_STAGE(PG8_SB(0, 1), cB + hstep, voffB); PG8_STAGE(PG8_SA(0, 1), cA + hstep, voffA);
  if (wr == 1) PG8_BAR;
  PG8_WAIT_V(4); PG8_BAR;
  PG8_STAGE(PG8_SB(1, 0), cB + kstep, voffB); PG8_STAGE(PG8_SA(1, 0), cA + kstep, voffA); PG8_STAGE(PG8_SB(1, 1), cB + hstep + kstep, voffB);
  PG8_WAIT_V(6); PG8_BAR;
  for (;;) {
    const bool has_next = S.next(ui + 1, nxt);
    const char* nA = has_next ? (const char*)g.A + (size_t)nxt.pm * tstep + (size_t)nxt.ks * ksbytes : cA; const char* nB = has_next ? (const char*)g.Bt + (size_t)nxt.pn * tstep + (size_t)nxt.ks * ksbytes : cB;
    for (int t = 0; t < nt; t += 2) {
      const bool last = (t == nt - 2);
      const char* a1 = cA + (size_t)(t + 1) * kstep;
      const char* a2 = last ? nA : cA + (size_t)(t + 2) * kstep; const char* b2 = last ? nB : cB + (size_t)(t + 2) * kstep;
      const char* a3 = a2 + kstep; const char* b3 = b2 + kstep;
      PG8_LDB(B0, 0, 0); PG8_SCHED; PG8_LDA(At, 0, 0); PG8_STAGE(PG8_SA(1, 1), a1 + hstep, voffA);
      PG8_WAIT_L(8); PG8_BAR; PG8_WAIT_L(0); PG8_MMA(0, 0, At, B0); PG8_BAR; PG8_SCHED;
      PG8_LDB(B1, 0, 1); PG8_STAGE(PG8_SB(0, 0), b2, voffB);
      PG8_BAR; PG8_WAIT_L(0); PG8_MMA(0, 1, At, B1); PG8_BAR;
      PG8_LDA(At, 0, 1); PG8_STAGE(PG8_SA(0, 0), a2, voffA);
      PG8_BAR; PG8_WAIT_L(0); PG8_MMA(1, 0, At, B0); PG8_BAR; PG8_SCHED;
      PG8_STAGE(PG8_SB(0, 1), b2 + hstep, voffB);
      PG8_WAIT_V(6); PG8_BAR; PG8_MMA(1, 1, At, B1); PG8_BAR;
      PG8_LDB(B0, 1, 0); PG8_SCHED; PG8_LDA(At, 1, 0); PG8_STAGE(PG8_SA(0, 1), a2 + hstep, voffA);
      PG8_WAIT_L(8); PG8_BAR; PG8_WAIT_L(0); PG8_MMA(0, 0, At, B0); PG8_BAR; PG8_SCHED;
      PG8_LDB(B1, 1, 1); PG8_STAGE(PG8_SB(1, 0), b3, voffB);
      PG8_BAR; PG8_WAIT_L(0); PG8_MMA(0, 1, At, B1); PG8_BAR;
      PG8_LDA(At, 1, 1); PG8_STAGE(PG8_SA(1, 0), a3, voffA);
      PG8_BAR; PG8_WAIT_L(0); PG8_MMA(1, 0, At, B0); PG8_BAR; PG8_SCHED;
      PG8_STAGE(PG8_SB(1, 1), b3 + hstep, voffB);
      PG8_WAIT_V(6); PG8_BAR; PG8_MMA(1, 1, At, B1); PG8_BAR;
    }
    run_epi(E, acc, cur, wr, wc, fr, fq);
    if (!has_next) break;
#pragma unroll
    for (int a = 0; a < 2; ++a)
#pragma unroll
      for (int b = 0; b < 2; ++b)
#pragma unroll
        for (int m = 0; m < 4; ++m)
#pragma unroll
          for (int n = 0; n < 2; ++n) acc[a][b][m][n] = (f32x4){0.f, 0.f, 0.f, 0.f};
    cur = nxt; cA = nA; cB = nB; ++ui;
  }
  PG8_WAIT_V(0);
  if (wr == 0) PG8_BAR;
  PG8_BAR;
#undef PG8_SA
#undef PG8_SB
#undef PG8_STAGE
#undef PG8_LDA
#undef PG8_LDB
#undef PG8_MMA
#undef PG8_WAIT_V
#undef PG8_WAIT_L
#undef PG8_BAR
#undef PG8_SCHED
}
}
template <class Epi>
__device__ __forceinline__ void phase_gemm(const u16* A, const u16* Bt, int M, int N, int K, int ksplit, const Epi& E, float* lds) {
  __syncthreads();
  pg8::Gemm g{A, Bt, M, N, K, ksplit};
  pg8::Order S; S.init(M, N, ksplit, (int)gridDim.x, (int)blockIdx.x);
  pg8::gemm_phase(( __attribute__((address_space(3))) unsigned char*)lds, g, S, E);
  __syncthreads();
}

__device__ __forceinline__ void seq_of_token(int t, int& s0, int& L, int& sb) {
  if (t < NPROMPT_T) { s0 = t & ~255; L = 256; sb = -1; } else { sb = (t - NPROMPT_T) >> 10; s0 = NPROMPT_T + (sb << 10); L = 1024; }
}
__device__ __forceinline__ void ret_item_naive(const P& p, int item, float* lds) {
  const int tg = item >> 2, h = item & 3, t0 = tg * 16, tid = threadIdx.x;
  int s0, L, sb; seq_of_token(t0, s0, L, sb);
  float* scr = lds;
  float* qs = lds + 16 * 1024;
  float* red = qs + 16 * 128;
  const float lgf = log1pf(-exp2f(-p.l0_decay[h])), lgb = log1pf(-exp2f(-p.l0_decay[4 + h]));
  __syncthreads();
  for (int i = tid; i < 16 * 128; i += NTHR) qs[i] = bf2f(p.proj[(size_t)(t0 + (i >> 7)) * 4096 + h * 128 + (i & 127)]);
  __syncthreads();
  for (int j = tid; j < L; j += NTHR) {
    float acc[16] = {};
    const u16* kr = p.proj + (size_t)(s0 + j) * 4096 + 512 + h * 128;
    for (int d0 = 0; d0 < 128; d0 += 8) {
      const u32x4 kv = *(const u32x4*)(kr + d0);
      float kf[8];
#pragma unroll
      for (int e = 0; e < 4; ++e) { kf[2 * e] = __uint_as_float(kv[e] << 16); kf[2 * e + 1] = __uint_as_float(kv[e] & 0xffff0000u); }
#pragma unroll
      for (int i = 0; i < 16; ++i)
#pragma unroll
        for (int e = 0; e < 8; ++e) acc[i] += qs[i * 128 + d0 + e] * kf[e];
    }
#pragma unroll
    for (int i = 0; i < 16; ++i) {
      const int d = (t0 + i - s0) - j;
      const float w = d > 0 ? __expf((float)d * lgf) : (d < 0 ? __expf((float)(-d) * lgb) : 2.f);
      scr[i * 1024 + j] = acc[i] * w;
    }
  }
  __syncthreads();
  const int dv = tid & 255, ig = tid >> 8;
  float o[8] = {};
  for (int j = 0; j < L; ++j) {
    const float v = bf2f(p.proj[(size_t)(s0 + j) * 4096 + 1024 + h * 256 + dv]);
#pragma unroll
    for (int e = 0; e < 8; ++e) o[e] += scr[(ig * 8 + e) * 1024 + j] * v;
  }
  if (sb >= 0) {
    const float* Sf = p.state + ((size_t)(sb * 2 + 0) * 4 + h) * 128 * 256;
    const float* Sb = p.state + ((size_t)(sb * 2 + 1) * 4 + h) * 128 * 256;
    float af[8] = {}, ab[8] = {};
    for (int dk = 0; dk < 128; ++dk) {
      const float sf = Sf[dk * 256 + dv], sbv = Sb[dk * 256 + dv];
#pragma unroll
      for (int e = 0; e < 8; ++e) { const float q = qs[(ig * 8 + e) * 128 + dk]; af[e] += q * sf; ab[e] += q * sbv; }
    }
#pragma unroll
    for (int e = 0; e < 8; ++e) {
      const int pos = t0 + ig * 8 + e - s0;
      o[e] += __expf((float)(pos + 1) * lgf) * af[e] + __expf((float)(L - pos) * lgb) * ab[e];
    }
  }
  const int wid = tid >> 6, lane = tid & 63;
#pragma unroll
  for (int e = 0; e < 8; ++e) { const float s = wave_sum(o[e] * o[e]); if (lane == 0) red[wid * 8 + e] = s; }
  __syncthreads();
#pragma unroll
  for (int e = 0; e < 8; ++e) {
    const float ss = red[(ig * 4 + 0) * 8 + e] + red[(ig * 4 + 1) * 8 + e] + red[(ig * 4 + 2) * 8 + e] + red[(ig * 4 + 3) * 8 + e];
    const float r = rsqrtf(ss * (1.f / 256.f) + EPS);
    const int t = t0 + ig * 8 + e;
    const float g = bf2f(p.proj[(size_t)t * 4096 + 2048 + h * 256 + dv]);
    p.cat[(size_t)t * 1536 + h * 256 + dv] = f2bf(o[e] * r * g);
  }
}
__device__ __forceinline__ void state_item_naive(const P& p, int item) {
  const int b = item >> 3, h = (item >> 1) & 3, dir = item & 1, tid = threadIdx.x;
  const float lg = log1pf(-exp2f(-p.l0_decay[dir * 4 + h]));
  const int dv = tid & 255;
  float* o = p.out + (size_t)NT * DM + ((size_t)(b * 2 + dir) * 4 + h) * 128 * 256;
  for (int pass = 0; pass < 4; ++pass) {
    const int dk0 = (tid >> 8) * 64 + pass * 16;
    float acc[16] = {};
    for (int s = 0; s < 256; ++s) {
      const int t = b * 256 + s;
      const float w = dir == 0 ? __expf((float)(255 - s) * lg) : __expf((float)s * lg);
      const float v = bf2f(p.proj[(size_t)t * 4096 + 1024 + h * 256 + dv]) * w;
      const u16* kr = p.proj + (size_t)t * 4096 + 512 + h * 128 + dk0;
#pragma unroll
      for (int e = 0; e < 16; ++e) acc[e] += bf2f(kr[e]) * v;
    }
#pragma unroll
    for (int e = 0; e < 16; ++e) o[(dk0 + e) * 256 + dv] = acc[e];
  }
}
__device__ __forceinline__ void gmlp_item_naive(const P& p, int item, float* lds) {
  const int ci = item >> 2, g = item & 3, tid = threadIdx.x, wid = tid >> 6, lane = tid & 63;
  float* zn = lds;
  float* mu = lds + 128 * 128;
  float* rs = mu + 128;
  __syncthreads();
  for (int q = wid; q < 128; q += 8) {
    const u32x4 v = *(const u32x4*)(p.proj + (size_t)(ci * 128 + q) * 4096 + 3584 + lane * 8);
    float s = 0.f, s2 = 0.f;
#pragma unroll
    for (int e = 0; e < 4; ++e) { const float a = __uint_as_float(v[e] << 16), b = __uint_as_float(v[e] & 0xffff0000u); s += a + b; s2 += a * a + b * b; }
    s = wave_sum(s); s2 = wave_sum(s2);
    if (lane == 0) { const float m = s * (1.f / 512.f); const float var = fmaxf(s2 * (1.f / 512.f) - m * m, 0.f); mu[q] = m; rs[q] = rsqrtf(var + EPS); }
  }
  __syncthreads();
  for (int i = tid; i < 128 * 128; i += NTHR) {
    const int q = i >> 7, c = i & 127;
    zn[i] = (bf2f(p.proj[(size_t)(ci * 128 + q) * 4096 + 3584 + g * 128 + c]) - mu[q]) * rs[q];
  }
  __syncthreads();
  const int c = tid & 127, p0 = (tid >> 7) * 32;
  float acc[32] = {};
  const float* W = p.l0_gws + (size_t)g * 128 * 128;
  for (int q = 0; q < 128; ++q) {
    const float z = zn[q * 128 + c];
#pragma unroll
    for (int e = 0; e < 32; ++e) acc[e] += W[(p0 + e) * 128 + q] * z;
  }
#pragma unroll
  for (int e = 0; e < 32; ++e) {
    const int t = ci * 128 + p0 + e;
    const float u = bf2f(p.proj[(size_t)t * 4096 + 3072 + g * 128 + c]);
    p.cat[(size_t)t * 1536 + 1024 + g * 128 + c] = f2bf((acc[e] + p.l0_gb[g * 128 + p0 + e]) * u);
  }
}
__device__ __forceinline__ void phase_mixer_naive(const P& p, float* lds) {
  const int nR = 1536, nS = 128, nG = 192, total = nR + nS + nG;
  for (int it = blockIdx.x; it < total; it += gridDim.x) {
    if (it < nR) ret_item_naive(p, it, lds);
    else if (it < nR + nS) state_item_naive(p, it - nR);
    else gmlp_item_naive(p, it - nR - nS, lds);
  }
}


#define LAS __attribute__((address_space(3)))
typedef short bf16x8 __attribute__((ext_vector_type(8)));
typedef short bf16x4 __attribute__((ext_vector_type(4)));
constexpr int PK = 136;
constexpr int PV = 264;
__device__ __forceinline__ bf16x8 frag_row(const LAS u16* base, int pitch, int r0, int k0, int fr, int fq) {
  return *(const LAS bf16x8*)(base + (r0 + fr) * pitch + k0 + fq * 8);
}
__device__ __forceinline__ bf16x8 frag_tr(const LAS u16* base, int pitch, int k0, int n0, int fr, int fq) {
  const LAS u16* a = base + (k0 + fq * 8 + (fr >> 2)) * pitch + n0 + 4 * (fr & 3);
  const bf16x4 lo = __builtin_amdgcn_ds_read_tr16_b64_v4i16((LAS bf16x4*)a);
  const bf16x4 hi = __builtin_amdgcn_ds_read_tr16_b64_v4i16((LAS bf16x4*)(a + 4 * pitch));
  bf16x8 r; r[0] = lo[0]; r[1] = lo[1]; r[2] = lo[2]; r[3] = lo[3]; r[4] = hi[0]; r[5] = hi[1]; r[6] = hi[2]; r[7] = hi[3];
  return r;
}
__device__ __forceinline__ f32x4 mfma16(bf16x8 a, bf16x8 b, f32x4 c) { return __builtin_amdgcn_mfma_f32_16x16x32_bf16(a, b, c, 0, 0, 0); }
__device__ __forceinline__ void tile_to_lds(const u16* __restrict__ g, size_t gp, LAS u16* l, int lp, int rows, int cols) {
  const int cpr = cols >> 3, total = rows * cpr;
  for (int i = threadIdx.x; i < total; i += NTHR) {
    const int r = i / cpr, c = (i % cpr) * 8;
    *(LAS u32x4*)(l + r * lp + c) = *(const u32x4*)(g + (size_t)r * gp + c);
  }
}

__device__ __forceinline__ void kv_item(const P& p, int item, LAS u16* lds) {
  const int ci = item >> 2, h = item & 3, tid = threadIdx.x, wid = tid >> 6, lane = tid & 63, fr = lane & 15, fq = lane >> 4;
  LAS u16* kbuf = lds; LAS u16* vbuf = lds + 128 * PK;
  __syncthreads();
  tile_to_lds(p.proj + (size_t)ci * 128 * 4096 + 512 + h * 128, 4096, kbuf, PK, 128, 128);
  tile_to_lds(p.proj + (size_t)ci * 128 * 4096 + 1024 + h * 256, 4096, vbuf, PV, 128, 256);
  __syncthreads();
  const int dir = wid >> 2, m0 = (wid & 3) * 32;
  const float lg = log1pf(-exp2f(-p.l0_decay[dir * 4 + h]));
#pragma unroll 1
  for (int nh = 0; nh < 2; ++nh) {
    f32x4 acc[2][8];
#pragma unroll
    for (int m = 0; m < 2; ++m)
#pragma unroll
      for (int n = 0; n < 8; ++n) acc[m][n] = (f32x4){0.f, 0.f, 0.f, 0.f};
#pragma unroll 1
    for (int ks = 0; ks < 4; ++ks) {
      bf16x8 a[2];
      a[0] = frag_tr(kbuf, PK, ks * 32, m0, fr, fq); a[1] = frag_tr(kbuf, PK, ks * 32, m0 + 16, fr, fq);
#pragma unroll
      for (int j = 0; j < 8; ++j) {
        const int tok = ks * 32 + fq * 8 + j;
        const float w = __expf((float)(dir == 0 ? 127 - tok : tok) * lg);
        a[0][j] = (short)f2bf(bf2f((u16)a[0][j]) * w); a[1][j] = (short)f2bf(bf2f((u16)a[1][j]) * w);
      }
#pragma unroll
      for (int n = 0; n < 8; ++n) {
        const bf16x8 b = frag_tr(vbuf, PV, ks * 32, nh * 128 + n * 16, fr, fq);
        acc[0][n] = mfma16(a[0], b, acc[0][n]); acc[1][n] = mfma16(a[1], b, acc[1][n]);
      }
    }
    float* o = p.part + ((size_t)(ci * 4 + h) * 2 + dir) * 128 * 256 + (size_t)(m0 + fq * 4) * 256 + nh * 128 + fr;
#pragma unroll
    for (int m = 0; m < 2; ++m)
#pragma unroll
      for (int j = 0; j < 4; ++j)
#pragma unroll
        for (int n = 0; n < 8; ++n) o[(m * 16 + j) * 256 + n * 16] = acc[m][n][j];
  }
}

__device__ __forceinline__ void gmlp_item(const P& p, int item, LAS u16* lds) {
  const int ci = item >> 2, g = item & 3, tid = threadIdx.x, wid = tid >> 6, lane = tid & 63, fr = lane & 15, fq = lane >> 4;
  LAS u16* zn = lds; LAS u16* wsb = lds + 128 * PK; LAS float* mu = (LAS float*)(lds + 2 * 128 * PK); LAS float* rs = mu + 128;
  __syncthreads();
  for (int q = wid; q < 128; q += 8) {
    const u32x4 v = *(const u32x4*)(p.proj + (size_t)(ci * 128 + q) * 4096 + 3584 + lane * 8);
    float s = 0.f, s2 = 0.f;
#pragma unroll
    for (int e = 0; e < 4; ++e) { const float a = __uint_as_float(v[e] << 16), b = __uint_as_float(v[e] & 0xffff0000u); s += a + b; s2 += a * a + b * b; }
    s = wave_sum(s); s2 = wave_sum(s2);
    if (lane == 0) { const float m = s * (1.f / 512.f); const float var = fmaxf(s2 * (1.f / 512.f) - m * m, 0.f); mu[q] = m; rs[q] = rsqrtf(var + EPS); }
  }
  {
    const float* W = p.l0_gws + (size_t)g * 128 * 128;
    for (int i = tid; i < 128 * 32; i += NTHR) {
      const int r = i >> 5, c = (i & 31) * 4;
      const f32x4 v = *(const f32x4*)(W + r * 128 + c);
      u32x2 o; o[0] = pk2(v[0], v[1]); o[1] = pk2(v[2], v[3]);
      *(LAS u32x2*)(wsb + r * PK + c) = o;
    }
  }
  __syncthreads();
  for (int i = tid; i < 128 * 16; i += NTHR) {
    const int q = i >> 4, c = (i & 15) * 8;
    const u32x4 v = *(const u32x4*)(p.proj + (size_t)(ci * 128 + q) * 4096 + 3584 + g * 128 + c);
    const float m = mu[q], r = rs[q];
    u32x4 o;
#pragma unroll
    for (int e = 0; e < 4; ++e) o[e] = pk2((__uint_as_float(v[e] << 16) - m) * r, (__uint_as_float(v[e] & 0xffff0000u) - m) * r);
    *(LAS u32x4*)(zn + q * PK + c) = o;
  }
  __syncthreads();
  f32x4 acc[8];
#pragma unroll
  for (int n = 0; n < 8; ++n) acc[n] = (f32x4){0.f, 0.f, 0.f, 0.f};
#pragma unroll
  for (int ks = 0; ks < 4; ++ks) {
    const bf16x8 a = frag_row(wsb, PK, wid * 16, ks * 32, fr, fq);
#pragma unroll
    for (int n = 0; n < 8; ++n) acc[n] = mfma16(a, frag_tr(zn, PK, ks * 32, n * 16, fr, fq), acc[n]);
  }
#pragma unroll
  for (int j = 0; j < 4; ++j) {
    const int pr = wid * 16 + fq * 4 + j, t = ci * 128 + pr;
    const float gb = p.l0_gb[g * 128 + pr];
#pragma unroll
    for (int n = 0; n < 8; ++n) {
      const int c = n * 16 + fr;
      const float u = bf2f(p.proj[(size_t)t * 4096 + 3072 + g * 128 + c]);
      p.cat[(size_t)t * 1536 + 1024 + g * 128 + c] = f2bf((acc[n][j] + gb) * u);
    }
  }
}
__device__ __forceinline__ void phase_mix_a(const P& p, LAS u16* lds) {
  for (int it = blockIdx.x; it < 384; it += gridDim.x) { if (it < 192) kv_item(p, it, lds); else gmlp_item(p, it - 192, lds); }
}

__device__ __forceinline__ void build_state(const P& p, LAS u16* bbuf, const float* S0, float w0, int cbase, int h, int dir, int c_lo, int c_hi, int c_ref, float lg128) {
  const int tid = threadIdx.x;
#pragma unroll 1
  for (int half = 0; half < 2; ++half) {
    f32x4 a[8];
    const int base = (tid + half * 4096) * 4;
    if (S0) {
#pragma unroll
      for (int k = 0; k < 8; ++k) a[k] = *(const f32x4*)(S0 + base + k * 2048);
#pragma unroll
      for (int k = 0; k < 8; ++k) a[k] = a[k] * w0;
    } else {
#pragma unroll
      for (int k = 0; k < 8; ++k) a[k] = (f32x4){0.f, 0.f, 0.f, 0.f};
    }
#pragma unroll 1
    for (int cc = c_lo; cc < c_hi; ++cc) {
      const int e = dir == 0 ? (c_ref - 1 - cc) : (cc - c_ref - 1);
      const float w = __expf(lg128 * (float)e);
      const float* src = p.part + ((size_t)((cbase + cc) * 4 + h) * 2 + dir) * 128 * 256 + base;
      f32x4 t[8];
#pragma unroll
      for (int k = 0; k < 8; ++k) t[k] = *(const f32x4*)(src + k * 2048);
#pragma unroll
      for (int k = 0; k < 8; ++k) a[k] = a[k] + t[k] * w;
    }
#pragma unroll
    for (int k = 0; k < 8; ++k) {
      const int i = tid + half * 4096 + k * 512, r = i >> 6, c = (i & 63) * 4;
      u32x2 o; o[0] = pk2(a[k][0], a[k][1]); o[1] = pk2(a[k][2], a[k][3]);
      *(LAS u32x2*)(bbuf + r * PV + c) = o;
    }
  }
}
__device__ __forceinline__ void ret_item(const P& p, int item, LAS u16* lds) {
  const int ci = item >> 2, h = item & 3, tid = threadIdx.x, wid = tid >> 6, lane = tid & 63, fr = lane & 15, fq = lane >> 4;
  int sb, lc, n;
  if (ci < 32) { sb = -1; lc = ci & 1; n = 2; } else { sb = (ci - 32) >> 3; lc = (ci - 32) & 7; n = 8; }
  const int cbase = ci - lc;
  const float lgf = log1pf(-exp2f(-p.l0_decay[h])), lgb = log1pf(-exp2f(-p.l0_decay[4 + h]));
  LAS u16* kbuf = lds; LAS u16* bbuf = lds + 128 * PK; LAS float* red = (LAS float*)(lds + 128 * PK + 128 * PV);
  const bool hasF = (sb >= 0) || lc > 0, hasB = (sb >= 0) || lc < n - 1;
  const u16* qg = p.proj + (size_t)ci * 128 * 4096 + h * 128;
  __syncthreads();
  tile_to_lds(p.proj + (size_t)ci * 128 * 4096 + 512 + h * 128, 4096, kbuf, PK, 128, 128);
  if (hasF) build_state(p, bbuf, sb >= 0 ? p.state + ((size_t)(sb * 2 + 0) * 4 + h) * 128 * 256 : nullptr, __expf(lgf * 128.f * (float)lc), cbase, h, 0, 0, lc, lc, lgf * 128.f);
  __syncthreads();
  {
    f32x4 s[8];
#pragma unroll
    for (int nn = 0; nn < 8; ++nn) s[nn] = (f32x4){0.f, 0.f, 0.f, 0.f};
#pragma unroll 1
    for (int ks = 0; ks < 4; ++ks) {
      const bf16x8 a = *(const bf16x8*)(qg + (size_t)(wid * 16 + fr) * 4096 + ks * 32 + fq * 8);
#pragma unroll
      for (int nn = 0; nn < 8; ++nn) s[nn] = mfma16(a, frag_row(kbuf, PK, nn * 16, ks * 32, fr, fq), s[nn]);
    }
    __syncthreads();
    int bd = wid * 16 + fq * 4 - fr;
    asm volatile("" : "+v"(bd));
    LAS u16* prow = kbuf + (wid * 16 + fq * 4) * PK + fr;
#pragma unroll
    for (int nn = 0; nn < 8; ++nn)
#pragma unroll
      for (int j = 0; j < 4; ++j) {
        const int d = bd + j - 16 * nn;
        const float w = d > 0 ? __expf((float)d * lgf) : (d < 0 ? __expf((float)(-d) * lgb) : 2.f);
        prow[j * PK + nn * 16] = f2bf(s[nn][j] * w);
      }
  }
  const int m0 = (wid & 3) * 32, n0 = (wid >> 2) * 128;
  f32x4 acc[2][8];
#pragma unroll
  for (int m = 0; m < 2; ++m)
#pragma unroll
    for (int nn = 0; nn < 8; ++nn) acc[m][nn] = (f32x4){0.f, 0.f, 0.f, 0.f};
  const u16* qrow = qg + (size_t)(m0 + fr) * 4096 + fq * 8;
  if (hasF) {
#pragma unroll 1
    for (int ks = 0; ks < 4; ++ks) {
      const bf16x8 q0 = *(const bf16x8*)(qrow + ks * 32), q1 = *(const bf16x8*)(qrow + 16 * 4096 + ks * 32);
#pragma unroll
      for (int nn = 0; nn < 8; ++nn) {
        const bf16x8 b = frag_tr(bbuf, PV, ks * 32, n0 + nn * 16, fr, fq);
        acc[0][nn] = mfma16(q0, b, acc[0][nn]); acc[1][nn] = mfma16(q1, b, acc[1][nn]);
      }
    }
#pragma unroll
    for (int m = 0; m < 2; ++m)
#pragma unroll
      for (int j = 0; j < 4; ++j) {
        const int il = m0 + m * 16 + fq * 4 + j;
        const float sc = hasB ? __expf((float)(il + 1) * lgf - (float)(128 - il) * lgb) : __expf((float)(il + 1) * lgf);
#pragma unroll
        for (int nn = 0; nn < 8; ++nn) acc[m][nn][j] *= sc;
      }
  }
  if (hasB) {
    __syncthreads();
    build_state(p, bbuf, sb >= 0 ? p.state + ((size_t)(sb * 2 + 1) * 4 + h) * 128 * 256 : nullptr, __expf(lgb * 128.f * (float)(n - 1 - lc)), cbase, h, 1, lc + 1, n, lc, lgb * 128.f);
    __syncthreads();
#pragma unroll 1
    for (int ks = 0; ks < 4; ++ks) {
      const bf16x8 q0 = *(const bf16x8*)(qrow + ks * 32), q1 = *(const bf16x8*)(qrow + 16 * 4096 + ks * 32);
#pragma unroll
      for (int nn = 0; nn < 8; ++nn) {
        const bf16x8 b = frag_tr(bbuf, PV, ks * 32, n0 + nn * 16, fr, fq);
        acc[0][nn] = mfma16(q0, b, acc[0][nn]); acc[1][nn] = mfma16(q1, b, acc[1][nn]);
      }
    }
#pragma unroll
    for (int m = 0; m < 2; ++m)
#pragma unroll
      for (int j = 0; j < 4; ++j) {
        const int il = m0 + m * 16 + fq * 4 + j;
        const float sc = __expf((float)(128 - il) * lgb);
#pragma unroll
        for (int nn = 0; nn < 8; ++nn) acc[m][nn][j] *= sc;
      }
  }
  __syncthreads();
  tile_to_lds(p.proj + (size_t)ci * 128 * 4096 + 1024 + h * 256, 4096, bbuf, PV, 128, 256);
  __syncthreads();
#pragma unroll 1
  for (int ks = 0; ks < 4; ++ks) {
    const bf16x8 a0 = frag_row(kbuf, PK, m0, ks * 32, fr, fq), a1 = frag_row(kbuf, PK, m0 + 16, ks * 32, fr, fq);
#pragma unroll
    for (int nn = 0; nn < 8; ++nn) {
      const bf16x8 b = frag_tr(bbuf, PV, ks * 32, n0 + nn * 16, fr, fq);
      acc[0][nn] = mfma16(a0, b, acc[0][nn]); acc[1][nn] = mfma16(a1, b, acc[1][nn]);
    }
  }
#pragma unroll
  for (int m = 0; m < 2; ++m)
#pragma unroll
    for (int j = 0; j < 4; ++j) {
      float s = 0.f;
#pragma unroll
      for (int nn = 0; nn < 8; ++nn) s += acc[m][nn][j] * acc[m][nn][j];
      s += __shfl_xor(s, 1); s += __shfl_xor(s, 2); s += __shfl_xor(s, 4); s += __shfl_xor(s, 8);
      if (fr == 0) red[(wid >> 2) * 128 + m0 + m * 16 + fq * 4 + j] = s;
    }
  __syncthreads();
#pragma unroll
  for (int m = 0; m < 2; ++m)
#pragma unroll
    for (int j = 0; j < 4; ++j) {
      const int il = m0 + m * 16 + fq * 4 + j;
      const float r = rsqrtf((red[il] + red[128 + il]) * (1.f / 256.f) + EPS);
      LAS u16* orow = bbuf + il * PV + n0 + fr;
#pragma unroll
      for (int nn = 0; nn < 8; ++nn) orow[nn * 16] = f2bf(acc[m][nn][j] * r);
    }
  __syncthreads();
  {
    const u16* gbase = p.proj + (size_t)ci * 128 * 4096 + 2048 + h * 256;
    u16* obase = p.cat + (size_t)ci * 128 * 1536 + h * 256;
#pragma unroll 2
    for (int i = tid; i < 128 * 32; i += NTHR) {
      const int r = i >> 5, c = (i & 31) * 8;
      const u32x4 ov = *(const LAS u32x4*)(bbuf + r * PV + c);
      const u32x4 gv = *(const u32x4*)(gbase + (size_t)r * 4096 + c);
      u32x4 o;
#pragma unroll
      for (int e = 0; e < 4; ++e) o[e] = pk2(__uint_as_float(ov[e] << 16) * __uint_as_float(gv[e] << 16), __uint_as_float(ov[e] & 0xffff0000u) * __uint_as_float(gv[e] & 0xffff0000u));
      *(u32x4*)(obase + (size_t)r * 1536 + c) = o;
    }
  }
}
__device__ __forceinline__ void state_item(const P& p, int item) {
  const int b = item >> 3, h = (item >> 1) & 3, dir = item & 1;
  const float w = __expf(128.f * log1pf(-exp2f(-p.l0_decay[dir * 4 + h])));
  const int c_old = dir == 0 ? 2 * b : 2 * b + 1, c_new = dir == 0 ? 2 * b + 1 : 2 * b;
  const float* A = p.part + ((size_t)(c_old * 4 + h) * 2 + dir) * 128 * 256;
  const float* B = p.part + ((size_t)(c_new * 4 + h) * 2 + dir) * 128 * 256;
  float* o = p.out + (size_t)NT * DM + ((size_t)(b * 2 + dir) * 4 + h) * 128 * 256;
  for (int i = threadIdx.x; i < 128 * 64; i += NTHR) *(f32x4*)(o + i * 4) = *(const f32x4*)(A + i * 4) * w + *(const f32x4*)(B + i * 4);
}
__device__ __forceinline__ void phase_mix_b(const P& p, LAS u16* lds) {
  for (int it = blockIdx.x; it < 320; it += gridDim.x) { if (it < 192) ret_item(p, it, lds); else state_item(p, it - 192); }
}

__device__ __forceinline__ void phase_conv(const P& p) {
  const u16* pj = p.proj;
  for (size_t i = (size_t)blockIdx.x * NTHR + threadIdx.x; i < (size_t)NT * 256; i += (size_t)gridDim.x * NTHR) {
    const int t = (int)(i >> 8), c4 = (int)(i & 255) * 4;
    const int seg = t < NPROMPT_T ? 256 : 64;
    const int pos = t < NPROMPT_T ? (t & 255) : ((t - NPROMPT_T) & 63);
    f32x4 xc[3];
#pragma unroll
    for (int d = 0; d < 3; ++d) {
      const int pp = pos + d - 1;
      if (pp < 0 || pp >= seg) { xc[d] = (f32x4){0.f, 0.f, 0.f, 0.f}; continue; }
      const u16* r = pj + (size_t)(t + d - 1) * 3072;
      const u32x2 a = *(const u32x2*)(r + 1024 + c4), b = *(const u32x2*)(r + 2048 + c4);
      xc[d][0] = __uint_as_float(a[0] << 16) * __uint_as_float(b[0] << 16);
      xc[d][1] = __uint_as_float(a[0] & 0xffff0000u) * __uint_as_float(b[0] & 0xffff0000u);
      xc[d][2] = __uint_as_float(a[1] << 16) * __uint_as_float(b[1] << 16);
      xc[d][3] = __uint_as_float(a[1] & 0xffff0000u) * __uint_as_float(b[1] & 0xffff0000u);
    }
    const f32x4 w0 = *(const f32x4*)(p.l1_conv + c4), w1 = *(const f32x4*)(p.l1_conv + 1024 + c4), w2 = *(const f32x4*)(p.l1_conv + 2048 + c4);
    const u32x2 bgv = *(const u32x2*)(pj + (size_t)t * 3072 + c4);
    f32x4 bg = {__uint_as_float(bgv[0] << 16), __uint_as_float(bgv[0] & 0xffff0000u), __uint_as_float(bgv[1] << 16), __uint_as_float(bgv[1] & 0xffff0000u)};
    const f32x4 y = bg * (w0 * xc[0] + w1 * xc[1] + w2 * xc[2]);
    u32x2 o; o[0] = pk2(y[0], y[1]); o[1] = pk2(y[2], y[3]);
    *(u32x2*)(p.cat + (size_t)t * 1024 + c4) = o;
  }
}


#define XB_TMO      128
#define XB_XCNT(j)  (256  + 64 * (j))
#define XB_XSUB(j)  (1280 + 64 * (j))
#define XB_XGEN(j)  (2304 + 64 * (j))
#define XB_TOP      3328
#define XB_TOPGEN   3392
#define XCD_BAR_WORDS 3456
#define XB_SPIN_CAP (1u << 18)
__device__ __forceinline__ unsigned xb_ld(unsigned* p)              { return __hip_atomic_load(p, __ATOMIC_RELAXED, __HIP_MEMORY_SCOPE_AGENT); }
__device__ __forceinline__ unsigned xb_add(unsigned* p, unsigned v) { return __hip_atomic_fetch_add(p, v, __ATOMIC_RELAXED, __HIP_MEMORY_SCOPE_AGENT); }
__device__ __forceinline__ unsigned xb_xcc_id() { return (unsigned)__builtin_amdgcn_s_getreg((3 << 11) | 20) & 0xFu; }
#define XB_SPIN(cond, bar) do { unsigned _sp = 0; while (cond) { __builtin_amdgcn_s_sleep(1); \
    if ((++_sp & 255u) == 0u) { if (xb_ld(&(bar)[XB_TMO])) break; if (_sp > XB_SPIN_CAP) { atomicAdd(&(bar)[XB_TMO], 1u); break; } } } } while (0)
struct XcdBarrier { unsigned* bar; unsigned x; volatile __attribute__((address_space(3))) unsigned* st; };
__device__ __forceinline__ XcdBarrier xcd_barrier_post(unsigned* bar, volatile __attribute__((address_space(3))) unsigned* st) {
  XcdBarrier b; b.bar = bar; b.x = xb_xcc_id(); b.st = st;
  if (threadIdx.x == 0) (void)xb_add(&bar[XB_XCNT(b.x)], 1u);
  return b;
}
__device__ __forceinline__ void xcd_barrier_complete(unsigned* bar, unsigned x, unsigned& nloc, unsigned& nx) {
  const unsigned G = gridDim.x * gridDim.y * gridDim.z;
  unsigned sum, cnt, mine, sp = 0u;
  for (;;) {
    sum = 0u; cnt = 0u; mine = 0u;
#pragma unroll
    for (unsigned j = 0; j < 16; ++j) { const unsigned c = xb_ld(&bar[XB_XCNT(j)]); sum += c; cnt += (c > 0u) ? 1u : 0u; mine = (j == x) ? c : mine; }
    if (sum == G) break;
    __builtin_amdgcn_s_sleep(1);
    if ((++sp & 255u) == 0u) { if (xb_ld(&bar[XB_TMO])) break; if (sp > XB_SPIN_CAP) { atomicAdd(&bar[XB_TMO], 1u); break; } }
  }
  nloc = mine > 0u ? mine : 1u; nx = cnt > 0u ? cnt : 1u;
}
__device__ __forceinline__ void xcd_barrier(const XcdBarrier& b) {
  asm volatile("s_waitcnt vmcnt(0)" ::: "memory");
  __syncthreads();
  if (threadIdx.x == 0) {
    unsigned* bar = b.bar;
    __builtin_amdgcn_s_waitcnt(0);
    unsigned nloc = b.st[0], nx = b.st[1];
    if (nloc == 0u) { xcd_barrier_complete(bar, b.x, nloc, nx); b.st[0] = nloc; b.st[1] = nx; }
    const unsigned old = xb_add(&bar[XB_XSUB(b.x)], 1u);
    const unsigned gen = old / nloc;
    if (old + 1u == (gen + 1u) * nloc) {
      __builtin_amdgcn_fence(__ATOMIC_RELEASE, "agent");
      asm volatile("s_waitcnt vmcnt(0)" ::: "memory");
      const unsigned og = xb_add(&bar[XB_TOP], 1u);
      const unsigned tg = og / nx;
      if (og + 1u == (tg + 1u) * nx) xb_add(&bar[XB_TOPGEN], 1u);
      else XB_SPIN(xb_ld(&bar[XB_TOPGEN]) == tg, bar);
      __builtin_amdgcn_fence(__ATOMIC_ACQUIRE, "agent");
      xb_add(&bar[XB_XGEN(b.x)], 1u);
      asm volatile("s_waitcnt vmcnt(0)" ::: "memory");
    } else {
      XB_SPIN(xb_ld(&bar[XB_XGEN(b.x)]) == gen, bar);
      __builtin_amdgcn_fence(__ATOMIC_ACQUIRE, "agent");
      asm volatile("s_waitcnt vmcnt(0)" ::: "memory");
    }
  }
  __syncthreads();
}

constexpr int NPHASE = 17;
#ifndef REPMASK
#define REPMASK 0
#endif
__global__ void __launch_bounds__(NTHR) mega(P p, int lo, int hi) {
  extern __shared__ __attribute__((aligned(16))) unsigned char smem[];
  float* lds = (float*)smem;
  cg::grid_group grid = cg::this_grid();
  volatile LAS unsigned* xst = (volatile LAS unsigned*)(smem + 131072);
  if (threadIdx.x == 0) { xst[0] = 0u; xst[1] = 0u; }
  __syncthreads();
  const XcdBarrier xb = xcd_barrier_post(p.bar, xst);
  if (hi < 0) grid.sync();
  const float* m0 = p.mod; const float* m1 = p.mod + 3 * 6144;
#define PH(n, ...) if (lo <= (n) && (n) < hi) { if ((n) > lo) xcd_barrier(xb); __VA_ARGS__ if ((REPMASK >> (n)) & 1) { xcd_barrier(xb); __VA_ARGS__ } }
  PH(0, phase_prep(p, lds);)
  PH(1, { NormArgs a{p.x_prompt, p.x_sample, nullptr, nullptr, nullptr, nullptr, p.l0_norm1, m0 + 0, m0 + 1024, p.hA, nullptr}; phase_norm(a); })
  PH(2, { EpiProj0 e{p.proj}; phase_gemm(p.hA, p.wt0_in, NT, 4096, 1024, 1, e, lds); phase_prep2(p, lds, 0, 128); })
  PH(3, phase_mix_a(p, (LAS u16*)smem);)
  PH(4, phase_mix_b(p, (LAS u16*)smem);)
  PH(5, { EpiPart e{p.part}; phase_gemm(p.cat, p.wt0_out, NT, 1024, 1536, 2, e, lds); phase_prep2(p, lds, 1, 192); })
  PH(6, { NormArgs a{p.x_prompt, p.x_sample, p.part, p.part + (size_t)NT * DM, m0 + 2048, p.xres, p.l0_norm2, m0 + 3072, m0 + 4096, p.hA, nullptr}; phase_norm(a); })
  PH(7, { EpiRelu2 e{p.proj}; phase_gemm(p.hA, p.wt0_f1, NT, 4096, 1024, 1, e, lds); })
  PH(8, { EpiPart e{p.part}; phase_gemm(p.proj, p.wt0_f2, NT, 1024, 4096, 2, e, lds); phase_prep2(p, lds, 2, 192); })
  PH(9, { NormArgs a{p.xres, p.xres + (size_t)NPROMPT_T * DM, p.part, p.part + (size_t)NT * DM, m0 + 5120, p.xres, p.l1_norm1, m1 + 0, m1 + 1024, p.hA, nullptr}; phase_norm(a); })
  PH(10, { EpiPlain e{p.proj, 3072}; phase_gemm(p.hA, p.wt1_in, NT, 3072, 1024, 1, e, lds); })
  PH(11, phase_conv(p);)
  PH(12, { EpiPart e{p.part}; phase_gemm(p.cat, p.wt1_out, NT, 1024, 1024, 2, e, lds); })
  PH(13, { NormArgs a{p.xres, p.xres + (size_t)NPROMPT_T * DM, p.part, p.part + (size_t)NT * DM, m1 + 2048, p.xres, p.l1_norm2, m1 + 3072, m1 + 4096, p.hA, nullptr}; phase_norm(a); })
  PH(14, { EpiRelu2 e{p.proj}; phase_gemm(p.hA, p.wt1_f1, NT, 4096, 1024, 1, e, lds); })
  PH(15, { EpiPart e{p.part}; phase_gemm(p.proj, p.wt1_f2, NT, 1024, 4096, 2, e, lds); })
  PH(16, { NormArgs a{p.xres, p.xres + (size_t)NPROMPT_T * DM, p.part, p.part + (size_t)NT * DM, m1 + 5120, nullptr, p.final_norm, nullptr, nullptr, nullptr, p.out}; phase_norm(a); })
#undef PH
}

constexpr size_t LDS_BYTES = 131072 + 256;
constexpr bool ONE_LAUNCH = true;

extern "C" void kernel_launch(void* const* d_in, const int* in_sizes, int n_in, void* d_out, int out_size, void* d_ws, size_t ws_size, hipStream_t stream) {
  static int grid_blocks = 0;
  if (!grid_blocks) {
    hipFuncSetAttribute((const void*)mega, hipFuncAttributeMaxDynamicSharedMemorySize, (int)LDS_BYTES);
    int dev = 0, cus = 0, per_cu = 0;
    hipGetDevice(&dev);
    hipDeviceGetAttribute(&cus, hipDeviceAttributeMultiprocessorCount, dev);
    hipOccupancyMaxActiveBlocksPerMultiprocessor(&per_cu, mega, NTHR, LDS_BYTES);
    if (per_cu < 1) per_cu = 1;
    if (per_cu > 1) per_cu = 1;
    grid_blocks = cus * per_cu;
  }
  P p{};
  const float* const* in = (const float* const*)d_in;
  p.x_prompt = in[0]; p.x_sample = in[1]; p.state = in[2]; p.c = in[3]; p.c_ctx = in[4];
  p.l0_norm1 = in[5]; p.l0_w_in = in[6]; p.l0_decay = in[7]; p.l0_gws = in[8]; p.l0_gb = in[9]; p.l0_w_out = in[10]; p.l0_norm2 = in[11];
  p.l0_w_mod = in[12]; p.l0_b_mod = in[13]; p.l0_f1 = in[14]; p.l0_f2 = in[15];
  p.l1_norm1 = in[16]; p.l1_w_in = in[17]; p.l1_conv = in[18]; p.l1_w_out = in[19]; p.l1_norm2 = in[20]; p.l1_w_mod = in[21]; p.l1_b_mod = in[22];
  p.l1_f1 = in[23]; p.l1_f2 = in[24]; p.final_norm = in[25];
  p.out = (float*)d_out;
  unsigned char* w = (unsigned char*)d_ws; size_t off = 0;
  auto take = [&](size_t bytes) { void* r = w + off; off += (bytes + 255) & ~(size_t)255; return r; };
  p.wt0_in = (u16*)take((size_t)4096 * 1024 * 2); p.wt0_out = (u16*)take((size_t)1024 * 1536 * 2);
  p.wt0_f1 = (u16*)take((size_t)4096 * 1024 * 2); p.wt0_f2 = (u16*)take((size_t)4096 * 1024 * 2);
  p.wt1_in = (u16*)take((size_t)3072 * 1024 * 2); p.wt1_out = (u16*)take((size_t)1024 * 1024 * 2);
  p.wt1_f1 = (u16*)take((size_t)4096 * 1024 * 2); p.wt1_f2 = (u16*)take((size_t)4096 * 1024 * 2);
  p.mod = (float*)take((size_t)2 * 3 * 6144 * 4);
  p.hA = (u16*)take((size_t)NT * 1024 * 2);
  p.proj = (u16*)take((size_t)NT * 4096 * 2);
  p.cat = (u16*)take((size_t)NT * 1536 * 2);
  p.part = (float*)take((size_t)2 * NT * 1024 * 4);
  p.xres = (float*)take((size_t)NT * 1024 * 4);
  p.bar = (unsigned*)take((size_t)XCD_BAR_WORDS * 4);
  hipMemsetAsync(p.bar, 0, (size_t)XCD_BAR_WORDS * 4, stream);
  if (ONE_LAUNCH) {
    int lo = 0, hi = NPHASE; void* args[] = {&p, &lo, &hi};
    hipError_t e = hipLaunchCooperativeKernel((void*)mega, dim3(grid_blocks), dim3(NTHR), args, LDS_BYTES, stream);
    if (e != hipSuccess) fprintf(stderr, "cooperative launch failed: %s (grid %d)\n", hipGetErrorString(e), grid_blocks);
  } else {
    for (int ph = 0; ph < NPHASE; ++ph) hipLaunchKernelGGL(mega, dim3(grid_blocks), dim3(NTHR), LDS_BYTES, stream, p, ph, ph + 1);
  }
}
```

```cpp
#include <hip/hip_runtime.h>
#include <hip/hip_cooperative_groups.h>
#include <cstdio>
namespace cg = cooperative_groups;

typedef unsigned short u16;
typedef float f32x4 __attribute__((ext_vector_type(4)));
typedef unsigned u32x4 __attribute__((ext_vector_type(4)));
typedef unsigned u32x2 __attribute__((ext_vector_type(2)));

constexpr int NT = 6144, DM = 1024, NPROMPT_T = 4096;
constexpr float EPS = 1e-6f;
constexpr int NTHR = 512;

__device__ __forceinline__ float bf2f(u16 b) { return __uint_as_float(((unsigned)b) << 16); }
typedef float f32x2 __attribute__((ext_vector_type(2)));
typedef __bf16 hbf16x2 __attribute__((ext_vector_type(2)));
__device__ __forceinline__ unsigned pk2(float a, float b) { const f32x2 v = {a, b}; const hbf16x2 r = __builtin_convertvector(v, hbf16x2); return __builtin_bit_cast(unsigned, r); }
__device__ __forceinline__ u16 f2bf(float f) { return (u16)(pk2(f, 0.f) & 0xffffu); }
__device__ __forceinline__ float silu_f(float x) { return x * __builtin_amdgcn_rcpf(1.f + __expf(-x)); }
__device__ __forceinline__ float gelu_f(float x) { const float u = -1.5957691216057308f * (x + 0.044715f * x * x * x); return x * __builtin_amdgcn_rcpf(1.f + __expf(u)); }
__device__ __forceinline__ int cond_of(int t) { return t < NPROMPT_T ? 0 : 1 + ((t - NPROMPT_T) >> 10); }
__device__ __forceinline__ float wave_sum(float v) {
#pragma unroll
  for (int o = 32; o > 0; o >>= 1) v += __shfl_xor(v, o);
  return v;
}

struct P {
  const float *x_prompt, *x_sample, *state, *c, *c_ctx;
  const float *l0_norm1, *l0_w_in, *l0_decay, *l0_gws, *l0_gb, *l0_w_out, *l0_norm2, *l0_w_mod, *l0_b_mod, *l0_f1, *l0_f2;
  const float *l1_norm1, *l1_w_in, *l1_conv, *l1_w_out, *l1_norm2, *l1_w_mod, *l1_b_mod, *l1_f1, *l1_f2, *final_norm;
  float* out;
  u16 *wt0_in, *wt0_out, *wt0_f1, *wt0_f2, *wt1_in, *wt1_out, *wt1_f1, *wt1_f2;
  float* mod;
  u16* hA;
  u16* proj;
  u16* cat;
  float* part;
  float* xres;
  unsigned* bar;
};

__device__ __forceinline__ void transpose_tile(const float* __restrict__ W, int K, int N, u16* __restrict__ Wt, int tile, float* lds) {
  const int tn = N / 256; const int k0 = (tile / tn) * 64, n0 = (tile % tn) * 256;
  const int tid = threadIdx.x;
  float (*T)[257] = (float (*)[257])lds;
  __syncthreads();
  {
    const int r = tid >> 6, c4 = (tid & 63) * 4;
    f32x4 v[8];
#pragma unroll
    for (int i = 0; i < 8; ++i) v[i] = *(const f32x4*)(W + (size_t)(k0 + r + 8 * i) * N + n0 + c4);
#pragma unroll
    for (int i = 0; i < 8; ++i) { T[r + 8 * i][c4 + 0] = v[i][0]; T[r + 8 * i][c4 + 1] = v[i][1]; T[r + 8 * i][c4 + 2] = v[i][2]; T[r + 8 * i][c4 + 3] = v[i][3]; }
  }
  __syncthreads();
  {
    const int kk = (tid & 7) * 8;
#pragma unroll
    for (int ps = 0; ps < 4; ++ps) {
      const int nn = (tid >> 3) + 64 * ps;
      u32x4 o;
      o[0] = pk2(T[kk + 0][nn], T[kk + 1][nn]); o[1] = pk2(T[kk + 2][nn], T[kk + 3][nn]);
      o[2] = pk2(T[kk + 4][nn], T[kk + 5][nn]); o[3] = pk2(T[kk + 6][nn], T[kk + 7][nn]);
      *(u32x4*)(Wt + (size_t)(n0 + nn) * K + k0 + kk) = o;
    }
  }
}

__device__ __forceinline__ void adaln_item(const P& p, int item, float* lds) {
  const int l = item / 96, n0 = (item % 96) * 64;
  const float* W = l ? p.l1_w_mod : p.l0_w_mod; const float* B = l ? p.l1_b_mod : p.l0_b_mod;
  const int tid = threadIdx.x;
  float* sc = lds;
  float* red = lds + 3072;
  __syncthreads();
  for (int i = tid; i < 3072; i += NTHR) {
    const int c = i >> 10, k = i & 1023;
    const float v = c == 0 ? p.c_ctx[k] : p.c[(c - 1) * 1024 + k];
    sc[i] = silu_f(v);
  }
  __syncthreads();
  const int cg4 = tid & 15, rg = tid >> 4;
  float acc[3][4] = {};
#pragma unroll 8
  for (int it = 0; it < 32; ++it) {
    const int k = it * 32 + rg;
    const f32x4 w = *(const f32x4*)(W + (size_t)k * 6144 + n0 + cg4 * 4);
#pragma unroll
    for (int c = 0; c < 3; ++c) { const float s = sc[c * 1024 + k];
#pragma unroll
      for (int e = 0; e < 4; ++e) acc[c][e] += s * w[e]; }
  }
#pragma unroll
  for (int c = 0; c < 3; ++c)
#pragma unroll
    for (int e = 0; e < 4; ++e) red[(rg * 3 + c) * 64 + cg4 * 4 + e] = acc[c][e];
  __syncthreads();
  if (tid < 192) {
    const int c = tid >> 6, n = tid & 63; float s = B[n0 + n];
    for (int r = 0; r < 32; ++r) s += red[(r * 3 + c) * 64 + n];
    p.mod[(size_t)(l * 3 + c) * 6144 + n0 + n] = s;
  }
}

__device__ __forceinline__ void phase_prep(const P& p, float* lds) {
  for (int it = blockIdx.x; it < 96 + 256; it += gridDim.x) {
    if (it < 96) adaln_item(p, it, lds); else transpose_tile(p.l0_w_in, 1024, 4096, p.wt0_in, it - 96, lds);
  }
}
__device__ __forceinline__ void phase_prep2(const P& p, float* lds, int group, int first_want) {
  const int first = (int)gridDim.x >= 256 ? first_want : 0, nblk = (int)gridDim.x - first;
  if ((int)blockIdx.x < first) return;
  const int total = group == 0 ? 96 + 256 + 256 : (group == 1 ? 96 + 192 + 64 : 256 + 256);
  for (int it = (int)blockIdx.x - first; it < total; it += nblk) {
    int i = it;
    if (group == 0) {
      if (i < 96) { transpose_tile(p.l0_w_out, 1536, 1024, p.wt0_out, i, lds); continue; } i -= 96;
      if (i < 256) { transpose_tile(p.l0_f1, 1024, 4096, p.wt0_f1, i, lds); continue; } i -= 256;
      transpose_tile(p.l0_f2, 4096, 1024, p.wt0_f2, i, lds);
    } else if (group == 1) {
      if (i < 96) { adaln_item(p, 96 + i, lds); continue; } i -= 96;
      if (i < 192) { transpose_tile(p.l1_w_in, 1024, 3072, p.wt1_in, i, lds); continue; } i -= 192;
      transpose_tile(p.l1_w_out, 1024, 1024, p.wt1_out, i, lds);
    } else {
      if (i < 256) { transpose_tile(p.l1_f1, 1024, 4096, p.wt1_f1, i, lds); continue; } i -= 256;
      transpose_tile(p.l1_f2, 4096, 1024, p.wt1_f2, i, lds);
    }
  }
}

struct NormArgs {
  const float* xin0; const float* xin1;
  const float* p0; const float* p1; const float* gate;
  float* xout; const float* nw; const float* sh; const float* sc;
  u16* hout; float* fout;
};
__device__ __forceinline__ void norm_row(const NormArgs& a, int t, int lane) {
  {
    const int c = cond_of(t);
    const float* xr = t < NPROMPT_T ? a.xin0 + (size_t)t * DM : a.xin1 + (size_t)(t - NPROMPT_T) * DM;
    f32x4 x[4]; float ss = 0.f;
#pragma unroll
    for (int i = 0; i < 4; ++i) {
      const int col = lane * 4 + 256 * i;
      x[i] = *(const f32x4*)(xr + col);
      if (a.p0) {
        const u32x2 q0 = *(const u32x2*)((const u16*)a.p0 + (size_t)t * DM + col), q1 = *(const u32x2*)((const u16*)a.p0 + (size_t)(NT + t) * DM + col);
        const f32x4 g = *(const f32x4*)(a.gate + (size_t)c * 6144 + col);
        f32x4 ps;
        ps[0] = __uint_as_float(q0[0] << 16) + __uint_as_float(q1[0] << 16); ps[1] = __uint_as_float(q0[0] & 0xffff0000u) + __uint_as_float(q1[0] & 0xffff0000u);
        ps[2] = __uint_as_float(q0[1] << 16) + __uint_as_float(q1[1] << 16); ps[3] = __uint_as_float(q0[1] & 0xffff0000u) + __uint_as_float(q1[1] & 0xffff0000u);
        x[i] = x[i] + g * ps;
      }
      if (a.xout) *(f32x4*)(a.xout + (size_t)t * DM + col) = x[i];
      ss += x[i][0] * x[i][0] + x[i][1] * x[i][1] + x[i][2] * x[i][2] + x[i][3] * x[i][3];
    }
    ss = wave_sum(ss);
    const float r = rsqrtf(ss * (1.f / 1024.f) + EPS);
#pragma unroll
    for (int i = 0; i < 4; ++i) {
      const int col = lane * 4 + 256 * i;
      const f32x4 w = *(const f32x4*)(a.nw + col);
      f32x4 y = x[i] * r * w;
      if (a.fout) *(f32x4*)(a.fout + (size_t)t * DM + col) = y;
      if (a.hout) {
        const f32x4 sh = *(const f32x4*)(a.sh + (size_t)c * 6144 + col), sc = *(const f32x4*)(a.sc + (size_t)c * 6144 + col);
        y = y * (1.f + sc) + sh;
        u32x2 o; o[0] = pk2(y[0], y[1]); o[1] = pk2(y[2], y[3]);
        *(u32x2*)(a.hout + (size_t)t * DM + col) = o;
      }
    }
  }
}
template <int R>
__device__ __forceinline__ void norm_rows(const NormArgs& a, int t0, int lane) {
  const int c = cond_of(t0);
  f32x4 x[R][4];
#pragma unroll
  for (int r = 0; r < R; ++r) {
    const int t = t0 + r;
    const float* xr = t < NPROMPT_T ? a.xin0 + (size_t)t * DM : a.xin1 + (size_t)(t - NPROMPT_T) * DM;
#pragma unroll
    for (int i = 0; i < 4; ++i) x[r][i] = *(const f32x4*)(xr + lane * 4 + 256 * i);
  }
  if (a.p0) {
    u32x2 q0[R][4], q1[R][4];
#pragma unroll
    for (int r = 0; r < R; ++r)
#pragma unroll
      for (int i = 0; i < 4; ++i) {
        const size_t o = (size_t)(t0 + r) * DM + lane * 4 + 256 * i;
        q0[r][i] = *(const u32x2*)((const u16*)a.p0 + o); q1[r][i] = *(const u32x2*)((const u16*)a.p0 + (size_t)NT * DM + o);
      }
#pragma unroll
    for (int i = 0; i < 4; ++i) {
      const f32x4 g = *(const f32x4*)(a.gate + (size_t)c * 6144 + lane * 4 + 256 * i);
#pragma unroll
      for (int r = 0; r < R; ++r) {
        f32x4 ps;
        ps[0] = __uint_as_float(q0[r][i][0] << 16) + __uint_as_float(q1[r][i][0] << 16); ps[1] = __uint_as_float(q0[r][i][0] & 0xffff0000u) + __uint_as_float(q1[r][i][0] & 0xffff0000u);
        ps[2] = __uint_as_float(q0[r][i][1] << 16) + __uint_as_float(q1[r][i][1] << 16); ps[3] = __uint_as_float(q0[r][i][1] & 0xffff0000u) + __uint_as_float(q1[r][i][1] & 0xffff0000u);
        x[r][i] = x[r][i] + g * ps;
      }
    }
  }
  float rs[R];
#pragma unroll
  for (int r = 0; r < R; ++r) {
    float ss = 0.f;
#pragma unroll
    for (int i = 0; i < 4; ++i) {
      if (a.xout) *(f32x4*)(a.xout + (size_t)(t0 + r) * DM + lane * 4 + 256 * i) = x[r][i];
      ss += x[r][i][0] * x[r][i][0] + x[r][i][1] * x[r][i][1] + x[r][i][2] * x[r][i][2] + x[r][i][3] * x[r][i][3];
    }
    ss = wave_sum(ss);
    rs[r] = rsqrtf(ss * (1.f / 1024.f) + EPS);
  }
#pragma unroll
  for (int i = 0; i < 4; ++i) {
    const int col = lane * 4 + 256 * i;
    const f32x4 w = *(const f32x4*)(a.nw + col);
    f32x4 sh = {0.f, 0.f, 0.f, 0.f}, sc = {0.f, 0.f, 0.f, 0.f};
    if (a.hout) { sh = *(const f32x4*)(a.sh + (size_t)c * 6144 + col); sc = *(const f32x4*)(a.sc + (size_t)c * 6144 + col); }
#pragma unroll
    for (int r = 0; r < R; ++r) {
      f32x4 y = x[r][i] * rs[r] * w;
      if (a.fout) *(f32x4*)(a.fout + (size_t)(t0 + r) * DM + col) = y;
      if (a.hout) {
        y = y * (1.f + sc) + sh;
        u32x2 o; o[0] = pk2(y[0], y[1]); o[1] = pk2(y[2], y[3]);
        *(u32x2*)(a.hout + (size_t)(t0 + r) * DM + col) = o;
      }
    }
  }
}
__device__ __forceinline__ void phase_norm(const NormArgs& a) {
  const int wid = threadIdx.x >> 6, lane = threadIdx.x & 63;
  for (int g = blockIdx.x * 8 + wid; g < NT / 4; g += gridDim.x * 8) norm_rows<4>(a, g * 4, lane);
}
struct EpiProj0 {
  u16* O;
  __device__ __forceinline__ void store8(int row, int col, f32x4 v0, f32x4 v1, int) const {
    if (col >= 3072) {
#pragma unroll
      for (int e = 0; e < 4; ++e) { v0[e] = gelu_f(v0[e]); v1[e] = gelu_f(v1[e]); }
    } else if (col >= 2048) {
#pragma unroll
      for (int e = 0; e < 4; ++e) { v0[e] = silu_f(v0[e]); v1[e] = silu_f(v1[e]); }
    } else if (col >= 512 && col < 1024) { v0 = v0 * 0.08838834764831845f; v1 = v1 * 0.08838834764831845f; }
    u32x4 o; o[0] = pk2(v0[0], v0[1]); o[1] = pk2(v0[2], v0[3]); o[2] = pk2(v1[0], v1[1]); o[3] = pk2(v1[2], v1[3]);
    *(u32x4*)(O + (size_t)row * 4096 + col) = o;
  }
  __device__ __forceinline__ void store4(int row, int col, f32x4 v, int) const {
    if (col >= 3072) { v[0] = gelu_f(v[0]); v[1] = gelu_f(v[1]); v[2] = gelu_f(v[2]); v[3] = gelu_f(v[3]); }
    else if (col >= 2048) { v[0] = silu_f(v[0]); v[1] = silu_f(v[1]); v[2] = silu_f(v[2]); v[3] = silu_f(v[3]); }
    else if (col >= 512 && col < 1024) v = v * 0.08838834764831845f;
    u32x2 o; o[0] = pk2(v[0], v[1]); o[1] = pk2(v[2], v[3]);
    *(u32x2*)(O + (size_t)row * 4096 + col) = o;
  }
};
struct EpiPart {
  float* Pp;
  __device__ __forceinline__ void store8(int row, int col, f32x4 v0, f32x4 v1, int ks) const {
    u32x4 o; o[0] = pk2(v0[0], v0[1]); o[1] = pk2(v0[2], v0[3]); o[2] = pk2(v1[0], v1[1]); o[3] = pk2(v1[2], v1[3]);
    *(u32x4*)((u16*)Pp + ((size_t)ks * NT + row) * DM + col) = o;
  }
};
struct EpiRelu2 {
  u16* O;
  __device__ __forceinline__ void store8(int row, int col, f32x4 v0, f32x4 v1, int) const {
#pragma unroll
    for (int e = 0; e < 4; ++e) { const float r0 = fmaxf(v0[e], 0.f), r1 = fmaxf(v1[e], 0.f); v0[e] = r0 * r0; v1[e] = r1 * r1; }
    u32x4 o; o[0] = pk2(v0[0], v0[1]); o[1] = pk2(v0[2], v0[3]); o[2] = pk2(v1[0], v1[1]); o[3] = pk2(v1[2], v1[3]);
    *(u32x4*)(O + (size_t)row * 4096 + col) = o;
  }
  __device__ __forceinline__ void store4(int row, int col, f32x4 v, int) const {
#pragma unroll
    for (int e = 0; e < 4; ++e) { const float r = fmaxf(v[e], 0.f); v[e] = r * r; }
    u32x2 o; o[0] = pk2(v[0], v[1]); o[1] = pk2(v[2], v[3]);
    *(u32x2*)(O + (size_t)row * 4096 + col) = o;
  }
};
struct EpiPlain {
  u16* O; int ld;
  __device__ __forceinline__ void store8(int row, int col, f32x4 v0, f32x4 v1, int) const {
    u32x4 o; o[0] = pk2(v0[0], v0[1]); o[1] = pk2(v0[2], v0[3]); o[2] = pk2(v1[0], v1[1]); o[3] = pk2(v1[2], v1[3]);
    *(u32x4*)(O + (size_t)row * ld + col) = o;
  }
  __device__ __forceinline__ void store4(int row, int col, f32x4 v, int) const {
    u32x2 o; o[0] = pk2(v[0], v[1]); o[1] = pk2(v[2], v[3]);
    *(u32x2*)(O + (size_t)row * ld + col) = o;
  }
};

template <class Epi>
__device__ __forceinline__ void phase_gemm_naive(const u16* __restrict__ A, const u16* __restrict__ Bt, int M, int N, int K, int ksplit, const Epi& E, float* lds) {
  float (*As)[33] = (float (*)[33])lds;
  float (*Bs)[33] = (float (*)[33])(lds + 128 * 33);
  const int tm = M / 128, tn = N / 64, total = tm * tn * ksplit, kper = K / ksplit;
  const int tid = threadIdx.x, r = tid >> 2, cq = tid & 3;
  for (int it = blockIdx.x; it < total; it += gridDim.x) {
    const int ks = it / (tm * tn), rem = it % (tm * tn), m0 = (rem / tn) * 128, n0 = (rem % tn) * 64;
    float acc[4][4] = {};
    for (int k0 = ks * kper; k0 < (ks + 1) * kper; k0 += 32) {
      __syncthreads();
      {
        const int kc = (tid & 3) * 8;
        const u32x4 va = *(const u32x4*)(A + (size_t)(m0 + r) * K + k0 + kc);
#pragma unroll
        for (int e = 0; e < 4; ++e) { As[r][kc + 2 * e] = __uint_as_float(va[e] << 16); As[r][kc + 2 * e + 1] = __uint_as_float(va[e] & 0xffff0000u); }
        if (tid < 256) {
          const u32x4 vb = *(const u32x4*)(Bt + (size_t)(n0 + r) * K + k0 + kc);
#pragma unroll
          for (int e = 0; e < 4; ++e) { Bs[r][kc + 2 * e] = __uint_as_float(vb[e] << 16); Bs[r][kc + 2 * e + 1] = __uint_as_float(vb[e] & 0xffff0000u); }
        }
      }
      __syncthreads();
#pragma unroll 4
      for (int k = 0; k < 32; ++k) {
        const float a = As[r][k];
#pragma unroll
        for (int jj = 0; jj < 4; ++jj)
#pragma unroll
          for (int e = 0; e < 4; ++e) acc[jj][e] += a * Bs[cq * 4 + 16 * jj + e][k];
      }
    }
#pragma unroll
    for (int jj = 0; jj < 4; ++jj) { f32x4 v = {acc[jj][0], acc[jj][1], acc[jj][2], acc[jj][3]}; E.store4(m0 + r, n0 + cq * 4 + 16 * jj, v, ks); }
  }
}


namespace pg8 {
#define PG8_LAS __attribute__((address_space(3)))
typedef short bf16x8 __attribute__((ext_vector_type(8)));
constexpr int BM = 256, BK = 64, HALF = 128, HTB = HALF * BK * 2, STAGE_BYTES = 8 * HTB, NXCD = 8, WGM = 8;
__device__ __forceinline__ int lds_byte(int r, int c) { const int st = (r >> 4) * 2 + (c >> 5), rr = r & 15, cc = c & 31, ob = rr * 64 + cc * 2; return st * 1024 + (ob ^ (((ob >> 9) & 1) << 5)); }
__device__ __forceinline__ int perm32(int rho) { const int n = rho >> 4, i = rho & 15; return 8 * (i >> 2) + 4 * n + (i & 3); }
__device__ __forceinline__ void stage_rc(int b, int& R, int& C) { const int st = b / 1024, sb = b % 1024, swz = sb ^ (((sb >> 9) & 1) << 5); R = (st >> 1) * 16 + swz / 64; C = (st & 1) * 32 + (swz % 64) / 2; }
struct Unit { int pm, pn, ks; };
struct Gemm { const u16* A; const u16* Bt; int M, N, K, ksplit; };
struct Order {
  int nM, nN, ntile, nwg, G, c;
  __device__ void init(int M, int N, int ksplit, int G_, int c_) { nM = M / BM; nN = N / BM; ntile = nM * nN; nwg = ntile * ksplit; G = G_; c = c_; }
  __device__ bool next(int i, Unit& u) const {
    const int L = i * G + c; if (L >= nwg) return false;
    u.ks = L / ntile; int wgid = L % ntile;
    { const int q = ntile / NXCD, r = ntile % NXCD, xcd = wgid % NXCD, off = wgid / NXCD; wgid = (xcd < r ? xcd * (q + 1) : r * (q + 1) + (xcd - r) * q) + off; }
    const int nig = WGM * nN, gid = wgid / nig, fm = gid * WGM, gsz = (nM - fm) < WGM ? (nM - fm) : WGM;
    u.pm = fm + ((wgid % nig) % gsz); u.pn = (wgid % nig) / gsz; return true;
  }
};
template <class Epi>
__device__ __forceinline__ void run_epi(const Epi& E, const f32x4 (&acc)[2][2][4][2], const Unit& u, int wr, int wc, int fr, int fq) {
  const int row0 = u.pm * BM + wr * 64 + fr, col0 = u.pn * BM + wc * 32 + 8 * fq;
#pragma unroll
  for (int ai = 0; ai < 2; ++ai)
#pragma unroll
    for (int m = 0; m < 4; ++m)
#pragma unroll
      for (int bj = 0; bj < 2; ++bj) E.store8(row0 + ai * HALF + m * 16, col0 + bj * HALF, acc[ai][bj][m][0], acc[ai][bj][m][1], u.ks);
}
template <class Epi>
__device__ __forceinline__ void gemm_phase(PG8_LAS unsigned char* lds, const Gemm g, const Order& S, const Epi& E) {
  const int tid = threadIdx.x, wid = __builtin_amdgcn_readfirstlane(tid >> 6), lane = tid & 63, wr = wid >> 2, wc = wid & 3, fr = lane & 15, fq = lane >> 4;
  const int K = g.K, kper = g.K / g.ksplit, nt = kper / BK;
  unsigned voffA[2], voffB[2];
#pragma unroll
  for (int i = 0; i < 2; ++i) { int R, C; stage_rc(tid * 16 + i * 8192, R, C); const int Rb = (R & ~31) + perm32(R & 31);
    voffA[i] = (unsigned)(R * K + C) * 2u; voffB[i] = (unsigned)(Rb * K + C) * 2u; }
  const size_t kstep = (size_t)(BK * 2);
  const size_t hstep = (size_t)HALF * K * 2;
  const size_t tstep = 2 * hstep;
  const size_t ksbytes = (size_t)kper * 2;
  const unsigned ldsw = (unsigned)wid * 1024u;
  const int aoff = lds_byte(wr * 64 + fr, fq * 8), boff = lds_byte(wc * 32 + fr, fq * 8);
#define PG8_SA(b, h) (((b) * 2 + (h)) * HTB)
#define PG8_SB(b, h) ((4 + (b) * 2 + (h)) * HTB)
#define PG8_STAGE(bufoff, gbase, voff) do { _Pragma("unroll") for (int _i = 0; _i < 2; ++_i) \
    __builtin_amdgcn_global_load_lds((const unsigned*)((const char*)(gbase) + (voff)[_i]), (PG8_LAS unsigned*)(lds + (bufoff) + ldsw + _i * 8192), 16, 0, 0); } while (0)
#define PG8_LDA(dst, b, h) do { _Pragma("unroll") for (int m = 0; m < 4; ++m) _Pragma("unroll") for (int k = 0; k < 2; ++k) dst[m][k] = *(const PG8_LAS bf16x8*)(lds + PG8_SA(b, h) + aoff + m * 2048 + k * 1024); } while (0)
#define PG8_LDB(dst, b, h) do { _Pragma("unroll") for (int n = 0; n < 2; ++n) _Pragma("unroll") for (int k = 0; k < 2; ++k) dst[n][k] = *(const PG8_LAS bf16x8*)(lds + PG8_SB(b, h) + boff + n * 2048 + k * 1024); } while (0)
#define PG8_MMA(ai, bj, At, Bt) do { __builtin_amdgcn_s_setprio(1); _Pragma("unroll") for (int m = 0; m < 4; ++m) _Pragma("unroll") for (int n = 0; n < 2; ++n) _Pragma("unroll") for (int k = 0; k < 2; ++k) \
    acc[ai][bj][m][n] = __builtin_amdgcn_mfma_f32_16x16x32_bf16(Bt[n][k], At[m][k], acc[ai][bj][m][n], 0, 0, 0); __builtin_amdgcn_s_setprio(0); } while (0)
#define PG8_WAIT_V(n) asm volatile("s_waitcnt vmcnt(" #n ")" ::: "memory")
#define PG8_WAIT_L(n) asm volatile("s_waitcnt lgkmcnt(" #n ")" ::: "memory")
#define PG8_BAR __builtin_amdgcn_s_barrier()
#define PG8_SCHED __builtin_amdgcn_sched_barrier(0)
  Unit cur, nxt; int ui = 0;
  if (!S.next(0, cur)) return;
  f32x4 acc[2][2][4][2];
#pragma unroll
  for (int a = 0; a < 2; ++a)
#pragma unroll
    for (int b = 0; b < 2; ++b)
#pragma unroll
      for (int m = 0; m < 4; ++m)
#pragma unroll
        for (int n = 0; n < 2; ++n) acc[a][b][m][n] = (f32x4){0.f, 0.f, 0.f, 0.f};
  bf16x8 At[4][2], B0[2][2], B1[2][2];
  const char* cA = (const char*)g.A + (size_t)cur.pm * tstep + (size_t)cur.ks * ksbytes; const char* cB = (const char*)g.Bt + (size_t)cur.pn * tstep + (size_t)cur.ks * ksbytes;
  PG8_STAGE(PG8_SB(0, 0), cB, voffB); PG8_STAGE(PG8_SA(0, 0), cA, voffA); PG8_STAGE(PG8_SB(0, 1), cB + hstep, voffB); PG8_STAGE(PG8_SA(0, 1), cA + hstep, voffA);
  if (wr == 1) PG8_BAR;
  PG8_WAIT_V(4); PG8_BAR;
  PG8_STAGE(PG8_SB(1, 0), cB + kstep, voffB); PG8_STAGE(PG8_SA(1, 0), cA + kstep, voffA); PG8_STAGE(PG8_SB(1, 1), cB + hstep + kstep, voffB);
  PG8_WAIT_V(6); PG8_BAR;
  for (;;) {
    const bool has_next = S.next(ui + 1, nxt);
    const char* nA = has_next ? (const char*)g.A + (size_t)nxt.pm * tstep + (size_t)nxt.ks * ksbytes : cA; const char* nB = has_next ? (const char*)g.Bt + (size_t)nxt.pn * tstep + (size_t)nxt.ks * ksbytes : cB;
    for (int t = 0; t < nt; t += 2) {
      const bool last = (t == nt - 2);
      const char* a1 = cA + (size_t)(t + 1) * kstep;
      const char* a2 = last ? nA : cA + (size_t)(t + 2) * kstep; const char* b2 = last ? nB : cB + (size_t)(t + 2) * kstep;
      const char* a3 = a2 + kstep; const char* b3 = b2 + kstep;
      PG8_LDB(B0, 0, 0); PG8_SCHED; PG8_LDA(At, 0, 0); PG8_STAGE(PG8_SA(1, 1), a1 + hstep, voffA);
      PG8_WAIT_L(8); PG8_BAR; PG8_WAIT_L(0); PG8_MMA(0, 0, At, B0); PG8_BAR; PG8_SCHED;
      PG8_LDB(B1, 0, 1); PG8_STAGE(PG8_SB(0, 0), b2, voffB);
      PG8_BAR; PG8_WAIT_L(0); PG8_MMA(0, 1, At, B1); PG8_BAR;
      PG8_LDA(At, 0, 1); PG8_STAGE(PG8_SA(0, 0), a2, voffA);
      PG8_BAR; PG8_WAIT_L(0); PG8_MMA(1, 0, At, B0); PG8_BAR; PG8_SCHED;
      PG8_STAGE(PG8_SB(0, 1), b2 + hstep, voffB);
      PG8_WAIT_V(6); PG8_BAR; PG8_MMA(1, 1, At, B1); PG8_BAR;
      PG8_LDB(B0, 1, 0); PG8_SCHED; PG8_LDA(At, 1, 0); PG8_STAGE(PG8_SA(0, 1), a2 + hstep, voffA);
      PG8_WAIT_L(8); PG8_BAR; PG8_WAIT_L(0); PG8_MMA(0, 0, At, B0); PG8_BAR; PG8_SCHED;
      PG8_LDB(B1, 1, 1); PG8_STAGE(PG8_SB(1, 0), b3, voffB);
      PG8_BAR; PG8_WAIT_L(0); PG8_MMA(0, 1, At, B1); PG8_BAR;
      PG8_LDA(At, 1, 1); PG8_STAGE(PG8_SA(1, 0), a3, voffA);
      PG8_BAR; PG8_WAIT_L(0); PG8_MMA(1, 0, At, B0); PG8_BAR; PG8_SCHED;
      PG8_STAGE(PG8_SB(1, 1), b3 + hstep, voffB);
      PG8_WAIT_V(6); PG8_BAR; PG8_MMA(1, 1, At, B1); PG8_BAR;
    }
    run_epi(E, acc, cur, wr, wc, fr, fq);
    if (!has_next) break;
#pragma unroll
    for (int a = 0; a < 2; ++a)
#pragma unroll
      for (int b = 0; b < 2; ++b)
#pragma unroll
        for (int m = 0; m < 4; ++m)
#pragma unroll
          for (int n = 0; n < 2; ++n) acc[a][b][m][n] = (f32x4){0.f, 0.f, 0.f, 0.f};
    cur = nxt; cA = nA; cB = nB; ++ui;
  }
  PG8_WAIT_V(0);
  if (wr == 0) PG8_BAR;
  PG8_BAR;
#undef PG8_SA
#undef PG8_SB
#undef PG8_STAGE
#undef PG8_LDA
#undef PG8_LDB
#undef PG8_MMA
#undef PG8_WAIT_V
#undef PG8_WAIT_L
#undef PG8_BAR
#undef PG8_SCHED
}
}
template <class Epi>
__device__ __forceinline__ void phase_gemm(const u16* A, const u16* Bt, int M, int N, int K, int ksplit, const Epi& E, float* lds) {
  __syncthreads();
  pg8::Gemm g{A, Bt, M, N, K, ksplit};
  pg8::Order S; S.init(M, N, ksplit, (int)gridDim.x, (int)blockIdx.x);
  pg8::gemm_phase(( __attribute__((address_space(3))) unsigned char*)lds, g, S, E);
  __syncthreads();
}

__device__ __forceinline__ void seq_of_token(int t, int& s0, int& L, int& sb) {
  if (t < NPROMPT_T) { s0 = t & ~255; L = 256; sb = -1; } else { sb = (t - NPROMPT_T) >> 10; s0 = NPROMPT_T + (sb << 10); L = 1024; }
}
__device__ __forceinline__ void ret_item_naive(const P& p, int item, float* lds) {
  const int tg = item >> 2, h = item & 3, t0 = tg * 16, tid = threadIdx.x;
  int s0, L, sb; seq_of_token(t0, s0, L, sb);
  float* scr = lds;
  float* qs = lds + 16 * 1024;
  float* red = qs + 16 * 128;
  const float lgf = log1pf(-exp2f(-p.l0_decay[h])), lgb = log1pf(-exp2f(-p.l0_decay[4 + h]));
  __syncthreads();
  for (int i = tid; i < 16 * 128; i += NTHR) qs[i] = bf2f(p.proj[(size_t)(t0 + (i >> 7)) * 4096 + h * 128 + (i & 127)]);
  __syncthreads();
  for (int j = tid; j < L; j += NTHR) {
    float acc[16] = {};
    const u16* kr = p.proj + (size_t)(s0 + j) * 4096 + 512 + h * 128;
    for (int d0 = 0; d0 < 128; d0 += 8) {
      const u32x4 kv = *(const u32x4*)(kr + d0);
      float kf[8];
#pragma unroll
      for (int e = 0; e < 4; ++e) { kf[2 * e] = __uint_as_float(kv[e] << 16); kf[2 * e + 1] = __uint_as_float(kv[e] & 0xffff0000u); }
#pragma unroll
      for (int i = 0; i < 16; ++i)
#pragma unroll
        for (int e = 0; e < 8; ++e) acc[i] += qs[i * 128 + d0 + e] * kf[e];
    }
#pragma unroll
    for (int i = 0; i < 16; ++i) {
      const int d = (t0 + i - s0) - j;
      const float w = d > 0 ? __expf((float)d * lgf) : (d < 0 ? __expf((float)(-d) * lgb) : 2.f);
      scr[i * 1024 + j] = acc[i] * w;
    }
  }
  __syncthreads();
  const int dv = tid & 255, ig = tid >> 8;
  float o[8] = {};
  for (int j = 0; j < L; ++j) {
    const float v = bf2f(p.proj[(size_t)(s0 + j) * 4096 + 1024 + h * 256 + dv]);
#pragma unroll
    for (int e = 0; e < 8; ++e) o[e] += scr[(ig * 8 + e) * 1024 + j] * v;
  }
  if (sb >= 0) {
    const float* Sf = p.state + ((size_t)(sb * 2 + 0) * 4 + h) * 128 * 256;
    const float* Sb = p.state + ((size_t)(sb * 2 + 1) * 4 + h) * 128 * 256;
    float af[8] = {}, ab[8] = {};
    for (int dk = 0; dk < 128; ++dk) {
      const float sf = Sf[dk * 256 + dv], sbv = Sb[dk * 256 + dv];
#pragma unroll
      for (int e = 0; e < 8; ++e) { const float q = qs[(ig * 8 + e) * 128 + dk]; af[e] += q * sf; ab[e] += q * sbv; }
    }
#pragma unroll
    for (int e = 0; e < 8; ++e) {
      const int pos = t0 + ig * 8 + e - s0;
      o[e] += __expf((float)(pos + 1) * lgf) * af[e] + __expf((float)(L - pos) * lgb) * ab[e];
    }
  }
  const int wid = tid >> 6, lane = tid & 63;
#pragma unroll
  for (int e = 0; e < 8; ++e) { const float s = wave_sum(o[e] * o[e]); if (lane == 0) red[wid * 8 + e] = s; }
  __syncthreads();
#pragma unroll
  for (int e = 0; e < 8; ++e) {
    const float ss = red[(ig * 4 + 0) * 8 + e] + red[(ig * 4 + 1) * 8 + e] + red[(ig * 4 + 2) * 8 + e] + red[(ig * 4 + 3) * 8 + e];
    const float r = rsqrtf(ss * (1.f / 256.f) + EPS);
    const int t = t0 + ig * 8 + e;
    const float g = bf2f(p.proj[(size_t)t * 4096 + 2048 + h * 256 + dv]);
    p.cat[(size_t)t * 1536 + h * 256 + dv] = f2bf(o[e] * r * g);
  }
}
__device__ __forceinline__ void state_item_naive(const P& p, int item) {
  const int b = item >> 3, h = (item >> 1) & 3, dir = item & 1, tid = threadIdx.x;
  const float lg = log1pf(-exp2f(-p.l0_decay[dir * 4 + h]));
  const int dv = tid & 255;
  float* o = p.out + (size_t)NT * DM + ((size_t)(b * 2 + dir) * 4 + h) * 128 * 256;
  for (int pass = 0; pass < 4; ++pass) {
    const int dk0 = (tid >> 8) * 64 + pass * 16;
    float acc[16] = {};
    for (int s = 0; s < 256; ++s) {
      const int t = b * 256 + s;
      const float w = dir == 0 ? __expf((float)(255 - s) * lg) : __expf((float)s * lg);
      const float v = bf2f(p.proj[(size_t)t * 4096 + 1024 + h * 256 + dv]) * w;
      const u16* kr = p.proj + (size_t)t * 4096 + 512 + h * 128 + dk0;
#pragma unroll
      for (int e = 0; e < 16; ++e) acc[e] += bf2f(kr[e]) * v;
    }
#pragma unroll
    for (int e = 0; e < 16; ++e) o[(dk0 + e) * 256 + dv] = acc[e];
  }
}
__device__ __forceinline__ void gmlp_item_naive(const P& p, int item, float* lds) {
  const int ci = item >> 2, g = item & 3, tid = threadIdx.x, wid = tid >> 6, lane = tid & 63;
  float* zn = lds;
  float* mu = lds + 128 * 128;
  float* rs = mu + 128;
  __syncthreads();
  for (int q = wid; q < 128; q += 8) {
    const u32x4 v = *(const u32x4*)(p.proj + (size_t)(ci * 128 + q) * 4096 + 3584 + lane * 8);
    float s = 0.f, s2 = 0.f;
#pragma unroll
    for (int e = 0; e < 4; ++e) { const float a = __uint_as_float(v[e] << 16), b = __uint_as_float(v[e] & 0xffff0000u); s += a + b; s2 += a * a + b * b; }
    s = wave_sum(s); s2 = wave_sum(s2);
    if (lane == 0) { const float m = s * (1.f / 512.f); const float var = fmaxf(s2 * (1.f / 512.f) - m * m, 0.f); mu[q] = m; rs[q] = rsqrtf(var + EPS); }
  }
  __syncthreads();
  for (int i = tid; i < 128 * 128; i += NTHR) {
    const int q = i >> 7, c = i & 127;
    zn[i] = (bf2f(p.proj[(size_t)(ci * 128 + q) * 4096 + 3584 + g * 128 + c]) - mu[q]) * rs[q];
  }
  __syncthreads();
  const int c = tid & 127, p0 = (tid >> 7) * 32;
  float acc[32] = {};
  const float* W = p.l0_gws + (size_t)g * 128 * 128;
  for (int q = 0; q < 128; ++q) {
    const float z = zn[q * 128 + c];
#pragma unroll
    for (int e = 0; e < 32; ++e) acc[e] += W[(p0 + e) * 128 + q] * z;
  }
#pragma unroll
  for (int e = 0; e < 32; ++e) {
    const int t = ci * 128 + p0 + e;
    const float u = bf2f(p.proj[(size_t)t * 4096 + 3072 + g * 128 + c]);
    p.cat[(size_t)t * 1536 + 1024 + g * 128 + c] = f2bf((acc[e] + p.l0_gb[g * 128 + p0 + e]) * u);
  }
}
__device__ __forceinline__ void phase_mixer_naive(const P& p, float* lds) {
  const int nR = 1536, nS = 128, nG = 192, total = nR + nS + nG;
  for (int it = blockIdx.x; it < total; it += gridDim.x) {
    if (it < nR) ret_item_naive(p, it, lds);
    else if (it < nR + nS) state_item_naive(p, it - nR);
    else gmlp_item_naive(p, it - nR - nS, lds);
  }
}


#define LAS __attribute__((address_space(3)))
typedef short bf16x8 __attribute__((ext_vector_type(8)));
typedef short bf16x4 __attribute__((ext_vector_type(4)));
constexpr int PK = 136;
constexpr int PV = 264;
__device__ __forceinline__ bf16x8 frag_row(const LAS u16* base, int pitch, int r0, int k0, int fr, int fq) {
  return *(const LAS bf16x8*)(base + (r0 + fr) * pitch + k0 + fq * 8);
}
__device__ __forceinline__ bf16x8 frag_tr(const LAS u16* base, int pitch, int k0, int n0, int fr, int fq) {
  const LAS u16* a = base + (k0 + fq * 8 + (fr >> 2)) * pitch + n0 + 4 * (fr & 3);
  const bf16x4 lo = __builtin_amdgcn_ds_read_tr16_b64_v4i16((LAS bf16x4*)a);
  const bf16x4 hi = __builtin_amdgcn_ds_read_tr16_b64_v4i16((LAS bf16x4*)(a + 4 * pitch));
  bf16x8 r; r[0] = lo[0]; r[1] = lo[1]; r[2] = lo[2]; r[3] = lo[3]; r[4] = hi[0]; r[5] = hi[1]; r[6] = hi[2]; r[7] = hi[3];
  return r;
}
__device__ __forceinline__ f32x4 mfma16(bf16x8 a, bf16x8 b, f32x4 c) { return __builtin_amdgcn_mfma_f32_16x16x32_bf16(a, b, c, 0, 0, 0); }
__device__ __forceinline__ void tile_to_lds(const u16* __restrict__ g, size_t gp, LAS u16* l, int lp, int rows, int cols) {
  const int cpr = cols >> 3, total = rows * cpr;
  for (int i = threadIdx.x; i < total; i += NTHR) {
    const int r = i / cpr, c = (i % cpr) * 8;
    *(LAS u32x4*)(l + r * lp + c) = *(const u32x4*)(g + (size_t)r * gp + c);
  }
}

__device__ __forceinline__ void kv_item(const P& p, int item, LAS u16* lds) {
  const int ci = item >> 2, h = item & 3, tid = threadIdx.x, wid = tid >> 6, lane = tid & 63, fr = lane & 15, fq = lane >> 4;
  LAS u16* kbuf = lds; LAS u16* vbuf = lds + 128 * PK;
  __syncthreads();
  tile_to_lds(p.proj + (size_t)ci * 128 * 4096 + 512 + h * 128, 4096, kbuf, PK, 128, 128);
  tile_to_lds(p.proj + (size_t)ci * 128 * 4096 + 1024 + h * 256, 4096, vbuf, PV, 128, 256);
  __syncthreads();
  const int dir = wid >> 2, m0 = (wid & 3) * 32;
  const float lg = log1pf(-exp2f(-p.l0_decay[dir * 4 + h]));
#pragma unroll 1
  for (int nh = 0; nh < 2; ++nh) {
    f32x4 acc[2][8];
#pragma unroll
    for (int m = 0; m < 2; ++m)
#pragma unroll
      for (int n = 0; n < 8; ++n) acc[m][n] = (f32x4){0.f, 0.f, 0.f, 0.f};
#pragma unroll 1
    for (int ks = 0; ks < 4; ++ks) {
      bf16x8 a[2];
      a[0] = frag_tr(kbuf, PK, ks * 32, m0, fr, fq); a[1] = frag_tr(kbuf, PK, ks * 32, m0 + 16, fr, fq);
#pragma unroll
      for (int j = 0; j < 8; ++j) {
        const int tok = ks * 32 + fq * 8 + j;
        const float w = __expf((float)(dir == 0 ? 127 - tok : tok) * lg);
        a[0][j] = (short)f2bf(bf2f((u16)a[0][j]) * w); a[1][j] = (short)f2bf(bf2f((u16)a[1][j]) * w);
      }
#pragma unroll
      for (int n = 0; n < 8; ++n) {
        const bf16x8 b = frag_tr(vbuf, PV, ks * 32, nh * 128 + n * 16, fr, fq);
        acc[0][n] = mfma16(a[0], b, acc[0][n]); acc[1][n] = mfma16(a[1], b, acc[1][n]);
      }
    }
    float* o = p.part + ((size_t)(ci * 4 + h) * 2 + dir) * 128 * 256 + (size_t)(m0 + fq * 4) * 256 + nh * 128 + fr;
#pragma unroll
    for (int m = 0; m < 2; ++m)
#pragma unroll
      for (int j = 0; j < 4; ++j)
#pragma unroll
        for (int n = 0; n < 8; ++n) o[(m * 16 + j) * 256 + n * 16] = acc[m][n][j];
  }
}

__device__ __forceinline__ void gmlp_item(const P& p, int item, LAS u16* lds) {
  const int ci = item >> 2, g = item & 3, tid = threadIdx.x, wid = tid >> 6, lane = tid & 63, fr = lane & 15, fq = lane >> 4;
  LAS u16* zn = lds; LAS u16* wsb = lds + 128 * PK; LAS float* mu = (LAS float*)(lds + 2 * 128 * PK); LAS float* rs = mu + 128;
  __syncthreads();
  for (int q = wid; q < 128; q += 8) {
    const u32x4 v = *(const u32x4*)(p.proj + (size_t)(ci * 128 + q) * 4096 + 3584 + lane * 8);
    float s = 0.f, s2 = 0.f;
#pragma unroll
    for (int e = 0; e < 4; ++e) { const float a = __uint_as_float(v[e] << 16), b = __uint_as_float(v[e] & 0xffff0000u); s += a + b; s2 += a * a + b * b; }
    s = wave_sum(s); s2 = wave_sum(s2);
    if (lane == 0) { const float m = s * (1.f / 512.f); const float var = fmaxf(s2 * (1.f / 512.f) - m * m, 0.f); mu[q] = m; rs[q] = rsqrtf(var + EPS); }
  }
  {
    const float* W = p.l0_gws + (size_t)g * 128 * 128;
    for (int i = tid; i < 128 * 32; i += NTHR) {
      const int r = i >> 5, c = (i & 31) * 4;
      const f32x4 v = *(const f32x4*)(W + r * 128 + c);
      u32x2 o; o[0] = pk2(v[0], v[1]); o[1] = pk2(v[2], v[3]);
      *(LAS u32x2*)(wsb + r * PK + c) = o;
    }
  }
  __syncthreads();
  for (int i = tid; i < 128 * 16; i += NTHR) {
    const int q = i >> 4, c = (i & 15) * 8;
    const u32x4 v = *(const u32x4*)(p.proj + (size_t)(ci * 128 + q) * 4096 + 3584 + g * 128 + c);
    const float m = mu[q], r = rs[q];
    u32x4 o;
#pragma unroll
    for (int e = 0; e < 4; ++e) o[e] = pk2((__uint_as_float(v[e] << 16) - m) * r, (__uint_as_float(v[e] & 0xffff0000u) - m) * r);
    *(LAS u32x4*)(zn + q * PK + c) = o;
  }
  __syncthreads();
  f32x4 acc[8];
#pragma unroll
  for (int n = 0; n < 8; ++n) acc[n] = (f32x4){0.f, 0.f, 0.f, 0.f};
#pragma unroll
  for (int ks = 0; ks < 4; ++ks) {
    const bf16x8 a = frag_row(wsb, PK, wid * 16, ks * 32, fr, fq);
#pragma unroll
    for (int n = 0; n < 8; ++n) acc[n] = mfma16(a, frag_tr(zn, PK, ks * 32, n * 16, fr, fq), acc[n]);
  }
#pragma unroll
  for (int j = 0; j < 4; ++j) {
    const int pr = wid * 16 + fq * 4 + j, t = ci * 128 + pr;
    const float gb = p.l0_gb[g * 128 + pr];
#pragma unroll
    for (int n = 0; n < 8; ++n) {
      const int c = n * 16 + fr;
      const float u = bf2f(p.proj[(size_t)t * 4096 + 3072 + g * 128 + c]);
      p.cat[(size_t)t * 1536 + 1024 + g * 128 + c] = f2bf((acc[n][j] + gb) * u);
    }
  }
}
__device__ __forceinline__ void phase_mix_a(const P& p, LAS u16* lds) {
  for (int it = blockIdx.x; it < 384; it += gridDim.x) { if (it < 192) kv_item(p, it, lds); else gmlp_item(p, it - 192, lds); }
}

__device__ __forceinline__ void build_state(const P& p, LAS u16* bbuf, const float* S0, float w0, int cbase, int h, int dir, int c_lo, int c_hi, int c_ref, float lg128) {
  const int tid = threadIdx.x;
#pragma unroll 1
  for (int half = 0; half < 2; ++half) {
    f32x4 a[8];
    const int base = (tid + half * 4096) * 4;
    if (S0) {
#pragma unroll
      for (int k = 0; k < 8; ++k) a[k] = *(const f32x4*)(S0 + base + k * 2048);
#pragma unroll
      for (int k = 0; k < 8; ++k) a[k] = a[k] * w0;
    } else {
#pragma unroll
      for (int k = 0; k < 8; ++k) a[k] = (f32x4){0.f, 0.f, 0.f, 0.f};
    }
#pragma unroll 1
    for (int cc = c_lo; cc < c_hi; ++cc) {
      const int e = dir == 0 ? (c_ref - 1 - cc) : (cc - c_ref - 1);
      const float w = __expf(lg128 * (float)e);
      const float* src = p.part + ((size_t)((cbase + cc) * 4 + h) * 2 + dir) * 128 * 256 + base;
      f32x4 t[8];
#pragma unroll
      for (int k = 0; k < 8; ++k) t[k] = *(const f32x4*)(src + k * 2048);
#pragma unroll
      for (int k = 0; k < 8; ++k) a[k] = a[k] + t[k] * w;
    }
#pragma unroll
    for (int k = 0; k < 8; ++k) {
      const int i = tid + half * 4096 + k * 512, r = i >> 6, c = (i & 63) * 4;
      u32x2 o; o[0] = pk2(a[k][0], a[k][1]); o[1] = pk2(a[k][2], a[k][3]);
      *(LAS u32x2*)(bbuf + r * PV + c) = o;
    }
  }
}
__device__ __forceinline__ void ret_item(const P& p, int item, LAS u16* lds) {
  const int ci = item >> 2, h = item & 3, tid = threadIdx.x, wid = tid >> 6, lane = tid & 63, fr = lane & 15, fq = lane >> 4;
  int sb, lc, n;
  if (ci < 32) { sb = -1; lc = ci & 1; n = 2; } else { sb = (ci - 32) >> 3; lc = (ci - 32) & 7; n = 8; }
  const int cbase = ci - lc;
  const float lgf = log1pf(-exp2f(-p.l0_decay[h])), lgb = log1pf(-exp2f(-p.l0_decay[4 + h]));
  LAS u16* kbuf = lds; LAS u16* bbuf = lds + 128 * PK; LAS float* red = (LAS float*)(lds + 128 * PK + 128 * PV);
  const bool hasF = (sb >= 0) || lc > 0, hasB = (sb >= 0) || lc < n - 1;
  const u16* qg = p.proj + (size_t)ci * 128 * 4096 + h * 128;
  __syncthreads();
  tile_to_lds(p.proj + (size_t)ci * 128 * 4096 + 512 + h * 128, 4096, kbuf, PK, 128, 128);
  if (hasF) build_state(p, bbuf, sb >= 0 ? p.state + ((size_t)(sb * 2 + 0) * 4 + h) * 128 * 256 : nullptr, __expf(lgf * 128.f * (float)lc), cbase, h, 0, 0, lc, lc, lgf * 128.f);
  __syncthreads();
  {
    f32x4 s[8];
#pragma unroll
    for (int nn = 0; nn < 8; ++nn) s[nn] = (f32x4){0.f, 0.f, 0.f, 0.f};
#pragma unroll 1
    for (int ks = 0; ks < 4; ++ks) {
      const bf16x8 a = *(const bf16x8*)(qg + (size_t)(wid * 16 + fr) * 4096 + ks * 32 + fq * 8);
#pragma unroll
      for (int nn = 0; nn < 8; ++nn) s[nn] = mfma16(a, frag_row(kbuf, PK, nn * 16, ks * 32, fr, fq), s[nn]);
    }
    __syncthreads();
    int bd = wid * 16 + fq * 4 - fr;
    asm volatile("" : "+v"(bd));
    LAS u16* prow = kbuf + (wid * 16 + fq * 4) * PK + fr;
#pragma unroll
    for (int nn = 0; nn < 8; ++nn)
#pragma unroll
      for (int j = 0; j < 4; ++j) {
        const int d = bd + j - 16 * nn;
        const float w = d > 0 ? __expf((float)d * lgf) : (d < 0 ? __expf((float)(-d) * lgb) : 2.f);
        prow[j * PK + nn * 16] = f2bf(s[nn][j] * w);
      }
  }
  const int m0 = (wid & 3) * 32, n0 = (wid >> 2) * 128;
  f32x4 acc[2][8];
#pragma unroll
  for (int m = 0; m < 2; ++m)
#pragma unroll
    for (int nn = 0; nn < 8; ++nn) acc[m][nn] = (f32x4){0.f, 0.f, 0.f, 0.f};
  const u16* qrow = qg + (size_t)(m0 + fr) * 4096 + fq * 8;
  if (hasF) {
#pragma unroll 1
    for (int ks = 0; ks < 4; ++ks) {
      const bf16x8 q0 = *(const bf16x8*)(qrow + ks * 32), q1 = *(const bf16x8*)(qrow + 16 * 4096 + ks * 32);
#pragma unroll
      for (int nn = 0; nn < 8; ++nn) {
        const bf16x8 b = frag_tr(bbuf, PV, ks * 32, n0 + nn * 16, fr, fq);
        acc[0][nn] = mfma16(q0, b, acc[0][nn]); acc[1][nn] = mfma16(q1, b, acc[1][nn]);
      }
    }
#pragma unroll
    for (int m = 0; m < 2; ++m)
#pragma unroll
      for (int j = 0; j < 4; ++j) {
        const int il = m0 + m * 16 + fq * 4 + j;
        const float sc = hasB ? __expf((float)(il + 1) * lgf - (float)(128 - il) * lgb) : __expf((float)(il + 1) * lgf);
#pragma unroll
        for (int nn = 0; nn < 8; ++nn) acc[m][nn][j] *= sc;
      }
  }
  if (hasB) {
    __syncthreads();
    build_state(p, bbuf, sb >= 0 ? p.state + ((size_t)(sb * 2 + 1) * 4 + h) * 128 * 256 : nullptr, __expf(lgb * 128.f * (float)(n - 1 - lc)), cbase, h, 1, lc + 1, n, lc, lgb * 128.f);
    __syncthreads();
#pragma unroll 1
    for (int ks = 0; ks < 4; ++ks) {
      const bf16x8 q0 = *(const bf16x8*)(qrow + ks * 32), q1 = *(const bf16x8*)(qrow + 16 * 4096 + ks * 32);
#pragma unroll
      for (int nn = 0; nn < 8; ++nn) {
        const bf16x8 b = frag_tr(bbuf, PV, ks * 32, n0 + nn * 16, fr, fq);
        acc[0][nn] = mfma16(q0, b, acc[0][nn]); acc[1][nn] = mfma16(q1, b, acc[1][nn]);
      }
    }
#pragma unroll
    for (int m = 0; m < 2; ++m)
#pragma unroll
      for (int j = 0; j < 4; ++j) {
        const int il = m0 + m * 16 + fq * 4 + j;
        const float sc = __expf((float)(128 - il) * lgb);
#pragma unroll
        for (int nn = 0; nn < 8; ++nn) acc[m][nn][j] *= sc;
      }
  }
  __syncthreads();
  tile_to_lds(p.proj + (size_t)ci * 128 * 4096 + 1024 + h * 256, 4096, bbuf, PV, 128, 256);
  __syncthreads();
#pragma unroll 1
  for (int ks = 0; ks < 4; ++ks) {
    const bf16x8 a0 = frag_row(kbuf, PK, m0, ks * 32, fr, fq), a1 = frag_row(kbuf, PK, m0 + 16, ks * 32, fr, fq);
#pragma unroll
    for (int nn = 0; nn < 8; ++nn) {
      const bf16x8 b = frag_tr(bbuf, PV, ks * 32, n0 + nn * 16, fr, fq);
      acc[0][nn] = mfma16(a0, b, acc[0][nn]); acc[1][nn] = mfma16(a1, b, acc[1][nn]);
    }
  }
#pragma unroll
  for (int m = 0; m < 2; ++m)
#pragma unroll
    for (int j = 0; j < 4; ++j) {
      float s = 0.f;
#pragma unroll
      for (int nn = 0; nn < 8; ++nn) s += acc[m][nn][j] * acc[m][nn][j];
      s += __shfl_xor(s, 1); s += __shfl_xor(s, 2); s += __shfl_xor(s, 4); s += __shfl_xor(s, 8);
      if (fr == 0) red[(wid >> 2) * 128 + m0 + m * 16 + fq * 4 + j] = s;
    }
  __syncthreads();
#pragma unroll
  for (int m = 0; m < 2; ++m)
#pragma unroll
    for (int j = 0; j < 4; ++j) {
      const int il = m0 + m * 16 + fq * 4 + j;
      const float r = rsqrtf((red[il] + red[128 + il]) * (1.f / 256.f) + EPS);
      LAS u16* orow = bbuf + il * PV + n0 + fr;
#pragma unroll
      for (int nn = 0; nn < 8; ++nn) orow[nn * 16] = f2bf(acc[m][nn][j] * r);
    }
  __syncthreads();
  {
    const u16* gbase = p.proj + (size_t)ci * 128 * 4096 + 2048 + h * 256;
    u16* obase = p.cat + (size_t)ci * 128 * 1536 + h * 256;
#pragma unroll 2
    for (int i = tid; i < 128 * 32; i += NTHR) {
      const int r = i >> 5, c = (i & 31) * 8;
      const u32x4 ov = *(const LAS u32x4*)(bbuf + r * PV + c);
      const u32x4 gv = *(const u32x4*)(gbase + (size_t)r * 4096 + c);
      u32x4 o;
#pragma unroll
      for (int e = 0; e < 4; ++e) o[e] = pk2(__uint_as_float(ov[e] << 16) * __uint_as_float(gv[e] << 16), __uint_as_float(ov[e] & 0xffff0000u) * __uint_as_float(gv[e] & 0xffff0000u));
      *(u32x4*)(obase + (size_t)r * 1536 + c) = o;
    }
  }
}
__device__ __forceinline__ void state_item(const P& p, int item) {
  const int b = item >> 3, h = (item >> 1) & 3, dir = item & 1;
  const float w = __expf(128.f * log1pf(-exp2f(-p.l0_decay[dir * 4 + h])));
  const int c_old = dir == 0 ? 2 * b : 2 * b + 1, c_new = dir == 0 ? 2 * b + 1 : 2 * b;
  const float* A = p.part + ((size_t)(c_old * 4 + h) * 2 + dir) * 128 * 256;
  const float* B = p.part + ((size_t)(c_new * 4 + h) * 2 + dir) * 128 * 256;
  float* o = p.out + (size_t)NT * DM + ((size_t)(b * 2 + dir) * 4 + h) * 128 * 256;
  for (int i = threadIdx.x; i < 128 * 64; i += NTHR) *(f32x4*)(o + i * 4) = *(const f32x4*)(A + i * 4) * w + *(const f32x4*)(B + i * 4);
}
__device__ __forceinline__ void phase_mix_b(const P& p, LAS u16* lds) {
  for (int it = blockIdx.x; it < 320; it += gridDim.x) { if (it < 192) ret_item(p, it, lds); else state_item(p, it - 192); }
}

__device__ __forceinline__ void phase_conv(const P& p) {
  const u16* pj = p.proj;
  for (size_t i = (size_t)blockIdx.x * NTHR + threadIdx.x; i < (size_t)NT * 256; i += (size_t)gridDim.x * NTHR) {
    const int t = (int)(i >> 8), c4 = (int)(i & 255) * 4;
    const int seg = t < NPROMPT_T ? 256 : 64;
    const int pos = t < NPROMPT_T ? (t & 255) : ((t - NPROMPT_T) & 63);
    f32x4 xc[3];
#pragma unroll
    for (int d = 0; d < 3; ++d) {
      const int pp = pos + d - 1;
      if (pp < 0 || pp >= seg) { xc[d] = (f32x4){0.f, 0.f, 0.f, 0.f}; continue; }
      const u16* r = pj + (size_t)(t + d - 1) * 3072;
      const u32x2 a = *(const u32x2*)(r + 1024 + c4), b = *(const u32x2*)(r + 2048 + c4);
      xc[d][0] = __uint_as_float(a[0] << 16) * __uint_as_float(b[0] << 16);
      xc[d][1] = __uint_as_float(a[0] & 0xffff0000u) * __uint_as_float(b[0] & 0xffff0000u);
      xc[d][2] = __uint_as_float(a[1] << 16) * __uint_as_float(b[1] << 16);
      xc[d][3] = __uint_as_float(a[1] & 0xffff0000u) * __uint_as_float(b[1] & 0xffff0000u);
    }
    const f32x4 w0 = *(const f32x4*)(p.l1_conv + c4), w1 = *(const f32x4*)(p.l1_conv + 1024 + c4), w2 = *(const f32x4*)(p.l1_conv + 2048 + c4);
    const u32x2 bgv = *(const u32x2*)(pj + (size_t)t * 3072 + c4);
    f32x4 bg = {__uint_as_float(bgv[0] << 16), __uint_as_float(bgv[0] & 0xffff0000u), __uint_as_float(bgv[1] << 16), __uint_as_float(bgv[1] & 0xffff0000u)};
    const f32x4 y = bg * (w0 * xc[0] + w1 * xc[1] + w2 * xc[2]);
    u32x2 o; o[0] = pk2(y[0], y[1]); o[1] = pk2(y[2], y[3]);
    *(u32x2*)(p.cat + (size_t)t * 1024 + c4) = o;
  }
}


#define XB_TMO      128
#define XB_XCNT(j)  (256  + 64 * (j))
#define XB_XSUB(j)  (1280 + 64 * (j))
#define XB_XGEN(j)  (2304 + 64 * (j))
#define XB_TOP      3328
#define XB_TOPGEN   3392
#define XCD_BAR_WORDS 3456
#define XB_SPIN_CAP (1u << 18)
__device__ __forceinline__ unsigned xb_ld(unsigned* p)              { return __hip_atomic_load(p, __ATOMIC_RELAXED, __HIP_MEMORY_SCOPE_AGENT); }
__device__ __forceinline__ unsigned xb_add(unsigned* p, unsigned v) { return __hip_atomic_fetch_add(p, v, __ATOMIC_RELAXED, __HIP_MEMORY_SCOPE_AGENT); }
__device__ __forceinline__ unsigned xb_xcc_id() { return (unsigned)__builtin_amdgcn_s_getreg((3 << 11) | 20) & 0xFu; }
#define XB_SPIN(cond, bar) do { unsigned _sp = 0; while (cond) { __builtin_amdgcn_s_sleep(1); \
    if ((++_sp & 255u) == 0u) { if (xb_ld(&(bar)[XB_TMO])) break; if (_sp > XB_SPIN_CAP) { atomicAdd(&(bar)[XB_TMO], 1u); break; } } } } while (0)
struct XcdBarrier { unsigned* bar; unsigned x; volatile __attribute__((address_space(3))) unsigned* st; };
__device__ __forceinline__ XcdBarrier xcd_barrier_post(unsigned* bar, volatile __attribute__((address_space(3))) unsigned* st) {
  XcdBarrier b; b.bar = bar; b.x = xb_xcc_id(); b.st = st;
  if (threadIdx.x == 0) (void)xb_add(&bar[XB_XCNT(b.x)], 1u);
  return b;
}
__device__ __forceinline__ void xcd_barrier_complete(unsigned* bar, unsigned x, unsigned& nloc, unsigned& nx) {
  const unsigned G = gridDim.x * gridDim.y * gridDim.z;
  unsigned sum, cnt, mine, sp = 0u;
  for (;;) {
    sum = 0u; cnt = 0u; mine = 0u;
#pragma unroll
    for (unsigned j = 0; j < 16; ++j) { const unsigned c = xb_ld(&bar[XB_XCNT(j)]); sum += c; cnt += (c > 0u) ? 1u : 0u; mine = (j == x) ? c : mine; }
    if (sum == G) break;
    __builtin_amdgcn_s_sleep(1);
    if ((++sp & 255u) == 0u) { if (xb_ld(&bar[XB_TMO])) break; if (sp > XB_SPIN_CAP) { atomicAdd(&bar[XB_TMO], 1u); break; } }
  }
  nloc = mine > 0u ? mine : 1u; nx = cnt > 0u ? cnt : 1u;
}
__device__ __forceinline__ void xcd_barrier(const XcdBarrier& b) {
  asm volatile("s_waitcnt vmcnt(0)" ::: "memory");
  __syncthreads();
  if (threadIdx.x == 0) {
    unsigned* bar = b.bar;
    __builtin_amdgcn_s_waitcnt(0);
    unsigned nloc = b.st[0], nx = b.st[1];
    if (nloc == 0u) { xcd_barrier_complete(bar, b.x, nloc, nx); b.st[0] = nloc; b.st[1] = nx; }
    const unsigned old = xb_add(&bar[XB_XSUB(b.x)], 1u);
    const unsigned gen = old / nloc;
    if (old + 1u == (gen + 1u) * nloc) {
      __builtin_amdgcn_fence(__ATOMIC_RELEASE, "agent");
      asm volatile("s_waitcnt vmcnt(0)" ::: "memory");
      const unsigned og = xb_add(&bar[XB_TOP], 1u);
      const unsigned tg = og / nx;
      if (og + 1u == (tg + 1u) * nx) xb_add(&bar[XB_TOPGEN], 1u);
      else XB_SPIN(xb_ld(&bar[XB_TOPGEN]) == tg, bar);
      __builtin_amdgcn_fence(__ATOMIC_ACQUIRE, "agent");
      xb_add(&bar[XB_XGEN(b.x)], 1u);
      asm volatile("s_waitcnt vmcnt(0)" ::: "memory");
    } else {
      XB_SPIN(xb_ld(&bar[XB_XGEN(b.x)]) == gen, bar);
      __builtin_amdgcn_fence(__ATOMIC_ACQUIRE, "agent");
      asm volatile("s_waitcnt vmcnt(0)" ::: "memory");
    }
  }
  __syncthreads();
}

__device__ __forceinline__ void phase_norm_fused(const NormArgs& a, unsigned* cnt, unsigned* bar) {
  pg8::Order S; S.init(NT, 1024, 2, (int)gridDim.x, (int)blockIdx.x);
  pg8::Unit u;
  if (!S.next(0, u)) return;
  asm volatile("s_waitcnt vmcnt(0)" ::: "memory");
  __syncthreads();
  if (threadIdx.x == 0) {
    __builtin_amdgcn_fence(__ATOMIC_RELEASE, "agent");
    asm volatile("s_waitcnt vmcnt(0)" ::: "memory");
    for (int i = 0; S.next(i, u); ++i) xb_add(&cnt[u.pm * 16], 1u);
  }
  const int wid = threadIdx.x >> 6, lane = threadIdx.x & 63;
  for (int i = 0; S.next(i, u); ++i) {
    if (threadIdx.x == 0) {
      XB_SPIN(xb_ld(&cnt[u.pm * 16]) < 8u, bar);
      __builtin_amdgcn_fence(__ATOMIC_ACQUIRE, "agent");
      asm volatile("s_waitcnt vmcnt(0)" ::: "memory");
    }
    __syncthreads();
    const int r0 = u.pm * 256 + (u.pn * 2 + u.ks) * 32 + wid * 4;
    norm_rows<4>(a, r0, lane);
  }
}

constexpr int NPHASE = 13;
#ifndef REPMASK
#define REPMASK 0
#endif
__global__ void __launch_bounds__(NTHR) mega(P p, int lo, int hi) {
  extern __shared__ __attribute__((aligned(16))) unsigned char smem[];
  float* lds = (float*)smem;
  cg::grid_group grid = cg::this_grid();
  volatile LAS unsigned* xst = (volatile LAS unsigned*)(smem + 131072);
  if (threadIdx.x == 0) { xst[0] = 0u; xst[1] = 0u; }
  __syncthreads();
  const XcdBarrier xb = xcd_barrier_post(p.bar, xst);
  if (hi < 0) grid.sync();
  const float* m0 = p.mod; const float* m1 = p.mod + 3 * 6144;
#define PH(n, ...) if (lo <= (n) && (n) < hi) { if ((n) > lo) xcd_barrier(xb); __VA_ARGS__ if ((REPMASK >> (n)) & 1) { xcd_barrier(xb); __VA_ARGS__ } }
  unsigned* pcnt = p.bar + XCD_BAR_WORDS;
  float* const xs = p.xres + (size_t)NPROMPT_T * DM; float* const pp = p.part;
  PH(0, phase_prep(p, lds);)
  PH(1, { NormArgs a{p.x_prompt, p.x_sample, nullptr, nullptr, nullptr, nullptr, p.l0_norm1, m0 + 0, m0 + 1024, p.hA, nullptr}; phase_norm(a); })
  PH(2, { EpiProj0 e{p.proj}; phase_gemm(p.hA, p.wt0_in, NT, 4096, 1024, 1, e, lds); phase_prep2(p, lds, 0, 128); })
  PH(3, phase_mix_a(p, (LAS u16*)smem);)
  PH(4, phase_mix_b(p, (LAS u16*)smem);)
  PH(5, { EpiPart e{p.part}; phase_gemm(p.cat, p.wt0_out, NT, 1024, 1536, 2, e, lds);
          NormArgs a{p.x_prompt, p.x_sample, pp, pp, m0 + 2048, p.xres, p.l0_norm2, m0 + 3072, m0 + 4096, p.hA, nullptr}; phase_norm_fused(a, pcnt + 0 * 384, p.bar);
          phase_prep2(p, lds, 1, 192); })
  PH(6, { EpiRelu2 e{p.proj}; phase_gemm(p.hA, p.wt0_f1, NT, 4096, 1024, 1, e, lds); })
  PH(7, { EpiPart e{p.part}; phase_gemm(p.proj, p.wt0_f2, NT, 1024, 4096, 2, e, lds);
          NormArgs a{p.xres, xs, pp, pp, m0 + 5120, p.xres, p.l1_norm1, m1 + 0, m1 + 1024, p.hA, nullptr}; phase_norm_fused(a, pcnt + 1 * 384, p.bar);
          phase_prep2(p, lds, 2, 192); })
  PH(8, { EpiPlain e{p.proj, 3072}; phase_gemm(p.hA, p.wt1_in, NT, 3072, 1024, 1, e, lds); })
  PH(9, phase_conv(p);)
  PH(10, { EpiPart e{p.part}; phase_gemm(p.cat, p.wt1_out, NT, 1024, 1024, 2, e, lds);
           NormArgs a{p.xres, xs, pp, pp, m1 + 2048, p.xres, p.l1_norm2, m1 + 3072, m1 + 4096, p.hA, nullptr}; phase_norm_fused(a, pcnt + 2 * 384, p.bar); })
  PH(11, { EpiRelu2 e{p.proj}; phase_gemm(p.hA, p.wt1_f1, NT, 4096, 1024, 1, e, lds); })
  PH(12, { EpiPart e{p.part}; phase_gemm(p.proj, p.wt1_f2, NT, 1024, 4096, 2, e, lds);
           NormArgs a{p.xres, xs, pp, pp, m1 + 5120, nullptr, p.final_norm, nullptr, nullptr, nullptr, p.out}; phase_norm_fused(a, pcnt + 3 * 384, p.bar); })
#undef PH
}

constexpr size_t LDS_BYTES = 131072 + 256;
constexpr bool ONE_LAUNCH = true;

extern "C" void kernel_launch(void* const* d_in, const int* in_sizes, int n_in, void* d_out, int out_size, void* d_ws, size_t ws_size, hipStream_t stream) {
  static int grid_blocks = 0;
  if (!grid_blocks) {
    hipFuncSetAttribute((const void*)mega, hipFuncAttributeMaxDynamicSharedMemorySize, (int)LDS_BYTES);
    int dev = 0, cus = 0, per_cu = 0;
    hipGetDevice(&dev);
    hipDeviceGetAttribute(&cus, hipDeviceAttributeMultiprocessorCount, dev);
    hipOccupancyMaxActiveBlocksPerMultiprocessor(&per_cu, mega, NTHR, LDS_BYTES);
    if (per_cu < 1) per_cu = 1;
    if (per_cu > 1) per_cu = 1;
    grid_blocks = cus * per_cu;
  }
  P p{};
  const float* const* in = (const float* const*)d_in;
  p.x_prompt = in[0]; p.x_sample = in[1]; p.state = in[2]; p.c = in[3]; p.c_ctx = in[4];
  p.l0_norm1 = in[5]; p.l0_w_in = in[6]; p.l0_decay = in[7]; p.l0_gws = in[8]; p.l0_gb = in[9]; p.l0_w_out = in[10]; p.l0_norm2 = in[11];
  p.l0_w_mod = in[12]; p.l0_b_mod = in[13]; p.l0_f1 = in[14]; p.l0_f2 = in[15];
  p.l1_norm1 = in[16]; p.l1_w_in = in[17]; p.l1_conv = in[18]; p.l1_w_out = in[19]; p.l1_norm2 = in[20]; p.l1_w_mod = in[21]; p.l1_b_mod = in[22];
  p.l1_f1 = in[23]; p.l1_f2 = in[24]; p.final_norm = in[25];
  p.out = (float*)d_out;
  unsigned char* w = (unsigned char*)d_ws; size_t off = 0;
  auto take = [&](size_t bytes) { void* r = w + off; off += (bytes + 255) & ~(size_t)255; return r; };
  p.wt0_in = (u16*)take((size_t)4096 * 1024 * 2); p.wt0_out = (u16*)take((size_t)1024 * 1536 * 2);
  p.wt0_f1 = (u16*)take((size_t)4096 * 1024 * 2); p.wt0_f2 = (u16*)take((size_t)4096 * 1024 * 2);
  p.wt1_in = (u16*)take((size_t)3072 * 1024 * 2); p.wt1_out = (u16*)take((size_t)1024 * 1024 * 2);
  p.wt1_f1 = (u16*)take((size_t)4096 * 1024 * 2); p.wt1_f2 = (u16*)take((size_t)4096 * 1024 * 2);
  p.mod = (float*)take((size_t)2 * 3 * 6144 * 4);
  p.hA = (u16*)take((size_t)NT * 1024 * 2);
  p.proj = (u16*)take((size_t)NT * 4096 * 2);
  p.cat = (u16*)take((size_t)NT * 1536 * 2);
  p.part = (float*)take((size_t)2 * NT * 1024 * 4);
  p.xres = (float*)take((size_t)NT * 1024 * 4);
  p.bar = (unsigned*)take((size_t)(XCD_BAR_WORDS + 4 * 384) * 4);
  hipMemsetAsync(p.bar, 0, (size_t)(XCD_BAR_WORDS + 4 * 384) * 4, stream);
  if (ONE_LAUNCH) {
    int lo = 0, hi = NPHASE; void* args[] = {&p, &lo, &hi};
    hipError_t e = hipLaunchCooperativeKernel((void*)mega, dim3(grid_blocks), dim3(NTHR), args, LDS_BYTES, stream);
    if (e != hipSuccess) fprintf(stderr, "cooperative launch failed: %s (grid %d)\n", hipGetErrorString(e), grid_blocks);
  } else {
    for (int ph = 0; ph < NPHASE; ++ph) hipLaunchKernelGGL(mega, dim3(grid_blocks), dim3(NTHR), LDS_BYTES, stream, p, ph, ph + 1);
  }
}
```

```cpp
#include <hip/hip_runtime.h>
#include <hip/hip_cooperative_groups.h>
#include <cstdio>
namespace cg = cooperative_groups;

typedef unsigned short u16;
typedef float f32x4 __attribute__((ext_vector_type(4)));
typedef unsigned u32x4 __attribute__((ext_vector_type(4)));
typedef unsigned u32x2 __attribute__((ext_vector_type(2)));

constexpr int NT = 6144, DM = 1024, NPROMPT_T = 4096;
constexpr float EPS = 1e-6f;
constexpr int NTHR = 512;

__device__ __forceinline__ float bf2f(u16 b) { return __uint_as_float(((unsigned)b) << 16); }
typedef float f32x2 __attribute__((ext_vector_type(2)));
typedef __bf16 hbf16x2 __attribute__((ext_vector_type(2)));
__device__ __forceinline__ unsigned pk2(float a, float b) { const f32x2 v = {a, b}; const hbf16x2 r = __builtin_convertvector(v, hbf16x2); return __builtin_bit_cast(unsigned, r); }
__device__ __forceinline__ u16 f2bf(float f) { return (u16)(pk2(f, 0.f) & 0xffffu); }
__device__ __forceinline__ float silu_f(float x) { return x * __builtin_amdgcn_rcpf(1.f + __expf(-x)); }
__device__ __forceinline__ float gelu_f(float x) { const float u = -1.5957691216057308f * (x + 0.044715f * x * x * x); return x * __builtin_amdgcn_rcpf(1.f + __expf(u)); }
__device__ __forceinline__ int cond_of(int t) { return t < NPROMPT_T ? 0 : 1 + ((t - NPROMPT_T) >> 10); }
__device__ __forceinline__ float wave_sum(float v) {
#pragma unroll
  for (int o = 32; o > 0; o >>= 1) v += __shfl_xor(v, o);
  return v;
}

struct P {
  const float *x_prompt, *x_sample, *state, *c, *c_ctx;
  const float *l0_norm1, *l0_w_in, *l0_decay, *l0_gws, *l0_gb, *l0_w_out, *l0_norm2, *l0_w_mod, *l0_b_mod, *l0_f1, *l0_f2;
  const float *l1_norm1, *l1_w_in, *l1_conv, *l1_w_out, *l1_norm2, *l1_w_mod, *l1_b_mod, *l1_f1, *l1_f2, *final_norm;
  float* out;
  u16 *wt0_in, *wt0_out, *wt0_f1, *wt0_f2, *wt1_in, *wt1_out, *wt1_f1, *wt1_f2;
  float* mod;
  u16* hA;
  u16* proj;
  u16* cat;
  float* part;
  float* xres;
  unsigned* bar;
};

__device__ __forceinline__ void transpose_tile(const float* __restrict__ W, int K, int N, u16* __restrict__ Wt, int tile, float* lds) {
  const int tn = N / 256; const int k0 = (tile / tn) * 64, n0 = (tile % tn) * 256;
  const int tid = threadIdx.x;
  float (*T)[257] = (float (*)[257])lds;
  __syncthreads();
  {
    const int r = tid >> 6, c4 = (tid & 63) * 4;
    f32x4 v[8];
#pragma unroll
    for (int i = 0; i < 8; ++i) v[i] = *(const f32x4*)(W + (size_t)(k0 + r + 8 * i) * N + n0 + c4);
#pragma unroll
    for (int i = 0; i < 8; ++i) { T[r + 8 * i][c4 + 0] = v[i][0]; T[r + 8 * i][c4 + 1] = v[i][1]; T[r + 8 * i][c4 + 2] = v[i][2]; T[r + 8 * i][c4 + 3] = v[i][3]; }
  }
  __syncthreads();
  {
    const int kk = (tid & 7) * 8;
#pragma unroll
    for (int ps = 0; ps < 4; ++ps) {
      const int nn = (tid >> 3) + 64 * ps;
      u32x4 o;
      o[0] = pk2(T[kk + 0][nn], T[kk + 1][nn]); o[1] = pk2(T[kk + 2][nn], T[kk + 3][nn]);
      o[2] = pk2(T[kk + 4][nn], T[kk + 5][nn]); o[3] = pk2(T[kk + 6][nn], T[kk + 7][nn]);
      *(u32x4*)(Wt + (size_t)(n0 + nn) * K + k0 + kk) = o;
    }
  }
}

__device__ __forceinline__ void adaln_item(const P& p, int item, float* lds) {
  const int l = item / 96, n0 = (item % 96) * 64;
  const float* W = l ? p.l1_w_mod : p.l0_w_mod; const float* B = l ? p.l1_b_mod : p.l0_b_mod;
  const int tid = threadIdx.x;
  float* sc = lds;
  float* red = lds + 3072;
  __syncthreads();
  for (int i = tid; i < 3072; i += NTHR) {
    const int c = i >> 10, k = i & 1023;
    const float v = c == 0 ? p.c_ctx[k] : p.c[(c - 1) * 1024 + k];
    sc[i] = silu_f(v);
  }
  __syncthreads();
  const int cg4 = tid & 15, rg = tid >> 4;
  float acc[3][4] = {};
#pragma unroll 8
  for (int it = 0; it < 32; ++it) {
    const int k = it * 32 + rg;
    const f32x4 w = *(const f32x4*)(W + (size_t)k * 6144 + n0 + cg4 * 4);
#pragma unroll
    for (int c = 0; c < 3; ++c) { const float s = sc[c * 1024 + k];
#pragma unroll
      for (int e = 0; e < 4; ++e) acc[c][e] += s * w[e]; }
  }
#pragma unroll
  for (int c = 0; c < 3; ++c)
#pragma unroll
    for (int e = 0; e < 4; ++e) red[(rg * 3 + c) * 64 + cg4 * 4 + e] = acc[c][e];
  __syncthreads();
  if (tid < 192) {
    const int c = tid >> 6, n = tid & 63; float s = B[n0 + n];
    for (int r = 0; r < 32; ++r) s += red[(r * 3 + c) * 64 + n];
    p.mod[(size_t)(l * 3 + c) * 6144 + n0 + n] = s;
  }
}

__device__ __forceinline__ void phase_prep(const P& p, float* lds) {
  for (int it = blockIdx.x; it < 96 + 256; it += gridDim.x) {
    if (it < 96) adaln_item(p, it, lds); else transpose_tile(p.l0_w_in, 1024, 4096, p.wt0_in, it - 96, lds);
  }
}
__device__ __forceinline__ void phase_prep2(const P& p, float* lds, int group, int first_want) {
  const int first = (int)gridDim.x >= 256 ? first_want : 0, nblk = (int)gridDim.x - first;
  if ((int)blockIdx.x < first) return;
  const int total = group == 0 ? 96 + 256 + 256 : (group == 1 ? 96 + 192 + 64 : 256 + 256);
  for (int it = (int)blockIdx.x - first; it < total; it += nblk) {
    int i = it;
    if (group == 0) {
      if (i < 96) { transpose_tile(p.l0_w_out, 1536, 1024, p.wt0_out, i, lds); continue; } i -= 96;
      if (i < 256) { transpose_tile(p.l0_f1, 1024, 4096, p.wt0_f1, i, lds); continue; } i -= 256;
      transpose_tile(p.l0_f2, 4096, 1024, p.wt0_f2, i, lds);
    } else if (group == 1) {
      if (i < 96) { adaln_item(p, 96 + i, lds); continue; } i -= 96;
      if (i < 192) { transpose_tile(p.l1_w_in, 1024, 3072, p.wt1_in, i, lds); continue; } i -= 192;
      transpose_tile(p.l1_w_out, 1024, 1024, p.wt1_out, i, lds);
    } else {
      if (i < 256) { transpose_tile(p.l1_f1, 1024, 4096, p.wt1_f1, i, lds); continue; } i -= 256;
      transpose_tile(p.l1_f2, 4096, 1024, p.wt1_f2, i, lds);
    }
  }
}

struct NormArgs {
  const float* xin0; const float* xin1;
  const float* p0; const float* p1; const float* gate;
  float* xout; const float* nw; const float* sh; const float* sc;
  u16* hout; float* fout;
};
__device__ __forceinline__ void norm_row(const NormArgs& a, int t, int lane) {
  {
    const int c = cond_of(t);
    const float* xr = t < NPROMPT_T ? a.xin0 + (size_t)t * DM : a.xin1 + (size_t)(t - NPROMPT_T) * DM;
    f32x4 x[4]; float ss = 0.f;
#pragma unroll
    for (int i = 0; i < 4; ++i) {
      const int col = lane * 4 + 256 * i;
      x[i] = *(const f32x4*)(xr + col);
      if (a.p0) {
        const u32x2 q0 = *(const u32x2*)((const u16*)a.p0 + (size_t)t * DM + col), q1 = *(const u32x2*)((const u16*)a.p0 + (size_t)(NT + t) * DM + col);
        const f32x4 g = *(const f32x4*)(a.gate + (size_t)c * 6144 + col);
        f32x4 ps;
        ps[0] = __uint_as_float(q0[0] << 16) + __uint_as_float(q1[0] << 16); ps[1] = __uint_as_float(q0[0] & 0xffff0000u) + __uint_as_float(q1[0] & 0xffff0000u);
        ps[2] = __uint_as_float(q0[1] << 16) + __uint_as_float(q1[1] << 16); ps[3] = __uint_as_float(q0[1] & 0xffff0000u) + __uint_as_float(q1[1] & 0xffff0000u);
        x[i] = x[i] + g * ps;
      }
      if (a.xout) *(f32x4*)(a.xout + (size_t)t * DM + col) = x[i];
      ss += x[i][0] * x[i][0] + x[i][1] * x[i][1] + x[i][2] * x[i][2] + x[i][3] * x[i][3];
    }
    ss = wave_sum(ss);
    const float r = rsqrtf(ss * (1.f / 1024.f) + EPS);
#pragma unroll
    for (int i = 0; i < 4; ++i) {
      const int col = lane * 4 + 256 * i;
      const f32x4 w = *(const f32x4*)(a.nw + col);
      f32x4 y = x[i] * r * w;
      if (a.fout) *(f32x4*)(a.fout + (size_t)t * DM + col) = y;
      if (a.hout) {
        const f32x4 sh = *(const f32x4*)(a.sh + (size_t)c * 6144 + col), sc = *(const f32x4*)(a.sc + (size_t)c * 6144 + col);
        y = y * (1.f + sc) + sh;
        u32x2 o; o[0] = pk2(y[0], y[1]); o[1] = pk2(y[2], y[3]);
        *(u32x2*)(a.hout + (size_t)t * DM + col) = o;
      }
    }
  }
}
template <int R, int NP>
__device__ __forceinline__ void norm_rows(const NormArgs& a, int t0, int lane) {
  const int c = cond_of(t0);
  f32x4 x[R][4];
#pragma unroll
  for (int r = 0; r < R; ++r) {
    const int t = t0 + r;
    const float* xr = t < NPROMPT_T ? a.xin0 + (size_t)t * DM : a.xin1 + (size_t)(t - NPROMPT_T) * DM;
#pragma unroll
    for (int i = 0; i < 4; ++i) x[r][i] = *(const f32x4*)(xr + lane * 4 + 256 * i);
  }
  if (a.p0) {
    u32x2 q[R][NP][4];
#pragma unroll
    for (int r = 0; r < R; ++r)
#pragma unroll
      for (int k = 0; k < NP; ++k)
#pragma unroll
        for (int i = 0; i < 4; ++i) q[r][k][i] = *(const u32x2*)((const u16*)a.p0 + ((size_t)k * NT + t0 + r) * DM + lane * 4 + 256 * i);
#pragma unroll
    for (int i = 0; i < 4; ++i) {
      const f32x4 g = *(const f32x4*)(a.gate + (size_t)c * 6144 + lane * 4 + 256 * i);
#pragma unroll
      for (int r = 0; r < R; ++r) {
        f32x4 ps = {0.f, 0.f, 0.f, 0.f};
#pragma unroll
        for (int k = 0; k < NP; ++k) {
          ps[0] += __uint_as_float(q[r][k][i][0] << 16); ps[1] += __uint_as_float(q[r][k][i][0] & 0xffff0000u);
          ps[2] += __uint_as_float(q[r][k][i][1] << 16); ps[3] += __uint_as_float(q[r][k][i][1] & 0xffff0000u);
        }
        x[r][i] = x[r][i] + g * ps;
      }
    }
  }
  float rs[R];
#pragma unroll
  for (int r = 0; r < R; ++r) {
    float ss = 0.f;
#pragma unroll
    for (int i = 0; i < 4; ++i) {
      if (a.xout) *(f32x4*)(a.xout + (size_t)(t0 + r) * DM + lane * 4 + 256 * i) = x[r][i];
      ss += x[r][i][0] * x[r][i][0] + x[r][i][1] * x[r][i][1] + x[r][i][2] * x[r][i][2] + x[r][i][3] * x[r][i][3];
    }
    ss = wave_sum(ss);
    rs[r] = rsqrtf(ss * (1.f / 1024.f) + EPS);
  }
#pragma unroll
  for (int i = 0; i < 4; ++i) {
    const int col = lane * 4 + 256 * i;
    const f32x4 w = *(const f32x4*)(a.nw + col);
    f32x4 sh = {0.f, 0.f, 0.f, 0.f}, sc = {0.f, 0.f, 0.f, 0.f};
    if (a.hout) { sh = *(const f32x4*)(a.sh + (size_t)c * 6144 + col); sc = *(const f32x4*)(a.sc + (size_t)c * 6144 + col); }
#pragma unroll
    for (int r = 0; r < R; ++r) {
      f32x4 y = x[r][i] * rs[r] * w;
      if (a.fout) *(f32x4*)(a.fout + (size_t)(t0 + r) * DM + col) = y;
      if (a.hout) {
        y = y * (1.f + sc) + sh;
        u32x2 o; o[0] = pk2(y[0], y[1]); o[1] = pk2(y[2], y[3]);
        *(u32x2*)(a.hout + (size_t)(t0 + r) * DM + col) = o;
      }
    }
  }
}
__device__ __forceinline__ void phase_norm(const NormArgs& a) {
  const int wid = threadIdx.x >> 6, lane = threadIdx.x & 63;
  for (int g = blockIdx.x * 8 + wid; g < NT / 4; g += gridDim.x * 8) norm_rows<4, 2>(a, g * 4, lane);
}
struct EpiProj0 {
  u16* O;
  __device__ __forceinline__ void store8(int row, int col, f32x4 v0, f32x4 v1, int) const {
    if (col >= 3072) {
#pragma unroll
      for (int e = 0; e < 4; ++e) { v0[e] = gelu_f(v0[e]); v1[e] = gelu_f(v1[e]); }
    } else if (col >= 2048) {
#pragma unroll
      for (int e = 0; e < 4; ++e) { v0[e] = silu_f(v0[e]); v1[e] = silu_f(v1[e]); }
    } else if (col >= 512 && col < 1024) { v0 = v0 * 0.08838834764831845f; v1 = v1 * 0.08838834764831845f; }
    u32x4 o; o[0] = pk2(v0[0], v0[1]); o[1] = pk2(v0[2], v0[3]); o[2] = pk2(v1[0], v1[1]); o[3] = pk2(v1[2], v1[3]);
    *(u32x4*)(O + (size_t)row * 4096 + col) = o;
  }
  __device__ __forceinline__ void store4(int row, int col, f32x4 v, int) const {
    if (col >= 3072) { v[0] = gelu_f(v[0]); v[1] = gelu_f(v[1]); v[2] = gelu_f(v[2]); v[3] = gelu_f(v[3]); }
    else if (col >= 2048) { v[0] = silu_f(v[0]); v[1] = silu_f(v[1]); v[2] = silu_f(v[2]); v[3] = silu_f(v[3]); }
    else if (col >= 512 && col < 1024) v = v * 0.08838834764831845f;
    u32x2 o; o[0] = pk2(v[0], v[1]); o[1] = pk2(v[2], v[3]);
    *(u32x2*)(O + (size_t)row * 4096 + col) = o;
  }
};
struct EpiPart {
  float* Pp;
  __device__ __forceinline__ void store8(int row, int col, f32x4 v0, f32x4 v1, int ks) const {
    u32x4 o; o[0] = pk2(v0[0], v0[1]); o[1] = pk2(v0[2], v0[3]); o[2] = pk2(v1[0], v1[1]); o[3] = pk2(v1[2], v1[3]);
    *(u32x4*)((u16*)Pp + ((size_t)ks * NT + row) * DM + col) = o;
  }
};
struct EpiRelu2 {
  u16* O;
  __device__ __forceinline__ void store8(int row, int col, f32x4 v0, f32x4 v1, int) const {
#pragma unroll
    for (int e = 0; e < 4; ++e) { const float r0 = fmaxf(v0[e], 0.f), r1 = fmaxf(v1[e], 0.f); v0[e] = r0 * r0; v1[e] = r1 * r1; }
    u32x4 o; o[0] = pk2(v0[0], v0[1]); o[1] = pk2(v0[2], v0[3]); o[2] = pk2(v1[0], v1[1]); o[3] = pk2(v1[2], v1[3]);
    *(u32x4*)(O + (size_t)row * 4096 + col) = o;
  }
  __device__ __forceinline__ void store4(int row, int col, f32x4 v, int) const {
#pragma unroll
    for (int e = 0; e < 4; ++e) { const float r = fmaxf(v[e], 0.f); v[e] = r * r; }
    u32x2 o; o[0] = pk2(v[0], v[1]); o[1] = pk2(v[2], v[3]);
    *(u32x2*)(O + (size_t)row * 4096 + col) = o;
  }
};
struct EpiPartW {
  __amdgpu_buffer_rsrc_t rs;
  __device__ __forceinline__ void store8(int row, int col, f32x4 v0, f32x4 v1, int ks) const {
    u32x4 o; o[0] = pk2(v0[0], v0[1]); o[1] = pk2(v0[2], v0[3]); o[2] = pk2(v1[0], v1[1]); o[3] = pk2(v1[2], v1[3]);
    __builtin_amdgcn_raw_buffer_store_b128(o, rs, (unsigned)((((size_t)ks * NT + row) * DM + col) * 2), 0, 16);
  }
};
struct EpiRelu2W {
  __amdgpu_buffer_rsrc_t rs;
  __device__ __forceinline__ void store8(int row, int col, f32x4 v0, f32x4 v1, int) const {
#pragma unroll
    for (int e = 0; e < 4; ++e) { const float r0 = fmaxf(v0[e], 0.f), r1 = fmaxf(v1[e], 0.f); v0[e] = r0 * r0; v1[e] = r1 * r1; }
    u32x4 o; o[0] = pk2(v0[0], v0[1]); o[1] = pk2(v0[2], v0[3]); o[2] = pk2(v1[0], v1[1]); o[3] = pk2(v1[2], v1[3]);
    __builtin_amdgcn_raw_buffer_store_b128(o, rs, (unsigned)(((size_t)row * 4096 + col) * 2), 0, 16);
  }
};
__device__ __forceinline__ __amdgpu_buffer_rsrc_t mk_rsrc(void* p, unsigned bytes) { return __builtin_amdgcn_make_buffer_rsrc(p, 0, (int)bytes, 0x00020000); }
struct EpiPlain {
  u16* O; int ld;
  __device__ __forceinline__ void store8(int row, int col, f32x4 v0, f32x4 v1, int) const {
    u32x4 o; o[0] = pk2(v0[0], v0[1]); o[1] = pk2(v0[2], v0[3]); o[2] = pk2(v1[0], v1[1]); o[3] = pk2(v1[2], v1[3]);
    *(u32x4*)(O + (size_t)row * ld + col) = o;
  }
  __device__ __forceinline__ void store4(int row, int col, f32x4 v, int) const {
    u32x2 o; o[0] = pk2(v[0], v[1]); o[1] = pk2(v[2], v[3]);
    *(u32x2*)(O + (size_t)row * ld + col) = o;
  }
};

template <class Epi>
__device__ __forceinline__ void phase_gemm_naive(const u16* __restrict__ A, const u16* __restrict__ Bt, int M, int N, int K, int ksplit, const Epi& E, float* lds) {
  float (*As)[33] = (float (*)[33])lds;
  float (*Bs)[33] = (float (*)[33])(lds + 128 * 33);
  const int tm = M / 128, tn = N / 64, total = tm * tn * ksplit, kper = K / ksplit;
  const int tid = threadIdx.x, r = tid >> 2, cq = tid & 3;
  for (int it = blockIdx.x; it < total; it += gridDim.x) {
    const int ks = it / (tm * tn), rem = it % (tm * tn), m0 = (rem / tn) * 128, n0 = (rem % tn) * 64;
    float acc[4][4] = {};
    for (int k0 = ks * kper; k0 < (ks + 1) * kper; k0 += 32) {
      __syncthreads();
      {
        const int kc = (tid & 3) * 8;
        const u32x4 va = *(const u32x4*)(A + (size_t)(m0 + r) * K + k0 + kc);
#pragma unroll
        for (int e = 0; e < 4; ++e) { As[r][kc + 2 * e] = __uint_as_float(va[e] << 16); As[r][kc + 2 * e + 1] = __uint_as_float(va[e] & 0xffff0000u); }
        if (tid < 256) {
          const u32x4 vb = *(const u32x4*)(Bt + (size_t)(n0 + r) * K + k0 + kc);
#pragma unroll
          for (int e = 0; e < 4; ++e) { Bs[r][kc + 2 * e] = __uint_as_float(vb[e] << 16); Bs[r][kc + 2 * e + 1] = __uint_as_float(vb[e] & 0xffff0000u); }
        }
      }
      __syncthreads();
#pragma unroll 4
      for (int k = 0; k < 32; ++k) {
        const float a = As[r][k];
#pragma unroll
        for (int jj = 0; jj < 4; ++jj)
#pragma unroll
          for (int e = 0; e < 4; ++e) acc[jj][e] += a * Bs[cq * 4 + 16 * jj + e][k];
      }
    }
#pragma unroll
    for (int jj = 0; jj < 4; ++jj) { f32x4 v = {acc[jj][0], acc[jj][1], acc[jj][2], acc[jj][3]}; E.store4(m0 + r, n0 + cq * 4 + 16 * jj, v, ks); }
  }
}


namespace pg8 {
#define PG8_LAS __attribute__((address_space(3)))
typedef short bf16x8 __attribute__((ext_vector_type(8)));
constexpr int BM = 256, BK = 64, HALF = 128, HTB = HALF * BK * 2, STAGE_BYTES = 8 * HTB, NXCD = 8, WGM = 8;
__device__ __forceinline__ int lds_byte(int r, int c) { const int st = (r >> 4) * 2 + (c >> 5), rr = r & 15, cc = c & 31, ob = rr * 64 + cc * 2; return st * 1024 + (ob ^ (((ob >> 9) & 1) << 5)); }
__device__ __forceinline__ int perm32(int rho) { const int n = rho >> 4, i = rho & 15; return 8 * (i >> 2) + 4 * n + (i & 3); }
__device__ __forceinline__ void stage_rc(int b, int& R, int& C) { const int st = b / 1024, sb = b % 1024, swz = sb ^ (((sb >> 9) & 1) << 5); R = (st >> 1) * 16 + swz / 64; C = (st & 1) * 32 + (swz % 64) / 2; }
struct Unit { int pm, pn, ks; };
struct Gemm { const u16* A; const u16* Bt; int M, N, K, ksplit; };
struct Order {
  int nM, nN, ntile, nwg, G, c;
  __device__ void init(int M, int N, int ksplit, int G_, int c_) { nM = M / BM; nN = N / BM; ntile = nM * nN; nwg = ntile * ksplit; G = G_; c = c_; }
  __device__ bool next(int i, Unit& u) const {
    const int L = i * G + c; if (L >= nwg) return false;
    u.ks = L / ntile; int wgid = L % ntile;
    { const int q = ntile / NXCD, r = ntile % NXCD, xcd = wgid % NXCD, off = wgid / NXCD; wgid = (xcd < r ? xcd * (q + 1) : r * (q + 1) + (xcd - r) * q) + off; }
    const int nig = WGM * nN, gid = wgid / nig, fm = gid * WGM, gsz = (nM - fm) < WGM ? (nM - fm) : WGM;
    u.pm = fm + ((wgid % nig) % gsz); u.pn = (wgid % nig) / gsz; return true;
  }
};
template <class Epi>
__device__ __forceinline__ void run_epi(const Epi& E, const f32x4 (&acc)[2][2][4][2], const Unit& u, int wr, int wc, int fr, int fq) {
  const int row0 = u.pm * BM + wr * 64 + fr, col0 = u.pn * BM + wc * 32 + 8 * fq;
#pragma unroll
  for (int ai = 0; ai < 2; ++ai)
#pragma unroll
    for (int m = 0; m < 4; ++m)
#pragma unroll
      for (int bj = 0; bj < 2; ++bj) E.store8(row0 + ai * HALF + m * 16, col0 + bj * HALF, acc[ai][bj][m][0], acc[ai][bj][m][1], u.ks);
}
struct OneUnit { Unit u; __device__ __forceinline__ bool next(int i, Unit& o) const { if (i) return false; o = u; return true; } };
struct FfnOrder1 {
  int c;
  __device__ __forceinline__ bool next(int i, Unit& u) const {
    const int x = c & 7, o = c >> 3;
    if (i == 0) { u.pm = 4 * (x >> 1) + (o >> 3); u.pn = (x & 1) * 8 + (o & 7); u.ks = 0; return true; }
    if (i == 1 && c < 128) { u.pm = 16 + 2 * (x >> 1) + (o >> 3); u.pn = (x & 1) * 8 + (o & 7); u.ks = 0; return true; }
    return false;
  }
};
template <class Epi, class Sched>
__device__ __forceinline__ void gemm_phase(PG8_LAS unsigned char* lds, const Gemm g, const Sched& S, const Epi& E) {
  const int tid = threadIdx.x, wid = __builtin_amdgcn_readfirstlane(tid >> 6), lane = tid & 63, wr = wid >> 2, wc = wid & 3, fr = lane & 15, fq = lane >> 4;
  const int K = g.K, kper = g.K / g.ksplit, nt = kper / BK;
  unsigned voffA[2], voffB[2];
#pragma unroll
  for (int i = 0; i < 2; ++i) { int R, C; stage_rc(tid * 16 + i * 8192, R, C); const int Rb = (R & ~31) + perm32(R & 31);
    voffA[i] = (unsigned)(R * K + C) * 2u; voffB[i] = (unsigned)(Rb * K + C) * 2u; }
  const size_t kstep = (size_t)(BK * 2);
  const size_t hstep = (size_t)HALF * K * 2;
  const size_t tstep = 2 * hstep;
  const size_t ksbytes = (size_t)kper * 2;
  const unsigned ldsw = (unsigned)wid * 1024u;
  const int aoff = lds_byte(wr * 64 + fr, fq * 8), boff = lds_byte(wc * 32 + fr, fq * 8);
#define PG8_SA(b, h) (((b) * 2 + (h)) * HTB)
#define PG8_SB(b, h) ((4 + (b) * 2 + (h)) * HTB)
#define PG8_STAGE(bufoff, gbase, voff) do { _Pragma("unroll") for (int _i = 0; _i < 2; ++_i) \
    __builtin_amdgcn_global_load_lds((const unsigned*)((const char*)(gbase) + (voff)[_i]), (PG8_LAS unsigned*)(lds + (bufoff) + ldsw + _i * 8192), 16, 0, 0); } while (0)
#define PG8_LDA(dst, b, h) do { _Pragma("unroll") for (int m = 0; m < 4; ++m) _Pragma("unroll") for (int k = 0; k < 2; ++k) dst[m][k] = *(const PG8_LAS bf16x8*)(lds + PG8_SA(b, h) + aoff + m * 2048 + k * 1024); } while (0)
#define PG8_LDB(dst, b, h) do { _Pragma("unroll") for (int n = 0; n < 2; ++n) _Pragma("unroll") for (int k = 0; k < 2; ++k) dst[n][k] = *(const PG8_LAS bf16x8*)(lds + PG8_SB(b, h) + boff + n * 2048 + k * 1024); } while (0)
#define PG8_MMA(ai, bj, At, Bt) do { __builtin_amdgcn_s_setprio(1); _Pragma("unroll") for (int m = 0; m < 4; ++m) _Pragma("unroll") for (int n = 0; n < 2; ++n) _Pragma("unroll") for (int k = 0; k < 2; ++k) \
    acc[ai][bj][m][n] = __builtin_amdgcn_mfma_f32_16x16x32_bf16(Bt[n][k], At[m][k], acc[ai][bj][m][n], 0, 0, 0); __builtin_amdgcn_s_setprio(0); } while (0)
#define PG8_WAIT_V(n) asm volatile("s_waitcnt vmcnt(" #n ")" ::: "memory")
#define PG8_WAIT_L(n) asm volatile("s_waitcnt lgkmcnt(" #n ")" ::: "memory")
#define PG8_BAR __builtin_amdgcn_s_barrier()
#define PG8_SCHED __builtin_amdgcn_sched_barrier(0)
  Unit cur, nxt; int ui = 0;
  if (!S.next(0, cur)) return;
  f32x4 acc[2][2][4][2];
#pragma unroll
  for (int a = 0; a < 2; ++a)
#pragma unroll
    for (int b = 0; b < 2; ++b)
#pragma unroll
      for (int m = 0; m < 4; ++m)
#pragma unroll
        for (int n = 0; n < 2; ++n) acc[a][b][m][n] = (f32x4){0.f, 0.f, 0.f, 0.f};
  bf16x8 At[4][2], B0[2][2], B1[2][2];
  const char* cA = (const char*)g.A + (size_t)cur.pm * tstep + (size_t)cur.ks * ksbytes; const char* cB = (const char*)g.Bt + (size_t)cur.pn * tstep + (size_t)cur.ks * ksbytes;
  PG8_STAGE(PG8_SB(0, 0), cB, voffB); PG8_STAGE(PG8_SA(0, 0), cA, voffA); PG8_STAGE(PG8_SB(0, 1), cB + hstep, voffB); PG8_STAGE(PG8_SA(0, 1), cA + hstep, voffA);
  if (wr == 1) PG8_BAR;
  PG8_WAIT_V(4); PG8_BAR;
  PG8_STAGE(PG8_SB(1, 0), cB + kstep, voffB); PG8_STAGE(PG8_SA(1, 0), cA + kstep, voffA); PG8_STAGE(PG8_SB(1, 1), cB + hstep + kstep, voffB);
  PG8_WAIT_V(6); PG8_BAR;
  for (;;) {
    const bool has_next = S.next(ui + 1, nxt);
    const char* nA = has_next ? (const char*)g.A + (size_t)nxt.pm * tstep + (size_t)nxt.ks * ksbytes : cA; const char* nB = has_next ? (const char*)g.Bt + (size_t)nxt.pn * tstep + (size_t)nxt.ks * ksbytes : cB;
    for (int t = 0; t < nt; t += 2) {
      const bool last = (t == nt - 2);
      const char* a1 = cA + (size_t)(t + 1) * kstep;
      const char* a2 = last ? nA : cA + (size_t)(t + 2) * kstep; const char* b2 = last ? nB : cB + (size_t)(t + 2) * kstep;
      const char* a3 = a2 + kstep; const char* b3 = b2 + kstep;
      PG8_LDB(B0, 0, 0); PG8_SCHED; PG8_LDA(At, 0, 0); PG8_STAGE(PG8_SA(1, 1), a1 + hstep, voffA);
      PG8_WAIT_L(8); PG8_BAR; PG8_WAIT_L(0); PG8_MMA(0, 0, At, B0); PG8_BAR; PG8_SCHED;
      PG8_LDB(B1, 0, 1); PG8_STAGE(PG8_SB(0, 0), b2, voffB);
      PG8_BAR; PG8_WAIT_L(0); PG8_MMA(0, 1, At, B1); PG8_BAR;
      PG8_LDA(At, 0, 1); PG8_STAGE(PG8_SA(0, 0), a2, voffA);
      PG8_BAR; PG8_WAIT_L(0); PG8_MMA(1, 0, At, B0); PG8_BAR; PG8_SCHED;
      PG8_STAGE(PG8_SB(0, 1), b2 + hstep, voffB);
      PG8_WAIT_V(6); PG8_BAR; PG8_MMA(1, 1, At, B1); PG8_BAR;
      PG8_LDB(B0, 1, 0); PG8_SCHED; PG8_LDA(At, 1, 0); PG8_STAGE(PG8_SA(0, 1), a2 + hstep, voffA);
      PG8_WAIT_L(8); PG8_BAR; PG8_WAIT_L(0); PG8_MMA(0, 0, At, B0); PG8_BAR; PG8_SCHED;
      PG8_LDB(B1, 1, 1); PG8_STAGE(PG8_SB(1, 0), b3, voffB);
      PG8_BAR; PG8_WAIT_L(0); PG8_MMA(0, 1, At, B1); PG8_BAR;
      PG8_LDA(At, 1, 1); PG8_STAGE(PG8_SA(1, 0), a3, voffA);
      PG8_BAR; PG8_WAIT_L(0); PG8_MMA(1, 0, At, B0); PG8_BAR; PG8_SCHED;
      PG8_STAGE(PG8_SB(1, 1), b3 + hstep, voffB);
      PG8_WAIT_V(6); PG8_BAR; PG8_MMA(1, 1, At, B1); PG8_BAR;
    }
    run_epi(E, acc, cur, wr, wc, fr, fq);
    if (!has_next) break;
#pragma unroll
    for (int a = 0; a < 2; ++a)
#pragma unroll
      for (int b = 0; b < 2; ++b)
#pragma unroll
        for (int m = 0; m < 4; ++m)
#pragma unroll
          for (int n = 0; n < 2; ++n) acc[a][b][m][n] = (f32x4){0.f, 0.f, 0.f, 0.f};
    cur = nxt; cA = nA; cB = nB; ++ui;
  }
  PG8_WAIT_V(0);
  if (wr == 0) PG8_BAR;
  PG8_BAR;
#undef PG8_SA
#undef PG8_SB
#undef PG8_STAGE
#undef PG8_LDA
#undef PG8_LDB
#undef PG8_MMA
#undef PG8_WAIT_V
#undef PG8_WAIT_L
#undef PG8_BAR
#undef PG8_SCHED
}
}
template <class Epi>
__device__ __forceinline__ void phase_gemm(const u16* A, const u16* Bt, int M, int N, int K, int ksplit, const Epi& E, float* lds) {
  __syncthreads();
  pg8::Gemm g{A, Bt, M, N, K, ksplit};
  pg8::Order S; S.init(M, N, ksplit, (int)gridDim.x, (int)blockIdx.x);
  pg8::gemm_phase(( __attribute__((address_space(3))) unsigned char*)lds, g, S, E);
  __syncthreads();
}

__device__ __forceinline__ void seq_of_token(int t, int& s0, int& L, int& sb) {
  if (t < NPROMPT_T) { s0 = t & ~255; L = 256; sb = -1; } else { sb = (t - NPROMPT_T) >> 10; s0 = NPROMPT_T + (sb << 10); L = 1024; }
}
__device__ __forceinline__ void ret_item_naive(const P& p, int item, float* lds) {
  const int tg = item >> 2, h = item & 3, t0 = tg * 16, tid = threadIdx.x;
  int s0, L, sb; seq_of_token(t0, s0, L, sb);
  float* scr = lds;
  float* qs = lds + 16 * 1024;
  float* red = qs + 16 * 128;
  const float lgf = log1pf(-exp2f(-p.l0_decay[h])), lgb = log1pf(-exp2f(-p.l0_decay[4 + h]));
  __syncthreads();
  for (int i = tid; i < 16 * 128; i += NTHR) qs[i] = bf2f(p.proj[(size_t)(t0 + (i >> 7)) * 4096 + h * 128 + (i & 127)]);
  __syncthreads();
  for (int j = tid; j < L; j += NTHR) {
    float acc[16] = {};
    const u16* kr = p.proj + (size_t)(s0 + j) * 4096 + 512 + h * 128;
    for (int d0 = 0; d0 < 128; d0 += 8) {
      const u32x4 kv = *(const u32x4*)(kr + d0);
      float kf[8];
#pragma unroll
      for (int e = 0; e < 4; ++e) { kf[2 * e] = __uint_as_float(kv[e] << 16); kf[2 * e + 1] = __uint_as_float(kv[e] & 0xffff0000u); }
#pragma unroll
      for (int i = 0; i < 16; ++i)
#pragma unroll
        for (int e = 0; e < 8; ++e) acc[i] += qs[i * 128 + d0 + e] * kf[e];
    }
#pragma unroll
    for (int i = 0; i < 16; ++i) {
      const int d = (t0 + i - s0) - j;
      const float w = d > 0 ? __expf((float)d * lgf) : (d < 0 ? __expf((float)(-d) * lgb) : 2.f);
      scr[i * 1024 + j] = acc[i] * w;
    }
  }
  __syncthreads();
  const int dv = tid & 255, ig = tid >> 8;
  float o[8] = {};
  for (int j = 0; j < L; ++j) {
    const float v = bf2f(p.proj[(size_t)(s0 + j) * 4096 + 1024 + h * 256 + dv]);
#pragma unroll
    for (int e = 0; e < 8; ++e) o[e] += scr[(ig * 8 + e) * 1024 + j] * v;
  }
  if (sb >= 0) {
    const float* Sf = p.state + ((size_t)(sb * 2 + 0) * 4 + h) * 128 * 256;
    const float* Sb = p.state + ((size_t)(sb * 2 + 1) * 4 + h) * 128 * 256;
    float af[8] = {}, ab[8] = {};
    for (int dk = 0; dk < 128; ++dk) {
      const float sf = Sf[dk * 256 + dv], sbv = Sb[dk * 256 + dv];
#pragma unroll
      for (int e = 0; e < 8; ++e) { const float q = qs[(ig * 8 + e) * 128 + dk]; af[e] += q * sf; ab[e] += q * sbv; }
    }
#pragma unroll
    for (int e = 0; e < 8; ++e) {
      const int pos = t0 + ig * 8 + e - s0;
      o[e] += __expf((float)(pos + 1) * lgf) * af[e] + __expf((float)(L - pos) * lgb) * ab[e];
    }
  }
  const int wid = tid >> 6, lane = tid & 63;
#pragma unroll
  for (int e = 0; e < 8; ++e) { const float s = wave_sum(o[e] * o[e]); if (lane == 0) red[wid * 8 + e] = s; }
  __syncthreads();
#pragma unroll
  for (int e = 0; e < 8; ++e) {
    const float ss = red[(ig * 4 + 0) * 8 + e] + red[(ig * 4 + 1) * 8 + e] + red[(ig * 4 + 2) * 8 + e] + red[(ig * 4 + 3) * 8 + e];
    const float r = rsqrtf(ss * (1.f / 256.f) + EPS);
    const int t = t0 + ig * 8 + e;
    const float g = bf2f(p.proj[(size_t)t * 4096 + 2048 + h * 256 + dv]);
    p.cat[(size_t)t * 1536 + h * 256 + dv] = f2bf(o[e] * r * g);
  }
}
__device__ __forceinline__ void state_item_naive(const P& p, int item) {
  const int b = item >> 3, h = (item >> 1) & 3, dir = item & 1, tid = threadIdx.x;
  const float lg = log1pf(-exp2f(-p.l0_decay[dir * 4 + h]));
  const int dv = tid & 255;
  float* o = p.out + (size_t)NT * DM + ((size_t)(b * 2 + dir) * 4 + h) * 128 * 256;
  for (int pass = 0; pass < 4; ++pass) {
    const int dk0 = (tid >> 8) * 64 + pass * 16;
    float acc[16] = {};
    for (int s = 0; s < 256; ++s) {
      const int t = b * 256 + s;
      const float w = dir == 0 ? __expf((float)(255 - s) * lg) : __expf((float)s * lg);
      const float v = bf2f(p.proj[(size_t)t * 4096 + 1024 + h * 256 + dv]) * w;
      const u16* kr = p.proj + (size_t)t * 4096 + 512 + h * 128 + dk0;
#pragma unroll
      for (int e = 0; e < 16; ++e) acc[e] += bf2f(kr[e]) * v;
    }
#pragma unroll
    for (int e = 0; e < 16; ++e) o[(dk0 + e) * 256 + dv] = acc[e];
  }
}
__device__ __forceinline__ void gmlp_item_naive(const P& p, int item, float* lds) {
  const int ci = item >> 2, g = item & 3, tid = threadIdx.x, wid = tid >> 6, lane = tid & 63;
  float* zn = lds;
  float* mu = lds + 128 * 128;
  float* rs = mu + 128;
  __syncthreads();
  for (int q = wid; q < 128; q += 8) {
    const u32x4 v = *(const u32x4*)(p.proj + (size_t)(ci * 128 + q) * 4096 + 3584 + lane * 8);
    float s = 0.f, s2 = 0.f;
#pragma unroll
    for (int e = 0; e < 4; ++e) { const float a = __uint_as_float(v[e] << 16), b = __uint_as_float(v[e] & 0xffff0000u); s += a + b; s2 += a * a + b * b; }
    s = wave_sum(s); s2 = wave_sum(s2);
    if (lane == 0) { const float m = s * (1.f / 512.f); const float var = fmaxf(s2 * (1.f / 512.f) - m * m, 0.f); mu[q] = m; rs[q] = rsqrtf(var + EPS); }
  }
  __syncthreads();
  for (int i = tid; i < 128 * 128; i += NTHR) {
    const int q = i >> 7, c = i & 127;
    zn[i] = (bf2f(p.proj[(size_t)(ci * 128 + q) * 4096 + 3584 + g * 128 + c]) - mu[q]) * rs[q];
  }
  __syncthreads();
  const int c = tid & 127, p0 = (tid >> 7) * 32;
  float acc[32] = {};
  const float* W = p.l0_gws + (size_t)g * 128 * 128;
  for (int q = 0; q < 128; ++q) {
    const float z = zn[q * 128 + c];
#pragma unroll
    for (int e = 0; e < 32; ++e) acc[e] += W[(p0 + e) * 128 + q] * z;
  }
#pragma unroll
  for (int e = 0; e < 32; ++e) {
    const int t = ci * 128 + p0 + e;
    const float u = bf2f(p.proj[(size_t)t * 4096 + 3072 + g * 128 + c]);
    p.cat[(size_t)t * 1536 + 1024 + g * 128 + c] = f2bf((acc[e] + p.l0_gb[g * 128 + p0 + e]) * u);
  }
}
__device__ __forceinline__ void phase_mixer_naive(const P& p, float* lds) {
  const int nR = 1536, nS = 128, nG = 192, total = nR + nS + nG;
  for (int it = blockIdx.x; it < total; it += gridDim.x) {
    if (it < nR) ret_item_naive(p, it, lds);
    else if (it < nR + nS) state_item_naive(p, it - nR);
    else gmlp_item_naive(p, it - nR - nS, lds);
  }
}


#define LAS __attribute__((address_space(3)))
typedef short bf16x8 __attribute__((ext_vector_type(8)));
typedef short bf16x4 __attribute__((ext_vector_type(4)));
constexpr int PK = 136;
constexpr int PV = 264;
__device__ __forceinline__ bf16x8 frag_row(const LAS u16* base, int pitch, int r0, int k0, int fr, int fq) {
  return *(const LAS bf16x8*)(base + (r0 + fr) * pitch + k0 + fq * 8);
}
__device__ __forceinline__ bf16x8 frag_tr(const LAS u16* base, int pitch, int k0, int n0, int fr, int fq) {
  const LAS u16* a = base + (k0 + fq * 8 + (fr >> 2)) * pitch + n0 + 4 * (fr & 3);
  const bf16x4 lo = __builtin_amdgcn_ds_read_tr16_b64_v4i16((LAS bf16x4*)a);
  const bf16x4 hi = __builtin_amdgcn_ds_read_tr16_b64_v4i16((LAS bf16x4*)(a + 4 * pitch));
  bf16x8 r; r[0] = lo[0]; r[1] = lo[1]; r[2] = lo[2]; r[3] = lo[3]; r[4] = hi[0]; r[5] = hi[1]; r[6] = hi[2]; r[7] = hi[3];
  return r;
}
__device__ __forceinline__ f32x4 mfma16(bf16x8 a, bf16x8 b, f32x4 c) { return __builtin_amdgcn_mfma_f32_16x16x32_bf16(a, b, c, 0, 0, 0); }
__device__ __forceinline__ void tile_to_lds(const u16* __restrict__ g, size_t gp, LAS u16* l, int lp, int rows, int cols) {
  const int cpr = cols >> 3, total = rows * cpr;
  for (int i = threadIdx.x; i < total; i += NTHR) {
    const int r = i / cpr, c = (i % cpr) * 8;
    *(LAS u32x4*)(l + r * lp + c) = *(const u32x4*)(g + (size_t)r * gp + c);
  }
}

__device__ __forceinline__ void kv_item(const P& p, int item, LAS u16* lds) {
  const int ci = item >> 2, h = item & 3, tid = threadIdx.x, wid = tid >> 6, lane = tid & 63, fr = lane & 15, fq = lane >> 4;
  LAS u16* kbuf = lds; LAS u16* vbuf = lds + 128 * PK;
  __syncthreads();
  tile_to_lds(p.proj + (size_t)ci * 128 * 4096 + 512 + h * 128, 4096, kbuf, PK, 128, 128);
  tile_to_lds(p.proj + (size_t)ci * 128 * 4096 + 1024 + h * 256, 4096, vbuf, PV, 128, 256);
  __syncthreads();
  const int dir = wid >> 2, m0 = (wid & 3) * 32;
  const float lg = log1pf(-exp2f(-p.l0_decay[dir * 4 + h]));
#pragma unroll 1
  for (int nh = 0; nh < 2; ++nh) {
    f32x4 acc[2][8];
#pragma unroll
    for (int m = 0; m < 2; ++m)
#pragma unroll
      for (int n = 0; n < 8; ++n) acc[m][n] = (f32x4){0.f, 0.f, 0.f, 0.f};
#pragma unroll 1
    for (int ks = 0; ks < 4; ++ks) {
      bf16x8 a[2];
      a[0] = frag_tr(kbuf, PK, ks * 32, m0, fr, fq); a[1] = frag_tr(kbuf, PK, ks * 32, m0 + 16, fr, fq);
#pragma unroll
      for (int j = 0; j < 8; ++j) {
        const int tok = ks * 32 + fq * 8 + j;
        const float w = __expf((float)(dir == 0 ? 127 - tok : tok) * lg);
        a[0][j] = (short)f2bf(bf2f((u16)a[0][j]) * w); a[1][j] = (short)f2bf(bf2f((u16)a[1][j]) * w);
      }
#pragma unroll
      for (int n = 0; n < 8; ++n) {
        const bf16x8 b = frag_tr(vbuf, PV, ks * 32, nh * 128 + n * 16, fr, fq);
        acc[0][n] = mfma16(a[0], b, acc[0][n]); acc[1][n] = mfma16(a[1], b, acc[1][n]);
      }
    }
    float* o = p.part + ((size_t)(ci * 4 + h) * 2 + dir) * 128 * 256 + (size_t)(m0 + fq * 4) * 256 + nh * 128 + fr;
#pragma unroll
    for (int m = 0; m < 2; ++m)
#pragma unroll
      for (int j = 0; j < 4; ++j)
#pragma unroll
        for (int n = 0; n < 8; ++n) o[(m * 16 + j) * 256 + n * 16] = acc[m][n][j];
  }
}

__device__ __forceinline__ void gmlp_item(const P& p, int item, LAS u16* lds) {
  const int ci = item >> 2, g = item & 3, tid = threadIdx.x, wid = tid >> 6, lane = tid & 63, fr = lane & 15, fq = lane >> 4;
  LAS u16* zn = lds; LAS u16* wsb = lds + 128 * PK; LAS float* mu = (LAS float*)(lds + 2 * 128 * PK); LAS float* rs = mu + 128;
  __syncthreads();
  for (int q = wid; q < 128; q += 8) {
    const u32x4 v = *(const u32x4*)(p.proj + (size_t)(ci * 128 + q) * 4096 + 3584 + lane * 8);
    float s = 0.f, s2 = 0.f;
#pragma unroll
    for (int e = 0; e < 4; ++e) { const float a = __uint_as_float(v[e] << 16), b = __uint_as_float(v[e] & 0xffff0000u); s += a + b; s2 += a * a + b * b; }
    s = wave_sum(s); s2 = wave_sum(s2);
    if (lane == 0) { const float m = s * (1.f / 512.f); const float var = fmaxf(s2 * (1.f / 512.f) - m * m, 0.f); mu[q] = m; rs[q] = rsqrtf(var + EPS); }
  }
  {
    const float* W = p.l0_gws + (size_t)g * 128 * 128;
    for (int i = tid; i < 128 * 32; i += NTHR) {
      const int r = i >> 5, c = (i & 31) * 4;
      const f32x4 v = *(const f32x4*)(W + r * 128 + c);
      u32x2 o; o[0] = pk2(v[0], v[1]); o[1] = pk2(v[2], v[3]);
      *(LAS u32x2*)(wsb + r * PK + c) = o;
    }
  }
  __syncthreads();
  for (int i = tid; i < 128 * 16; i += NTHR) {
    const int q = i >> 4, c = (i & 15) * 8;
    const u32x4 v = *(const u32x4*)(p.proj + (size_t)(ci * 128 + q) * 4096 + 3584 + g * 128 + c);
    const float m = mu[q], r = rs[q];
    u32x4 o;
#pragma unroll
    for (int e = 0; e < 4; ++e) o[e] = pk2((__uint_as_float(v[e] << 16) - m) * r, (__uint_as_float(v[e] & 0xffff0000u) - m) * r);
    *(LAS u32x4*)(zn + q * PK + c) = o;
  }
  __syncthreads();
  f32x4 acc[8];
#pragma unroll
  for (int n = 0; n < 8; ++n) acc[n] = (f32x4){0.f, 0.f, 0.f, 0.f};
#pragma unroll
  for (int ks = 0; ks < 4; ++ks) {
    const bf16x8 a = frag_row(wsb, PK, wid * 16, ks * 32, fr, fq);
#pragma unroll
    for (int n = 0; n < 8; ++n) acc[n] = mfma16(a, frag_tr(zn, PK, ks * 32, n * 16, fr, fq), acc[n]);
  }
#pragma unroll
  for (int j = 0; j < 4; ++j) {
    const int pr = wid * 16 + fq * 4 + j, t = ci * 128 + pr;
    const float gb = p.l0_gb[g * 128 + pr];
#pragma unroll
    for (int n = 0; n < 8; ++n) {
      const int c = n * 16 + fr;
      const float u = bf2f(p.proj[(size_t)t * 4096 + 3072 + g * 128 + c]);
      p.cat[(size_t)t * 1536 + 1024 + g * 128 + c] = f2bf((acc[n][j] + gb) * u);
    }
  }
}
__device__ __forceinline__ void phase_mix_a(const P& p, LAS u16* lds) {
  for (int it = blockIdx.x; it < 384; it += gridDim.x) { if (it < 192) kv_item(p, it, lds); else gmlp_item(p, it - 192, lds); }
}

__device__ __forceinline__ void build_state(const P& p, LAS u16* bbuf, const float* S0, float w0, int cbase, int h, int dir, int c_lo, int c_hi, int c_ref, float lg128) {
  const int tid = threadIdx.x;
#pragma unroll 1
  for (int half = 0; half < 2; ++half) {
    f32x4 a[8];
    const int base = (tid + half * 4096) * 4;
    if (S0) {
#pragma unroll
      for (int k = 0; k < 8; ++k) a[k] = *(const f32x4*)(S0 + base + k * 2048);
#pragma unroll
      for (int k = 0; k < 8; ++k) a[k] = a[k] * w0;
    } else {
#pragma unroll
      for (int k = 0; k < 8; ++k) a[k] = (f32x4){0.f, 0.f, 0.f, 0.f};
    }
#pragma unroll 1
    for (int cc = c_lo; cc < c_hi; ++cc) {
      const int e = dir == 0 ? (c_ref - 1 - cc) : (cc - c_ref - 1);
      const float w = __expf(lg128 * (float)e);
      const float* src = p.part + ((size_t)((cbase + cc) * 4 + h) * 2 + dir) * 128 * 256 + base;
      f32x4 t[8];
#pragma unroll
      for (int k = 0; k < 8; ++k) t[k] = *(const f32x4*)(src + k * 2048);
#pragma unroll
      for (int k = 0; k < 8; ++k) a[k] = a[k] + t[k] * w;
    }
#pragma unroll
    for (int k = 0; k < 8; ++k) {
      const int i = tid + half * 4096 + k * 512, r = i >> 6, c = (i & 63) * 4;
      u32x2 o; o[0] = pk2(a[k][0], a[k][1]); o[1] = pk2(a[k][2], a[k][3]);
      *(LAS u32x2*)(bbuf + r * PV + c) = o;
    }
  }
}
__device__ __forceinline__ void ret_item(const P& p, int item, LAS u16* lds) {
  const int ci = item >> 2, h = item & 3, tid = threadIdx.x, wid = tid >> 6, lane = tid & 63, fr = lane & 15, fq = lane >> 4;
  int sb, lc, n;
  if (ci < 32) { sb = -1; lc = ci & 1; n = 2; } else { sb = (ci - 32) >> 3; lc = (ci - 32) & 7; n = 8; }
  const int cbase = ci - lc;
  const float lgf = log1pf(-exp2f(-p.l0_decay[h])), lgb = log1pf(-exp2f(-p.l0_decay[4 + h]));
  LAS u16* kbuf = lds; LAS u16* bbuf = lds + 128 * PK; LAS float* red = (LAS float*)(lds + 128 * PK + 128 * PV);
  const bool hasF = (sb >= 0) || lc > 0, hasB = (sb >= 0) || lc < n - 1;
  const u16* qg = p.proj + (size_t)ci * 128 * 4096 + h * 128;
  __syncthreads();
  tile_to_lds(p.proj + (size_t)ci * 128 * 4096 + 512 + h * 128, 4096, kbuf, PK, 128, 128);
  if (hasF) build_state(p, bbuf, sb >= 0 ? p.state + ((size_t)(sb * 2 + 0) * 4 + h) * 128 * 256 : nullptr, __expf(lgf * 128.f * (float)lc), cbase, h, 0, 0, lc, lc, lgf * 128.f);
  __syncthreads();
  {
    f32x4 s[8];
#pragma unroll
    for (int nn = 0; nn < 8; ++nn) s[nn] = (f32x4){0.f, 0.f, 0.f, 0.f};
#pragma unroll 1
    for (int ks = 0; ks < 4; ++ks) {
      const bf16x8 a = *(const bf16x8*)(qg + (size_t)(wid * 16 + fr) * 4096 + ks * 32 + fq * 8);
#pragma unroll
      for (int nn = 0; nn < 8; ++nn) s[nn] = mfma16(a, frag_row(kbuf, PK, nn * 16, ks * 32, fr, fq), s[nn]);
    }
    __syncthreads();
    int bd = wid * 16 + fq * 4 - fr;
    asm volatile("" : "+v"(bd));
    LAS u16* prow = kbuf + (wid * 16 + fq * 4) * PK + fr;
#pragma unroll
    for (int nn = 0; nn < 8; ++nn)
#pragma unroll
      for (int j = 0; j < 4; ++j) {
        const int d = bd + j - 16 * nn;
        const float w = d > 0 ? __expf((float)d * lgf) : (d < 0 ? __expf((float)(-d) * lgb) : 2.f);
        prow[j * PK + nn * 16] = f2bf(s[nn][j] * w);
      }
  }
  const int m0 = (wid & 3) * 32, n0 = (wid >> 2) * 128;
  f32x4 acc[2][8];
#pragma unroll
  for (int m = 0; m < 2; ++m)
#pragma unroll
    for (int nn = 0; nn < 8; ++nn) acc[m][nn] = (f32x4){0.f, 0.f, 0.f, 0.f};
  const u16* qrow = qg + (size_t)(m0 + fr) * 4096 + fq * 8;
  if (hasF) {
#pragma unroll 1
    for (int ks = 0; ks < 4; ++ks) {
      const bf16x8 q0 = *(const bf16x8*)(qrow + ks * 32), q1 = *(const bf16x8*)(qrow + 16 * 4096 + ks * 32);
#pragma unroll
      for (int nn = 0; nn < 8; ++nn) {
        const bf16x8 b = frag_tr(bbuf, PV, ks * 32, n0 + nn * 16, fr, fq);
        acc[0][nn] = mfma16(q0, b, acc[0][nn]); acc[1][nn] = mfma16(q1, b, acc[1][nn]);
      }
    }
#pragma unroll
    for (int m = 0; m < 2; ++m)
#pragma unroll
      for (int j = 0; j < 4; ++j) {
        const int il = m0 + m * 16 + fq * 4 + j;
        const float sc = hasB ? __expf((float)(il + 1) * lgf - (float)(128 - il) * lgb) : __expf((float)(il + 1) * lgf);
#pragma unroll
        for (int nn = 0; nn < 8; ++nn) acc[m][nn][j] *= sc;
      }
  }
  if (hasB) {
    __syncthreads();
    build_state(p, bbuf, sb >= 0 ? p.state + ((size_t)(sb * 2 + 1) * 4 + h) * 128 * 256 : nullptr, __expf(lgb * 128.f * (float)(n - 1 - lc)), cbase, h, 1, lc + 1, n, lc, lgb * 128.f);
    __syncthreads();
#pragma unroll 1
    for (int ks = 0; ks < 4; ++ks) {
      const bf16x8 q0 = *(const bf16x8*)(qrow + ks * 32), q1 = *(const bf16x8*)(qrow + 16 * 4096 + ks * 32);
#pragma unroll
      for (int nn = 0; nn < 8; ++nn) {
        const bf16x8 b = frag_tr(bbuf, PV, ks * 32, n0 + nn * 16, fr, fq);
        acc[0][nn] = mfma16(q0, b, acc[0][nn]); acc[1][nn] = mfma16(q1, b, acc[1][nn]);
      }
    }
#pragma unroll
    for (int m = 0; m < 2; ++m)
#pragma unroll
      for (int j = 0; j < 4; ++j) {
        const int il = m0 + m * 16 + fq * 4 + j;
        const float sc = __expf((float)(128 - il) * lgb);
#pragma unroll
        for (int nn = 0; nn < 8; ++nn) acc[m][nn][j] *= sc;
      }
  }
  __syncthreads();
  tile_to_lds(p.proj + (size_t)ci * 128 * 4096 + 1024 + h * 256, 4096, bbuf, PV, 128, 256);
  __syncthreads();
#pragma unroll 1
  for (int ks = 0; ks < 4; ++ks) {
    const bf16x8 a0 = frag_row(kbuf, PK, m0, ks * 32, fr, fq), a1 = frag_row(kbuf, PK, m0 + 16, ks * 32, fr, fq);
#pragma unroll
    for (int nn = 0; nn < 8; ++nn) {
      const bf16x8 b = frag_tr(bbuf, PV, ks * 32, n0 + nn * 16, fr, fq);
      acc[0][nn] = mfma16(a0, b, acc[0][nn]); acc[1][nn] = mfma16(a1, b, acc[1][nn]);
    }
  }
#pragma unroll
  for (int m = 0; m < 2; ++m)
#pragma unroll
    for (int j = 0; j < 4; ++j) {
      float s = 0.f;
#pragma unroll
      for (int nn = 0; nn < 8; ++nn) s += acc[m][nn][j] * acc[m][nn][j];
      s += __shfl_xor(s, 1); s += __shfl_xor(s, 2); s += __shfl_xor(s, 4); s += __shfl_xor(s, 8);
      if (fr == 0) red[(wid >> 2) * 128 + m0 + m * 16 + fq * 4 + j] = s;
    }
  __syncthreads();
#pragma unroll
  for (int m = 0; m < 2; ++m)
#pragma unroll
    for (int j = 0; j < 4; ++j) {
      const int il = m0 + m * 16 + fq * 4 + j;
      const float r = rsqrtf((red[il] + red[128 + il]) * (1.f / 256.f) + EPS);
      LAS u16* orow = bbuf + il * PV + n0 + fr;
#pragma unroll
      for (int nn = 0; nn < 8; ++nn) orow[nn * 16] = f2bf(acc[m][nn][j] * r);
    }
  __syncthreads();
  {
    const u16* gbase = p.proj + (size_t)ci * 128 * 4096 + 2048 + h * 256;
    u16* obase = p.cat + (size_t)ci * 128 * 1536 + h * 256;
#pragma unroll 2
    for (int i = tid; i < 128 * 32; i += NTHR) {
      const int r = i >> 5, c = (i & 31) * 8;
      const u32x4 ov = *(const LAS u32x4*)(bbuf + r * PV + c);
      const u32x4 gv = *(const u32x4*)(gbase + (size_t)r * 4096 + c);
      u32x4 o;
#pragma unroll
      for (int e = 0; e < 4; ++e) o[e] = pk2(__uint_as_float(ov[e] << 16) * __uint_as_float(gv[e] << 16), __uint_as_float(ov[e] & 0xffff0000u) * __uint_as_float(gv[e] & 0xffff0000u));
      *(u32x4*)(obase + (size_t)r * 1536 + c) = o;
    }
  }
}
__device__ __forceinline__ void state_item(const P& p, int item) {
  const int b = item >> 3, h = (item >> 1) & 3, dir = item & 1;
  const float w = __expf(128.f * log1pf(-exp2f(-p.l0_decay[dir * 4 + h])));
  const int c_old = dir == 0 ? 2 * b : 2 * b + 1, c_new = dir == 0 ? 2 * b + 1 : 2 * b;
  const float* A = p.part + ((size_t)(c_old * 4 + h) * 2 + dir) * 128 * 256;
  const float* B = p.part + ((size_t)(c_new * 4 + h) * 2 + dir) * 128 * 256;
  float* o = p.out + (size_t)NT * DM + ((size_t)(b * 2 + dir) * 4 + h) * 128 * 256;
  for (int i = threadIdx.x; i < 128 * 64; i += NTHR) *(f32x4*)(o + i * 4) = *(const f32x4*)(A + i * 4) * w + *(const f32x4*)(B + i * 4);
}
__device__ __forceinline__ void phase_mix_b(const P& p, LAS u16* lds) {
  for (int it = blockIdx.x; it < 320; it += gridDim.x) { if (it < 192) ret_item(p, it, lds); else state_item(p, it - 192); }
}

__device__ __forceinline__ void phase_conv(const P& p) {
  const u16* pj = p.proj;
  for (size_t i = (size_t)blockIdx.x * NTHR + threadIdx.x; i < (size_t)NT * 256; i += (size_t)gridDim.x * NTHR) {
    const int t = (int)(i >> 8), c4 = (int)(i & 255) * 4;
    const int seg = t < NPROMPT_T ? 256 : 64;
    const int pos = t < NPROMPT_T ? (t & 255) : ((t - NPROMPT_T) & 63);
    f32x4 xc[3];
#pragma unroll
    for (int d = 0; d < 3; ++d) {
      const int pp = pos + d - 1;
      if (pp < 0 || pp >= seg) { xc[d] = (f32x4){0.f, 0.f, 0.f, 0.f}; continue; }
      const u16* r = pj + (size_t)(t + d - 1) * 3072;
      const u32x2 a = *(const u32x2*)(r + 1024 + c4), b = *(const u32x2*)(r + 2048 + c4);
      xc[d][0] = __uint_as_float(a[0] << 16) * __uint_as_float(b[0] << 16);
      xc[d][1] = __uint_as_float(a[0] & 0xffff0000u) * __uint_as_float(b[0] & 0xffff0000u);
      xc[d][2] = __uint_as_float(a[1] << 16) * __uint_as_float(b[1] << 16);
      xc[d][3] = __uint_as_float(a[1] & 0xffff0000u) * __uint_as_float(b[1] & 0xffff0000u);
    }
    const f32x4 w0 = *(const f32x4*)(p.l1_conv + c4), w1 = *(const f32x4*)(p.l1_conv + 1024 + c4), w2 = *(const f32x4*)(p.l1_conv + 2048 + c4);
    const u32x2 bgv = *(const u32x2*)(pj + (size_t)t * 3072 + c4);
    f32x4 bg = {__uint_as_float(bgv[0] << 16), __uint_as_float(bgv[0] & 0xffff0000u), __uint_as_float(bgv[1] << 16), __uint_as_float(bgv[1] & 0xffff0000u)};
    const f32x4 y = bg * (w0 * xc[0] + w1 * xc[1] + w2 * xc[2]);
    u32x2 o; o[0] = pk2(y[0], y[1]); o[1] = pk2(y[2], y[3]);
    *(u32x2*)(p.cat + (size_t)t * 1024 + c4) = o;
  }
}


#define XB_TMO      128
#define XB_XCNT(j)  (256  + 64 * (j))
#define XB_XSUB(j)  (1280 + 64 * (j))
#define XB_XGEN(j)  (2304 + 64 * (j))
#define XB_TOP      3328
#define XB_TOPGEN   3392
#define XCD_BAR_WORDS 3456
#define XB_SPIN_CAP (1u << 18)
__device__ __forceinline__ unsigned xb_ld(unsigned* p)              { return __hip_atomic_load(p, __ATOMIC_RELAXED, __HIP_MEMORY_SCOPE_AGENT); }
__device__ __forceinline__ unsigned xb_add(unsigned* p, unsigned v) { return __hip_atomic_fetch_add(p, v, __ATOMIC_RELAXED, __HIP_MEMORY_SCOPE_AGENT); }
__device__ __forceinline__ unsigned xb_xcc_id() { return (unsigned)__builtin_amdgcn_s_getreg((3 << 11) | 20) & 0xFu; }
#define XB_SPIN(cond, bar) do { unsigned _sp = 0; while (cond) { __builtin_amdgcn_s_sleep(1); \
    if ((++_sp & 255u) == 0u) { if (xb_ld(&(bar)[XB_TMO])) break; if (_sp > XB_SPIN_CAP) { atomicAdd(&(bar)[XB_TMO], 1u); break; } } } } while (0)
struct XcdBarrier { unsigned* bar; unsigned x; volatile __attribute__((address_space(3))) unsigned* st; };
__device__ __forceinline__ XcdBarrier xcd_barrier_post(unsigned* bar, volatile __attribute__((address_space(3))) unsigned* st) {
  XcdBarrier b; b.bar = bar; b.x = xb_xcc_id(); b.st = st;
  if (threadIdx.x == 0) (void)xb_add(&bar[XB_XCNT(b.x)], 1u);
  return b;
}
__device__ __forceinline__ void xcd_barrier_complete(unsigned* bar, unsigned x, unsigned& nloc, unsigned& nx) {
  const unsigned G = gridDim.x * gridDim.y * gridDim.z;
  unsigned sum, cnt, mine, sp = 0u;
  for (;;) {
    sum = 0u; cnt = 0u; mine = 0u;
#pragma unroll
    for (unsigned j = 0; j < 16; ++j) { const unsigned c = xb_ld(&bar[XB_XCNT(j)]); sum += c; cnt += (c > 0u) ? 1u : 0u; mine = (j == x) ? c : mine; }
    if (sum == G) break;
    __builtin_amdgcn_s_sleep(1);
    if ((++sp & 255u) == 0u) { if (xb_ld(&bar[XB_TMO])) break; if (sp > XB_SPIN_CAP) { atomicAdd(&bar[XB_TMO], 1u); break; } }
  }
  nloc = mine > 0u ? mine : 1u; nx = cnt > 0u ? cnt : 1u;
}
__device__ __forceinline__ void xcd_barrier(const XcdBarrier& b) {
  asm volatile("s_waitcnt vmcnt(0)" ::: "memory");
  __syncthreads();
  if (threadIdx.x == 0) {
    unsigned* bar = b.bar;
    __builtin_amdgcn_s_waitcnt(0);
    unsigned nloc = b.st[0], nx = b.st[1];
    if (nloc == 0u) { xcd_barrier_complete(bar, b.x, nloc, nx); b.st[0] = nloc; b.st[1] = nx; }
    const unsigned old = xb_add(&bar[XB_XSUB(b.x)], 1u);
    const unsigned gen = old / nloc;
    if (old + 1u == (gen + 1u) * nloc) {
      __builtin_amdgcn_fence(__ATOMIC_RELEASE, "agent");
      asm volatile("s_waitcnt vmcnt(0)" ::: "memory");
      const unsigned og = xb_add(&bar[XB_TOP], 1u);
      const unsigned tg = og / nx;
      if (og + 1u == (tg + 1u) * nx) xb_add(&bar[XB_TOPGEN], 1u);
      else XB_SPIN(xb_ld(&bar[XB_TOPGEN]) == tg, bar);
      __builtin_amdgcn_fence(__ATOMIC_ACQUIRE, "agent");
      xb_add(&bar[XB_XGEN(b.x)], 1u);
      asm volatile("s_waitcnt vmcnt(0)" ::: "memory");
    } else {
      XB_SPIN(xb_ld(&bar[XB_XGEN(b.x)]) == gen, bar);
      __builtin_amdgcn_fence(__ATOMIC_ACQUIRE, "agent");
      asm volatile("s_waitcnt vmcnt(0)" ::: "memory");
    }
  }
  __syncthreads();
}

__device__ __forceinline__ void phase_norm_fused(const NormArgs& a, unsigned* cnt, unsigned* bar) {
  pg8::Order S; S.init(NT, 1024, 2, (int)gridDim.x, (int)blockIdx.x);
  pg8::Unit u;
  if (!S.next(0, u)) return;
  asm volatile("s_waitcnt vmcnt(0)" ::: "memory");
  __syncthreads();
  if (threadIdx.x == 0) {
    for (int i = 0; S.next(i, u); ++i) xb_add(&cnt[u.pm * 16], 1u);
  }
  const int wid = threadIdx.x >> 6, lane = threadIdx.x & 63;
  for (int i = 0; S.next(i, u); ++i) {
    if (threadIdx.x == 0) {
      XB_SPIN(xb_ld(&cnt[u.pm * 16]) < 8u, bar);
      __builtin_amdgcn_fence(__ATOMIC_ACQUIRE, "agent");
      asm volatile("s_waitcnt vmcnt(0)" ::: "memory");
    }
    __syncthreads();
    const int r0 = u.pm * 256 + (u.pn * 2 + u.ks) * 32 + wid * 4;
    norm_rows<4, 2>(a, r0, lane);
  }
}

__device__ __forceinline__ void phase_ffn(const P& p, const u16* w1t, const u16* w2t, const NormArgs& na, unsigned* cntA, unsigned* cntB, float* lds) {
  const int c = (int)blockIdx.x, tid = threadIdx.x, wid = tid >> 6, lane = tid & 63;
  PG8_LAS unsigned char* l3 = (PG8_LAS unsigned char*)lds;
  __syncthreads();
  { pg8::Gemm g{p.hA, w1t, NT, 4096, 1024, 1}; pg8::FfnOrder1 S{c}; EpiRelu2W e{mk_rsrc(p.proj, (unsigned)NT * 4096u * 2u)}; pg8::gemm_phase(l3, g, S, e); }
  asm volatile("s_waitcnt vmcnt(0)" ::: "memory");
  __syncthreads();
  pg8::Unit u; int ksplit;
  if (c >= 128) { const int j = c - 128, x = j & 7, o = j >> 3; u.pm = 2 * x + (o >> 3); u.pn = (o & 7) >> 1; u.ks = o & 1; ksplit = 2; }
  else { const int x = c & 7, o = c >> 3; u.pm = 16 + x; u.pn = o >> 2; u.ks = o & 3; ksplit = 4; }
  if (tid == 0) {
    { const int x = c & 7, o = c >> 3; xb_add(&cntA[(4 * (x >> 1) + (o >> 3)) * 16], 1u); if (c < 128) xb_add(&cntA[(16 + 2 * (x >> 1) + (o >> 3)) * 16], 1u); }
    XB_SPIN(xb_ld(&cntA[u.pm * 16]) < 16u, p.bar);
    __builtin_amdgcn_fence(__ATOMIC_ACQUIRE, "agent");
    asm volatile("s_waitcnt vmcnt(0)" ::: "memory");
  }
  __syncthreads();
  { pg8::Gemm g{p.proj, w2t, NT, 1024, 4096, ksplit}; pg8::OneUnit S{u}; EpiPartW e{mk_rsrc(p.part, 4u * (unsigned)NT * 1024u * 2u)}; pg8::gemm_phase(l3, g, S, e); }
  asm volatile("s_waitcnt vmcnt(0)" ::: "memory");
  __syncthreads();
  if (tid == 0) {
    xb_add(&cntB[u.pm * 16], 1u);
    XB_SPIN(xb_ld(&cntB[u.pm * 16]) < (unsigned)(4 * ksplit), p.bar);
    __builtin_amdgcn_fence(__ATOMIC_ACQUIRE, "agent");
    asm volatile("s_waitcnt vmcnt(0)" ::: "memory");
  }
  __syncthreads();
  if (ksplit == 2) norm_rows<4, 2>(na, u.pm * 256 + (u.pn * 2 + u.ks) * 32 + wid * 4, lane);
  else norm_rows<2, 4>(na, u.pm * 256 + (u.pn * 4 + u.ks) * 16 + wid * 2, lane);
}

constexpr int NPHASE = 11;
#ifndef REPMASK
#define REPMASK 0
#endif
__global__ void __launch_bounds__(NTHR) mega(P p, int lo, int hi) {
  extern __shared__ __attribute__((aligned(16))) unsigned char smem[];
  float* lds = (float*)smem;
  cg::grid_group grid = cg::this_grid();
  volatile LAS unsigned* xst = (volatile LAS unsigned*)(smem + 131072);
  if (threadIdx.x == 0) { xst[0] = 0u; xst[1] = 0u; }
  __syncthreads();
  const XcdBarrier xb = xcd_barrier_post(p.bar, xst);
  if (hi < 0) grid.sync();
  const float* m0 = p.mod; const float* m1 = p.mod + 3 * 6144;
#define PH(n, ...) if (lo <= (n) && (n) < hi) { if ((n) > lo) xcd_barrier(xb); __VA_ARGS__ if ((REPMASK >> (n)) & 1) { xcd_barrier(xb); __VA_ARGS__ } }
  unsigned* pcnt = p.bar + XCD_BAR_WORDS;
  float* const xs = p.xres + (size_t)NPROMPT_T * DM; float* const pp = p.part;
  PH(0, phase_prep(p, lds);)
  PH(1, { NormArgs a{p.x_prompt, p.x_sample, nullptr, nullptr, nullptr, nullptr, p.l0_norm1, m0 + 0, m0 + 1024, p.hA, nullptr}; phase_norm(a); })
  PH(2, { EpiProj0 e{p.proj}; phase_gemm(p.hA, p.wt0_in, NT, 4096, 1024, 1, e, lds); phase_prep2(p, lds, 0, 128); })
  PH(3, phase_mix_a(p, (LAS u16*)smem);)
  PH(4, phase_mix_b(p, (LAS u16*)smem);)
  PH(5, { EpiPartW e{mk_rsrc(p.part, 4u * (unsigned)NT * 1024u * 2u)}; phase_gemm(p.cat, p.wt0_out, NT, 1024, 1536, 2, e, lds);
          NormArgs a{p.x_prompt, p.x_sample, pp, pp, m0 + 2048, p.xres, p.l0_norm2, m0 + 3072, m0 + 4096, p.hA, nullptr}; phase_norm_fused(a, pcnt + 0 * 384, p.bar);
          phase_prep2(p, lds, 1, 192); })
  PH(6, { NormArgs a{p.xres, xs, pp, pp, m0 + 5120, p.xres, p.l1_norm1, m1 + 0, m1 + 1024, p.hA, nullptr}; phase_ffn(p, p.wt0_f1, p.wt0_f2, a, pcnt + 1 * 384, pcnt + 2 * 384, lds); })
  PH(7, { EpiPlain e{p.proj, 3072}; phase_gemm(p.hA, p.wt1_in, NT, 3072, 1024, 1, e, lds); })
  PH(8, phase_conv(p);)
  PH(9, { EpiPartW e{mk_rsrc(p.part, 4u * (unsigned)NT * 1024u * 2u)}; phase_gemm(p.cat, p.wt1_out, NT, 1024, 1024, 2, e, lds);
          NormArgs a{p.xres, xs, pp, pp, m1 + 2048, p.xres, p.l1_norm2, m1 + 3072, m1 + 4096, p.hA, nullptr}; phase_norm_fused(a, pcnt + 3 * 384, p.bar);
          phase_prep2(p, lds, 2, 192); })
  PH(10, { NormArgs a{p.xres, xs, pp, pp, m1 + 5120, nullptr, p.final_norm, nullptr, nullptr, nullptr, p.out}; phase_ffn(p, p.wt1_f1, p.wt1_f2, a, pcnt + 4 * 384, pcnt + 5 * 384, lds); })
#undef PH
}

constexpr size_t LDS_BYTES = 131072 + 256;
constexpr bool ONE_LAUNCH = true;

extern "C" void kernel_launch(void* const* d_in, const int* in_sizes, int n_in, void* d_out, int out_size, void* d_ws, size_t ws_size, hipStream_t stream) {
  static int grid_blocks = 0;
  if (!grid_blocks) {
    hipFuncSetAttribute((const void*)mega, hipFuncAttributeMaxDynamicSharedMemorySize, (int)LDS_BYTES);
    int dev = 0, cus = 0, per_cu = 0;
    hipGetDevice(&dev);
    hipDeviceGetAttribute(&cus, hipDeviceAttributeMultiprocessorCount, dev);
    hipOccupancyMaxActiveBlocksPerMultiprocessor(&per_cu, mega, NTHR, LDS_BYTES);
    if (per_cu < 1) per_cu = 1;
    if (per_cu > 1) per_cu = 1;
    grid_blocks = 256;
  }
  P p{};
  const float* const* in = (const float* const*)d_in;
  p.x_prompt = in[0]; p.x_sample = in[1]; p.state = in[2]; p.c = in[3]; p.c_ctx = in[4];
  p.l0_norm1 = in[5]; p.l0_w_in = in[6]; p.l0_decay = in[7]; p.l0_gws = in[8]; p.l0_gb = in[9]; p.l0_w_out = in[10]; p.l0_norm2 = in[11];
  p.l0_w_mod = in[12]; p.l0_b_mod = in[13]; p.l0_f1 = in[14]; p.l0_f2 = in[15];
  p.l1_norm1 = in[16]; p.l1_w_in = in[17]; p.l1_conv = in[18]; p.l1_w_out = in[19]; p.l1_norm2 = in[20]; p.l1_w_mod = in[21]; p.l1_b_mod = in[22];
  p.l1_f1 = in[23]; p.l1_f2 = in[24]; p.final_norm = in[25];
  p.out = (float*)d_out;
  unsigned char* w = (unsigned char*)d_ws; size_t off = 0;
  auto take = [&](size_t bytes) { void* r = w + off; off += (bytes + 255) & ~(size_t)255; return r; };
  p.wt0_in = (u16*)take((size_t)4096 * 1024 * 2); p.wt0_out = (u16*)take((size_t)1024 * 1536 * 2);
  p.wt0_f1 = (u16*)take((size_t)4096 * 1024 * 2); p.wt0_f2 = (u16*)take((size_t)4096 * 1024 * 2);
  p.wt1_in = (u16*)take((size_t)3072 * 1024 * 2); p.wt1_out = (u16*)take((size_t)1024 * 1024 * 2);
  p.wt1_f1 = (u16*)take((size_t)4096 * 1024 * 2); p.wt1_f2 = (u16*)take((size_t)4096 * 1024 * 2);
  p.mod = (float*)take((size_t)2 * 3 * 6144 * 4);
  p.hA = (u16*)take((size_t)NT * 1024 * 2);
  p.proj = (u16*)take((size_t)NT * 4096 * 2);
  p.cat = (u16*)take((size_t)NT * 1536 * 2);
  p.part = (float*)take((size_t)2 * NT * 1024 * 4);
  p.xres = (float*)take((size_t)NT * 1024 * 4);
  p.bar = (unsigned*)take((size_t)(XCD_BAR_WORDS + 6 * 384) * 4);
  hipMemsetAsync(p.bar, 0, (size_t)(XCD_BAR_WORDS + 6 * 384) * 4, stream);
  if (ONE_LAUNCH) {
    int lo = 0, hi = NPHASE; void* args[] = {&p, &lo, &hi};
    hipError_t e = hipLaunchCooperativeKernel((void*)mega, dim3(grid_blocks), dim3(NTHR), args, LDS_BYTES, stream);
    if (e != hipSuccess) fprintf(stderr, "cooperative launch failed: %s (grid %d)\n", hipGetErrorString(e), grid_blocks);
  } else {
    for (int ph = 0; ph < NPHASE; ++ph) hipLaunchKernelGGL(mega, dim3(grid_blocks), dim3(NTHR), LDS_BYTES, stream, p, ph, ph + 1);
  }
}
```

```cpp
#include <hip/hip_runtime.h>
#include <hip/hip_cooperative_groups.h>
#include <cstdio>
namespace cg = cooperative_groups;

typedef unsigned short u16;
typedef float f32x4 __attribute__((ext_vector_type(4)));
typedef unsigned u32x4 __attribute__((ext_vector_type(4)));
typedef unsigned u32x2 __attribute__((ext_vector_type(2)));

constexpr int NT = 6144, DM = 1024, NPROMPT_T = 4096;
constexpr float EPS = 1e-6f;
constexpr int NTHR = 512;

__device__ __forceinline__ float bf2f(u16 b) { return __uint_as_float(((unsigned)b) << 16); }
typedef float f32x2 __attribute__((ext_vector_type(2)));
typedef __bf16 hbf16x2 __attribute__((ext_vector_type(2)));
__device__ __forceinline__ unsigned pk2(float a, float b) { const f32x2 v = {a, b}; const hbf16x2 r = __builtin_convertvector(v, hbf16x2); return __builtin_bit_cast(unsigned, r); }
__device__ __forceinline__ u16 f2bf(float f) { return (u16)(pk2(f, 0.f) & 0xffffu); }
__device__ __forceinline__ float silu_f(float x) { return x * __builtin_amdgcn_rcpf(1.f + __expf(-x)); }
__device__ __forceinline__ float gelu_f(float x) { const float u = -1.5957691216057308f * (x + 0.044715f * x * x * x); return x * __builtin_amdgcn_rcpf(1.f + __expf(u)); }
__device__ __forceinline__ int cond_of(int t) { return t < NPROMPT_T ? 0 : 1 + ((t - NPROMPT_T) >> 10); }
__device__ __forceinline__ float wave_sum(float v) {
#pragma unroll
  for (int o = 32; o > 0; o >>= 1) v += __shfl_xor(v, o);
  return v;
}

struct P {
  const float *x_prompt, *x_sample, *state, *c, *c_ctx;
  const float *l0_norm1, *l0_w_in, *l0_decay, *l0_gws, *l0_gb, *l0_w_out, *l0_norm2, *l0_w_mod, *l0_b_mod, *l0_f1, *l0_f2;
  const float *l1_norm1, *l1_w_in, *l1_conv, *l1_w_out, *l1_norm2, *l1_w_mod, *l1_b_mod, *l1_f1, *l1_f2, *final_norm;
  float* out;
  u16 *wt0_in, *wt0_out, *wt0_f1, *wt0_f2, *wt1_in, *wt1_out, *wt1_f1, *wt1_f2;
  float* mod;
  u16* hA;
  u16* proj;
  u16* cat;
  float* part;
  float* xres;
  u16* stimg;
  unsigned* bar;
};

__device__ __forceinline__ unsigned xb_ld(unsigned* p)              { return __hip_atomic_load(p, __ATOMIC_RELAXED, __HIP_MEMORY_SCOPE_AGENT); }
__device__ __forceinline__ unsigned xb_add(unsigned* p, unsigned v) { return __hip_atomic_fetch_add(p, v, __ATOMIC_RELAXED, __HIP_MEMORY_SCOPE_AGENT); }
#define XB_TMO      128
#define XB_SPIN_CAP (1u << 18)
#define XB_SPIN(cond, bar) do { unsigned _sp = 0; while (cond) { __builtin_amdgcn_s_sleep(1); \
    if ((++_sp & 255u) == 0u) { if (xb_ld(&(bar)[XB_TMO])) break; if (_sp > XB_SPIN_CAP) { atomicAdd(&(bar)[XB_TMO], 1u); break; } } } } while (0)

__device__ __forceinline__ void transpose_tile(const float* __restrict__ W, int K, int N, u16* __restrict__ Wt, int tile, float* lds) {
  const int tn = N / 256; const int k0 = (tile / tn) * 64, n0 = (tile % tn) * 256;
  const int tid = threadIdx.x;
  float (*T)[257] = (float (*)[257])lds;
  __syncthreads();
  {
    const int r = tid >> 6, c4 = (tid & 63) * 4;
    f32x4 v[8];
#pragma unroll
    for (int i = 0; i < 8; ++i) v[i] = *(const f32x4*)(W + (size_t)(k0 + r + 8 * i) * N + n0 + c4);
#pragma unroll
    for (int i = 0; i < 8; ++i) { T[r + 8 * i][c4 + 0] = v[i][0]; T[r + 8 * i][c4 + 1] = v[i][1]; T[r + 8 * i][c4 + 2] = v[i][2]; T[r + 8 * i][c4 + 3] = v[i][3]; }
  }
  __syncthreads();
  {
    const int kk = (tid & 7) * 8;
#pragma unroll
    for (int ps = 0; ps < 4; ++ps) {
      const int nn = (tid >> 3) + 64 * ps;
      u32x4 o;
      o[0] = pk2(T[kk + 0][nn], T[kk + 1][nn]); o[1] = pk2(T[kk + 2][nn], T[kk + 3][nn]);
      o[2] = pk2(T[kk + 4][nn], T[kk + 5][nn]); o[3] = pk2(T[kk + 6][nn], T[kk + 7][nn]);
      *(u32x4*)(Wt + (size_t)(n0 + nn) * K + k0 + kk) = o;
    }
  }
}

__device__ __forceinline__ void adaln_item(const P& p, int item, float* lds) {
  const int l = item / 96, n0 = (item % 96) * 64;
  const float* W = l ? p.l1_w_mod : p.l0_w_mod; const float* B = l ? p.l1_b_mod : p.l0_b_mod;
  const int tid = threadIdx.x;
  float* sc = lds;
  float* red = lds + 3072;
  __syncthreads();
  for (int i = tid; i < 3072; i += NTHR) {
    const int c = i >> 10, k = i & 1023;
    const float v = c == 0 ? p.c_ctx[k] : p.c[(c - 1) * 1024 + k];
    sc[i] = silu_f(v);
  }
  __syncthreads();
  const int cg4 = tid & 15, rg = tid >> 4;
  float acc[3][4] = {};
#pragma unroll 8
  for (int it = 0; it < 32; ++it) {
    const int k = it * 32 + rg;
    const f32x4 w = *(const f32x4*)(W + (size_t)k * 6144 + n0 + cg4 * 4);
#pragma unroll
    for (int c = 0; c < 3; ++c) { const float s = sc[c * 1024 + k];
#pragma unroll
      for (int e = 0; e < 4; ++e) acc[c][e] += s * w[e]; }
  }
#pragma unroll
  for (int c = 0; c < 3; ++c)
#pragma unroll
    for (int e = 0; e < 4; ++e) red[(rg * 3 + c) * 64 + cg4 * 4 + e] = acc[c][e];
  __syncthreads();
  if (tid < 192) {
    const int c = tid >> 6, n = tid & 63; float s = B[n0 + n];
    for (int r = 0; r < 32; ++r) s += red[(r * 3 + c) * 64 + n];
    p.mod[(size_t)(l * 3 + c) * 6144 + n0 + n] = s;
  }
}

__device__ __forceinline__ void phase_prep(const P& p, float* lds) {
  for (int it = blockIdx.x; it < 96 + 256; it += gridDim.x) {
    if (it < 96) adaln_item(p, it, lds); else transpose_tile(p.l0_w_in, 1024, 4096, p.wt0_in, it - 96, lds);
  }
}
__device__ __forceinline__ void phase_prep2(const P& p, float* lds, int group, int first_want) {
  const int first = (int)gridDim.x >= 256 ? first_want : 0, nblk = (int)gridDim.x - first;
  if ((int)blockIdx.x < first) return;
  const int total = group == 0 ? 96 + 256 + 256 : (group == 1 ? 96 + 192 + 64 : 256 + 256);
  for (int it = (int)blockIdx.x - first; it < total; it += nblk) {
    int i = it;
    if (group == 0) {
      if (i < 96) { transpose_tile(p.l0_w_out, 1536, 1024, p.wt0_out, i, lds); continue; } i -= 96;
      if (i < 256) { transpose_tile(p.l0_f1, 1024, 4096, p.wt0_f1, i, lds); continue; } i -= 256;
      transpose_tile(p.l0_f2, 4096, 1024, p.wt0_f2, i, lds);
    } else if (group == 1) {
      if (i < 96) { adaln_item(p, 96 + i, lds); continue; } i -= 96;
      if (i < 192) { transpose_tile(p.l1_w_in, 1024, 3072, p.wt1_in, i, lds); continue; } i -= 192;
      transpose_tile(p.l1_w_out, 1024, 1024, p.wt1_out, i, lds);
    } else {
      if (i < 256) { transpose_tile(p.l1_f1, 1024, 4096, p.wt1_f1, i, lds); continue; } i -= 256;
      transpose_tile(p.l1_f2, 4096, 1024, p.wt1_f2, i, lds);
    }
  }
}

struct NormArgs {
  const float* xin0; const float* xin1;
  const float* p0; const float* p1; const float* gate;
  float* xout; const float* nw; const float* sh; const float* sc;
  u16* hout; float* fout;
};
__device__ __forceinline__ void norm_row(const NormArgs& a, int t, int lane) {
  {
    const int c = cond_of(t);
    const float* xr = t < NPROMPT_T ? a.xin0 + (size_t)t * DM : a.xin1 + (size_t)(t - NPROMPT_T) * DM;
    f32x4 x[4]; float ss = 0.f;
#pragma unroll
    for (int i = 0; i < 4; ++i) {
      const int col = lane * 4 + 256 * i;
      x[i] = *(const f32x4*)(xr + col);
      if (a.p0) {
        const u32x2 q0 = *(const u32x2*)((const u16*)a.p0 + (size_t)t * DM + col), q1 = *(const u32x2*)((const u16*)a.p0 + (size_t)(NT + t) * DM + col);
        const f32x4 g = *(const f32x4*)(a.gate + (size_t)c * 6144 + col);
        f32x4 ps;
        ps[0] = __uint_as_float(q0[0] << 16) + __uint_as_float(q1[0] << 16); ps[1] = __uint_as_float(q0[0] & 0xffff0000u) + __uint_as_float(q1[0] & 0xffff0000u);
        ps[2] = __uint_as_float(q0[1] << 16) + __uint_as_float(q1[1] << 16); ps[3] = __uint_as_float(q0[1] & 0xffff0000u) + __uint_as_float(q1[1] & 0xffff0000u);
        x[i] = x[i] + g * ps;
      }
      if (a.xout) *(f32x4*)(a.xout + (size_t)t * DM + col) = x[i];
      ss += x[i][0] * x[i][0] + x[i][1] * x[i][1] + x[i][2] * x[i][2] + x[i][3] * x[i][3];
    }
    ss = wave_sum(ss);
    const float r = rsqrtf(ss * (1.f / 1024.f) + EPS);
#pragma unroll
    for (int i = 0; i < 4; ++i) {
      const int col = lane * 4 + 256 * i;
      const f32x4 w = *(const f32x4*)(a.nw + col);
      f32x4 y = x[i] * r * w;
      if (a.fout) *(f32x4*)(a.fout + (size_t)t * DM + col) = y;
      if (a.hout) {
        const f32x4 sh = *(const f32x4*)(a.sh + (size_t)c * 6144 + col), sc = *(const f32x4*)(a.sc + (size_t)c * 6144 + col);
        y = y * (1.f + sc) + sh;
        u32x2 o; o[0] = pk2(y[0], y[1]); o[1] = pk2(y[2], y[3]);
        *(u32x2*)(a.hout + (size_t)t * DM + col) = o;
      }
    }
  }
}
template <int R, int NP>
__device__ __forceinline__ void norm_rows(const NormArgs& a, int t0, int lane) {
  const int c = cond_of(t0);
  f32x4 x[R][4];
#pragma unroll
  for (int r = 0; r < R; ++r) {
    const int t = t0 + r;
    const float* xr = t < NPROMPT_T ? a.xin0 + (size_t)t * DM : a.xin1 + (size_t)(t - NPROMPT_T) * DM;
#pragma unroll
    for (int i = 0; i < 4; ++i) x[r][i] = *(const f32x4*)(xr + lane * 4 + 256 * i);
  }
  if (a.p0) {
    u32x2 q[R][NP][4];
#pragma unroll
    for (int r = 0; r < R; ++r)
#pragma unroll
      for (int k = 0; k < NP; ++k)
#pragma unroll
        for (int i = 0; i < 4; ++i) q[r][k][i] = *(const u32x2*)((const u16*)a.p0 + ((size_t)k * NT + t0 + r) * DM + lane * 4 + 256 * i);
#pragma unroll
    for (int i = 0; i < 4; ++i) {
      const f32x4 g = *(const f32x4*)(a.gate + (size_t)c * 6144 + lane * 4 + 256 * i);
#pragma unroll
      for (int r = 0; r < R; ++r) {
        f32x4 ps = {0.f, 0.f, 0.f, 0.f};
#pragma unroll
        for (int k = 0; k < NP; ++k) {
          ps[0] += __uint_as_float(q[r][k][i][0] << 16); ps[1] += __uint_as_float(q[r][k][i][0] & 0xffff0000u);
          ps[2] += __uint_as_float(q[r][k][i][1] << 16); ps[3] += __uint_as_float(q[r][k][i][1] & 0xffff0000u);
        }
        x[r][i] = x[r][i] + g * ps;
      }
    }
  }
  float rs[R];
#pragma unroll
  for (int r = 0; r < R; ++r) {
    float ss = 0.f;
#pragma unroll
    for (int i = 0; i < 4; ++i) {
      if (a.xout) *(f32x4*)(a.xout + (size_t)(t0 + r) * DM + lane * 4 + 256 * i) = x[r][i];
      ss += x[r][i][0] * x[r][i][0] + x[r][i][1] * x[r][i][1] + x[r][i][2] * x[r][i][2] + x[r][i][3] * x[r][i][3];
    }
    ss = wave_sum(ss);
    rs[r] = rsqrtf(ss * (1.f / 1024.f) + EPS);
  }
#pragma unroll
  for (int i = 0; i < 4; ++i) {
    const int col = lane * 4 + 256 * i;
    const f32x4 w = *(const f32x4*)(a.nw + col);
    f32x4 sh = {0.f, 0.f, 0.f, 0.f}, sc = {0.f, 0.f, 0.f, 0.f};
    if (a.hout) { sh = *(const f32x4*)(a.sh + (size_t)c * 6144 + col); sc = *(const f32x4*)(a.sc + (size_t)c * 6144 + col); }
#pragma unroll
    for (int r = 0; r < R; ++r) {
      f32x4 y = x[r][i] * rs[r] * w;
      if (a.fout) *(f32x4*)(a.fout + (size_t)(t0 + r) * DM + col) = y;
      if (a.hout) {
        y = y * (1.f + sc) + sh;
        u32x2 o; o[0] = pk2(y[0], y[1]); o[1] = pk2(y[2], y[3]);
        *(u32x2*)(a.hout + (size_t)(t0 + r) * DM + col) = o;
      }
    }
  }
}
__device__ __forceinline__ void phase_norm(const NormArgs& a) {
  const int wid = threadIdx.x >> 6, lane = threadIdx.x & 63;
  for (int g = blockIdx.x * 8 + wid; g < NT / 4; g += gridDim.x * 8) norm_rows<4, 2>(a, g * 4, lane);
}
__device__ __forceinline__ __amdgpu_buffer_rsrc_t mk_rsrc(void* p, unsigned bytes) { return __builtin_amdgcn_make_buffer_rsrc(p, 0, (int)bytes, 0x00020000); }
struct EpiProj0 {
  u16* O;
  __device__ __forceinline__ void store8(int row, int col, f32x4 v0, f32x4 v1, int) const {
    if (col >= 3072) {
#pragma unroll
      for (int e = 0; e < 4; ++e) { v0[e] = gelu_f(v0[e]); v1[e] = gelu_f(v1[e]); }
    } else if (col >= 2048) {
#pragma unroll
      for (int e = 0; e < 4; ++e) { v0[e] = silu_f(v0[e]); v1[e] = silu_f(v1[e]); }
    } else if (col >= 512 && col < 1024) { v0 = v0 * 0.08838834764831845f; v1 = v1 * 0.08838834764831845f; }
    u32x4 o; o[0] = pk2(v0[0], v0[1]); o[1] = pk2(v0[2], v0[3]); o[2] = pk2(v1[0], v1[1]); o[3] = pk2(v1[2], v1[3]);
    __builtin_amdgcn_raw_buffer_store_b128(o, mk_rsrc(O, (unsigned)NT * 4096u * 2u), (unsigned)(((size_t)row * 4096 + col) * 2), 0, 16);
  }
  __device__ __forceinline__ void store4(int row, int col, f32x4 v, int) const {
    if (col >= 3072) { v[0] = gelu_f(v[0]); v[1] = gelu_f(v[1]); v[2] = gelu_f(v[2]); v[3] = gelu_f(v[3]); }
    else if (col >= 2048) { v[0] = silu_f(v[0]); v[1] = silu_f(v[1]); v[2] = silu_f(v[2]); v[3] = silu_f(v[3]); }
    else if (col >= 512 && col < 1024) v = v * 0.08838834764831845f;
    u32x2 o; o[0] = pk2(v[0], v[1]); o[1] = pk2(v[2], v[3]);
    *(u32x2*)(O + (size_t)row * 4096 + col) = o;
  }
};
struct EpiPart {
  float* Pp;
  __device__ __forceinline__ void store8(int row, int col, f32x4 v0, f32x4 v1, int ks) const {
    u32x4 o; o[0] = pk2(v0[0], v0[1]); o[1] = pk2(v0[2], v0[3]); o[2] = pk2(v1[0], v1[1]); o[3] = pk2(v1[2], v1[3]);
    *(u32x4*)((u16*)Pp + ((size_t)ks * NT + row) * DM + col) = o;
  }
};
struct EpiRelu2 {
  u16* O;
  __device__ __forceinline__ void store8(int row, int col, f32x4 v0, f32x4 v1, int) const {
#pragma unroll
    for (int e = 0; e < 4; ++e) { const float r0 = fmaxf(v0[e], 0.f), r1 = fmaxf(v1[e], 0.f); v0[e] = r0 * r0; v1[e] = r1 * r1; }
    u32x4 o; o[0] = pk2(v0[0], v0[1]); o[1] = pk2(v0[2], v0[3]); o[2] = pk2(v1[0], v1[1]); o[3] = pk2(v1[2], v1[3]);
    *(u32x4*)(O + (size_t)row * 4096 + col) = o;
  }
  __device__ __forceinline__ void store4(int row, int col, f32x4 v, int) const {
#pragma unroll
    for (int e = 0; e < 4; ++e) { const float r = fmaxf(v[e], 0.f); v[e] = r * r; }
    u32x2 o; o[0] = pk2(v[0], v[1]); o[1] = pk2(v[2], v[3]);
    *(u32x2*)(O + (size_t)row * 4096 + col) = o;
  }
};
struct EpiPartW {
  __amdgpu_buffer_rsrc_t rs;
  __device__ __forceinline__ void store8(int row, int col, f32x4 v0, f32x4 v1, int ks) const {
    u32x4 o; o[0] = pk2(v0[0], v0[1]); o[1] = pk2(v0[2], v0[3]); o[2] = pk2(v1[0], v1[1]); o[3] = pk2(v1[2], v1[3]);
    __builtin_amdgcn_raw_buffer_store_b128(o, rs, (unsigned)((((size_t)ks * NT + row) * DM + col) * 2), 0, 16);
  }
};
struct EpiRelu2W {
  __amdgpu_buffer_rsrc_t rs;
  __device__ __forceinline__ void store8(int row, int col, f32x4 v0, f32x4 v1, int) const {
#pragma unroll
    for (int e = 0; e < 4; ++e) { const float r0 = fmaxf(v0[e], 0.f), r1 = fmaxf(v1[e], 0.f); v0[e] = r0 * r0; v1[e] = r1 * r1; }
    u32x4 o; o[0] = pk2(v0[0], v0[1]); o[1] = pk2(v0[2], v0[3]); o[2] = pk2(v1[0], v1[1]); o[3] = pk2(v1[2], v1[3]);
    __builtin_amdgcn_raw_buffer_store_b128(o, rs, (unsigned)(((size_t)row * 4096 + col) * 2), 0, 16);
  }
};
struct EpiPlain {
  u16* O; int ld;
  __device__ __forceinline__ void store8(int row, int col, f32x4 v0, f32x4 v1, int) const {
    u32x4 o; o[0] = pk2(v0[0], v0[1]); o[1] = pk2(v0[2], v0[3]); o[2] = pk2(v1[0], v1[1]); o[3] = pk2(v1[2], v1[3]);
    __builtin_amdgcn_raw_buffer_store_b128(o, mk_rsrc(O, (unsigned)NT * 4096u * 2u), (unsigned)(((size_t)row * ld + col) * 2), 0, 16);
  }
  __device__ __forceinline__ void store4(int row, int col, f32x4 v, int) const {
    u32x2 o; o[0] = pk2(v[0], v[1]); o[1] = pk2(v[2], v[3]);
    *(u32x2*)(O + (size_t)row * ld + col) = o;
  }
};

template <class Epi>
__device__ __forceinline__ void phase_gemm_naive(const u16* __restrict__ A, const u16* __restrict__ Bt, int M, int N, int K, int ksplit, const Epi& E, float* lds) {
  float (*As)[33] = (float (*)[33])lds;
  float (*Bs)[33] = (float (*)[33])(lds + 128 * 33);
  const int tm = M / 128, tn = N / 64, total = tm * tn * ksplit, kper = K / ksplit;
  const int tid = threadIdx.x, r = tid >> 2, cq = tid & 3;
  for (int it = blockIdx.x; it < total; it += gridDim.x) {
    const int ks = it / (tm * tn), rem = it % (tm * tn), m0 = (rem / tn) * 128, n0 = (rem % tn) * 64;
    float acc[4][4] = {};
    for (int k0 = ks * kper; k0 < (ks + 1) * kper; k0 += 32) {
      __syncthreads();
      {
        const int kc = (tid & 3) * 8;
        const u32x4 va = *(const u32x4*)(A + (size_t)(m0 + r) * K + k0 + kc);
#pragma unroll
        for (int e = 0; e < 4; ++e) { As[r][kc + 2 * e] = __uint_as_float(va[e] << 16); As[r][kc + 2 * e + 1] = __uint_as_float(va[e] & 0xffff0000u); }
        if (tid < 256) {
          const u32x4 vb = *(const u32x4*)(Bt + (size_t)(n0 + r) * K + k0 + kc);
#pragma unroll
          for (int e = 0; e < 4; ++e) { Bs[r][kc + 2 * e] = __uint_as_float(vb[e] << 16); Bs[r][kc + 2 * e + 1] = __uint_as_float(vb[e] & 0xffff0000u); }
        }
      }
      __syncthreads();
#pragma unroll 4
      for (int k = 0; k < 32; ++k) {
        const float a = As[r][k];
#pragma unroll
        for (int jj = 0; jj < 4; ++jj)
#pragma unroll
          for (int e = 0; e < 4; ++e) acc[jj][e] += a * Bs[cq * 4 + 16 * jj + e][k];
      }
    }
#pragma unroll
    for (int jj = 0; jj < 4; ++jj) { f32x4 v = {acc[jj][0], acc[jj][1], acc[jj][2], acc[jj][3]}; E.store4(m0 + r, n0 + cq * 4 + 16 * jj, v, ks); }
  }
}


namespace pg8 {
#define PG8_LAS __attribute__((address_space(3)))
typedef short bf16x8 __attribute__((ext_vector_type(8)));
constexpr int BM = 256, BK = 64, HALF = 128, HTB = HALF * BK * 2, STAGE_BYTES = 8 * HTB, NXCD = 8, WGM = 8;
__device__ __forceinline__ int lds_byte(int r, int c) { const int st = (r >> 4) * 2 + (c >> 5), rr = r & 15, cc = c & 31, ob = rr * 64 + cc * 2; return st * 1024 + (ob ^ (((ob >> 9) & 1) << 5)); }
__device__ __forceinline__ int perm32(int rho) { const int n = rho >> 4, i = rho & 15; return 8 * (i >> 2) + 4 * n + (i & 3); }
__device__ __forceinline__ void stage_rc(int b, int& R, int& C) { const int st = b / 1024, sb = b % 1024, swz = sb ^ (((sb >> 9) & 1) << 5); R = (st >> 1) * 16 + swz / 64; C = (st & 1) * 32 + (swz % 64) / 2; }
struct Unit { int pm, pn, ks; };
struct Gemm { const u16* A; const u16* Bt; int M, N, K, ksplit; };
struct Order {
  int nM, nN, ntile, nwg, G, c;
  __device__ void init(int M, int N, int ksplit, int G_, int c_) { nM = M / BM; nN = N / BM; ntile = nM * nN; nwg = ntile * ksplit; G = G_; c = c_; }
  __device__ bool next(int i, Unit& u) const {
    const int L = i * G + c; if (L >= nwg) return false;
    u.ks = L / ntile; int wgid = L % ntile;
    { const int q = ntile / NXCD, r = ntile % NXCD, xcd = wgid % NXCD, off = wgid / NXCD; wgid = (xcd < r ? xcd * (q + 1) : r * (q + 1) + (xcd - r) * q) + off; }
    const int nig = WGM * nN, gid = wgid / nig, fm = gid * WGM, gsz = (nM - fm) < WGM ? (nM - fm) : WGM;
    u.pm = fm + ((wgid % nig) % gsz); u.pn = (wgid % nig) / gsz; return true;
  }
};
template <class Epi>
__device__ __forceinline__ void run_epi(const Epi& E, const f32x4 (&acc)[2][2][4][2], const Unit& u, int wr, int wc, int fr, int fq) {
  const int row0 = u.pm * BM + wr * 64 + fr, col0 = u.pn * BM + wc * 32 + 8 * fq;
#pragma unroll
  for (int ai = 0; ai < 2; ++ai)
#pragma unroll
    for (int m = 0; m < 4; ++m)
#pragma unroll
      for (int bj = 0; bj < 2; ++bj) E.store8(row0 + ai * HALF + m * 16, col0 + bj * HALF, acc[ai][bj][m][0], acc[ai][bj][m][1], u.ks);
}
struct OneUnit { Unit u; __device__ __forceinline__ bool next(int i, Unit& o) const { if (i) return false; o = u; return true; } };
struct FfnOrder1 {
  int c;
  __device__ __forceinline__ bool next(int i, Unit& u) const {
    const int x = c & 7, o = c >> 3;
    if (i == 0) { u.pm = 4 * (x >> 1) + (o >> 3); u.pn = (x & 1) * 8 + (o & 7); u.ks = 0; return true; }
    if (i == 1 && c < 128) { u.pm = 16 + 2 * (x >> 1) + (o >> 3); u.pn = (x & 1) * 8 + (o & 7); u.ks = 0; return true; }
    return false;
  }
};
template <class Epi, class Sched>
__device__ __forceinline__ void gemm_phase(PG8_LAS unsigned char* lds, const Gemm g, const Sched& S, const Epi& E) {
  const int tid = threadIdx.x, wid = __builtin_amdgcn_readfirstlane(tid >> 6), lane = tid & 63, wr = wid >> 2, wc = wid & 3, fr = lane & 15, fq = lane >> 4;
  const int K = g.K, kper = g.K / g.ksplit, nt = kper / BK;
  unsigned voffA[2], voffB[2];
#pragma unroll
  for (int i = 0; i < 2; ++i) { int R, C; stage_rc(tid * 16 + i * 8192, R, C); const int Rb = (R & ~31) + perm32(R & 31);
    voffA[i] = (unsigned)(R * K + C) * 2u; voffB[i] = (unsigned)(Rb * K + C) * 2u; }
  const size_t kstep = (size_t)(BK * 2);
  const size_t hstep = (size_t)HALF * K * 2;
  const size_t tstep = 2 * hstep;
  const size_t ksbytes = (size_t)kper * 2;
  const unsigned ldsw = (unsigned)wid * 1024u;
  const int aoff = lds_byte(wr * 64 + fr, fq * 8), boff = lds_byte(wc * 32 + fr, fq * 8);
#define PG8_SA(b, h) (((b) * 2 + (h)) * HTB)
#define PG8_SB(b, h) ((4 + (b) * 2 + (h)) * HTB)
#define PG8_STAGE(bufoff, gbase, voff) do { _Pragma("unroll") for (int _i = 0; _i < 2; ++_i) \
    __builtin_amdgcn_global_load_lds((const unsigned*)((const char*)(gbase) + (voff)[_i]), (PG8_LAS unsigned*)(lds + (bufoff) + ldsw + _i * 8192), 16, 0, 0); } while (0)
#define PG8_LDA(dst, b, h) do { _Pragma("unroll") for (int m = 0; m < 4; ++m) _Pragma("unroll") for (int k = 0; k < 2; ++k) dst[m][k] = *(const PG8_LAS bf16x8*)(lds + PG8_SA(b, h) + aoff + m * 2048 + k * 1024); } while (0)
#define PG8_LDB(dst, b, h) do { _Pragma("unroll") for (int n = 0; n < 2; ++n) _Pragma("unroll") for (int k = 0; k < 2; ++k) dst[n][k] = *(const PG8_LAS bf16x8*)(lds + PG8_SB(b, h) + boff + n * 2048 + k * 1024); } while (0)
#define PG8_MMA(ai, bj, At, Bt) do { __builtin_amdgcn_s_setprio(1); _Pragma("unroll") for (int m = 0; m < 4; ++m) _Pragma("unroll") for (int n = 0; n < 2; ++n) _Pragma("unroll") for (int k = 0; k < 2; ++k) \
    acc[ai][bj][m][n] = __builtin_amdgcn_mfma_f32_16x16x32_bf16(Bt[n][k], At[m][k], acc[ai][bj][m][n], 0, 0, 0); __builtin_amdgcn_s_setprio(0); } while (0)
#define PG8_WAIT_V(n) asm volatile("s_waitcnt vmcnt(" #n ")" ::: "memory")
#define PG8_WAIT_L(n) asm volatile("s_waitcnt lgkmcnt(" #n ")" ::: "memory")
#define PG8_BAR __builtin_amdgcn_s_barrier()
#define PG8_SCHED __builtin_amdgcn_sched_barrier(0)
  Unit cur, nxt; int ui = 0;
  if (!S.next(0, cur)) return;
  f32x4 acc[2][2][4][2];
#pragma unroll
  for (int a = 0; a < 2; ++a)
#pragma unroll
    for (int b = 0; b < 2; ++b)
#pragma unroll
      for (int m = 0; m < 4; ++m)
#pragma unroll
        for (int n = 0; n < 2; ++n) acc[a][b][m][n] = (f32x4){0.f, 0.f, 0.f, 0.f};
  bf16x8 At[4][2], B0[2][2], B1[2][2];
  const char* cA = (const char*)g.A + (size_t)cur.pm * tstep + (size_t)cur.ks * ksbytes; const char* cB = (const char*)g.Bt + (size_t)cur.pn * tstep + (size_t)cur.ks * ksbytes;
  PG8_STAGE(PG8_SB(0, 0), cB, voffB); PG8_STAGE(PG8_SA(0, 0), cA, voffA); PG8_STAGE(PG8_SB(0, 1), cB + hstep, voffB); PG8_STAGE(PG8_SA(0, 1), cA + hstep, voffA);
  if (wr == 1) PG8_BAR;
  PG8_WAIT_V(4); PG8_BAR;
  PG8_STAGE(PG8_SB(1, 0), cB + kstep, voffB); PG8_STAGE(PG8_SA(1, 0), cA + kstep, voffA); PG8_STAGE(PG8_SB(1, 1), cB + hstep + kstep, voffB);
  PG8_WAIT_V(6); PG8_BAR;
  for (;;) {
    const bool has_next = S.next(ui + 1, nxt);
    const char* nA = has_next ? (const char*)g.A + (size_t)nxt.pm * tstep + (size_t)nxt.ks * ksbytes : cA; const char* nB = has_next ? (const char*)g.Bt + (size_t)nxt.pn * tstep + (size_t)nxt.ks * ksbytes : cB;
    for (int t = 0; t < nt; t += 2) {
      const bool last = (t == nt - 2);
      const char* a1 = cA + (size_t)(t + 1) * kstep;
      const char* a2 = last ? nA : cA + (size_t)(t + 2) * kstep; const char* b2 = last ? nB : cB + (size_t)(t + 2) * kstep;
      const char* a3 = a2 + kstep; const char* b3 = b2 + kstep;
      PG8_LDB(B0, 0, 0); PG8_SCHED; PG8_LDA(At, 0, 0); PG8_STAGE(PG8_SA(1, 1), a1 + hstep, voffA);
      PG8_WAIT_L(8); PG8_BAR; PG8_WAIT_L(0); PG8_MMA(0, 0, At, B0); PG8_BAR; PG8_SCHED;
      PG8_LDB(B1, 0, 1); PG8_STAGE(PG8_SB(0, 0), b2, voffB);
      PG8_BAR; PG8_WAIT_L(0); PG8_MMA(0, 1, At, B1); PG8_BAR;
      PG8_LDA(At, 0, 1); PG8_STAGE(PG8_SA(0, 0), a2, voffA);
      PG8_BAR; PG8_WAIT_L(0); PG8_MMA(1, 0, At, B0); PG8_BAR; PG8_SCHED;
      PG8_STAGE(PG8_SB(0, 1), b2 + hstep, voffB);
      PG8_WAIT_V(6); PG8_BAR; PG8_MMA(1, 1, At, B1); PG8_BAR;
      PG8_LDB(B0, 1, 0); PG8_SCHED; PG8_LDA(At, 1, 0); PG8_STAGE(PG8_SA(0, 1), a2 + hstep, voffA);
      PG8_WAIT_L(8); PG8_BAR; PG8_WAIT_L(0); PG8_MMA(0, 0, At, B0); PG8_BAR; PG8_SCHED;
      PG8_LDB(B1, 1, 1); PG8_STAGE(PG8_SB(1, 0), b3, voffB);
      PG8_BAR; PG8_WAIT_L(0); PG8_MMA(0, 1, At, B1); PG8_BAR;
      PG8_LDA(At, 1, 1); PG8_STAGE(PG8_SA(1, 0), a3, voffA);
      PG8_BAR; PG8_WAIT_L(0); PG8_MMA(1, 0, At, B0); PG8_BAR; PG8_SCHED;
      PG8_STAGE(PG8_SB(1, 1), b3 + hstep, voffB);
      PG8_WAIT_V(6); PG8_BAR; PG8_MMA(1, 1, At, B1); PG8_BAR;
    }
    run_epi(E, acc, cur, wr, wc, fr, fq);
    if (!has_next) break;
#pragma unroll
    for (int a = 0; a < 2; ++a)
#pragma unroll
      for (int b = 0; b < 2; ++b)
#pragma unroll
        for (int m = 0; m < 4; ++m)
#pragma unroll
          for (int n = 0; n < 2; ++n) acc[a][b][m][n] = (f32x4){0.f, 0.f, 0.f, 0.f};
    cur = nxt; cA = nA; cB = nB; ++ui;
  }
  PG8_WAIT_V(0);
  if (wr == 0) PG8_BAR;
  PG8_BAR;
#undef PG8_SA
#undef PG8_SB
#undef PG8_STAGE
#undef PG8_LDA
#undef PG8_LDB
#undef PG8_MMA
#undef PG8_WAIT_V
#undef PG8_WAIT_L
#undef PG8_BAR
#undef PG8_SCHED
}
}
template <class Epi>
__device__ __forceinline__ void phase_gemm(const u16* A, const u16* Bt, int M, int N, int K, int ksplit, const Epi& E, float* lds) {
  __syncthreads();
  pg8::Gemm g{A, Bt, M, N, K, ksplit};
  pg8::Order S; S.init(M, N, ksplit, (int)gridDim.x, (int)blockIdx.x);
  pg8::gemm_phase(( __attribute__((address_space(3))) unsigned char*)lds, g, S, E);
  __syncthreads();
}

__device__ __forceinline__ void seq_of_token(int t, int& s0, int& L, int& sb) {
  if (t < NPROMPT_T) { s0 = t & ~255; L = 256; sb = -1; } else { sb = (t - NPROMPT_T) >> 10; s0 = NPROMPT_T + (sb << 10); L = 1024; }
}
__device__ __forceinline__ void ret_item_naive(const P& p, int item, float* lds) {
  const int tg = item >> 2, h = item & 3, t0 = tg * 16, tid = threadIdx.x;
  int s0, L, sb; seq_of_token(t0, s0, L, sb);
  float* scr = lds;
  float* qs = lds + 16 * 1024;
  float* red = qs + 16 * 128;
  const float lgf = log1pf(-exp2f(-p.l0_decay[h])), lgb = log1pf(-exp2f(-p.l0_decay[4 + h]));
  __syncthreads();
  for (int i = tid; i < 16 * 128; i += NTHR) qs[i] = bf2f(p.proj[(size_t)(t0 + (i >> 7)) * 4096 + h * 128 + (i & 127)]);
  __syncthreads();
  for (int j = tid; j < L; j += NTHR) {
    float acc[16] = {};
    const u16* kr = p.proj + (size_t)(s0 + j) * 4096 + 512 + h * 128;
    for (int d0 = 0; d0 < 128; d0 += 8) {
      const u32x4 kv = *(const u32x4*)(kr + d0);
      float kf[8];
#pragma unroll
      for (int e = 0; e < 4; ++e) { kf[2 * e] = __uint_as_float(kv[e] << 16); kf[2 * e + 1] = __uint_as_float(kv[e] & 0xffff0000u); }
#pragma unroll
      for (int i = 0; i < 16; ++i)
#pragma unroll
        for (int e = 0; e < 8; ++e) acc[i] += qs[i * 128 + d0 + e] * kf[e];
    }
#pragma unroll
    for (int i = 0; i < 16; ++i) {
      const int d = (t0 + i - s0) - j;
      const float w = d > 0 ? __expf((float)d * lgf) : (d < 0 ? __expf((float)(-d) * lgb) : 2.f);
      scr[i * 1024 + j] = acc[i] * w;
    }
  }
  __syncthreads();
  const int dv = tid & 255, ig = tid >> 8;
  float o[8] = {};
  for (int j = 0; j < L; ++j) {
    const float v = bf2f(p.proj[(size_t)(s0 + j) * 4096 + 1024 + h * 256 + dv]);
#pragma unroll
    for (int e = 0; e < 8; ++e) o[e] += scr[(ig * 8 + e) * 1024 + j] * v;
  }
  if (sb >= 0) {
    const float* Sf = p.state + ((size_t)(sb * 2 + 0) * 4 + h) * 128 * 256;
    const float* Sb = p.state + ((size_t)(sb * 2 + 1) * 4 + h) * 128 * 256;
    float af[8] = {}, ab[8] = {};
    for (int dk = 0; dk < 128; ++dk) {
      const float sf = Sf[dk * 256 + dv], sbv = Sb[dk * 256 + dv];
#pragma unroll
      for (int e = 0; e < 8; ++e) { const float q = qs[(ig * 8 + e) * 128 + dk]; af[e] += q * sf; ab[e] += q * sbv; }
    }
#pragma unroll
    for (int e = 0; e < 8; ++e) {
      const int pos = t0 + ig * 8 + e - s0;
      o[e] += __expf((float)(pos + 1) * lgf) * af[e] + __expf((float)(L - pos) * lgb) * ab[e];
    }
  }
  const int wid = tid >> 6, lane = tid & 63;
#pragma unroll
  for (int e = 0; e < 8; ++e) { const float s = wave_sum(o[e] * o[e]); if (lane == 0) red[wid * 8 + e] = s; }
  __syncthreads();
#pragma unroll
  for (int e = 0; e < 8; ++e) {
    const float ss = red[(ig * 4 + 0) * 8 + e] + red[(ig * 4 + 1) * 8 + e] + red[(ig * 4 + 2) * 8 + e] + red[(ig * 4 + 3) * 8 + e];
    const float r = rsqrtf(ss * (1.f / 256.f) + EPS);
    const int t = t0 + ig * 8 + e;
    const float g = bf2f(p.proj[(size_t)t * 4096 + 2048 + h * 256 + dv]);
    p.cat[(size_t)t * 1536 + h * 256 + dv] = f2bf(o[e] * r * g);
  }
}
__device__ __forceinline__ void state_item_naive(const P& p, int item) {
  const int b = item >> 3, h = (item >> 1) & 3, dir = item & 1, tid = threadIdx.x;
  const float lg = log1pf(-exp2f(-p.l0_decay[dir * 4 + h]));
  const int dv = tid & 255;
  float* o = p.out + (size_t)NT * DM + ((size_t)(b * 2 + dir) * 4 + h) * 128 * 256;
  for (int pass = 0; pass < 4; ++pass) {
    const int dk0 = (tid >> 8) * 64 + pass * 16;
    float acc[16] = {};
    for (int s = 0; s < 256; ++s) {
      const int t = b * 256 + s;
      const float w = dir == 0 ? __expf((float)(255 - s) * lg) : __expf((float)s * lg);
      const float v = bf2f(p.proj[(size_t)t * 4096 + 1024 + h * 256 + dv]) * w;
      const u16* kr = p.proj + (size_t)t * 4096 + 512 + h * 128 + dk0;
#pragma unroll
      for (int e = 0; e < 16; ++e) acc[e] += bf2f(kr[e]) * v;
    }
#pragma unroll
    for (int e = 0; e < 16; ++e) o[(dk0 + e) * 256 + dv] = acc[e];
  }
}
__device__ __forceinline__ void gmlp_item_naive(const P& p, int item, float* lds) {
  const int ci = item >> 2, g = item & 3, tid = threadIdx.x, wid = tid >> 6, lane = tid & 63;
  float* zn = lds;
  float* mu = lds + 128 * 128;
  float* rs = mu + 128;
  __syncthreads();
  for (int q = wid; q < 128; q += 8) {
    const u32x4 v = *(const u32x4*)(p.proj + (size_t)(ci * 128 + q) * 4096 + 3584 + lane * 8);
    float s = 0.f, s2 = 0.f;
#pragma unroll
    for (int e = 0; e < 4; ++e) { const float a = __uint_as_float(v[e] << 16), b = __uint_as_float(v[e] & 0xffff0000u); s += a + b; s2 += a * a + b * b; }
    s = wave_sum(s); s2 = wave_sum(s2);
    if (lane == 0) { const float m = s * (1.f / 512.f); const float var = fmaxf(s2 * (1.f / 512.f) - m * m, 0.f); mu[q] = m; rs[q] = rsqrtf(var + EPS); }
  }
  __syncthreads();
  for (int i = tid; i < 128 * 128; i += NTHR) {
    const int q = i >> 7, c = i & 127;
    zn[i] = (bf2f(p.proj[(size_t)(ci * 128 + q) * 4096 + 3584 + g * 128 + c]) - mu[q]) * rs[q];
  }
  __syncthreads();
  const int c = tid & 127, p0 = (tid >> 7) * 32;
  float acc[32] = {};
  const float* W = p.l0_gws + (size_t)g * 128 * 128;
  for (int q = 0; q < 128; ++q) {
    const float z = zn[q * 128 + c];
#pragma unroll
    for (int e = 0; e < 32; ++e) acc[e] += W[(p0 + e) * 128 + q] * z;
  }
#pragma unroll
  for (int e = 0; e < 32; ++e) {
    const int t = ci * 128 + p0 + e;
    const float u = bf2f(p.proj[(size_t)t * 4096 + 3072 + g * 128 + c]);
    p.cat[(size_t)t * 1536 + 1024 + g * 128 + c] = f2bf((acc[e] + p.l0_gb[g * 128 + p0 + e]) * u);
  }
}
__device__ __forceinline__ void phase_mixer_naive(const P& p, float* lds) {
  const int nR = 1536, nS = 128, nG = 192, total = nR + nS + nG;
  for (int it = blockIdx.x; it < total; it += gridDim.x) {
    if (it < nR) ret_item_naive(p, it, lds);
    else if (it < nR + nS) state_item_naive(p, it - nR);
    else gmlp_item_naive(p, it - nR - nS, lds);
  }
}


#define LAS __attribute__((address_space(3)))
typedef short bf16x8 __attribute__((ext_vector_type(8)));
typedef short bf16x4 __attribute__((ext_vector_type(4)));
constexpr int PK = 136;
constexpr int PV = 264;
__device__ __forceinline__ bf16x8 frag_row(const LAS u16* base, int pitch, int r0, int k0, int fr, int fq) {
  return *(const LAS bf16x8*)(base + (r0 + fr) * pitch + k0 + fq * 8);
}
__device__ __forceinline__ bf16x8 frag_tr(const LAS u16* base, int pitch, int k0, int n0, int fr, int fq) {
  const LAS u16* a = base + (k0 + fq * 8 + (fr >> 2)) * pitch + n0 + 4 * (fr & 3);
  const bf16x4 lo = __builtin_amdgcn_ds_read_tr16_b64_v4i16((LAS bf16x4*)a);
  const bf16x4 hi = __builtin_amdgcn_ds_read_tr16_b64_v4i16((LAS bf16x4*)(a + 4 * pitch));
  bf16x8 r; r[0] = lo[0]; r[1] = lo[1]; r[2] = lo[2]; r[3] = lo[3]; r[4] = hi[0]; r[5] = hi[1]; r[6] = hi[2]; r[7] = hi[3];
  return r;
}
__device__ __forceinline__ f32x4 mfma16(bf16x8 a, bf16x8 b, f32x4 c) { return __builtin_amdgcn_mfma_f32_16x16x32_bf16(a, b, c, 0, 0, 0); }
__device__ __forceinline__ void tile_to_lds(const u16* __restrict__ g, size_t gp, LAS u16* l, int lp, int rows, int cols) {
  const int cpr = cols >> 3, total = rows * cpr;
  for (int i = threadIdx.x; i < total; i += NTHR) {
    const int r = i / cpr, c = (i % cpr) * 8;
    *(LAS u32x4*)(l + r * lp + c) = *(const u32x4*)(g + (size_t)r * gp + c);
  }
}

__device__ __forceinline__ void kv_item(const P& p, int item, LAS u16* lds) {
  const int ci = item >> 2, h = item & 3, tid = threadIdx.x, wid = tid >> 6, lane = tid & 63, fr = lane & 15, fq = lane >> 4;
  LAS u16* kbuf = lds; LAS u16* vbuf = lds + 128 * PK;
  __syncthreads();
  tile_to_lds(p.proj + (size_t)ci * 128 * 4096 + 512 + h * 128, 4096, kbuf, PK, 128, 128);
  tile_to_lds(p.proj + (size_t)ci * 128 * 4096 + 1024 + h * 256, 4096, vbuf, PV, 128, 256);
  __syncthreads();
  const int dir = wid >> 2, m0 = (wid & 3) * 32;
  const float lg = log1pf(-exp2f(-p.l0_decay[dir * 4 + h]));
#pragma unroll 1
  for (int nh = 0; nh < 2; ++nh) {
    f32x4 acc[2][8];
#pragma unroll
    for (int m = 0; m < 2; ++m)
#pragma unroll
      for (int n = 0; n < 8; ++n) acc[m][n] = (f32x4){0.f, 0.f, 0.f, 0.f};
#pragma unroll 1
    for (int ks = 0; ks < 4; ++ks) {
      bf16x8 a[2];
      a[0] = frag_tr(kbuf, PK, ks * 32, m0, fr, fq); a[1] = frag_tr(kbuf, PK, ks * 32, m0 + 16, fr, fq);
#pragma unroll
      for (int j = 0; j < 8; ++j) {
        const int tok = ks * 32 + fq * 8 + j;
        const float w = __expf((float)(dir == 0 ? 127 - tok : tok) * lg);
        a[0][j] = (short)f2bf(bf2f((u16)a[0][j]) * w); a[1][j] = (short)f2bf(bf2f((u16)a[1][j]) * w);
      }
#pragma unroll
      for (int n = 0; n < 8; ++n) {
        const bf16x8 b = frag_tr(vbuf, PV, ks * 32, nh * 128 + n * 16, fr, fq);
        acc[0][n] = mfma16(a[0], b, acc[0][n]); acc[1][n] = mfma16(a[1], b, acc[1][n]);
      }
    }
    float* o = p.part + ((size_t)(ci * 4 + h) * 2 + dir) * 128 * 256 + (size_t)(m0 + fq * 4) * 256 + nh * 128 + fr;
#pragma unroll
    for (int m = 0; m < 2; ++m)
#pragma unroll
      for (int j = 0; j < 4; ++j)
#pragma unroll
        for (int n = 0; n < 8; ++n) o[(m * 16 + j) * 256 + n * 16] = acc[m][n][j];
  }
}

__device__ __forceinline__ void gmlp_item(const P& p, int item, LAS u16* lds) {
  const int ci = item >> 2, g = item & 3, tid = threadIdx.x, wid = tid >> 6, lane = tid & 63, fr = lane & 15, fq = lane >> 4;
  LAS u16* zn = lds; LAS u16* wsb = lds + 128 * PK; LAS float* mu = (LAS float*)(lds + 2 * 128 * PK); LAS float* rs = mu + 128;
  __syncthreads();
  for (int q = wid; q < 128; q += 8) {
    const u32x4 v = *(const u32x4*)(p.proj + (size_t)(ci * 128 + q) * 4096 + 3584 + lane * 8);
    float s = 0.f, s2 = 0.f;
#pragma unroll
    for (int e = 0; e < 4; ++e) { const float a = __uint_as_float(v[e] << 16), b = __uint_as_float(v[e] & 0xffff0000u); s += a + b; s2 += a * a + b * b; }
    s = wave_sum(s); s2 = wave_sum(s2);
    if (lane == 0) { const float m = s * (1.f / 512.f); const float var = fmaxf(s2 * (1.f / 512.f) - m * m, 0.f); mu[q] = m; rs[q] = rsqrtf(var + EPS); }
  }
  {
    const float* W = p.l0_gws + (size_t)g * 128 * 128;
    for (int i = tid; i < 128 * 32; i += NTHR) {
      const int r = i >> 5, c = (i & 31) * 4;
      const f32x4 v = *(const f32x4*)(W + r * 128 + c);
      u32x2 o; o[0] = pk2(v[0], v[1]); o[1] = pk2(v[2], v[3]);
      *(LAS u32x2*)(wsb + r * PK + c) = o;
    }
  }
  __syncthreads();
  for (int i = tid; i < 128 * 16; i += NTHR) {
    const int q = i >> 4, c = (i & 15) * 8;
    const u32x4 v = *(const u32x4*)(p.proj + (size_t)(ci * 128 + q) * 4096 + 3584 + g * 128 + c);
    const float m = mu[q], r = rs[q];
    u32x4 o;
#pragma unroll
    for (int e = 0; e < 4; ++e) o[e] = pk2((__uint_as_float(v[e] << 16) - m) * r, (__uint_as_float(v[e] & 0xffff0000u) - m) * r);
    *(LAS u32x4*)(zn + q * PK + c) = o;
  }
  __syncthreads();
  f32x4 acc[8];
#pragma unroll
  for (int n = 0; n < 8; ++n) acc[n] = (f32x4){0.f, 0.f, 0.f, 0.f};
#pragma unroll
  for (int ks = 0; ks < 4; ++ks) {
    const bf16x8 a = frag_row(wsb, PK, wid * 16, ks * 32, fr, fq);
#pragma unroll
    for (int n = 0; n < 8; ++n) acc[n] = mfma16(a, frag_tr(zn, PK, ks * 32, n * 16, fr, fq), acc[n]);
  }
#pragma unroll
  for (int j = 0; j < 4; ++j) {
    const int pr = wid * 16 + fq * 4 + j, t = ci * 128 + pr;
    const float gb = p.l0_gb[g * 128 + pr];
#pragma unroll
    for (int n = 0; n < 8; ++n) {
      const int c = n * 16 + fr;
      const float u = bf2f(p.proj[(size_t)t * 4096 + 3072 + g * 128 + c]);
      p.cat[(size_t)t * 1536 + 1024 + g * 128 + c] = f2bf((acc[n][j] + gb) * u);
    }
  }
}
__device__ __forceinline__ void phase_mix_a(const P& p, LAS u16* lds) {
  for (int it = blockIdx.x; it < 384; it += gridDim.x) { if (it < 192) kv_item(p, it, lds); else gmlp_item(p, it - 192, lds); }
}

__device__ __forceinline__ void build_state(const P& p, LAS u16* bbuf, const float* S0, float w0, int cbase, int h, int dir, int c_lo, int c_hi, int c_ref, float lg128) {
  const int tid = threadIdx.x;
#pragma unroll 1
  for (int half = 0; half < 2; ++half) {
    f32x4 a[8];
    const int base = (tid + half * 4096) * 4;
    if (S0) {
#pragma unroll
      for (int k = 0; k < 8; ++k) a[k] = *(const f32x4*)(S0 + base + k * 2048);
#pragma unroll
      for (int k = 0; k < 8; ++k) a[k] = a[k] * w0;
    } else {
#pragma unroll
      for (int k = 0; k < 8; ++k) a[k] = (f32x4){0.f, 0.f, 0.f, 0.f};
    }
#pragma unroll 1
    for (int cc = c_lo; cc < c_hi; ++cc) {
      const int e = dir == 0 ? (c_ref - 1 - cc) : (cc - c_ref - 1);
      const float w = __expf(lg128 * (float)e);
      const float* src = p.part + ((size_t)((cbase + cc) * 4 + h) * 2 + dir) * 128 * 256 + base;
      f32x4 t[8];
#pragma unroll
      for (int k = 0; k < 8; ++k) t[k] = *(const f32x4*)(src + k * 2048);
#pragma unroll
      for (int k = 0; k < 8; ++k) a[k] = a[k] + t[k] * w;
    }
#pragma unroll
    for (int k = 0; k < 8; ++k) {
      const int i = tid + half * 4096 + k * 512, r = i >> 6, c = (i & 63) * 4;
      u32x2 o; o[0] = pk2(a[k][0], a[k][1]); o[1] = pk2(a[k][2], a[k][3]);
      *(LAS u32x2*)(bbuf + r * PV + c) = o;
    }
  }
}
__device__ __forceinline__ void scan_item(const P& p, int item, unsigned* scnt) {
  const int combo = item >> 2, q = item & 3, dir = combo & 1, h = (combo >> 1) & 3, sb = combo >> 3, tid = threadIdx.x;
  const float g = __expf(128.f * log1pf(-exp2f(-p.l0_decay[dir * 4 + h])));
  const float* S0 = p.state + ((size_t)(sb * 2 + dir) * 4 + h) * 128 * 256 + q * 32 * 256;
  const float* KV = p.part + ((size_t)((32 + sb * 8) * 4 + h) * 2 + dir) * 128 * 256 + q * 32 * 256;
  u16* img = p.stimg + ((size_t)combo * 8) * 128 * 256 + q * 32 * 256;
  f32x4 s[4], kv[7][4];
#pragma unroll
  for (int k = 0; k < 4; ++k) s[k] = *(const f32x4*)(S0 + (tid + 512 * k) * 4);
#pragma unroll
  for (int c = 0; c < 7; ++c)
#pragma unroll
    for (int k = 0; k < 4; ++k) kv[c][k] = *(const f32x4*)(KV + (size_t)(c + dir) * (4 * 2 * 128 * 256) + (tid + 512 * k) * 4);
#pragma unroll
  for (int st = 0; st < 8; ++st) {
    const int c = dir == 0 ? st : 7 - st;
    if (st > 0) {
#pragma unroll
      for (int k = 0; k < 4; ++k) s[k] = s[k] * g + kv[dir == 0 ? st - 1 : 7 - st][k];
    }
#pragma unroll
    for (int k = 0; k < 4; ++k) {
      const unsigned long long v = (unsigned long long)pk2(s[k][0], s[k][1]) | ((unsigned long long)pk2(s[k][2], s[k][3]) << 32);
      __hip_atomic_store((unsigned long long*)(img + (size_t)c * 128 * 256 + (tid + 512 * k) * 4), v, __ATOMIC_RELAXED, __HIP_MEMORY_SCOPE_AGENT);
    }
  }
  asm volatile("s_waitcnt vmcnt(0)" ::: "memory");
  __syncthreads();
  if (tid == 0) xb_add(&scnt[combo * 16], 1u);
}
__device__ __forceinline__ void ret_item(const P& p, int item, LAS u16* lds, unsigned* scnt) {
  const int ci = item >> 2, h = item & 3, tid = threadIdx.x, wid = tid >> 6, lane = tid & 63, fr = lane & 15, fq = lane >> 4;
  int sb, lc, n;
  if (ci < 32) { sb = -1; lc = ci & 1; n = 2; } else { sb = (ci - 32) >> 3; lc = (ci - 32) & 7; n = 8; }
  const int cbase = ci - lc;
  const float lgf = log1pf(-exp2f(-p.l0_decay[h])), lgb = log1pf(-exp2f(-p.l0_decay[4 + h]));
  LAS u16* kbuf = lds; LAS u16* bbuf = lds + 128 * PK; LAS float* red = (LAS float*)(lds + 128 * PK + 128 * PV);
  const bool hasF = (sb >= 0) || lc > 0, hasB = (sb >= 0) || lc < n - 1;
  const u16* qg = p.proj + (size_t)ci * 128 * 4096 + h * 128;
  __syncthreads();
  tile_to_lds(p.proj + (size_t)ci * 128 * 4096 + 512 + h * 128, 4096, kbuf, PK, 128, 128);
  __syncthreads();
  {
    f32x4 s[8];
#pragma unroll
    for (int nn = 0; nn < 8; ++nn) s[nn] = (f32x4){0.f, 0.f, 0.f, 0.f};
#pragma unroll 1
    for (int ks = 0; ks < 4; ++ks) {
      const bf16x8 a = *(const bf16x8*)(qg + (size_t)(wid * 16 + fr) * 4096 + ks * 32 + fq * 8);
#pragma unroll
      for (int nn = 0; nn < 8; ++nn) s[nn] = mfma16(a, frag_row(kbuf, PK, nn * 16, ks * 32, fr, fq), s[nn]);
    }
    __syncthreads();
    int bd = wid * 16 + fq * 4 - fr;
    asm volatile("" : "+v"(bd));
    LAS u16* prow = kbuf + (wid * 16 + fq * 4) * PK + fr;
#pragma unroll
    for (int nn = 0; nn < 8; ++nn)
#pragma unroll
      for (int j = 0; j < 4; ++j) {
        const int d = bd + j - 16 * nn;
        const float w = d > 0 ? __expf((float)d * lgf) : (d < 0 ? __expf((float)(-d) * lgb) : 2.f);
        prow[j * PK + nn * 16] = f2bf(s[nn][j] * w);
      }
  }
  const int m0 = (wid & 3) * 32, n0 = (wid >> 2) * 128;
  f32x4 acc[2][8];
#pragma unroll
  for (int m = 0; m < 2; ++m)
#pragma unroll
    for (int nn = 0; nn < 8; ++nn) acc[m][nn] = (f32x4){0.f, 0.f, 0.f, 0.f};
  const u16* qrow = qg + (size_t)(m0 + fr) * 4096 + fq * 8;
  if (sb >= 0) {
    if (tid == 0) {
      XB_SPIN(xb_ld(&scnt[((sb * 4 + h) * 2 + 0) * 16]) < 4u || xb_ld(&scnt[((sb * 4 + h) * 2 + 1) * 16]) < 4u, p.bar);
      __builtin_amdgcn_fence(__ATOMIC_ACQUIRE, "agent");
      asm volatile("s_waitcnt vmcnt(0)" ::: "memory");
    }
    __syncthreads();
    tile_to_lds(p.stimg + ((size_t)((sb * 4 + h) * 2 + 0) * 8 + lc) * 128 * 256, 256, bbuf, PV, 128, 256);
    __syncthreads();
  } else if (hasF) {
    build_state(p, bbuf, nullptr, 0.f, cbase, h, 0, 0, lc, lc, lgf * 128.f);
    __syncthreads();
  }
  if (hasF) {
#pragma unroll 1
    for (int ks = 0; ks < 4; ++ks) {
      const bf16x8 q0 = *(const bf16x8*)(qrow + ks * 32), q1 = *(const bf16x8*)(qrow + 16 * 4096 + ks * 32);
#pragma unroll
      for (int nn = 0; nn < 8; ++nn) {
        const bf16x8 b = frag_tr(bbuf, PV, ks * 32, n0 + nn * 16, fr, fq);
        acc[0][nn] = mfma16(q0, b, acc[0][nn]); acc[1][nn] = mfma16(q1, b, acc[1][nn]);
      }
    }
#pragma unroll
    for (int m = 0; m < 2; ++m)
#pragma unroll
      for (int j = 0; j < 4; ++j) {
        const int il = m0 + m * 16 + fq * 4 + j;
        const float sc = hasB ? __expf((float)(il + 1) * lgf - (float)(128 - il) * lgb) : __expf((float)(il + 1) * lgf);
#pragma unroll
        for (int nn = 0; nn < 8; ++nn) acc[m][nn][j] *= sc;
      }
  }
  if (hasB) {
    __syncthreads();
    if (sb >= 0) tile_to_lds(p.stimg + ((size_t)((sb * 4 + h) * 2 + 1) * 8 + lc) * 128 * 256, 256, bbuf, PV, 128, 256);
    else build_state(p, bbuf, nullptr, 0.f, cbase, h, 1, lc + 1, n, lc, lgb * 128.f);
    __syncthreads();
#pragma unroll 1
    for (int ks = 0; ks < 4; ++ks) {
      const bf16x8 q0 = *(const bf16x8*)(qrow + ks * 32), q1 = *(const bf16x8*)(qrow + 16 * 4096 + ks * 32);
#pragma unroll
      for (int nn = 0; nn < 8; ++nn) {
        const bf16x8 b = frag_tr(bbuf, PV, ks * 32, n0 + nn * 16, fr, fq);
        acc[0][nn] = mfma16(q0, b, acc[0][nn]); acc[1][nn] = mfma16(q1, b, acc[1][nn]);
      }
    }
#pragma unroll
    for (int m = 0; m < 2; ++m)
#pragma unroll
      for (int j = 0; j < 4; ++j) {
        const int il = m0 + m * 16 + fq * 4 + j;
        const float sc = __expf((float)(128 - il) * lgb);
#pragma unroll
        for (int nn = 0; nn < 8; ++nn) acc[m][nn][j] *= sc;
      }
  }
  __syncthreads();
  tile_to_lds(p.proj + (size_t)ci * 128 * 4096 + 1024 + h * 256, 4096, bbuf, PV, 128, 256);
  __syncthreads();
#pragma unroll 1
  for (int ks = 0; ks < 4; ++ks) {
    const bf16x8 a0 = frag_row(kbuf, PK, m0, ks * 32, fr, fq), a1 = frag_row(kbuf, PK, m0 + 16, ks * 32, fr, fq);
#pragma unroll
    for (int nn = 0; nn < 8; ++nn) {
      const bf16x8 b = frag_tr(bbuf, PV, ks * 32, n0 + nn * 16, fr, fq);
      acc[0][nn] = mfma16(a0, b, acc[0][nn]); acc[1][nn] = mfma16(a1, b, acc[1][nn]);
    }
  }
#pragma unroll
  for (int m = 0; m < 2; ++m)
#pragma unroll
    for (int j = 0; j < 4; ++j) {
      float s = 0.f;
#pragma unroll
      for (int nn = 0; nn < 8; ++nn) s += acc[m][nn][j] * acc[m][nn][j];
      s += __shfl_xor(s, 1); s += __shfl_xor(s, 2); s += __shfl_xor(s, 4); s += __shfl_xor(s, 8);
      if (fr == 0) red[(wid >> 2) * 128 + m0 + m * 16 + fq * 4 + j] = s;
    }
  __syncthreads();
#pragma unroll
  for (int m = 0; m < 2; ++m)
#pragma unroll
    for (int j = 0; j < 4; ++j) {
      const int il = m0 + m * 16 + fq * 4 + j;
      const float r = rsqrtf((red[il] + red[128 + il]) * (1.f / 256.f) + EPS);
      LAS u16* orow = bbuf + il * PV + n0 + fr;
#pragma unroll
      for (int nn = 0; nn < 8; ++nn) orow[nn * 16] = f2bf(acc[m][nn][j] * r);
    }
  __syncthreads();
  {
    const u16* gbase = p.proj + (size_t)ci * 128 * 4096 + 2048 + h * 256;
    u16* obase = p.cat + (size_t)ci * 128 * 1536 + h * 256;
#pragma unroll 2
    for (int i = tid; i < 128 * 32; i += NTHR) {
      const int r = i >> 5, c = (i & 31) * 8;
      const u32x4 ov = *(const LAS u32x4*)(bbuf + r * PV + c);
      const u32x4 gv = *(const u32x4*)(gbase + (size_t)r * 4096 + c);
      u32x4 o;
#pragma unroll
      for (int e = 0; e < 4; ++e) o[e] = pk2(__uint_as_float(ov[e] << 16) * __uint_as_float(gv[e] << 16), __uint_as_float(ov[e] & 0xffff0000u) * __uint_as_float(gv[e] & 0xffff0000u));
      *(u32x4*)(obase + (size_t)r * 1536 + c) = o;
    }
  }
}
__device__ __forceinline__ void state_item(const P& p, int item) {
  const int b = item >> 3, h = (item >> 1) & 3, dir = item & 1;
  const float w = __expf(128.f * log1pf(-exp2f(-p.l0_decay[dir * 4 + h])));
  const int c_old = dir == 0 ? 2 * b : 2 * b + 1, c_new = dir == 0 ? 2 * b + 1 : 2 * b;
  const float* A = p.part + ((size_t)(c_old * 4 + h) * 2 + dir) * 128 * 256;
  const float* B = p.part + ((size_t)(c_new * 4 + h) * 2 + dir) * 128 * 256;
  float* o = p.out + (size_t)NT * DM + ((size_t)(b * 2 + dir) * 4 + h) * 128 * 256;
  for (int i = threadIdx.x; i < 128 * 64; i += NTHR) *(f32x4*)(o + i * 4) = *(const f32x4*)(A + i * 4) * w + *(const f32x4*)(B + i * 4);
}
__device__ __forceinline__ void phase_mix_b(const P& p, LAS u16* lds, unsigned* scnt) {
  const int b = (int)blockIdx.x;
  if (b < 64) ret_item(p, 128 + b, lds, scnt);
  else if (b < 192) ret_item(p, b - 64, lds, scnt);
  else { scan_item(p, b - 192, scnt); state_item(p, 2 * (b - 192)); state_item(p, 2 * (b - 192) + 1); }
}

__device__ __forceinline__ void phase_conv(const P& p) {
  const u16* pj = p.proj;
  for (size_t i = (size_t)blockIdx.x * NTHR + threadIdx.x; i < (size_t)NT * 256; i += (size_t)gridDim.x * NTHR) {
    const int t = (int)(i >> 8), c4 = (int)(i & 255) * 4;
    const int seg = t < NPROMPT_T ? 256 : 64;
    const int pos = t < NPROMPT_T ? (t & 255) : ((t - NPROMPT_T) & 63);
    f32x4 xc[3];
#pragma unroll
    for (int d = 0; d < 3; ++d) {
      const int pp = pos + d - 1;
      if (pp < 0 || pp >= seg) { xc[d] = (f32x4){0.f, 0.f, 0.f, 0.f}; continue; }
      const u16* r = pj + (size_t)(t + d - 1) * 3072;
      const u32x2 a = *(const u32x2*)(r + 1024 + c4), b = *(const u32x2*)(r + 2048 + c4);
      xc[d][0] = __uint_as_float(a[0] << 16) * __uint_as_float(b[0] << 16);
      xc[d][1] = __uint_as_float(a[0] & 0xffff0000u) * __uint_as_float(b[0] & 0xffff0000u);
      xc[d][2] = __uint_as_float(a[1] << 16) * __uint_as_float(b[1] << 16);
      xc[d][3] = __uint_as_float(a[1] & 0xffff0000u) * __uint_as_float(b[1] & 0xffff0000u);
    }
    const f32x4 w0 = *(const f32x4*)(p.l1_conv + c4), w1 = *(const f32x4*)(p.l1_conv + 1024 + c4), w2 = *(const f32x4*)(p.l1_conv + 2048 + c4);
    const u32x2 bgv = *(const u32x2*)(pj + (size_t)t * 3072 + c4);
    f32x4 bg = {__uint_as_float(bgv[0] << 16), __uint_as_float(bgv[0] & 0xffff0000u), __uint_as_float(bgv[1] << 16), __uint_as_float(bgv[1] & 0xffff0000u)};
    const f32x4 y = bg * (w0 * xc[0] + w1 * xc[1] + w2 * xc[2]);
    u32x2 o; o[0] = pk2(y[0], y[1]); o[1] = pk2(y[2], y[3]);
    *(u32x2*)(p.cat + (size_t)t * 1024 + c4) = o;
  }
}


#define XB_XCNT(j)  (256  + 64 * (j))
#define XB_XSUB(j)  (1280 + 64 * (j))
#define XB_XGEN(j)  (2304 + 64 * (j))
#define XB_TOP      3328
#define XB_TOPGEN   3392
#define XCD_BAR_WORDS 3456
__device__ __forceinline__ unsigned xb_xcc_id() { return (unsigned)__builtin_amdgcn_s_getreg((3 << 11) | 20) & 0xFu; }
struct XcdBarrier { unsigned* bar; unsigned x; volatile __attribute__((address_space(3))) unsigned* st; };
__device__ __forceinline__ XcdBarrier xcd_barrier_post(unsigned* bar, volatile __attribute__((address_space(3))) unsigned* st) {
  XcdBarrier b; b.bar = bar; b.x = xb_xcc_id(); b.st = st;
  if (threadIdx.x == 0) (void)xb_add(&bar[XB_XCNT(b.x)], 1u);
  return b;
}
__device__ __forceinline__ void xcd_barrier_complete(unsigned* bar, unsigned x, unsigned& nloc, unsigned& nx) {
  const unsigned G = gridDim.x * gridDim.y * gridDim.z;
  unsigned sum, cnt, mine, sp = 0u;
  for (;;) {
    sum = 0u; cnt = 0u; mine = 0u;
#pragma unroll
    for (unsigned j = 0; j < 16; ++j) { const unsigned c = xb_ld(&bar[XB_XCNT(j)]); sum += c; cnt += (c > 0u) ? 1u : 0u; mine = (j == x) ? c : mine; }
    if (sum == G) break;
    __builtin_amdgcn_s_sleep(1);
    if ((++sp & 255u) == 0u) { if (xb_ld(&bar[XB_TMO])) break; if (sp > XB_SPIN_CAP) { atomicAdd(&bar[XB_TMO], 1u); break; } }
  }
  nloc = mine > 0u ? mine : 1u; nx = cnt > 0u ? cnt : 1u;
}
__device__ __forceinline__ void xcd_barrier(const XcdBarrier& b) {
  asm volatile("s_waitcnt vmcnt(0)" ::: "memory");
  __syncthreads();
  if (threadIdx.x == 0) {
    unsigned* bar = b.bar;
    __builtin_amdgcn_s_waitcnt(0);
    unsigned nloc = b.st[0], nx = b.st[1];
    if (nloc == 0u) { xcd_barrier_complete(bar, b.x, nloc, nx); b.st[0] = nloc; b.st[1] = nx; }
    const unsigned old = xb_add(&bar[XB_XSUB(b.x)], 1u);
    const unsigned gen = old / nloc;
    if (old + 1u == (gen + 1u) * nloc) {
      __builtin_amdgcn_fence(__ATOMIC_RELEASE, "agent");
      asm volatile("s_waitcnt vmcnt(0)" ::: "memory");
      const unsigned og = xb_add(&bar[XB_TOP], 1u);
      const unsigned tg = og / nx;
      if (og + 1u == (tg + 1u) * nx) xb_add(&bar[XB_TOPGEN], 1u);
      else XB_SPIN(xb_ld(&bar[XB_TOPGEN]) == tg, bar);
      __builtin_amdgcn_fence(__ATOMIC_ACQUIRE, "agent");
      xb_add(&bar[XB_XGEN(b.x)], 1u);
      asm volatile("s_waitcnt vmcnt(0)" ::: "memory");
    } else {
      XB_SPIN(xb_ld(&bar[XB_XGEN(b.x)]) == gen, bar);
      __builtin_amdgcn_fence(__ATOMIC_ACQUIRE, "agent");
      asm volatile("s_waitcnt vmcnt(0)" ::: "memory");
    }
  }
  __syncthreads();
}

__device__ __forceinline__ void phase_norm_fused(const NormArgs& a, unsigned* cnt, unsigned* bar) {
  pg8::Order S; S.init(NT, 1024, 2, (int)gridDim.x, (int)blockIdx.x);
  pg8::Unit u;
  if (!S.next(0, u)) return;
  asm volatile("s_waitcnt vmcnt(0)" ::: "memory");
  __syncthreads();
  if (threadIdx.x == 0) {
    for (int i = 0; S.next(i, u); ++i) xb_add(&cnt[u.pm * 16], 1u);
  }
  const int wid = threadIdx.x >> 6, lane = threadIdx.x & 63;
  for (int i = 0; S.next(i, u); ++i) {
    if (threadIdx.x == 0) {
      XB_SPIN(xb_ld(&cnt[u.pm * 16]) < 8u, bar);
      __builtin_amdgcn_fence(__ATOMIC_ACQUIRE, "agent");
      asm volatile("s_waitcnt vmcnt(0)" ::: "memory");
    }
    __syncthreads();
    const int r0 = u.pm * 256 + (u.pn * 2 + u.ks) * 32 + wid * 4;
    norm_rows<4, 2>(a, r0, lane);
  }
}

__device__ __forceinline__ void phase_ffn(const P& p, const u16* w1t, const u16* w2t, const NormArgs& na, unsigned* cntA, unsigned* cntB, float* lds) {
  const int c = (int)blockIdx.x, tid = threadIdx.x, wid = tid >> 6, lane = tid & 63;
  PG8_LAS unsigned char* l3 = (PG8_LAS unsigned char*)lds;
  __syncthreads();
  { pg8::Gemm g{p.hA, w1t, NT, 4096, 1024, 1}; pg8::FfnOrder1 S{c}; EpiRelu2W e{mk_rsrc(p.proj, (unsigned)NT * 4096u * 2u)}; pg8::gemm_phase(l3, g, S, e); }
  asm volatile("s_waitcnt vmcnt(0)" ::: "memory");
  __syncthreads();
  pg8::Unit u; int ksplit;
  if (c >= 128) { const int j = c - 128, x = j & 7, o = j >> 3; u.pm = 2 * x + (o >> 3); u.pn = (o & 7) >> 1; u.ks = o & 1; ksplit = 2; }
  else { const int x = c & 7, o = c >> 3; u.pm = 16 + x; u.pn = o >> 2; u.ks = o & 3; ksplit = 4; }
  if (tid == 0) {
    { const int x = c & 7, o = c >> 3; xb_add(&cntA[(4 * (x >> 1) + (o >> 3)) * 16], 1u); if (c < 128) xb_add(&cntA[(16 + 2 * (x >> 1) + (o >> 3)) * 16], 1u); }
    XB_SPIN(xb_ld(&cntA[u.pm * 16]) < 16u, p.bar);
    __builtin_amdgcn_fence(__ATOMIC_ACQUIRE, "agent");
    asm volatile("s_waitcnt vmcnt(0)" ::: "memory");
  }
  __syncthreads();
  { pg8::Gemm g{p.proj, w2t, NT, 1024, 4096, ksplit}; pg8::OneUnit S{u}; EpiPartW e{mk_rsrc(p.part, 4u * (unsigned)NT * 1024u * 2u)}; pg8::gemm_phase(l3, g, S, e); }
  asm volatile("s_waitcnt vmcnt(0)" ::: "memory");
  __syncthreads();
  if (tid == 0) {
    xb_add(&cntB[u.pm * 16], 1u);
    XB_SPIN(xb_ld(&cntB[u.pm * 16]) < (unsigned)(4 * ksplit), p.bar);
    __builtin_amdgcn_fence(__ATOMIC_ACQUIRE, "agent");
    asm volatile("s_waitcnt vmcnt(0)" ::: "memory");
  }
  __syncthreads();
  if (ksplit == 2) norm_rows<4, 2>(na, u.pm * 256 + (u.pn * 2 + u.ks) * 32 + wid * 4, lane);
  else norm_rows<2, 4>(na, u.pm * 256 + (u.pn * 4 + u.ks) * 16 + wid * 2, lane);
}

constexpr int NPHASE = 11;
#ifndef REPMASK
#define REPMASK 0
#endif
__global__ void __launch_bounds__(NTHR) mega(P p, int lo, int hi) {
  extern __shared__ __attribute__((aligned(16))) unsigned char smem[];
  float* lds = (float*)smem;
  cg::grid_group grid = cg::this_grid();
  volatile LAS unsigned* xst = (volatile LAS unsigned*)(smem + 131072);
  if (threadIdx.x == 0) { xst[0] = 0u; xst[1] = 0u; }
  __syncthreads();
  const XcdBarrier xb = xcd_barrier_post(p.bar, xst);
  if (hi < 0) grid.sync();
  const float* m0 = p.mod; const float* m1 = p.mod + 3 * 6144;
#define PH(n, ...) if (lo <= (n) && (n) < hi) { if ((n) > lo) xcd_barrier(xb); __VA_ARGS__ if ((REPMASK >> (n)) & 1) { xcd_barrier(xb); __VA_ARGS__ } }
  unsigned* pcnt = p.bar + XCD_BAR_WORDS;
  float* const xs = p.xres + (size_t)NPROMPT_T * DM; float* const pp = p.part;
  PH(0, phase_prep(p, lds);)
  PH(1, { NormArgs a{p.x_prompt, p.x_sample, nullptr, nullptr, nullptr, nullptr, p.l0_norm1, m0 + 0, m0 + 1024, p.hA, nullptr}; phase_norm(a); })
  PH(2, { EpiProj0 e{p.proj}; phase_gemm(p.hA, p.wt0_in, NT, 4096, 1024, 1, e, lds); phase_prep2(p, lds, 0, 128); })
  PH(3, phase_mix_a(p, (LAS u16*)smem);)
  PH(4, phase_mix_b(p, (LAS u16*)smem, pcnt + 6 * 384);)
  PH(5, { EpiPartW e{mk_rsrc(p.part, 4u * (unsigned)NT * 1024u * 2u)}; phase_gemm(p.cat, p.wt0_out, NT, 1024, 1536, 2, e, lds);
          NormArgs a{p.x_prompt, p.x_sample, pp, pp, m0 + 2048, p.xres, p.l0_norm2, m0 + 3072, m0 + 4096, p.hA, nullptr}; phase_norm_fused(a, pcnt + 0 * 384, p.bar);
          phase_prep2(p, lds, 1, 192); })
  PH(6, { NormArgs a{p.xres, xs, pp, pp, m0 + 5120, p.xres, p.l1_norm1, m1 + 0, m1 + 1024, p.hA, nullptr}; phase_ffn(p, p.wt0_f1, p.wt0_f2, a, pcnt + 1 * 384, pcnt + 2 * 384, lds); })
  PH(7, { EpiPlain e{p.proj, 3072}; phase_gemm(p.hA, p.wt1_in, NT, 3072, 1024, 1, e, lds); })
  PH(8, phase_conv(p);)
  PH(9, { EpiPartW e{mk_rsrc(p.part, 4u * (unsigned)NT * 1024u * 2u)}; phase_gemm(p.cat, p.wt1_out, NT, 1024, 1024, 2, e, lds);
          NormArgs a{p.xres, xs, pp, pp, m1 + 2048, p.xres, p.l1_norm2, m1 + 3072, m1 + 4096, p.hA, nullptr}; phase_norm_fused(a, pcnt + 3 * 384, p.bar);
          phase_prep2(p, lds, 2, 192); })
  PH(10, { NormArgs a{p.xres, xs, pp, pp, m1 + 5120, nullptr, p.final_norm, nullptr, nullptr, nullptr, p.out}; phase_ffn(p, p.wt1_f1, p.wt1_f2, a, pcnt + 4 * 384, pcnt + 5 * 384, lds); })
#undef PH
}

constexpr size_t LDS_BYTES = 131072 + 256;
constexpr bool ONE_LAUNCH = true;

extern "C" void kernel_launch(void* const* d_in, const int* in_sizes, int n_in, void* d_out, int out_size, void* d_ws, size_t ws_size, hipStream_t stream) {
  static int grid_blocks = 0;
  if (!grid_blocks) {
    hipFuncSetAttribute((const void*)mega, hipFuncAttributeMaxDynamicSharedMemorySize, (int)LDS_BYTES);
    int dev = 0, cus = 0, per_cu = 0;
    hipGetDevice(&dev);
    hipDeviceGetAttribute(&cus, hipDeviceAttributeMultiprocessorCount, dev);
    hipOccupancyMaxActiveBlocksPerMultiprocessor(&per_cu, mega, NTHR, LDS_BYTES);
    if (per_cu < 1) per_cu = 1;
    if (per_cu > 1) per_cu = 1;
    grid_blocks = 256;
  }
  P p{};
  const float* const* in = (const float* const*)d_in;
  p.x_prompt = in[0]; p.x_sample = in[1]; p.state = in[2]; p.c = in[3]; p.c_ctx = in[4];
  p.l0_norm1 = in[5]; p.l0_w_in = in[6]; p.l0_decay = in[7]; p.l0_gws = in[8]; p.l0_gb = in[9]; p.l0_w_out = in[10]; p.l0_norm2 = in[11];
  p.l0_w_mod = in[12]; p.l0_b_mod = in[13]; p.l0_f1 = in[14]; p.l0_f2 = in[15];
  p.l1_norm1 = in[16]; p.l1_w_in = in[17]; p.l1_conv = in[18]; p.l1_w_out = in[19]; p.l1_norm2 = in[20]; p.l1_w_mod = in[21]; p.l1_b_mod = in[22];
  p.l1_f1 = in[23]; p.l1_f2 = in[24]; p.final_norm = in[25];
  p.out = (float*)d_out;
  unsigned char* w = (unsigned char*)d_ws; size_t off = 0;
  auto take = [&](size_t bytes) { void* r = w + off; off += (bytes + 255) & ~(size_t)255; return r; };
  p.wt0_in = (u16*)take((size_t)4096 * 1024 * 2); p.wt0_out = (u16*)take((size_t)1024 * 1536 * 2);
  p.wt0_f1 = (u16*)take((size_t)4096 * 1024 * 2); p.wt0_f2 = (u16*)take((size_t)4096 * 1024 * 2);
  p.wt1_in = (u16*)take((size_t)3072 * 1024 * 2); p.wt1_out = (u16*)take((size_t)1024 * 1024 * 2);
  p.wt1_f1 = (u16*)take((size_t)4096 * 1024 * 2); p.wt1_f2 = (u16*)take((size_t)4096 * 1024 * 2);
  p.mod = (float*)take((size_t)2 * 3 * 6144 * 4);
  p.hA = (u16*)take((size_t)NT * 1024 * 2);
  p.proj = (u16*)take((size_t)NT * 4096 * 2);
  p.cat = (u16*)take((size_t)NT * 1536 * 2);
  p.part = (float*)take((size_t)2 * NT * 1024 * 4);
  p.xres = (float*)take((size_t)NT * 1024 * 4);
  p.stimg = (u16*)take((size_t)2 * 4 * 2 * 8 * 128 * 256 * 2);
  p.bar = (unsigned*)take((size_t)(XCD_BAR_WORDS + 7 * 384) * 4);
  hipMemsetAsync(p.bar, 0, (size_t)(XCD_BAR_WORDS + 7 * 384) * 4, stream);
  if (ONE_LAUNCH) {
    int lo = 0, hi = NPHASE; void* args[] = {&p, &lo, &hi};
    hipError_t e = hipLaunchCooperativeKernel((void*)mega, dim3(grid_blocks), dim3(NTHR), args, LDS_BYTES, stream);
    if (e != hipSuccess) fprintf(stderr, "cooperative launch failed: %s (grid %d)\n", hipGetErrorString(e), grid_blocks);
  } else {
    for (int ph = 0; ph < NPHASE; ++ph) hipLaunchKernelGGL(mega, dim3(grid_blocks), dim3(NTHR), LDS_BYTES, stream, p, ph, ph + 1);
  }
}
```

```cpp
#include <hip/hip_runtime.h>
#include <hip/hip_cooperative_groups.h>
#include <cstdio>
namespace cg = cooperative_groups;

typedef unsigned short u16;
typedef float f32x4 __attribute__((ext_vector_type(4)));
typedef unsigned u32x4 __attribute__((ext_vector_type(4)));
typedef unsigned u32x2 __attribute__((ext_vector_type(2)));

constexpr int NT = 6144, DM = 1024, NPROMPT_T = 4096;
constexpr float EPS = 1e-6f;
constexpr int NTHR = 512;

__device__ __forceinline__ float bf2f(u16 b) { return __uint_as_float(((unsigned)b) << 16); }
typedef float f32x2 __attribute__((ext_vector_type(2)));
typedef __bf16 hbf16x2 __attribute__((ext_vector_type(2)));
__device__ __forceinline__ unsigned pk2(float a, float b) { const f32x2 v = {a, b}; const hbf16x2 r = __builtin_convertvector(v, hbf16x2); return __builtin_bit_cast(unsigned, r); }
__device__ __forceinline__ u16 f2bf(float f) { return (u16)(pk2(f, 0.f) & 0xffffu); }
__device__ __forceinline__ float silu_f(float x) { return x * __builtin_amdgcn_rcpf(1.f + __expf(-x)); }
__device__ __forceinline__ float gelu_f(float x) { const float u = -1.5957691216057308f * (x + 0.044715f * x * x * x); return x * __builtin_amdgcn_rcpf(1.f + __expf(u)); }
__device__ __forceinline__ int cond_of(int t) { return t < NPROMPT_T ? 0 : 1 + ((t - NPROMPT_T) >> 10); }
__device__ __forceinline__ float wave_sum(float v) {
#pragma unroll
  for (int o = 32; o > 0; o >>= 1) v += __shfl_xor(v, o);
  return v;
}

struct P {
  const float *x_prompt, *x_sample, *state, *c, *c_ctx;
  const float *l0_norm1, *l0_w_in, *l0_decay, *l0_gws, *l0_gb, *l0_w_out, *l0_norm2, *l0_w_mod, *l0_b_mod, *l0_f1, *l0_f2;
  const float *l1_norm1, *l1_w_in, *l1_conv, *l1_w_out, *l1_norm2, *l1_w_mod, *l1_b_mod, *l1_f1, *l1_f2, *final_norm;
  float* out;
  u16 *wt0_in, *wt0_out, *wt0_f1, *wt0_f2, *wt1_in, *wt1_out, *wt1_f1, *wt1_f2;
  float* mod;
  u16* hA;
  u16* proj;
  u16* cat;
  float* part;
  float* xres;
  u16* stimg;
  unsigned* bar;
};

__device__ __forceinline__ unsigned xb_ld(unsigned* p)              { return __hip_atomic_load(p, __ATOMIC_RELAXED, __HIP_MEMORY_SCOPE_AGENT); }
__device__ __forceinline__ unsigned xb_add(unsigned* p, unsigned v) { return __hip_atomic_fetch_add(p, v, __ATOMIC_RELAXED, __HIP_MEMORY_SCOPE_AGENT); }
#define XB_TMO      128
#define XB_SPIN_CAP (1u << 18)
#define XB_SPIN(cond, bar) do { unsigned _sp = 0; while (cond) { __builtin_amdgcn_s_sleep(1); \
    if ((++_sp & 255u) == 0u) { if (xb_ld(&(bar)[XB_TMO])) break; if (_sp > XB_SPIN_CAP) { atomicAdd(&(bar)[XB_TMO], 1u); break; } } } } while (0)

__device__ __forceinline__ __amdgpu_buffer_rsrc_t mk_rsrc(void* p, unsigned bytes) { return __builtin_amdgcn_make_buffer_rsrc(p, 0, (int)bytes, 0x00020000); }

__device__ __forceinline__ void transpose_tile(const float* __restrict__ W, int K, int N, u16* __restrict__ Wt, int tile, float* lds) {
  const int tn = N / 256; const int k0 = (tile / tn) * 64, n0 = (tile % tn) * 256;
  const int tid = threadIdx.x;
  float (*T)[257] = (float (*)[257])lds;
  __syncthreads();
  {
    const int r = tid >> 6, c4 = (tid & 63) * 4;
    f32x4 v[8];
#pragma unroll
    for (int i = 0; i < 8; ++i) v[i] = *(const f32x4*)(W + (size_t)(k0 + r + 8 * i) * N + n0 + c4);
#pragma unroll
    for (int i = 0; i < 8; ++i) { T[r + 8 * i][c4 + 0] = v[i][0]; T[r + 8 * i][c4 + 1] = v[i][1]; T[r + 8 * i][c4 + 2] = v[i][2]; T[r + 8 * i][c4 + 3] = v[i][3]; }
  }
  __syncthreads();
  {
    const int kk = (tid & 7) * 8;
#pragma unroll
    for (int ps = 0; ps < 4; ++ps) {
      const int nn = (tid >> 3) + 64 * ps;
      u32x4 o;
      o[0] = pk2(T[kk + 0][nn], T[kk + 1][nn]); o[1] = pk2(T[kk + 2][nn], T[kk + 3][nn]);
      o[2] = pk2(T[kk + 4][nn], T[kk + 5][nn]); o[3] = pk2(T[kk + 6][nn], T[kk + 7][nn]);
      *(u32x4*)(Wt + (size_t)(n0 + nn) * K + k0 + kk) = o;
    }
  }
}

__device__ __forceinline__ void adaln_item(const P& p, int item, float* lds) {
  const int l = item / 96, n0 = (item % 96) * 64;
  const float* W = l ? p.l1_w_mod : p.l0_w_mod; const float* B = l ? p.l1_b_mod : p.l0_b_mod;
  const int tid = threadIdx.x;
  float* sc = lds;
  float* red = lds + 3072;
  __syncthreads();
  for (int i = tid; i < 3072; i += NTHR) {
    const int c = i >> 10, k = i & 1023;
    const float v = c == 0 ? p.c_ctx[k] : p.c[(c - 1) * 1024 + k];
    sc[i] = silu_f(v);
  }
  __syncthreads();
  const int cg4 = tid & 15, rg = tid >> 4;
  float acc[3][4] = {};
#pragma unroll 8
  for (int it = 0; it < 32; ++it) {
    const int k = it * 32 + rg;
    const f32x4 w = *(const f32x4*)(W + (size_t)k * 6144 + n0 + cg4 * 4);
#pragma unroll
    for (int c = 0; c < 3; ++c) { const float s = sc[c * 1024 + k];
#pragma unroll
      for (int e = 0; e < 4; ++e) acc[c][e] += s * w[e]; }
  }
#pragma unroll
  for (int c = 0; c < 3; ++c)
#pragma unroll
    for (int e = 0; e < 4; ++e) red[(rg * 3 + c) * 64 + cg4 * 4 + e] = acc[c][e];
  __syncthreads();
  if (tid < 192) {
    const int c = tid >> 6, n = tid & 63; float s = B[n0 + n];
    for (int r = 0; r < 32; ++r) s += red[(r * 3 + c) * 64 + n];
    p.mod[(size_t)(l * 3 + c) * 6144 + n0 + n] = s;
  }
}

__device__ __forceinline__ void phase_prep(const P& p, float* lds) {
  for (int it = blockIdx.x; it < 96 + 256; it += gridDim.x) {
    if (it < 96) adaln_item(p, it, lds); else transpose_tile(p.l0_w_in, 1024, 4096, p.wt0_in, it - 96, lds);
  }
}
__device__ __forceinline__ void phase_prep2(const P& p, float* lds, int group, int first_want) {
  const int first = (int)gridDim.x >= 256 ? first_want : 0, nblk = (int)gridDim.x - first;
  if ((int)blockIdx.x < first) return;
  const int total = group == 0 ? 96 + 96 + 256 + 256 : (group == 1 ? 192 + 64 : 256 + 256);
  for (int it = (int)blockIdx.x - first; it < total; it += nblk) {
    int i = it;
    if (group == 0) {
      if (i < 96) { adaln_item(p, 96 + i, lds); continue; } i -= 96;
      if (i < 96) { transpose_tile(p.l0_w_out, 1536, 1024, p.wt0_out, i, lds); continue; } i -= 96;
      if (i < 256) { transpose_tile(p.l0_f1, 1024, 4096, p.wt0_f1, i, lds); continue; } i -= 256;
      transpose_tile(p.l0_f2, 4096, 1024, p.wt0_f2, i, lds);
    } else if (group == 1) {
      if (i < 192) { transpose_tile(p.l1_w_in, 1024, 3072, p.wt1_in, i, lds); continue; } i -= 192;
      transpose_tile(p.l1_w_out, 1024, 1024, p.wt1_out, i, lds);
    } else {
      if (i < 256) { transpose_tile(p.l1_f1, 1024, 4096, p.wt1_f1, i, lds); continue; } i -= 256;
      transpose_tile(p.l1_f2, 4096, 1024, p.wt1_f2, i, lds);
    }
  }
}

struct NormArgs {
  const float* xin0; const float* xin1;
  const float* p0; const float* p1; const float* gate;
  float* xout; const float* nw; const float* sh; const float* sc;
  u16* hout; float* fout;
};
__device__ __forceinline__ void norm_row(const NormArgs& a, int t, int lane) {
  {
    const int c = cond_of(t);
    const float* xr = t < NPROMPT_T ? a.xin0 + (size_t)t * DM : a.xin1 + (size_t)(t - NPROMPT_T) * DM;
    f32x4 x[4]; float ss = 0.f;
#pragma unroll
    for (int i = 0; i < 4; ++i) {
      const int col = lane * 4 + 256 * i;
      x[i] = *(const f32x4*)(xr + col);
      if (a.p0) {
        const u32x2 q0 = *(const u32x2*)((const u16*)a.p0 + (size_t)t * DM + col), q1 = *(const u32x2*)((const u16*)a.p0 + (size_t)(NT + t) * DM + col);
        const f32x4 g = *(const f32x4*)(a.gate + (size_t)c * 6144 + col);
        f32x4 ps;
        ps[0] = __uint_as_float(q0[0] << 16) + __uint_as_float(q1[0] << 16); ps[1] = __uint_as_float(q0[0] & 0xffff0000u) + __uint_as_float(q1[0] & 0xffff0000u);
        ps[2] = __uint_as_float(q0[1] << 16) + __uint_as_float(q1[1] << 16); ps[3] = __uint_as_float(q0[1] & 0xffff0000u) + __uint_as_float(q1[1] & 0xffff0000u);
        x[i] = x[i] + g * ps;
      }
      if (a.xout) *(f32x4*)(a.xout + (size_t)t * DM + col) = x[i];
      ss += x[i][0] * x[i][0] + x[i][1] * x[i][1] + x[i][2] * x[i][2] + x[i][3] * x[i][3];
    }
    ss = wave_sum(ss);
    const float r = rsqrtf(ss * (1.f / 1024.f) + EPS);
#pragma unroll
    for (int i = 0; i < 4; ++i) {
      const int col = lane * 4 + 256 * i;
      const f32x4 w = *(const f32x4*)(a.nw + col);
      f32x4 y = x[i] * r * w;
      if (a.fout) *(f32x4*)(a.fout + (size_t)t * DM + col) = y;
      if (a.hout) {
        const f32x4 sh = *(const f32x4*)(a.sh + (size_t)c * 6144 + col), sc = *(const f32x4*)(a.sc + (size_t)c * 6144 + col);
        y = y * (1.f + sc) + sh;
        u32x2 o; o[0] = pk2(y[0], y[1]); o[1] = pk2(y[2], y[3]);
        *(u32x2*)(a.hout + (size_t)t * DM + col) = o;
      }
    }
  }
}
template <int R, int NP>
__device__ __forceinline__ void norm_rows(const NormArgs& a, int t0, int lane) {
  const int c = cond_of(t0);
  f32x4 x[R][4];
#pragma unroll
  for (int r = 0; r < R; ++r) {
    const int t = t0 + r;
    const float* xr = t < NPROMPT_T ? a.xin0 + (size_t)t * DM : a.xin1 + (size_t)(t - NPROMPT_T) * DM;
#pragma unroll
    for (int i = 0; i < 4; ++i) x[r][i] = *(const f32x4*)(xr + lane * 4 + 256 * i);
  }
  if (a.p0) {
    u32x2 q[R][NP][4];
#pragma unroll
    for (int r = 0; r < R; ++r)
#pragma unroll
      for (int k = 0; k < NP; ++k)
#pragma unroll
        for (int i = 0; i < 4; ++i) q[r][k][i] = *(const u32x2*)((const u16*)a.p0 + ((size_t)k * NT + t0 + r) * DM + lane * 4 + 256 * i);
#pragma unroll
    for (int i = 0; i < 4; ++i) {
      const f32x4 g = *(const f32x4*)(a.gate + (size_t)c * 6144 + lane * 4 + 256 * i);
#pragma unroll
      for (int r = 0; r < R; ++r) {
        f32x4 ps = {0.f, 0.f, 0.f, 0.f};
#pragma unroll
        for (int k = 0; k < NP; ++k) {
          ps[0] += __uint_as_float(q[r][k][i][0] << 16); ps[1] += __uint_as_float(q[r][k][i][0] & 0xffff0000u);
          ps[2] += __uint_as_float(q[r][k][i][1] << 16); ps[3] += __uint_as_float(q[r][k][i][1] & 0xffff0000u);
        }
        x[r][i] = x[r][i] + g * ps;
      }
    }
  }
  float rs[R];
#pragma unroll
  for (int r = 0; r < R; ++r) {
    float ss = 0.f;
#pragma unroll
    for (int i = 0; i < 4; ++i) {
      if (a.xout) *(f32x4*)(a.xout + (size_t)(t0 + r) * DM + lane * 4 + 256 * i) = x[r][i];
      ss += x[r][i][0] * x[r][i][0] + x[r][i][1] * x[r][i][1] + x[r][i][2] * x[r][i][2] + x[r][i][3] * x[r][i][3];
    }
    ss = wave_sum(ss);
    rs[r] = rsqrtf(ss * (1.f / 1024.f) + EPS);
  }
#pragma unroll
  for (int i = 0; i < 4; ++i) {
    const int col = lane * 4 + 256 * i;
    const f32x4 w = *(const f32x4*)(a.nw + col);
    f32x4 sh = {0.f, 0.f, 0.f, 0.f}, sc = {0.f, 0.f, 0.f, 0.f};
    if (a.hout) { sh = *(const f32x4*)(a.sh + (size_t)c * 6144 + col); sc = *(const f32x4*)(a.sc + (size_t)c * 6144 + col); }
#pragma unroll
    for (int r = 0; r < R; ++r) {
      f32x4 y = x[r][i] * rs[r] * w;
      if (a.fout) *(f32x4*)(a.fout + (size_t)(t0 + r) * DM + col) = y;
      if (a.hout) {
        y = y * (1.f + sc) + sh;
        u32x2 o; o[0] = pk2(y[0], y[1]); o[1] = pk2(y[2], y[3]);
        *(u32x2*)(a.hout + (size_t)(t0 + r) * DM + col) = o;
      }
    }
  }
}
__device__ __forceinline__ void phase_norm(const NormArgs& a) {
  const int wid = threadIdx.x >> 6, lane = threadIdx.x & 63;
  for (int g = blockIdx.x * 8 + wid; g < NT / 4; g += gridDim.x * 8) norm_rows<4, 2>(a, g * 4, lane);
}
struct EpiProj0 {
  u16* O;
  __device__ __forceinline__ void store8(int row, int col, f32x4 v0, f32x4 v1, int) const {
    if (col >= 3072) {
#pragma unroll
      for (int e = 0; e < 4; ++e) { v0[e] = gelu_f(v0[e]); v1[e] = gelu_f(v1[e]); }
    } else if (col >= 2048) {
#pragma unroll
      for (int e = 0; e < 4; ++e) { v0[e] = silu_f(v0[e]); v1[e] = silu_f(v1[e]); }
    } else if (col >= 512 && col < 1024) { v0 = v0 * 0.08838834764831845f; v1 = v1 * 0.08838834764831845f; }
    u32x4 o; o[0] = pk2(v0[0], v0[1]); o[1] = pk2(v0[2], v0[3]); o[2] = pk2(v1[0], v1[1]); o[3] = pk2(v1[2], v1[3]);
    __builtin_amdgcn_raw_buffer_store_b128(o, mk_rsrc(O, (unsigned)NT * 4096u * 2u), (unsigned)(((size_t)row * 4096 + col) * 2), 0, 16);
  }
  __device__ __forceinline__ void store4(int row, int col, f32x4 v, int) const {
    if (col >= 3072) { v[0] = gelu_f(v[0]); v[1] = gelu_f(v[1]); v[2] = gelu_f(v[2]); v[3] = gelu_f(v[3]); }
    else if (col >= 2048) { v[0] = silu_f(v[0]); v[1] = silu_f(v[1]); v[2] = silu_f(v[2]); v[3] = silu_f(v[3]); }
    else if (col >= 512 && col < 1024) v = v * 0.08838834764831845f;
    u32x2 o; o[0] = pk2(v[0], v[1]); o[1] = pk2(v[2], v[3]);
    *(u32x2*)(O + (size_t)row * 4096 + col) = o;
  }
};
struct EpiPart {
  float* Pp;
  __device__ __forceinline__ void store8(int row, int col, f32x4 v0, f32x4 v1, int ks) const {
    u32x4 o; o[0] = pk2(v0[0], v0[1]); o[1] = pk2(v0[2], v0[3]); o[2] = pk2(v1[0], v1[1]); o[3] = pk2(v1[2], v1[3]);
    *(u32x4*)((u16*)Pp + ((size_t)ks * NT + row) * DM + col) = o;
  }
};
struct EpiRelu2 {
  u16* O;
  __device__ __forceinline__ void store8(int row, int col, f32x4 v0, f32x4 v1, int) const {
#pragma unroll
    for (int e = 0; e < 4; ++e) { const float r0 = fmaxf(v0[e], 0.f), r1 = fmaxf(v1[e], 0.f); v0[e] = r0 * r0; v1[e] = r1 * r1; }
    u32x4 o; o[0] = pk2(v0[0], v0[1]); o[1] = pk2(v0[2], v0[3]); o[2] = pk2(v1[0], v1[1]); o[3] = pk2(v1[2], v1[3]);
    *(u32x4*)(O + (size_t)row * 4096 + col) = o;
  }
  __device__ __forceinline__ void store4(int row, int col, f32x4 v, int) const {
#pragma unroll
    for (int e = 0; e < 4; ++e) { const float r = fmaxf(v[e], 0.f); v[e] = r * r; }
    u32x2 o; o[0] = pk2(v[0], v[1]); o[1] = pk2(v[2], v[3]);
    *(u32x2*)(O + (size_t)row * 4096 + col) = o;
  }
};
struct EpiPartW {
  __amdgpu_buffer_rsrc_t rs;
  __device__ __forceinline__ void store8(int row, int col, f32x4 v0, f32x4 v1, int ks) const {
    u32x4 o; o[0] = pk2(v0[0], v0[1]); o[1] = pk2(v0[2], v0[3]); o[2] = pk2(v1[0], v1[1]); o[3] = pk2(v1[2], v1[3]);
    __builtin_amdgcn_raw_buffer_store_b128(o, rs, (unsigned)((((size_t)ks * NT + row) * DM + col) * 2), 0, 16);
  }
};
struct EpiRelu2W {
  __amdgpu_buffer_rsrc_t rs;
  __device__ __forceinline__ void store8(int row, int col, f32x4 v0, f32x4 v1, int) const {
#pragma unroll
    for (int e = 0; e < 4; ++e) { const float r0 = fmaxf(v0[e], 0.f), r1 = fmaxf(v1[e], 0.f); v0[e] = r0 * r0; v1[e] = r1 * r1; }
    u32x4 o; o[0] = pk2(v0[0], v0[1]); o[1] = pk2(v0[2], v0[3]); o[2] = pk2(v1[0], v1[1]); o[3] = pk2(v1[2], v1[3]);
    __builtin_amdgcn_raw_buffer_store_b128(o, rs, (unsigned)(((size_t)row * 4096 + col) * 2), 0, 16);
  }
};
struct EpiPlain {
  u16* O; int ld;
  __device__ __forceinline__ void store8(int row, int col, f32x4 v0, f32x4 v1, int) const {
    u32x4 o; o[0] = pk2(v0[0], v0[1]); o[1] = pk2(v0[2], v0[3]); o[2] = pk2(v1[0], v1[1]); o[3] = pk2(v1[2], v1[3]);
    __builtin_amdgcn_raw_buffer_store_b128(o, mk_rsrc(O, (unsigned)NT * 4096u * 2u), (unsigned)(((size_t)row * ld + col) * 2), 0, 16);
  }
  __device__ __forceinline__ void store4(int row, int col, f32x4 v, int) const {
    u32x2 o; o[0] = pk2(v[0], v[1]); o[1] = pk2(v[2], v[3]);
    *(u32x2*)(O + (size_t)row * ld + col) = o;
  }
};

template <class Epi>
__device__ __forceinline__ void phase_gemm_naive(const u16* __restrict__ A, const u16* __restrict__ Bt, int M, int N, int K, int ksplit, const Epi& E, float* lds) {
  float (*As)[33] = (float (*)[33])lds;
  float (*Bs)[33] = (float (*)[33])(lds + 128 * 33);
  const int tm = M / 128, tn = N / 64, total = tm * tn * ksplit, kper = K / ksplit;
  const int tid = threadIdx.x, r = tid >> 2, cq = tid & 3;
  for (int it = blockIdx.x; it < total; it += gridDim.x) {
    const int ks = it / (tm * tn), rem = it % (tm * tn), m0 = (rem / tn) * 128, n0 = (rem % tn) * 64;
    float acc[4][4] = {};
    for (int k0 = ks * kper; k0 < (ks + 1) * kper; k0 += 32) {
      __syncthreads();
      {
        const int kc = (tid & 3) * 8;
        const u32x4 va = *(const u32x4*)(A + (size_t)(m0 + r) * K + k0 + kc);
#pragma unroll
        for (int e = 0; e < 4; ++e) { As[r][kc + 2 * e] = __uint_as_float(va[e] << 16); As[r][kc + 2 * e + 1] = __uint_as_float(va[e] & 0xffff0000u); }
        if (tid < 256) {
          const u32x4 vb = *(const u32x4*)(Bt + (size_t)(n0 + r) * K + k0 + kc);
#pragma unroll
          for (int e = 0; e < 4; ++e) { Bs[r][kc + 2 * e] = __uint_as_float(vb[e] << 16); Bs[r][kc + 2 * e + 1] = __uint_as_float(vb[e] & 0xffff0000u); }
        }
      }
      __syncthreads();
#pragma unroll 4
      for (int k = 0; k < 32; ++k) {
        const float a = As[r][k];
#pragma unroll
        for (int jj = 0; jj < 4; ++jj)
#pragma unroll
          for (int e = 0; e < 4; ++e) acc[jj][e] += a * Bs[cq * 4 + 16 * jj + e][k];
      }
    }
#pragma unroll
    for (int jj = 0; jj < 4; ++jj) { f32x4 v = {acc[jj][0], acc[jj][1], acc[jj][2], acc[jj][3]}; E.store4(m0 + r, n0 + cq * 4 + 16 * jj, v, ks); }
  }
}


namespace pg8 {
#define PG8_LAS __attribute__((address_space(3)))
typedef short bf16x8 __attribute__((ext_vector_type(8)));
constexpr int BM = 256, BK = 64, HALF = 128, HTB = HALF * BK * 2, STAGE_BYTES = 8 * HTB, NXCD = 8, WGM = 8;
__device__ __forceinline__ int lds_byte(int r, int c) { const int st = (r >> 4) * 2 + (c >> 5), rr = r & 15, cc = c & 31, ob = rr * 64 + cc * 2; return st * 1024 + (ob ^ (((ob >> 9) & 1) << 5)); }
__device__ __forceinline__ int perm32(int rho) { const int n = rho >> 4, i = rho & 15; return 8 * (i >> 2) + 4 * n + (i & 3); }
__device__ __forceinline__ void stage_rc(int b, int& R, int& C) { const int st = b / 1024, sb = b % 1024, swz = sb ^ (((sb >> 9) & 1) << 5); R = (st >> 1) * 16 + swz / 64; C = (st & 1) * 32 + (swz % 64) / 2; }
struct Unit { int pm, pn, ks; };
struct Gemm { const u16* A; const u16* Bt; int M, N, K, ksplit; };
struct Order {
  int nM, nN, ntile, nwg, G, c;
  __device__ void init(int M, int N, int ksplit, int G_, int c_) { nM = M / BM; nN = N / BM; ntile = nM * nN; nwg = ntile * ksplit; G = G_; c = c_; }
  __device__ bool next(int i, Unit& u) const {
    const int L = i * G + c; if (L >= nwg) return false;
    u.ks = L / ntile; int wgid = L % ntile;
    { const int q = ntile / NXCD, r = ntile % NXCD, xcd = wgid % NXCD, off = wgid / NXCD; wgid = (xcd < r ? xcd * (q + 1) : r * (q + 1) + (xcd - r) * q) + off; }
    const int nig = WGM * nN, gid = wgid / nig, fm = gid * WGM, gsz = (nM - fm) < WGM ? (nM - fm) : WGM;
    u.pm = fm + ((wgid % nig) % gsz); u.pn = (wgid % nig) / gsz; return true;
  }
};
template <class Epi>
__device__ __forceinline__ void run_epi(const Epi& E, const f32x4 (&acc)[2][2][4][2], const Unit& u, int wr, int wc, int fr, int fq) {
  const int row0 = u.pm * BM + wr * 64 + fr, col0 = u.pn * BM + wc * 32 + 8 * fq;
#pragma unroll
  for (int ai = 0; ai < 2; ++ai)
#pragma unroll
    for (int m = 0; m < 4; ++m)
#pragma unroll
      for (int bj = 0; bj < 2; ++bj) E.store8(row0 + ai * HALF + m * 16, col0 + bj * HALF, acc[ai][bj][m][0], acc[ai][bj][m][1], u.ks);
}
struct OneUnit { Unit u; __device__ __forceinline__ bool next(int i, Unit& o) const { if (i) return false; o = u; return true; } };
struct FfnOrder1 {
  int c;
  __device__ __forceinline__ bool next(int i, Unit& u) const {
    const int x = c & 7; u.ks = 0;
    if (c >= 128) { if (i) return false; const int oj = (c - 128) >> 3; u.pm = 2 * (x >> 1) + (oj >> 3); u.pn = (x & 1) * 8 + (oj & 7); return true; }
    if (i > 1) return false;
    const int t = i * 16 + (c >> 3); u.pm = 8 + 4 * (x >> 1) + (t >> 3); u.pn = (x & 1) * 8 + (t & 7); return true;
  }
};
template <class Epi, class Sched>
__device__ __forceinline__ void gemm_phase(PG8_LAS unsigned char* lds, const Gemm g, const Sched& S, const Epi& E) {
  const int tid = threadIdx.x, wid = __builtin_amdgcn_readfirstlane(tid >> 6), lane = tid & 63, wr = wid >> 2, wc = wid & 3, fr = lane & 15, fq = lane >> 4;
  const int K = g.K, kper = g.K / g.ksplit, nt = kper / BK;
  unsigned voffA[2], voffB[2];
#pragma unroll
  for (int i = 0; i < 2; ++i) { int R, C; stage_rc(tid * 16 + i * 8192, R, C); const int Rb = (R & ~31) + perm32(R & 31);
    voffA[i] = (unsigned)(R * K + C) * 2u; voffB[i] = (unsigned)(Rb * K + C) * 2u; }
  const size_t kstep = (size_t)(BK * 2);
  const size_t hstep = (size_t)HALF * K * 2;
  const size_t tstep = 2 * hstep;
  const size_t ksbytes = (size_t)kper * 2;
  const unsigned ldsw = (unsigned)wid * 1024u;
  const int aoff = lds_byte(wr * 64 + fr, fq * 8), boff = lds_byte(wc * 32 + fr, fq * 8);
#define PG8_SA(b, h) (((b) * 2 + (h)) * HTB)
#define PG8_SB(b, h) ((4 + (b) * 2 + (h)) * HTB)
#define PG8_STAGE(bufoff, gbase, voff) do { _Pragma("unroll") for (int _i = 0; _i < 2; ++_i) \
    __builtin_amdgcn_global_load_lds((const unsigned*)((const char*)(gbase) + (voff)[_i]), (PG8_LAS unsigned*)(lds + (bufoff) + ldsw + _i * 8192), 16, 0, 0); } while (0)
#define PG8_LDA(dst, b, h) do { _Pragma("unroll") for (int m = 0; m < 4; ++m) _Pragma("unroll") for (int k = 0; k < 2; ++k) dst[m][k] = *(const PG8_LAS bf16x8*)(lds + PG8_SA(b, h) + aoff + m * 2048 + k * 1024); } while (0)
#define PG8_LDB(dst, b, h) do { _Pragma("unroll") for (int n = 0; n < 2; ++n) _Pragma("unroll") for (int k = 0; k < 2; ++k) dst[n][k] = *(const PG8_LAS bf16x8*)(lds + PG8_SB(b, h) + boff + n * 2048 + k * 1024); } while (0)
#define PG8_MMA(ai, bj, At, Bt) do { __builtin_amdgcn_s_setprio(1); _Pragma("unroll") for (int m = 0; m < 4; ++m) _Pragma("unroll") for (int n = 0; n < 2; ++n) _Pragma("unroll") for (int k = 0; k < 2; ++k) \
    acc[ai][bj][m][n] = __builtin_amdgcn_mfma_f32_16x16x32_bf16(Bt[n][k], At[m][k], acc[ai][bj][m][n], 0, 0, 0); __builtin_amdgcn_s_setprio(0); } while (0)
#define PG8_WAIT_V(n) asm volatile("s_waitcnt vmcnt(" #n ")" ::: "memory")
#define PG8_WAIT_L(n) asm volatile("s_waitcnt lgkmcnt(" #n ")" ::: "memory")
#define PG8_BAR __builtin_amdgcn_s_barrier()
#define PG8_SCHED __builtin_amdgcn_sched_barrier(0)
  Unit cur, nxt; int ui = 0;
  if (!S.next(0, cur)) return;
  f32x4 acc[2][2][4][2];
#pragma unroll
  for (int a = 0; a < 2; ++a)
#pragma unroll
    for (int b = 0; b < 2; ++b)
#pragma unroll
      for (int m = 0; m < 4; ++m)
#pragma unroll
        for (int n = 0; n < 2; ++n) acc[a][b][m][n] = (f32x4){0.f, 0.f, 0.f, 0.f};
  bf16x8 At[4][2], B0[2][2], B1[2][2];
  const char* cA = (const char*)g.A + (size_t)cur.pm * tstep + (size_t)cur.ks * ksbytes; const char* cB = (const char*)g.Bt + (size_t)cur.pn * tstep + (size_t)cur.ks * ksbytes;
  PG8_STAGE(PG8_SB(0, 0), cB, voffB); PG8_STAGE(PG8_SA(0, 0), cA, voffA); PG8_STAGE(PG8_SB(0, 1), cB + hstep, voffB); PG8_STAGE(PG8_SA(0, 1), cA + hstep, voffA);
  if (wr == 1) PG8_BAR;
  PG8_WAIT_V(4); PG8_BAR;
  PG8_STAGE(PG8_SB(1, 0), cB + kstep, voffB); PG8_STAGE(PG8_SA(1, 0), cA + kstep, voffA); PG8_STAGE(PG8_SB(1, 1), cB + hstep + kstep, voffB);
  PG8_WAIT_V(6); PG8_BAR;
  for (;;) {
    const bool has_next = S.next(ui + 1, nxt);
    const char* nA = has_next ? (const char*)g.A + (size_t)nxt.pm * tstep + (size_t)nxt.ks * ksbytes : cA; const char* nB = has_next ? (const char*)g.Bt + (size_t)nxt.pn * tstep + (size_t)nxt.ks * ksbytes : cB;
    for (int t = 0; t < nt; t += 2) {
      const bool last = (t == nt - 2);
      const char* a1 = cA + (size_t)(t + 1) * kstep;
      const char* a2 = last ? nA : cA + (size_t)(t + 2) * kstep; const char* b2 = last ? nB : cB + (size_t)(t + 2) * kstep;
      const char* a3 = a2 + kstep; const char* b3 = b2 + kstep;
      PG8_LDB(B0, 0, 0); PG8_SCHED; PG8_LDA(At, 0, 0); PG8_STAGE(PG8_SA(1, 1), a1 + hstep, voffA);
      PG8_WAIT_L(8); PG8_BAR; PG8_WAIT_L(0); PG8_MMA(0, 0, At, B0); PG8_BAR; PG8_SCHED;
      PG8_LDB(B1, 0, 1); PG8_STAGE(PG8_SB(0, 0), b2, voffB);
      PG8_BAR; PG8_WAIT_L(0); PG8_MMA(0, 1, At, B1); PG8_BAR;
      PG8_LDA(At, 0, 1); PG8_STAGE(PG8_SA(0, 0), a2, voffA);
      PG8_BAR; PG8_WAIT_L(0); PG8_MMA(1, 0, At, B0); PG8_BAR; PG8_SCHED;
      PG8_STAGE(PG8_SB(0, 1), b2 + hstep, voffB);
      PG8_WAIT_V(6); PG8_BAR; PG8_MMA(1, 1, At, B1); PG8_BAR;
      PG8_LDB(B0, 1, 0); PG8_SCHED; PG8_LDA(At, 1, 0); PG8_STAGE(PG8_SA(0, 1), a2 + hstep, voffA);
      PG8_WAIT_L(8); PG8_BAR; PG8_WAIT_L(0); PG8_MMA(0, 0, At, B0); PG8_BAR; PG8_SCHED;
      PG8_LDB(B1, 1, 1); PG8_STAGE(PG8_SB(1, 0), b3, voffB);
      PG8_BAR; PG8_WAIT_L(0); PG8_MMA(0, 1, At, B1); PG8_BAR;
      PG8_LDA(At, 1, 1); PG8_STAGE(PG8_SA(1, 0), a3, voffA);
      PG8_BAR; PG8_WAIT_L(0); PG8_MMA(1, 0, At, B0); PG8_BAR; PG8_SCHED;
      PG8_STAGE(PG8_SB(1, 1), b3 + hstep, voffB);
      PG8_WAIT_V(6); PG8_BAR; PG8_MMA(1, 1, At, B1); PG8_BAR;
    }
    run_epi(E, acc, cur, wr, wc, fr, fq);
    if (!has_next) break;
#pragma unroll
    for (int a = 0; a < 2; ++a)
#pragma unroll
      for (int b = 0; b < 2; ++b)
#pragma unroll
        for (int m = 0; m < 4; ++m)
#pragma unroll
          for (int n = 0; n < 2; ++n) acc[a][b][m][n] = (f32x4){0.f, 0.f, 0.f, 0.f};
    cur = nxt; cA = nA; cB = nB; ++ui;
  }
  PG8_WAIT_V(0);
  if (wr == 0) PG8_BAR;
  PG8_BAR;
#undef PG8_SA
#undef PG8_SB
#undef PG8_STAGE
#undef PG8_LDA
#undef PG8_LDB
#undef PG8_MMA
#undef PG8_WAIT_V
#undef PG8_WAIT_L
#undef PG8_BAR
#undef PG8_SCHED
}
}
template <class Epi>
__device__ __forceinline__ void phase_gemm(const u16* A, const u16* Bt, int M, int N, int K, int ksplit, const Epi& E, float* lds) {
  __syncthreads();
  pg8::Gemm g{A, Bt, M, N, K, ksplit};
  pg8::Order S; S.init(M, N, ksplit, (int)gridDim.x, (int)blockIdx.x);
  pg8::gemm_phase(( __attribute__((address_space(3))) unsigned char*)lds, g, S, E);
  __syncthreads();
}

__device__ __forceinline__ void seq_of_token(int t, int& s0, int& L, int& sb) {
  if (t < NPROMPT_T) { s0 = t & ~255; L = 256; sb = -1; } else { sb = (t - NPROMPT_T) >> 10; s0 = NPROMPT_T + (sb << 10); L = 1024; }
}
__device__ __forceinline__ void ret_item_naive(const P& p, int item, float* lds) {
  const int tg = item >> 2, h = item & 3, t0 = tg * 16, tid = threadIdx.x;
  int s0, L, sb; seq_of_token(t0, s0, L, sb);
  float* scr = lds;
  float* qs = lds + 16 * 1024;
  float* red = qs + 16 * 128;
  const float lgf = log1pf(-exp2f(-p.l0_decay[h])), lgb = log1pf(-exp2f(-p.l0_decay[4 + h]));
  __syncthreads();
  for (int i = tid; i < 16 * 128; i += NTHR) qs[i] = bf2f(p.proj[(size_t)(t0 + (i >> 7)) * 4096 + h * 128 + (i & 127)]);
  __syncthreads();
  for (int j = tid; j < L; j += NTHR) {
    float acc[16] = {};
    const u16* kr = p.proj + (size_t)(s0 + j) * 4096 + 512 + h * 128;
    for (int d0 = 0; d0 < 128; d0 += 8) {
      const u32x4 kv = *(const u32x4*)(kr + d0);
      float kf[8];
#pragma unroll
      for (int e = 0; e < 4; ++e) { kf[2 * e] = __uint_as_float(kv[e] << 16); kf[2 * e + 1] = __uint_as_float(kv[e] & 0xffff0000u); }
#pragma unroll
      for (int i = 0; i < 16; ++i)
#pragma unroll
        for (int e = 0; e < 8; ++e) acc[i] += qs[i * 128 + d0 + e] * kf[e];
    }
#pragma unroll
    for (int i = 0; i < 16; ++i) {
      const int d = (t0 + i - s0) - j;
      const float w = d > 0 ? __expf((float)d * lgf) : (d < 0 ? __expf((float)(-d) * lgb) : 2.f);
      scr[i * 1024 + j] = acc[i] * w;
    }
  }
  __syncthreads();
  const int dv = tid & 255, ig = tid >> 8;
  float o[8] = {};
  for (int j = 0; j < L; ++j) {
    const float v = bf2f(p.proj[(size_t)(s0 + j) * 4096 + 1024 + h * 256 + dv]);
#pragma unroll
    for (int e = 0; e < 8; ++e) o[e] += scr[(ig * 8 + e) * 1024 + j] * v;
  }
  if (sb >= 0) {
    const float* Sf = p.state + ((size_t)(sb * 2 + 0) * 4 + h) * 128 * 256;
    const float* Sb = p.state + ((size_t)(sb * 2 + 1) * 4 + h) * 128 * 256;
    float af[8] = {}, ab[8] = {};
    for (int dk = 0; dk < 128; ++dk) {
      const float sf = Sf[dk * 256 + dv], sbv = Sb[dk * 256 + dv];
#pragma unroll
      for (int e = 0; e < 8; ++e) { const float q = qs[(ig * 8 + e) * 128 + dk]; af[e] += q * sf; ab[e] += q * sbv; }
    }
#pragma unroll
    for (int e = 0; e < 8; ++e) {
      const int pos = t0 + ig * 8 + e - s0;
      o[e] += __expf((float)(pos + 1) * lgf) * af[e] + __expf((float)(L - pos) * lgb) * ab[e];
    }
  }
  const int wid = tid >> 6, lane = tid & 63;
#pragma unroll
  for (int e = 0; e < 8; ++e) { const float s = wave_sum(o[e] * o[e]); if (lane == 0) red[wid * 8 + e] = s; }
  __syncthreads();
#pragma unroll
  for (int e = 0; e < 8; ++e) {
    const float ss = red[(ig * 4 + 0) * 8 + e] + red[(ig * 4 + 1) * 8 + e] + red[(ig * 4 + 2) * 8 + e] + red[(ig * 4 + 3) * 8 + e];
    const float r = rsqrtf(ss * (1.f / 256.f) + EPS);
    const int t = t0 + ig * 8 + e;
    const float g = bf2f(p.proj[(size_t)t * 4096 + 2048 + h * 256 + dv]);
    p.cat[(size_t)t * 1536 + h * 256 + dv] = f2bf(o[e] * r * g);
  }
}
__device__ __forceinline__ void state_item_naive(const P& p, int item) {
  const int b = item >> 3, h = (item >> 1) & 3, dir = item & 1, tid = threadIdx.x;
  const float lg = log1pf(-exp2f(-p.l0_decay[dir * 4 + h]));
  const int dv = tid & 255;
  float* o = p.out + (size_t)NT * DM + ((size_t)(b * 2 + dir) * 4 + h) * 128 * 256;
  for (int pass = 0; pass < 4; ++pass) {
    const int dk0 = (tid >> 8) * 64 + pass * 16;
    float acc[16] = {};
    for (int s = 0; s < 256; ++s) {
      const int t = b * 256 + s;
      const float w = dir == 0 ? __expf((float)(255 - s) * lg) : __expf((float)s * lg);
      const float v = bf2f(p.proj[(size_t)t * 4096 + 1024 + h * 256 + dv]) * w;
      const u16* kr = p.proj + (size_t)t * 4096 + 512 + h * 128 + dk0;
#pragma unroll
      for (int e = 0; e < 16; ++e) acc[e] += bf2f(kr[e]) * v;
    }
#pragma unroll
    for (int e = 0; e < 16; ++e) o[(dk0 + e) * 256 + dv] = acc[e];
  }
}
__device__ __forceinline__ void gmlp_item_naive(const P& p, int item, float* lds) {
  const int ci = item >> 2, g = item & 3, tid = threadIdx.x, wid = tid >> 6, lane = tid & 63;
  float* zn = lds;
  float* mu = lds + 128 * 128;
  float* rs = mu + 128;
  __syncthreads();
  for (int q = wid; q < 128; q += 8) {
    const u32x4 v = *(const u32x4*)(p.proj + (size_t)(ci * 128 + q) * 4096 + 3584 + lane * 8);
    float s = 0.f, s2 = 0.f;
#pragma unroll
    for (int e = 0; e < 4; ++e) { const float a = __uint_as_float(v[e] << 16), b = __uint_as_float(v[e] & 0xffff0000u); s += a + b; s2 += a * a + b * b; }
    s = wave_sum(s); s2 = wave_sum(s2);
    if (lane == 0) { const float m = s * (1.f / 512.f); const float var = fmaxf(s2 * (1.f / 512.f) - m * m, 0.f); mu[q] = m; rs[q] = rsqrtf(var + EPS); }
  }
  __syncthreads();
  for (int i = tid; i < 128 * 128; i += NTHR) {
    const int q = i >> 7, c = i & 127;
    zn[i] = (bf2f(p.proj[(size_t)(ci * 128 + q) * 4096 + 3584 + g * 128 + c]) - mu[q]) * rs[q];
  }
  __syncthreads();
  const int c = tid & 127, p0 = (tid >> 7) * 32;
  float acc[32] = {};
  const float* W = p.l0_gws + (size_t)g * 128 * 128;
  for (int q = 0; q < 128; ++q) {
    const float z = zn[q * 128 + c];
#pragma unroll
    for (int e = 0; e < 32; ++e) acc[e] += W[(p0 + e) * 128 + q] * z;
  }
#pragma unroll
  for (int e = 0; e < 32; ++e) {
    const int t = ci * 128 + p0 + e;
    const float u = bf2f(p.proj[(size_t)t * 4096 + 3072 + g * 128 + c]);
    p.cat[(size_t)t * 1536 + 1024 + g * 128 + c] = f2bf((acc[e] + p.l0_gb[g * 128 + p0 + e]) * u);
  }
}
__device__ __forceinline__ void phase_mixer_naive(const P& p, float* lds) {
  const int nR = 1536, nS = 128, nG = 192, total = nR + nS + nG;
  for (int it = blockIdx.x; it < total; it += gridDim.x) {
    if (it < nR) ret_item_naive(p, it, lds);
    else if (it < nR + nS) state_item_naive(p, it - nR);
    else gmlp_item_naive(p, it - nR - nS, lds);
  }
}


#define LAS __attribute__((address_space(3)))
typedef short bf16x8 __attribute__((ext_vector_type(8)));
typedef short bf16x4 __attribute__((ext_vector_type(4)));
constexpr int PK = 136;
constexpr int PV = 264;
__device__ __forceinline__ bf16x8 frag_row(const LAS u16* base, int pitch, int r0, int k0, int fr, int fq) {
  return *(const LAS bf16x8*)(base + (r0 + fr) * pitch + k0 + fq * 8);
}
__device__ __forceinline__ bf16x8 frag_tr(const LAS u16* base, int pitch, int k0, int n0, int fr, int fq) {
  const LAS u16* a = base + (k0 + fq * 8 + (fr >> 2)) * pitch + n0 + 4 * (fr & 3);
  const bf16x4 lo = __builtin_amdgcn_ds_read_tr16_b64_v4i16((LAS bf16x4*)a);
  const bf16x4 hi = __builtin_amdgcn_ds_read_tr16_b64_v4i16((LAS bf16x4*)(a + 4 * pitch));
  bf16x8 r; r[0] = lo[0]; r[1] = lo[1]; r[2] = lo[2]; r[3] = lo[3]; r[4] = hi[0]; r[5] = hi[1]; r[6] = hi[2]; r[7] = hi[3];
  return r;
}
__device__ __forceinline__ f32x4 mfma16(bf16x8 a, bf16x8 b, f32x4 c) { return __builtin_amdgcn_mfma_f32_16x16x32_bf16(a, b, c, 0, 0, 0); }
template <int ROWS, int COLS>
__device__ __forceinline__ void tile_to_lds_t(const u16* __restrict__ g, size_t gp, LAS u16* l, int lp) {
  constexpr int CPR = COLS / 8, N = ROWS * CPR / NTHR;
  u32x4 v[N];
#pragma unroll
  for (int k = 0; k < N; ++k) { const int i = threadIdx.x + k * NTHR, r = i / CPR, c = (i % CPR) * 8; v[k] = *(const u32x4*)(g + (size_t)r * gp + c); }
#pragma unroll
  for (int k = 0; k < N; ++k) { const int i = threadIdx.x + k * NTHR, r = i / CPR, c = (i % CPR) * 8; *(LAS u32x4*)(l + r * lp + c) = v[k]; }
}
__device__ __forceinline__ void tile_to_lds(const u16* __restrict__ g, size_t gp, LAS u16* l, int lp, int rows, int cols) {
  if (cols == 128) tile_to_lds_t<128, 128>(g, gp, l, lp); else tile_to_lds_t<128, 256>(g, gp, l, lp);
}

__device__ __forceinline__ void kv_item(const P& p, int item, LAS u16* lds) {
  const int ci = item >> 2, h = item & 3, tid = threadIdx.x, wid = tid >> 6, lane = tid & 63, fr = lane & 15, fq = lane >> 4;
  LAS u16* kbuf = lds; LAS u16* vbuf = lds + 128 * PK;
  __syncthreads();
  tile_to_lds(p.proj + (size_t)ci * 128 * 4096 + 512 + h * 128, 4096, kbuf, PK, 128, 128);
  tile_to_lds(p.proj + (size_t)ci * 128 * 4096 + 1024 + h * 256, 4096, vbuf, PV, 128, 256);
  __syncthreads();
  const int dir = wid >> 2, d0 = (wid & 3) * 32;
  const float lg = log1pf(-exp2f(-p.l0_decay[dir * 4 + h]));
  u16* o = (u16*)p.part + ((size_t)(ci * 4 + h) * 2 + dir) * 128 * 256;
#pragma unroll 1
  for (int nh = 0; nh < 2; ++nh) {
    f32x4 acc[8][2];
#pragma unroll
    for (int m = 0; m < 8; ++m) { acc[m][0] = (f32x4){0.f, 0.f, 0.f, 0.f}; acc[m][1] = (f32x4){0.f, 0.f, 0.f, 0.f}; }
#pragma unroll 1
    for (int ks = 0; ks < 4; ++ks) {
      bf16x8 kb[2];
      kb[0] = frag_tr(kbuf, PK, ks * 32, d0, fr, fq); kb[1] = frag_tr(kbuf, PK, ks * 32, d0 + 16, fr, fq);
#pragma unroll
      for (int j = 0; j < 8; ++j) {
        const int tok = ks * 32 + fq * 8 + j;
        const float w = __expf((float)(dir == 0 ? 127 - tok : tok) * lg);
        kb[0][j] = (short)f2bf(bf2f((u16)kb[0][j]) * w); kb[1][j] = (short)f2bf(bf2f((u16)kb[1][j]) * w);
      }
#pragma unroll
      for (int m = 0; m < 8; ++m) {
        const bf16x8 va = frag_tr(vbuf, PV, ks * 32, nh * 128 + m * 16, fr, fq);
        acc[m][0] = mfma16(va, kb[0], acc[m][0]); acc[m][1] = mfma16(va, kb[1], acc[m][1]);
      }
    }
#pragma unroll
    for (int n = 0; n < 2; ++n) {
      u16* orow = o + (size_t)(d0 + n * 16 + fr) * 256 + nh * 128 + fq * 4;
#pragma unroll
      for (int m = 0; m < 8; ++m) { u32x2 v; v[0] = pk2(acc[m][n][0], acc[m][n][1]); v[1] = pk2(acc[m][n][2], acc[m][n][3]); *(u32x2*)(orow + m * 16) = v; }
    }
  }
}

__device__ __forceinline__ void gmlp_item(const P& p, int item, LAS u16* lds) {
  const int ci = item >> 2, g = item & 3, tid = threadIdx.x, wid = tid >> 6, lane = tid & 63, fr = lane & 15, fq = lane >> 4;
  LAS u16* zn = lds; LAS u16* wsb = lds + 128 * PK; LAS float* mu = (LAS float*)(lds + 2 * 128 * PK); LAS float* rs = mu + 128;
  __syncthreads();
  {
    u32x4 zv[16];
#pragma unroll
    for (int k = 0; k < 16; ++k) zv[k] = *(const u32x4*)(p.proj + (size_t)(ci * 128 + wid + 8 * k) * 4096 + 3584 + lane * 8);
#pragma unroll
    for (int k = 0; k < 16; ++k) {
      float s = 0.f, s2 = 0.f;
#pragma unroll
      for (int e = 0; e < 4; ++e) { const float a = __uint_as_float(zv[k][e] << 16), b = __uint_as_float(zv[k][e] & 0xffff0000u); s += a + b; s2 += a * a + b * b; }
      s = wave_sum(s); s2 = wave_sum(s2);
      if (lane == 0) { const float m = s * (1.f / 512.f); const float var = fmaxf(s2 * (1.f / 512.f) - m * m, 0.f); mu[wid + 8 * k] = m; rs[wid + 8 * k] = rsqrtf(var + EPS); }
    }
  }
  u32x4 zr[4];
#pragma unroll
  for (int k = 0; k < 4; ++k) { const int i = tid + k * NTHR, q = i >> 4, c = (i & 15) * 8; zr[k] = *(const u32x4*)(p.proj + (size_t)(ci * 128 + q) * 4096 + 3584 + g * 128 + c); }
  {
    const float* W = p.l0_gws + (size_t)g * 128 * 128;
    f32x4 wv[8];
#pragma unroll
    for (int k = 0; k < 8; ++k) { const int i = tid + k * NTHR; wv[k] = *(const f32x4*)(W + (i >> 5) * 128 + (i & 31) * 4); }
#pragma unroll
    for (int k = 0; k < 8; ++k) {
      const int i = tid + k * NTHR, r = i >> 5, c = (i & 31) * 4;
      u32x2 o; o[0] = pk2(wv[k][0], wv[k][1]); o[1] = pk2(wv[k][2], wv[k][3]);
      *(LAS u32x2*)(wsb + r * PK + c) = o;
    }
  }
  __syncthreads();
#pragma unroll
  for (int k = 0; k < 4; ++k) {
    const int i = tid + k * NTHR, q = i >> 4, c = (i & 15) * 8;
    const float m = mu[q], r = rs[q];
    u32x4 o;
#pragma unroll
    for (int e = 0; e < 4; ++e) o[e] = pk2((__uint_as_float(zr[k][e] << 16) - m) * r, (__uint_as_float(zr[k][e] & 0xffff0000u) - m) * r);
    *(LAS u32x4*)(zn + q * PK + c) = o;
  }
  __syncthreads();
  f32x4 acc[8];
#pragma unroll
  for (int m = 0; m < 8; ++m) acc[m] = (f32x4){0.f, 0.f, 0.f, 0.f};
#pragma unroll
  for (int ks = 0; ks < 4; ++ks) {
    const bf16x8 wb = frag_row(wsb, PK, wid * 16, ks * 32, fr, fq);
#pragma unroll
    for (int m = 0; m < 8; ++m) acc[m] = mfma16(frag_tr(zn, PK, ks * 32, m * 16, fr, fq), wb, acc[m]);
  }
  {
    const int pr = wid * 16 + fr, t = ci * 128 + pr;
    const float gb = p.l0_gb[g * 128 + pr];
    const u16* urow = p.proj + (size_t)t * 4096 + 3072 + g * 128 + fq * 4;
    u16* orow = p.cat + (size_t)t * 1536 + 1024 + g * 128 + fq * 4;
#pragma unroll
    for (int m = 0; m < 8; ++m) {
      const u32x2 uv = *(const u32x2*)(urow + m * 16);
      u32x2 v;
      v[0] = pk2((acc[m][0] + gb) * __uint_as_float(uv[0] << 16), (acc[m][1] + gb) * __uint_as_float(uv[0] & 0xffff0000u));
      v[1] = pk2((acc[m][2] + gb) * __uint_as_float(uv[1] << 16), (acc[m][3] + gb) * __uint_as_float(uv[1] & 0xffff0000u));
      *(u32x2*)(orow + m * 16) = v;
    }
  }
}
__device__ __forceinline__ void phase_mix_a(const P& p, LAS u16* lds) {
  for (int it = blockIdx.x; it < 384; it += gridDim.x) { if (it < 192) kv_item(p, it, lds); else gmlp_item(p, it - 192, lds); }
}

__device__ __forceinline__ void build_state(const P& p, LAS u16* bbuf, const float* S0, float w0, int cbase, int h, int dir, int c_lo, int c_hi, int c_ref, float lg128) {
  const int tid = threadIdx.x;
#pragma unroll 1
  for (int half = 0; half < 2; ++half) {
    f32x4 a[8];
    const int base = (tid + half * 4096) * 4;
    if (S0) {
#pragma unroll
      for (int k = 0; k < 8; ++k) a[k] = *(const f32x4*)(S0 + base + k * 2048);
#pragma unroll
      for (int k = 0; k < 8; ++k) a[k] = a[k] * w0;
    } else {
#pragma unroll
      for (int k = 0; k < 8; ++k) a[k] = (f32x4){0.f, 0.f, 0.f, 0.f};
    }
#pragma unroll 1
    for (int cc = c_lo; cc < c_hi; ++cc) {
      const int e = dir == 0 ? (c_ref - 1 - cc) : (cc - c_ref - 1);
      const float w = __expf(lg128 * (float)e);
      const float* src = p.part + ((size_t)((cbase + cc) * 4 + h) * 2 + dir) * 128 * 256 + base;
      f32x4 t[8];
#pragma unroll
      for (int k = 0; k < 8; ++k) t[k] = *(const f32x4*)(src + k * 2048);
#pragma unroll
      for (int k = 0; k < 8; ++k) a[k] = a[k] + t[k] * w;
    }
#pragma unroll
    for (int k = 0; k < 8; ++k) {
      const int i = tid + half * 4096 + k * 512, r = i >> 6, c = (i & 63) * 4;
      u32x2 o; o[0] = pk2(a[k][0], a[k][1]); o[1] = pk2(a[k][2], a[k][3]);
      *(LAS u32x2*)(bbuf + r * PV + c) = o;
    }
  }
}
__device__ __forceinline__ void scan_item(const P& p, int item, unsigned* scnt) {
  const int combo = item >> 2, q = item & 3, dir = combo & 1, h = (combo >> 1) & 3, sb = combo >> 3, tid = threadIdx.x;
  const float g = __expf(128.f * log1pf(-exp2f(-p.l0_decay[dir * 4 + h])));
  const float* S0 = p.state + ((size_t)(sb * 2 + dir) * 4 + h) * 128 * 256 + q * 32 * 256;
  const u16* KV = (const u16*)p.part + ((size_t)((32 + sb * 8) * 4 + h) * 2 + dir) * 128 * 256 + q * 32 * 256;
  const __amdgpu_buffer_rsrc_t rs = mk_rsrc(p.stimg, 2u * 4u * 2u * 8u * 128u * 256u * 2u);
  const unsigned obase = (unsigned)((((size_t)combo * 8) * 128 * 256 + q * 32 * 256) * 2);
  float s[2][8]; u32x4 kv[7][2];
#pragma unroll
  for (int k = 0; k < 2; ++k) {
    const f32x4 a = *(const f32x4*)(S0 + (tid + 512 * k) * 8), b2 = *(const f32x4*)(S0 + (tid + 512 * k) * 8 + 4);
    s[k][0] = a[0]; s[k][1] = a[1]; s[k][2] = a[2]; s[k][3] = a[3]; s[k][4] = b2[0]; s[k][5] = b2[1]; s[k][6] = b2[2]; s[k][7] = b2[3];
  }
#pragma unroll
  for (int c = 0; c < 7; ++c)
#pragma unroll
    for (int k = 0; k < 2; ++k) kv[c][k] = *(const u32x4*)(KV + (size_t)(c + dir) * (4 * 2 * 128 * 256) + (tid + 512 * k) * 8);
#pragma unroll
  for (int st = 0; st < 8; ++st) {
    const int c = dir == 0 ? st : 7 - st;
#pragma unroll
    for (int k = 0; k < 2; ++k) {
      if (st > 0) {
        const u32x4 t = kv[dir == 0 ? st - 1 : 7 - st][k];
#pragma unroll
        for (int e = 0; e < 4; ++e) { s[k][2 * e] = s[k][2 * e] * g + __uint_as_float(t[e] << 16); s[k][2 * e + 1] = s[k][2 * e + 1] * g + __uint_as_float(t[e] & 0xffff0000u); }
      }
      u32x4 v; v[0] = pk2(s[k][0], s[k][1]); v[1] = pk2(s[k][2], s[k][3]); v[2] = pk2(s[k][4], s[k][5]); v[3] = pk2(s[k][6], s[k][7]);
      __builtin_amdgcn_raw_buffer_store_b128(v, rs, obase + (unsigned)(((size_t)c * 128 * 256 + (tid + 512 * k) * 8) * 2), 0, 16);
    }
  }
  asm volatile("s_waitcnt vmcnt(0)" ::: "memory");
  __syncthreads();
  if (tid == 0) xb_add(&scnt[combo * 16], 1u);
}
__device__ __forceinline__ void ret_item(const P& p, int item, LAS u16* lds, unsigned* scnt) {
  const int ci = item >> 2, h = item & 3, tid = threadIdx.x, wid = tid >> 6, lane = tid & 63, fr = lane & 15, fq = lane >> 4;
  int sb, lc, n;
  if (ci < 32) { sb = -1; lc = ci & 1; n = 2; } else { sb = (ci - 32) >> 3; lc = (ci - 32) & 7; n = 8; }
  const int cbase = ci - lc;
  const float lgf = log1pf(-exp2f(-p.l0_decay[h])), lgb = log1pf(-exp2f(-p.l0_decay[4 + h]));
  LAS u16* kbuf = lds; LAS u16* bbuf = lds + 128 * PK; LAS float* red = (LAS float*)(lds + 128 * PK + 128 * PV);
  const bool hasF = (sb >= 0) || lc > 0, hasB = (sb >= 0) || lc < n - 1;
  const u16* qg = p.proj + (size_t)ci * 128 * 4096 + h * 128;
  __syncthreads();
  tile_to_lds(p.proj + (size_t)ci * 128 * 4096 + 512 + h * 128, 4096, kbuf, PK, 128, 128);
  __syncthreads();
  {
    f32x4 s[8];
#pragma unroll
    for (int nn = 0; nn < 8; ++nn) s[nn] = (f32x4){0.f, 0.f, 0.f, 0.f};
    bf16x8 qa[4];
#pragma unroll
    for (int ks = 0; ks < 4; ++ks) qa[ks] = *(const bf16x8*)(qg + (size_t)(wid * 16 + fr) * 4096 + ks * 32 + fq * 8);
#pragma unroll
    for (int ks = 0; ks < 4; ++ks) {
#pragma unroll
      for (int nn = 0; nn < 8; ++nn) s[nn] = mfma16(qa[ks], frag_row(kbuf, PK, nn * 16, ks * 32, fr, fq), s[nn]);
    }
    __syncthreads();
    int bd = wid * 16 + fq * 4 - fr;
    asm volatile("" : "+v"(bd));
    LAS u16* prow = kbuf + (wid * 16 + fq * 4) * PK + fr;
#pragma unroll
    for (int nn = 0; nn < 8; ++nn)
#pragma unroll
      for (int j = 0; j < 4; ++j) {
        const int d = bd + j - 16 * nn;
        const float w = d > 0 ? __expf((float)d * lgf) : (d < 0 ? __expf((float)(-d) * lgb) : 2.f);
        prow[j * PK + nn * 16] = f2bf(s[nn][j] * w);
      }
  }
  const int m0 = (wid & 3) * 32, n0 = (wid >> 2) * 128;
  f32x4 acc[2][8];
#pragma unroll
  for (int m = 0; m < 2; ++m)
#pragma unroll
    for (int nn = 0; nn < 8; ++nn) acc[m][nn] = (f32x4){0.f, 0.f, 0.f, 0.f};
  const u16* qrow = qg + (size_t)(m0 + fr) * 4096 + fq * 8;
  if (sb >= 0) {
    if (tid == 0) {
      XB_SPIN(xb_ld(&scnt[((sb * 4 + h) * 2 + 0) * 16]) < 4u || xb_ld(&scnt[((sb * 4 + h) * 2 + 1) * 16]) < 4u, p.bar);
      __builtin_amdgcn_fence(__ATOMIC_ACQUIRE, "agent");
      asm volatile("s_waitcnt vmcnt(0)" ::: "memory");
    }
    __syncthreads();
    tile_to_lds(p.stimg + ((size_t)((sb * 4 + h) * 2 + 0) * 8 + lc) * 128 * 256, 256, bbuf, PV, 128, 256);
    __syncthreads();
  } else if (hasF) {
    tile_to_lds((const u16*)p.part + ((size_t)((cbase + 0) * 4 + h) * 2 + 0) * 128 * 256, 256, bbuf, PV, 128, 256);
    __syncthreads();
  }
  if (hasF) {
    {
      bf16x8 q0[4], q1[4];
#pragma unroll
      for (int ks = 0; ks < 4; ++ks) { q0[ks] = *(const bf16x8*)(qrow + ks * 32); q1[ks] = *(const bf16x8*)(qrow + 16 * 4096 + ks * 32); }
#pragma unroll 1
      for (int ks = 0; ks < 4; ++ks) {
        const bf16x8 a0 = ks == 0 ? q0[0] : (ks == 1 ? q0[1] : (ks == 2 ? q0[2] : q0[3])), a1 = ks == 0 ? q1[0] : (ks == 1 ? q1[1] : (ks == 2 ? q1[2] : q1[3]));
#pragma unroll
        for (int nn = 0; nn < 8; ++nn) {
          const bf16x8 b = frag_tr(bbuf, PV, ks * 32, n0 + nn * 16, fr, fq);
          acc[0][nn] = mfma16(a0, b, acc[0][nn]); acc[1][nn] = mfma16(a1, b, acc[1][nn]);
        }
      }
    }
#pragma unroll
    for (int m = 0; m < 2; ++m)
#pragma unroll
      for (int j = 0; j < 4; ++j) {
        const int il = m0 + m * 16 + fq * 4 + j;
        const float sc = hasB ? __expf((float)(il + 1) * lgf - (float)(128 - il) * lgb) : __expf((float)(il + 1) * lgf);
#pragma unroll
        for (int nn = 0; nn < 8; ++nn) acc[m][nn][j] *= sc;
      }
  }
  if (hasB) {
    __syncthreads();
    if (sb >= 0) tile_to_lds(p.stimg + ((size_t)((sb * 4 + h) * 2 + 1) * 8 + lc) * 128 * 256, 256, bbuf, PV, 128, 256);
    else tile_to_lds((const u16*)p.part + ((size_t)((cbase + 1) * 4 + h) * 2 + 1) * 128 * 256, 256, bbuf, PV, 128, 256);
    __syncthreads();
    {
      bf16x8 q0[4], q1[4];
#pragma unroll
      for (int ks = 0; ks < 4; ++ks) { q0[ks] = *(const bf16x8*)(qrow + ks * 32); q1[ks] = *(const bf16x8*)(qrow + 16 * 4096 + ks * 32); }
#pragma unroll 1
      for (int ks = 0; ks < 4; ++ks) {
        const bf16x8 a0 = ks == 0 ? q0[0] : (ks == 1 ? q0[1] : (ks == 2 ? q0[2] : q0[3])), a1 = ks == 0 ? q1[0] : (ks == 1 ? q1[1] : (ks == 2 ? q1[2] : q1[3]));
#pragma unroll
        for (int nn = 0; nn < 8; ++nn) {
          const bf16x8 b = frag_tr(bbuf, PV, ks * 32, n0 + nn * 16, fr, fq);
          acc[0][nn] = mfma16(a0, b, acc[0][nn]); acc[1][nn] = mfma16(a1, b, acc[1][nn]);
        }
      }
    }
#pragma unroll
    for (int m = 0; m < 2; ++m)
#pragma unroll
      for (int j = 0; j < 4; ++j) {
        const int il = m0 + m * 16 + fq * 4 + j;
        const float sc = __expf((float)(128 - il) * lgb);
#pragma unroll
        for (int nn = 0; nn < 8; ++nn) acc[m][nn][j] *= sc;
      }
  }
  __syncthreads();
  tile_to_lds(p.proj + (size_t)ci * 128 * 4096 + 1024 + h * 256, 4096, bbuf, PV, 128, 256);
  __syncthreads();
#pragma unroll 1
  for (int ks = 0; ks < 4; ++ks) {
    const bf16x8 a0 = frag_row(kbuf, PK, m0, ks * 32, fr, fq), a1 = frag_row(kbuf, PK, m0 + 16, ks * 32, fr, fq);
#pragma unroll
    for (int nn = 0; nn < 8; ++nn) {
      const bf16x8 b = frag_tr(bbuf, PV, ks * 32, n0 + nn * 16, fr, fq);
      acc[0][nn] = mfma16(a0, b, acc[0][nn]); acc[1][nn] = mfma16(a1, b, acc[1][nn]);
    }
  }
#pragma unroll
  for (int m = 0; m < 2; ++m)
#pragma unroll
    for (int j = 0; j < 4; ++j) {
      float s = 0.f;
#pragma unroll
      for (int nn = 0; nn < 8; ++nn) s += acc[m][nn][j] * acc[m][nn][j];
      s += __shfl_xor(s, 1); s += __shfl_xor(s, 2); s += __shfl_xor(s, 4); s += __shfl_xor(s, 8);
      if (fr == 0) red[(wid >> 2) * 128 + m0 + m * 16 + fq * 4 + j] = s;
    }
  __syncthreads();
#pragma unroll
  for (int m = 0; m < 2; ++m)
#pragma unroll
    for (int j = 0; j < 4; ++j) {
      const int il = m0 + m * 16 + fq * 4 + j;
      const float r = rsqrtf((red[il] + red[128 + il]) * (1.f / 256.f) + EPS);
      LAS u16* orow = bbuf + il * PV + n0 + fr;
#pragma unroll
      for (int nn = 0; nn < 8; ++nn) orow[nn * 16] = f2bf(acc[m][nn][j] * r);
    }
  __syncthreads();
  {
    const u16* gbase = p.proj + (size_t)ci * 128 * 4096 + 2048 + h * 256;
    u16* obase = p.cat + (size_t)ci * 128 * 1536 + h * 256;
    u32x4 gv[8];
#pragma unroll
    for (int k = 0; k < 8; ++k) { const int i = tid + k * NTHR, r = i >> 5, c = (i & 31) * 8; gv[k] = *(const u32x4*)(gbase + (size_t)r * 4096 + c); }
#pragma unroll
    for (int k = 0; k < 8; ++k) {
      const int i = tid + k * NTHR, r = i >> 5, c = (i & 31) * 8;
      const u32x4 ov = *(const LAS u32x4*)(bbuf + r * PV + c);
      u32x4 o;
#pragma unroll
      for (int e = 0; e < 4; ++e) o[e] = pk2(__uint_as_float(ov[e] << 16) * __uint_as_float(gv[k][e] << 16), __uint_as_float(ov[e] & 0xffff0000u) * __uint_as_float(gv[k][e] & 0xffff0000u));
      *(u32x4*)(obase + (size_t)r * 1536 + c) = o;
    }
  }
}
__device__ __forceinline__ void state_item(const P& p, int item) {
  const int b = item >> 3, h = (item >> 1) & 3, dir = item & 1;
  const float w = __expf(128.f * log1pf(-exp2f(-p.l0_decay[dir * 4 + h])));
  const int c_old = dir == 0 ? 2 * b : 2 * b + 1, c_new = dir == 0 ? 2 * b + 1 : 2 * b;
  const u16* A = (const u16*)p.part + ((size_t)(c_old * 4 + h) * 2 + dir) * 128 * 256;
  const u16* B = (const u16*)p.part + ((size_t)(c_new * 4 + h) * 2 + dir) * 128 * 256;
  float* o = p.out + (size_t)NT * DM + ((size_t)(b * 2 + dir) * 4 + h) * 128 * 256;
  u32x4 av[8], bv[8];
#pragma unroll
  for (int k = 0; k < 8; ++k) { const int i = threadIdx.x + k * NTHR; av[k] = *(const u32x4*)(A + i * 8); bv[k] = *(const u32x4*)(B + i * 8); }
#pragma unroll
  for (int k = 0; k < 8; ++k) {
    const int i = threadIdx.x + k * NTHR;
    f32x4 o0, o1;
    o0[0] = __uint_as_float(av[k][0] << 16) * w + __uint_as_float(bv[k][0] << 16); o0[1] = __uint_as_float(av[k][0] & 0xffff0000u) * w + __uint_as_float(bv[k][0] & 0xffff0000u);
    o0[2] = __uint_as_float(av[k][1] << 16) * w + __uint_as_float(bv[k][1] << 16); o0[3] = __uint_as_float(av[k][1] & 0xffff0000u) * w + __uint_as_float(bv[k][1] & 0xffff0000u);
    o1[0] = __uint_as_float(av[k][2] << 16) * w + __uint_as_float(bv[k][2] << 16); o1[1] = __uint_as_float(av[k][2] & 0xffff0000u) * w + __uint_as_float(bv[k][2] & 0xffff0000u);
    o1[2] = __uint_as_float(av[k][3] << 16) * w + __uint_as_float(bv[k][3] << 16); o1[3] = __uint_as_float(av[k][3] & 0xffff0000u) * w + __uint_as_float(bv[k][3] & 0xffff0000u);
    *(f32x4*)(o + i * 8) = o0; *(f32x4*)(o + i * 8 + 4) = o1;
  }
}
__device__ __forceinline__ void phase_mix_b(const P& p, LAS u16* lds, unsigned* scnt) {
  const int b = (int)blockIdx.x;
  if (b < 64) ret_item(p, 128 + b, lds, scnt);
  else if (b < 192) ret_item(p, b - 64, lds, scnt);
  else { scan_item(p, b - 192, scnt); state_item(p, 2 * (b - 192)); state_item(p, 2 * (b - 192) + 1); }
}

__device__ __forceinline__ void phase_conv(const P& p) {
  const u16* __restrict__ pj = p.proj;
  const size_t total = (size_t)NT * 256, stride = (size_t)gridDim.x * NTHR;
  for (size_t i0 = (size_t)blockIdx.x * NTHR + threadIdx.x; i0 < total; i0 += 4 * stride) {
    u32x2 av[4][3], bv[4][3], bgv[4]; bool ok[4][3];
#pragma unroll
    for (int u = 0; u < 4; ++u) {
      const size_t i = i0 + u * stride; const bool live = i < total;
      const int t = live ? (int)(i >> 8) : 0, c4 = (int)(i & 255) * 4;
      const int seg = t < NPROMPT_T ? 256 : 64, pos = t < NPROMPT_T ? (t & 255) : ((t - NPROMPT_T) & 63);
#pragma unroll
      for (int d = 0; d < 3; ++d) {
        const int pp = pos + d - 1; ok[u][d] = live && pp >= 0 && pp < seg;
        const u16* r = pj + (size_t)(ok[u][d] ? t + d - 1 : t) * 3072;
        av[u][d] = *(const u32x2*)(r + 1024 + c4); bv[u][d] = *(const u32x2*)(r + 2048 + c4);
      }
      bgv[u] = *(const u32x2*)(pj + (size_t)t * 3072 + c4);
    }
#pragma unroll
    for (int u = 0; u < 4; ++u) {
      const size_t i = i0 + u * stride; if (i >= total) continue;
      const int t = (int)(i >> 8), c4 = (int)(i & 255) * 4;
      f32x4 xc[3];
#pragma unroll
      for (int d = 0; d < 3; ++d) {
        const u32x2 a = av[u][d], b2 = bv[u][d];
        xc[d][0] = __uint_as_float(a[0] << 16) * __uint_as_float(b2[0] << 16); xc[d][1] = __uint_as_float(a[0] & 0xffff0000u) * __uint_as_float(b2[0] & 0xffff0000u);
        xc[d][2] = __uint_as_float(a[1] << 16) * __uint_as_float(b2[1] << 16); xc[d][3] = __uint_as_float(a[1] & 0xffff0000u) * __uint_as_float(b2[1] & 0xffff0000u);
        if (!ok[u][d]) xc[d] = (f32x4){0.f, 0.f, 0.f, 0.f};
      }
      const f32x4 w0 = *(const f32x4*)(p.l1_conv + c4), w1 = *(const f32x4*)(p.l1_conv + 1024 + c4), w2 = *(const f32x4*)(p.l1_conv + 2048 + c4);
      const f32x4 bg = {__uint_as_float(bgv[u][0] << 16), __uint_as_float(bgv[u][0] & 0xffff0000u), __uint_as_float(bgv[u][1] << 16), __uint_as_float(bgv[u][1] & 0xffff0000u)};
      const f32x4 y = bg * (w0 * xc[0] + w1 * xc[1] + w2 * xc[2]);
      u32x2 o; o[0] = pk2(y[0], y[1]); o[1] = pk2(y[2], y[3]);
      *(u32x2*)(p.cat + (size_t)t * 1024 + c4) = o;
    }
  }
}

#define XB_XCNT(j)  (256  + 64 * (j))
#define XB_XSUB(j)  (1280 + 64 * (j))
#define XB_XGEN(j)  (2304 + 64 * (j))
#define XB_TOP      3328
#define XB_TOPGEN   3392
#define XCD_BAR_WORDS 3456
__device__ __forceinline__ unsigned xb_xcc_id() { return (unsigned)__builtin_amdgcn_s_getreg((3 << 11) | 20) & 0xFu; }
struct XcdBarrier { unsigned* bar; unsigned x; volatile __attribute__((address_space(3))) unsigned* st; };
__device__ __forceinline__ XcdBarrier xcd_barrier_post(unsigned* bar, volatile __attribute__((address_space(3))) unsigned* st) {
  XcdBarrier b; b.bar = bar; b.x = xb_xcc_id(); b.st = st;
  if (threadIdx.x == 0) (void)xb_add(&bar[XB_XCNT(b.x)], 1u);
  return b;
}
__device__ __forceinline__ void xcd_barrier_complete(unsigned* bar, unsigned x, unsigned& nloc, unsigned& nx) {
  const unsigned G = gridDim.x * gridDim.y * gridDim.z;
  unsigned sum, cnt, mine, sp = 0u;
  for (;;) {
    sum = 0u; cnt = 0u; mine = 0u;
#pragma unroll
    for (unsigned j = 0; j < 16; ++j) { const unsigned c = xb_ld(&bar[XB_XCNT(j)]); sum += c; cnt += (c > 0u) ? 1u : 0u; mine = (j == x) ? c : mine; }
    if (sum == G) break;
    __builtin_amdgcn_s_sleep(1);
    if ((++sp & 255u) == 0u) { if (xb_ld(&bar[XB_TMO])) break; if (sp > XB_SPIN_CAP) { atomicAdd(&bar[XB_TMO], 1u); break; } }
  }
  nloc = mine > 0u ? mine : 1u; nx = cnt > 0u ? cnt : 1u;
}
__device__ __forceinline__ void xcd_barrier(const XcdBarrier& b) {
  asm volatile("s_waitcnt vmcnt(0)" ::: "memory");
  __syncthreads();
  if (threadIdx.x == 0) {
    unsigned* bar = b.bar;
    __builtin_amdgcn_s_waitcnt(0);
    unsigned nloc = b.st[0], nx = b.st[1];
    if (nloc == 0u) { xcd_barrier_complete(bar, b.x, nloc, nx); b.st[0] = nloc; b.st[1] = nx; }
    const unsigned old = xb_add(&bar[XB_XSUB(b.x)], 1u);
    const unsigned gen = old / nloc;
    if (old + 1u == (gen + 1u) * nloc) {
      __builtin_amdgcn_fence(__ATOMIC_RELEASE, "agent");
      asm volatile("s_waitcnt vmcnt(0)" ::: "memory");
      const unsigned og = xb_add(&bar[XB_TOP], 1u);
      const unsigned tg = og / nx;
      if (og + 1u == (tg + 1u) * nx) xb_add(&bar[XB_TOPGEN], 1u);
      else XB_SPIN(xb_ld(&bar[XB_TOPGEN]) == tg, bar);
      __builtin_amdgcn_fence(__ATOMIC_ACQUIRE, "agent");
      xb_add(&bar[XB_XGEN(b.x)], 1u);
      asm volatile("s_waitcnt vmcnt(0)" ::: "memory");
    } else {
      XB_SPIN(xb_ld(&bar[XB_XGEN(b.x)]) == gen, bar);
      __builtin_amdgcn_fence(__ATOMIC_ACQUIRE, "agent");
      asm volatile("s_waitcnt vmcnt(0)" ::: "memory");
    }
  }
  __syncthreads();
}

__device__ __forceinline__ void phase_norm_fused(const NormArgs& a, unsigned* cnt, unsigned* bar) {
  pg8::Order S; S.init(NT, 1024, 2, (int)gridDim.x, (int)blockIdx.x);
  pg8::Unit u;
  if (!S.next(0, u)) return;
  asm volatile("s_waitcnt vmcnt(0)" ::: "memory");
  __syncthreads();
  if (threadIdx.x == 0) {
    for (int i = 0; S.next(i, u); ++i) xb_add(&cnt[u.pm * 16], 1u);
  }
  const int wid = threadIdx.x >> 6, lane = threadIdx.x & 63;
  for (int i = 0; S.next(i, u); ++i) {
    if (threadIdx.x == 0) {
      XB_SPIN(xb_ld(&cnt[u.pm * 16]) < 8u, bar);
      __builtin_amdgcn_fence(__ATOMIC_ACQUIRE, "agent");
      asm volatile("s_waitcnt vmcnt(0)" ::: "memory");
    }
    __syncthreads();
    const int r0 = u.pm * 256 + (u.pn * 2 + u.ks) * 32 + wid * 4;
    norm_rows<4, 2>(a, r0, lane);
  }
}

__device__ __forceinline__ void phase_ffn(const P& p, const u16* w1t, const u16* w2t, const NormArgs& na, unsigned* cntA, unsigned* cntB, float* lds) {
  const int c = (int)blockIdx.x, tid = threadIdx.x, wid = tid >> 6, lane = tid & 63, x = c & 7;
  PG8_LAS unsigned char* l3 = (PG8_LAS unsigned char*)lds;
  __syncthreads();
  { pg8::Gemm g{p.hA, w1t, NT, 4096, 1024, 1}; pg8::FfnOrder1 S{c}; EpiRelu2W e{mk_rsrc(p.proj, (unsigned)NT * 4096u * 2u)}; pg8::gemm_phase(l3, g, S, e); }
  asm volatile("s_waitcnt vmcnt(0)" ::: "memory");
  __syncthreads();
  if (tid == 0) { pg8::FfnOrder1 S{c}; pg8::Unit u; for (int i = 0; S.next(i, u); ++i) xb_add(&cntA[u.pm * 16], 1u); }
  pg8::Unit ue, ul;
  { const int oj = (c - 128) >> 3; ue.pm = x; ue.pn = oj >> 2; ue.ks = oj & 3; }
  { const int o = c >> 3; ul.pm = 8 + 2 * x + (o >> 4); ul.pn = (o & 15) >> 2; ul.ks = o & 3; }
#pragma unroll 1
  for (int pass = (c >= 128 ? 0 : 1); pass < 2; ++pass) {
    const pg8::Unit u = pass == 0 ? ue : ul;
    if (tid == 0) {
      XB_SPIN(xb_ld(&cntA[u.pm * 16]) < 16u, p.bar);
      __builtin_amdgcn_fence(__ATOMIC_ACQUIRE, "agent");
      asm volatile("s_waitcnt vmcnt(0)" ::: "memory");
    }
    __syncthreads();
    { pg8::Gemm g{p.proj, w2t, NT, 1024, 4096, 4}; pg8::OneUnit S{u}; EpiPartW e{mk_rsrc(p.part, 4u * (unsigned)NT * 1024u * 2u)}; pg8::gemm_phase(l3, g, S, e); }
    asm volatile("s_waitcnt vmcnt(0)" ::: "memory");
    __syncthreads();
    if (tid == 0) xb_add(&cntB[u.pm * 16], 1u);
  }
#pragma unroll 1
  for (int pass = (c >= 128 ? 0 : 1); pass < 2; ++pass) {
    const pg8::Unit u = pass == 0 ? ue : ul;
    if (tid == 0) {
      XB_SPIN(xb_ld(&cntB[u.pm * 16]) < 16u, p.bar);
      __builtin_amdgcn_fence(__ATOMIC_ACQUIRE, "agent");
      asm volatile("s_waitcnt vmcnt(0)" ::: "memory");
    }
    __syncthreads();
    norm_rows<2, 4>(na, u.pm * 256 + (u.pn * 4 + u.ks) * 16 + wid * 2, lane);
  }
}

constexpr int NPHASE = 11;
#ifndef REPMASK
#define REPMASK 0
#endif
__global__ void __launch_bounds__(NTHR) mega(P p, int lo, int hi) {
  extern __shared__ __attribute__((aligned(16))) unsigned char smem[];
  float* lds = (float*)smem;
  cg::grid_group grid = cg::this_grid();
  volatile LAS unsigned* xst = (volatile LAS unsigned*)(smem + 131072);
  if (threadIdx.x == 0) { xst[0] = 0u; xst[1] = 0u; }
  __syncthreads();
  const XcdBarrier xb = xcd_barrier_post(p.bar, xst);
  if (hi < 0) grid.sync();
  const float* m0 = p.mod; const float* m1 = p.mod + 3 * 6144;
#define PH(n, ...) if (lo <= (n) && (n) < hi) { if ((n) > lo) xcd_barrier(xb); __VA_ARGS__ if ((REPMASK >> (n)) & 1) { xcd_barrier(xb); __VA_ARGS__ } }
  unsigned* pcnt = p.bar + XCD_BAR_WORDS;
  float* const xs = p.xres + (size_t)NPROMPT_T * DM; float* const pp = p.part;
  PH(0, phase_prep(p, lds);)
  PH(1, { NormArgs a{p.x_prompt, p.x_sample, nullptr, nullptr, nullptr, nullptr, p.l0_norm1, m0 + 0, m0 + 1024, p.hA, nullptr}; phase_norm(a); })
  PH(2, { EpiProj0 e{p.proj}; phase_gemm(p.hA, p.wt0_in, NT, 4096, 1024, 1, e, lds); phase_prep2(p, lds, 0, 128); })
  PH(3, phase_mix_a(p, (LAS u16*)smem);)
  PH(4, phase_mix_b(p, (LAS u16*)smem, pcnt + 6 * 384);)
  PH(5, { EpiPartW e{mk_rsrc(p.part, 4u * (unsigned)NT * 1024u * 2u)}; phase_gemm(p.cat, p.wt0_out, NT, 1024, 1536, 2, e, lds);
          NormArgs a{p.x_prompt, p.x_sample, pp, pp, m0 + 2048, p.xres, p.l0_norm2, m0 + 3072, m0 + 4096, p.hA, nullptr}; phase_norm_fused(a, pcnt + 0 * 384, p.bar);
          phase_prep2(p, lds, 1, 192); })
  PH(6, { NormArgs a{p.xres, xs, pp, pp, m0 + 5120, p.xres, p.l1_norm1, m1 + 0, m1 + 1024, p.hA, nullptr}; phase_ffn(p, p.wt0_f1, p.wt0_f2, a, pcnt + 1 * 384, pcnt + 2 * 384, lds); })
  PH(7, { EpiPlain e{p.proj, 3072}; phase_gemm(p.hA, p.wt1_in, NT, 3072, 1024, 1, e, lds); phase_prep2(p, lds, 2, 32); })
  PH(8, phase_conv(p);)
  PH(9, { EpiPartW e{mk_rsrc(p.part, 4u * (unsigned)NT * 1024u * 2u)}; phase_gemm(p.cat, p.wt1_out, NT, 1024, 1024, 2, e, lds);
          NormArgs a{p.xres, xs, pp, pp, m1 + 2048, p.xres, p.l1_norm2, m1 + 3072, m1 + 4096, p.hA, nullptr}; phase_norm_fused(a, pcnt + 3 * 384, p.bar); })
  PH(10, { NormArgs a{p.xres, xs, pp, pp, m1 + 5120, nullptr, p.final_norm, nullptr, nullptr, nullptr, p.out}; phase_ffn(p, p.wt1_f1, p.wt1_f2, a, pcnt + 4 * 384, pcnt + 5 * 384, lds); })
#undef PH
}

constexpr size_t LDS_BYTES = 131072 + 256;
constexpr bool ONE_LAUNCH = true;

extern "C" void kernel_launch(void* const* d_in, const int* in_sizes, int n_in, void* d_out, int out_size, void* d_ws, size_t ws_size, hipStream_t stream) {
  static int grid_blocks = 0;
  if (!grid_blocks) {
    hipFuncSetAttribute((const void*)mega, hipFuncAttributeMaxDynamicSharedMemorySize, (int)LDS_BYTES);
    int dev = 0, cus = 0, per_cu = 0;
    hipGetDevice(&dev);
    hipDeviceGetAttribute(&cus, hipDeviceAttributeMultiprocessorCount, dev);
    hipOccupancyMaxActiveBlocksPerMultiprocessor(&per_cu, mega, NTHR, LDS_BYTES);
    if (per_cu < 1) per_cu = 1;
    if (per_cu > 1) per_cu = 1;
    grid_blocks = 256;
  }
  P p{};
  const float* const* in = (const float* const*)d_in;
  p.x_prompt = in[0]; p.x_sample = in[1]; p.state = in[2]; p.c = in[3]; p.c_ctx = in[4];
  p.l0_norm1 = in[5]; p.l0_w_in = in[6]; p.l0_decay = in[7]; p.l0_gws = in[8]; p.l0_gb = in[9]; p.l0_w_out = in[10]; p.l0_norm2 = in[11];
  p.l0_w_mod = in[12]; p.l0_b_mod = in[13]; p.l0_f1 = in[14]; p.l0_f2 = in[15];
  p.l1_norm1 = in[16]; p.l1_w_in = in[17]; p.l1_conv = in[18]; p.l1_w_out = in[19]; p.l1_norm2 = in[20]; p.l1_w_mod = in[21]; p.l1_b_mod = in[22];
  p.l1_f1 = in[23]; p.l1_f2 = in[24]; p.final_norm = in[25];
  p.out = (float*)d_out;
  unsigned char* w = (unsigned char*)d_ws; size_t off = 0;
  auto take = [&](size_t bytes) { void* r = w + off; off += (bytes + 255) & ~(size_t)255; return r; };
  p.wt0_in = (u16*)take((size_t)4096 * 1024 * 2); p.wt0_out = (u16*)take((size_t)1024 * 1536 * 2);
  p.wt0_f1 = (u16*)take((size_t)4096 * 1024 * 2); p.wt0_f2 = (u16*)take((size_t)4096 * 1024 * 2);
  p.wt1_in = (u16*)take((size_t)3072 * 1024 * 2); p.wt1_out = (u16*)take((size_t)1024 * 1024 * 2);
  p.wt1_f1 = (u16*)take((size_t)4096 * 1024 * 2); p.wt1_f2 = (u16*)take((size_t)4096 * 1024 * 2);
  p.mod = (float*)take((size_t)2 * 3 * 6144 * 4);
  p.hA = (u16*)take((size_t)NT * 1024 * 2);
  p.proj = (u16*)take((size_t)NT * 4096 * 2);
  p.cat = (u16*)take((size_t)NT * 1536 * 2);
  p.part = (float*)take((size_t)2 * NT * 1024 * 4);
  p.xres = (float*)take((size_t)NT * 1024 * 4);
  p.stimg = (u16*)take((size_t)2 * 4 * 2 * 8 * 128 * 256 * 2);
  p.bar = (unsigned*)take((size_t)(XCD_BAR_WORDS + 7 * 384) * 4);
  hipMemsetAsync(p.bar, 0, (size_t)(XCD_BAR_WORDS + 7 * 384) * 4, stream);
  if (ONE_LAUNCH) {
    int lo = 0, hi = NPHASE; void* args[] = {&p, &lo, &hi};
    hipError_t e = hipLaunchCooperativeKernel((void*)mega, dim3(grid_blocks), dim3(NTHR), args, LDS_BYTES, stream);
    if (e != hipSuccess) fprintf(stderr, "cooperative launch failed: %s (grid %d)\n", hipGetErrorString(e), grid_blocks);
  } else {
    for (int ph = 0; ph < NPHASE; ++ph) hipLaunchKernelGGL(mega, dim3(grid_blocks), dim3(NTHR), LDS_BYTES, stream, p, ph, ph + 1);
  }
}
```

```cpp
#include <hip/hip_runtime.h>
#include <hip/hip_cooperative_groups.h>
#include <cstdio>
namespace cg = cooperative_groups;

typedef unsigned short u16;
typedef float f32x4 __attribute__((ext_vector_type(4)));
typedef unsigned u32x4 __attribute__((ext_vector_type(4)));
typedef unsigned u32x2 __attribute__((ext_vector_type(2)));

constexpr int NT = 6144, DM = 1024, NPROMPT_T = 4096;
constexpr float EPS = 1e-6f;
constexpr int NTHR = 512;

__device__ __forceinline__ float bf2f(u16 b) { return __uint_as_float(((unsigned)b) << 16); }
typedef float f32x2 __attribute__((ext_vector_type(2)));
typedef __bf16 hbf16x2 __attribute__((ext_vector_type(2)));
__device__ __forceinline__ unsigned pk2(float a, float b) { const f32x2 v = {a, b}; const hbf16x2 r = __builtin_convertvector(v, hbf16x2); return __builtin_bit_cast(unsigned, r); }
__device__ __forceinline__ u16 f2bf(float f) { return (u16)(pk2(f, 0.f) & 0xffffu); }
__device__ __forceinline__ float silu_f(float x) { return x * __builtin_amdgcn_rcpf(1.f + __expf(-x)); }
__device__ __forceinline__ float gelu_f(float x) { const float u = -1.5957691216057308f * (x + 0.044715f * x * x * x); return x * __builtin_amdgcn_rcpf(1.f + __expf(u)); }
__device__ __forceinline__ int cond_of(int t) { return t < NPROMPT_T ? 0 : 1 + ((t - NPROMPT_T) >> 10); }
__device__ __forceinline__ float wave_sum(float v) {
#pragma unroll
  for (int o = 32; o > 0; o >>= 1) v += __shfl_xor(v, o);
  return v;
}

struct P {
  const float *x_prompt, *x_sample, *state, *c, *c_ctx;
  const float *l0_norm1, *l0_w_in, *l0_decay, *l0_gws, *l0_gb, *l0_w_out, *l0_norm2, *l0_w_mod, *l0_b_mod, *l0_f1, *l0_f2;
  const float *l1_norm1, *l1_w_in, *l1_conv, *l1_w_out, *l1_norm2, *l1_w_mod, *l1_b_mod, *l1_f1, *l1_f2, *final_norm;
  float* out;
  u16 *wt0_in, *wt0_out, *wt0_f1, *wt0_f2, *wt1_in, *wt1_out, *wt1_f1, *wt1_f2;
  float* mod;
  u16* hA;
  u16* proj;
  u16* cat;
  float* part;
  float* xres;
  u16* stimg;
  unsigned* bar;
};

__device__ __forceinline__ unsigned xb_ld(unsigned* p)              { return __hip_atomic_load(p, __ATOMIC_RELAXED, __HIP_MEMORY_SCOPE_AGENT); }
__device__ __forceinline__ unsigned xb_add(unsigned* p, unsigned v) { return __hip_atomic_fetch_add(p, v, __ATOMIC_RELAXED, __HIP_MEMORY_SCOPE_AGENT); }
#define XB_TMO      128
#define XB_SPIN_CAP (1u << 18)
#define XB_SPIN(cond, bar) do { unsigned _sp = 0; while (cond) { __builtin_amdgcn_s_sleep(1); \
    if ((++_sp & 255u) == 0u) { if (xb_ld(&(bar)[XB_TMO])) break; if (_sp > XB_SPIN_CAP) { atomicAdd(&(bar)[XB_TMO], 1u); break; } } } } while (0)

__device__ __forceinline__ __amdgpu_buffer_rsrc_t mk_rsrc(void* p, unsigned bytes) { return __builtin_amdgcn_make_buffer_rsrc(p, 0, (int)bytes, 0x00020000); }

__device__ __forceinline__ void transpose_tile(const float* __restrict__ W, int K, int N, u16* __restrict__ Wt, int tile, float* lds) {
  const int tn = N / 256; const int k0 = (tile / tn) * 64, n0 = (tile % tn) * 256;
  const int tid = threadIdx.x;
  float (*T)[257] = (float (*)[257])lds;
  __syncthreads();
  {
    const int r = tid >> 6, c4 = (tid & 63) * 4;
    f32x4 v[8];
#pragma unroll
    for (int i = 0; i < 8; ++i) v[i] = *(const f32x4*)(W + (size_t)(k0 + r + 8 * i) * N + n0 + c4);
#pragma unroll
    for (int i = 0; i < 8; ++i) { T[r + 8 * i][c4 + 0] = v[i][0]; T[r + 8 * i][c4 + 1] = v[i][1]; T[r + 8 * i][c4 + 2] = v[i][2]; T[r + 8 * i][c4 + 3] = v[i][3]; }
  }
  __syncthreads();
  {
    const int kk = (tid & 7) * 8;
#pragma unroll
    for (int ps = 0; ps < 4; ++ps) {
      const int nn = (tid >> 3) + 64 * ps;
      u32x4 o;
      o[0] = pk2(T[kk + 0][nn], T[kk + 1][nn]); o[1] = pk2(T[kk + 2][nn], T[kk + 3][nn]);
      o[2] = pk2(T[kk + 4][nn], T[kk + 5][nn]); o[3] = pk2(T[kk + 6][nn], T[kk + 7][nn]);
      *(u32x4*)(Wt + (size_t)(n0 + nn) * K + k0 + kk) = o;
    }
  }
}

__device__ __forceinline__ void adaln_item(const P& p, int item, float* lds) {
  const int l = item / 96, n0 = (item % 96) * 64;
  const float* W = l ? p.l1_w_mod : p.l0_w_mod; const float* B = l ? p.l1_b_mod : p.l0_b_mod;
  const int tid = threadIdx.x;
  float* sc = lds;
  float* red = lds + 3072;
  __syncthreads();
  for (int i = tid; i < 3072; i += NTHR) {
    const int c = i >> 10, k = i & 1023;
    const float v = c == 0 ? p.c_ctx[k] : p.c[(c - 1) * 1024 + k];
    sc[i] = silu_f(v);
  }
  __syncthreads();
  const int cg4 = tid & 15, rg = tid >> 4;
  float acc[3][4] = {};
#pragma unroll 8
  for (int it = 0; it < 32; ++it) {
    const int k = it * 32 + rg;
    const f32x4 w = *(const f32x4*)(W + (size_t)k * 6144 + n0 + cg4 * 4);
#pragma unroll
    for (int c = 0; c < 3; ++c) { const float s = sc[c * 1024 + k];
#pragma unroll
      for (int e = 0; e < 4; ++e) acc[c][e] += s * w[e]; }
  }
#pragma unroll
  for (int c = 0; c < 3; ++c)
#pragma unroll
    for (int e = 0; e < 4; ++e) red[(rg * 3 + c) * 64 + cg4 * 4 + e] = acc[c][e];
  __syncthreads();
  if (tid < 192) {
    const int c = tid >> 6, n = tid & 63; float s = B[n0 + n];
    for (int r = 0; r < 32; ++r) s += red[(r * 3 + c) * 64 + n];
    p.mod[(size_t)(l * 3 + c) * 6144 + n0 + n] = s;
  }
}

__device__ __forceinline__ void phase_prep(const P& p, float* lds) {
  for (int it = blockIdx.x; it < 96 + 256; it += gridDim.x) {
    if (it < 96) adaln_item(p, it, lds); else transpose_tile(p.l0_w_in, 1024, 4096, p.wt0_in, it - 96, lds);
  }
}
__device__ __forceinline__ void phase_prep2(const P& p, float* lds, int group, int first_want) {
  const int first = (int)gridDim.x >= 256 ? first_want : 0, nblk = (int)gridDim.x - first;
  if ((int)blockIdx.x < first) return;
  const int total = group == 0 ? 96 + 96 + 256 + 256 : (group == 1 ? 192 + 64 + 256 : 256);
  for (int it = (int)blockIdx.x - first; it < total; it += nblk) {
    int i = it;
    if (group == 0) {
      if (i < 96) { adaln_item(p, 96 + i, lds); continue; } i -= 96;
      if (i < 96) { transpose_tile(p.l0_w_out, 1536, 1024, p.wt0_out, i, lds); continue; } i -= 96;
      if (i < 256) { transpose_tile(p.l0_f1, 1024, 4096, p.wt0_f1, i, lds); continue; } i -= 256;
      transpose_tile(p.l0_f2, 4096, 1024, p.wt0_f2, i, lds);
    } else if (group == 1) {
      if (i < 192) { transpose_tile(p.l1_w_in, 1024, 3072, p.wt1_in, i, lds); continue; } i -= 192;
      if (i < 64) { transpose_tile(p.l1_w_out, 1024, 1024, p.wt1_out, i, lds); continue; } i -= 64;
      transpose_tile(p.l1_f2, 4096, 1024, p.wt1_f2, i, lds);
    } else {
      transpose_tile(p.l1_f1, 1024, 4096, p.wt1_f1, i, lds);
    }
  }
}

struct NormArgs {
  const float* xin0; const float* xin1;
  const float* p0; const float* p1; const float* gate;
  float* xout; const float* nw; const float* sh; const float* sc;
  u16* hout; float* fout;
};
__device__ __forceinline__ void norm_row(const NormArgs& a, int t, int lane) {
  {
    const int c = cond_of(t);
    const float* xr = t < NPROMPT_T ? a.xin0 + (size_t)t * DM : a.xin1 + (size_t)(t - NPROMPT_T) * DM;
    f32x4 x[4]; float ss = 0.f;
#pragma unroll
    for (int i = 0; i < 4; ++i) {
      const int col = lane * 4 + 256 * i;
      x[i] = *(const f32x4*)(xr + col);
      if (a.p0) {
        const u32x2 q0 = *(const u32x2*)((const u16*)a.p0 + (size_t)t * DM + col), q1 = *(const u32x2*)((const u16*)a.p0 + (size_t)(NT + t) * DM + col);
        const f32x4 g = *(const f32x4*)(a.gate + (size_t)c * 6144 + col);
        f32x4 ps;
        ps[0] = __uint_as_float(q0[0] << 16) + __uint_as_float(q1[0] << 16); ps[1] = __uint_as_float(q0[0] & 0xffff0000u) + __uint_as_float(q1[0] & 0xffff0000u);
        ps[2] = __uint_as_float(q0[1] << 16) + __uint_as_float(q1[1] << 16); ps[3] = __uint_as_float(q0[1] & 0xffff0000u) + __uint_as_float(q1[1] & 0xffff0000u);
        x[i] = x[i] + g * ps;
      }
      if (a.xout) *(f32x4*)(a.xout + (size_t)t * DM + col) = x[i];
      ss += x[i][0] * x[i][0] + x[i][1] * x[i][1] + x[i][2] * x[i][2] + x[i][3] * x[i][3];
    }
    ss = wave_sum(ss);
    const float r = rsqrtf(ss * (1.f / 1024.f) + EPS);
#pragma unroll
    for (int i = 0; i < 4; ++i) {
      const int col = lane * 4 + 256 * i;
      const f32x4 w = *(const f32x4*)(a.nw + col);
      f32x4 y = x[i] * r * w;
      if (a.fout) *(f32x4*)(a.fout + (size_t)t * DM + col) = y;
      if (a.hout) {
        const f32x4 sh = *(const f32x4*)(a.sh + (size_t)c * 6144 + col), sc = *(const f32x4*)(a.sc + (size_t)c * 6144 + col);
        y = y * (1.f + sc) + sh;
        u32x2 o; o[0] = pk2(y[0], y[1]); o[1] = pk2(y[2], y[3]);
        *(u32x2*)(a.hout + (size_t)t * DM + col) = o;
      }
    }
  }
}
template <int R, int NP>
__device__ __forceinline__ void norm_rows(const NormArgs& a, int t0, int lane) {
  const int c = cond_of(t0);
  f32x4 x[R][4];
#pragma unroll
  for (int r = 0; r < R; ++r) {
    const int t = t0 + r;
    const float* xr = t < NPROMPT_T ? a.xin0 + (size_t)t * DM : a.xin1 + (size_t)(t - NPROMPT_T) * DM;
#pragma unroll
    for (int i = 0; i < 4; ++i) x[r][i] = *(const f32x4*)(xr + lane * 4 + 256 * i);
  }
  if (a.p0) {
    u32x2 q[R][NP][4];
#pragma unroll
    for (int r = 0; r < R; ++r)
#pragma unroll
      for (int k = 0; k < NP; ++k)
#pragma unroll
        for (int i = 0; i < 4; ++i) q[r][k][i] = *(const u32x2*)((const u16*)a.p0 + ((size_t)k * NT + t0 + r) * DM + lane * 4 + 256 * i);
#pragma unroll
    for (int i = 0; i < 4; ++i) {
      const f32x4 g = *(const f32x4*)(a.gate + (size_t)c * 6144 + lane * 4 + 256 * i);
#pragma unroll
      for (int r = 0; r < R; ++r) {
        f32x4 ps = {0.f, 0.f, 0.f, 0.f};
#pragma unroll
        for (int k = 0; k < NP; ++k) {
          ps[0] += __uint_as_float(q[r][k][i][0] << 16); ps[1] += __uint_as_float(q[r][k][i][0] & 0xffff0000u);
          ps[2] += __uint_as_float(q[r][k][i][1] << 16); ps[3] += __uint_as_float(q[r][k][i][1] & 0xffff0000u);
        }
        x[r][i] = x[r][i] + g * ps;
      }
    }
  }
  float rs[R];
#pragma unroll
  for (int r = 0; r < R; ++r) {
    float ss = 0.f;
#pragma unroll
    for (int i = 0; i < 4; ++i) {
      if (a.xout) *(f32x4*)(a.xout + (size_t)(t0 + r) * DM + lane * 4 + 256 * i) = x[r][i];
      ss += x[r][i][0] * x[r][i][0] + x[r][i][1] * x[r][i][1] + x[r][i][2] * x[r][i][2] + x[r][i][3] * x[r][i][3];
    }
    ss = wave_sum(ss);
    rs[r] = rsqrtf(ss * (1.f / 1024.f) + EPS);
  }
#pragma unroll
  for (int i = 0; i < 4; ++i) {
    const int col = lane * 4 + 256 * i;
    const f32x4 w = *(const f32x4*)(a.nw + col);
    f32x4 sh = {0.f, 0.f, 0.f, 0.f}, sc = {0.f, 0.f, 0.f, 0.f};
    if (a.hout) { sh = *(const f32x4*)(a.sh + (size_t)c * 6144 + col); sc = *(const f32x4*)(a.sc + (size_t)c * 6144 + col); }
#pragma unroll
    for (int r = 0; r < R; ++r) {
      f32x4 y = x[r][i] * rs[r] * w;
      if (a.fout) *(f32x4*)(a.fout + (size_t)(t0 + r) * DM + col) = y;
      if (a.hout) {
        y = y * (1.f + sc) + sh;
        u32x2 o; o[0] = pk2(y[0], y[1]); o[1] = pk2(y[2], y[3]);
        *(u32x2*)(a.hout + (size_t)(t0 + r) * DM + col) = o;
      }
    }
  }
}
__device__ __forceinline__ void phase_norm(const NormArgs& a) {
  const int wid = threadIdx.x >> 6, lane = threadIdx.x & 63;
  for (int g = blockIdx.x * 8 + wid; g < NT / 4; g += gridDim.x * 8) norm_rows<4, 2>(a, g * 4, lane);
}
struct EpiProj0 {
  u16* O;
  __device__ __forceinline__ void store8(int row, int col, f32x4 v0, f32x4 v1, int) const {
    if (col >= 3072) {
#pragma unroll
      for (int e = 0; e < 4; ++e) { v0[e] = gelu_f(v0[e]); v1[e] = gelu_f(v1[e]); }
    } else if (col >= 2048) {
#pragma unroll
      for (int e = 0; e < 4; ++e) { v0[e] = silu_f(v0[e]); v1[e] = silu_f(v1[e]); }
    } else if (col >= 512 && col < 1024) { v0 = v0 * 0.08838834764831845f; v1 = v1 * 0.08838834764831845f; }
    u32x4 o; o[0] = pk2(v0[0], v0[1]); o[1] = pk2(v0[2], v0[3]); o[2] = pk2(v1[0], v1[1]); o[3] = pk2(v1[2], v1[3]);
    __builtin_amdgcn_raw_buffer_store_b128(o, mk_rsrc(O, (unsigned)NT * 4096u * 2u), (unsigned)(((size_t)row * 4096 + col) * 2), 0, 16);
  }
  __device__ __forceinline__ void store4(int row, int col, f32x4 v, int) const {
    if (col >= 3072) { v[0] = gelu_f(v[0]); v[1] = gelu_f(v[1]); v[2] = gelu_f(v[2]); v[3] = gelu_f(v[3]); }
    else if (col >= 2048) { v[0] = silu_f(v[0]); v[1] = silu_f(v[1]); v[2] = silu_f(v[2]); v[3] = silu_f(v[3]); }
    else if (col >= 512 && col < 1024) v = v * 0.08838834764831845f;
    u32x2 o; o[0] = pk2(v[0], v[1]); o[1] = pk2(v[2], v[3]);
    *(u32x2*)(O + (size_t)row * 4096 + col) = o;
  }
};
struct EpiPart {
  float* Pp;
  __device__ __forceinline__ void store8(int row, int col, f32x4 v0, f32x4 v1, int ks) const {
    u32x4 o; o[0] = pk2(v0[0], v0[1]); o[1] = pk2(v0[2], v0[3]); o[2] = pk2(v1[0], v1[1]); o[3] = pk2(v1[2], v1[3]);
    *(u32x4*)((u16*)Pp + ((size_t)ks * NT + row) * DM + col) = o;
  }
};
struct EpiRelu2 {
  u16* O;
  __device__ __forceinline__ void store8(int row, int col, f32x4 v0, f32x4 v1, int) const {
#pragma unroll
    for (int e = 0; e < 4; ++e) { const float r0 = fmaxf(v0[e], 0.f), r1 = fmaxf(v1[e], 0.f); v0[e] = r0 * r0; v1[e] = r1 * r1; }
    u32x4 o; o[0] = pk2(v0[0], v0[1]); o[1] = pk2(v0[2], v0[3]); o[2] = pk2(v1[0], v1[1]); o[3] = pk2(v1[2], v1[3]);
    *(u32x4*)(O + (size_t)row * 4096 + col) = o;
  }
  __device__ __forceinline__ void store4(int row, int col, f32x4 v, int) const {
#pragma unroll
    for (int e = 0; e < 4; ++e) { const float r = fmaxf(v[e], 0.f); v[e] = r * r; }
    u32x2 o; o[0] = pk2(v[0], v[1]); o[1] = pk2(v[2], v[3]);
    *(u32x2*)(O + (size_t)row * 4096 + col) = o;
  }
};
struct EpiPartW {
  __amdgpu_buffer_rsrc_t rs;
  __device__ __forceinline__ void store8(int row, int col, f32x4 v0, f32x4 v1, int ks) const {
    u32x4 o; o[0] = pk2(v0[0], v0[1]); o[1] = pk2(v0[2], v0[3]); o[2] = pk2(v1[0], v1[1]); o[3] = pk2(v1[2], v1[3]);
    __builtin_amdgcn_raw_buffer_store_b128(o, rs, (unsigned)((((size_t)ks * NT + row) * DM + col) * 2), 0, 16);
  }
};
struct EpiRelu2W {
  __amdgpu_buffer_rsrc_t rs;
  __device__ __forceinline__ void store8(int row, int col, f32x4 v0, f32x4 v1, int) const {
#pragma unroll
    for (int e = 0; e < 4; ++e) { const float r0 = fmaxf(v0[e], 0.f), r1 = fmaxf(v1[e], 0.f); v0[e] = r0 * r0; v1[e] = r1 * r1; }
    u32x4 o; o[0] = pk2(v0[0], v0[1]); o[1] = pk2(v0[2], v0[3]); o[2] = pk2(v1[0], v1[1]); o[3] = pk2(v1[2], v1[3]);
    __builtin_amdgcn_raw_buffer_store_b128(o, rs, (unsigned)(((size_t)row * 4096 + col) * 2), 0, 16);
  }
};
struct EpiPlain {
  u16* O; int ld;
  __device__ __forceinline__ void store8(int row, int col, f32x4 v0, f32x4 v1, int) const {
    u32x4 o; o[0] = pk2(v0[0], v0[1]); o[1] = pk2(v0[2], v0[3]); o[2] = pk2(v1[0], v1[1]); o[3] = pk2(v1[2], v1[3]);
    __builtin_amdgcn_raw_buffer_store_b128(o, mk_rsrc(O, (unsigned)NT * 4096u * 2u), (unsigned)(((size_t)row * ld + col) * 2), 0, 16);
  }
  __device__ __forceinline__ void store4(int row, int col, f32x4 v, int) const {
    u32x2 o; o[0] = pk2(v[0], v[1]); o[1] = pk2(v[2], v[3]);
    *(u32x2*)(O + (size_t)row * ld + col) = o;
  }
};

template <class Epi>
__device__ __forceinline__ void phase_gemm_naive(const u16* __restrict__ A, const u16* __restrict__ Bt, int M, int N, int K, int ksplit, const Epi& E, float* lds) {
  float (*As)[33] = (float (*)[33])lds;
  float (*Bs)[33] = (float (*)[33])(lds + 128 * 33);
  const int tm = M / 128, tn = N / 64, total = tm * tn * ksplit, kper = K / ksplit;
  const int tid = threadIdx.x, r = tid >> 2, cq = tid & 3;
  for (int it = blockIdx.x; it < total; it += gridDim.x) {
    const int ks = it / (tm * tn), rem = it % (tm * tn), m0 = (rem / tn) * 128, n0 = (rem % tn) * 64;
    float acc[4][4] = {};
    for (int k0 = ks * kper; k0 < (ks + 1) * kper; k0 += 32) {
      __syncthreads();
      {
        const int kc = (tid & 3) * 8;
        const u32x4 va = *(const u32x4*)(A + (size_t)(m0 + r) * K + k0 + kc);
#pragma unroll
        for (int e = 0; e < 4; ++e) { As[r][kc + 2 * e] = __uint_as_float(va[e] << 16); As[r][kc + 2 * e + 1] = __uint_as_float(va[e] & 0xffff0000u); }
        if (tid < 256) {
          const u32x4 vb = *(const u32x4*)(Bt + (size_t)(n0 + r) * K + k0 + kc);
#pragma unroll
          for (int e = 0; e < 4; ++e) { Bs[r][kc + 2 * e] = __uint_as_float(vb[e] << 16); Bs[r][kc + 2 * e + 1] = __uint_as_float(vb[e] & 0xffff0000u); }
        }
      }
      __syncthreads();
#pragma unroll 4
      for (int k = 0; k < 32; ++k) {
        const float a = As[r][k];
#pragma unroll
        for (int jj = 0; jj < 4; ++jj)
#pragma unroll
          for (int e = 0; e < 4; ++e) acc[jj][e] += a * Bs[cq * 4 + 16 * jj + e][k];
      }
    }
#pragma unroll
    for (int jj = 0; jj < 4; ++jj) { f32x4 v = {acc[jj][0], acc[jj][1], acc[jj][2], acc[jj][3]}; E.store4(m0 + r, n0 + cq * 4 + 16 * jj, v, ks); }
  }
}


namespace pg8 {
#define PG8_LAS __attribute__((address_space(3)))
typedef short bf16x8 __attribute__((ext_vector_type(8)));
constexpr int BM = 256, BK = 64, HALF = 128, HTB = HALF * BK * 2, STAGE_BYTES = 8 * HTB, NXCD = 8, WGM = 8;
__device__ __forceinline__ int lds_byte(int r, int c) { const int st = (r >> 4) * 2 + (c >> 5), rr = r & 15, cc = c & 31, ob = rr * 64 + cc * 2; return st * 1024 + (ob ^ (((ob >> 9) & 1) << 5)); }
__device__ __forceinline__ int perm32(int rho) { const int n = rho >> 4, i = rho & 15; return 8 * (i >> 2) + 4 * n + (i & 3); }
__device__ __forceinline__ void stage_rc(int b, int& R, int& C) { const int st = b / 1024, sb = b % 1024, swz = sb ^ (((sb >> 9) & 1) << 5); R = (st >> 1) * 16 + swz / 64; C = (st & 1) * 32 + (swz % 64) / 2; }
struct Unit { int pm, pn, ks; };
struct Gemm { const u16* A; const u16* Bt; int M, N, K, ksplit; };
struct Order {
  int nM, nN, ntile, nwg, G, c;
  __device__ void init(int M, int N, int ksplit, int G_, int c_) { nM = M / BM; nN = N / BM; ntile = nM * nN; nwg = ntile * ksplit; G = G_; c = c_; }
  __device__ bool next(int i, Unit& u) const {
    const int L = i * G + c; if (L >= nwg) return false;
    u.ks = L / ntile; int wgid = L % ntile;
    { const int q = ntile / NXCD, r = ntile % NXCD, xcd = wgid % NXCD, off = wgid / NXCD; wgid = (xcd < r ? xcd * (q + 1) : r * (q + 1) + (xcd - r) * q) + off; }
    const int nig = WGM * nN, gid = wgid / nig, fm = gid * WGM, gsz = (nM - fm) < WGM ? (nM - fm) : WGM;
    u.pm = fm + ((wgid % nig) % gsz); u.pn = (wgid % nig) / gsz; return true;
  }
};
template <class Epi>
__device__ __forceinline__ void run_epi(const Epi& E, const f32x4 (&acc)[2][2][4][2], const Unit& u, int wr, int wc, int fr, int fq) {
  const int row0 = u.pm * BM + wr * 64 + fr, col0 = u.pn * BM + wc * 32 + 8 * fq;
#pragma unroll
  for (int ai = 0; ai < 2; ++ai)
#pragma unroll
    for (int m = 0; m < 4; ++m)
#pragma unroll
      for (int bj = 0; bj < 2; ++bj) E.store8(row0 + ai * HALF + m * 16, col0 + bj * HALF, acc[ai][bj][m][0], acc[ai][bj][m][1], u.ks);
}
struct OneUnit { Unit u; __device__ __forceinline__ bool next(int i, Unit& o) const { if (i) return false; o = u; return true; } };
struct FfnOrder1 {
  int c;
  __device__ __forceinline__ bool next(int i, Unit& u) const {
    const int x = c & 7; u.ks = 0;
    if (c >= 128) { if (i) return false; const int oj = (c - 128) >> 3; u.pm = 2 * (x >> 1) + (oj >> 3); u.pn = (x & 1) * 8 + (oj & 7); return true; }
    if (i > 1) return false;
    const int t = i * 16 + (c >> 3); u.pm = 8 + 4 * (x >> 1) + (t >> 3); u.pn = (x & 1) * 8 + (t & 7); return true;
  }
};
struct L1InOrder {
  int c;
  __device__ __forceinline__ bool next(int i, Unit& u) const {
    u.ks = 0;
    if (c >= 40) { if (i) return false; const int idx = c - 40; u.pm = idx / 12; u.pn = idx % 12; return true; }
    if (c >= 36 || i > 1) return false;
    const int t = i * 36 + c; u.pm = 18 + t / 12; u.pn = t % 12; return true;
  }
};
template <class Epi, class Sched>
__device__ __forceinline__ void gemm_phase(PG8_LAS unsigned char* lds, const Gemm g, const Sched& S, const Epi& E) {
  const int tid = threadIdx.x, wid = __builtin_amdgcn_readfirstlane(tid >> 6), lane = tid & 63, wr = wid >> 2, wc = wid & 3, fr = lane & 15, fq = lane >> 4;
  const int K = g.K, kper = g.K / g.ksplit, nt = kper / BK;
  unsigned voffA[2], voffB[2];
#pragma unroll
  for (int i = 0; i < 2; ++i) { int R, C; stage_rc(tid * 16 + i * 8192, R, C); const int Rb = (R & ~31) + perm32(R & 31);
    voffA[i] = (unsigned)(R * K + C) * 2u; voffB[i] = (unsigned)(Rb * K + C) * 2u; }
  const size_t kstep = (size_t)(BK * 2);
  const size_t hstep = (size_t)HALF * K * 2;
  const size_t tstep = 2 * hstep;
  const size_t ksbytes = (size_t)kper * 2;
  const unsigned ldsw = (unsigned)wid * 1024u;
  const int aoff = lds_byte(wr * 64 + fr, fq * 8), boff = lds_byte(wc * 32 + fr, fq * 8);
#define PG8_SA(b, h) (((b) * 2 + (h)) * HTB)
#define PG8_SB(b, h) ((4 + (b) * 2 + (h)) * HTB)
#define PG8_STAGE(bufoff, gbase, voff) do { _Pragma("unroll") for (int _i = 0; _i < 2; ++_i) \
    __builtin_amdgcn_global_load_lds((const unsigned*)((const char*)(gbase) + (voff)[_i]), (PG8_LAS unsigned*)(lds + (bufoff) + ldsw + _i * 8192), 16, 0, 0); } while (0)
#define PG8_LDA(dst, b, h) do { _Pragma("unroll") for (int m = 0; m < 4; ++m) _Pragma("unroll") for (int k = 0; k < 2; ++k) dst[m][k] = *(const PG8_LAS bf16x8*)(lds + PG8_SA(b, h) + aoff + m * 2048 + k * 1024); } while (0)
#define PG8_LDB(dst, b, h) do { _Pragma("unroll") for (int n = 0; n < 2; ++n) _Pragma("unroll") for (int k = 0; k < 2; ++k) dst[n][k] = *(const PG8_LAS bf16x8*)(lds + PG8_SB(b, h) + boff + n * 2048 + k * 1024); } while (0)
#define PG8_MMA(ai, bj, At, Bt) do { __builtin_amdgcn_s_setprio(1); _Pragma("unroll") for (int m = 0; m < 4; ++m) _Pragma("unroll") for (int n = 0; n < 2; ++n) _Pragma("unroll") for (int k = 0; k < 2; ++k) \
    acc[ai][bj][m][n] = __builtin_amdgcn_mfma_f32_16x16x32_bf16(Bt[n][k], At[m][k], acc[ai][bj][m][n], 0, 0, 0); __builtin_amdgcn_s_setprio(0); } while (0)
#define PG8_WAIT_V(n) asm volatile("s_waitcnt vmcnt(" #n ")" ::: "memory")
#define PG8_WAIT_L(n) asm volatile("s_waitcnt lgkmcnt(" #n ")" ::: "memory")
#define PG8_BAR __builtin_amdgcn_s_barrier()
#define PG8_SCHED __builtin_amdgcn_sched_barrier(0)
  Unit cur, nxt; int ui = 0;
  if (!S.next(0, cur)) return;
  f32x4 acc[2][2][4][2];
#pragma unroll
  for (int a = 0; a < 2; ++a)
#pragma unroll
    for (int b = 0; b < 2; ++b)
#pragma unroll
      for (int m = 0; m < 4; ++m)
#pragma unroll
        for (int n = 0; n < 2; ++n) acc[a][b][m][n] = (f32x4){0.f, 0.f, 0.f, 0.f};
  bf16x8 At[4][2], B0[2][2], B1[2][2];
  const char* cA = (const char*)g.A + (size_t)cur.pm * tstep + (size_t)cur.ks * ksbytes; const char* cB = (const char*)g.Bt + (size_t)cur.pn * tstep + (size_t)cur.ks * ksbytes;
  PG8_STAGE(PG8_SB(0, 0), cB, voffB); PG8_STAGE(PG8_SA(0, 0), cA, voffA); PG8_STAGE(PG8_SB(0, 1), cB + hstep, voffB); PG8_STAGE(PG8_SA(0, 1), cA + hstep, voffA);
  if (wr == 1) PG8_BAR;
  PG8_WAIT_V(4); PG8_BAR;
  PG8_STAGE(PG8_SB(1, 0), cB + kstep, voffB); PG8_STAGE(PG8_SA(1, 0), cA + kstep, voffA); PG8_STAGE(PG8_SB(1, 1), cB + hstep + kstep, voffB);
  PG8_WAIT_V(6); PG8_BAR;
  for (;;) {
    const bool has_next = S.next(ui + 1, nxt);
    const char* nA = has_next ? (const char*)g.A + (size_t)nxt.pm * tstep + (size_t)nxt.ks * ksbytes : cA; const char* nB = has_next ? (const char*)g.Bt + (size_t)nxt.pn * tstep + (size_t)nxt.ks * ksbytes : cB;
    for (int t = 0; t < nt; t += 2) {
      const bool last = (t == nt - 2);
      const char* a1 = cA + (size_t)(t + 1) * kstep;
      const char* a2 = last ? nA : cA + (size_t)(t + 2) * kstep; const char* b2 = last ? nB : cB + (size_t)(t + 2) * kstep;
      const char* a3 = a2 + kstep; const char* b3 = b2 + kstep;
      PG8_LDB(B0, 0, 0); PG8_SCHED; PG8_LDA(At, 0, 0); PG8_STAGE(PG8_SA(1, 1), a1 + hstep, voffA);
      PG8_WAIT_L(8); PG8_BAR; PG8_WAIT_L(0); PG8_MMA(0, 0, At, B0); PG8_BAR; PG8_SCHED;
      PG8_LDB(B1, 0, 1); PG8_STAGE(PG8_SB(0, 0), b2, voffB);
      PG8_BAR; PG8_WAIT_L(0); PG8_MMA(0, 1, At, B1); PG8_BAR;
      PG8_LDA(At, 0, 1); PG8_STAGE(PG8_SA(0, 0), a2, voffA);
      PG8_BAR; PG8_WAIT_L(0); PG8_MMA(1, 0, At, B0); PG8_BAR; PG8_SCHED;
      PG8_STAGE(PG8_SB(0, 1), b2 + hstep, voffB);
      PG8_WAIT_V(6); PG8_BAR; PG8_MMA(1, 1, At, B1); PG8_BAR;
      PG8_LDB(B0, 1, 0); PG8_SCHED; PG8_LDA(At, 1, 0); PG8_STAGE(PG8_SA(0, 1), a2 + hstep, voffA);
      PG8_WAIT_L(8); PG8_BAR; PG8_WAIT_L(0); PG8_MMA(0, 0, At, B0); PG8_BAR; PG8_SCHED;
      PG8_LDB(B1, 1, 1); PG8_STAGE(PG8_SB(1, 0), b3, voffB);
      PG8_BAR; PG8_WAIT_L(0); PG8_MMA(0, 1, At, B1); PG8_BAR;
      PG8_LDA(At, 1, 1); PG8_STAGE(PG8_SA(1, 0), a3, voffA);
      PG8_BAR; PG8_WAIT_L(0); PG8_MMA(1, 0, At, B0); PG8_BAR; PG8_SCHED;
      PG8_STAGE(PG8_SB(1, 1), b3 + hstep, voffB);
      PG8_WAIT_V(6); PG8_BAR; PG8_MMA(1, 1, At, B1); PG8_BAR;
    }
    run_epi(E, acc, cur, wr, wc, fr, fq);
    if (!has_next) break;
#pragma unroll
    for (int a = 0; a < 2; ++a)
#pragma unroll
      for (int b = 0; b < 2; ++b)
#pragma unroll
        for (int m = 0; m < 4; ++m)
#pragma unroll
          for (int n = 0; n < 2; ++n) acc[a][b][m][n] = (f32x4){0.f, 0.f, 0.f, 0.f};
    cur = nxt; cA = nA; cB = nB; ++ui;
  }
  PG8_WAIT_V(0);
  if (wr == 0) PG8_BAR;
  PG8_BAR;
#undef PG8_SA
#undef PG8_SB
#undef PG8_STAGE
#undef PG8_LDA
#undef PG8_LDB
#undef PG8_MMA
#undef PG8_WAIT_V
#undef PG8_WAIT_L
#undef PG8_BAR
#undef PG8_SCHED
}
}
template <class Epi>
__device__ __forceinline__ void phase_gemm(const u16* A, const u16* Bt, int M, int N, int K, int ksplit, const Epi& E, float* lds) {
  __syncthreads();
  pg8::Gemm g{A, Bt, M, N, K, ksplit};
  pg8::Order S; S.init(M, N, ksplit, (int)gridDim.x, (int)blockIdx.x);
  pg8::gemm_phase(( __attribute__((address_space(3))) unsigned char*)lds, g, S, E);
  __syncthreads();
}

__device__ __forceinline__ void seq_of_token(int t, int& s0, int& L, int& sb) {
  if (t < NPROMPT_T) { s0 = t & ~255; L = 256; sb = -1; } else { sb = (t - NPROMPT_T) >> 10; s0 = NPROMPT_T + (sb << 10); L = 1024; }
}
__device__ __forceinline__ void ret_item_naive(const P& p, int item, float* lds) {
  const int tg = item >> 2, h = item & 3, t0 = tg * 16, tid = threadIdx.x;
  int s0, L, sb; seq_of_token(t0, s0, L, sb);
  float* scr = lds;
  float* qs = lds + 16 * 1024;
  float* red = qs + 16 * 128;
  const float lgf = log1pf(-exp2f(-p.l0_decay[h])), lgb = log1pf(-exp2f(-p.l0_decay[4 + h]));
  __syncthreads();
  for (int i = tid; i < 16 * 128; i += NTHR) qs[i] = bf2f(p.proj[(size_t)(t0 + (i >> 7)) * 4096 + h * 128 + (i & 127)]);
  __syncthreads();
  for (int j = tid; j < L; j += NTHR) {
    float acc[16] = {};
    const u16* kr = p.proj + (size_t)(s0 + j) * 4096 + 512 + h * 128;
    for (int d0 = 0; d0 < 128; d0 += 8) {
      const u32x4 kv = *(const u32x4*)(kr + d0);
      float kf[8];
#pragma unroll
      for (int e = 0; e < 4; ++e) { kf[2 * e] = __uint_as_float(kv[e] << 16); kf[2 * e + 1] = __uint_as_float(kv[e] & 0xffff0000u); }
#pragma unroll
      for (int i = 0; i < 16; ++i)
#pragma unroll
        for (int e = 0; e < 8; ++e) acc[i] += qs[i * 128 + d0 + e] * kf[e];
    }
#pragma unroll
    for (int i = 0; i < 16; ++i) {
      const int d = (t0 + i - s0) - j;
      const float w = d > 0 ? __expf((float)d * lgf) : (d < 0 ? __expf((float)(-d) * lgb) : 2.f);
      scr[i * 1024 + j] = acc[i] * w;
    }
  }
  __syncthreads();
  const int dv = tid & 255, ig = tid >> 8;
  float o[8] = {};
  for (int j = 0; j < L; ++j) {
    const float v = bf2f(p.proj[(size_t)(s0 + j) * 4096 + 1024 + h * 256 + dv]);
#pragma unroll
    for (int e = 0; e < 8; ++e) o[e] += scr[(ig * 8 + e) * 1024 + j] * v;
  }
  if (sb >= 0) {
    const float* Sf = p.state + ((size_t)(sb * 2 + 0) * 4 + h) * 128 * 256;
    const float* Sb = p.state + ((size_t)(sb * 2 + 1) * 4 + h) * 128 * 256;
    float af[8] = {}, ab[8] = {};
    for (int dk = 0; dk < 128; ++dk) {
      const float sf = Sf[dk * 256 + dv], sbv = Sb[dk * 256 + dv];
#pragma unroll
      for (int e = 0; e < 8; ++e) { const float q = qs[(ig * 8 + e) * 128 + dk]; af[e] += q * sf; ab[e] += q * sbv; }
    }
#pragma unroll
    for (int e = 0; e < 8; ++e) {
      const int pos = t0 + ig * 8 + e - s0;
      o[e] += __expf((float)(pos + 1) * lgf) * af[e] + __expf((float)(L - pos) * lgb) * ab[e];
    }
  }
  const int wid = tid >> 6, lane = tid & 63;
#pragma unroll
  for (int e = 0; e < 8; ++e) { const float s = wave_sum(o[e] * o[e]); if (lane == 0) red[wid * 8 + e] = s; }
  __syncthreads();
#pragma unroll
  for (int e = 0; e < 8; ++e) {
    const float ss = red[(ig * 4 + 0) * 8 + e] + red[(ig * 4 + 1) * 8 + e] + red[(ig * 4 + 2) * 8 + e] + red[(ig * 4 + 3) * 8 + e];
    const float r = rsqrtf(ss * (1.f / 256.f) + EPS);
    const int t = t0 + ig * 8 + e;
    const float g = bf2f(p.proj[(size_t)t * 4096 + 2048 + h * 256 + dv]);
    p.cat[(size_t)t * 1536 + h * 256 + dv] = f2bf(o[e] * r * g);
  }
}
__device__ __forceinline__ void state_item_naive(const P& p, int item) {
  const int b = item >> 3, h = (item >> 1) & 3, dir = item & 1, tid = threadIdx.x;
  const float lg = log1pf(-exp2f(-p.l0_decay[dir * 4 + h]));
  const int dv = tid & 255;
  float* o = p.out + (size_t)NT * DM + ((size_t)(b * 2 + dir) * 4 + h) * 128 * 256;
  for (int pass = 0; pass < 4; ++pass) {
    const int dk0 = (tid >> 8) * 64 + pass * 16;
    float acc[16] = {};
    for (int s = 0; s < 256; ++s) {
      const int t = b * 256 + s;
      const float w = dir == 0 ? __expf((float)(255 - s) * lg) : __expf((float)s * lg);
      const float v = bf2f(p.proj[(size_t)t * 4096 + 1024 + h * 256 + dv]) * w;
      const u16* kr = p.proj + (size_t)t * 4096 + 512 + h * 128 + dk0;
#pragma unroll
      for (int e = 0; e < 16; ++e) acc[e] += bf2f(kr[e]) * v;
    }
#pragma unroll
    for (int e = 0; e < 16; ++e) o[(dk0 + e) * 256 + dv] = acc[e];
  }
}
__device__ __forceinline__ void gmlp_item_naive(const P& p, int item, float* lds) {
  const int ci = item >> 2, g = item & 3, tid = threadIdx.x, wid = tid >> 6, lane = tid & 63;
  float* zn = lds;
  float* mu = lds + 128 * 128;
  float* rs = mu + 128;
  __syncthreads();
  for (int q = wid; q < 128; q += 8) {
    const u32x4 v = *(const u32x4*)(p.proj + (size_t)(ci * 128 + q) * 4096 + 3584 + lane * 8);
    float s = 0.f, s2 = 0.f;
#pragma unroll
    for (int e = 0; e < 4; ++e) { const float a = __uint_as_float(v[e] << 16), b = __uint_as_float(v[e] & 0xffff0000u); s += a + b; s2 += a * a + b * b; }
    s = wave_sum(s); s2 = wave_sum(s2);
    if (lane == 0) { const float m = s * (1.f / 512.f); const float var = fmaxf(s2 * (1.f / 512.f) - m * m, 0.f); mu[q] = m; rs[q] = rsqrtf(var + EPS); }
  }
  __syncthreads();
  for (int i = tid; i < 128 * 128; i += NTHR) {
    const int q = i >> 7, c = i & 127;
    zn[i] = (bf2f(p.proj[(size_t)(ci * 128 + q) * 4096 + 3584 + g * 128 + c]) - mu[q]) * rs[q];
  }
  __syncthreads();
  const int c = tid & 127, p0 = (tid >> 7) * 32;
  float acc[32] = {};
  const float* W = p.l0_gws + (size_t)g * 128 * 128;
  for (int q = 0; q < 128; ++q) {
    const float z = zn[q * 128 + c];
#pragma unroll
    for (int e = 0; e < 32; ++e) acc[e] += W[(p0 + e) * 128 + q] * z;
  }
#pragma unroll
  for (int e = 0; e < 32; ++e) {
    const int t = ci * 128 + p0 + e;
    const float u = bf2f(p.proj[(size_t)t * 4096 + 3072 + g * 128 + c]);
    p.cat[(size_t)t * 1536 + 1024 + g * 128 + c] = f2bf((acc[e] + p.l0_gb[g * 128 + p0 + e]) * u);
  }
}
__device__ __forceinline__ void phase_mixer_naive(const P& p, float* lds) {
  const int nR = 1536, nS = 128, nG = 192, total = nR + nS + nG;
  for (int it = blockIdx.x; it < total; it += gridDim.x) {
    if (it < nR) ret_item_naive(p, it, lds);
    else if (it < nR + nS) state_item_naive(p, it - nR);
    else gmlp_item_naive(p, it - nR - nS, lds);
  }
}


#define LAS __attribute__((address_space(3)))
typedef short bf16x8 __attribute__((ext_vector_type(8)));
typedef short bf16x4 __attribute__((ext_vector_type(4)));
constexpr int PK = 136;
constexpr int PV = 264;
__device__ __forceinline__ bf16x8 frag_row(const LAS u16* base, int pitch, int r0, int k0, int fr, int fq) {
  return *(const LAS bf16x8*)(base + (r0 + fr) * pitch + k0 + fq * 8);
}
__device__ __forceinline__ bf16x8 frag_tr(const LAS u16* base, int pitch, int k0, int n0, int fr, int fq) {
  const LAS u16* a = base + (k0 + fq * 8 + (fr >> 2)) * pitch + n0 + 4 * (fr & 3);
  const bf16x4 lo = __builtin_amdgcn_ds_read_tr16_b64_v4i16((LAS bf16x4*)a);
  const bf16x4 hi = __builtin_amdgcn_ds_read_tr16_b64_v4i16((LAS bf16x4*)(a + 4 * pitch));
  bf16x8 r; r[0] = lo[0]; r[1] = lo[1]; r[2] = lo[2]; r[3] = lo[3]; r[4] = hi[0]; r[5] = hi[1]; r[6] = hi[2]; r[7] = hi[3];
  return r;
}
__device__ __forceinline__ f32x4 mfma16(bf16x8 a, bf16x8 b, f32x4 c) { return __builtin_amdgcn_mfma_f32_16x16x32_bf16(a, b, c, 0, 0, 0); }
template <int ROWS, int COLS>
__device__ __forceinline__ void tile_to_lds_t(const u16* __restrict__ g, size_t gp, LAS u16* l, int lp) {
  constexpr int CPR = COLS / 8, N = ROWS * CPR / NTHR;
  u32x4 v[N];
#pragma unroll
  for (int k = 0; k < N; ++k) { const int i = threadIdx.x + k * NTHR, r = i / CPR, c = (i % CPR) * 8; v[k] = *(const u32x4*)(g + (size_t)r * gp + c); }
#pragma unroll
  for (int k = 0; k < N; ++k) { const int i = threadIdx.x + k * NTHR, r = i / CPR, c = (i % CPR) * 8; *(LAS u32x4*)(l + r * lp + c) = v[k]; }
}
__device__ __forceinline__ void tile_to_lds(const u16* __restrict__ g, size_t gp, LAS u16* l, int lp, int rows, int cols) {
  if (cols == 128) tile_to_lds_t<128, 128>(g, gp, l, lp); else tile_to_lds_t<128, 256>(g, gp, l, lp);
}

__device__ __forceinline__ void kv_item(const P& p, int item, LAS u16* lds) {
  const int ci = item >> 2, h = item & 3, tid = threadIdx.x, wid = tid >> 6, lane = tid & 63, fr = lane & 15, fq = lane >> 4;
  LAS u16* kbuf = lds; LAS u16* vbuf = lds + 128 * PK;
  __syncthreads();
  tile_to_lds(p.proj + (size_t)ci * 128 * 4096 + 512 + h * 128, 4096, kbuf, PK, 128, 128);
  tile_to_lds(p.proj + (size_t)ci * 128 * 4096 + 1024 + h * 256, 4096, vbuf, PV, 128, 256);
  __syncthreads();
  const int dir = wid >> 2, d0 = (wid & 3) * 32;
  const float lg = log1pf(-exp2f(-p.l0_decay[dir * 4 + h]));
  u16* o = (u16*)p.part + ((size_t)(ci * 4 + h) * 2 + dir) * 128 * 256;
#pragma unroll 1
  for (int nh = 0; nh < 2; ++nh) {
    f32x4 acc[8][2];
#pragma unroll
    for (int m = 0; m < 8; ++m) { acc[m][0] = (f32x4){0.f, 0.f, 0.f, 0.f}; acc[m][1] = (f32x4){0.f, 0.f, 0.f, 0.f}; }
#pragma unroll 1
    for (int ks = 0; ks < 4; ++ks) {
      bf16x8 kb[2];
      kb[0] = frag_tr(kbuf, PK, ks * 32, d0, fr, fq); kb[1] = frag_tr(kbuf, PK, ks * 32, d0 + 16, fr, fq);
#pragma unroll
      for (int j = 0; j < 8; ++j) {
        const int tok = ks * 32 + fq * 8 + j;
        const float w = __expf((float)(dir == 0 ? 127 - tok : tok) * lg);
        kb[0][j] = (short)f2bf(bf2f((u16)kb[0][j]) * w); kb[1][j] = (short)f2bf(bf2f((u16)kb[1][j]) * w);
      }
#pragma unroll
      for (int m = 0; m < 8; ++m) {
        const bf16x8 va = frag_tr(vbuf, PV, ks * 32, nh * 128 + m * 16, fr, fq);
        acc[m][0] = mfma16(va, kb[0], acc[m][0]); acc[m][1] = mfma16(va, kb[1], acc[m][1]);
      }
    }
#pragma unroll
    for (int n = 0; n < 2; ++n) {
      u16* orow = o + (size_t)(d0 + n * 16 + fr) * 256 + nh * 128 + fq * 4;
#pragma unroll
      for (int m = 0; m < 8; ++m) { u32x2 v; v[0] = pk2(acc[m][n][0], acc[m][n][1]); v[1] = pk2(acc[m][n][2], acc[m][n][3]); *(u32x2*)(orow + m * 16) = v; }
    }
  }
}

__device__ __forceinline__ void gmlp_item(const P& p, int item, LAS u16* lds) {
  const int ci = item >> 2, g = item & 3, tid = threadIdx.x, wid = tid >> 6, lane = tid & 63, fr = lane & 15, fq = lane >> 4;
  LAS u16* zn = lds; LAS u16* wsb = lds + 128 * PK; LAS float* mu = (LAS float*)(lds + 2 * 128 * PK); LAS float* rs = mu + 128;
  __syncthreads();
  {
    u32x4 zv[16];
#pragma unroll
    for (int k = 0; k < 16; ++k) zv[k] = *(const u32x4*)(p.proj + (size_t)(ci * 128 + wid + 8 * k) * 4096 + 3584 + lane * 8);
#pragma unroll
    for (int k = 0; k < 16; ++k) {
      float s = 0.f, s2 = 0.f;
#pragma unroll
      for (int e = 0; e < 4; ++e) { const float a = __uint_as_float(zv[k][e] << 16), b = __uint_as_float(zv[k][e] & 0xffff0000u); s += a + b; s2 += a * a + b * b; }
      s = wave_sum(s); s2 = wave_sum(s2);
      if (lane == 0) { const float m = s * (1.f / 512.f); const float var = fmaxf(s2 * (1.f / 512.f) - m * m, 0.f); mu[wid + 8 * k] = m; rs[wid + 8 * k] = rsqrtf(var + EPS); }
    }
  }
  u32x4 zr[4];
#pragma unroll
  for (int k = 0; k < 4; ++k) { const int i = tid + k * NTHR, q = i >> 4, c = (i & 15) * 8; zr[k] = *(const u32x4*)(p.proj + (size_t)(ci * 128 + q) * 4096 + 3584 + g * 128 + c); }
  {
    const float* W = p.l0_gws + (size_t)g * 128 * 128;
    f32x4 wv[8];
#pragma unroll
    for (int k = 0; k < 8; ++k) { const int i = tid + k * NTHR; wv[k] = *(const f32x4*)(W + (i >> 5) * 128 + (i & 31) * 4); }
#pragma unroll
    for (int k = 0; k < 8; ++k) {
      const int i = tid + k * NTHR, r = i >> 5, c = (i & 31) * 4;
      u32x2 o; o[0] = pk2(wv[k][0], wv[k][1]); o[1] = pk2(wv[k][2], wv[k][3]);
      *(LAS u32x2*)(wsb + r * PK + c) = o;
    }
  }
  __syncthreads();
#pragma unroll
  for (int k = 0; k < 4; ++k) {
    const int i = tid + k * NTHR, q = i >> 4, c = (i & 15) * 8;
    const float m = mu[q], r = rs[q];
    u32x4 o;
#pragma unroll
    for (int e = 0; e < 4; ++e) o[e] = pk2((__uint_as_float(zr[k][e] << 16) - m) * r, (__uint_as_float(zr[k][e] & 0xffff0000u) - m) * r);
    *(LAS u32x4*)(zn + q * PK + c) = o;
  }
  __syncthreads();
  f32x4 acc[8];
#pragma unroll
  for (int m = 0; m < 8; ++m) acc[m] = (f32x4){0.f, 0.f, 0.f, 0.f};
#pragma unroll
  for (int ks = 0; ks < 4; ++ks) {
    const bf16x8 wb = frag_row(wsb, PK, wid * 16, ks * 32, fr, fq);
#pragma unroll
    for (int m = 0; m < 8; ++m) acc[m] = mfma16(frag_tr(zn, PK, ks * 32, m * 16, fr, fq), wb, acc[m]);
  }
  {
    const int pr = wid * 16 + fr, t = ci * 128 + pr;
    const float gb = p.l0_gb[g * 128 + pr];
    const u16* urow = p.proj + (size_t)t * 4096 + 3072 + g * 128 + fq * 4;
    u16* orow = p.cat + (size_t)t * 1536 + 1024 + g * 128 + fq * 4;
#pragma unroll
    for (int m = 0; m < 8; ++m) {
      const u32x2 uv = *(const u32x2*)(urow + m * 16);
      u32x2 v;
      v[0] = pk2((acc[m][0] + gb) * __uint_as_float(uv[0] << 16), (acc[m][1] + gb) * __uint_as_float(uv[0] & 0xffff0000u));
      v[1] = pk2((acc[m][2] + gb) * __uint_as_float(uv[1] << 16), (acc[m][3] + gb) * __uint_as_float(uv[1] & 0xffff0000u));
      *(u32x2*)(orow + m * 16) = v;
    }
  }
}
__device__ __forceinline__ void phase_mix_a(const P& p, LAS u16* lds) {
  for (int it = blockIdx.x; it < 384; it += gridDim.x) { if (it < 192) kv_item(p, it, lds); else gmlp_item(p, it - 192, lds); }
}

__device__ __forceinline__ void build_state(const P& p, LAS u16* bbuf, const float* S0, float w0, int cbase, int h, int dir, int c_lo, int c_hi, int c_ref, float lg128) {
  const int tid = threadIdx.x;
#pragma unroll 1
  for (int half = 0; half < 2; ++half) {
    f32x4 a[8];
    const int base = (tid + half * 4096) * 4;
    if (S0) {
#pragma unroll
      for (int k = 0; k < 8; ++k) a[k] = *(const f32x4*)(S0 + base + k * 2048);
#pragma unroll
      for (int k = 0; k < 8; ++k) a[k] = a[k] * w0;
    } else {
#pragma unroll
      for (int k = 0; k < 8; ++k) a[k] = (f32x4){0.f, 0.f, 0.f, 0.f};
    }
#pragma unroll 1
    for (int cc = c_lo; cc < c_hi; ++cc) {
      const int e = dir == 0 ? (c_ref - 1 - cc) : (cc - c_ref - 1);
      const float w = __expf(lg128 * (float)e);
      const float* src = p.part + ((size_t)((cbase + cc) * 4 + h) * 2 + dir) * 128 * 256 + base;
      f32x4 t[8];
#pragma unroll
      for (int k = 0; k < 8; ++k) t[k] = *(const f32x4*)(src + k * 2048);
#pragma unroll
      for (int k = 0; k < 8; ++k) a[k] = a[k] + t[k] * w;
    }
#pragma unroll
    for (int k = 0; k < 8; ++k) {
      const int i = tid + half * 4096 + k * 512, r = i >> 6, c = (i & 63) * 4;
      u32x2 o; o[0] = pk2(a[k][0], a[k][1]); o[1] = pk2(a[k][2], a[k][3]);
      *(LAS u32x2*)(bbuf + r * PV + c) = o;
    }
  }
}
__device__ __forceinline__ void scan_item(const P& p, int item, unsigned* scnt) {
  const int combo = item >> 2, q = item & 3, dir = combo & 1, h = (combo >> 1) & 3, sb = combo >> 3, tid = threadIdx.x;
  const float g = __expf(128.f * log1pf(-exp2f(-p.l0_decay[dir * 4 + h])));
  const float* S0 = p.state + ((size_t)(sb * 2 + dir) * 4 + h) * 128 * 256 + q * 32 * 256;
  const u16* KV = (const u16*)p.part + ((size_t)((32 + sb * 8) * 4 + h) * 2 + dir) * 128 * 256 + q * 32 * 256;
  const __amdgpu_buffer_rsrc_t rs = mk_rsrc(p.stimg, 2u * 4u * 2u * 8u * 128u * 256u * 2u);
  const unsigned obase = (unsigned)((((size_t)combo * 8) * 128 * 256 + q * 32 * 256) * 2);
  float s[2][8]; u32x4 kv[7][2];
#pragma unroll
  for (int k = 0; k < 2; ++k) {
    const f32x4 a = *(const f32x4*)(S0 + (tid + 512 * k) * 8), b2 = *(const f32x4*)(S0 + (tid + 512 * k) * 8 + 4);
    s[k][0] = a[0]; s[k][1] = a[1]; s[k][2] = a[2]; s[k][3] = a[3]; s[k][4] = b2[0]; s[k][5] = b2[1]; s[k][6] = b2[2]; s[k][7] = b2[3];
  }
#pragma unroll
  for (int c = 0; c < 7; ++c)
#pragma unroll
    for (int k = 0; k < 2; ++k) kv[c][k] = *(const u32x4*)(KV + (size_t)(c + dir) * (4 * 2 * 128 * 256) + (tid + 512 * k) * 8);
#pragma unroll
  for (int st = 0; st < 8; ++st) {
    const int c = dir == 0 ? st : 7 - st;
#pragma unroll
    for (int k = 0; k < 2; ++k) {
      if (st > 0) {
        const u32x4 t = kv[dir == 0 ? st - 1 : 7 - st][k];
#pragma unroll
        for (int e = 0; e < 4; ++e) { s[k][2 * e] = s[k][2 * e] * g + __uint_as_float(t[e] << 16); s[k][2 * e + 1] = s[k][2 * e + 1] * g + __uint_as_float(t[e] & 0xffff0000u); }
      }
      u32x4 v; v[0] = pk2(s[k][0], s[k][1]); v[1] = pk2(s[k][2], s[k][3]); v[2] = pk2(s[k][4], s[k][5]); v[3] = pk2(s[k][6], s[k][7]);
      __builtin_amdgcn_raw_buffer_store_b128(v, rs, obase + (unsigned)(((size_t)c * 128 * 256 + (tid + 512 * k) * 8) * 2), 0, 16);
    }
  }
  asm volatile("s_waitcnt vmcnt(0)" ::: "memory");
  __syncthreads();
  if (tid == 0) xb_add(&scnt[combo * 16], 1u);
}
__device__ __forceinline__ void ret_item(const P& p, int item, LAS u16* lds, unsigned* scnt) {
  const int ci = item >> 2, h = item & 3, tid = threadIdx.x, wid = tid >> 6, lane = tid & 63, fr = lane & 15, fq = lane >> 4;
  int sb, lc, n;
  if (ci < 32) { sb = -1; lc = ci & 1; n = 2; } else { sb = (ci - 32) >> 3; lc = (ci - 32) & 7; n = 8; }
  const int cbase = ci - lc;
  const float lgf = log1pf(-exp2f(-p.l0_decay[h])), lgb = log1pf(-exp2f(-p.l0_decay[4 + h]));
  LAS u16* kbuf = lds; LAS u16* bbuf = lds + 128 * PK; LAS float* red = (LAS float*)(lds + 128 * PK + 128 * PV);
  const bool hasF = (sb >= 0) || lc > 0, hasB = (sb >= 0) || lc < n - 1;
  const u16* qg = p.proj + (size_t)ci * 128 * 4096 + h * 128;
  __syncthreads();
  tile_to_lds(p.proj + (size_t)ci * 128 * 4096 + 512 + h * 128, 4096, kbuf, PK, 128, 128);
  __syncthreads();
  {
    f32x4 s[8];
#pragma unroll
    for (int nn = 0; nn < 8; ++nn) s[nn] = (f32x4){0.f, 0.f, 0.f, 0.f};
    bf16x8 qa[4];
#pragma unroll
    for (int ks = 0; ks < 4; ++ks) qa[ks] = *(const bf16x8*)(qg + (size_t)(wid * 16 + fr) * 4096 + ks * 32 + fq * 8);
#pragma unroll
    for (int ks = 0; ks < 4; ++ks) {
#pragma unroll
      for (int nn = 0; nn < 8; ++nn) s[nn] = mfma16(qa[ks], frag_row(kbuf, PK, nn * 16, ks * 32, fr, fq), s[nn]);
    }
    __syncthreads();
    int bd = wid * 16 + fq * 4 - fr;
    asm volatile("" : "+v"(bd));
    LAS u16* prow = kbuf + (wid * 16 + fq * 4) * PK + fr;
#pragma unroll
    for (int nn = 0; nn < 8; ++nn)
#pragma unroll
      for (int j = 0; j < 4; ++j) {
        const int d = bd + j - 16 * nn;
        const float w = d > 0 ? __expf((float)d * lgf) : (d < 0 ? __expf((float)(-d) * lgb) : 2.f);
        prow[j * PK + nn * 16] = f2bf(s[nn][j] * w);
      }
  }
  const int m0 = (wid & 3) * 32, n0 = (wid >> 2) * 128;
  f32x4 acc[2][8];
#pragma unroll
  for (int m = 0; m < 2; ++m)
#pragma unroll
    for (int nn = 0; nn < 8; ++nn) acc[m][nn] = (f32x4){0.f, 0.f, 0.f, 0.f};
  const u16* qrow = qg + (size_t)(m0 + fr) * 4096 + fq * 8;
  if (sb >= 0) {
    if (tid == 0) {
      XB_SPIN(xb_ld(&scnt[((sb * 4 + h) * 2 + 0) * 16]) < 4u || xb_ld(&scnt[((sb * 4 + h) * 2 + 1) * 16]) < 4u, p.bar);
      __builtin_amdgcn_fence(__ATOMIC_ACQUIRE, "agent");
      asm volatile("s_waitcnt vmcnt(0)" ::: "memory");
    }
    __syncthreads();
    tile_to_lds(p.stimg + ((size_t)((sb * 4 + h) * 2 + 0) * 8 + lc) * 128 * 256, 256, bbuf, PV, 128, 256);
    __syncthreads();
  } else if (hasF) {
    tile_to_lds((const u16*)p.part + ((size_t)((cbase + 0) * 4 + h) * 2 + 0) * 128 * 256, 256, bbuf, PV, 128, 256);
    __syncthreads();
  }
  if (hasF) {
    {
      bf16x8 q0[4], q1[4];
#pragma unroll
      for (int ks = 0; ks < 4; ++ks) { q0[ks] = *(const bf16x8*)(qrow + ks * 32); q1[ks] = *(const bf16x8*)(qrow + 16 * 4096 + ks * 32); }
#pragma unroll 1
      for (int ks = 0; ks < 4; ++ks) {
        const bf16x8 a0 = ks == 0 ? q0[0] : (ks == 1 ? q0[1] : (ks == 2 ? q0[2] : q0[3])), a1 = ks == 0 ? q1[0] : (ks == 1 ? q1[1] : (ks == 2 ? q1[2] : q1[3]));
#pragma unroll
        for (int nn = 0; nn < 8; ++nn) {
          const bf16x8 b = frag_tr(bbuf, PV, ks * 32, n0 + nn * 16, fr, fq);
          acc[0][nn] = mfma16(a0, b, acc[0][nn]); acc[1][nn] = mfma16(a1, b, acc[1][nn]);
        }
      }
    }
#pragma unroll
    for (int m = 0; m < 2; ++m)
#pragma unroll
      for (int j = 0; j < 4; ++j) {
        const int il = m0 + m * 16 + fq * 4 + j;
        const float sc = hasB ? __expf((float)(il + 1) * lgf - (float)(128 - il) * lgb) : __expf((float)(il + 1) * lgf);
#pragma unroll
        for (int nn = 0; nn < 8; ++nn) acc[m][nn][j] *= sc;
      }
  }
  if (hasB) {
    __syncthreads();
    if (sb >= 0) tile_to_lds(p.stimg + ((size_t)((sb * 4 + h) * 2 + 1) * 8 + lc) * 128 * 256, 256, bbuf, PV, 128, 256);
    else tile_to_lds((const u16*)p.part + ((size_t)((cbase + 1) * 4 + h) * 2 + 1) * 128 * 256, 256, bbuf, PV, 128, 256);
    __syncthreads();
    {
      bf16x8 q0[4], q1[4];
#pragma unroll
      for (int ks = 0; ks < 4; ++ks) { q0[ks] = *(const bf16x8*)(qrow + ks * 32); q1[ks] = *(const bf16x8*)(qrow + 16 * 4096 + ks * 32); }
#pragma unroll 1
      for (int ks = 0; ks < 4; ++ks) {
        const bf16x8 a0 = ks == 0 ? q0[0] : (ks == 1 ? q0[1] : (ks == 2 ? q0[2] : q0[3])), a1 = ks == 0 ? q1[0] : (ks == 1 ? q1[1] : (ks == 2 ? q1[2] : q1[3]));
#pragma unroll
        for (int nn = 0; nn < 8; ++nn) {
          const bf16x8 b = frag_tr(bbuf, PV, ks * 32, n0 + nn * 16, fr, fq);
          acc[0][nn] = mfma16(a0, b, acc[0][nn]); acc[1][nn] = mfma16(a1, b, acc[1][nn]);
        }
      }
    }
#pragma unroll
    for (int m = 0; m < 2; ++m)
#pragma unroll
      for (int j = 0; j < 4; ++j) {
        const int il = m0 + m * 16 + fq * 4 + j;
        const float sc = __expf((float)(128 - il) * lgb);
#pragma unroll
        for (int nn = 0; nn < 8; ++nn) acc[m][nn][j] *= sc;
      }
  }
  __syncthreads();
  tile_to_lds(p.proj + (size_t)ci * 128 * 4096 + 1024 + h * 256, 4096, bbuf, PV, 128, 256);
  __syncthreads();
#pragma unroll 1
  for (int ks = 0; ks < 4; ++ks) {
    const bf16x8 a0 = frag_row(kbuf, PK, m0, ks * 32, fr, fq), a1 = frag_row(kbuf, PK, m0 + 16, ks * 32, fr, fq);
#pragma unroll
    for (int nn = 0; nn < 8; ++nn) {
      const bf16x8 b = frag_tr(bbuf, PV, ks * 32, n0 + nn * 16, fr, fq);
      acc[0][nn] = mfma16(a0, b, acc[0][nn]); acc[1][nn] = mfma16(a1, b, acc[1][nn]);
    }
  }
#pragma unroll
  for (int m = 0; m < 2; ++m)
#pragma unroll
    for (int j = 0; j < 4; ++j) {
      float s = 0.f;
#pragma unroll
      for (int nn = 0; nn < 8; ++nn) s += acc[m][nn][j] * acc[m][nn][j];
      s += __shfl_xor(s, 1); s += __shfl_xor(s, 2); s += __shfl_xor(s, 4); s += __shfl_xor(s, 8);
      if (fr == 0) red[(wid >> 2) * 128 + m0 + m * 16 + fq * 4 + j] = s;
    }
  __syncthreads();
#pragma unroll
  for (int m = 0; m < 2; ++m)
#pragma unroll
    for (int j = 0; j < 4; ++j) {
      const int il = m0 + m * 16 + fq * 4 + j;
      const float r = rsqrtf((red[il] + red[128 + il]) * (1.f / 256.f) + EPS);
      LAS u16* orow = bbuf + il * PV + n0 + fr;
#pragma unroll
      for (int nn = 0; nn < 8; ++nn) orow[nn * 16] = f2bf(acc[m][nn][j] * r);
    }
  __syncthreads();
  {
    const u16* gbase = p.proj + (size_t)ci * 128 * 4096 + 2048 + h * 256;
    u16* obase = p.cat + (size_t)ci * 128 * 1536 + h * 256;
    u32x4 gv[8];
#pragma unroll
    for (int k = 0; k < 8; ++k) { const int i = tid + k * NTHR, r = i >> 5, c = (i & 31) * 8; gv[k] = *(const u32x4*)(gbase + (size_t)r * 4096 + c); }
#pragma unroll
    for (int k = 0; k < 8; ++k) {
      const int i = tid + k * NTHR, r = i >> 5, c = (i & 31) * 8;
      const u32x4 ov = *(const LAS u32x4*)(bbuf + r * PV + c);
      u32x4 o;
#pragma unroll
      for (int e = 0; e < 4; ++e) o[e] = pk2(__uint_as_float(ov[e] << 16) * __uint_as_float(gv[k][e] << 16), __uint_as_float(ov[e] & 0xffff0000u) * __uint_as_float(gv[k][e] & 0xffff0000u));
      *(u32x4*)(obase + (size_t)r * 1536 + c) = o;
    }
  }
}
__device__ __forceinline__ void state_item(const P& p, int item) {
  const int b = item >> 3, h = (item >> 1) & 3, dir = item & 1;
  const float w = __expf(128.f * log1pf(-exp2f(-p.l0_decay[dir * 4 + h])));
  const int c_old = dir == 0 ? 2 * b : 2 * b + 1, c_new = dir == 0 ? 2 * b + 1 : 2 * b;
  const u16* A = (const u16*)p.part + ((size_t)(c_old * 4 + h) * 2 + dir) * 128 * 256;
  const u16* B = (const u16*)p.part + ((size_t)(c_new * 4 + h) * 2 + dir) * 128 * 256;
  float* o = p.out + (size_t)NT * DM + ((size_t)(b * 2 + dir) * 4 + h) * 128 * 256;
  u32x4 av[8], bv[8];
#pragma unroll
  for (int k = 0; k < 8; ++k) { const int i = threadIdx.x + k * NTHR; av[k] = *(const u32x4*)(A + i * 8); bv[k] = *(const u32x4*)(B + i * 8); }
#pragma unroll
  for (int k = 0; k < 8; ++k) {
    const int i = threadIdx.x + k * NTHR;
    f32x4 o0, o1;
    o0[0] = __uint_as_float(av[k][0] << 16) * w + __uint_as_float(bv[k][0] << 16); o0[1] = __uint_as_float(av[k][0] & 0xffff0000u) * w + __uint_as_float(bv[k][0] & 0xffff0000u);
    o0[2] = __uint_as_float(av[k][1] << 16) * w + __uint_as_float(bv[k][1] << 16); o0[3] = __uint_as_float(av[k][1] & 0xffff0000u) * w + __uint_as_float(bv[k][1] & 0xffff0000u);
    o1[0] = __uint_as_float(av[k][2] << 16) * w + __uint_as_float(bv[k][2] << 16); o1[1] = __uint_as_float(av[k][2] & 0xffff0000u) * w + __uint_as_float(bv[k][2] & 0xffff0000u);
    o1[2] = __uint_as_float(av[k][3] << 16) * w + __uint_as_float(bv[k][3] << 16); o1[3] = __uint_as_float(av[k][3] & 0xffff0000u) * w + __uint_as_float(bv[k][3] & 0xffff0000u);
    *(f32x4*)(o + i * 8) = o0; *(f32x4*)(o + i * 8 + 4) = o1;
  }
}
__device__ __forceinline__ void phase_mix_b(const P& p, LAS u16* lds, unsigned* scnt) {
  const int b = (int)blockIdx.x;
  if (b < 64) ret_item(p, 128 + b, lds, scnt);
  else if (b < 192) ret_item(p, b - 64, lds, scnt);
  else { scan_item(p, b - 192, scnt); state_item(p, 2 * (b - 192)); state_item(p, 2 * (b - 192) + 1); }
}

__device__ __forceinline__ void phase_conv(const P& p) {
  const u16* __restrict__ pj = p.proj;
  const size_t total = (size_t)NT * 256, stride = (size_t)gridDim.x * NTHR;
  for (size_t i0 = (size_t)blockIdx.x * NTHR + threadIdx.x; i0 < total; i0 += 4 * stride) {
    u32x2 av[4][3], bv[4][3], bgv[4]; bool ok[4][3];
#pragma unroll
    for (int u = 0; u < 4; ++u) {
      const size_t i = i0 + u * stride; const bool live = i < total;
      const int t = live ? (int)(i >> 8) : 0, c4 = (int)(i & 255) * 4;
      const int seg = t < NPROMPT_T ? 256 : 64, pos = t < NPROMPT_T ? (t & 255) : ((t - NPROMPT_T) & 63);
#pragma unroll
      for (int d = 0; d < 3; ++d) {
        const int pp = pos + d - 1; ok[u][d] = live && pp >= 0 && pp < seg;
        const u16* r = pj + (size_t)(ok[u][d] ? t + d - 1 : t) * 3072;
        av[u][d] = *(const u32x2*)(r + 1024 + c4); bv[u][d] = *(const u32x2*)(r + 2048 + c4);
      }
      bgv[u] = *(const u32x2*)(pj + (size_t)t * 3072 + c4);
    }
#pragma unroll
    for (int u = 0; u < 4; ++u) {
      const size_t i = i0 + u * stride; if (i >= total) continue;
      const int t = (int)(i >> 8), c4 = (int)(i & 255) * 4;
      f32x4 xc[3];
#pragma unroll
      for (int d = 0; d < 3; ++d) {
        const u32x2 a = av[u][d], b2 = bv[u][d];
        xc[d][0] = __uint_as_float(a[0] << 16) * __uint_as_float(b2[0] << 16); xc[d][1] = __uint_as_float(a[0] & 0xffff0000u) * __uint_as_float(b2[0] & 0xffff0000u);
        xc[d][2] = __uint_as_float(a[1] << 16) * __uint_as_float(b2[1] << 16); xc[d][3] = __uint_as_float(a[1] & 0xffff0000u) * __uint_as_float(b2[1] & 0xffff0000u);
        if (!ok[u][d]) xc[d] = (f32x4){0.f, 0.f, 0.f, 0.f};
      }
      const f32x4 w0 = *(const f32x4*)(p.l1_conv + c4), w1 = *(const f32x4*)(p.l1_conv + 1024 + c4), w2 = *(const f32x4*)(p.l1_conv + 2048 + c4);
      const f32x4 bg = {__uint_as_float(bgv[u][0] << 16), __uint_as_float(bgv[u][0] & 0xffff0000u), __uint_as_float(bgv[u][1] << 16), __uint_as_float(bgv[u][1] & 0xffff0000u)};
      const f32x4 y = bg * (w0 * xc[0] + w1 * xc[1] + w2 * xc[2]);
      u32x2 o; o[0] = pk2(y[0], y[1]); o[1] = pk2(y[2], y[3]);
      *(u32x2*)(p.cat + (size_t)t * 1024 + c4) = o;
    }
  }
}

#define XB_XCNT(j)  (256  + 64 * (j))
#define XB_XSUB(j)  (1280 + 64 * (j))
#define XB_XGEN(j)  (2304 + 64 * (j))
#define XB_TOP      3328
#define XB_TOPGEN   3392
#define XCD_BAR_WORDS 3456
__device__ __forceinline__ unsigned xb_xcc_id() { return (unsigned)__builtin_amdgcn_s_getreg((3 << 11) | 20) & 0xFu; }
struct XcdBarrier { unsigned* bar; unsigned x; volatile __attribute__((address_space(3))) unsigned* st; };
__device__ __forceinline__ XcdBarrier xcd_barrier_post(unsigned* bar, volatile __attribute__((address_space(3))) unsigned* st) {
  XcdBarrier b; b.bar = bar; b.x = xb_xcc_id(); b.st = st;
  if (threadIdx.x == 0) (void)xb_add(&bar[XB_XCNT(b.x)], 1u);
  return b;
}
__device__ __forceinline__ void xcd_barrier_complete(unsigned* bar, unsigned x, unsigned& nloc, unsigned& nx) {
  const unsigned G = gridDim.x * gridDim.y * gridDim.z;
  unsigned sum, cnt, mine, sp = 0u;
  for (;;) {
    sum = 0u; cnt = 0u; mine = 0u;
#pragma unroll
    for (unsigned j = 0; j < 16; ++j) { const unsigned c = xb_ld(&bar[XB_XCNT(j)]); sum += c; cnt += (c > 0u) ? 1u : 0u; mine = (j == x) ? c : mine; }
    if (sum == G) break;
    __builtin_amdgcn_s_sleep(1);
    if ((++sp & 255u) == 0u) { if (xb_ld(&bar[XB_TMO])) break; if (sp > XB_SPIN_CAP) { atomicAdd(&bar[XB_TMO], 1u); break; } }
  }
  nloc = mine > 0u ? mine : 1u; nx = cnt > 0u ? cnt : 1u;
}
__device__ __forceinline__ void xcd_barrier(const XcdBarrier& b) {
  asm volatile("s_waitcnt vmcnt(0)" ::: "memory");
  __syncthreads();
  if (threadIdx.x == 0) {
    unsigned* bar = b.bar;
    __builtin_amdgcn_s_waitcnt(0);
    unsigned nloc = b.st[0], nx = b.st[1];
    if (nloc == 0u) { xcd_barrier_complete(bar, b.x, nloc, nx); b.st[0] = nloc; b.st[1] = nx; }
    const unsigned old = xb_add(&bar[XB_XSUB(b.x)], 1u);
    const unsigned gen = old / nloc;
    if (old + 1u == (gen + 1u) * nloc) {
      __builtin_amdgcn_fence(__ATOMIC_RELEASE, "agent");
      asm volatile("s_waitcnt vmcnt(0)" ::: "memory");
      const unsigned og = xb_add(&bar[XB_TOP], 1u);
      const unsigned tg = og / nx;
      if (og + 1u == (tg + 1u) * nx) xb_add(&bar[XB_TOPGEN], 1u);
      else XB_SPIN(xb_ld(&bar[XB_TOPGEN]) == tg, bar);
      __builtin_amdgcn_fence(__ATOMIC_ACQUIRE, "agent");
      xb_add(&bar[XB_XGEN(b.x)], 1u);
      asm volatile("s_waitcnt vmcnt(0)" ::: "memory");
    } else {
      XB_SPIN(xb_ld(&bar[XB_XGEN(b.x)]) == gen, bar);
      __builtin_amdgcn_fence(__ATOMIC_ACQUIRE, "agent");
      asm volatile("s_waitcnt vmcnt(0)" ::: "memory");
    }
  }
  __syncthreads();
}

__device__ __forceinline__ void phase_norm_fused(const NormArgs& a, unsigned* cnt, unsigned* bar) {
  pg8::Order S; S.init(NT, 1024, 2, (int)gridDim.x, (int)blockIdx.x);
  pg8::Unit u;
  if (!S.next(0, u)) return;
  asm volatile("s_waitcnt vmcnt(0)" ::: "memory");
  __syncthreads();
  if (threadIdx.x == 0) {
    for (int i = 0; S.next(i, u); ++i) xb_add(&cnt[u.pm * 16], 1u);
  }
  const int wid = threadIdx.x >> 6, lane = threadIdx.x & 63;
  for (int i = 0; S.next(i, u); ++i) {
    if (threadIdx.x == 0) {
      XB_SPIN(xb_ld(&cnt[u.pm * 16]) < 8u, bar);
      __builtin_amdgcn_fence(__ATOMIC_ACQUIRE, "agent");
      asm volatile("s_waitcnt vmcnt(0)" ::: "memory");
    }
    __syncthreads();
    const int r0 = u.pm * 256 + (u.pn * 2 + u.ks) * 32 + wid * 4;
    norm_rows<4, 2>(a, r0, lane);
  }
}

__device__ __forceinline__ void phase_ffn(const P& p, const u16* w1t, const u16* w2t, const NormArgs& na, unsigned* cntA, unsigned* cntB, float* lds) {
  const int c = (int)blockIdx.x, tid = threadIdx.x, wid = tid >> 6, lane = tid & 63, x = c & 7;
  PG8_LAS unsigned char* l3 = (PG8_LAS unsigned char*)lds;
  __syncthreads();
  { pg8::Gemm g{p.hA, w1t, NT, 4096, 1024, 1}; pg8::FfnOrder1 S{c}; EpiRelu2W e{mk_rsrc(p.proj, (unsigned)NT * 4096u * 2u)}; pg8::gemm_phase(l3, g, S, e); }
  asm volatile("s_waitcnt vmcnt(0)" ::: "memory");
  __syncthreads();
  if (tid == 0) { pg8::FfnOrder1 S{c}; pg8::Unit u; for (int i = 0; S.next(i, u); ++i) xb_add(&cntA[u.pm * 16], 1u); }
  pg8::Unit ue, ul;
  { const int oj = (c - 128) >> 3; ue.pm = x; ue.pn = oj >> 2; ue.ks = oj & 3; }
  { const int o = c >> 3; ul.pm = 8 + 2 * x + (o >> 4); ul.pn = (o & 15) >> 2; ul.ks = o & 3; }
#pragma unroll 1
  for (int pass = (c >= 128 ? 0 : 1); pass < 2; ++pass) {
    const pg8::Unit u = pass == 0 ? ue : ul;
    if (tid == 0) {
      XB_SPIN(xb_ld(&cntA[u.pm * 16]) < 16u, p.bar);
      __builtin_amdgcn_fence(__ATOMIC_ACQUIRE, "agent");
      asm volatile("s_waitcnt vmcnt(0)" ::: "memory");
    }
    __syncthreads();
    { pg8::Gemm g{p.proj, w2t, NT, 1024, 4096, 4}; pg8::OneUnit S{u}; EpiPartW e{mk_rsrc(p.part, 4u * (unsigned)NT * 1024u * 2u)}; pg8::gemm_phase(l3, g, S, e); }
    asm volatile("s_waitcnt vmcnt(0)" ::: "memory");
    __syncthreads();
    if (tid == 0) xb_add(&cntB[u.pm * 16], 1u);
  }
#pragma unroll 1
  for (int pass = (c >= 128 ? 0 : 1); pass < 2; ++pass) {
    const pg8::Unit u = pass == 0 ? ue : ul;
    if (tid == 0) {
      XB_SPIN(xb_ld(&cntB[u.pm * 16]) < 16u, p.bar);
      __builtin_amdgcn_fence(__ATOMIC_ACQUIRE, "agent");
      asm volatile("s_waitcnt vmcnt(0)" ::: "memory");
    }
    __syncthreads();
    norm_rows<2, 4>(na, u.pm * 256 + (u.pn * 4 + u.ks) * 16 + wid * 2, lane);
  }
}

__device__ __forceinline__ void conv_rect(const P& p, int row0, int ch0) {
  const u16* __restrict__ pj = p.proj;
  const __amdgpu_buffer_rsrc_t rs = mk_rsrc(p.cat, (unsigned)NT * 1024u * 2u);
#pragma unroll 1
  for (int b0 = 0; b0 < 16; b0 += 4) {
    u32x2 av[4][3], bv[4][3], bgv[4]; bool ok[4][3];
#pragma unroll
    for (int u = 0; u < 4; ++u) {
      const int i = threadIdx.x + (b0 + u) * NTHR;
      const int t = row0 + (i >> 7), c4 = ch0 + (i & 127) * 4;
      const int seg = t < NPROMPT_T ? 256 : 64, pos = t < NPROMPT_T ? (t & 255) : ((t - NPROMPT_T) & 63);
#pragma unroll
      for (int d = 0; d < 3; ++d) {
        const int pp = pos + d - 1; ok[u][d] = pp >= 0 && pp < seg;
        const u16* r = pj + (size_t)(ok[u][d] ? t + d - 1 : t) * 3072;
        av[u][d] = *(const u32x2*)(r + 1024 + c4); bv[u][d] = *(const u32x2*)(r + 2048 + c4);
      }
      bgv[u] = *(const u32x2*)(pj + (size_t)t * 3072 + c4);
    }
#pragma unroll
    for (int u = 0; u < 4; ++u) {
      const int i = threadIdx.x + (b0 + u) * NTHR;
      const int t = row0 + (i >> 7), c4 = ch0 + (i & 127) * 4;
      f32x4 xc[3];
#pragma unroll
      for (int d = 0; d < 3; ++d) {
        const u32x2 a = av[u][d], b2 = bv[u][d];
        xc[d][0] = __uint_as_float(a[0] << 16) * __uint_as_float(b2[0] << 16); xc[d][1] = __uint_as_float(a[0] & 0xffff0000u) * __uint_as_float(b2[0] & 0xffff0000u);
        xc[d][2] = __uint_as_float(a[1] << 16) * __uint_as_float(b2[1] << 16); xc[d][3] = __uint_as_float(a[1] & 0xffff0000u) * __uint_as_float(b2[1] & 0xffff0000u);
        if (!ok[u][d]) xc[d] = (f32x4){0.f, 0.f, 0.f, 0.f};
      }
      const f32x4 w0 = *(const f32x4*)(p.l1_conv + c4), w1 = *(const f32x4*)(p.l1_conv + 1024 + c4), w2 = *(const f32x4*)(p.l1_conv + 2048 + c4);
      const f32x4 bg = {__uint_as_float(bgv[u][0] << 16), __uint_as_float(bgv[u][0] & 0xffff0000u), __uint_as_float(bgv[u][1] << 16), __uint_as_float(bgv[u][1] & 0xffff0000u)};
      const f32x4 y = bg * (w0 * xc[0] + w1 * xc[1] + w2 * xc[2]);
      const unsigned long long v = (unsigned long long)pk2(y[0], y[1]) | ((unsigned long long)pk2(y[2], y[3]) << 32);
      __hip_atomic_store((unsigned long long*)(p.cat + (size_t)t * 1024 + c4), v, __ATOMIC_RELAXED, __HIP_MEMORY_SCOPE_AGENT);
    }
  }
}

__device__ __forceinline__ void phase_l1(const P& p, const NormArgs& na, unsigned* cntA, unsigned* cntC, unsigned* cntB, float* lds) {
  const int c = (int)blockIdx.x, tid = threadIdx.x, wid = tid >> 6, lane = tid & 63;
  PG8_LAS unsigned char* l3 = (PG8_LAS unsigned char*)lds;
  __syncthreads();
  { pg8::Gemm g{p.hA, p.wt1_in, NT, 3072, 1024, 1}; pg8::L1InOrder S{c}; EpiPlain e{p.proj, 3072}; pg8::gemm_phase(l3, g, S, e); }
  asm volatile("s_waitcnt vmcnt(0)" ::: "memory");
  __syncthreads();
  if (tid == 0) { pg8::L1InOrder S{c}; pg8::Unit u; for (int i = 0; S.next(i, u); ++i) xb_add(&cntA[u.pm * 16], 1u); }
  if (c < 40 || c >= 232) return;
  pg8::Unit u;
  { const int j = c - 40; u.pm = j >> 3; u.pn = (j & 7) >> 1; u.ks = j & 1; }
  if (tid == 0) {
    XB_SPIN(xb_ld(&cntA[u.pm * 16]) < 12u, p.bar);
    __builtin_amdgcn_fence(__ATOMIC_ACQUIRE, "agent");
    asm volatile("s_waitcnt vmcnt(0)" ::: "memory");
  }
  __syncthreads();
  conv_rect(p, u.pm * 256 + u.pn * 64, u.ks * 512);
  asm volatile("s_waitcnt vmcnt(0)" ::: "memory");
  __syncthreads();
  if (tid == 0) {
    xb_add(&cntC[(u.pm * 2 + u.ks) * 8], 1u);
    XB_SPIN(xb_ld(&cntC[(u.pm * 2 + u.ks) * 8]) < 4u, p.bar);
    __builtin_amdgcn_fence(__ATOMIC_ACQUIRE, "agent");
    asm volatile("s_waitcnt vmcnt(0)" ::: "memory");
  }
  __syncthreads();
  { pg8::Gemm g{p.cat, p.wt1_out, NT, 1024, 1024, 2}; pg8::OneUnit S{u}; EpiPartW e{mk_rsrc(p.part, 4u * (unsigned)NT * 1024u * 2u)}; pg8::gemm_phase(l3, g, S, e); }
  asm volatile("s_waitcnt vmcnt(0)" ::: "memory");
  __syncthreads();
  if (tid == 0) {
    xb_add(&cntB[u.pm * 16], 1u);
    XB_SPIN(xb_ld(&cntB[u.pm * 16]) < 8u, p.bar);
    __builtin_amdgcn_fence(__ATOMIC_ACQUIRE, "agent");
    asm volatile("s_waitcnt vmcnt(0)" ::: "memory");
  }
  __syncthreads();
  norm_rows<4, 2>(na, u.pm * 256 + (u.pn * 2 + u.ks) * 32 + wid * 4, lane);
}

constexpr int NPHASE = 9;
#ifndef REPMASK
#define REPMASK 0
#endif
__global__ void __launch_bounds__(NTHR) mega(P p, int lo, int hi) {
  extern __shared__ __attribute__((aligned(16))) unsigned char smem[];
  float* lds = (float*)smem;
  cg::grid_group grid = cg::this_grid();
  volatile LAS unsigned* xst = (volatile LAS unsigned*)(smem + 131072);
  if (threadIdx.x == 0) { xst[0] = 0u; xst[1] = 0u; }
  __syncthreads();
  const XcdBarrier xb = xcd_barrier_post(p.bar, xst);
  if (hi < 0) grid.sync();
  const float* m0 = p.mod; const float* m1 = p.mod + 3 * 6144;
#define PH(n, ...) if (lo <= (n) && (n) < hi) { if ((n) > lo) xcd_barrier(xb); __VA_ARGS__ if ((REPMASK >> (n)) & 1) { xcd_barrier(xb); __VA_ARGS__ } }
  unsigned* pcnt = p.bar + XCD_BAR_WORDS;
  float* const xs = p.xres + (size_t)NPROMPT_T * DM; float* const pp = p.part;
  PH(0, phase_prep(p, lds);)
  PH(1, { NormArgs a{p.x_prompt, p.x_sample, nullptr, nullptr, nullptr, nullptr, p.l0_norm1, m0 + 0, m0 + 1024, p.hA, nullptr}; phase_norm(a); })
  PH(2, { EpiProj0 e{p.proj}; phase_gemm(p.hA, p.wt0_in, NT, 4096, 1024, 1, e, lds); phase_prep2(p, lds, 0, 128); })
  PH(3, { phase_mix_a(p, (LAS u16*)smem); phase_prep2(p, lds, 2, 128); })
  PH(4, phase_mix_b(p, (LAS u16*)smem, pcnt + 6 * 384);)
  PH(5, { EpiPartW e{mk_rsrc(p.part, 4u * (unsigned)NT * 1024u * 2u)}; phase_gemm(p.cat, p.wt0_out, NT, 1024, 1536, 2, e, lds);
          NormArgs a{p.x_prompt, p.x_sample, pp, pp, m0 + 2048, p.xres, p.l0_norm2, m0 + 3072, m0 + 4096, p.hA, nullptr}; phase_norm_fused(a, pcnt + 0 * 384, p.bar);
          phase_prep2(p, lds, 1, 192); })
  PH(6, { NormArgs a{p.xres, xs, pp, pp, m0 + 5120, p.xres, p.l1_norm1, m1 + 0, m1 + 1024, p.hA, nullptr}; phase_ffn(p, p.wt0_f1, p.wt0_f2, a, pcnt + 1 * 384, pcnt + 2 * 384, lds); })
  PH(7, { NormArgs a{p.xres, xs, pp, pp, m1 + 2048, p.xres, p.l1_norm2, m1 + 3072, m1 + 4096, p.hA, nullptr}; phase_l1(p, a, pcnt + 7 * 384, pcnt + 8 * 384, pcnt + 3 * 384, lds); })
  PH(8, { NormArgs a{p.xres, xs, pp, pp, m1 + 5120, nullptr, p.final_norm, nullptr, nullptr, nullptr, p.out}; phase_ffn(p, p.wt1_f1, p.wt1_f2, a, pcnt + 4 * 384, pcnt + 5 * 384, lds); })
#undef PH
}

constexpr size_t LDS_BYTES = 131072 + 256;
constexpr bool ONE_LAUNCH = true;

extern "C" void kernel_launch(void* const* d_in, const int* in_sizes, int n_in, void* d_out, int out_size, void* d_ws, size_t ws_size, hipStream_t stream) {
  static int grid_blocks = 0;
  if (!grid_blocks) {
    hipFuncSetAttribute((const void*)mega, hipFuncAttributeMaxDynamicSharedMemorySize, (int)LDS_BYTES);
    int dev = 0, cus = 0, per_cu = 0;
    hipGetDevice(&dev);
    hipDeviceGetAttribute(&cus, hipDeviceAttributeMultiprocessorCount, dev);
    hipOccupancyMaxActiveBlocksPerMultiprocessor(&per_cu, mega, NTHR, LDS_BYTES);
    if (per_cu < 1) per_cu = 1;
    if (per_cu > 1) per_cu = 1;
    grid_blocks = 256;
  }
  P p{};
  const float* const* in = (const float* const*)d_in;
  p.x_prompt = in[0]; p.x_sample = in[1]; p.state = in[2]; p.c = in[3]; p.c_ctx = in[4];
  p.l0_norm1 = in[5]; p.l0_w_in = in[6]; p.l0_decay = in[7]; p.l0_gws = in[8]; p.l0_gb = in[9]; p.l0_w_out = in[10]; p.l0_norm2 = in[11];
  p.l0_w_mod = in[12]; p.l0_b_mod = in[13]; p.l0_f1 = in[14]; p.l0_f2 = in[15];
  p.l1_norm1 = in[16]; p.l1_w_in = in[17]; p.l1_conv = in[18]; p.l1_w_out = in[19]; p.l1_norm2 = in[20]; p.l1_w_mod = in[21]; p.l1_b_mod = in[22];
  p.l1_f1 = in[23]; p.l1_f2 = in[24]; p.final_norm = in[25];
  p.out = (float*)d_out;
  unsigned char* w = (unsigned char*)d_ws; size_t off = 0;
  auto take = [&](size_t bytes) { void* r = w + off; off += (bytes + 255) & ~(size_t)255; return r; };
  p.wt0_in = (u16*)take((size_t)4096 * 1024 * 2); p.wt0_out = (u16*)take((size_t)1024 * 1536 * 2);
  p.wt0_f1 = (u16*)take((size_t)4096 * 1024 * 2); p.wt0_f2 = (u16*)take((size_t)4096 * 1024 * 2);
  p.wt1_in = (u16*)take((size_t)3072 * 1024 * 2); p.wt1_out = (u16*)take((size_t)1024 * 1024 * 2);
  p.wt1_f1 = (u16*)take((size_t)4096 * 1024 * 2); p.wt1_f2 = (u16*)take((size_t)4096 * 1024 * 2);
  p.mod = (float*)take((size_t)2 * 3 * 6144 * 4);
  p.hA = (u16*)take((size_t)NT * 1024 * 2);
  p.proj = (u16*)take((size_t)NT * 4096 * 2);
  p.cat = (u16*)take((size_t)NT * 1536 * 2);
  p.part = (float*)take((size_t)2 * NT * 1024 * 4);
  p.xres = (float*)take((size_t)NT * 1024 * 4);
  p.stimg = (u16*)take((size_t)2 * 4 * 2 * 8 * 128 * 256 * 2);
  p.bar = (unsigned*)take((size_t)(XCD_BAR_WORDS + 9 * 384) * 4);
  hipMemsetAsync(p.bar, 0, (size_t)(XCD_BAR_WORDS + 9 * 384) * 4, stream);
  if (ONE_LAUNCH) {
    int lo = 0, hi = NPHASE; void* args[] = {&p, &lo, &hi};
    hipError_t e = hipLaunchCooperativeKernel((void*)mega, dim3(grid_blocks), dim3(NTHR), args, LDS_BYTES, stream);
    if (e != hipSuccess) fprintf(stderr, "cooperative launch failed: %s (grid %d)\n", hipGetErrorString(e), grid_blocks);
  } else {
    for (int ph = 0; ph < NPHASE; ++ph) hipLaunchKernelGGL(mega, dim3(grid_blocks), dim3(NTHR), LDS_BYTES, stream, p, ph, ph + 1);
  }
}
```

```cpp
#include <hip/hip_runtime.h>
#include <hip/hip_cooperative_groups.h>
#include <cstdio>
namespace cg = cooperative_groups;

typedef unsigned short u16;
typedef float f32x4 __attribute__((ext_vector_type(4)));
typedef unsigned u32x4 __attribute__((ext_vector_type(4)));
typedef unsigned u32x2 __attribute__((ext_vector_type(2)));

constexpr int NT = 6144, DM = 1024, NPROMPT_T = 4096;
constexpr float EPS = 1e-6f;
constexpr int NTHR = 512;

__device__ __forceinline__ float bf2f(u16 b) { return __uint_as_float(((unsigned)b) << 16); }
typedef float f32x2 __attribute__((ext_vector_type(2)));
typedef __bf16 hbf16x2 __attribute__((ext_vector_type(2)));
__device__ __forceinline__ unsigned pk2(float a, float b) { const f32x2 v = {a, b}; const hbf16x2 r = __builtin_convertvector(v, hbf16x2); return __builtin_bit_cast(unsigned, r); }
__device__ __forceinline__ u16 f2bf(float f) { return (u16)(pk2(f, 0.f) & 0xffffu); }
__device__ __forceinline__ float silu_f(float x) { return x * __builtin_amdgcn_rcpf(1.f + __expf(-x)); }
__device__ __forceinline__ float gelu_f(float x) { const float u = -1.5957691216057308f * (x + 0.044715f * x * x * x); return x * __builtin_amdgcn_rcpf(1.f + __expf(u)); }
__device__ __forceinline__ int cond_of(int t) { return t < NPROMPT_T ? 0 : 1 + ((t - NPROMPT_T) >> 10); }
__device__ __forceinline__ float wave_sum(float v) {
#pragma unroll
  for (int o = 32; o > 0; o >>= 1) v += __shfl_xor(v, o);
  return v;
}

struct P {
  const float *x_prompt, *x_sample, *state, *c, *c_ctx;
  const float *l0_norm1, *l0_w_in, *l0_decay, *l0_gws, *l0_gb, *l0_w_out, *l0_norm2, *l0_w_mod, *l0_b_mod, *l0_f1, *l0_f2;
  const float *l1_norm1, *l1_w_in, *l1_conv, *l1_w_out, *l1_norm2, *l1_w_mod, *l1_b_mod, *l1_f1, *l1_f2, *final_norm;
  float* out;
  u16 *wt0_in, *wt0_out, *wt0_f1, *wt0_f2, *wt1_in, *wt1_out, *wt1_f1, *wt1_f2;
  float* mod;
  u16* hA;
  u16* proj;
  u16* cat;
  float* part;
  float* xres;
  u16* stimg;
  unsigned* bar;
};

__device__ __forceinline__ unsigned xb_ld(unsigned* p)              { return __hip_atomic_load(p, __ATOMIC_RELAXED, __HIP_MEMORY_SCOPE_AGENT); }
__device__ __forceinline__ unsigned xb_add(unsigned* p, unsigned v) { return __hip_atomic_fetch_add(p, v, __ATOMIC_RELAXED, __HIP_MEMORY_SCOPE_AGENT); }
#define XB_TMO      128
#define XB_SPIN_CAP (1u << 18)
#define XB_SPIN(cond, bar) do { unsigned _sp = 0; while (cond) { __builtin_amdgcn_s_sleep(1); \
    if ((++_sp & 255u) == 0u) { if (xb_ld(&(bar)[XB_TMO])) break; if (_sp > XB_SPIN_CAP) { atomicAdd(&(bar)[XB_TMO], 1u); break; } } } } while (0)

__device__ __forceinline__ __amdgpu_buffer_rsrc_t mk_rsrc(void* p, unsigned bytes) { return __builtin_amdgcn_make_buffer_rsrc(p, 0, (int)bytes, 0x00020000); }

__device__ __forceinline__ void transpose_tile(const float* __restrict__ W, int K, int N, u16* __restrict__ Wt, int tile, float* lds) {
  const int tn = N / 256; const int k0 = (tile / tn) * 64, n0 = (tile % tn) * 256;
  const int tid = threadIdx.x;
  float (*T)[257] = (float (*)[257])lds;
  __syncthreads();
  {
    const int r = tid >> 6, c4 = (tid & 63) * 4;
    f32x4 v[8];
#pragma unroll
    for (int i = 0; i < 8; ++i) v[i] = *(const f32x4*)(W + (size_t)(k0 + r + 8 * i) * N + n0 + c4);
#pragma unroll
    for (int i = 0; i < 8; ++i) { T[r + 8 * i][c4 + 0] = v[i][0]; T[r + 8 * i][c4 + 1] = v[i][1]; T[r + 8 * i][c4 + 2] = v[i][2]; T[r + 8 * i][c4 + 3] = v[i][3]; }
  }
  __syncthreads();
  {
    const int kk = (tid & 7) * 8;
#pragma unroll
    for (int ps = 0; ps < 4; ++ps) {
      const int nn = (tid >> 3) + 64 * ps;
      u32x4 o;
      o[0] = pk2(T[kk + 0][nn], T[kk + 1][nn]); o[1] = pk2(T[kk + 2][nn], T[kk + 3][nn]);
      o[2] = pk2(T[kk + 4][nn], T[kk + 5][nn]); o[3] = pk2(T[kk + 6][nn], T[kk + 7][nn]);
      *(u32x4*)(Wt + (size_t)(n0 + nn) * K + k0 + kk) = o;
    }
  }
}

__device__ __forceinline__ void adaln_item(const P& p, int item, float* lds) {
  const int l = item / 96, n0 = (item % 96) * 64;
  const float* W = l ? p.l1_w_mod : p.l0_w_mod; const float* B = l ? p.l1_b_mod : p.l0_b_mod;
  const int tid = threadIdx.x;
  float* sc = lds;
  float* red = lds + 3072;
  __syncthreads();
  for (int i = tid; i < 3072; i += NTHR) {
    const int c = i >> 10, k = i & 1023;
    const float v = c == 0 ? p.c_ctx[k] : p.c[(c - 1) * 1024 + k];
    sc[i] = silu_f(v);
  }
  __syncthreads();
  const int cg4 = tid & 15, rg = tid >> 4;
  float acc[3][4] = {};
#pragma unroll 8
  for (int it = 0; it < 32; ++it) {
    const int k = it * 32 + rg;
    const f32x4 w = *(const f32x4*)(W + (size_t)k * 6144 + n0 + cg4 * 4);
#pragma unroll
    for (int c = 0; c < 3; ++c) { const float s = sc[c * 1024 + k];
#pragma unroll
      for (int e = 0; e < 4; ++e) acc[c][e] += s * w[e]; }
  }
#pragma unroll
  for (int c = 0; c < 3; ++c)
#pragma unroll
    for (int e = 0; e < 4; ++e) red[(rg * 3 + c) * 64 + cg4 * 4 + e] = acc[c][e];
  __syncthreads();
  if (tid < 192) {
    const int c = tid >> 6, n = tid & 63; float s = B[n0 + n];
    for (int r = 0; r < 32; ++r) s += red[(r * 3 + c) * 64 + n];
    __hip_atomic_store(&p.mod[(size_t)(l * 3 + c) * 6144 + n0 + n], s, __ATOMIC_RELAXED, __HIP_MEMORY_SCOPE_AGENT);
  }
  if (l == 0) {
    asm volatile("s_waitcnt vmcnt(0)" ::: "memory");
    __syncthreads();
    if (tid == 0) xb_add(p.bar + 3456 + 9 * 384, 1u);
  }
}

__device__ __forceinline__ void phase_prep(const P& p, float* lds) {
  for (int it = blockIdx.x; it < 96 + 256; it += gridDim.x) {
    if (it < 96) adaln_item(p, it, lds); else transpose_tile(p.l0_w_in, 1024, 4096, p.wt0_in, it - 96, lds);
  }
}
__device__ __forceinline__ void phase_prep2(const P& p, float* lds, int group, int first_want) {
  const int first = (int)gridDim.x >= 256 ? first_want : 0, nblk = (int)gridDim.x - first;
  if ((int)blockIdx.x < first) return;
  const int total = group == 0 ? 96 + 96 + 256 + 256 : (group == 1 ? 192 + 64 + 256 : 256);
  for (int it = (int)blockIdx.x - first; it < total; it += nblk) {
    int i = it;
    if (group == 0) {
      if (i < 96) { adaln_item(p, 96 + i, lds); continue; } i -= 96;
      if (i < 96) { transpose_tile(p.l0_w_out, 1536, 1024, p.wt0_out, i, lds); continue; } i -= 96;
      if (i < 256) { transpose_tile(p.l0_f1, 1024, 4096, p.wt0_f1, i, lds); continue; } i -= 256;
      transpose_tile(p.l0_f2, 4096, 1024, p.wt0_f2, i, lds);
    } else if (group == 1) {
      if (i < 192) { transpose_tile(p.l1_w_in, 1024, 3072, p.wt1_in, i, lds); continue; } i -= 192;
      if (i < 64) { transpose_tile(p.l1_w_out, 1024, 1024, p.wt1_out, i, lds); continue; } i -= 64;
      transpose_tile(p.l1_f2, 4096, 1024, p.wt1_f2, i, lds);
    } else {
      transpose_tile(p.l1_f1, 1024, 4096, p.wt1_f1, i, lds);
    }
  }
}

struct NormArgs {
  const float* xin0; const float* xin1;
  const float* p0; const float* p1; const float* gate;
  float* xout; const float* nw; const float* sh; const float* sc;
  u16* hout; float* fout;
};
__device__ __forceinline__ void norm_row(const NormArgs& a, int t, int lane) {
  {
    const int c = cond_of(t);
    const float* xr = t < NPROMPT_T ? a.xin0 + (size_t)t * DM : a.xin1 + (size_t)(t - NPROMPT_T) * DM;
    f32x4 x[4]; float ss = 0.f;
#pragma unroll
    for (int i = 0; i < 4; ++i) {
      const int col = lane * 4 + 256 * i;
      x[i] = *(const f32x4*)(xr + col);
      if (a.p0) {
        const u32x2 q0 = *(const u32x2*)((const u16*)a.p0 + (size_t)t * DM + col), q1 = *(const u32x2*)((const u16*)a.p0 + (size_t)(NT + t) * DM + col);
        const f32x4 g = *(const f32x4*)(a.gate + (size_t)c * 6144 + col);
        f32x4 ps;
        ps[0] = __uint_as_float(q0[0] << 16) + __uint_as_float(q1[0] << 16); ps[1] = __uint_as_float(q0[0] & 0xffff0000u) + __uint_as_float(q1[0] & 0xffff0000u);
        ps[2] = __uint_as_float(q0[1] << 16) + __uint_as_float(q1[1] << 16); ps[3] = __uint_as_float(q0[1] & 0xffff0000u) + __uint_as_float(q1[1] & 0xffff0000u);
        x[i] = x[i] + g * ps;
      }
      if (a.xout) *(f32x4*)(a.xout + (size_t)t * DM + col) = x[i];
      ss += x[i][0] * x[i][0] + x[i][1] * x[i][1] + x[i][2] * x[i][2] + x[i][3] * x[i][3];
    }
    ss = wave_sum(ss);
    const float r = rsqrtf(ss * (1.f / 1024.f) + EPS);
#pragma unroll
    for (int i = 0; i < 4; ++i) {
      const int col = lane * 4 + 256 * i;
      const f32x4 w = *(const f32x4*)(a.nw + col);
      f32x4 y = x[i] * r * w;
      if (a.fout) *(f32x4*)(a.fout + (size_t)t * DM + col) = y;
      if (a.hout) {
        const f32x4 sh = *(const f32x4*)(a.sh + (size_t)c * 6144 + col), sc = *(const f32x4*)(a.sc + (size_t)c * 6144 + col);
        y = y * (1.f + sc) + sh;
        u32x2 o; o[0] = pk2(y[0], y[1]); o[1] = pk2(y[2], y[3]);
        *(u32x2*)(a.hout + (size_t)t * DM + col) = o;
      }
    }
  }
}
template <int R, int NP>
__device__ __forceinline__ void norm_rows(const NormArgs& a, int t0, int lane) {
  const int c = cond_of(t0);
  f32x4 x[R][4];
#pragma unroll
  for (int r = 0; r < R; ++r) {
    const int t = t0 + r;
    const float* xr = t < NPROMPT_T ? a.xin0 + (size_t)t * DM : a.xin1 + (size_t)(t - NPROMPT_T) * DM;
#pragma unroll
    for (int i = 0; i < 4; ++i) x[r][i] = *(const f32x4*)(xr + lane * 4 + 256 * i);
  }
  if (a.p0) {
    u32x2 q[R][NP][4];
#pragma unroll
    for (int r = 0; r < R; ++r)
#pragma unroll
      for (int k = 0; k < NP; ++k)
#pragma unroll
        for (int i = 0; i < 4; ++i) q[r][k][i] = *(const u32x2*)((const u16*)a.p0 + ((size_t)k * NT + t0 + r) * DM + lane * 4 + 256 * i);
#pragma unroll
    for (int i = 0; i < 4; ++i) {
      const f32x4 g = *(const f32x4*)(a.gate + (size_t)c * 6144 + lane * 4 + 256 * i);
#pragma unroll
      for (int r = 0; r < R; ++r) {
        f32x4 ps = {0.f, 0.f, 0.f, 0.f};
#pragma unroll
        for (int k = 0; k < NP; ++k) {
          ps[0] += __uint_as_float(q[r][k][i][0] << 16); ps[1] += __uint_as_float(q[r][k][i][0] & 0xffff0000u);
          ps[2] += __uint_as_float(q[r][k][i][1] << 16); ps[3] += __uint_as_float(q[r][k][i][1] & 0xffff0000u);
        }
        x[r][i] = x[r][i] + g * ps;
      }
    }
  }
  float rs[R];
#pragma unroll
  for (int r = 0; r < R; ++r) {
    float ss = 0.f;
#pragma unroll
    for (int i = 0; i < 4; ++i) {
      if (a.xout) *(f32x4*)(a.xout + (size_t)(t0 + r) * DM + lane * 4 + 256 * i) = x[r][i];
      ss += x[r][i][0] * x[r][i][0] + x[r][i][1] * x[r][i][1] + x[r][i][2] * x[r][i][2] + x[r][i][3] * x[r][i][3];
    }
    ss = wave_sum(ss);
    rs[r] = rsqrtf(ss * (1.f / 1024.f) + EPS);
  }
#pragma unroll
  for (int i = 0; i < 4; ++i) {
    const int col = lane * 4 + 256 * i;
    const f32x4 w = *(const f32x4*)(a.nw + col);
    f32x4 sh = {0.f, 0.f, 0.f, 0.f}, sc = {0.f, 0.f, 0.f, 0.f};
    if (a.hout) { sh = *(const f32x4*)(a.sh + (size_t)c * 6144 + col); sc = *(const f32x4*)(a.sc + (size_t)c * 6144 + col); }
#pragma unroll
    for (int r = 0; r < R; ++r) {
      f32x4 y = x[r][i] * rs[r] * w;
      if (a.fout) *(f32x4*)(a.fout + (size_t)(t0 + r) * DM + col) = y;
      if (a.hout) {
        y = y * (1.f + sc) + sh;
        u32x2 o; o[0] = pk2(y[0], y[1]); o[1] = pk2(y[2], y[3]);
        *(u32x2*)(a.hout + (size_t)(t0 + r) * DM + col) = o;
      }
    }
  }
}
__device__ __forceinline__ void phase_norm(const NormArgs& a) {
  const int wid = threadIdx.x >> 6, lane = threadIdx.x & 63;
  for (int g = blockIdx.x * 8 + wid; g < NT / 4; g += gridDim.x * 8) norm_rows<4, 2>(a, g * 4, lane);
}
struct EpiProj0 {
  u16* O;
  __device__ __forceinline__ void store8(int row, int col, f32x4 v0, f32x4 v1, int) const {
    if (col >= 3072) {
#pragma unroll
      for (int e = 0; e < 4; ++e) { v0[e] = gelu_f(v0[e]); v1[e] = gelu_f(v1[e]); }
    } else if (col >= 2048) {
#pragma unroll
      for (int e = 0; e < 4; ++e) { v0[e] = silu_f(v0[e]); v1[e] = silu_f(v1[e]); }
    } else if (col >= 512 && col < 1024) { v0 = v0 * 0.08838834764831845f; v1 = v1 * 0.08838834764831845f; }
    u32x4 o; o[0] = pk2(v0[0], v0[1]); o[1] = pk2(v0[2], v0[3]); o[2] = pk2(v1[0], v1[1]); o[3] = pk2(v1[2], v1[3]);
    __builtin_amdgcn_raw_buffer_store_b128(o, mk_rsrc(O, (unsigned)NT * 4096u * 2u), (unsigned)(((size_t)row * 4096 + col) * 2), 0, 16);
  }
  __device__ __forceinline__ void store4(int row, int col, f32x4 v, int) const {
    if (col >= 3072) { v[0] = gelu_f(v[0]); v[1] = gelu_f(v[1]); v[2] = gelu_f(v[2]); v[3] = gelu_f(v[3]); }
    else if (col >= 2048) { v[0] = silu_f(v[0]); v[1] = silu_f(v[1]); v[2] = silu_f(v[2]); v[3] = silu_f(v[3]); }
    else if (col >= 512 && col < 1024) v = v * 0.08838834764831845f;
    u32x2 o; o[0] = pk2(v[0], v[1]); o[1] = pk2(v[2], v[3]);
    *(u32x2*)(O + (size_t)row * 4096 + col) = o;
  }
};
struct EpiPart {
  float* Pp;
  __device__ __forceinline__ void store8(int row, int col, f32x4 v0, f32x4 v1, int ks) const {
    u32x4 o; o[0] = pk2(v0[0], v0[1]); o[1] = pk2(v0[2], v0[3]); o[2] = pk2(v1[0], v1[1]); o[3] = pk2(v1[2], v1[3]);
    *(u32x4*)((u16*)Pp + ((size_t)ks * NT + row) * DM + col) = o;
  }
};
struct EpiRelu2 {
  u16* O;
  __device__ __forceinline__ void store8(int row, int col, f32x4 v0, f32x4 v1, int) const {
#pragma unroll
    for (int e = 0; e < 4; ++e) { const float r0 = fmaxf(v0[e], 0.f), r1 = fmaxf(v1[e], 0.f); v0[e] = r0 * r0; v1[e] = r1 * r1; }
    u32x4 o; o[0] = pk2(v0[0], v0[1]); o[1] = pk2(v0[2], v0[3]); o[2] = pk2(v1[0], v1[1]); o[3] = pk2(v1[2], v1[3]);
    *(u32x4*)(O + (size_t)row * 4096 + col) = o;
  }
  __device__ __forceinline__ void store4(int row, int col, f32x4 v, int) const {
#pragma unroll
    for (int e = 0; e < 4; ++e) { const float r = fmaxf(v[e], 0.f); v[e] = r * r; }
    u32x2 o; o[0] = pk2(v[0], v[1]); o[1] = pk2(v[2], v[3]);
    *(u32x2*)(O + (size_t)row * 4096 + col) = o;
  }
};
struct EpiPartW {
  __amdgpu_buffer_rsrc_t rs;
  __device__ __forceinline__ void store8(int row, int col, f32x4 v0, f32x4 v1, int ks) const {
    u32x4 o; o[0] = pk2(v0[0], v0[1]); o[1] = pk2(v0[2], v0[3]); o[2] = pk2(v1[0], v1[1]); o[3] = pk2(v1[2], v1[3]);
    __builtin_amdgcn_raw_buffer_store_b128(o, rs, (unsigned)((((size_t)ks * NT + row) * DM + col) * 2), 0, 16);
  }
};
struct EpiRelu2W {
  __amdgpu_buffer_rsrc_t rs;
  __device__ __forceinline__ void store8(int row, int col, f32x4 v0, f32x4 v1, int) const {
#pragma unroll
    for (int e = 0; e < 4; ++e) { const float r0 = fmaxf(v0[e], 0.f), r1 = fmaxf(v1[e], 0.f); v0[e] = r0 * r0; v1[e] = r1 * r1; }
    u32x4 o; o[0] = pk2(v0[0], v0[1]); o[1] = pk2(v0[2], v0[3]); o[2] = pk2(v1[0], v1[1]); o[3] = pk2(v1[2], v1[3]);
    __builtin_amdgcn_raw_buffer_store_b128(o, rs, (unsigned)(((size_t)row * 4096 + col) * 2), 0, 16);
  }
};
struct EpiPlain {
  u16* O; int ld;
  __device__ __forceinline__ void store8(int row, int col, f32x4 v0, f32x4 v1, int) const {
    u32x4 o; o[0] = pk2(v0[0], v0[1]); o[1] = pk2(v0[2], v0[3]); o[2] = pk2(v1[0], v1[1]); o[3] = pk2(v1[2], v1[3]);
    __builtin_amdgcn_raw_buffer_store_b128(o, mk_rsrc(O, (unsigned)NT * 4096u * 2u), (unsigned)(((size_t)row * ld + col) * 2), 0, 16);
  }
  __device__ __forceinline__ void store4(int row, int col, f32x4 v, int) const {
    u32x2 o; o[0] = pk2(v[0], v[1]); o[1] = pk2(v[2], v[3]);
    *(u32x2*)(O + (size_t)row * ld + col) = o;
  }
};

template <class Epi>
__device__ __forceinline__ void phase_gemm_naive(const u16* __restrict__ A, const u16* __restrict__ Bt, int M, int N, int K, int ksplit, const Epi& E, float* lds) {
  float (*As)[33] = (float (*)[33])lds;
  float (*Bs)[33] = (float (*)[33])(lds + 128 * 33);
  const int tm = M / 128, tn = N / 64, total = tm * tn * ksplit, kper = K / ksplit;
  const int tid = threadIdx.x, r = tid >> 2, cq = tid & 3;
  for (int it = blockIdx.x; it < total; it += gridDim.x) {
    const int ks = it / (tm * tn), rem = it % (tm * tn), m0 = (rem / tn) * 128, n0 = (rem % tn) * 64;
    float acc[4][4] = {};
    for (int k0 = ks * kper; k0 < (ks + 1) * kper; k0 += 32) {
      __syncthreads();
      {
        const int kc = (tid & 3) * 8;
        const u32x4 va = *(const u32x4*)(A + (size_t)(m0 + r) * K + k0 + kc);
#pragma unroll
        for (int e = 0; e < 4; ++e) { As[r][kc + 2 * e] = __uint_as_float(va[e] << 16); As[r][kc + 2 * e + 1] = __uint_as_float(va[e] & 0xffff0000u); }
        if (tid < 256) {
          const u32x4 vb = *(const u32x4*)(Bt + (size_t)(n0 + r) * K + k0 + kc);
#pragma unroll
          for (int e = 0; e < 4; ++e) { Bs[r][kc + 2 * e] = __uint_as_float(vb[e] << 16); Bs[r][kc + 2 * e + 1] = __uint_as_float(vb[e] & 0xffff0000u); }
        }
      }
      __syncthreads();
#pragma unroll 4
      for (int k = 0; k < 32; ++k) {
        const float a = As[r][k];
#pragma unroll
        for (int jj = 0; jj < 4; ++jj)
#pragma unroll
          for (int e = 0; e < 4; ++e) acc[jj][e] += a * Bs[cq * 4 + 16 * jj + e][k];
      }
    }
#pragma unroll
    for (int jj = 0; jj < 4; ++jj) { f32x4 v = {acc[jj][0], acc[jj][1], acc[jj][2], acc[jj][3]}; E.store4(m0 + r, n0 + cq * 4 + 16 * jj, v, ks); }
  }
}


namespace pg8 {
#define PG8_LAS __attribute__((address_space(3)))
typedef short bf16x8 __attribute__((ext_vector_type(8)));
constexpr int BM = 256, BK = 64, HALF = 128, HTB = HALF * BK * 2, STAGE_BYTES = 8 * HTB, NXCD = 8, WGM = 8;
__device__ __forceinline__ int lds_byte(int r, int c) { const int st = (r >> 4) * 2 + (c >> 5), rr = r & 15, cc = c & 31, ob = rr * 64 + cc * 2; return st * 1024 + (ob ^ (((ob >> 9) & 1) << 5)); }
__device__ __forceinline__ int perm32(int rho) { const int n = rho >> 4, i = rho & 15; return 8 * (i >> 2) + 4 * n + (i & 3); }
__device__ __forceinline__ void stage_rc(int b, int& R, int& C) { const int st = b / 1024, sb = b % 1024, swz = sb ^ (((sb >> 9) & 1) << 5); R = (st >> 1) * 16 + swz / 64; C = (st & 1) * 32 + (swz % 64) / 2; }
struct Unit { int pm, pn, ks; };
struct Gemm { const u16* A; const u16* Bt; int M, N, K, ksplit; };
struct Order {
  int nM, nN, ntile, nwg, G, c;
  __device__ void init(int M, int N, int ksplit, int G_, int c_) { nM = M / BM; nN = N / BM; ntile = nM * nN; nwg = ntile * ksplit; G = G_; c = c_; }
  __device__ bool next(int i, Unit& u) const {
    const int L = i * G + c; if (L >= nwg) return false;
    u.ks = L / ntile; int wgid = L % ntile;
    { const int q = ntile / NXCD, r = ntile % NXCD, xcd = wgid % NXCD, off = wgid / NXCD; wgid = (xcd < r ? xcd * (q + 1) : r * (q + 1) + (xcd - r) * q) + off; }
    const int nig = WGM * nN, gid = wgid / nig, fm = gid * WGM, gsz = (nM - fm) < WGM ? (nM - fm) : WGM;
    u.pm = fm + ((wgid % nig) % gsz); u.pn = (wgid % nig) / gsz; return true;
  }
};
template <class Epi>
__device__ __forceinline__ void run_epi(const Epi& E, const f32x4 (&acc)[2][2][4][2], const Unit& u, int wr, int wc, int fr, int fq) {
  const int row0 = u.pm * BM + wr * 64 + fr, col0 = u.pn * BM + wc * 32 + 8 * fq;
#pragma unroll
  for (int ai = 0; ai < 2; ++ai)
#pragma unroll
    for (int m = 0; m < 4; ++m)
#pragma unroll
      for (int bj = 0; bj < 2; ++bj) E.store8(row0 + ai * HALF + m * 16, col0 + bj * HALF, acc[ai][bj][m][0], acc[ai][bj][m][1], u.ks);
}
struct OneUnit { Unit u; __device__ __forceinline__ bool next(int i, Unit& o) const { if (i) return false; o = u; return true; } };
struct FfnOrder1 {
  int c;
  __device__ __forceinline__ bool next(int i, Unit& u) const {
    const int x = c & 7; u.ks = 0;
    if (c >= 128) { if (i) return false; const int oj = (c - 128) >> 3; u.pm = 2 * (x >> 1) + (oj >> 3); u.pn = (x & 1) * 8 + (oj & 7); return true; }
    if (i > 1) return false;
    const int t = i * 16 + (c >> 3); u.pm = 8 + 4 * (x >> 1) + (t >> 3); u.pn = (x & 1) * 8 + (t & 7); return true;
  }
};
struct L1InOrder {
  int c;
  __device__ __forceinline__ bool next(int i, Unit& u) const {
    u.ks = 0;
    if (c >= 40) { if (i) return false; const int idx = c - 40; u.pm = idx / 12; u.pn = idx % 12; return true; }
    if (c >= 36 || i > 1) return false;
    const int t = i * 36 + c; u.pm = 18 + t / 12; u.pn = t % 12; return true;
  }
};
template <class Epi, class Sched>
__device__ __forceinline__ void gemm_phase(PG8_LAS unsigned char* lds, const Gemm g, const Sched& S, const Epi& E) {
  const int tid = threadIdx.x, wid = __builtin_amdgcn_readfirstlane(tid >> 6), lane = tid & 63, wr = wid >> 2, wc = wid & 3, fr = lane & 15, fq = lane >> 4;
  const int K = g.K, kper = g.K / g.ksplit, nt = kper / BK;
  unsigned voffA[2], voffB[2];
#pragma unroll
  for (int i = 0; i < 2; ++i) { int R, C; stage_rc(tid * 16 + i * 8192, R, C); const int Rb = (R & ~31) + perm32(R & 31);
    voffA[i] = (unsigned)(R * K + C) * 2u; voffB[i] = (unsigned)(Rb * K + C) * 2u; }
  const size_t kstep = (size_t)(BK * 2);
  const size_t hstep = (size_t)HALF * K * 2;
  const size_t tstep = 2 * hstep;
  const size_t ksbytes = (size_t)kper * 2;
  const unsigned ldsw = (unsigned)wid * 1024u;
  const int aoff = lds_byte(wr * 64 + fr, fq * 8), boff = lds_byte(wc * 32 + fr, fq * 8);
#define PG8_SA(b, h) (((b) * 2 + (h)) * HTB)
#define PG8_SB(b, h) ((4 + (b) * 2 + (h)) * HTB)
#define PG8_STAGE(bufoff, gbase, voff) do { _Pragma("unroll") for (int _i = 0; _i < 2; ++_i) \
    __builtin_amdgcn_global_load_lds((const unsigned*)((const char*)(gbase) + (voff)[_i]), (PG8_LAS unsigned*)(lds + (bufoff) + ldsw + _i * 8192), 16, 0, 0); } while (0)
#define PG8_LDA(dst, b, h) do { _Pragma("unroll") for (int m = 0; m < 4; ++m) _Pragma("unroll") for (int k = 0; k < 2; ++k) dst[m][k] = *(const PG8_LAS bf16x8*)(lds + PG8_SA(b, h) + aoff + m * 2048 + k * 1024); } while (0)
#define PG8_LDB(dst, b, h) do { _Pragma("unroll") for (int n = 0; n < 2; ++n) _Pragma("unroll") for (int k = 0; k < 2; ++k) dst[n][k] = *(const PG8_LAS bf16x8*)(lds + PG8_SB(b, h) + boff + n * 2048 + k * 1024); } while (0)
#define PG8_MMA(ai, bj, At, Bt) do { __builtin_amdgcn_s_setprio(1); _Pragma("unroll") for (int m = 0; m < 4; ++m) _Pragma("unroll") for (int n = 0; n < 2; ++n) _Pragma("unroll") for (int k = 0; k < 2; ++k) \
    acc[ai][bj][m][n] = __builtin_amdgcn_mfma_f32_16x16x32_bf16(Bt[n][k], At[m][k], acc[ai][bj][m][n], 0, 0, 0); __builtin_amdgcn_s_setprio(0); } while (0)
#define PG8_WAIT_V(n) asm volatile("s_waitcnt vmcnt(" #n ")" ::: "memory")
#define PG8_WAIT_L(n) asm volatile("s_waitcnt lgkmcnt(" #n ")" ::: "memory")
#define PG8_BAR __builtin_amdgcn_s_barrier()
#define PG8_SCHED __builtin_amdgcn_sched_barrier(0)
  Unit cur, nxt; int ui = 0;
  if (!S.next(0, cur)) return;
  f32x4 acc[2][2][4][2];
#pragma unroll
  for (int a = 0; a < 2; ++a)
#pragma unroll
    for (int b = 0; b < 2; ++b)
#pragma unroll
      for (int m = 0; m < 4; ++m)
#pragma unroll
        for (int n = 0; n < 2; ++n) acc[a][b][m][n] = (f32x4){0.f, 0.f, 0.f, 0.f};
  bf16x8 At[4][2], B0[2][2], B1[2][2];
  const char* cA = (const char*)g.A + (size_t)cur.pm * tstep + (size_t)cur.ks * ksbytes; const char* cB = (const char*)g.Bt + (size_t)cur.pn * tstep + (size_t)cur.ks * ksbytes;
  PG8_STAGE(PG8_SB(0, 0), cB, voffB); PG8_STAGE(PG8_SA(0, 0), cA, voffA); PG8_STAGE(PG8_SB(0, 1), cB + hstep, voffB); PG8_STAGE(PG8_SA(0, 1), cA + hstep, voffA);
  if (wr == 1) PG8_BAR;
  PG8_WAIT_V(4); PG8_BAR;
  PG8_STAGE(PG8_SB(1, 0), cB + kstep, voffB); PG8_STAGE(PG8_SA(1, 0), cA + kstep, voffA); PG8_STAGE(PG8_SB(1, 1), cB + hstep + kstep, voffB);
  PG8_WAIT_V(6); PG8_BAR;
  for (;;) {
    const bool has_next = S.next(ui + 1, nxt);
    const char* nA = has_next ? (const char*)g.A + (size_t)nxt.pm * tstep + (size_t)nxt.ks * ksbytes : cA; const char* nB = has_next ? (const char*)g.Bt + (size_t)nxt.pn * tstep + (size_t)nxt.ks * ksbytes : cB;
    for (int t = 0; t < nt; t += 2) {
      const bool last = (t == nt - 2);
      const char* a1 = cA + (size_t)(t + 1) * kstep;
      const char* a2 = last ? nA : cA + (size_t)(t + 2) * kstep; const char* b2 = last ? nB : cB + (size_t)(t + 2) * kstep;
      const char* a3 = a2 + kstep; const char* b3 = b2 + kstep;
      PG8_LDB(B0, 0, 0); PG8_SCHED; PG8_LDA(At, 0, 0); PG8_STAGE(PG8_SA(1, 1), a1 + hstep, voffA);
      PG8_WAIT_L(8); PG8_BAR; PG8_WAIT_L(0); PG8_MMA(0, 0, At, B0); PG8_BAR; PG8_SCHED;
      PG8_LDB(B1, 0, 1); PG8_STAGE(PG8_SB(0, 0), b2, voffB);
      PG8_BAR; PG8_WAIT_L(0); PG8_MMA(0, 1, At, B1); PG8_BAR;
      PG8_LDA(At, 0, 1); PG8_STAGE(PG8_SA(0, 0), a2, voffA);
      PG8_BAR; PG8_WAIT_L(0); PG8_MMA(1, 0, At, B0); PG8_BAR; PG8_SCHED;
      PG8_STAGE(PG8_SB(0, 1), b2 + hstep, voffB);
      PG8_WAIT_V(6); PG8_BAR; PG8_MMA(1, 1, At, B1); PG8_BAR;
      PG8_LDB(B0, 1, 0); PG8_SCHED; PG8_LDA(At, 1, 0); PG8_STAGE(PG8_SA(0, 1), a2 + hstep, voffA);
      PG8_WAIT_L(8); PG8_BAR; PG8_WAIT_L(0); PG8_MMA(0, 0, At, B0); PG8_BAR; PG8_SCHED;
      PG8_LDB(B1, 1, 1); PG8_STAGE(PG8_SB(1, 0), b3, voffB);
      PG8_BAR; PG8_WAIT_L(0); PG8_MMA(0, 1, At, B1); PG8_BAR;
      PG8_LDA(At, 1, 1); PG8_STAGE(PG8_SA(1, 0), a3, voffA);
      PG8_BAR; PG8_WAIT_L(0); PG8_MMA(1, 0, At, B0); PG8_BAR; PG8_SCHED;
      PG8_STAGE(PG8_SB(1, 1), b3 + hstep, voffB);
      PG8_WAIT_V(6); PG8_BAR; PG8_MMA(1, 1, At, B1); PG8_BAR;
    }
    run_epi(E, acc, cur, wr, wc, fr, fq);
    if (!has_next) break;
#pragma unroll
    for (int a = 0; a < 2; ++a)
#pragma unroll
      for (int b = 0; b < 2; ++b)
#pragma unroll
        for (int m = 0; m < 4; ++m)
#pragma unroll
          for (int n = 0; n < 2; ++n) acc[a][b][m][n] = (f32x4){0.f, 0.f, 0.f, 0.f};
    cur = nxt; cA = nA; cB = nB; ++ui;
  }
  PG8_WAIT_V(0);
  if (wr == 0) PG8_BAR;
  PG8_BAR;
#undef PG8_SA
#undef PG8_SB
#undef PG8_STAGE
#undef PG8_LDA
#undef PG8_LDB
#undef PG8_MMA
#undef PG8_WAIT_V
#undef PG8_WAIT_L
#undef PG8_BAR
#undef PG8_SCHED
}
}
template <class Epi>
__device__ __forceinline__ void phase_gemm(const u16* A, const u16* Bt, int M, int N, int K, int ksplit, const Epi& E, float* lds) {
  __syncthreads();
  pg8::Gemm g{A, Bt, M, N, K, ksplit};
  pg8::Order S; S.init(M, N, ksplit, (int)gridDim.x, (int)blockIdx.x);
  pg8::gemm_phase(( __attribute__((address_space(3))) unsigned char*)lds, g, S, E);
  __syncthreads();
}

__device__ __forceinline__ void seq_of_token(int t, int& s0, int& L, int& sb) {
  if (t < NPROMPT_T) { s0 = t & ~255; L = 256; sb = -1; } else { sb = (t - NPROMPT_T) >> 10; s0 = NPROMPT_T + (sb << 10); L = 1024; }
}
__device__ __forceinline__ void ret_item_naive(const P& p, int item, float* lds) {
  const int tg = item >> 2, h = item & 3, t0 = tg * 16, tid = threadIdx.x;
  int s0, L, sb; seq_of_token(t0, s0, L, sb);
  float* scr = lds;
  float* qs = lds + 16 * 1024;
  float* red = qs + 16 * 128;
  const float lgf = log1pf(-exp2f(-p.l0_decay[h])), lgb = log1pf(-exp2f(-p.l0_decay[4 + h]));
  __syncthreads();
  for (int i = tid; i < 16 * 128; i += NTHR) qs[i] = bf2f(p.proj[(size_t)(t0 + (i >> 7)) * 4096 + h * 128 + (i & 127)]);
  __syncthreads();
  for (int j = tid; j < L; j += NTHR) {
    float acc[16] = {};
    const u16* kr = p.proj + (size_t)(s0 + j) * 4096 + 512 + h * 128;
    for (int d0 = 0; d0 < 128; d0 += 8) {
      const u32x4 kv = *(const u32x4*)(kr + d0);
      float kf[8];
#pragma unroll
      for (int e = 0; e < 4; ++e) { kf[2 * e] = __uint_as_float(kv[e] << 16); kf[2 * e + 1] = __uint_as_float(kv[e] & 0xffff0000u); }
#pragma unroll
      for (int i = 0; i < 16; ++i)
#pragma unroll
        for (int e = 0; e < 8; ++e) acc[i] += qs[i * 128 + d0 + e] * kf[e];
    }
#pragma unroll
    for (int i = 0; i < 16; ++i) {
      const int d = (t0 + i - s0) - j;
      const float w = d > 0 ? __expf((float)d * lgf) : (d < 0 ? __expf((float)(-d) * lgb) : 2.f);
      scr[i * 1024 + j] = acc[i] * w;
    }
  }
  __syncthreads();
  const int dv = tid & 255, ig = tid >> 8;
  float o[8] = {};
  for (int j = 0; j < L; ++j) {
    const float v = bf2f(p.proj[(size_t)(s0 + j) * 4096 + 1024 + h * 256 + dv]);
#pragma unroll
    for (int e = 0; e < 8; ++e) o[e] += scr[(ig * 8 + e) * 1024 + j] * v;
  }
  if (sb >= 0) {
    const float* Sf = p.state + ((size_t)(sb * 2 + 0) * 4 + h) * 128 * 256;
    const float* Sb = p.state + ((size_t)(sb * 2 + 1) * 4 + h) * 128 * 256;
    float af[8] = {}, ab[8] = {};
    for (int dk = 0; dk < 128; ++dk) {
      const float sf = Sf[dk * 256 + dv], sbv = Sb[dk * 256 + dv];
#pragma unroll
      for (int e = 0; e < 8; ++e) { const float q = qs[(ig * 8 + e) * 128 + dk]; af[e] += q * sf; ab[e] += q * sbv; }
    }
#pragma unroll
    for (int e = 0; e < 8; ++e) {
      const int pos = t0 + ig * 8 + e - s0;
      o[e] += __expf((float)(pos + 1) * lgf) * af[e] + __expf((float)(L - pos) * lgb) * ab[e];
    }
  }
  const int wid = tid >> 6, lane = tid & 63;
#pragma unroll
  for (int e = 0; e < 8; ++e) { const float s = wave_sum(o[e] * o[e]); if (lane == 0) red[wid * 8 + e] = s; }
  __syncthreads();
#pragma unroll
  for (int e = 0; e < 8; ++e) {
    const float ss = red[(ig * 4 + 0) * 8 + e] + red[(ig * 4 + 1) * 8 + e] + red[(ig * 4 + 2) * 8 + e] + red[(ig * 4 + 3) * 8 + e];
    const float r = rsqrtf(ss * (1.f / 256.f) + EPS);
    const int t = t0 + ig * 8 + e;
    const float g = bf2f(p.proj[(size_t)t * 4096 + 2048 + h * 256 + dv]);
    p.cat[(size_t)t * 1536 + h * 256 + dv] = f2bf(o[e] * r * g);
  }
}
__device__ __forceinline__ void state_item_naive(const P& p, int item) {
  const int b = item >> 3, h = (item >> 1) & 3, dir = item & 1, tid = threadIdx.x;
  const float lg = log1pf(-exp2f(-p.l0_decay[dir * 4 + h]));
  const int dv = tid & 255;
  float* o = p.out + (size_t)NT * DM + ((size_t)(b * 2 + dir) * 4 + h) * 128 * 256;
  for (int pass = 0; pass < 4; ++pass) {
    const int dk0 = (tid >> 8) * 64 + pass * 16;
    float acc[16] = {};
    for (int s = 0; s < 256; ++s) {
      const int t = b * 256 + s;
      const float w = dir == 0 ? __expf((float)(255 - s) * lg) : __expf((float)s * lg);
      const float v = bf2f(p.proj[(size_t)t * 4096 + 1024 + h * 256 + dv]) * w;
      const u16* kr = p.proj + (size_t)t * 4096 + 512 + h * 128 + dk0;
#pragma unroll
      for (int e = 0; e < 16; ++e) acc[e] += bf2f(kr[e]) * v;
    }
#pragma unroll
    for (int e = 0; e < 16; ++e) o[(dk0 + e) * 256 + dv] = acc[e];
  }
}
__device__ __forceinline__ void gmlp_item_naive(const P& p, int item, float* lds) {
  const int ci = item >> 2, g = item & 3, tid = threadIdx.x, wid = tid >> 6, lane = tid & 63;
  float* zn = lds;
  float* mu = lds + 128 * 128;
  float* rs = mu + 128;
  __syncthreads();
  for (int q = wid; q < 128; q += 8) {
    const u32x4 v = *(const u32x4*)(p.proj + (size_t)(ci * 128 + q) * 4096 + 3584 + lane * 8);
    float s = 0.f, s2 = 0.f;
#pragma unroll
    for (int e = 0; e < 4; ++e) { const float a = __uint_as_float(v[e] << 16), b = __uint_as_float(v[e] & 0xffff0000u); s += a + b; s2 += a * a + b * b; }
    s = wave_sum(s); s2 = wave_sum(s2);
    if (lane == 0) { const float m = s * (1.f / 512.f); const float var = fmaxf(s2 * (1.f / 512.f) - m * m, 0.f); mu[q] = m; rs[q] = rsqrtf(var + EPS); }
  }
  __syncthreads();
  for (int i = tid; i < 128 * 128; i += NTHR) {
    const int q = i >> 7, c = i & 127;
    zn[i] = (bf2f(p.proj[(size_t)(ci * 128 + q) * 4096 + 3584 + g * 128 + c]) - mu[q]) * rs[q];
  }
  __syncthreads();
  const int c = tid & 127, p0 = (tid >> 7) * 32;
  float acc[32] = {};
  const float* W = p.l0_gws + (size_t)g * 128 * 128;
  for (int q = 0; q < 128; ++q) {
    const float z = zn[q * 128 + c];
#pragma unroll
    for (int e = 0; e < 32; ++e) acc[e] += W[(p0 + e) * 128 + q] * z;
  }
#pragma unroll
  for (int e = 0; e < 32; ++e) {
    const int t = ci * 128 + p0 + e;
    const float u = bf2f(p.proj[(size_t)t * 4096 + 3072 + g * 128 + c]);
    p.cat[(size_t)t * 1536 + 1024 + g * 128 + c] = f2bf((acc[e] + p.l0_gb[g * 128 + p0 + e]) * u);
  }
}
__device__ __forceinline__ void phase_mixer_naive(const P& p, float* lds) {
  const int nR = 1536, nS = 128, nG = 192, total = nR + nS + nG;
  for (int it = blockIdx.x; it < total; it += gridDim.x) {
    if (it < nR) ret_item_naive(p, it, lds);
    else if (it < nR + nS) state_item_naive(p, it - nR);
    else gmlp_item_naive(p, it - nR - nS, lds);
  }
}


#define LAS __attribute__((address_space(3)))
typedef short bf16x8 __attribute__((ext_vector_type(8)));
typedef short bf16x4 __attribute__((ext_vector_type(4)));
constexpr int PK = 136;
constexpr int PV = 264;
__device__ __forceinline__ bf16x8 frag_row(const LAS u16* base, int pitch, int r0, int k0, int fr, int fq) {
  return *(const LAS bf16x8*)(base + (r0 + fr) * pitch + k0 + fq * 8);
}
__device__ __forceinline__ bf16x8 frag_tr(const LAS u16* base, int pitch, int k0, int n0, int fr, int fq) {
  const LAS u16* a = base + (k0 + fq * 8 + (fr >> 2)) * pitch + n0 + 4 * (fr & 3);
  const bf16x4 lo = __builtin_amdgcn_ds_read_tr16_b64_v4i16((LAS bf16x4*)a);
  const bf16x4 hi = __builtin_amdgcn_ds_read_tr16_b64_v4i16((LAS bf16x4*)(a + 4 * pitch));
  bf16x8 r; r[0] = lo[0]; r[1] = lo[1]; r[2] = lo[2]; r[3] = lo[3]; r[4] = hi[0]; r[5] = hi[1]; r[6] = hi[2]; r[7] = hi[3];
  return r;
}
__device__ __forceinline__ f32x4 mfma16(bf16x8 a, bf16x8 b, f32x4 c) { return __builtin_amdgcn_mfma_f32_16x16x32_bf16(a, b, c, 0, 0, 0); }
template <int ROWS, int COLS>
__device__ __forceinline__ void tile_to_lds_t(const u16* __restrict__ g, size_t gp, LAS u16* l, int lp) {
  constexpr int CPR = COLS / 8, N = ROWS * CPR / NTHR;
  u32x4 v[N];
#pragma unroll
  for (int k = 0; k < N; ++k) { const int i = threadIdx.x + k * NTHR, r = i / CPR, c = (i % CPR) * 8; v[k] = *(const u32x4*)(g + (size_t)r * gp + c); }
#pragma unroll
  for (int k = 0; k < N; ++k) { const int i = threadIdx.x + k * NTHR, r = i / CPR, c = (i % CPR) * 8; *(LAS u32x4*)(l + r * lp + c) = v[k]; }
}
__device__ __forceinline__ void tile_to_lds(const u16* __restrict__ g, size_t gp, LAS u16* l, int lp, int rows, int cols) {
  if (cols == 128) tile_to_lds_t<128, 128>(g, gp, l, lp); else tile_to_lds_t<128, 256>(g, gp, l, lp);
}

__device__ __forceinline__ void kv_item(const P& p, int item, LAS u16* lds) {
  const int ci = item >> 2, h = item & 3, tid = threadIdx.x, wid = tid >> 6, lane = tid & 63, fr = lane & 15, fq = lane >> 4;
  LAS u16* kbuf = lds; LAS u16* vbuf = lds + 128 * PK;
  __syncthreads();
  tile_to_lds(p.proj + (size_t)ci * 128 * 4096 + 512 + h * 128, 4096, kbuf, PK, 128, 128);
  tile_to_lds(p.proj + (size_t)ci * 128 * 4096 + 1024 + h * 256, 4096, vbuf, PV, 128, 256);
  __syncthreads();
  const int dir = wid >> 2, d0 = (wid & 3) * 32;
  const float lg = log1pf(-exp2f(-p.l0_decay[dir * 4 + h]));
  u16* o = (u16*)p.part + ((size_t)(ci * 4 + h) * 2 + dir) * 128 * 256;
#pragma unroll 1
  for (int nh = 0; nh < 2; ++nh) {
    f32x4 acc[8][2];
#pragma unroll
    for (int m = 0; m < 8; ++m) { acc[m][0] = (f32x4){0.f, 0.f, 0.f, 0.f}; acc[m][1] = (f32x4){0.f, 0.f, 0.f, 0.f}; }
#pragma unroll 1
    for (int ks = 0; ks < 4; ++ks) {
      bf16x8 kb[2];
      kb[0] = frag_tr(kbuf, PK, ks * 32, d0, fr, fq); kb[1] = frag_tr(kbuf, PK, ks * 32, d0 + 16, fr, fq);
#pragma unroll
      for (int j = 0; j < 8; ++j) {
        const int tok = ks * 32 + fq * 8 + j;
        const float w = __expf((float)(dir == 0 ? 127 - tok : tok) * lg);
        kb[0][j] = (short)f2bf(bf2f((u16)kb[0][j]) * w); kb[1][j] = (short)f2bf(bf2f((u16)kb[1][j]) * w);
      }
#pragma unroll
      for (int m = 0; m < 8; ++m) {
        const bf16x8 va = frag_tr(vbuf, PV, ks * 32, nh * 128 + m * 16, fr, fq);
        acc[m][0] = mfma16(va, kb[0], acc[m][0]); acc[m][1] = mfma16(va, kb[1], acc[m][1]);
      }
    }
#pragma unroll
    for (int n = 0; n < 2; ++n) {
      u16* orow = o + (size_t)(d0 + n * 16 + fr) * 256 + nh * 128 + fq * 4;
#pragma unroll
      for (int m = 0; m < 8; ++m) { u32x2 v; v[0] = pk2(acc[m][n][0], acc[m][n][1]); v[1] = pk2(acc[m][n][2], acc[m][n][3]); *(u32x2*)(orow + m * 16) = v; }
    }
  }
}

__device__ __forceinline__ void gmlp_item(const P& p, int item, LAS u16* lds) {
  const int ci = item >> 2, g = item & 3, tid = threadIdx.x, wid = tid >> 6, lane = tid & 63, fr = lane & 15, fq = lane >> 4;
  LAS u16* zn = lds; LAS u16* wsb = lds + 128 * PK; LAS float* mu = (LAS float*)(lds + 2 * 128 * PK); LAS float* rs = mu + 128;
  __syncthreads();
  {
    u32x4 zv[16];
#pragma unroll
    for (int k = 0; k < 16; ++k) zv[k] = *(const u32x4*)(p.proj + (size_t)(ci * 128 + wid + 8 * k) * 4096 + 3584 + lane * 8);
#pragma unroll
    for (int k = 0; k < 16; ++k) {
      float s = 0.f, s2 = 0.f;
#pragma unroll
      for (int e = 0; e < 4; ++e) { const float a = __uint_as_float(zv[k][e] << 16), b = __uint_as_float(zv[k][e] & 0xffff0000u); s += a + b; s2 += a * a + b * b; }
      s = wave_sum(s); s2 = wave_sum(s2);
      if (lane == 0) { const float m = s * (1.f / 512.f); const float var = fmaxf(s2 * (1.f / 512.f) - m * m, 0.f); mu[wid + 8 * k] = m; rs[wid + 8 * k] = rsqrtf(var + EPS); }
    }
  }
  u32x4 zr[4];
#pragma unroll
  for (int k = 0; k < 4; ++k) { const int i = tid + k * NTHR, q = i >> 4, c = (i & 15) * 8; zr[k] = *(const u32x4*)(p.proj + (size_t)(ci * 128 + q) * 4096 + 3584 + g * 128 + c); }
  {
    const float* W = p.l0_gws + (size_t)g * 128 * 128;
    f32x4 wv[8];
#pragma unroll
    for (int k = 0; k < 8; ++k) { const int i = tid + k * NTHR; wv[k] = *(const f32x4*)(W + (i >> 5) * 128 + (i & 31) * 4); }
#pragma unroll
    for (int k = 0; k < 8; ++k) {
      const int i = tid + k * NTHR, r = i >> 5, c = (i & 31) * 4;
      u32x2 o; o[0] = pk2(wv[k][0], wv[k][1]); o[1] = pk2(wv[k][2], wv[k][3]);
      *(LAS u32x2*)(wsb + r * PK + c) = o;
    }
  }
  __syncthreads();
#pragma unroll
  for (int k = 0; k < 4; ++k) {
    const int i = tid + k * NTHR, q = i >> 4, c = (i & 15) * 8;
    const float m = mu[q], r = rs[q];
    u32x4 o;
#pragma unroll
    for (int e = 0; e < 4; ++e) o[e] = pk2((__uint_as_float(zr[k][e] << 16) - m) * r, (__uint_as_float(zr[k][e] & 0xffff0000u) - m) * r);
    *(LAS u32x4*)(zn + q * PK + c) = o;
  }
  __syncthreads();
  f32x4 acc[8];
#pragma unroll
  for (int m = 0; m < 8; ++m) acc[m] = (f32x4){0.f, 0.f, 0.f, 0.f};
#pragma unroll
  for (int ks = 0; ks < 4; ++ks) {
    const bf16x8 wb = frag_row(wsb, PK, wid * 16, ks * 32, fr, fq);
#pragma unroll
    for (int m = 0; m < 8; ++m) acc[m] = mfma16(frag_tr(zn, PK, ks * 32, m * 16, fr, fq), wb, acc[m]);
  }
  {
    const int pr = wid * 16 + fr, t = ci * 128 + pr;
    const float gb = p.l0_gb[g * 128 + pr];
    const u16* urow = p.proj + (size_t)t * 4096 + 3072 + g * 128 + fq * 4;
    u16* orow = p.cat + (size_t)t * 1536 + 1024 + g * 128 + fq * 4;
#pragma unroll
    for (int m = 0; m < 8; ++m) {
      const u32x2 uv = *(const u32x2*)(urow + m * 16);
      u32x2 v;
      v[0] = pk2((acc[m][0] + gb) * __uint_as_float(uv[0] << 16), (acc[m][1] + gb) * __uint_as_float(uv[0] & 0xffff0000u));
      v[1] = pk2((acc[m][2] + gb) * __uint_as_float(uv[1] << 16), (acc[m][3] + gb) * __uint_as_float(uv[1] & 0xffff0000u));
      *(u32x2*)(orow + m * 16) = v;
    }
  }
}
__device__ __forceinline__ void phase_mix_a(const P& p, LAS u16* lds) {
  for (int it = blockIdx.x; it < 384; it += gridDim.x) { if (it < 192) kv_item(p, it, lds); else gmlp_item(p, it - 192, lds); }
}

__device__ __forceinline__ void build_state(const P& p, LAS u16* bbuf, const float* S0, float w0, int cbase, int h, int dir, int c_lo, int c_hi, int c_ref, float lg128) {
  const int tid = threadIdx.x;
#pragma unroll 1
  for (int half = 0; half < 2; ++half) {
    f32x4 a[8];
    const int base = (tid + half * 4096) * 4;
    if (S0) {
#pragma unroll
      for (int k = 0; k < 8; ++k) a[k] = *(const f32x4*)(S0 + base + k * 2048);
#pragma unroll
      for (int k = 0; k < 8; ++k) a[k] = a[k] * w0;
    } else {
#pragma unroll
      for (int k = 0; k < 8; ++k) a[k] = (f32x4){0.f, 0.f, 0.f, 0.f};
    }
#pragma unroll 1
    for (int cc = c_lo; cc < c_hi; ++cc) {
      const int e = dir == 0 ? (c_ref - 1 - cc) : (cc - c_ref - 1);
      const float w = __expf(lg128 * (float)e);
      const float* src = p.part + ((size_t)((cbase + cc) * 4 + h) * 2 + dir) * 128 * 256 + base;
      f32x4 t[8];
#pragma unroll
      for (int k = 0; k < 8; ++k) t[k] = *(const f32x4*)(src + k * 2048);
#pragma unroll
      for (int k = 0; k < 8; ++k) a[k] = a[k] + t[k] * w;
    }
#pragma unroll
    for (int k = 0; k < 8; ++k) {
      const int i = tid + half * 4096 + k * 512, r = i >> 6, c = (i & 63) * 4;
      u32x2 o; o[0] = pk2(a[k][0], a[k][1]); o[1] = pk2(a[k][2], a[k][3]);
      *(LAS u32x2*)(bbuf + r * PV + c) = o;
    }
  }
}
__device__ __forceinline__ void scan_item(const P& p, int item, unsigned* scnt) {
  const int combo = item >> 2, q = item & 3, dir = combo & 1, h = (combo >> 1) & 3, sb = combo >> 3, tid = threadIdx.x;
  const float g = __expf(128.f * log1pf(-exp2f(-p.l0_decay[dir * 4 + h])));
  const float* S0 = p.state + ((size_t)(sb * 2 + dir) * 4 + h) * 128 * 256 + q * 32 * 256;
  const u16* KV = (const u16*)p.part + ((size_t)((32 + sb * 8) * 4 + h) * 2 + dir) * 128 * 256 + q * 32 * 256;
  const __amdgpu_buffer_rsrc_t rs = mk_rsrc(p.stimg, 2u * 4u * 2u * 8u * 128u * 256u * 2u);
  const unsigned obase = (unsigned)((((size_t)combo * 8) * 128 * 256 + q * 32 * 256) * 2);
  float s[2][8]; u32x4 kv[7][2];
#pragma unroll
  for (int k = 0; k < 2; ++k) {
    const f32x4 a = *(const f32x4*)(S0 + (tid + 512 * k) * 8), b2 = *(const f32x4*)(S0 + (tid + 512 * k) * 8 + 4);
    s[k][0] = a[0]; s[k][1] = a[1]; s[k][2] = a[2]; s[k][3] = a[3]; s[k][4] = b2[0]; s[k][5] = b2[1]; s[k][6] = b2[2]; s[k][7] = b2[3];
  }
#pragma unroll
  for (int c = 0; c < 7; ++c)
#pragma unroll
    for (int k = 0; k < 2; ++k) kv[c][k] = *(const u32x4*)(KV + (size_t)(c + dir) * (4 * 2 * 128 * 256) + (tid + 512 * k) * 8);
#pragma unroll
  for (int st = 0; st < 8; ++st) {
    const int c = dir == 0 ? st : 7 - st;
#pragma unroll
    for (int k = 0; k < 2; ++k) {
      if (st > 0) {
        const u32x4 t = kv[dir == 0 ? st - 1 : 7 - st][k];
#pragma unroll
        for (int e = 0; e < 4; ++e) { s[k][2 * e] = s[k][2 * e] * g + __uint_as_float(t[e] << 16); s[k][2 * e + 1] = s[k][2 * e + 1] * g + __uint_as_float(t[e] & 0xffff0000u); }
      }
      u32x4 v; v[0] = pk2(s[k][0], s[k][1]); v[1] = pk2(s[k][2], s[k][3]); v[2] = pk2(s[k][4], s[k][5]); v[3] = pk2(s[k][6], s[k][7]);
      __builtin_amdgcn_raw_buffer_store_b128(v, rs, obase + (unsigned)(((size_t)c * 128 * 256 + (tid + 512 * k) * 8) * 2), 0, 16);
    }
  }
  asm volatile("s_waitcnt vmcnt(0)" ::: "memory");
  __syncthreads();
  if (tid == 0) xb_add(&scnt[combo * 16], 1u);
}
__device__ __forceinline__ void ret_item(const P& p, int item, LAS u16* lds, unsigned* scnt) {
  const int ci = item >> 2, h = item & 3, tid = threadIdx.x, wid = tid >> 6, lane = tid & 63, fr = lane & 15, fq = lane >> 4;
  int sb, lc, n;
  if (ci < 32) { sb = -1; lc = ci & 1; n = 2; } else { sb = (ci - 32) >> 3; lc = (ci - 32) & 7; n = 8; }
  const int cbase = ci - lc;
  const float lgf = log1pf(-exp2f(-p.l0_decay[h])), lgb = log1pf(-exp2f(-p.l0_decay[4 + h]));
  LAS u16* kbuf = lds; LAS u16* bbuf = lds + 128 * PK; LAS float* red = (LAS float*)(lds + 128 * PK + 128 * PV);
  const bool hasF = (sb >= 0) || lc > 0, hasB = (sb >= 0) || lc < n - 1;
  const u16* qg = p.proj + (size_t)ci * 128 * 4096 + h * 128;
  __syncthreads();
  tile_to_lds(p.proj + (size_t)ci * 128 * 4096 + 512 + h * 128, 4096, kbuf, PK, 128, 128);
  __syncthreads();
  {
    f32x4 s[8];
#pragma unroll
    for (int nn = 0; nn < 8; ++nn) s[nn] = (f32x4){0.f, 0.f, 0.f, 0.f};
    bf16x8 qa[4];
#pragma unroll
    for (int ks = 0; ks < 4; ++ks) qa[ks] = *(const bf16x8*)(qg + (size_t)(wid * 16 + fr) * 4096 + ks * 32 + fq * 8);
#pragma unroll
    for (int ks = 0; ks < 4; ++ks) {
#pragma unroll
      for (int nn = 0; nn < 8; ++nn) s[nn] = mfma16(qa[ks], frag_row(kbuf, PK, nn * 16, ks * 32, fr, fq), s[nn]);
    }
    __syncthreads();
    int bd = wid * 16 + fq * 4 - fr;
    asm volatile("" : "+v"(bd));
    LAS u16* prow = kbuf + (wid * 16 + fq * 4) * PK + fr;
#pragma unroll
    for (int nn = 0; nn < 8; ++nn)
#pragma unroll
      for (int j = 0; j < 4; ++j) {
        const int d = bd + j - 16 * nn;
        const float w = d > 0 ? __expf((float)d * lgf) : (d < 0 ? __expf((float)(-d) * lgb) : 2.f);
        prow[j * PK + nn * 16] = f2bf(s[nn][j] * w);
      }
  }
  const int m0 = (wid & 3) * 32, n0 = (wid >> 2) * 128;
  f32x4 acc[2][8];
#pragma unroll
  for (int m = 0; m < 2; ++m)
#pragma unroll
    for (int nn = 0; nn < 8; ++nn) acc[m][nn] = (f32x4){0.f, 0.f, 0.f, 0.f};
  const u16* qrow = qg + (size_t)(m0 + fr) * 4096 + fq * 8;
  if (sb >= 0) {
    if (tid == 0) {
      XB_SPIN(xb_ld(&scnt[((sb * 4 + h) * 2 + 0) * 16]) < 4u || xb_ld(&scnt[((sb * 4 + h) * 2 + 1) * 16]) < 4u, p.bar);
      __builtin_amdgcn_fence(__ATOMIC_ACQUIRE, "agent");
      asm volatile("s_waitcnt vmcnt(0)" ::: "memory");
    }
    __syncthreads();
    tile_to_lds(p.stimg + ((size_t)((sb * 4 + h) * 2 + 0) * 8 + lc) * 128 * 256, 256, bbuf, PV, 128, 256);
    __syncthreads();
  } else if (hasF) {
    tile_to_lds((const u16*)p.part + ((size_t)((cbase + 0) * 4 + h) * 2 + 0) * 128 * 256, 256, bbuf, PV, 128, 256);
    __syncthreads();
  }
  if (hasF) {
    {
      bf16x8 q0[4], q1[4];
#pragma unroll
      for (int ks = 0; ks < 4; ++ks) { q0[ks] = *(const bf16x8*)(qrow + ks * 32); q1[ks] = *(const bf16x8*)(qrow + 16 * 4096 + ks * 32); }
#pragma unroll 1
      for (int ks = 0; ks < 4; ++ks) {
        const bf16x8 a0 = ks == 0 ? q0[0] : (ks == 1 ? q0[1] : (ks == 2 ? q0[2] : q0[3])), a1 = ks == 0 ? q1[0] : (ks == 1 ? q1[1] : (ks == 2 ? q1[2] : q1[3]));
#pragma unroll
        for (int nn = 0; nn < 8; ++nn) {
          const bf16x8 b = frag_tr(bbuf, PV, ks * 32, n0 + nn * 16, fr, fq);
          acc[0][nn] = mfma16(a0, b, acc[0][nn]); acc[1][nn] = mfma16(a1, b, acc[1][nn]);
        }
      }
    }
#pragma unroll
    for (int m = 0; m < 2; ++m)
#pragma unroll
      for (int j = 0; j < 4; ++j) {
        const int il = m0 + m * 16 + fq * 4 + j;
        const float sc = hasB ? __expf((float)(il + 1) * lgf - (float)(128 - il) * lgb) : __expf((float)(il + 1) * lgf);
#pragma unroll
        for (int nn = 0; nn < 8; ++nn) acc[m][nn][j] *= sc;
      }
  }
  if (hasB) {
    __syncthreads();
    if (sb >= 0) tile_to_lds(p.stimg + ((size_t)((sb * 4 + h) * 2 + 1) * 8 + lc) * 128 * 256, 256, bbuf, PV, 128, 256);
    else tile_to_lds((const u16*)p.part + ((size_t)((cbase + 1) * 4 + h) * 2 + 1) * 128 * 256, 256, bbuf, PV, 128, 256);
    __syncthreads();
    {
      bf16x8 q0[4], q1[4];
#pragma unroll
      for (int ks = 0; ks < 4; ++ks) { q0[ks] = *(const bf16x8*)(qrow + ks * 32); q1[ks] = *(const bf16x8*)(qrow + 16 * 4096 + ks * 32); }
#pragma unroll 1
      for (int ks = 0; ks < 4; ++ks) {
        const bf16x8 a0 = ks == 0 ? q0[0] : (ks == 1 ? q0[1] : (ks == 2 ? q0[2] : q0[3])), a1 = ks == 0 ? q1[0] : (ks == 1 ? q1[1] : (ks == 2 ? q1[2] : q1[3]));
#pragma unroll
        for (int nn = 0; nn < 8; ++nn) {
          const bf16x8 b = frag_tr(bbuf, PV, ks * 32, n0 + nn * 16, fr, fq);
          acc[0][nn] = mfma16(a0, b, acc[0][nn]); acc[1][nn] = mfma16(a1, b, acc[1][nn]);
        }
      }
    }
#pragma unroll
    for (int m = 0; m < 2; ++m)
#pragma unroll
      for (int j = 0; j < 4; ++j) {
        const int il = m0 + m * 16 + fq * 4 + j;
        const float sc = __expf((float)(128 - il) * lgb);
#pragma unroll
        for (int nn = 0; nn < 8; ++nn) acc[m][nn][j] *= sc;
      }
  }
  __syncthreads();
  tile_to_lds(p.proj + (size_t)ci * 128 * 4096 + 1024 + h * 256, 4096, bbuf, PV, 128, 256);
  __syncthreads();
#pragma unroll 1
  for (int ks = 0; ks < 4; ++ks) {
    const bf16x8 a0 = frag_row(kbuf, PK, m0, ks * 32, fr, fq), a1 = frag_row(kbuf, PK, m0 + 16, ks * 32, fr, fq);
#pragma unroll
    for (int nn = 0; nn < 8; ++nn) {
      const bf16x8 b = frag_tr(bbuf, PV, ks * 32, n0 + nn * 16, fr, fq);
      acc[0][nn] = mfma16(a0, b, acc[0][nn]); acc[1][nn] = mfma16(a1, b, acc[1][nn]);
    }
  }
#pragma unroll
  for (int m = 0; m < 2; ++m)
#pragma unroll
    for (int j = 0; j < 4; ++j) {
      float s = 0.f;
#pragma unroll
      for (int nn = 0; nn < 8; ++nn) s += acc[m][nn][j] * acc[m][nn][j];
      s += __shfl_xor(s, 1); s += __shfl_xor(s, 2); s += __shfl_xor(s, 4); s += __shfl_xor(s, 8);
      if (fr == 0) red[(wid >> 2) * 128 + m0 + m * 16 + fq * 4 + j] = s;
    }
  __syncthreads();
#pragma unroll
  for (int m = 0; m < 2; ++m)
#pragma unroll
    for (int j = 0; j < 4; ++j) {
      const int il = m0 + m * 16 + fq * 4 + j;
      const float r = rsqrtf((red[il] + red[128 + il]) * (1.f / 256.f) + EPS);
      LAS u16* orow = bbuf + il * PV + n0 + fr;
#pragma unroll
      for (int nn = 0; nn < 8; ++nn) orow[nn * 16] = f2bf(acc[m][nn][j] * r);
    }
  __syncthreads();
  {
    const u16* gbase = p.proj + (size_t)ci * 128 * 4096 + 2048 + h * 256;
    u16* obase = p.cat + (size_t)ci * 128 * 1536 + h * 256;
    u32x4 gv[8];
#pragma unroll
    for (int k = 0; k < 8; ++k) { const int i = tid + k * NTHR, r = i >> 5, c = (i & 31) * 8; gv[k] = *(const u32x4*)(gbase + (size_t)r * 4096 + c); }
#pragma unroll
    for (int k = 0; k < 8; ++k) {
      const int i = tid + k * NTHR, r = i >> 5, c = (i & 31) * 8;
      const u32x4 ov = *(const LAS u32x4*)(bbuf + r * PV + c);
      u32x4 o;
#pragma unroll
      for (int e = 0; e < 4; ++e) o[e] = pk2(__uint_as_float(ov[e] << 16) * __uint_as_float(gv[k][e] << 16), __uint_as_float(ov[e] & 0xffff0000u) * __uint_as_float(gv[k][e] & 0xffff0000u));
      *(u32x4*)(obase + (size_t)r * 1536 + c) = o;
    }
  }
}
__device__ __forceinline__ void state_item(const P& p, int item) {
  const int b = item >> 3, h = (item >> 1) & 3, dir = item & 1;
  const float w = __expf(128.f * log1pf(-exp2f(-p.l0_decay[dir * 4 + h])));
  const int c_old = dir == 0 ? 2 * b : 2 * b + 1, c_new = dir == 0 ? 2 * b + 1 : 2 * b;
  const u16* A = (const u16*)p.part + ((size_t)(c_old * 4 + h) * 2 + dir) * 128 * 256;
  const u16* B = (const u16*)p.part + ((size_t)(c_new * 4 + h) * 2 + dir) * 128 * 256;
  float* o = p.out + (size_t)NT * DM + ((size_t)(b * 2 + dir) * 4 + h) * 128 * 256;
  u32x4 av[8], bv[8];
#pragma unroll
  for (int k = 0; k < 8; ++k) { const int i = threadIdx.x + k * NTHR; av[k] = *(const u32x4*)(A + i * 8); bv[k] = *(const u32x4*)(B + i * 8); }
#pragma unroll
  for (int k = 0; k < 8; ++k) {
    const int i = threadIdx.x + k * NTHR;
    f32x4 o0, o1;
    o0[0] = __uint_as_float(av[k][0] << 16) * w + __uint_as_float(bv[k][0] << 16); o0[1] = __uint_as_float(av[k][0] & 0xffff0000u) * w + __uint_as_float(bv[k][0] & 0xffff0000u);
    o0[2] = __uint_as_float(av[k][1] << 16) * w + __uint_as_float(bv[k][1] << 16); o0[3] = __uint_as_float(av[k][1] & 0xffff0000u) * w + __uint_as_float(bv[k][1] & 0xffff0000u);
    o1[0] = __uint_as_float(av[k][2] << 16) * w + __uint_as_float(bv[k][2] << 16); o1[1] = __uint_as_float(av[k][2] & 0xffff0000u) * w + __uint_as_float(bv[k][2] & 0xffff0000u);
    o1[2] = __uint_as_float(av[k][3] << 16) * w + __uint_as_float(bv[k][3] << 16); o1[3] = __uint_as_float(av[k][3] & 0xffff0000u) * w + __uint_as_float(bv[k][3] & 0xffff0000u);
    *(f32x4*)(o + i * 8) = o0; *(f32x4*)(o + i * 8 + 4) = o1;
  }
}
__device__ __forceinline__ void phase_mix_b(const P& p, LAS u16* lds, unsigned* scnt) {
  const int b = (int)blockIdx.x;
  if (b < 64) ret_item(p, 128 + b, lds, scnt);
  else if (b < 192) ret_item(p, b - 64, lds, scnt);
  else { scan_item(p, b - 192, scnt); state_item(p, 2 * (b - 192)); state_item(p, 2 * (b - 192) + 1); }
}

__device__ __forceinline__ void phase_conv(const P& p) {
  const u16* __restrict__ pj = p.proj;
  const size_t total = (size_t)NT * 256, stride = (size_t)gridDim.x * NTHR;
  for (size_t i0 = (size_t)blockIdx.x * NTHR + threadIdx.x; i0 < total; i0 += 4 * stride) {
    u32x2 av[4][3], bv[4][3], bgv[4]; bool ok[4][3];
#pragma unroll
    for (int u = 0; u < 4; ++u) {
      const size_t i = i0 + u * stride; const bool live = i < total;
      const int t = live ? (int)(i >> 8) : 0, c4 = (int)(i & 255) * 4;
      const int seg = t < NPROMPT_T ? 256 : 64, pos = t < NPROMPT_T ? (t & 255) : ((t - NPROMPT_T) & 63);
#pragma unroll
      for (int d = 0; d < 3; ++d) {
        const int pp = pos + d - 1; ok[u][d] = live && pp >= 0 && pp < seg;
        const u16* r = pj + (size_t)(ok[u][d] ? t + d - 1 : t) * 3072;
        av[u][d] = *(const u32x2*)(r + 1024 + c4); bv[u][d] = *(const u32x2*)(r + 2048 + c4);
      }
      bgv[u] = *(const u32x2*)(pj + (size_t)t * 3072 + c4);
    }
#pragma unroll
    for (int u = 0; u < 4; ++u) {
      const size_t i = i0 + u * stride; if (i >= total) continue;
      const int t = (int)(i >> 8), c4 = (int)(i & 255) * 4;
      f32x4 xc[3];
#pragma unroll
      for (int d = 0; d < 3; ++d) {
        const u32x2 a = av[u][d], b2 = bv[u][d];
        xc[d][0] = __uint_as_float(a[0] << 16) * __uint_as_float(b2[0] << 16); xc[d][1] = __uint_as_float(a[0] & 0xffff0000u) * __uint_as_float(b2[0] & 0xffff0000u);
        xc[d][2] = __uint_as_float(a[1] << 16) * __uint_as_float(b2[1] << 16); xc[d][3] = __uint_as_float(a[1] & 0xffff0000u) * __uint_as_float(b2[1] & 0xffff0000u);
        if (!ok[u][d]) xc[d] = (f32x4){0.f, 0.f, 0.f, 0.f};
      }
      const f32x4 w0 = *(const f32x4*)(p.l1_conv + c4), w1 = *(const f32x4*)(p.l1_conv + 1024 + c4), w2 = *(const f32x4*)(p.l1_conv + 2048 + c4);
      const f32x4 bg = {__uint_as_float(bgv[u][0] << 16), __uint_as_float(bgv[u][0] & 0xffff0000u), __uint_as_float(bgv[u][1] << 16), __uint_as_float(bgv[u][1] & 0xffff0000u)};
      const f32x4 y = bg * (w0 * xc[0] + w1 * xc[1] + w2 * xc[2]);
      u32x2 o; o[0] = pk2(y[0], y[1]); o[1] = pk2(y[2], y[3]);
      *(u32x2*)(p.cat + (size_t)t * 1024 + c4) = o;
    }
  }
}

#define XB_XCNT(j)  (256  + 64 * (j))
#define XB_XSUB(j)  (1280 + 64 * (j))
#define XB_XGEN(j)  (2304 + 64 * (j))
#define XB_TOP      3328
#define XB_TOPGEN   3392
#define XCD_BAR_WORDS 3456
__device__ __forceinline__ unsigned xb_xcc_id() { return (unsigned)__builtin_amdgcn_s_getreg((3 << 11) | 20) & 0xFu; }
struct XcdBarrier { unsigned* bar; unsigned x; volatile __attribute__((address_space(3))) unsigned* st; };
__device__ __forceinline__ XcdBarrier xcd_barrier_post(unsigned* bar, volatile __attribute__((address_space(3))) unsigned* st) {
  XcdBarrier b; b.bar = bar; b.x = xb_xcc_id(); b.st = st;
  if (threadIdx.x == 0) (void)xb_add(&bar[XB_XCNT(b.x)], 1u);
  return b;
}
__device__ __forceinline__ void xcd_barrier_complete(unsigned* bar, unsigned x, unsigned& nloc, unsigned& nx) {
  const unsigned G = gridDim.x * gridDim.y * gridDim.z;
  unsigned sum, cnt, mine, sp = 0u;
  for (;;) {
    sum = 0u; cnt = 0u; mine = 0u;
#pragma unroll
    for (unsigned j = 0; j < 16; ++j) { const unsigned c = xb_ld(&bar[XB_XCNT(j)]); sum += c; cnt += (c > 0u) ? 1u : 0u; mine = (j == x) ? c : mine; }
    if (sum == G) break;
    __builtin_amdgcn_s_sleep(1);
    if ((++sp & 255u) == 0u) { if (xb_ld(&bar[XB_TMO])) break; if (sp > XB_SPIN_CAP) { atomicAdd(&bar[XB_TMO], 1u); break; } }
  }
  nloc = mine > 0u ? mine : 1u; nx = cnt > 0u ? cnt : 1u;
}
__device__ __forceinline__ void xcd_barrier(const XcdBarrier& b) {
  asm volatile("s_waitcnt vmcnt(0)" ::: "memory");
  __syncthreads();
  if (threadIdx.x == 0) {
    unsigned* bar = b.bar;
    __builtin_amdgcn_s_waitcnt(0);
    unsigned nloc = b.st[0], nx = b.st[1];
    if (nloc == 0u) { xcd_barrier_complete(bar, b.x, nloc, nx); b.st[0] = nloc; b.st[1] = nx; }
    const unsigned old = xb_add(&bar[XB_XSUB(b.x)], 1u);
    const unsigned gen = old / nloc;
    if (old + 1u == (gen + 1u) * nloc) {
      __builtin_amdgcn_fence(__ATOMIC_RELEASE, "agent");
      asm volatile("s_waitcnt vmcnt(0)" ::: "memory");
      const unsigned og = xb_add(&bar[XB_TOP], 1u);
      const unsigned tg = og / nx;
      if (og + 1u == (tg + 1u) * nx) xb_add(&bar[XB_TOPGEN], 1u);
      else XB_SPIN(xb_ld(&bar[XB_TOPGEN]) == tg, bar);
      __builtin_amdgcn_fence(__ATOMIC_ACQUIRE, "agent");
      xb_add(&bar[XB_XGEN(b.x)], 1u);
      asm volatile("s_waitcnt vmcnt(0)" ::: "memory");
    } else {
      XB_SPIN(xb_ld(&bar[XB_XGEN(b.x)]) == gen, bar);
      __builtin_amdgcn_fence(__ATOMIC_ACQUIRE, "agent");
      asm volatile("s_waitcnt vmcnt(0)" ::: "memory");
    }
  }
  __syncthreads();
}

__device__ __forceinline__ void phase_norm_fused(const NormArgs& a, unsigned* cnt, unsigned* bar) {
  pg8::Order S; S.init(NT, 1024, 2, (int)gridDim.x, (int)blockIdx.x);
  pg8::Unit u;
  if (!S.next(0, u)) return;
  asm volatile("s_waitcnt vmcnt(0)" ::: "memory");
  __syncthreads();
  if (threadIdx.x == 0) {
    for (int i = 0; S.next(i, u); ++i) xb_add(&cnt[u.pm * 16], 1u);
  }
  const int wid = threadIdx.x >> 6, lane = threadIdx.x & 63;
  for (int i = 0; S.next(i, u); ++i) {
    if (threadIdx.x == 0) {
      XB_SPIN(xb_ld(&cnt[u.pm * 16]) < 8u, bar);
      __builtin_amdgcn_fence(__ATOMIC_ACQUIRE, "agent");
      asm volatile("s_waitcnt vmcnt(0)" ::: "memory");
    }
    __syncthreads();
    const int r0 = u.pm * 256 + (u.pn * 2 + u.ks) * 32 + wid * 4;
    norm_rows<4, 2>(a, r0, lane);
  }
}

__device__ __forceinline__ void phase_ffn(const P& p, const u16* w1t, const u16* w2t, const NormArgs& na, unsigned* cntA, unsigned* cntB, float* lds) {
  const int c = (int)blockIdx.x, tid = threadIdx.x, wid = tid >> 6, lane = tid & 63, x = c & 7;
  PG8_LAS unsigned char* l3 = (PG8_LAS unsigned char*)lds;
  __syncthreads();
  { pg8::Gemm g{p.hA, w1t, NT, 4096, 1024, 1}; pg8::FfnOrder1 S{c}; EpiRelu2W e{mk_rsrc(p.proj, (unsigned)NT * 4096u * 2u)}; pg8::gemm_phase(l3, g, S, e); }
  asm volatile("s_waitcnt vmcnt(0)" ::: "memory");
  __syncthreads();
  if (tid == 0) { pg8::FfnOrder1 S{c}; pg8::Unit u; for (int i = 0; S.next(i, u); ++i) xb_add(&cntA[u.pm * 16], 1u); }
  pg8::Unit ue, ul;
  { const int oj = (c - 128) >> 3; ue.pm = x; ue.pn = oj >> 2; ue.ks = oj & 3; }
  { const int o = c >> 3; ul.pm = 8 + 2 * x + (o >> 4); ul.pn = (o & 15) >> 2; ul.ks = o & 3; }
#pragma unroll 1
  for (int pass = (c >= 128 ? 0 : 1); pass < 2; ++pass) {
    const pg8::Unit u = pass == 0 ? ue : ul;
    if (tid == 0) {
      XB_SPIN(xb_ld(&cntA[u.pm * 16]) < 16u, p.bar);
      __builtin_amdgcn_fence(__ATOMIC_ACQUIRE, "agent");
      asm volatile("s_waitcnt vmcnt(0)" ::: "memory");
    }
    __syncthreads();
    { pg8::Gemm g{p.proj, w2t, NT, 1024, 4096, 4}; pg8::OneUnit S{u}; EpiPartW e{mk_rsrc(p.part, 4u * (unsigned)NT * 1024u * 2u)}; pg8::gemm_phase(l3, g, S, e); }
    asm volatile("s_waitcnt vmcnt(0)" ::: "memory");
    __syncthreads();
    if (tid == 0) xb_add(&cntB[u.pm * 16], 1u);
  }
#pragma unroll 1
  for (int pass = (c >= 128 ? 0 : 1); pass < 2; ++pass) {
    const pg8::Unit u = pass == 0 ? ue : ul;
    if (tid == 0) {
      XB_SPIN(xb_ld(&cntB[u.pm * 16]) < 16u, p.bar);
      __builtin_amdgcn_fence(__ATOMIC_ACQUIRE, "agent");
      asm volatile("s_waitcnt vmcnt(0)" ::: "memory");
    }
    __syncthreads();
    norm_rows<2, 4>(na, u.pm * 256 + (u.pn * 4 + u.ks) * 16 + wid * 2, lane);
  }
}

__device__ __forceinline__ void conv_rect(const P& p, int row0, int ch0) {
  const u16* __restrict__ pj = p.proj;
  const __amdgpu_buffer_rsrc_t rs = mk_rsrc(p.cat, (unsigned)NT * 1024u * 2u);
#pragma unroll 1
  for (int b0 = 0; b0 < 16; b0 += 4) {
    u32x2 av[4][3], bv[4][3], bgv[4]; bool ok[4][3];
#pragma unroll
    for (int u = 0; u < 4; ++u) {
      const int i = threadIdx.x + (b0 + u) * NTHR;
      const int t = row0 + (i >> 7), c4 = ch0 + (i & 127) * 4;
      const int seg = t < NPROMPT_T ? 256 : 64, pos = t < NPROMPT_T ? (t & 255) : ((t - NPROMPT_T) & 63);
#pragma unroll
      for (int d = 0; d < 3; ++d) {
        const int pp = pos + d - 1; ok[u][d] = pp >= 0 && pp < seg;
        const u16* r = pj + (size_t)(ok[u][d] ? t + d - 1 : t) * 3072;
        av[u][d] = *(const u32x2*)(r + 1024 + c4); bv[u][d] = *(const u32x2*)(r + 2048 + c4);
      }
      bgv[u] = *(const u32x2*)(pj + (size_t)t * 3072 + c4);
    }
#pragma unroll
    for (int u = 0; u < 4; ++u) {
      const int i = threadIdx.x + (b0 + u) * NTHR;
      const int t = row0 + (i >> 7), c4 = ch0 + (i & 127) * 4;
      f32x4 xc[3];
#pragma unroll
      for (int d = 0; d < 3; ++d) {
        const u32x2 a = av[u][d], b2 = bv[u][d];
        xc[d][0] = __uint_as_float(a[0] << 16) * __uint_as_float(b2[0] << 16); xc[d][1] = __uint_as_float(a[0] & 0xffff0000u) * __uint_as_float(b2[0] & 0xffff0000u);
        xc[d][2] = __uint_as_float(a[1] << 16) * __uint_as_float(b2[1] << 16); xc[d][3] = __uint_as_float(a[1] & 0xffff0000u) * __uint_as_float(b2[1] & 0xffff0000u);
        if (!ok[u][d]) xc[d] = (f32x4){0.f, 0.f, 0.f, 0.f};
      }
      const f32x4 w0 = *(const f32x4*)(p.l1_conv + c4), w1 = *(const f32x4*)(p.l1_conv + 1024 + c4), w2 = *(const f32x4*)(p.l1_conv + 2048 + c4);
      const f32x4 bg = {__uint_as_float(bgv[u][0] << 16), __uint_as_float(bgv[u][0] & 0xffff0000u), __uint_as_float(bgv[u][1] << 16), __uint_as_float(bgv[u][1] & 0xffff0000u)};
      const f32x4 y = bg * (w0 * xc[0] + w1 * xc[1] + w2 * xc[2]);
      const unsigned long long v = (unsigned long long)pk2(y[0], y[1]) | ((unsigned long long)pk2(y[2], y[3]) << 32);
      __hip_atomic_store((unsigned long long*)(p.cat + (size_t)t * 1024 + c4), v, __ATOMIC_RELAXED, __HIP_MEMORY_SCOPE_AGENT);
    }
  }
}

__device__ __forceinline__ void phase_l1(const P& p, const NormArgs& na, unsigned* cntA, unsigned* cntC, unsigned* cntB, float* lds) {
  const int c = (int)blockIdx.x, tid = threadIdx.x, wid = tid >> 6, lane = tid & 63;
  PG8_LAS unsigned char* l3 = (PG8_LAS unsigned char*)lds;
  __syncthreads();
  { pg8::Gemm g{p.hA, p.wt1_in, NT, 3072, 1024, 1}; pg8::L1InOrder S{c}; EpiPlain e{p.proj, 3072}; pg8::gemm_phase(l3, g, S, e); }
  asm volatile("s_waitcnt vmcnt(0)" ::: "memory");
  __syncthreads();
  if (tid == 0) { pg8::L1InOrder S{c}; pg8::Unit u; for (int i = 0; S.next(i, u); ++i) xb_add(&cntA[u.pm * 16], 1u); }
  if (c < 40 || c >= 232) return;
  pg8::Unit u;
  { const int j = c - 40; u.pm = j >> 3; u.pn = (j & 7) >> 1; u.ks = j & 1; }
  if (tid == 0) {
    XB_SPIN(xb_ld(&cntA[u.pm * 16]) < 12u, p.bar);
    __builtin_amdgcn_fence(__ATOMIC_ACQUIRE, "agent");
    asm volatile("s_waitcnt vmcnt(0)" ::: "memory");
  }
  __syncthreads();
  conv_rect(p, u.pm * 256 + u.pn * 64, u.ks * 512);
  asm volatile("s_waitcnt vmcnt(0)" ::: "memory");
  __syncthreads();
  if (tid == 0) {
    xb_add(&cntC[(u.pm * 2 + u.ks) * 8], 1u);
    XB_SPIN(xb_ld(&cntC[(u.pm * 2 + u.ks) * 8]) < 4u, p.bar);
    __builtin_amdgcn_fence(__ATOMIC_ACQUIRE, "agent");
    asm volatile("s_waitcnt vmcnt(0)" ::: "memory");
  }
  __syncthreads();
  { pg8::Gemm g{p.cat, p.wt1_out, NT, 1024, 1024, 2}; pg8::OneUnit S{u}; EpiPartW e{mk_rsrc(p.part, 4u * (unsigned)NT * 1024u * 2u)}; pg8::gemm_phase(l3, g, S, e); }
  asm volatile("s_waitcnt vmcnt(0)" ::: "memory");
  __syncthreads();
  if (tid == 0) {
    xb_add(&cntB[u.pm * 16], 1u);
    XB_SPIN(xb_ld(&cntB[u.pm * 16]) < 8u, p.bar);
    __builtin_amdgcn_fence(__ATOMIC_ACQUIRE, "agent");
    asm volatile("s_waitcnt vmcnt(0)" ::: "memory");
  }
  __syncthreads();
  norm_rows<4, 2>(na, u.pm * 256 + (u.pn * 2 + u.ks) * 32 + wid * 4, lane);
}

constexpr int NPHASE = 8;
#ifndef REPMASK
#define REPMASK 0
#endif
__global__ void __launch_bounds__(NTHR) mega(P p, int lo, int hi) {
  extern __shared__ __attribute__((aligned(16))) unsigned char smem[];
  float* lds = (float*)smem;
  cg::grid_group grid = cg::this_grid();
  volatile LAS unsigned* xst = (volatile LAS unsigned*)(smem + 131072);
  if (threadIdx.x == 0) { xst[0] = 0u; xst[1] = 0u; }
  __syncthreads();
  const XcdBarrier xb = xcd_barrier_post(p.bar, xst);
  if (hi < 0) grid.sync();
  const float* m0 = p.mod; const float* m1 = p.mod + 3 * 6144;
#define PH(n, ...) if (lo <= (n) && (n) < hi) { if ((n) > lo) xcd_barrier(xb); __VA_ARGS__ if ((REPMASK >> (n)) & 1) { xcd_barrier(xb); __VA_ARGS__ } }
  unsigned* pcnt = p.bar + XCD_BAR_WORDS;
  float* const xs = p.xres + (size_t)NPROMPT_T * DM; float* const pp = p.part;
  PH(0, { phase_prep(p, lds);
          if (threadIdx.x == 0) { XB_SPIN(xb_ld(pcnt + 9 * 384) < 96u, p.bar); __builtin_amdgcn_fence(__ATOMIC_ACQUIRE, "agent"); asm volatile("s_waitcnt vmcnt(0)" ::: "memory"); }
          __syncthreads();
          NormArgs a{p.x_prompt, p.x_sample, nullptr, nullptr, nullptr, nullptr, p.l0_norm1, m0 + 0, m0 + 1024, p.hA, nullptr}; phase_norm(a); })
  PH(1, { EpiProj0 e{p.proj}; phase_gemm(p.hA, p.wt0_in, NT, 4096, 1024, 1, e, lds); phase_prep2(p, lds, 0, 128); })
  PH(2, { phase_mix_a(p, (LAS u16*)smem); phase_prep2(p, lds, 2, 128); })
  PH(3, phase_mix_b(p, (LAS u16*)smem, pcnt + 6 * 384);)
  PH(4, { EpiPartW e{mk_rsrc(p.part, 4u * (unsigned)NT * 1024u * 2u)}; phase_gemm(p.cat, p.wt0_out, NT, 1024, 1536, 2, e, lds);
          NormArgs a{p.x_prompt, p.x_sample, pp, pp, m0 + 2048, p.xres, p.l0_norm2, m0 + 3072, m0 + 4096, p.hA, nullptr}; phase_norm_fused(a, pcnt + 0 * 384, p.bar);
          phase_prep2(p, lds, 1, 192); })
  PH(5, { NormArgs a{p.xres, xs, pp, pp, m0 + 5120, p.xres, p.l1_norm1, m1 + 0, m1 + 1024, p.hA, nullptr}; phase_ffn(p, p.wt0_f1, p.wt0_f2, a, pcnt + 1 * 384, pcnt + 2 * 384, lds); })
  PH(6, { NormArgs a{p.xres, xs, pp, pp, m1 + 2048, p.xres, p.l1_norm2, m1 + 3072, m1 + 4096, p.hA, nullptr}; phase_l1(p, a, pcnt + 7 * 384, pcnt + 8 * 384, pcnt + 3 * 384, lds); })
  PH(7, { NormArgs a{p.xres, xs, pp, pp, m1 + 5120, nullptr, p.final_norm, nullptr, nullptr, nullptr, p.out}; phase_ffn(p, p.wt1_f1, p.wt1_f2, a, pcnt + 4 * 384, pcnt + 5 * 384, lds); })
#undef PH
}

constexpr size_t LDS_BYTES = 131072 + 256;
constexpr bool ONE_LAUNCH = true;

extern "C" void kernel_launch(void* const* d_in, const int* in_sizes, int n_in, void* d_out, int out_size, void* d_ws, size_t ws_size, hipStream_t stream) {
  static int grid_blocks = 0;
  if (!grid_blocks) {
    hipFuncSetAttribute((const void*)mega, hipFuncAttributeMaxDynamicSharedMemorySize, (int)LDS_BYTES);
    int dev = 0, cus = 0, per_cu = 0;
    hipGetDevice(&dev);
    hipDeviceGetAttribute(&cus, hipDeviceAttributeMultiprocessorCount, dev);
    hipOccupancyMaxActiveBlocksPerMultiprocessor(&per_cu, mega, NTHR, LDS_BYTES);
    if (per_cu < 1) per_cu = 1;
    if (per_cu > 1) per_cu = 1;
    grid_blocks = 256;
  }
  P p{};
  const float* const* in = (const float* const*)d_in;
  p.x_prompt = in[0]; p.x_sample = in[1]; p.state = in[2]; p.c = in[3]; p.c_ctx = in[4];
  p.l0_norm1 = in[5]; p.l0_w_in = in[6]; p.l0_decay = in[7]; p.l0_gws = in[8]; p.l0_gb = in[9]; p.l0_w_out = in[10]; p.l0_norm2 = in[11];
  p.l0_w_mod = in[12]; p.l0_b_mod = in[13]; p.l0_f1 = in[14]; p.l0_f2 = in[15];
  p.l1_norm1 = in[16]; p.l1_w_in = in[17]; p.l1_conv = in[18]; p.l1_w_out = in[19]; p.l1_norm2 = in[20]; p.l1_w_mod = in[21]; p.l1_b_mod = in[22];
  p.l1_f1 = in[23]; p.l1_f2 = in[24]; p.final_norm = in[25];
  p.out = (float*)d_out;
  unsigned char* w = (unsigned char*)d_ws; size_t off = 0;
  auto take = [&](size_t bytes) { void* r = w + off; off += (bytes + 255) & ~(size_t)255; return r; };
  p.wt0_in = (u16*)take((size_t)4096 * 1024 * 2); p.wt0_out = (u16*)take((size_t)1024 * 1536 * 2);
  p.wt0_f1 = (u16*)take((size_t)4096 * 1024 * 2); p.wt0_f2 = (u16*)take((size_t)4096 * 1024 * 2);
  p.wt1_in = (u16*)take((size_t)3072 * 1024 * 2); p.wt1_out = (u16*)take((size_t)1024 * 1024 * 2);
  p.wt1_f1 = (u16*)take((size_t)4096 * 1024 * 2); p.wt1_f2 = (u16*)take((size_t)4096 * 1024 * 2);
  p.mod = (float*)take((size_t)2 * 3 * 6144 * 4);
  p.hA = (u16*)take((size_t)NT * 1024 * 2);
  p.proj = (u16*)take((size_t)NT * 4096 * 2);
  p.cat = (u16*)take((size_t)NT * 1536 * 2);
  p.part = (float*)take((size_t)2 * NT * 1024 * 4);
  p.xres = (float*)take((size_t)NT * 1024 * 4);
  p.stimg = (u16*)take((size_t)2 * 4 * 2 * 8 * 128 * 256 * 2);
  p.bar = (unsigned*)take((size_t)(XCD_BAR_WORDS + 10 * 384) * 4);
  hipMemsetAsync(p.bar, 0, (size_t)(XCD_BAR_WORDS + 10 * 384) * 4, stream);
  if (ONE_LAUNCH) {
    int lo = 0, hi = NPHASE; void* args[] = {&p, &lo, &hi};
    hipError_t e = hipLaunchCooperativeKernel((void*)mega, dim3(grid_blocks), dim3(NTHR), args, LDS_BYTES, stream);
    if (e != hipSuccess) fprintf(stderr, "cooperative launch failed: %s (grid %d)\n", hipGetErrorString(e), grid_blocks);
  } else {
    for (int ph = 0; ph < NPHASE; ++ph) hipLaunchKernelGGL(mega, dim3(grid_blocks), dim3(NTHR), LDS_BYTES, stream, p, ph, ph + 1);
  }
}
```

```cpp
#include <hip/hip_runtime.h>
#include <hip/hip_cooperative_groups.h>
#include <cstdio>
namespace cg = cooperative_groups;

typedef unsigned short u16;
typedef float f32x4 __attribute__((ext_vector_type(4)));
typedef unsigned u32x4 __attribute__((ext_vector_type(4)));
typedef unsigned u32x2 __attribute__((ext_vector_type(2)));

constexpr int NT = 6144, DM = 1024, NPROMPT_T = 4096;
constexpr float EPS = 1e-6f;
constexpr int NTHR = 512;

__device__ __forceinline__ float bf2f(u16 b) { return __uint_as_float(((unsigned)b) << 16); }
typedef float f32x2 __attribute__((ext_vector_type(2)));
typedef __bf16 hbf16x2 __attribute__((ext_vector_type(2)));
__device__ __forceinline__ unsigned pk2(float a, float b) { const f32x2 v = {a, b}; const hbf16x2 r = __builtin_convertvector(v, hbf16x2); return __builtin_bit_cast(unsigned, r); }
__device__ __forceinline__ u16 f2bf(float f) { return (u16)(pk2(f, 0.f) & 0xffffu); }
__device__ __forceinline__ float silu_f(float x) { return x * __builtin_amdgcn_rcpf(1.f + __expf(-x)); }
__device__ __forceinline__ float gelu_f(float x) { const float u = -1.5957691216057308f * (x + 0.044715f * x * x * x); return x * __builtin_amdgcn_rcpf(1.f + __expf(u)); }
__device__ __forceinline__ int cond_of(int t) { return t < NPROMPT_T ? 0 : 1 + ((t - NPROMPT_T) >> 10); }
__device__ __forceinline__ float wave_sum(float v) {
#pragma unroll
  for (int o = 32; o > 0; o >>= 1) v += __shfl_xor(v, o);
  return v;
}

struct P {
  const float *x_prompt, *x_sample, *state, *c, *c_ctx;
  const float *l0_norm1, *l0_w_in, *l0_decay, *l0_gws, *l0_gb, *l0_w_out, *l0_norm2, *l0_w_mod, *l0_b_mod, *l0_f1, *l0_f2;
  const float *l1_norm1, *l1_w_in, *l1_conv, *l1_w_out, *l1_norm2, *l1_w_mod, *l1_b_mod, *l1_f1, *l1_f2, *final_norm;
  float* out;
  u16 *wt0_in, *wt0_out, *wt0_f1, *wt0_f2, *wt1_in, *wt1_out, *wt1_f1, *wt1_f2;
  float* mod;
  u16* hA;
  u16* proj;
  u16* cat;
  float* part;
  float* xres;
  u16* stimg;
  unsigned* bar;
};

__device__ __forceinline__ unsigned xb_ld(unsigned* p)              { return __hip_atomic_load(p, __ATOMIC_RELAXED, __HIP_MEMORY_SCOPE_AGENT); }
__device__ __forceinline__ unsigned xb_add(unsigned* p, unsigned v) { return __hip_atomic_fetch_add(p, v, __ATOMIC_RELAXED, __HIP_MEMORY_SCOPE_AGENT); }
#define XB_TMO      128
#define XB_SPIN_CAP (1u << 18)
#define XB_SPIN(cond, bar) do { unsigned _sp = 0; while (cond) { __builtin_amdgcn_s_sleep(1); \
    if ((++_sp & 255u) == 0u) { if (xb_ld(&(bar)[XB_TMO])) break; if (_sp > XB_SPIN_CAP) { atomicAdd(&(bar)[XB_TMO], 1u); break; } } } } while (0)
#define XB_WAIT(cond, bar) do { unsigned _sp = 0; while (cond) { __builtin_amdgcn_s_sleep(16); \
    if ((++_sp & 63u) == 0u) { if (xb_ld(&(bar)[XB_TMO])) break; if (_sp > (1u << 16)) { atomicAdd(&(bar)[XB_TMO], 1u); break; } } } } while (0)

__device__ __forceinline__ __amdgpu_buffer_rsrc_t mk_rsrc(void* p, unsigned bytes) { return __builtin_amdgcn_make_buffer_rsrc(p, 0, (int)bytes, 0x00020000); }

__device__ __forceinline__ void transpose_tile(const float* __restrict__ W, int K, int N, u16* __restrict__ Wt, int tile, float* lds) {
  const int tn = N / 256; const int k0 = (tile / tn) * 64, n0 = (tile % tn) * 256;
  const int tid = threadIdx.x;
  float (*T)[257] = (float (*)[257])lds;
  __syncthreads();
  {
    const int r = tid >> 6, c4 = (tid & 63) * 4;
    f32x4 v[8];
#pragma unroll
    for (int i = 0; i < 8; ++i) v[i] = *(const f32x4*)(W + (size_t)(k0 + r + 8 * i) * N + n0 + c4);
#pragma unroll
    for (int i = 0; i < 8; ++i) { T[r + 8 * i][c4 + 0] = v[i][0]; T[r + 8 * i][c4 + 1] = v[i][1]; T[r + 8 * i][c4 + 2] = v[i][2]; T[r + 8 * i][c4 + 3] = v[i][3]; }
  }
  __syncthreads();
  {
    const int kk = (tid & 7) * 8;
#pragma unroll
    for (int ps = 0; ps < 4; ++ps) {
      const int nn = (tid >> 3) + 64 * ps;
      u32x4 o;
      o[0] = pk2(T[kk + 0][nn], T[kk + 1][nn]); o[1] = pk2(T[kk + 2][nn], T[kk + 3][nn]);
      o[2] = pk2(T[kk + 4][nn], T[kk + 5][nn]); o[3] = pk2(T[kk + 6][nn], T[kk + 7][nn]);
      *(u32x4*)(Wt + (size_t)(n0 + nn) * K + k0 + kk) = o;
    }
  }
}

__device__ __forceinline__ void adaln_item(const P& p, int item, float* lds) {
  const int l = item / 96, n0 = (item % 96) * 64;
  const float* W = l ? p.l1_w_mod : p.l0_w_mod; const float* B = l ? p.l1_b_mod : p.l0_b_mod;
  const int tid = threadIdx.x;
  float* sc = lds;
  float* red = lds + 3072;
  __syncthreads();
  for (int i = tid; i < 3072; i += NTHR) {
    const int c = i >> 10, k = i & 1023;
    const float v = c == 0 ? p.c_ctx[k] : p.c[(c - 1) * 1024 + k];
    sc[i] = silu_f(v);
  }
  __syncthreads();
  const int cg4 = tid & 15, rg = tid >> 4;
  float acc[3][4] = {};
#pragma unroll 8
  for (int it = 0; it < 32; ++it) {
    const int k = it * 32 + rg;
    const f32x4 w = *(const f32x4*)(W + (size_t)k * 6144 + n0 + cg4 * 4);
#pragma unroll
    for (int c = 0; c < 3; ++c) { const float s = sc[c * 1024 + k];
#pragma unroll
      for (int e = 0; e < 4; ++e) acc[c][e] += s * w[e]; }
  }
#pragma unroll
  for (int c = 0; c < 3; ++c)
#pragma unroll
    for (int e = 0; e < 4; ++e) red[(rg * 3 + c) * 64 + cg4 * 4 + e] = acc[c][e];
  __syncthreads();
  if (tid < 192) {
    const int c = tid >> 6, n = tid & 63; float s = B[n0 + n];
    for (int r = 0; r < 32; ++r) s += red[(r * 3 + c) * 64 + n];
    __hip_atomic_store(&p.mod[(size_t)(l * 3 + c) * 6144 + n0 + n], s, __ATOMIC_RELAXED, __HIP_MEMORY_SCOPE_AGENT);
  }
  if (l == 0) {
    asm volatile("s_waitcnt vmcnt(0)" ::: "memory");
    __syncthreads();
    if (tid == 0) xb_add(p.bar + 3456 + 9 * 384, 1u);
  }
}

__device__ __forceinline__ void phase_prep(const P& p, float* lds) {
  for (int it = blockIdx.x; it < 96 + 256; it += gridDim.x) {
    if (it < 96) adaln_item(p, it, lds); else transpose_tile(p.l0_w_in, 1024, 4096, p.wt0_in, it - 96, lds);
  }
}
__device__ __forceinline__ void phase_prep2(const P& p, float* lds, int group, int first_want) {
  const int first = (int)gridDim.x >= 256 ? first_want : 0, nblk = (int)gridDim.x - first;
  if ((int)blockIdx.x < first) return;
  const int total = group == 0 ? 96 + 96 + 256 + 256 : (group == 1 ? 192 + 64 + 256 : 256);
  for (int it = (int)blockIdx.x - first; it < total; it += nblk) {
    int i = it;
    if (group == 0) {
      if (i < 96) { adaln_item(p, 96 + i, lds); continue; } i -= 96;
      if (i < 96) { transpose_tile(p.l0_w_out, 1536, 1024, p.wt0_out, i, lds); continue; } i -= 96;
      if (i < 256) { transpose_tile(p.l0_f1, 1024, 4096, p.wt0_f1, i, lds); continue; } i -= 256;
      transpose_tile(p.l0_f2, 4096, 1024, p.wt0_f2, i, lds);
    } else if (group == 1) {
      if (i < 192) { transpose_tile(p.l1_w_in, 1024, 3072, p.wt1_in, i, lds); continue; } i -= 192;
      if (i < 64) { transpose_tile(p.l1_w_out, 1024, 1024, p.wt1_out, i, lds); continue; } i -= 64;
      transpose_tile(p.l1_f2, 4096, 1024, p.wt1_f2, i, lds);
    } else {
      transpose_tile(p.l1_f1, 1024, 4096, p.wt1_f1, i, lds);
    }
  }
}

struct NormArgs {
  const float* xin0; const float* xin1;
  const float* p0; const float* p1; const float* gate;
  float* xout; const float* nw; const float* sh; const float* sc;
  u16* hout; float* fout;
};
__device__ __forceinline__ void norm_row(const NormArgs& a, int t, int lane) {
  {
    const int c = cond_of(t);
    const float* xr = t < NPROMPT_T ? a.xin0 + (size_t)t * DM : a.xin1 + (size_t)(t - NPROMPT_T) * DM;
    f32x4 x[4]; float ss = 0.f;
#pragma unroll
    for (int i = 0; i < 4; ++i) {
      const int col = lane * 4 + 256 * i;
      x[i] = *(const f32x4*)(xr + col);
      if (a.p0) {
        const u32x2 q0 = *(const u32x2*)((const u16*)a.p0 + (size_t)t * DM + col), q1 = *(const u32x2*)((const u16*)a.p0 + (size_t)(NT + t) * DM + col);
        const f32x4 g = *(const f32x4*)(a.gate + (size_t)c * 6144 + col);
        f32x4 ps;
        ps[0] = __uint_as_float(q0[0] << 16) + __uint_as_float(q1[0] << 16); ps[1] = __uint_as_float(q0[0] & 0xffff0000u) + __uint_as_float(q1[0] & 0xffff0000u);
        ps[2] = __uint_as_float(q0[1] << 16) + __uint_as_float(q1[1] << 16); ps[3] = __uint_as_float(q0[1] & 0xffff0000u) + __uint_as_float(q1[1] & 0xffff0000u);
        x[i] = x[i] + g * ps;
      }
      if (a.xout) *(f32x4*)(a.xout + (size_t)t * DM + col) = x[i];
      ss += x[i][0] * x[i][0] + x[i][1] * x[i][1] + x[i][2] * x[i][2] + x[i][3] * x[i][3];
    }
    ss = wave_sum(ss);
    const float r = rsqrtf(ss * (1.f / 1024.f) + EPS);
#pragma unroll
    for (int i = 0; i < 4; ++i) {
      const int col = lane * 4 + 256 * i;
      const f32x4 w = *(const f32x4*)(a.nw + col);
      f32x4 y = x[i] * r * w;
      if (a.fout) *(f32x4*)(a.fout + (size_t)t * DM + col) = y;
      if (a.hout) {
        const f32x4 sh = *(const f32x4*)(a.sh + (size_t)c * 6144 + col), sc = *(const f32x4*)(a.sc + (size_t)c * 6144 + col);
        y = y * (1.f + sc) + sh;
        u32x2 o; o[0] = pk2(y[0], y[1]); o[1] = pk2(y[2], y[3]);
        *(u32x2*)(a.hout + (size_t)t * DM + col) = o;
      }
    }
  }
}
template <int R, int NP>
__device__ __forceinline__ void norm_rows(const NormArgs& a, int t0, int lane) {
  const int c = cond_of(t0);
  f32x4 x[R][4];
#pragma unroll
  for (int r = 0; r < R; ++r) {
    const int t = t0 + r;
    const float* xr = t < NPROMPT_T ? a.xin0 + (size_t)t * DM : a.xin1 + (size_t)(t - NPROMPT_T) * DM;
#pragma unroll
    for (int i = 0; i < 4; ++i) x[r][i] = *(const f32x4*)(xr + lane * 4 + 256 * i);
  }
  if (a.p0) {
    u32x2 q[R][NP][4];
#pragma unroll
    for (int r = 0; r < R; ++r)
#pragma unroll
      for (int k = 0; k < NP; ++k)
#pragma unroll
        for (int i = 0; i < 4; ++i) q[r][k][i] = *(const u32x2*)((const u16*)a.p0 + ((size_t)k * NT + t0 + r) * DM + lane * 4 + 256 * i);
#pragma unroll
    for (int i = 0; i < 4; ++i) {
      const f32x4 g = *(const f32x4*)(a.gate + (size_t)c * 6144 + lane * 4 + 256 * i);
#pragma unroll
      for (int r = 0; r < R; ++r) {
        f32x4 ps = {0.f, 0.f, 0.f, 0.f};
#pragma unroll
        for (int k = 0; k < NP; ++k) {
          ps[0] += __uint_as_float(q[r][k][i][0] << 16); ps[1] += __uint_as_float(q[r][k][i][0] & 0xffff0000u);
          ps[2] += __uint_as_float(q[r][k][i][1] << 16); ps[3] += __uint_as_float(q[r][k][i][1] & 0xffff0000u);
        }
        x[r][i] = x[r][i] + g * ps;
      }
    }
  }
  float rs[R];
#pragma unroll
  for (int r = 0; r < R; ++r) {
    float ss = 0.f;
#pragma unroll
    for (int i = 0; i < 4; ++i) {
      if (a.xout) *(f32x4*)(a.xout + (size_t)(t0 + r) * DM + lane * 4 + 256 * i) = x[r][i];
      ss += x[r][i][0] * x[r][i][0] + x[r][i][1] * x[r][i][1] + x[r][i][2] * x[r][i][2] + x[r][i][3] * x[r][i][3];
    }
    ss = wave_sum(ss);
    rs[r] = rsqrtf(ss * (1.f / 1024.f) + EPS);
  }
#pragma unroll
  for (int i = 0; i < 4; ++i) {
    const int col = lane * 4 + 256 * i;
    const f32x4 w = *(const f32x4*)(a.nw + col);
    f32x4 sh = {0.f, 0.f, 0.f, 0.f}, sc = {0.f, 0.f, 0.f, 0.f};
    if (a.hout) { sh = *(const f32x4*)(a.sh + (size_t)c * 6144 + col); sc = *(const f32x4*)(a.sc + (size_t)c * 6144 + col); }
#pragma unroll
    for (int r = 0; r < R; ++r) {
      f32x4 y = x[r][i] * rs[r] * w;
      if (a.fout) *(f32x4*)(a.fout + (size_t)(t0 + r) * DM + col) = y;
      if (a.hout) {
        y = y * (1.f + sc) + sh;
        u32x2 o; o[0] = pk2(y[0], y[1]); o[1] = pk2(y[2], y[3]);
        *(u32x2*)(a.hout + (size_t)(t0 + r) * DM + col) = o;
      }
    }
  }
}
template <int R, int NP>
__device__ __forceinline__ void norm_rows_idx(const NormArgs& a, const int (&rows)[R], int lane) {
  f32x4 x[R][4];
#pragma unroll
  for (int r = 0; r < R; ++r) {
    const int t = rows[r];
    const float* xr = t < NPROMPT_T ? a.xin0 + (size_t)t * DM : a.xin1 + (size_t)(t - NPROMPT_T) * DM;
#pragma unroll
    for (int i = 0; i < 4; ++i) x[r][i] = *(const f32x4*)(xr + lane * 4 + 256 * i);
  }
  if (a.p0) {
    u32x2 q[R][NP][4];
#pragma unroll
    for (int r = 0; r < R; ++r)
#pragma unroll
      for (int k = 0; k < NP; ++k)
#pragma unroll
        for (int i = 0; i < 4; ++i) q[r][k][i] = *(const u32x2*)((const u16*)a.p0 + ((size_t)k * NT + rows[r]) * DM + lane * 4 + 256 * i);
#pragma unroll
    for (int i = 0; i < 4; ++i) {
#pragma unroll
      for (int r = 0; r < R; ++r) {
        const f32x4 g = *(const f32x4*)(a.gate + (size_t)cond_of(rows[r]) * 6144 + lane * 4 + 256 * i);
        f32x4 ps = {0.f, 0.f, 0.f, 0.f};
#pragma unroll
        for (int k = 0; k < NP; ++k) {
          ps[0] += __uint_as_float(q[r][k][i][0] << 16); ps[1] += __uint_as_float(q[r][k][i][0] & 0xffff0000u);
          ps[2] += __uint_as_float(q[r][k][i][1] << 16); ps[3] += __uint_as_float(q[r][k][i][1] & 0xffff0000u);
        }
        x[r][i] = x[r][i] + g * ps;
      }
    }
  }
  float rs[R];
#pragma unroll
  for (int r = 0; r < R; ++r) {
    float ss = 0.f;
#pragma unroll
    for (int i = 0; i < 4; ++i) {
      if (a.xout) *(f32x4*)(a.xout + (size_t)(rows[r]) * DM + lane * 4 + 256 * i) = x[r][i];
      ss += x[r][i][0] * x[r][i][0] + x[r][i][1] * x[r][i][1] + x[r][i][2] * x[r][i][2] + x[r][i][3] * x[r][i][3];
    }
    ss = wave_sum(ss);
    rs[r] = rsqrtf(ss * (1.f / 1024.f) + EPS);
  }
#pragma unroll
  for (int i = 0; i < 4; ++i) {
    const int col = lane * 4 + 256 * i;
    const f32x4 w = *(const f32x4*)(a.nw + col);
#pragma unroll
    for (int r = 0; r < R; ++r) {
      f32x4 sh = {0.f, 0.f, 0.f, 0.f}, sc = {0.f, 0.f, 0.f, 0.f};
      if (a.hout) { const int c = cond_of(rows[r]); sh = *(const f32x4*)(a.sh + (size_t)c * 6144 + col); sc = *(const f32x4*)(a.sc + (size_t)c * 6144 + col); }
      f32x4 y = x[r][i] * rs[r] * w;
      if (a.fout) *(f32x4*)(a.fout + (size_t)(rows[r]) * DM + col) = y;
      if (a.hout) {
        y = y * (1.f + sc) + sh;
        u32x2 o; o[0] = pk2(y[0], y[1]); o[1] = pk2(y[2], y[3]);
        *(u32x2*)(a.hout + (size_t)(rows[r]) * DM + col) = o;
      }
    }
  }
}
__device__ __forceinline__ void phase_norm(const NormArgs& a) {
  const int wid = threadIdx.x >> 6, lane = threadIdx.x & 63;
  for (int g = blockIdx.x * 8 + wid; g < NT / 4; g += gridDim.x * 8) norm_rows<4, 2>(a, g * 4, lane);
}
struct EpiProj0 {
  u16* O;
  __device__ __forceinline__ void store8(int row, int col, f32x4 v0, f32x4 v1, int) const {
    if (col >= 3072) {
#pragma unroll
      for (int e = 0; e < 4; ++e) { v0[e] = gelu_f(v0[e]); v1[e] = gelu_f(v1[e]); }
    } else if (col >= 2048) {
#pragma unroll
      for (int e = 0; e < 4; ++e) { v0[e] = silu_f(v0[e]); v1[e] = silu_f(v1[e]); }
    } else if (col >= 512 && col < 1024) { v0 = v0 * 0.08838834764831845f; v1 = v1 * 0.08838834764831845f; }
    u32x4 o; o[0] = pk2(v0[0], v0[1]); o[1] = pk2(v0[2], v0[3]); o[2] = pk2(v1[0], v1[1]); o[3] = pk2(v1[2], v1[3]);
    __builtin_amdgcn_raw_buffer_store_b128(o, mk_rsrc(O, (unsigned)NT * 4096u * 2u), (unsigned)(((size_t)row * 4096 + col) * 2), 0, 16);
  }
  __device__ __forceinline__ void store4(int row, int col, f32x4 v, int) const {
    if (col >= 3072) { v[0] = gelu_f(v[0]); v[1] = gelu_f(v[1]); v[2] = gelu_f(v[2]); v[3] = gelu_f(v[3]); }
    else if (col >= 2048) { v[0] = silu_f(v[0]); v[1] = silu_f(v[1]); v[2] = silu_f(v[2]); v[3] = silu_f(v[3]); }
    else if (col >= 512 && col < 1024) v = v * 0.08838834764831845f;
    u32x2 o; o[0] = pk2(v[0], v[1]); o[1] = pk2(v[2], v[3]);
    *(u32x2*)(O + (size_t)row * 4096 + col) = o;
  }
};
struct EpiPart {
  float* Pp;
  __device__ __forceinline__ void store8(int row, int col, f32x4 v0, f32x4 v1, int ks) const {
    u32x4 o; o[0] = pk2(v0[0], v0[1]); o[1] = pk2(v0[2], v0[3]); o[2] = pk2(v1[0], v1[1]); o[3] = pk2(v1[2], v1[3]);
    *(u32x4*)((u16*)Pp + ((size_t)ks * NT + row) * DM + col) = o;
  }
};
struct EpiRelu2 {
  u16* O;
  __device__ __forceinline__ void store8(int row, int col, f32x4 v0, f32x4 v1, int) const {
#pragma unroll
    for (int e = 0; e < 4; ++e) { const float r0 = fmaxf(v0[e], 0.f), r1 = fmaxf(v1[e], 0.f); v0[e] = r0 * r0; v1[e] = r1 * r1; }
    u32x4 o; o[0] = pk2(v0[0], v0[1]); o[1] = pk2(v0[2], v0[3]); o[2] = pk2(v1[0], v1[1]); o[3] = pk2(v1[2], v1[3]);
    *(u32x4*)(O + (size_t)row * 4096 + col) = o;
  }
  __device__ __forceinline__ void store4(int row, int col, f32x4 v, int) const {
#pragma unroll
    for (int e = 0; e < 4; ++e) { const float r = fmaxf(v[e], 0.f); v[e] = r * r; }
    u32x2 o; o[0] = pk2(v[0], v[1]); o[1] = pk2(v[2], v[3]);
    *(u32x2*)(O + (size_t)row * 4096 + col) = o;
  }
};
struct EpiPartW {
  __amdgpu_buffer_rsrc_t rs;
  __device__ __forceinline__ void store8(int row, int col, f32x4 v0, f32x4 v1, int ks) const {
    u32x4 o; o[0] = pk2(v0[0], v0[1]); o[1] = pk2(v0[2], v0[3]); o[2] = pk2(v1[0], v1[1]); o[3] = pk2(v1[2], v1[3]);
    __builtin_amdgcn_raw_buffer_store_b128(o, rs, (unsigned)((((size_t)ks * NT + row) * DM + col) * 2), 0, 16);
  }
};
struct EpiRelu2W {
  __amdgpu_buffer_rsrc_t rs;
  __device__ __forceinline__ void store8(int row, int col, f32x4 v0, f32x4 v1, int) const {
#pragma unroll
    for (int e = 0; e < 4; ++e) { const float r0 = fmaxf(v0[e], 0.f), r1 = fmaxf(v1[e], 0.f); v0[e] = r0 * r0; v1[e] = r1 * r1; }
    u32x4 o; o[0] = pk2(v0[0], v0[1]); o[1] = pk2(v0[2], v0[3]); o[2] = pk2(v1[0], v1[1]); o[3] = pk2(v1[2], v1[3]);
    __builtin_amdgcn_raw_buffer_store_b128(o, rs, (unsigned)(((size_t)row * 4096 + col) * 2), 0, 16);
  }
};
struct EpiPlain {
  u16* O; int ld;
  __device__ __forceinline__ void store8(int row, int col, f32x4 v0, f32x4 v1, int) const {
    u32x4 o; o[0] = pk2(v0[0], v0[1]); o[1] = pk2(v0[2], v0[3]); o[2] = pk2(v1[0], v1[1]); o[3] = pk2(v1[2], v1[3]);
    __builtin_amdgcn_raw_buffer_store_b128(o, mk_rsrc(O, (unsigned)NT * 4096u * 2u), (unsigned)(((size_t)row * ld + col) * 2), 0, 16);
  }
  __device__ __forceinline__ void store4(int row, int col, f32x4 v, int) const {
    u32x2 o; o[0] = pk2(v[0], v[1]); o[1] = pk2(v[2], v[3]);
    *(u32x2*)(O + (size_t)row * ld + col) = o;
  }
};

template <class Epi>
__device__ __forceinline__ void phase_gemm_naive(const u16* __restrict__ A, const u16* __restrict__ Bt, int M, int N, int K, int ksplit, const Epi& E, float* lds) {
  float (*As)[33] = (float (*)[33])lds;
  float (*Bs)[33] = (float (*)[33])(lds + 128 * 33);
  const int tm = M / 128, tn = N / 64, total = tm * tn * ksplit, kper = K / ksplit;
  const int tid = threadIdx.x, r = tid >> 2, cq = tid & 3;
  for (int it = blockIdx.x; it < total; it += gridDim.x) {
    const int ks = it / (tm * tn), rem = it % (tm * tn), m0 = (rem / tn) * 128, n0 = (rem % tn) * 64;
    float acc[4][4] = {};
    for (int k0 = ks * kper; k0 < (ks + 1) * kper; k0 += 32) {
      __syncthreads();
      {
        const int kc = (tid & 3) * 8;
        const u32x4 va = *(const u32x4*)(A + (size_t)(m0 + r) * K + k0 + kc);
#pragma unroll
        for (int e = 0; e < 4; ++e) { As[r][kc + 2 * e] = __uint_as_float(va[e] << 16); As[r][kc + 2 * e + 1] = __uint_as_float(va[e] & 0xffff0000u); }
        if (tid < 256) {
          const u32x4 vb = *(const u32x4*)(Bt + (size_t)(n0 + r) * K + k0 + kc);
#pragma unroll
          for (int e = 0; e < 4; ++e) { Bs[r][kc + 2 * e] = __uint_as_float(vb[e] << 16); Bs[r][kc + 2 * e + 1] = __uint_as_float(vb[e] & 0xffff0000u); }
        }
      }
      __syncthreads();
#pragma unroll 4
      for (int k = 0; k < 32; ++k) {
        const float a = As[r][k];
#pragma unroll
        for (int jj = 0; jj < 4; ++jj)
#pragma unroll
          for (int e = 0; e < 4; ++e) acc[jj][e] += a * Bs[cq * 4 + 16 * jj + e][k];
      }
    }
#pragma unroll
    for (int jj = 0; jj < 4; ++jj) { f32x4 v = {acc[jj][0], acc[jj][1], acc[jj][2], acc[jj][3]}; E.store4(m0 + r, n0 + cq * 4 + 16 * jj, v, ks); }
  }
}


namespace pg8 {
#define PG8_LAS __attribute__((address_space(3)))
typedef short bf16x8 __attribute__((ext_vector_type(8)));
constexpr int BM = 256, BK = 64, HALF = 128, HTB = HALF * BK * 2, STAGE_BYTES = 8 * HTB, NXCD = 8, WGM = 8;
__device__ __forceinline__ int lds_byte(int r, int c) { const int st = (r >> 4) * 2 + (c >> 5), rr = r & 15, cc = c & 31, ob = rr * 64 + cc * 2; return st * 1024 + (ob ^ (((ob >> 9) & 1) << 5)); }
__device__ __forceinline__ int perm32(int rho) { const int n = rho >> 4, i = rho & 15; return 8 * (i >> 2) + 4 * n + (i & 3); }
__device__ __forceinline__ void stage_rc(int b, int& R, int& C) { const int st = b / 1024, sb = b % 1024, swz = sb ^ (((sb >> 9) & 1) << 5); R = (st >> 1) * 16 + swz / 64; C = (st & 1) * 32 + (swz % 64) / 2; }
struct Unit { int pm, pn, ks; };
struct Gemm { const u16* A; const u16* Bt; int M, N, K, ksplit; };
struct Order {
  int nM, nN, ntile, nwg, G, c;
  __device__ void init(int M, int N, int ksplit, int G_, int c_) { nM = M / BM; nN = N / BM; ntile = nM * nN; nwg = ntile * ksplit; G = G_; c = c_; }
  __device__ bool next(int i, Unit& u) const {
    const int L = i * G + c; if (L >= nwg) return false;
    u.ks = L / ntile; int wgid = L % ntile;
    { const int q = ntile / NXCD, r = ntile % NXCD, xcd = wgid % NXCD, off = wgid / NXCD; wgid = (xcd < r ? xcd * (q + 1) : r * (q + 1) + (xcd - r) * q) + off; }
    const int nig = WGM * nN, gid = wgid / nig, fm = gid * WGM, gsz = (nM - fm) < WGM ? (nM - fm) : WGM;
    u.pm = fm + ((wgid % nig) % gsz); u.pn = (wgid % nig) / gsz; return true;
  }
};
template <class Epi>
__device__ __forceinline__ void run_epi(const Epi& E, const f32x4 (&acc)[2][2][4][2], const Unit& u, int wr, int wc, int fr, int fq) {
  const int row0 = u.pm * BM + wr * 64 + fr, col0 = u.pn * BM + wc * 32 + 8 * fq;
#pragma unroll
  for (int ai = 0; ai < 2; ++ai)
#pragma unroll
    for (int m = 0; m < 4; ++m)
#pragma unroll
      for (int bj = 0; bj < 2; ++bj) E.store8(row0 + ai * HALF + m * 16, col0 + bj * HALF, acc[ai][bj][m][0], acc[ai][bj][m][1], u.ks);
}
struct OneUnit { Unit u; __device__ __forceinline__ bool next(int i, Unit& o) const { if (i) return false; o = u; return true; } };
struct FfnOrder1 {
  int c;
  __device__ __forceinline__ bool next(int i, Unit& u) const {
    const int x = c & 7; u.ks = 0;
    if (c >= 128) { if (i) return false; const int oj = (c - 128) >> 3; u.pm = 2 * (x >> 1) + (oj >> 3); u.pn = (x & 1) * 8 + (oj & 7); return true; }
    if (i > 1) return false;
    const int t = i * 16 + (c >> 3); u.pm = 8 + 4 * (x >> 1) + (t >> 3); u.pn = (x & 1) * 8 + (t & 7); return true;
  }
};
struct L1InOrder {
  int c;
  __device__ __forceinline__ bool next(int i, Unit& u) const {
    u.ks = 0;
    if (c >= 40) { if (i) return false; const int idx = c - 40; u.pm = idx / 12; u.pn = idx % 12; return true; }
    if (c >= 36 || i > 1) return false;
    const int t = i * 36 + c; u.pm = 18 + t / 12; u.pn = t % 12; return true;
  }
};
template <class Epi, class Sched>
__device__ __forceinline__ void gemm_phase(PG8_LAS unsigned char* lds, const Gemm g, const Sched& S, const Epi& E) {
  const int tid = threadIdx.x, wid = __builtin_amdgcn_readfirstlane(tid >> 6), lane = tid & 63, wr = wid >> 2, wc = wid & 3, fr = lane & 15, fq = lane >> 4;
  const int K = g.K, kper = g.K / g.ksplit, nt = kper / BK;
  unsigned voffA[2], voffB[2];
#pragma unroll
  for (int i = 0; i < 2; ++i) { int R, C; stage_rc(tid * 16 + i * 8192, R, C); const int Rb = (R & ~31) + perm32(R & 31);
    voffA[i] = (unsigned)(R * K + C) * 2u; voffB[i] = (unsigned)(Rb * K + C) * 2u; }
  const size_t kstep = (size_t)(BK * 2);
  const size_t hstep = (size_t)HALF * K * 2;
  const size_t tstep = 2 * hstep;
  const size_t ksbytes = (size_t)kper * 2;
  const unsigned ldsw = (unsigned)wid * 1024u;
  const int aoff = lds_byte(wr * 64 + fr, fq * 8), boff = lds_byte(wc * 32 + fr, fq * 8);
#define PG8_SA(b, h) (((b) * 2 + (h)) * HTB)
#define PG8_SB(b, h) ((4 + (b) * 2 + (h)) * HTB)
#define PG8_STAGE(bufoff, gbase, voff) do { _Pragma("unroll") for (int _i = 0; _i < 2; ++_i) \
    __builtin_amdgcn_global_load_lds((const unsigned*)((const char*)(gbase) + (voff)[_i]), (PG8_LAS unsigned*)(lds + (bufoff) + ldsw + _i * 8192), 16, 0, 0); } while (0)
#define PG8_LDA(dst, b, h) do { _Pragma("unroll") for (int m = 0; m < 4; ++m) _Pragma("unroll") for (int k = 0; k < 2; ++k) dst[m][k] = *(const PG8_LAS bf16x8*)(lds + PG8_SA(b, h) + aoff + m * 2048 + k * 1024); } while (0)
#define PG8_LDB(dst, b, h) do { _Pragma("unroll") for (int n = 0; n < 2; ++n) _Pragma("unroll") for (int k = 0; k < 2; ++k) dst[n][k] = *(const PG8_LAS bf16x8*)(lds + PG8_SB(b, h) + boff + n * 2048 + k * 1024); } while (0)
#define PG8_MMA(ai, bj, At, Bt) do { __builtin_amdgcn_s_setprio(1); _Pragma("unroll") for (int m = 0; m < 4; ++m) _Pragma("unroll") for (int n = 0; n < 2; ++n) _Pragma("unroll") for (int k = 0; k < 2; ++k) \
    acc[ai][bj][m][n] = __builtin_amdgcn_mfma_f32_16x16x32_bf16(Bt[n][k], At[m][k], acc[ai][bj][m][n], 0, 0, 0); __builtin_amdgcn_s_setprio(0); } while (0)
#define PG8_WAIT_V(n) asm volatile("s_waitcnt vmcnt(" #n ")" ::: "memory")
#define PG8_WAIT_L(n) asm volatile("s_waitcnt lgkmcnt(" #n ")" ::: "memory")
#define PG8_BAR __builtin_amdgcn_s_barrier()
#define PG8_SCHED __builtin_amdgcn_sched_barrier(0)
  Unit cur, nxt; int ui = 0;
  if (!S.next(0, cur)) return;
  f32x4 acc[2][2][4][2];
#pragma unroll
  for (int a = 0; a < 2; ++a)
#pragma unroll
    for (int b = 0; b < 2; ++b)
#pragma unroll
      for (int m = 0; m < 4; ++m)
#pragma unroll
        for (int n = 0; n < 2; ++n) acc[a][b][m][n] = (f32x4){0.f, 0.f, 0.f, 0.f};
  bf16x8 At[4][2], B0[2][2], B1[2][2];
  const char* cA = (const char*)g.A + (size_t)cur.pm * tstep + (size_t)cur.ks * ksbytes; const char* cB = (const char*)g.Bt + (size_t)cur.pn * tstep + (size_t)cur.ks * ksbytes;
  PG8_STAGE(PG8_SB(0, 0), cB, voffB); PG8_STAGE(PG8_SA(0, 0), cA, voffA); PG8_STAGE(PG8_SB(0, 1), cB + hstep, voffB); PG8_STAGE(PG8_SA(0, 1), cA + hstep, voffA);
  if (wr == 1) PG8_BAR;
  PG8_WAIT_V(4); PG8_BAR;
  PG8_STAGE(PG8_SB(1, 0), cB + kstep, voffB); PG8_STAGE(PG8_SA(1, 0), cA + kstep, voffA); PG8_STAGE(PG8_SB(1, 1), cB + hstep + kstep, voffB);
  PG8_WAIT_V(6); PG8_BAR;
  for (;;) {
    const bool has_next = S.next(ui + 1, nxt);
    const char* nA = has_next ? (const char*)g.A + (size_t)nxt.pm * tstep + (size_t)nxt.ks * ksbytes : cA; const char* nB = has_next ? (const char*)g.Bt + (size_t)nxt.pn * tstep + (size_t)nxt.ks * ksbytes : cB;
    for (int t = 0; t < nt; t += 2) {
      const bool last = (t == nt - 2);
      const char* a1 = cA + (size_t)(t + 1) * kstep;
      const char* a2 = last ? nA : cA + (size_t)(t + 2) * kstep; const char* b2 = last ? nB : cB + (size_t)(t + 2) * kstep;
      const char* a3 = a2 + kstep; const char* b3 = b2 + kstep;
      PG8_LDB(B0, 0, 0); PG8_SCHED; PG8_LDA(At, 0, 0); PG8_STAGE(PG8_SA(1, 1), a1 + hstep, voffA);
      PG8_WAIT_L(8); PG8_BAR; PG8_WAIT_L(0); PG8_MMA(0, 0, At, B0); PG8_BAR; PG8_SCHED;
      PG8_LDB(B1, 0, 1); PG8_STAGE(PG8_SB(0, 0), b2, voffB);
      PG8_BAR; PG8_WAIT_L(0); PG8_MMA(0, 1, At, B1); PG8_BAR;
      PG8_LDA(At, 0, 1); PG8_STAGE(PG8_SA(0, 0), a2, voffA);
      PG8_BAR; PG8_WAIT_L(0); PG8_MMA(1, 0, At, B0); PG8_BAR; PG8_SCHED;
      PG8_STAGE(PG8_SB(0, 1), b2 + hstep, voffB);
      PG8_WAIT_V(6); PG8_BAR; PG8_MMA(1, 1, At, B1); PG8_BAR;
      PG8_LDB(B0, 1, 0); PG8_SCHED; PG8_LDA(At, 1, 0); PG8_STAGE(PG8_SA(0, 1), a2 + hstep, voffA);
      PG8_WAIT_L(8); PG8_BAR; PG8_WAIT_L(0); PG8_MMA(0, 0, At, B0); PG8_BAR; PG8_SCHED;
      PG8_LDB(B1, 1, 1); PG8_STAGE(PG8_SB(1, 0), b3, voffB);
      PG8_BAR; PG8_WAIT_L(0); PG8_MMA(0, 1, At, B1); PG8_BAR;
      PG8_LDA(At, 1, 1); PG8_STAGE(PG8_SA(1, 0), a3, voffA);
      PG8_BAR; PG8_WAIT_L(0); PG8_MMA(1, 0, At, B0); PG8_BAR; PG8_SCHED;
      PG8_STAGE(PG8_SB(1, 1), b3 + hstep, voffB);
      PG8_WAIT_V(6); PG8_BAR; PG8_MMA(1, 1, At, B1); PG8_BAR;
    }
    run_epi(E, acc, cur, wr, wc, fr, fq);
    if (!has_next) break;
#pragma unroll
    for (int a = 0; a < 2; ++a)
#pragma unroll
      for (int b = 0; b < 2; ++b)
#pragma unroll
        for (int m = 0; m < 4; ++m)
#pragma unroll
          for (int n = 0; n < 2; ++n) acc[a][b][m][n] = (f32x4){0.f, 0.f, 0.f, 0.f};
    cur = nxt; cA = nA; cB = nB; ++ui;
  }
  PG8_WAIT_V(0);
  if (wr == 0) PG8_BAR;
  PG8_BAR;
#undef PG8_SA
#undef PG8_SB
#undef PG8_STAGE
#undef PG8_LDA
#undef PG8_LDB
#undef PG8_MMA
#undef PG8_WAIT_V
#undef PG8_WAIT_L
#undef PG8_BAR
#undef PG8_SCHED
}
}
template <class Epi>
__device__ __forceinline__ void phase_gemm(const u16* A, const u16* Bt, int M, int N, int K, int ksplit, const Epi& E, float* lds) {
  __syncthreads();
  pg8::Gemm g{A, Bt, M, N, K, ksplit};
  pg8::Order S; S.init(M, N, ksplit, (int)gridDim.x, (int)blockIdx.x);
  pg8::gemm_phase(( __attribute__((address_space(3))) unsigned char*)lds, g, S, E);
  __syncthreads();
}

__device__ __forceinline__ void seq_of_token(int t, int& s0, int& L, int& sb) {
  if (t < NPROMPT_T) { s0 = t & ~255; L = 256; sb = -1; } else { sb = (t - NPROMPT_T) >> 10; s0 = NPROMPT_T + (sb << 10); L = 1024; }
}
__device__ __forceinline__ void ret_item_naive(const P& p, int item, float* lds) {
  const int tg = item >> 2, h = item & 3, t0 = tg * 16, tid = threadIdx.x;
  int s0, L, sb; seq_of_token(t0, s0, L, sb);
  float* scr = lds;
  float* qs = lds + 16 * 1024;
  float* red = qs + 16 * 128;
  const float lgf = log1pf(-exp2f(-p.l0_decay[h])), lgb = log1pf(-exp2f(-p.l0_decay[4 + h]));
  __syncthreads();
  for (int i = tid; i < 16 * 128; i += NTHR) qs[i] = bf2f(p.proj[(size_t)(t0 + (i >> 7)) * 4096 + h * 128 + (i & 127)]);
  __syncthreads();
  for (int j = tid; j < L; j += NTHR) {
    float acc[16] = {};
    const u16* kr = p.proj + (size_t)(s0 + j) * 4096 + 512 + h * 128;
    for (int d0 = 0; d0 < 128; d0 += 8) {
      const u32x4 kv = *(const u32x4*)(kr + d0);
      float kf[8];
#pragma unroll
      for (int e = 0; e < 4; ++e) { kf[2 * e] = __uint_as_float(kv[e] << 16); kf[2 * e + 1] = __uint_as_float(kv[e] & 0xffff0000u); }
#pragma unroll
      for (int i = 0; i < 16; ++i)
#pragma unroll
        for (int e = 0; e < 8; ++e) acc[i] += qs[i * 128 + d0 + e] * kf[e];
    }
#pragma unroll
    for (int i = 0; i < 16; ++i) {
      const int d = (t0 + i - s0) - j;
      const float w = d > 0 ? __expf((float)d * lgf) : (d < 0 ? __expf((float)(-d) * lgb) : 2.f);
      scr[i * 1024 + j] = acc[i] * w;
    }
  }
  __syncthreads();
  const int dv = tid & 255, ig = tid >> 8;
  float o[8] = {};
  for (int j = 0; j < L; ++j) {
    const float v = bf2f(p.proj[(size_t)(s0 + j) * 4096 + 1024 + h * 256 + dv]);
#pragma unroll
    for (int e = 0; e < 8; ++e) o[e] += scr[(ig * 8 + e) * 1024 + j] * v;
  }
  if (sb >= 0) {
    const float* Sf = p.state + ((size_t)(sb * 2 + 0) * 4 + h) * 128 * 256;
    const float* Sb = p.state + ((size_t)(sb * 2 + 1) * 4 + h) * 128 * 256;
    float af[8] = {}, ab[8] = {};
    for (int dk = 0; dk < 128; ++dk) {
      const float sf = Sf[dk * 256 + dv], sbv = Sb[dk * 256 + dv];
#pragma unroll
      for (int e = 0; e < 8; ++e) { const float q = qs[(ig * 8 + e) * 128 + dk]; af[e] += q * sf; ab[e] += q * sbv; }
    }
#pragma unroll
    for (int e = 0; e < 8; ++e) {
      const int pos = t0 + ig * 8 + e - s0;
      o[e] += __expf((float)(pos + 1) * lgf) * af[e] + __expf((float)(L - pos) * lgb) * ab[e];
    }
  }
  const int wid = tid >> 6, lane = tid & 63;
#pragma unroll
  for (int e = 0; e < 8; ++e) { const float s = wave_sum(o[e] * o[e]); if (lane == 0) red[wid * 8 + e] = s; }
  __syncthreads();
#pragma unroll
  for (int e = 0; e < 8; ++e) {
    const float ss = red[(ig * 4 + 0) * 8 + e] + red[(ig * 4 + 1) * 8 + e] + red[(ig * 4 + 2) * 8 + e] + red[(ig * 4 + 3) * 8 + e];
    const float r = rsqrtf(ss * (1.f / 256.f) + EPS);
    const int t = t0 + ig * 8 + e;
    const float g = bf2f(p.proj[(size_t)t * 4096 + 2048 + h * 256 + dv]);
    p.cat[(size_t)t * 1536 + h * 256 + dv] = f2bf(o[e] * r * g);
  }
}
__device__ __forceinline__ void state_item_naive(const P& p, int item) {
  const int b = item >> 3, h = (item >> 1) & 3, dir = item & 1, tid = threadIdx.x;
  const float lg = log1pf(-exp2f(-p.l0_decay[dir * 4 + h]));
  const int dv = tid & 255;
  float* o = p.out + (size_t)NT * DM + ((size_t)(b * 2 + dir) * 4 + h) * 128 * 256;
  for (int pass = 0; pass < 4; ++pass) {
    const int dk0 = (tid >> 8) * 64 + pass * 16;
    float acc[16] = {};
    for (int s = 0; s < 256; ++s) {
      const int t = b * 256 + s;
      const float w = dir == 0 ? __expf((float)(255 - s) * lg) : __expf((float)s * lg);
      const float v = bf2f(p.proj[(size_t)t * 4096 + 1024 + h * 256 + dv]) * w;
      const u16* kr = p.proj + (size_t)t * 4096 + 512 + h * 128 + dk0;
#pragma unroll
      for (int e = 0; e < 16; ++e) acc[e] += bf2f(kr[e]) * v;
    }
#pragma unroll
    for (int e = 0; e < 16; ++e) o[(dk0 + e) * 256 + dv] = acc[e];
  }
}
__device__ __forceinline__ void gmlp_item_naive(const P& p, int item, float* lds) {
  const int ci = item >> 2, g = item & 3, tid = threadIdx.x, wid = tid >> 6, lane = tid & 63;
  float* zn = lds;
  float* mu = lds + 128 * 128;
  float* rs = mu + 128;
  __syncthreads();
  for (int q = wid; q < 128; q += 8) {
    const u32x4 v = *(const u32x4*)(p.proj + (size_t)(ci * 128 + q) * 4096 + 3584 + lane * 8);
    float s = 0.f, s2 = 0.f;
#pragma unroll
    for (int e = 0; e < 4; ++e) { const float a = __uint_as_float(v[e] << 16), b = __uint_as_float(v[e] & 0xffff0000u); s += a + b; s2 += a * a + b * b; }
    s = wave_sum(s); s2 = wave_sum(s2);
    if (lane == 0) { const float m = s * (1.f / 512.f); const float var = fmaxf(s2 * (1.f / 512.f) - m * m, 0.f); mu[q] = m; rs[q] = rsqrtf(var + EPS); }
  }
  __syncthreads();
  for (int i = tid; i < 128 * 128; i += NTHR) {
    const int q = i >> 7, c = i & 127;
    zn[i] = (bf2f(p.proj[(size_t)(ci * 128 + q) * 4096 + 3584 + g * 128 + c]) - mu[q]) * rs[q];
  }
  __syncthreads();
  const int c = tid & 127, p0 = (tid >> 7) * 32;
  float acc[32] = {};
  const float* W = p.l0_gws + (size_t)g * 128 * 128;
  for (int q = 0; q < 128; ++q) {
    const float z = zn[q * 128 + c];
#pragma unroll
    for (int e = 0; e < 32; ++e) acc[e] += W[(p0 + e) * 128 + q] * z;
  }
#pragma unroll
  for (int e = 0; e < 32; ++e) {
    const int t = ci * 128 + p0 + e;
    const float u = bf2f(p.proj[(size_t)t * 4096 + 3072 + g * 128 + c]);
    p.cat[(size_t)t * 1536 + 1024 + g * 128 + c] = f2bf((acc[e] + p.l0_gb[g * 128 + p0 + e]) * u);
  }
}
__device__ __forceinline__ void phase_mixer_naive(const P& p, float* lds) {
  const int nR = 1536, nS = 128, nG = 192, total = nR + nS + nG;
  for (int it = blockIdx.x; it < total; it += gridDim.x) {
    if (it < nR) ret_item_naive(p, it, lds);
    else if (it < nR + nS) state_item_naive(p, it - nR);
    else gmlp_item_naive(p, it - nR - nS, lds);
  }
}


#define LAS __attribute__((address_space(3)))
typedef short bf16x8 __attribute__((ext_vector_type(8)));
typedef short bf16x4 __attribute__((ext_vector_type(4)));
constexpr int PK = 136;
constexpr int PV = 264;
__device__ __forceinline__ bf16x8 frag_row(const LAS u16* base, int pitch, int r0, int k0, int fr, int fq) {
  return *(const LAS bf16x8*)(base + (r0 + fr) * pitch + k0 + fq * 8);
}
__device__ __forceinline__ bf16x8 frag_tr(const LAS u16* base, int pitch, int k0, int n0, int fr, int fq) {
  const LAS u16* a = base + (k0 + fq * 8 + (fr >> 2)) * pitch + n0 + 4 * (fr & 3);
  const bf16x4 lo = __builtin_amdgcn_ds_read_tr16_b64_v4i16((LAS bf16x4*)a);
  const bf16x4 hi = __builtin_amdgcn_ds_read_tr16_b64_v4i16((LAS bf16x4*)(a + 4 * pitch));
  bf16x8 r; r[0] = lo[0]; r[1] = lo[1]; r[2] = lo[2]; r[3] = lo[3]; r[4] = hi[0]; r[5] = hi[1]; r[6] = hi[2]; r[7] = hi[3];
  return r;
}
__device__ __forceinline__ f32x4 mfma16(bf16x8 a, bf16x8 b, f32x4 c) { return __builtin_amdgcn_mfma_f32_16x16x32_bf16(a, b, c, 0, 0, 0); }
template <int ROWS, int COLS>
__device__ __forceinline__ void tile_to_lds_t(const u16* __restrict__ g, size_t gp, LAS u16* l, int lp) {
  constexpr int CPR = COLS / 8, N = ROWS * CPR / NTHR;
  u32x4 v[N];
#pragma unroll
  for (int k = 0; k < N; ++k) { const int i = threadIdx.x + k * NTHR, r = i / CPR, c = (i % CPR) * 8; v[k] = *(const u32x4*)(g + (size_t)r * gp + c); }
#pragma unroll
  for (int k = 0; k < N; ++k) { const int i = threadIdx.x + k * NTHR, r = i / CPR, c = (i % CPR) * 8; *(LAS u32x4*)(l + r * lp + c) = v[k]; }
}
__device__ __forceinline__ void tile_to_lds(const u16* __restrict__ g, size_t gp, LAS u16* l, int lp, int rows, int cols) {
  if (cols == 128) tile_to_lds_t<128, 128>(g, gp, l, lp); else tile_to_lds_t<128, 256>(g, gp, l, lp);
}

__device__ __forceinline__ void kv_item(const P& p, int item, LAS u16* lds) {
  const int ci = item >> 2, h = item & 3, tid = threadIdx.x, wid = tid >> 6, lane = tid & 63, fr = lane & 15, fq = lane >> 4;
  LAS u16* kbuf = lds; LAS u16* vbuf = lds + 128 * PK;
  __syncthreads();
  tile_to_lds(p.proj + (size_t)ci * 128 * 4096 + 512 + h * 128, 4096, kbuf, PK, 128, 128);
  tile_to_lds(p.proj + (size_t)ci * 128 * 4096 + 1024 + h * 256, 4096, vbuf, PV, 128, 256);
  __syncthreads();
  const int dir = wid >> 2, d0 = (wid & 3) * 32;
  const float lg = log1pf(-exp2f(-p.l0_decay[dir * 4 + h]));
  u16* o = (u16*)p.part + ((size_t)(ci * 4 + h) * 2 + dir) * 128 * 256;
#pragma unroll 1
  for (int nh = 0; nh < 2; ++nh) {
    f32x4 acc[8][2];
#pragma unroll
    for (int m = 0; m < 8; ++m) { acc[m][0] = (f32x4){0.f, 0.f, 0.f, 0.f}; acc[m][1] = (f32x4){0.f, 0.f, 0.f, 0.f}; }
#pragma unroll 1
    for (int ks = 0; ks < 4; ++ks) {
      bf16x8 kb[2];
      kb[0] = frag_tr(kbuf, PK, ks * 32, d0, fr, fq); kb[1] = frag_tr(kbuf, PK, ks * 32, d0 + 16, fr, fq);
#pragma unroll
      for (int j = 0; j < 8; ++j) {
        const int tok = ks * 32 + fq * 8 + j;
        const float w = __expf((float)(dir == 0 ? 127 - tok : tok) * lg);
        kb[0][j] = (short)f2bf(bf2f((u16)kb[0][j]) * w); kb[1][j] = (short)f2bf(bf2f((u16)kb[1][j]) * w);
      }
#pragma unroll
      for (int m = 0; m < 8; ++m) {
        const bf16x8 va = frag_tr(vbuf, PV, ks * 32, nh * 128 + m * 16, fr, fq);
        acc[m][0] = mfma16(va, kb[0], acc[m][0]); acc[m][1] = mfma16(va, kb[1], acc[m][1]);
      }
    }
#pragma unroll
    for (int n = 0; n < 2; ++n) {
      u16* orow = o + (size_t)(d0 + n * 16 + fr) * 256 + nh * 128 + fq * 4;
#pragma unroll
      for (int m = 0; m < 8; ++m) { u32x2 v; v[0] = pk2(acc[m][n][0], acc[m][n][1]); v[1] = pk2(acc[m][n][2], acc[m][n][3]); *(u32x2*)(orow + m * 16) = v; }
    }
  }
}

__device__ __forceinline__ void gmlp_item(const P& p, int item, LAS u16* lds) {
  const int ci = item >> 2, g = item & 3, tid = threadIdx.x, wid = tid >> 6, lane = tid & 63, fr = lane & 15, fq = lane >> 4;
  LAS u16* zn = lds; LAS u16* wsb = lds + 128 * PK; LAS float* mu = (LAS float*)(lds + 2 * 128 * PK); LAS float* rs = mu + 128;
  __syncthreads();
  {
    u32x4 zv[16];
#pragma unroll
    for (int k = 0; k < 16; ++k) zv[k] = *(const u32x4*)(p.proj + (size_t)(ci * 128 + wid + 8 * k) * 4096 + 3584 + lane * 8);
#pragma unroll
    for (int k = 0; k < 16; ++k) {
      float s = 0.f, s2 = 0.f;
#pragma unroll
      for (int e = 0; e < 4; ++e) { const float a = __uint_as_float(zv[k][e] << 16), b = __uint_as_float(zv[k][e] & 0xffff0000u); s += a + b; s2 += a * a + b * b; }
      s = wave_sum(s); s2 = wave_sum(s2);
      if (lane == 0) { const float m = s * (1.f / 512.f); const float var = fmaxf(s2 * (1.f / 512.f) - m * m, 0.f); mu[wid + 8 * k] = m; rs[wid + 8 * k] = rsqrtf(var + EPS); }
    }
  }
  u32x4 zr[4];
#pragma unroll
  for (int k = 0; k < 4; ++k) { const int i = tid + k * NTHR, q = i >> 4, c = (i & 15) * 8; zr[k] = *(const u32x4*)(p.proj + (size_t)(ci * 128 + q) * 4096 + 3584 + g * 128 + c); }
  {
    const float* W = p.l0_gws + (size_t)g * 128 * 128;
    f32x4 wv[8];
#pragma unroll
    for (int k = 0; k < 8; ++k) { const int i = tid + k * NTHR; wv[k] = *(const f32x4*)(W + (i >> 5) * 128 + (i & 31) * 4); }
#pragma unroll
    for (int k = 0; k < 8; ++k) {
      const int i = tid + k * NTHR, r = i >> 5, c = (i & 31) * 4;
      u32x2 o; o[0] = pk2(wv[k][0], wv[k][1]); o[1] = pk2(wv[k][2], wv[k][3]);
      *(LAS u32x2*)(wsb + r * PK + c) = o;
    }
  }
  __syncthreads();
#pragma unroll
  for (int k = 0; k < 4; ++k) {
    const int i = tid + k * NTHR, q = i >> 4, c = (i & 15) * 8;
    const float m = mu[q], r = rs[q];
    u32x4 o;
#pragma unroll
    for (int e = 0; e < 4; ++e) o[e] = pk2((__uint_as_float(zr[k][e] << 16) - m) * r, (__uint_as_float(zr[k][e] & 0xffff0000u) - m) * r);
    *(LAS u32x4*)(zn + q * PK + c) = o;
  }
  __syncthreads();
  f32x4 acc[8];
#pragma unroll
  for (int m = 0; m < 8; ++m) acc[m] = (f32x4){0.f, 0.f, 0.f, 0.f};
#pragma unroll
  for (int ks = 0; ks < 4; ++ks) {
    const bf16x8 wb = frag_row(wsb, PK, wid * 16, ks * 32, fr, fq);
#pragma unroll
    for (int m = 0; m < 8; ++m) acc[m] = mfma16(frag_tr(zn, PK, ks * 32, m * 16, fr, fq), wb, acc[m]);
  }
  {
    const int pr = wid * 16 + fr, t = ci * 128 + pr;
    const float gb = p.l0_gb[g * 128 + pr];
    const u16* urow = p.proj + (size_t)t * 4096 + 3072 + g * 128 + fq * 4;
    u16* orow = p.cat + (size_t)t * 1536 + 1024 + g * 128 + fq * 4;
#pragma unroll
    for (int m = 0; m < 8; ++m) {
      const u32x2 uv = *(const u32x2*)(urow + m * 16);
      u32x2 v;
      v[0] = pk2((acc[m][0] + gb) * __uint_as_float(uv[0] << 16), (acc[m][1] + gb) * __uint_as_float(uv[0] & 0xffff0000u));
      v[1] = pk2((acc[m][2] + gb) * __uint_as_float(uv[1] << 16), (acc[m][3] + gb) * __uint_as_float(uv[1] & 0xffff0000u));
      *(u32x2*)(orow + m * 16) = v;
    }
  }
}
__device__ __forceinline__ void phase_mix_a(const P& p, LAS u16* lds) {
  for (int it = blockIdx.x; it < 384; it += gridDim.x) { if (it < 192) kv_item(p, it, lds); else gmlp_item(p, it - 192, lds); }
}

__device__ __forceinline__ void build_state(const P& p, LAS u16* bbuf, const float* S0, float w0, int cbase, int h, int dir, int c_lo, int c_hi, int c_ref, float lg128) {
  const int tid = threadIdx.x;
#pragma unroll 1
  for (int half = 0; half < 2; ++half) {
    f32x4 a[8];
    const int base = (tid + half * 4096) * 4;
    if (S0) {
#pragma unroll
      for (int k = 0; k < 8; ++k) a[k] = *(const f32x4*)(S0 + base + k * 2048);
#pragma unroll
      for (int k = 0; k < 8; ++k) a[k] = a[k] * w0;
    } else {
#pragma unroll
      for (int k = 0; k < 8; ++k) a[k] = (f32x4){0.f, 0.f, 0.f, 0.f};
    }
#pragma unroll 1
    for (int cc = c_lo; cc < c_hi; ++cc) {
      const int e = dir == 0 ? (c_ref - 1 - cc) : (cc - c_ref - 1);
      const float w = __expf(lg128 * (float)e);
      const float* src = p.part + ((size_t)((cbase + cc) * 4 + h) * 2 + dir) * 128 * 256 + base;
      f32x4 t[8];
#pragma unroll
      for (int k = 0; k < 8; ++k) t[k] = *(const f32x4*)(src + k * 2048);
#pragma unroll
      for (int k = 0; k < 8; ++k) a[k] = a[k] + t[k] * w;
    }
#pragma unroll
    for (int k = 0; k < 8; ++k) {
      const int i = tid + half * 4096 + k * 512, r = i >> 6, c = (i & 63) * 4;
      u32x2 o; o[0] = pk2(a[k][0], a[k][1]); o[1] = pk2(a[k][2], a[k][3]);
      *(LAS u32x2*)(bbuf + r * PV + c) = o;
    }
  }
}
__device__ __forceinline__ void scan_item(const P& p, int item, unsigned* scnt) {
  const int combo = item >> 2, q = item & 3, dir = combo & 1, h = (combo >> 1) & 3, sb = combo >> 3, tid = threadIdx.x;
  const float g = __expf(128.f * log1pf(-exp2f(-p.l0_decay[dir * 4 + h])));
  const float* S0 = p.state + ((size_t)(sb * 2 + dir) * 4 + h) * 128 * 256 + q * 32 * 256;
  const u16* KV = (const u16*)p.part + ((size_t)((32 + sb * 8) * 4 + h) * 2 + dir) * 128 * 256 + q * 32 * 256;
  const __amdgpu_buffer_rsrc_t rs = mk_rsrc(p.stimg, 2u * 4u * 2u * 8u * 128u * 256u * 2u);
  const unsigned obase = (unsigned)((((size_t)combo * 8) * 128 * 256 + q * 32 * 256) * 2);
  float s[2][8]; u32x4 kv[7][2];
#pragma unroll
  for (int k = 0; k < 2; ++k) {
    const f32x4 a = *(const f32x4*)(S0 + (tid + 512 * k) * 8), b2 = *(const f32x4*)(S0 + (tid + 512 * k) * 8 + 4);
    s[k][0] = a[0]; s[k][1] = a[1]; s[k][2] = a[2]; s[k][3] = a[3]; s[k][4] = b2[0]; s[k][5] = b2[1]; s[k][6] = b2[2]; s[k][7] = b2[3];
  }
#pragma unroll
  for (int c = 0; c < 7; ++c)
#pragma unroll
    for (int k = 0; k < 2; ++k) kv[c][k] = *(const u32x4*)(KV + (size_t)(c + dir) * (4 * 2 * 128 * 256) + (tid + 512 * k) * 8);
#pragma unroll
  for (int st = 0; st < 8; ++st) {
    const int c = dir == 0 ? st : 7 - st;
#pragma unroll
    for (int k = 0; k < 2; ++k) {
      if (st > 0) {
        const u32x4 t = kv[dir == 0 ? st - 1 : 7 - st][k];
#pragma unroll
        for (int e = 0; e < 4; ++e) { s[k][2 * e] = s[k][2 * e] * g + __uint_as_float(t[e] << 16); s[k][2 * e + 1] = s[k][2 * e + 1] * g + __uint_as_float(t[e] & 0xffff0000u); }
      }
      u32x4 v; v[0] = pk2(s[k][0], s[k][1]); v[1] = pk2(s[k][2], s[k][3]); v[2] = pk2(s[k][4], s[k][5]); v[3] = pk2(s[k][6], s[k][7]);
      __builtin_amdgcn_raw_buffer_store_b128(v, rs, obase + (unsigned)(((size_t)c * 128 * 256 + (tid + 512 * k) * 8) * 2), 0, 16);
    }
  }
  asm volatile("s_waitcnt vmcnt(0)" ::: "memory");
  __syncthreads();
  if (tid == 0) xb_add(&scnt[combo * 16], 1u);
}
__device__ __forceinline__ void ret_item(const P& p, int item, LAS u16* lds, unsigned* scnt) {
  const int ci = item >> 2, h = item & 3, tid = threadIdx.x, wid = tid >> 6, lane = tid & 63, fr = lane & 15, fq = lane >> 4;
  int sb, lc, n;
  if (ci < 32) { sb = -1; lc = ci & 1; n = 2; } else { sb = (ci - 32) >> 3; lc = (ci - 32) & 7; n = 8; }
  const int cbase = ci - lc;
  const float lgf = log1pf(-exp2f(-p.l0_decay[h])), lgb = log1pf(-exp2f(-p.l0_decay[4 + h]));
  LAS u16* kbuf = lds; LAS u16* bbuf = lds + 128 * PK; LAS float* red = (LAS float*)(lds + 128 * PK + 128 * PV);
  const bool hasF = (sb >= 0) || lc > 0, hasB = (sb >= 0) || lc < n - 1;
  const u16* qg = p.proj + (size_t)ci * 128 * 4096 + h * 128;
  __syncthreads();
  tile_to_lds(p.proj + (size_t)ci * 128 * 4096 + 512 + h * 128, 4096, kbuf, PK, 128, 128);
  __syncthreads();
  {
    f32x4 s[8];
#pragma unroll
    for (int nn = 0; nn < 8; ++nn) s[nn] = (f32x4){0.f, 0.f, 0.f, 0.f};
    bf16x8 qa[4];
#pragma unroll
    for (int ks = 0; ks < 4; ++ks) qa[ks] = *(const bf16x8*)(qg + (size_t)(wid * 16 + fr) * 4096 + ks * 32 + fq * 8);
#pragma unroll
    for (int ks = 0; ks < 4; ++ks) {
#pragma unroll
      for (int nn = 0; nn < 8; ++nn) s[nn] = mfma16(qa[ks], frag_row(kbuf, PK, nn * 16, ks * 32, fr, fq), s[nn]);
    }
    __syncthreads();
    int bd = wid * 16 + fq * 4 - fr;
    asm volatile("" : "+v"(bd));
    LAS u16* prow = kbuf + (wid * 16 + fq * 4) * PK + fr;
#pragma unroll
    for (int nn = 0; nn < 8; ++nn)
#pragma unroll
      for (int j = 0; j < 4; ++j) {
        const int d = bd + j - 16 * nn;
        const float w = d > 0 ? __expf((float)d * lgf) : (d < 0 ? __expf((float)(-d) * lgb) : 2.f);
        prow[j * PK + nn * 16] = f2bf(s[nn][j] * w);
      }
  }
  const int m0 = (wid & 3) * 32, n0 = (wid >> 2) * 128;
  f32x4 acc[2][8];
#pragma unroll
  for (int m = 0; m < 2; ++m)
#pragma unroll
    for (int nn = 0; nn < 8; ++nn) acc[m][nn] = (f32x4){0.f, 0.f, 0.f, 0.f};
  const u16* qrow = qg + (size_t)(m0 + fr) * 4096 + fq * 8;
  if (sb >= 0) {
    if (tid == 0) {
      XB_WAIT(xb_ld(&scnt[((sb * 4 + h) * 2 + 0) * 16]) < 4u || xb_ld(&scnt[((sb * 4 + h) * 2 + 1) * 16]) < 4u, p.bar);
      __builtin_amdgcn_fence(__ATOMIC_ACQUIRE, "agent");
      asm volatile("s_waitcnt vmcnt(0)" ::: "memory");
    }
    __syncthreads();
    tile_to_lds(p.stimg + ((size_t)((sb * 4 + h) * 2 + 0) * 8 + lc) * 128 * 256, 256, bbuf, PV, 128, 256);
    __syncthreads();
  } else if (hasF) {
    tile_to_lds((const u16*)p.part + ((size_t)((cbase + 0) * 4 + h) * 2 + 0) * 128 * 256, 256, bbuf, PV, 128, 256);
    __syncthreads();
  }
  if (hasF) {
    {
      bf16x8 q0[4], q1[4];
#pragma unroll
      for (int ks = 0; ks < 4; ++ks) { q0[ks] = *(const bf16x8*)(qrow + ks * 32); q1[ks] = *(const bf16x8*)(qrow + 16 * 4096 + ks * 32); }
#pragma unroll 1
      for (int ks = 0; ks < 4; ++ks) {
        const bf16x8 a0 = ks == 0 ? q0[0] : (ks == 1 ? q0[1] : (ks == 2 ? q0[2] : q0[3])), a1 = ks == 0 ? q1[0] : (ks == 1 ? q1[1] : (ks == 2 ? q1[2] : q1[3]));
#pragma unroll
        for (int nn = 0; nn < 8; ++nn) {
          const bf16x8 b = frag_tr(bbuf, PV, ks * 32, n0 + nn * 16, fr, fq);
          acc[0][nn] = mfma16(a0, b, acc[0][nn]); acc[1][nn] = mfma16(a1, b, acc[1][nn]);
        }
      }
    }
#pragma unroll
    for (int m = 0; m < 2; ++m)
#pragma unroll
      for (int j = 0; j < 4; ++j) {
        const int il = m0 + m * 16 + fq * 4 + j;
        const float sc = hasB ? __expf((float)(il + 1) * lgf - (float)(128 - il) * lgb) : __expf((float)(il + 1) * lgf);
#pragma unroll
        for (int nn = 0; nn < 8; ++nn) acc[m][nn][j] *= sc;
      }
  }
  if (hasB) {
    __syncthreads();
    if (sb >= 0) tile_to_lds(p.stimg + ((size_t)((sb * 4 + h) * 2 + 1) * 8 + lc) * 128 * 256, 256, bbuf, PV, 128, 256);
    else tile_to_lds((const u16*)p.part + ((size_t)((cbase + 1) * 4 + h) * 2 + 1) * 128 * 256, 256, bbuf, PV, 128, 256);
    __syncthreads();
    {
      bf16x8 q0[4], q1[4];
#pragma unroll
      for (int ks = 0; ks < 4; ++ks) { q0[ks] = *(const bf16x8*)(qrow + ks * 32); q1[ks] = *(const bf16x8*)(qrow + 16 * 4096 + ks * 32); }
#pragma unroll 1
      for (int ks = 0; ks < 4; ++ks) {
        const bf16x8 a0 = ks == 0 ? q0[0] : (ks == 1 ? q0[1] : (ks == 2 ? q0[2] : q0[3])), a1 = ks == 0 ? q1[0] : (ks == 1 ? q1[1] : (ks == 2 ? q1[2] : q1[3]));
#pragma unroll
        for (int nn = 0; nn < 8; ++nn) {
          const bf16x8 b = frag_tr(bbuf, PV, ks * 32, n0 + nn * 16, fr, fq);
          acc[0][nn] = mfma16(a0, b, acc[0][nn]); acc[1][nn] = mfma16(a1, b, acc[1][nn]);
        }
      }
    }
#pragma unroll
    for (int m = 0; m < 2; ++m)
#pragma unroll
      for (int j = 0; j < 4; ++j) {
        const int il = m0 + m * 16 + fq * 4 + j;
        const float sc = __expf((float)(128 - il) * lgb);
#pragma unroll
        for (int nn = 0; nn < 8; ++nn) acc[m][nn][j] *= sc;
      }
  }
  __syncthreads();
  tile_to_lds(p.proj + (size_t)ci * 128 * 4096 + 1024 + h * 256, 4096, bbuf, PV, 128, 256);
  __syncthreads();
#pragma unroll 1
  for (int ks = 0; ks < 4; ++ks) {
    const bf16x8 a0 = frag_row(kbuf, PK, m0, ks * 32, fr, fq), a1 = frag_row(kbuf, PK, m0 + 16, ks * 32, fr, fq);
#pragma unroll
    for (int nn = 0; nn < 8; ++nn) {
      const bf16x8 b = frag_tr(bbuf, PV, ks * 32, n0 + nn * 16, fr, fq);
      acc[0][nn] = mfma16(a0, b, acc[0][nn]); acc[1][nn] = mfma16(a1, b, acc[1][nn]);
    }
  }
#pragma unroll
  for (int m = 0; m < 2; ++m)
#pragma unroll
    for (int j = 0; j < 4; ++j) {
      float s = 0.f;
#pragma unroll
      for (int nn = 0; nn < 8; ++nn) s += acc[m][nn][j] * acc[m][nn][j];
      s += __shfl_xor(s, 1); s += __shfl_xor(s, 2); s += __shfl_xor(s, 4); s += __shfl_xor(s, 8);
      if (fr == 0) red[(wid >> 2) * 128 + m0 + m * 16 + fq * 4 + j] = s;
    }
  __syncthreads();
#pragma unroll
  for (int m = 0; m < 2; ++m)
#pragma unroll
    for (int j = 0; j < 4; ++j) {
      const int il = m0 + m * 16 + fq * 4 + j;
      const float r = rsqrtf((red[il] + red[128 + il]) * (1.f / 256.f) + EPS);
      LAS u16* orow = bbuf + il * PV + n0 + fr;
#pragma unroll
      for (int nn = 0; nn < 8; ++nn) orow[nn * 16] = f2bf(acc[m][nn][j] * r);
    }
  __syncthreads();
  {
    const u16* gbase = p.proj + (size_t)ci * 128 * 4096 + 2048 + h * 256;
    u16* obase = p.cat + (size_t)ci * 128 * 1536 + h * 256;
    u32x4 gv[8];
#pragma unroll
    for (int k = 0; k < 8; ++k) { const int i = tid + k * NTHR, r = i >> 5, c = (i & 31) * 8; gv[k] = *(const u32x4*)(gbase + (size_t)r * 4096 + c); }
#pragma unroll
    for (int k = 0; k < 8; ++k) {
      const int i = tid + k * NTHR, r = i >> 5, c = (i & 31) * 8;
      const u32x4 ov = *(const LAS u32x4*)(bbuf + r * PV + c);
      u32x4 o;
#pragma unroll
      for (int e = 0; e < 4; ++e) o[e] = pk2(__uint_as_float(ov[e] << 16) * __uint_as_float(gv[k][e] << 16), __uint_as_float(ov[e] & 0xffff0000u) * __uint_as_float(gv[k][e] & 0xffff0000u));
      *(u32x4*)(obase + (size_t)r * 1536 + c) = o;
    }
  }
}
__device__ __forceinline__ void state_item(const P& p, int item) {
  const int b = item >> 3, h = (item >> 1) & 3, dir = item & 1;
  const float w = __expf(128.f * log1pf(-exp2f(-p.l0_decay[dir * 4 + h])));
  const int c_old = dir == 0 ? 2 * b : 2 * b + 1, c_new = dir == 0 ? 2 * b + 1 : 2 * b;
  const u16* A = (const u16*)p.part + ((size_t)(c_old * 4 + h) * 2 + dir) * 128 * 256;
  const u16* B = (const u16*)p.part + ((size_t)(c_new * 4 + h) * 2 + dir) * 128 * 256;
  float* o = p.out + (size_t)NT * DM + ((size_t)(b * 2 + dir) * 4 + h) * 128 * 256;
  u32x4 av[8], bv[8];
#pragma unroll
  for (int k = 0; k < 8; ++k) { const int i = threadIdx.x + k * NTHR; av[k] = *(const u32x4*)(A + i * 8); bv[k] = *(const u32x4*)(B + i * 8); }
#pragma unroll
  for (int k = 0; k < 8; ++k) {
    const int i = threadIdx.x + k * NTHR;
    f32x4 o0, o1;
    o0[0] = __uint_as_float(av[k][0] << 16) * w + __uint_as_float(bv[k][0] << 16); o0[1] = __uint_as_float(av[k][0] & 0xffff0000u) * w + __uint_as_float(bv[k][0] & 0xffff0000u);
    o0[2] = __uint_as_float(av[k][1] << 16) * w + __uint_as_float(bv[k][1] << 16); o0[3] = __uint_as_float(av[k][1] & 0xffff0000u) * w + __uint_as_float(bv[k][1] & 0xffff0000u);
    o1[0] = __uint_as_float(av[k][2] << 16) * w + __uint_as_float(bv[k][2] << 16); o1[1] = __uint_as_float(av[k][2] & 0xffff0000u) * w + __uint_as_float(bv[k][2] & 0xffff0000u);
    o1[2] = __uint_as_float(av[k][3] << 16) * w + __uint_as_float(bv[k][3] << 16); o1[3] = __uint_as_float(av[k][3] & 0xffff0000u) * w + __uint_as_float(bv[k][3] & 0xffff0000u);
    *(f32x4*)(o + i * 8) = o0; *(f32x4*)(o + i * 8 + 4) = o1;
  }
}
__device__ __forceinline__ void phase_mix_b(const P& p, LAS u16* lds, unsigned* scnt) {
  const int b = (int)blockIdx.x;
  if (b < 64) ret_item(p, 128 + b, lds, scnt);
  else if (b < 192) ret_item(p, b - 64, lds, scnt);
  else { scan_item(p, b - 192, scnt); state_item(p, 2 * (b - 192)); state_item(p, 2 * (b - 192) + 1); }
}

__device__ __forceinline__ void phase_conv(const P& p) {
  const u16* __restrict__ pj = p.proj;
  const size_t total = (size_t)NT * 256, stride = (size_t)gridDim.x * NTHR;
  for (size_t i0 = (size_t)blockIdx.x * NTHR + threadIdx.x; i0 < total; i0 += 4 * stride) {
    u32x2 av[4][3], bv[4][3], bgv[4]; bool ok[4][3];
#pragma unroll
    for (int u = 0; u < 4; ++u) {
      const size_t i = i0 + u * stride; const bool live = i < total;
      const int t = live ? (int)(i >> 8) : 0, c4 = (int)(i & 255) * 4;
      const int seg = t < NPROMPT_T ? 256 : 64, pos = t < NPROMPT_T ? (t & 255) : ((t - NPROMPT_T) & 63);
#pragma unroll
      for (int d = 0; d < 3; ++d) {
        const int pp = pos + d - 1; ok[u][d] = live && pp >= 0 && pp < seg;
        const u16* r = pj + (size_t)(ok[u][d] ? t + d - 1 : t) * 3072;
        av[u][d] = *(const u32x2*)(r + 1024 + c4); bv[u][d] = *(const u32x2*)(r + 2048 + c4);
      }
      bgv[u] = *(const u32x2*)(pj + (size_t)t * 3072 + c4);
    }
#pragma unroll
    for (int u = 0; u < 4; ++u) {
      const size_t i = i0 + u * stride; if (i >= total) continue;
      const int t = (int)(i >> 8), c4 = (int)(i & 255) * 4;
      f32x4 xc[3];
#pragma unroll
      for (int d = 0; d < 3; ++d) {
        const u32x2 a = av[u][d], b2 = bv[u][d];
        xc[d][0] = __uint_as_float(a[0] << 16) * __uint_as_float(b2[0] << 16); xc[d][1] = __uint_as_float(a[0] & 0xffff0000u) * __uint_as_float(b2[0] & 0xffff0000u);
        xc[d][2] = __uint_as_float(a[1] << 16) * __uint_as_float(b2[1] << 16); xc[d][3] = __uint_as_float(a[1] & 0xffff0000u) * __uint_as_float(b2[1] & 0xffff0000u);
        if (!ok[u][d]) xc[d] = (f32x4){0.f, 0.f, 0.f, 0.f};
      }
      const f32x4 w0 = *(const f32x4*)(p.l1_conv + c4), w1 = *(const f32x4*)(p.l1_conv + 1024 + c4), w2 = *(const f32x4*)(p.l1_conv + 2048 + c4);
      const f32x4 bg = {__uint_as_float(bgv[u][0] << 16), __uint_as_float(bgv[u][0] & 0xffff0000u), __uint_as_float(bgv[u][1] << 16), __uint_as_float(bgv[u][1] & 0xffff0000u)};
      const f32x4 y = bg * (w0 * xc[0] + w1 * xc[1] + w2 * xc[2]);
      u32x2 o; o[0] = pk2(y[0], y[1]); o[1] = pk2(y[2], y[3]);
      *(u32x2*)(p.cat + (size_t)t * 1024 + c4) = o;
    }
  }
}

#define XB_XCNT(j)  (256  + 64 * (j))
#define XB_XSUB(j)  (1280 + 64 * (j))
#define XB_XGEN(j)  (2304 + 64 * (j))
#define XB_TOP      3328
#define XB_TOPGEN   3392
#define XCD_BAR_WORDS 3456
__device__ __forceinline__ unsigned xb_xcc_id() { return (unsigned)__builtin_amdgcn_s_getreg((3 << 11) | 20) & 0xFu; }
struct XcdBarrier { unsigned* bar; unsigned x; volatile __attribute__((address_space(3))) unsigned* st; };
__device__ __forceinline__ XcdBarrier xcd_barrier_post(unsigned* bar, volatile __attribute__((address_space(3))) unsigned* st) {
  XcdBarrier b; b.bar = bar; b.x = xb_xcc_id(); b.st = st;
  if (threadIdx.x == 0) (void)xb_add(&bar[XB_XCNT(b.x)], 1u);
  return b;
}
__device__ __forceinline__ void xcd_barrier_complete(unsigned* bar, unsigned x, unsigned& nloc, unsigned& nx) {
  const unsigned G = gridDim.x * gridDim.y * gridDim.z;
  unsigned sum, cnt, mine, sp = 0u;
  for (;;) {
    sum = 0u; cnt = 0u; mine = 0u;
#pragma unroll
    for (unsigned j = 0; j < 16; ++j) { const unsigned c = xb_ld(&bar[XB_XCNT(j)]); sum += c; cnt += (c > 0u) ? 1u : 0u; mine = (j == x) ? c : mine; }
    if (sum == G) break;
    __builtin_amdgcn_s_sleep(1);
    if ((++sp & 255u) == 0u) { if (xb_ld(&bar[XB_TMO])) break; if (sp > XB_SPIN_CAP) { atomicAdd(&bar[XB_TMO], 1u); break; } }
  }
  nloc = mine > 0u ? mine : 1u; nx = cnt > 0u ? cnt : 1u;
}
__device__ __forceinline__ void xcd_barrier(const XcdBarrier& b) {
  asm volatile("s_waitcnt vmcnt(0)" ::: "memory");
  __syncthreads();
  if (threadIdx.x == 0) {
    unsigned* bar = b.bar;
    __builtin_amdgcn_s_waitcnt(0);
    unsigned nloc = b.st[0], nx = b.st[1];
    if (nloc == 0u) { xcd_barrier_complete(bar, b.x, nloc, nx); b.st[0] = nloc; b.st[1] = nx; }
    const unsigned old = xb_add(&bar[XB_XSUB(b.x)], 1u);
    const unsigned gen = old / nloc;
    if (old + 1u == (gen + 1u) * nloc) {
      __builtin_amdgcn_fence(__ATOMIC_RELEASE, "agent");
      asm volatile("s_waitcnt vmcnt(0)" ::: "memory");
      const unsigned og = xb_add(&bar[XB_TOP], 1u);
      const unsigned tg = og / nx;
      if (og + 1u == (tg + 1u) * nx) xb_add(&bar[XB_TOPGEN], 1u);
      else XB_SPIN(xb_ld(&bar[XB_TOPGEN]) == tg, bar);
      __builtin_amdgcn_fence(__ATOMIC_ACQUIRE, "agent");
      xb_add(&bar[XB_XGEN(b.x)], 1u);
      asm volatile("s_waitcnt vmcnt(0)" ::: "memory");
    } else {
      XB_SPIN(xb_ld(&bar[XB_XGEN(b.x)]) == gen, bar);
      __builtin_amdgcn_fence(__ATOMIC_ACQUIRE, "agent");
      asm volatile("s_waitcnt vmcnt(0)" ::: "memory");
    }
  }
  __syncthreads();
}

__device__ __forceinline__ void phase_norm_fused(const NormArgs& a, unsigned* cnt, unsigned* bar) {
  pg8::Order S; S.init(NT, 1024, 2, (int)gridDim.x, (int)blockIdx.x);
  pg8::Unit u;
  if (!S.next(0, u)) return;
  asm volatile("s_waitcnt vmcnt(0)" ::: "memory");
  __syncthreads();
  if (threadIdx.x == 0) {
    for (int i = 0; S.next(i, u); ++i) xb_add(&cnt[u.pm * 16], 1u);
  }
  const int wid = threadIdx.x >> 6, lane = threadIdx.x & 63;
  for (int i = 0; S.next(i, u); ++i) {
    if (threadIdx.x == 0) {
      XB_WAIT(xb_ld(&cnt[u.pm * 16]) < 8u, bar);
      __builtin_amdgcn_fence(__ATOMIC_ACQUIRE, "agent");
      asm volatile("s_waitcnt vmcnt(0)" ::: "memory");
    }
    __syncthreads();
    const int r0 = u.pm * 256 + (u.pn * 2 + u.ks) * 32 + wid * 4;
    norm_rows<4, 2>(a, r0, lane);
  }
}

__device__ __forceinline__ void phase_ffn(const P& p, const u16* w1t, const u16* w2t, const NormArgs& na, unsigned* cntA, unsigned* cntB, float* lds) {
  const int c = (int)blockIdx.x, tid = threadIdx.x, wid = tid >> 6, lane = tid & 63, x = c & 7;
  PG8_LAS unsigned char* l3 = (PG8_LAS unsigned char*)lds;
  __syncthreads();
  { pg8::Gemm g{p.hA, w1t, NT, 4096, 1024, 1}; pg8::FfnOrder1 S{c}; EpiRelu2W e{mk_rsrc(p.proj, (unsigned)NT * 4096u * 2u)}; pg8::gemm_phase(l3, g, S, e); }
  asm volatile("s_waitcnt vmcnt(0)" ::: "memory");
  __syncthreads();
  if (tid == 0) { pg8::FfnOrder1 S{c}; pg8::Unit u; for (int i = 0; S.next(i, u); ++i) xb_add(&cntA[u.pm * 16], 1u); }
  pg8::Unit ue, ul;
  { const int oj = (c - 128) >> 3; ue.ks = x & 3; ue.pm = 4 * (x >> 2) + (oj >> 2); ue.pn = oj & 3; }
  { const int o = c >> 3; ul.ks = x & 3; ul.pm = 8 + 8 * (x >> 2) + (o >> 2); ul.pn = o & 3; }
#pragma unroll 1
  for (int pass = (c >= 128 ? 0 : 1); pass < 2; ++pass) {
    const pg8::Unit u = pass == 0 ? ue : ul;
    if (tid == 0) {
      XB_WAIT(xb_ld(&cntA[u.pm * 16]) < 16u, p.bar);
      __builtin_amdgcn_fence(__ATOMIC_ACQUIRE, "agent");
      asm volatile("s_waitcnt vmcnt(0)" ::: "memory");
    }
    __syncthreads();
    { pg8::Gemm g{p.proj, w2t, NT, 1024, 4096, 4}; pg8::OneUnit S{u}; EpiPartW e{mk_rsrc(p.part, 4u * (unsigned)NT * 1024u * 2u)}; pg8::gemm_phase(l3, g, S, e); }
    asm volatile("s_waitcnt vmcnt(0)" ::: "memory");
    __syncthreads();
    if (tid == 0) xb_add(&cntB[u.pm * 16], 1u);
  }
  if (tid == 0) {
    if (c >= 128) XB_WAIT(xb_ld(&cntB[ue.pm * 16]) < 16u, p.bar);
    XB_WAIT(xb_ld(&cntB[ul.pm * 16]) < 16u, p.bar);
    __builtin_amdgcn_fence(__ATOMIC_ACQUIRE, "agent");
    asm volatile("s_waitcnt vmcnt(0)" ::: "memory");
  }
  __syncthreads();
  const int rl = ul.pm * 256 + (ul.pn * 4 + ul.ks) * 16 + wid * 2, re = ue.pm * 256 + (ue.pn * 4 + ue.ks) * 16 + wid * 2;
  if (c >= 128) { const int rows[4] = {re, re + 1, rl, rl + 1}; norm_rows_idx<4, 4>(na, rows, lane); }
  else norm_rows<2, 4>(na, rl, lane);
}

__device__ __forceinline__ void conv_rect(const P& p, int row0, int ch0) {
  const u16* __restrict__ pj = p.proj;
  const __amdgpu_buffer_rsrc_t rs = mk_rsrc(p.cat, (unsigned)NT * 1024u * 2u);
#pragma unroll 1
  for (int b0 = 0; b0 < 16; b0 += 4) {
    u32x2 av[4][3], bv[4][3], bgv[4]; bool ok[4][3];
#pragma unroll
    for (int u = 0; u < 4; ++u) {
      const int i = threadIdx.x + (b0 + u) * NTHR;
      const int t = row0 + (i >> 7), c4 = ch0 + (i & 127) * 4;
      const int seg = t < NPROMPT_T ? 256 : 64, pos = t < NPROMPT_T ? (t & 255) : ((t - NPROMPT_T) & 63);
#pragma unroll
      for (int d = 0; d < 3; ++d) {
        const int pp = pos + d - 1; ok[u][d] = pp >= 0 && pp < seg;
        const u16* r = pj + (size_t)(ok[u][d] ? t + d - 1 : t) * 3072;
        av[u][d] = *(const u32x2*)(r + 1024 + c4); bv[u][d] = *(const u32x2*)(r + 2048 + c4);
      }
      bgv[u] = *(const u32x2*)(pj + (size_t)t * 3072 + c4);
    }
#pragma unroll
    for (int u = 0; u < 4; ++u) {
      const int i = threadIdx.x + (b0 + u) * NTHR;
      const int t = row0 + (i >> 7), c4 = ch0 + (i & 127) * 4;
      f32x4 xc[3];
#pragma unroll
      for (int d = 0; d < 3; ++d) {
        const u32x2 a = av[u][d], b2 = bv[u][d];
        xc[d][0] = __uint_as_float(a[0] << 16) * __uint_as_float(b2[0] << 16); xc[d][1] = __uint_as_float(a[0] & 0xffff0000u) * __uint_as_float(b2[0] & 0xffff0000u);
        xc[d][2] = __uint_as_float(a[1] << 16) * __uint_as_float(b2[1] << 16); xc[d][3] = __uint_as_float(a[1] & 0xffff0000u) * __uint_as_float(b2[1] & 0xffff0000u);
        if (!ok[u][d]) xc[d] = (f32x4){0.f, 0.f, 0.f, 0.f};
      }
      const f32x4 w0 = *(const f32x4*)(p.l1_conv + c4), w1 = *(const f32x4*)(p.l1_conv + 1024 + c4), w2 = *(const f32x4*)(p.l1_conv + 2048 + c4);
      const f32x4 bg = {__uint_as_float(bgv[u][0] << 16), __uint_as_float(bgv[u][0] & 0xffff0000u), __uint_as_float(bgv[u][1] << 16), __uint_as_float(bgv[u][1] & 0xffff0000u)};
      const f32x4 y = bg * (w0 * xc[0] + w1 * xc[1] + w2 * xc[2]);
      const unsigned long long v = (unsigned long long)pk2(y[0], y[1]) | ((unsigned long long)pk2(y[2], y[3]) << 32);
      __hip_atomic_store((unsigned long long*)(p.cat + (size_t)t * 1024 + c4), v, __ATOMIC_RELAXED, __HIP_MEMORY_SCOPE_AGENT);
    }
  }
}

__device__ __forceinline__ void phase_l1(const P& p, const NormArgs& na, unsigned* cntA, unsigned* cntC, unsigned* cntB, float* lds) {
  const int c = (int)blockIdx.x, tid = threadIdx.x, wid = tid >> 6, lane = tid & 63;
  PG8_LAS unsigned char* l3 = (PG8_LAS unsigned char*)lds;
  __syncthreads();
  { pg8::Gemm g{p.hA, p.wt1_in, NT, 3072, 1024, 1}; pg8::L1InOrder S{c}; EpiPlain e{p.proj, 3072}; pg8::gemm_phase(l3, g, S, e); }
  asm volatile("s_waitcnt vmcnt(0)" ::: "memory");
  __syncthreads();
  if (tid == 0) { pg8::L1InOrder S{c}; pg8::Unit u; for (int i = 0; S.next(i, u); ++i) xb_add(&cntA[u.pm * 16], 1u); }
  if (c < 40 || c >= 232) return;
  pg8::Unit u;
  { const int j = c - 40; u.pm = j >> 3; u.pn = (j & 7) >> 1; u.ks = j & 1; }
  if (tid == 0) {
    XB_WAIT(xb_ld(&cntA[u.pm * 16]) < 12u, p.bar);
    __builtin_amdgcn_fence(__ATOMIC_ACQUIRE, "agent");
    asm volatile("s_waitcnt vmcnt(0)" ::: "memory");
  }
  __syncthreads();
  conv_rect(p, u.pm * 256 + u.pn * 64, u.ks * 512);
  asm volatile("s_waitcnt vmcnt(0)" ::: "memory");
  __syncthreads();
  if (tid == 0) {
    xb_add(&cntC[(u.pm * 2 + u.ks) * 8], 1u);
    XB_WAIT(xb_ld(&cntC[(u.pm * 2 + u.ks) * 8]) < 4u, p.bar);
    __builtin_amdgcn_fence(__ATOMIC_ACQUIRE, "agent");
    asm volatile("s_waitcnt vmcnt(0)" ::: "memory");
  }
  __syncthreads();
  { pg8::Gemm g{p.cat, p.wt1_out, NT, 1024, 1024, 2}; pg8::OneUnit S{u}; EpiPartW e{mk_rsrc(p.part, 4u * (unsigned)NT * 1024u * 2u)}; pg8::gemm_phase(l3, g, S, e); }
  asm volatile("s_waitcnt vmcnt(0)" ::: "memory");
  __syncthreads();
  if (tid == 0) {
    xb_add(&cntB[u.pm * 16], 1u);
    XB_WAIT(xb_ld(&cntB[u.pm * 16]) < 8u, p.bar);
    __builtin_amdgcn_fence(__ATOMIC_ACQUIRE, "agent");
    asm volatile("s_waitcnt vmcnt(0)" ::: "memory");
  }
  __syncthreads();
  norm_rows<4, 2>(na, u.pm * 256 + (u.pn * 2 + u.ks) * 32 + wid * 4, lane);
}

constexpr int NPHASE = 8;
#ifndef REPMASK
#define REPMASK 0
#endif
__global__ void __launch_bounds__(NTHR) mega(P p, int lo, int hi) {
  extern __shared__ __attribute__((aligned(16))) unsigned char smem[];
  float* lds = (float*)smem;
  cg::grid_group grid = cg::this_grid();
  volatile LAS unsigned* xst = (volatile LAS unsigned*)(smem + 131072);
  if (threadIdx.x == 0) { xst[0] = 0u; xst[1] = 0u; }
  __syncthreads();
  const XcdBarrier xb = xcd_barrier_post(p.bar, xst);
  if (hi < 0) grid.sync();
  const float* m0 = p.mod; const float* m1 = p.mod + 3 * 6144;
#define PH(n, ...) if (lo <= (n) && (n) < hi) { if ((n) > lo) xcd_barrier(xb); __VA_ARGS__ if ((REPMASK >> (n)) & 1) { xcd_barrier(xb); __VA_ARGS__ } }
  unsigned* pcnt = p.bar + XCD_BAR_WORDS;
  float* const xs = p.xres + (size_t)NPROMPT_T * DM; float* const pp = p.part;
  PH(0, { phase_prep(p, lds);
          if (threadIdx.x == 0) { XB_WAIT(xb_ld(pcnt + 9 * 384) < 96u, p.bar); __builtin_amdgcn_fence(__ATOMIC_ACQUIRE, "agent"); asm volatile("s_waitcnt vmcnt(0)" ::: "memory"); }
          __syncthreads();
          NormArgs a{p.x_prompt, p.x_sample, nullptr, nullptr, nullptr, nullptr, p.l0_norm1, m0 + 0, m0 + 1024, p.hA, nullptr}; phase_norm(a); })
  PH(1, { EpiProj0 e{p.proj}; phase_gemm(p.hA, p.wt0_in, NT, 4096, 1024, 1, e, lds); phase_prep2(p, lds, 0, 128); })
  PH(2, { phase_mix_a(p, (LAS u16*)smem); phase_prep2(p, lds, 2, 128); })
  PH(3, phase_mix_b(p, (LAS u16*)smem, pcnt + 6 * 384);)
  PH(4, { EpiPartW e{mk_rsrc(p.part, 4u * (unsigned)NT * 1024u * 2u)}; phase_gemm(p.cat, p.wt0_out, NT, 1024, 1536, 2, e, lds);
          NormArgs a{p.x_prompt, p.x_sample, pp, pp, m0 + 2048, p.xres, p.l0_norm2, m0 + 3072, m0 + 4096, p.hA, nullptr}; phase_norm_fused(a, pcnt + 0 * 384, p.bar);
          phase_prep2(p, lds, 1, 192); })
  PH(5, { NormArgs a{p.xres, xs, pp, pp, m0 + 5120, p.xres, p.l1_norm1, m1 + 0, m1 + 1024, p.hA, nullptr}; phase_ffn(p, p.wt0_f1, p.wt0_f2, a, pcnt + 1 * 384, pcnt + 2 * 384, lds); })
  PH(6, { NormArgs a{p.xres, xs, pp, pp, m1 + 2048, p.xres, p.l1_norm2, m1 + 3072, m1 + 4096, p.hA, nullptr}; phase_l1(p, a, pcnt + 7 * 384, pcnt + 8 * 384, pcnt + 3 * 384, lds); })
  PH(7, { NormArgs a{p.xres, xs, pp, pp, m1 + 5120, nullptr, p.final_norm, nullptr, nullptr, nullptr, p.out}; phase_ffn(p, p.wt1_f1, p.wt1_f2, a, pcnt + 4 * 384, pcnt + 5 * 384, lds); })
#undef PH
}

constexpr size_t LDS_BYTES = 131072 + 256;
constexpr bool ONE_LAUNCH = true;

extern "C" void kernel_launch(void* const* d_in, const int* in_sizes, int n_in, void* d_out, int out_size, void* d_ws, size_t ws_size, hipStream_t stream) {
  static int grid_blocks = 0;
  if (!grid_blocks) {
    hipFuncSetAttribute((const void*)mega, hipFuncAttributeMaxDynamicSharedMemorySize, (int)LDS_BYTES);
    int dev = 0, cus = 0, per_cu = 0;
    hipGetDevice(&dev);
    hipDeviceGetAttribute(&cus, hipDeviceAttributeMultiprocessorCount, dev);
    hipOccupancyMaxActiveBlocksPerMultiprocessor(&per_cu, mega, NTHR, LDS_BYTES);
    if (per_cu < 1) per_cu = 1;
    if (per_cu > 1) per_cu = 1;
    grid_blocks = 256;
  }
  P p{};
  const float* const* in = (const float* const*)d_in;
  p.x_prompt = in[0]; p.x_sample = in[1]; p.state = in[2]; p.c = in[3]; p.c_ctx = in[4];
  p.l0_norm1 = in[5]; p.l0_w_in = in[6]; p.l0_decay = in[7]; p.l0_gws = in[8]; p.l0_gb = in[9]; p.l0_w_out = in[10]; p.l0_norm2 = in[11];
  p.l0_w_mod = in[12]; p.l0_b_mod = in[13]; p.l0_f1 = in[14]; p.l0_f2 = in[15];
  p.l1_norm1 = in[16]; p.l1_w_in = in[17]; p.l1_conv = in[18]; p.l1_w_out = in[19]; p.l1_norm2 = in[20]; p.l1_w_mod = in[21]; p.l1_b_mod = in[22];
  p.l1_f1 = in[23]; p.l1_f2 = in[24]; p.final_norm = in[25];
  p.out = (float*)d_out;
  unsigned char* w = (unsigned char*)d_ws; size_t off = 0;
  auto take = [&](size_t bytes) { void* r = w + off; off += (bytes + 255) & ~(size_t)255; return r; };
  p.wt0_in = (u16*)take((size_t)4096 * 1024 * 2); p.wt0_out = (u16*)take((size_t)1024 * 1536 * 2);
  p.wt0_f1 = (u16*)take((size_t)4096 * 1024 * 2); p.wt0_f2 = (u16*)take((size_t)4096 * 1024 * 2);
  p.wt1_in = (u16*)take((size_t)3072 * 1024 * 2); p.wt1_out = (u16*)take((size_t)1024 * 1024 * 2);
  p.wt1_f1 = (u16*)take((size_t)4096 * 1024 * 2); p.wt1_f2 = (u16*)take((size_t)4096 * 1024 * 2);
  p.mod = (float*)take((size_t)2 * 3 * 6144 * 4);
  p.hA = (u16*)take((size_t)NT * 1024 * 2);
  p.proj = (u16*)take((size_t)NT * 4096 * 2);
  p.cat = (u16*)take((size_t)NT * 1536 * 2);
  p.part = (float*)take((size_t)2 * NT * 1024 * 4);
  p.xres = (float*)take((size_t)NT * 1024 * 4);
  p.stimg = (u16*)take((size_t)2 * 4 * 2 * 8 * 128 * 256 * 2);
  p.bar = (unsigned*)take((size_t)(XCD_BAR_WORDS + 10 * 384) * 4);
  hipMemsetAsync(p.bar, 0, (size_t)(XCD_BAR_WORDS + 10 * 384) * 4, stream);
  if (ONE_LAUNCH) {
    int lo = 0, hi = NPHASE; void* args[] = {&p, &lo, &hi};
    hipError_t e = hipLaunchCooperativeKernel((void*)mega, dim3(grid_blocks), dim3(NTHR), args, LDS_BYTES, stream);
    if (e != hipSuccess) fprintf(stderr, "cooperative launch failed: %s (grid %d)\n", hipGetErrorString(e), grid_blocks);
  } else {
    for (int ph = 0; ph < NPHASE; ++ph) hipLaunchKernelGGL(mega, dim3(grid_blocks), dim3(NTHR), LDS_BYTES, stream, p, ph, ph + 1);
  }
}
```

```cpp
#include <hip/hip_runtime.h>
#include <hip/hip_cooperative_groups.h>
#include <cstdio>
namespace cg = cooperative_groups;

typedef unsigned short u16;
typedef float f32x4 __attribute__((ext_vector_type(4)));
typedef unsigned u32x4 __attribute__((ext_vector_type(4)));
typedef unsigned u32x2 __attribute__((ext_vector_type(2)));

constexpr int NT = 6144, DM = 1024, NPROMPT_T = 4096;
constexpr float EPS = 1e-6f;
constexpr int NTHR = 512;

__device__ __forceinline__ float bf2f(u16 b) { return __uint_as_float(((unsigned)b) << 16); }
typedef float f32x2 __attribute__((ext_vector_type(2)));
typedef __bf16 hbf16x2 __attribute__((ext_vector_type(2)));
__device__ __forceinline__ unsigned pk2(float a, float b) { const f32x2 v = {a, b}; const hbf16x2 r = __builtin_convertvector(v, hbf16x2); return __builtin_bit_cast(unsigned, r); }
__device__ __forceinline__ u16 f2bf(float f) { return (u16)(pk2(f, 0.f) & 0xffffu); }
__device__ __forceinline__ float silu_f(float x) { return x * __builtin_amdgcn_rcpf(1.f + __expf(-x)); }
__device__ __forceinline__ float gelu_f(float x) { const float u = -1.5957691216057308f * (x + 0.044715f * x * x * x); return x * __builtin_amdgcn_rcpf(1.f + __expf(u)); }
__device__ __forceinline__ int cond_of(int t) { return t < NPROMPT_T ? 0 : 1 + ((t - NPROMPT_T) >> 10); }
__device__ __forceinline__ float wave_sum(float v) {
#pragma unroll
  for (int o = 32; o > 0; o >>= 1) v += __shfl_xor(v, o);
  return v;
}

struct P {
  const float *x_prompt, *x_sample, *state, *c, *c_ctx;
  const float *l0_norm1, *l0_w_in, *l0_decay, *l0_gws, *l0_gb, *l0_w_out, *l0_norm2, *l0_w_mod, *l0_b_mod, *l0_f1, *l0_f2;
  const float *l1_norm1, *l1_w_in, *l1_conv, *l1_w_out, *l1_norm2, *l1_w_mod, *l1_b_mod, *l1_f1, *l1_f2, *final_norm;
  float* out;
  u16 *wt0_in, *wt0_out, *wt0_f1, *wt0_f2, *wt1_in, *wt1_out, *wt1_f1, *wt1_f2;
  float* mod;
  u16* hA;
  u16* proj;
  u16* proj2;
  u16* cat;
  float* part;
  float* xres;
  u16* stimg;
  unsigned* bar;
};

__device__ __forceinline__ unsigned xb_ld(unsigned* p)              { return __hip_atomic_load(p, __ATOMIC_RELAXED, __HIP_MEMORY_SCOPE_AGENT); }
__device__ __forceinline__ unsigned xb_add(unsigned* p, unsigned v) { return __hip_atomic_fetch_add(p, v, __ATOMIC_RELAXED, __HIP_MEMORY_SCOPE_AGENT); }
#define XB_TMO      128
#define XB_SPIN_CAP (1u << 18)
#define XB_SPIN(cond, bar) do { unsigned _sp = 0; while (cond) { __builtin_amdgcn_s_sleep(1); \
    if ((++_sp & 255u) == 0u) { if (xb_ld(&(bar)[XB_TMO])) break; if (_sp > XB_SPIN_CAP) { atomicAdd(&(bar)[XB_TMO], 1u); break; } } } } while (0)
#define XB_WAIT(cond, bar) do { unsigned _sp = 0; while (cond) { __builtin_amdgcn_s_sleep(16); \
    if ((++_sp & 63u) == 0u) { if (xb_ld(&(bar)[XB_TMO])) break; if (_sp > (1u << 16)) { atomicAdd(&(bar)[XB_TMO], 1u); break; } } } } while (0)

__device__ __forceinline__ __amdgpu_buffer_rsrc_t mk_rsrc(void* p, unsigned bytes) { return __builtin_amdgcn_make_buffer_rsrc(p, 0, (int)bytes, 0x00020000); }

__device__ __forceinline__ int l1_perm(int n) { if (n < 1024) return n; const int hv = n >= 2048, ch = n - (hv ? 2048 : 1024); return 1024 + (ch >> 7) * 256 + hv * 128 + (ch & 127); }
__device__ __forceinline__ void transpose_tile(const float* __restrict__ W, int K, int N, u16* __restrict__ Wt, int tile, float* lds, int perm = 0, unsigned* pub = nullptr) {
  const int tn = N / 256; const int k0 = (tile / tn) * 64, n0 = (tile % tn) * 256;
  const int tid = threadIdx.x;
  float (*T)[257] = (float (*)[257])lds;
  __syncthreads();
  {
    const int r = tid >> 6, c4 = (tid & 63) * 4;
    f32x4 v[8];
#pragma unroll
    for (int i = 0; i < 8; ++i) v[i] = __builtin_nontemporal_load((const f32x4*)(W + (size_t)(k0 + r + 8 * i) * N + n0 + c4));
#pragma unroll
    for (int i = 0; i < 8; ++i) { T[r + 8 * i][c4 + 0] = v[i][0]; T[r + 8 * i][c4 + 1] = v[i][1]; T[r + 8 * i][c4 + 2] = v[i][2]; T[r + 8 * i][c4 + 3] = v[i][3]; }
  }
  __syncthreads();
  {
    const int kk = (tid & 7) * 8;
#pragma unroll
    for (int ps = 0; ps < 4; ++ps) {
      const int nn = (tid >> 3) + 64 * ps;
      u32x4 o;
      o[0] = pk2(T[kk + 0][nn], T[kk + 1][nn]); o[1] = pk2(T[kk + 2][nn], T[kk + 3][nn]);
      o[2] = pk2(T[kk + 4][nn], T[kk + 5][nn]); o[3] = pk2(T[kk + 6][nn], T[kk + 7][nn]);
      if (pub) __builtin_amdgcn_raw_buffer_store_b128(o, mk_rsrc(Wt, (unsigned)((size_t)K * N * 2)), (unsigned)(((size_t)(n0 + nn) * K + k0 + kk) * 2), 0, 16);
      else __builtin_nontemporal_store(o, (u32x4*)(Wt + (size_t)(perm ? l1_perm(n0 + nn) : n0 + nn) * K + k0 + kk));
    }
  }
  if (pub) {
    asm volatile("s_waitcnt vmcnt(0)" ::: "memory");
    __syncthreads();
    if (threadIdx.x == 0) xb_add(&pub[(n0 >> 8) * 16], 1u);
  }
}

__device__ __forceinline__ void adaln_item(const P& p, int item, float* lds) {
  const int l = item / 96, n0 = (item % 96) * 64;
  const float* W = l ? p.l1_w_mod : p.l0_w_mod; const float* B = l ? p.l1_b_mod : p.l0_b_mod;
  const int tid = threadIdx.x;
  float* sc = lds;
  float* red = lds + 3072;
  __syncthreads();
  for (int i = tid; i < 3072; i += NTHR) {
    const int c = i >> 10, k = i & 1023;
    const float v = c == 0 ? p.c_ctx[k] : p.c[(c - 1) * 1024 + k];
    sc[i] = silu_f(v);
  }
  __syncthreads();
  const int cg4 = tid & 15, rg = tid >> 4;
  float acc[3][4] = {};
#pragma unroll 8
  for (int it = 0; it < 32; ++it) {
    const int k = it * 32 + rg;
    const f32x4 w = __builtin_nontemporal_load((const f32x4*)(W + (size_t)k * 6144 + n0 + cg4 * 4));
#pragma unroll
    for (int c = 0; c < 3; ++c) { const float s = sc[c * 1024 + k];
#pragma unroll
      for (int e = 0; e < 4; ++e) acc[c][e] += s * w[e]; }
  }
#pragma unroll
  for (int c = 0; c < 3; ++c)
#pragma unroll
    for (int e = 0; e < 4; ++e) red[(rg * 3 + c) * 64 + cg4 * 4 + e] = acc[c][e];
  __syncthreads();
  if (tid < 192) {
    const int c = tid >> 6, n = tid & 63; float s = B[n0 + n];
    for (int r = 0; r < 32; ++r) s += red[(r * 3 + c) * 64 + n];
    __hip_atomic_store(&p.mod[(size_t)(l * 3 + c) * 6144 + n0 + n], s, __ATOMIC_RELAXED, __HIP_MEMORY_SCOPE_AGENT);
  }
  if (l == 0) {
    asm volatile("s_waitcnt vmcnt(0)" ::: "memory");
    __syncthreads();
    if (tid == 0) xb_add(p.bar + 3456 + 9 * 384, 1u);
  }
}

__device__ __forceinline__ void phase_prep(const P& p, float* lds) {
  for (int it = blockIdx.x; it < 96 + 256; it += gridDim.x) {
    if (it < 96) adaln_item(p, it, lds); else transpose_tile(p.l0_w_in, 1024, 4096, p.wt0_in, it - 96, lds, 0, p.bar + 3456 + 15 * 384);
  }
}
__device__ __forceinline__ void phase_prep2(const P& p, float* lds, int group, int first_want) {
  const int first = (int)gridDim.x >= 256 ? first_want : 0, nblk = (int)gridDim.x - first;
  if ((int)blockIdx.x < first) return;
  const int total = group == 0 ? 96 + 96 + 256 + 256 : (group == 1 ? 192 + 64 + 256 : 256);
  for (int it = (int)blockIdx.x - first; it < total; it += nblk) {
    int i = it;
    if (group == 0) {
      if (i < 96) { adaln_item(p, 96 + i, lds); continue; } i -= 96;
      if (i < 96) { transpose_tile(p.l0_w_out, 1536, 1024, p.wt0_out, i, lds); continue; } i -= 96;
      if (i < 256) { transpose_tile(p.l0_f1, 1024, 4096, p.wt0_f1, i, lds); continue; } i -= 256;
      transpose_tile(p.l0_f2, 4096, 1024, p.wt0_f2, i, lds);
    } else if (group == 1) {
      if (i < 192) { transpose_tile(p.l1_w_in, 1024, 3072, p.wt1_in, i, lds, 1); continue; } i -= 192;
      if (i < 64) { transpose_tile(p.l1_w_out, 1024, 1024, p.wt1_out, i, lds); continue; } i -= 64;
      transpose_tile(p.l1_f2, 4096, 1024, p.wt1_f2, i, lds);
    } else {
      transpose_tile(p.l1_f1, 1024, 4096, p.wt1_f1, i, lds);
    }
  }
}

struct NormArgs {
  const float* xin0; const float* xin1;
  const float* p0; const float* p1; const float* gate;
  float* xout; const float* nw; const float* sh; const float* sc;
  u16* hout; float* fout;
  int xin_bf;
};
template <int R, int NP>
__device__ __forceinline__ void norm_rows(const NormArgs& a, int t0, int lane) {
  const int c = cond_of(t0);
  f32x4 x[R][4];
#pragma unroll
  for (int r = 0; r < R; ++r) {
    const int t = t0 + r;
    if (a.xin_bf) {
      const u16* xr = t < NPROMPT_T ? (const u16*)a.xin0 + (size_t)t * DM : (const u16*)a.xin1 + (size_t)(t - NPROMPT_T) * DM;
#pragma unroll
      for (int i = 0; i < 4; ++i) { const u32x2 v = *(const u32x2*)(xr + lane * 4 + 256 * i);
        x[r][i] = (f32x4){__uint_as_float(v[0] << 16), __uint_as_float(v[0] & 0xffff0000u), __uint_as_float(v[1] << 16), __uint_as_float(v[1] & 0xffff0000u)}; }
    } else {
      const float* xr = t < NPROMPT_T ? a.xin0 + (size_t)t * DM : a.xin1 + (size_t)(t - NPROMPT_T) * DM;
#pragma unroll
      for (int i = 0; i < 4; ++i) x[r][i] = __builtin_nontemporal_load((const f32x4*)(xr + lane * 4 + 256 * i));
    }
  }
  if (a.p0) {
    u32x2 q[R][NP][4];
#pragma unroll
    for (int r = 0; r < R; ++r)
#pragma unroll
      for (int k = 0; k < NP; ++k)
#pragma unroll
        for (int i = 0; i < 4; ++i) q[r][k][i] = *(const u32x2*)((const u16*)a.p0 + ((size_t)k * NT + t0 + r) * DM + lane * 4 + 256 * i);
#pragma unroll
    for (int i = 0; i < 4; ++i) {
      const f32x4 g = *(const f32x4*)(a.gate + (size_t)c * 6144 + lane * 4 + 256 * i);
#pragma unroll
      for (int r = 0; r < R; ++r) {
        f32x4 ps = {0.f, 0.f, 0.f, 0.f};
#pragma unroll
        for (int k = 0; k < NP; ++k) {
          ps[0] += __uint_as_float(q[r][k][i][0] << 16); ps[1] += __uint_as_float(q[r][k][i][0] & 0xffff0000u);
          ps[2] += __uint_as_float(q[r][k][i][1] << 16); ps[3] += __uint_as_float(q[r][k][i][1] & 0xffff0000u);
        }
        x[r][i] = x[r][i] + g * ps;
      }
    }
  }
  float rs[R];
#pragma unroll
  for (int r = 0; r < R; ++r) {
    float ss = 0.f;
#pragma unroll
    for (int i = 0; i < 4; ++i) {
      if (a.xout) { const unsigned long long o = (unsigned long long)pk2(x[r][i][0], x[r][i][1]) | ((unsigned long long)pk2(x[r][i][2], x[r][i][3]) << 32);
        __hip_atomic_store((unsigned long long*)((u16*)a.xout + (size_t)(t0 + r) * DM + lane * 4 + 256 * i), o, __ATOMIC_RELAXED, __HIP_MEMORY_SCOPE_AGENT); }
      ss += x[r][i][0] * x[r][i][0] + x[r][i][1] * x[r][i][1] + x[r][i][2] * x[r][i][2] + x[r][i][3] * x[r][i][3];
    }
    ss = wave_sum(ss);
    rs[r] = rsqrtf(ss * (1.f / 1024.f) + EPS);
  }
#pragma unroll
  for (int i = 0; i < 4; ++i) {
    const int col = lane * 4 + 256 * i;
    const f32x4 w = *(const f32x4*)(a.nw + col);
    f32x4 sh = {0.f, 0.f, 0.f, 0.f}, sc = {0.f, 0.f, 0.f, 0.f};
    if (a.hout) { sh = *(const f32x4*)(a.sh + (size_t)c * 6144 + col); sc = *(const f32x4*)(a.sc + (size_t)c * 6144 + col); }
#pragma unroll
    for (int r = 0; r < R; ++r) {
      f32x4 y = x[r][i] * rs[r] * w;
      if (a.fout) __builtin_nontemporal_store(y, (f32x4*)(a.fout + (size_t)(t0 + r) * DM + col));
      if (a.hout) {
        y = y * (1.f + sc) + sh;
        const unsigned long long o = (unsigned long long)pk2(y[0], y[1]) | ((unsigned long long)pk2(y[2], y[3]) << 32);
        __hip_atomic_store((unsigned long long*)(a.hout + (size_t)(t0 + r) * DM + col), o, __ATOMIC_RELAXED, __HIP_MEMORY_SCOPE_AGENT);
      }
    }
  }
}
template <int R, int NP>
__device__ __forceinline__ void norm_rows_idx(const NormArgs& a, const int (&rows)[R], int lane) {
  f32x4 x[R][4];
#pragma unroll
  for (int r = 0; r < R; ++r) {
    const int t = rows[r];
    if (a.xin_bf) {
      const u16* xr = t < NPROMPT_T ? (const u16*)a.xin0 + (size_t)t * DM : (const u16*)a.xin1 + (size_t)(t - NPROMPT_T) * DM;
#pragma unroll
      for (int i = 0; i < 4; ++i) { const u32x2 v = *(const u32x2*)(xr + lane * 4 + 256 * i);
        x[r][i] = (f32x4){__uint_as_float(v[0] << 16), __uint_as_float(v[0] & 0xffff0000u), __uint_as_float(v[1] << 16), __uint_as_float(v[1] & 0xffff0000u)}; }
    } else {
      const float* xr = t < NPROMPT_T ? a.xin0 + (size_t)t * DM : a.xin1 + (size_t)(t - NPROMPT_T) * DM;
#pragma unroll
      for (int i = 0; i < 4; ++i) x[r][i] = __builtin_nontemporal_load((const f32x4*)(xr + lane * 4 + 256 * i));
    }
  }
  if (a.p0) {
    u32x2 q[R][NP][4];
#pragma unroll
    for (int r = 0; r < R; ++r)
#pragma unroll
      for (int k = 0; k < NP; ++k)
#pragma unroll
        for (int i = 0; i < 4; ++i) q[r][k][i] = *(const u32x2*)((const u16*)a.p0 + ((size_t)k * NT + rows[r]) * DM + lane * 4 + 256 * i);
#pragma unroll
    for (int i = 0; i < 4; ++i) {
#pragma unroll
      for (int r = 0; r < R; ++r) {
        const f32x4 g = *(const f32x4*)(a.gate + (size_t)cond_of(rows[r]) * 6144 + lane * 4 + 256 * i);
        f32x4 ps = {0.f, 0.f, 0.f, 0.f};
#pragma unroll
        for (int k = 0; k < NP; ++k) {
          ps[0] += __uint_as_float(q[r][k][i][0] << 16); ps[1] += __uint_as_float(q[r][k][i][0] & 0xffff0000u);
          ps[2] += __uint_as_float(q[r][k][i][1] << 16); ps[3] += __uint_as_float(q[r][k][i][1] & 0xffff0000u);
        }
        x[r][i] = x[r][i] + g * ps;
      }
    }
  }
  float rs[R];
#pragma unroll
  for (int r = 0; r < R; ++r) {
    float ss = 0.f;
#pragma unroll
    for (int i = 0; i < 4; ++i) {
      if (a.xout) { const unsigned long long o = (unsigned long long)pk2(x[r][i][0], x[r][i][1]) | ((unsigned long long)pk2(x[r][i][2], x[r][i][3]) << 32);
        __hip_atomic_store((unsigned long long*)((u16*)a.xout + (size_t)(rows[r]) * DM + lane * 4 + 256 * i), o, __ATOMIC_RELAXED, __HIP_MEMORY_SCOPE_AGENT); }
      ss += x[r][i][0] * x[r][i][0] + x[r][i][1] * x[r][i][1] + x[r][i][2] * x[r][i][2] + x[r][i][3] * x[r][i][3];
    }
    ss = wave_sum(ss);
    rs[r] = rsqrtf(ss * (1.f / 1024.f) + EPS);
  }
#pragma unroll
  for (int i = 0; i < 4; ++i) {
    const int col = lane * 4 + 256 * i;
    const f32x4 w = *(const f32x4*)(a.nw + col);
#pragma unroll
    for (int r = 0; r < R; ++r) {
      f32x4 sh = {0.f, 0.f, 0.f, 0.f}, sc = {0.f, 0.f, 0.f, 0.f};
      if (a.hout) { const int c = cond_of(rows[r]); sh = *(const f32x4*)(a.sh + (size_t)c * 6144 + col); sc = *(const f32x4*)(a.sc + (size_t)c * 6144 + col); }
      f32x4 y = x[r][i] * rs[r] * w;
      if (a.fout) __builtin_nontemporal_store(y, (f32x4*)(a.fout + (size_t)(rows[r]) * DM + col));
      if (a.hout) {
        y = y * (1.f + sc) + sh;
        const unsigned long long o = (unsigned long long)pk2(y[0], y[1]) | ((unsigned long long)pk2(y[2], y[3]) << 32);
        __hip_atomic_store((unsigned long long*)(a.hout + (size_t)(rows[r]) * DM + col), o, __ATOMIC_RELAXED, __HIP_MEMORY_SCOPE_AGENT);
      }
    }
  }
}
__device__ __forceinline__ void phase_norm(const NormArgs& a) {
  const int wid = threadIdx.x >> 6, lane = threadIdx.x & 63;
  for (int g = blockIdx.x * 8 + wid; g < NT / 4; g += gridDim.x * 8) norm_rows<4, 2>(a, g * 4, lane);
}
struct EpiProj0 {
  static constexpr bool PAIR = false;
  u16* O;
  __device__ __forceinline__ void store8(int row, int col, f32x4 v0, f32x4 v1, int) const {
    if (col >= 3072) {
#pragma unroll
      for (int e = 0; e < 4; ++e) { v0[e] = gelu_f(v0[e]); v1[e] = gelu_f(v1[e]); }
    } else if (col >= 2048) {
#pragma unroll
      for (int e = 0; e < 4; ++e) { v0[e] = silu_f(v0[e]); v1[e] = silu_f(v1[e]); }
    } else if (col >= 512 && col < 1024) { v0 = v0 * 0.08838834764831845f; v1 = v1 * 0.08838834764831845f; }
    u32x4 o; o[0] = pk2(v0[0], v0[1]); o[1] = pk2(v0[2], v0[3]); o[2] = pk2(v1[0], v1[1]); o[3] = pk2(v1[2], v1[3]);
    __builtin_amdgcn_raw_buffer_store_b128(o, mk_rsrc(O, (unsigned)NT * 4096u * 2u), (unsigned)(((size_t)row * 4096 + col) * 2), 0, 16);
  }
  __device__ __forceinline__ void store4(int row, int col, f32x4 v, int) const {
    if (col >= 3072) { v[0] = gelu_f(v[0]); v[1] = gelu_f(v[1]); v[2] = gelu_f(v[2]); v[3] = gelu_f(v[3]); }
    else if (col >= 2048) { v[0] = silu_f(v[0]); v[1] = silu_f(v[1]); v[2] = silu_f(v[2]); v[3] = silu_f(v[3]); }
    else if (col >= 512 && col < 1024) v = v * 0.08838834764831845f;
    u32x2 o; o[0] = pk2(v[0], v[1]); o[1] = pk2(v[2], v[3]);
    *(u32x2*)(O + (size_t)row * 4096 + col) = o;
  }
};
struct EpiPart {
  static constexpr bool PAIR = false;
  float* Pp;
  __device__ __forceinline__ void store8(int row, int col, f32x4 v0, f32x4 v1, int ks) const {
    u32x4 o; o[0] = pk2(v0[0], v0[1]); o[1] = pk2(v0[2], v0[3]); o[2] = pk2(v1[0], v1[1]); o[3] = pk2(v1[2], v1[3]);
    *(u32x4*)((u16*)Pp + ((size_t)ks * NT + row) * DM + col) = o;
  }
};
struct EpiRelu2 {
  static constexpr bool PAIR = false;
  u16* O;
  __device__ __forceinline__ void store8(int row, int col, f32x4 v0, f32x4 v1, int) const {
#pragma unroll
    for (int e = 0; e < 4; ++e) { const float r0 = fmaxf(v0[e], 0.f), r1 = fmaxf(v1[e], 0.f); v0[e] = r0 * r0; v1[e] = r1 * r1; }
    u32x4 o; o[0] = pk2(v0[0], v0[1]); o[1] = pk2(v0[2], v0[3]); o[2] = pk2(v1[0], v1[1]); o[3] = pk2(v1[2], v1[3]);
    *(u32x4*)(O + (size_t)row * 4096 + col) = o;
  }
  __device__ __forceinline__ void store4(int row, int col, f32x4 v, int) const {
#pragma unroll
    for (int e = 0; e < 4; ++e) { const float r = fmaxf(v[e], 0.f); v[e] = r * r; }
    u32x2 o; o[0] = pk2(v[0], v[1]); o[1] = pk2(v[2], v[3]);
    *(u32x2*)(O + (size_t)row * 4096 + col) = o;
  }
};
struct EpiPartW {
  static constexpr bool PAIR = false;
  __amdgpu_buffer_rsrc_t rs;
  __device__ __forceinline__ void store8(int row, int col, f32x4 v0, f32x4 v1, int ks) const {
    u32x4 o; o[0] = pk2(v0[0], v0[1]); o[1] = pk2(v0[2], v0[3]); o[2] = pk2(v1[0], v1[1]); o[3] = pk2(v1[2], v1[3]);
    __builtin_amdgcn_raw_buffer_store_b128(o, rs, (unsigned)((((size_t)ks * NT + row) * DM + col) * 2), 0, 16);
  }
};
struct EpiRelu2W {
  static constexpr bool PAIR = false;
  __amdgpu_buffer_rsrc_t rs;
  __device__ __forceinline__ void store8(int row, int col, f32x4 v0, f32x4 v1, int) const {
#pragma unroll
    for (int e = 0; e < 4; ++e) { const float r0 = fmaxf(v0[e], 0.f), r1 = fmaxf(v1[e], 0.f); v0[e] = r0 * r0; v1[e] = r1 * r1; }
    u32x4 o; o[0] = pk2(v0[0], v0[1]); o[1] = pk2(v0[2], v0[3]); o[2] = pk2(v1[0], v1[1]); o[3] = pk2(v1[2], v1[3]);
    __builtin_amdgcn_raw_buffer_store_b128(o, rs, (unsigned)(((size_t)row * 4096 + col) * 2), 0, 16);
  }
};
struct EpiPlain {
  static constexpr bool PAIR = true;
  u16* O;
  __device__ __forceinline__ void store8(int row, int col, f32x4 v0, f32x4 v1, int) const {
    u32x4 o; o[0] = pk2(v0[0], v0[1]); o[1] = pk2(v0[2], v0[3]); o[2] = pk2(v1[0], v1[1]); o[3] = pk2(v1[2], v1[3]);
    __builtin_amdgcn_raw_buffer_store_b128(o, mk_rsrc(O, (unsigned)NT * 2048u * 2u), (unsigned)(((size_t)row * 2048 + col) * 2), 0, 16);
  }
  __device__ __forceinline__ void store_pair(int row, int ch, f32x4 c0, f32x4 c1, f32x4 h0, f32x4 h1) const {
    const f32x4 x0 = c0 * h0, x1 = c1 * h1;
    u32x4 o; o[0] = pk2(x0[0], x0[1]); o[1] = pk2(x0[2], x0[3]); o[2] = pk2(x1[0], x1[1]); o[3] = pk2(x1[2], x1[3]);
    __builtin_amdgcn_raw_buffer_store_b128(o, mk_rsrc(O, (unsigned)NT * 2048u * 2u), (unsigned)(((size_t)row * 2048 + 1024 + ch) * 2), 0, 16);
  }
};

template <class Epi>
__device__ __forceinline__ void phase_gemm_naive(const u16* __restrict__ A, const u16* __restrict__ Bt, int M, int N, int K, int ksplit, const Epi& E, float* lds) {
  float (*As)[33] = (float (*)[33])lds;
  float (*Bs)[33] = (float (*)[33])(lds + 128 * 33);
  const int tm = M / 128, tn = N / 64, total = tm * tn * ksplit, kper = K / ksplit;
  const int tid = threadIdx.x, r = tid >> 2, cq = tid & 3;
  for (int it = blockIdx.x; it < total; it += gridDim.x) {
    const int ks = it / (tm * tn), rem = it % (tm * tn), m0 = (rem / tn) * 128, n0 = (rem % tn) * 64;
    float acc[4][4] = {};
    for (int k0 = ks * kper; k0 < (ks + 1) * kper; k0 += 32) {
      __syncthreads();
      {
        const int kc = (tid & 3) * 8;
        const u32x4 va = *(const u32x4*)(A + (size_t)(m0 + r) * K + k0 + kc);
#pragma unroll
        for (int e = 0; e < 4; ++e) { As[r][kc + 2 * e] = __uint_as_float(va[e] << 16); As[r][kc + 2 * e + 1] = __uint_as_float(va[e] & 0xffff0000u); }
        if (tid < 256) {
          const u32x4 vb = *(const u32x4*)(Bt + (size_t)(n0 + r) * K + k0 + kc);
#pragma unroll
          for (int e = 0; e < 4; ++e) { Bs[r][kc + 2 * e] = __uint_as_float(vb[e] << 16); Bs[r][kc + 2 * e + 1] = __uint_as_float(vb[e] & 0xffff0000u); }
        }
      }
      __syncthreads();
#pragma unroll 4
      for (int k = 0; k < 32; ++k) {
        const float a = As[r][k];
#pragma unroll
        for (int jj = 0; jj < 4; ++jj)
#pragma unroll
          for (int e = 0; e < 4; ++e) acc[jj][e] += a * Bs[cq * 4 + 16 * jj + e][k];
      }
    }
#pragma unroll
    for (int jj = 0; jj < 4; ++jj) { f32x4 v = {acc[jj][0], acc[jj][1], acc[jj][2], acc[jj][3]}; E.store4(m0 + r, n0 + cq * 4 + 16 * jj, v, ks); }
  }
}


namespace pg8 {
#define PG8_LAS __attribute__((address_space(3)))
typedef short bf16x8 __attribute__((ext_vector_type(8)));
constexpr int BM = 256, BK = 64, HALF = 128, HTB = HALF * BK * 2, STAGE_BYTES = 8 * HTB, NXCD = 8, WGM = 8;
__device__ __forceinline__ int lds_byte(int r, int c) { const int st = (r >> 4) * 2 + (c >> 5), rr = r & 15, cc = c & 31, ob = rr * 64 + cc * 2; return st * 1024 + (ob ^ (((ob >> 9) & 1) << 5)); }
__device__ __forceinline__ int perm32(int rho) { const int n = rho >> 4, i = rho & 15; return 8 * (i >> 2) + 4 * n + (i & 3); }
__device__ __forceinline__ void stage_rc(int b, int& R, int& C) { const int st = b / 1024, sb = b % 1024, swz = sb ^ (((sb >> 9) & 1) << 5); R = (st >> 1) * 16 + swz / 64; C = (st & 1) * 32 + (swz % 64) / 2; }
struct Unit { int pm, pn, ks; };
struct Gemm { const u16* A; const u16* Bt; int M, N, K, ksplit; };
struct Order {
  int nM, nN, ntile, nwg, G, c;
  __device__ __forceinline__ void init(int M, int N, int ksplit, int G_, int c_) { nM = M / BM; nN = N / BM; ntile = nM * nN; nwg = ntile * ksplit; G = G_; c = c_; }
  __device__ __forceinline__ bool next(int i, Unit& u) const {
    const int L = i * G + c; if (L >= nwg) return false;
    u.ks = L / ntile; int wgid = L % ntile;
    { const int q = ntile / NXCD, r = ntile % NXCD, xcd = wgid % NXCD, off = wgid / NXCD; wgid = (xcd < r ? xcd * (q + 1) : r * (q + 1) + (xcd - r) * q) + off; }
    const int nig = WGM * nN, gid = wgid / nig, fm = gid * WGM, gsz = (nM - fm) < WGM ? (nM - fm) : WGM;
    u.pm = fm + ((wgid % nig) % gsz); u.pn = (wgid % nig) / gsz; return true;
  }
};
template <class Epi>
__device__ __forceinline__ void run_epi(const Epi& E, const f32x4 (&acc)[2][2][4][2], const Unit& u, int wr, int wc, int fr, int fq) {
  const int row0 = u.pm * BM + wr * 64 + fr, col0 = u.pn * BM + wc * 32 + 8 * fq;
#pragma unroll
  for (int ai = 0; ai < 2; ++ai)
#pragma unroll
    for (int m = 0; m < 4; ++m)
      {
        if constexpr (Epi::PAIR) {
          if (u.pn >= 4) { E.store_pair(row0 + ai * HALF + m * 16, (u.pn - 4) * HALF + wc * 32 + 8 * fq, acc[ai][0][m][0], acc[ai][0][m][1], acc[ai][1][m][0], acc[ai][1][m][1]); continue; }
        }
#pragma unroll
        for (int bj = 0; bj < 2; ++bj) E.store8(row0 + ai * HALF + m * 16, col0 + bj * HALF, acc[ai][bj][m][0], acc[ai][bj][m][1], u.ks);
      }
}
struct OneUnit { Unit u; __device__ __forceinline__ bool next(int i, Unit& o) const { if (i) return false; o = u; return true; } };
struct FfnOrder1 {
  int c;
  __device__ __forceinline__ bool next(int i, Unit& u) const {
    const int x = c & 7; u.ks = 0;
    if (c >= 128) { if (i) return false; const int oj = (c - 128) >> 3; u.pm = 2 * (x >> 1) + (oj >> 3); u.pn = (x & 1) * 8 + (oj & 7); return true; }
    if (i > 1) return false;
    const int o = c >> 3; u.pm = 8 + 8 * i + 2 * (x >> 1) + (o >> 3); u.pn = (x & 1) * 8 + (o & 7); return true;
  }
};
struct L1InOrder {
  int c;
  __device__ __forceinline__ bool next(int i, Unit& u) const {
    u.ks = 0;
    if (c >= 40) { if (i) return false; const int idx = c - 40; u.pm = idx / 12; u.pn = idx % 12; return true; }
    if (c >= 36 || i > 1) return false;
    const int t = i * 36 + c; u.pm = 18 + t / 12; u.pn = t % 12; return true;
  }
};
template <class Epi, class Sched>
__device__ __forceinline__ void gemm_phase(PG8_LAS unsigned char* lds, const Gemm g, const Sched& S, const Epi& E) {
  int tid_ = threadIdx.x; asm volatile("" : "+v"(tid_));
  const int tid = tid_, wid = __builtin_amdgcn_readfirstlane(tid >> 6), lane = tid & 63, wr = wid >> 2, wc = wid & 3, fr = lane & 15, fq = lane >> 4;
  const int K = g.K, kper = g.K / g.ksplit, nt = kper / BK;
  unsigned voffA[2], voffB[2];
#pragma unroll
  for (int i = 0; i < 2; ++i) { int R, C; stage_rc(tid * 16 + i * 8192, R, C); const int Rb = (R & ~31) + perm32(R & 31);
    voffA[i] = (unsigned)(R * K + C) * 2u; voffB[i] = (unsigned)(Rb * K + C) * 2u; }
  const size_t kstep = (size_t)(BK * 2);
  const size_t hstep = (size_t)HALF * K * 2;
  const size_t tstep = 2 * hstep;
  const size_t ksbytes = (size_t)kper * 2;
  const unsigned ldsw = (unsigned)wid * 1024u;
  const int aoff = lds_byte(wr * 64 + fr, fq * 8), boff = lds_byte(wc * 32 + fr, fq * 8);
#define PG8_SA(b, h) (((b) * 2 + (h)) * HTB)
#define PG8_SB(b, h) ((4 + (b) * 2 + (h)) * HTB)
#define PG8_STAGE(bufoff, gbase, voff) do { _Pragma("unroll") for (int _i = 0; _i < 2; ++_i) \
    __builtin_amdgcn_global_load_lds((const unsigned*)((const char*)(gbase) + (voff)[_i]), (PG8_LAS unsigned*)(lds + (bufoff) + ldsw + _i * 8192), 16, 0, 0); } while (0)
#define PG8_LDA(dst, b, h) do { _Pragma("unroll") for (int m = 0; m < 4; ++m) _Pragma("unroll") for (int k = 0; k < 2; ++k) dst[m][k] = *(const PG8_LAS bf16x8*)(lds + PG8_SA(b, h) + aoff + m * 2048 + k * 1024); } while (0)
#define PG8_LDB(dst, b, h) do { _Pragma("unroll") for (int n = 0; n < 2; ++n) _Pragma("unroll") for (int k = 0; k < 2; ++k) dst[n][k] = *(const PG8_LAS bf16x8*)(lds + PG8_SB(b, h) + boff + n * 2048 + k * 1024); } while (0)
#define PG8_MMA(ai, bj, At, Bt) do { __builtin_amdgcn_s_setprio(1); _Pragma("unroll") for (int m = 0; m < 4; ++m) _Pragma("unroll") for (int n = 0; n < 2; ++n) _Pragma("unroll") for (int k = 0; k < 2; ++k) \
    acc[ai][bj][m][n] = __builtin_amdgcn_mfma_f32_16x16x32_bf16(Bt[n][k], At[m][k], acc[ai][bj][m][n], 0, 0, 0); __builtin_amdgcn_s_setprio(0); } while (0)
#define PG8_WAIT_V(n) asm volatile("s_waitcnt vmcnt(" #n ")" ::: "memory")
#define PG8_WAIT_L(n) asm volatile("s_waitcnt lgkmcnt(" #n ")" ::: "memory")
#define PG8_BAR __builtin_amdgcn_s_barrier()
#define PG8_SCHED __builtin_amdgcn_sched_barrier(0)
  Unit cur, nxt; int ui = 0;
  if (!S.next(0, cur)) return;
  f32x4 acc[2][2][4][2];
#pragma unroll
  for (int a = 0; a < 2; ++a)
#pragma unroll
    for (int b = 0; b < 2; ++b)
#pragma unroll
      for (int m = 0; m < 4; ++m)
#pragma unroll
        for (int n = 0; n < 2; ++n) acc[a][b][m][n] = (f32x4){0.f, 0.f, 0.f, 0.f};
  bf16x8 At[4][2], B0[2][2], B1[2][2];
  const char* cA = (const char*)g.A + (size_t)cur.pm * tstep + (size_t)cur.ks * ksbytes; const char* cB = (const char*)g.Bt + (size_t)cur.pn * tstep + (size_t)cur.ks * ksbytes;
  PG8_STAGE(PG8_SB(0, 0), cB, voffB); PG8_STAGE(PG8_SA(0, 0), cA, voffA); PG8_STAGE(PG8_SB(0, 1), cB + hstep, voffB); PG8_STAGE(PG8_SA(0, 1), cA + hstep, voffA);
  if (wr == 1) PG8_BAR;
  PG8_WAIT_V(4); PG8_BAR;
  PG8_STAGE(PG8_SB(1, 0), cB + kstep, voffB); PG8_STAGE(PG8_SA(1, 0), cA + kstep, voffA); PG8_STAGE(PG8_SB(1, 1), cB + hstep + kstep, voffB);
  PG8_WAIT_V(6); PG8_BAR;
  for (;;) {
    const bool has_next = S.next(ui + 1, nxt);
    const char* nA = has_next ? (const char*)g.A + (size_t)nxt.pm * tstep + (size_t)nxt.ks * ksbytes : cA; const char* nB = has_next ? (const char*)g.Bt + (size_t)nxt.pn * tstep + (size_t)nxt.ks * ksbytes : cB;
    for (int t = 0; t < nt; t += 2) {
      const bool last = (t == nt - 2);
      const char* a1 = cA + (size_t)(t + 1) * kstep;
      const char* a2 = last ? nA : cA + (size_t)(t + 2) * kstep; const char* b2 = last ? nB : cB + (size_t)(t + 2) * kstep;
      const char* a3 = a2 + kstep; const char* b3 = b2 + kstep;
      PG8_LDB(B0, 0, 0); PG8_SCHED; PG8_LDA(At, 0, 0); PG8_STAGE(PG8_SA(1, 1), a1 + hstep, voffA);
      PG8_WAIT_L(8); PG8_BAR; PG8_WAIT_L(0); PG8_MMA(0, 0, At, B0); PG8_BAR; PG8_SCHED;
      PG8_LDB(B1, 0, 1); PG8_STAGE(PG8_SB(0, 0), b2, voffB);
      PG8_BAR; PG8_WAIT_L(0); PG8_MMA(0, 1, At, B1); PG8_BAR;
      PG8_LDA(At, 0, 1); PG8_STAGE(PG8_SA(0, 0), a2, voffA);
      PG8_BAR; PG8_WAIT_L(0); PG8_MMA(1, 0, At, B0); PG8_BAR; PG8_SCHED;
      PG8_STAGE(PG8_SB(0, 1), b2 + hstep, voffB);
      PG8_WAIT_V(6); PG8_BAR; PG8_MMA(1, 1, At, B1); PG8_BAR;
      PG8_LDB(B0, 1, 0); PG8_SCHED; PG8_LDA(At, 1, 0); PG8_STAGE(PG8_SA(0, 1), a2 + hstep, voffA);
      PG8_WAIT_L(8); PG8_BAR; PG8_WAIT_L(0); PG8_MMA(0, 0, At, B0); PG8_BAR; PG8_SCHED;
      PG8_LDB(B1, 1, 1); PG8_STAGE(PG8_SB(1, 0), b3, voffB);
      PG8_BAR; PG8_WAIT_L(0); PG8_MMA(0, 1, At, B1); PG8_BAR;
      PG8_LDA(At, 1, 1); PG8_STAGE(PG8_SA(1, 0), a3, voffA);
      PG8_BAR; PG8_WAIT_L(0); PG8_MMA(1, 0, At, B0); PG8_BAR; PG8_SCHED;
      PG8_STAGE(PG8_SB(1, 1), b3 + hstep, voffB);
      PG8_WAIT_V(6); PG8_BAR; PG8_MMA(1, 1, At, B1); PG8_BAR;
    }
    run_epi(E, acc, cur, wr, wc, fr, fq);
    if (!has_next) break;
#pragma unroll
    for (int a = 0; a < 2; ++a)
#pragma unroll
      for (int b = 0; b < 2; ++b)
#pragma unroll
        for (int m = 0; m < 4; ++m)
#pragma unroll
          for (int n = 0; n < 2; ++n) acc[a][b][m][n] = (f32x4){0.f, 0.f, 0.f, 0.f};
    cur = nxt; cA = nA; cB = nB; ++ui;
  }
  PG8_WAIT_V(0);
  if (wr == 0) PG8_BAR;
  PG8_BAR;
#undef PG8_SA
#undef PG8_SB
#undef PG8_STAGE
#undef PG8_LDA
#undef PG8_LDB
#undef PG8_MMA
#undef PG8_WAIT_V
#undef PG8_WAIT_L
#undef PG8_BAR
#undef PG8_SCHED
}
}
template <class Epi>
__device__ __forceinline__ void phase_gemm(const u16* A, const u16* Bt, int M, int N, int K, int ksplit, const Epi& E, float* lds) {
  __syncthreads();
  pg8::Gemm g{A, Bt, M, N, K, ksplit};
  pg8::Order S; S.init(M, N, ksplit, (int)gridDim.x, (int)blockIdx.x);
  pg8::gemm_phase(( __attribute__((address_space(3))) unsigned char*)lds, g, S, E);
  __syncthreads();
}

__device__ __forceinline__ void seq_of_token(int t, int& s0, int& L, int& sb) {
  if (t < NPROMPT_T) { s0 = t & ~255; L = 256; sb = -1; } else { sb = (t - NPROMPT_T) >> 10; s0 = NPROMPT_T + (sb << 10); L = 1024; }
}
__device__ __forceinline__ void ret_item_naive(const P& p, int item, float* lds) {
  const int tg = item >> 2, h = item & 3, t0 = tg * 16, tid = threadIdx.x;
  int s0, L, sb; seq_of_token(t0, s0, L, sb);
  float* scr = lds;
  float* qs = lds + 16 * 1024;
  float* red = qs + 16 * 128;
  const float lgf = log1pf(-exp2f(-p.l0_decay[h])), lgb = log1pf(-exp2f(-p.l0_decay[4 + h]));
  __syncthreads();
  for (int i = tid; i < 16 * 128; i += NTHR) qs[i] = bf2f(p.proj[(size_t)(t0 + (i >> 7)) * 4096 + h * 128 + (i & 127)]);
  __syncthreads();
  for (int j = tid; j < L; j += NTHR) {
    float acc[16] = {};
    const u16* kr = p.proj + (size_t)(s0 + j) * 4096 + 512 + h * 128;
    for (int d0 = 0; d0 < 128; d0 += 8) {
      const u32x4 kv = *(const u32x4*)(kr + d0);
      float kf[8];
#pragma unroll
      for (int e = 0; e < 4; ++e) { kf[2 * e] = __uint_as_float(kv[e] << 16); kf[2 * e + 1] = __uint_as_float(kv[e] & 0xffff0000u); }
#pragma unroll
      for (int i = 0; i < 16; ++i)
#pragma unroll
        for (int e = 0; e < 8; ++e) acc[i] += qs[i * 128 + d0 + e] * kf[e];
    }
#pragma unroll
    for (int i = 0; i < 16; ++i) {
      const int d = (t0 + i - s0) - j;
      const float w = d > 0 ? __expf((float)d * lgf) : (d < 0 ? __expf((float)(-d) * lgb) : 2.f);
      scr[i * 1024 + j] = acc[i] * w;
    }
  }
  __syncthreads();
  const int dv = tid & 255, ig = tid >> 8;
  float o[8] = {};
  for (int j = 0; j < L; ++j) {
    const float v = bf2f(p.proj[(size_t)(s0 + j) * 4096 + 1024 + h * 256 + dv]);
#pragma unroll
    for (int e = 0; e < 8; ++e) o[e] += scr[(ig * 8 + e) * 1024 + j] * v;
  }
  if (sb >= 0) {
    const float* Sf = p.state + ((size_t)(sb * 2 + 0) * 4 + h) * 128 * 256;
    const float* Sb = p.state + ((size_t)(sb * 2 + 1) * 4 + h) * 128 * 256;
    float af[8] = {}, ab[8] = {};
    for (int dk = 0; dk < 128; ++dk) {
      const float sf = Sf[dk * 256 + dv], sbv = Sb[dk * 256 + dv];
#pragma unroll
      for (int e = 0; e < 8; ++e) { const float q = qs[(ig * 8 + e) * 128 + dk]; af[e] += q * sf; ab[e] += q * sbv; }
    }
#pragma unroll
    for (int e = 0; e < 8; ++e) {
      const int pos = t0 + ig * 8 + e - s0;
      o[e] += __expf((float)(pos + 1) * lgf) * af[e] + __expf((float)(L - pos) * lgb) * ab[e];
    }
  }
  const int wid = tid >> 6, lane = tid & 63;
#pragma unroll
  for (int e = 0; e < 8; ++e) { const float s = wave_sum(o[e] * o[e]); if (lane == 0) red[wid * 8 + e] = s; }
  __syncthreads();
#pragma unroll
  for (int e = 0; e < 8; ++e) {
    const float ss = red[(ig * 4 + 0) * 8 + e] + red[(ig * 4 + 1) * 8 + e] + red[(ig * 4 + 2) * 8 + e] + red[(ig * 4 + 3) * 8 + e];
    const float r = rsqrtf(ss * (1.f / 256.f) + EPS);
    const int t = t0 + ig * 8 + e;
    const float g = bf2f(p.proj[(size_t)t * 4096 + 2048 + h * 256 + dv]);
    p.cat[(size_t)t * 1536 + h * 256 + dv] = f2bf(o[e] * r * g);
  }
}
__device__ __forceinline__ void state_item_naive(const P& p, int item) {
  const int b = item >> 3, h = (item >> 1) & 3, dir = item & 1, tid = threadIdx.x;
  const float lg = log1pf(-exp2f(-p.l0_decay[dir * 4 + h]));
  const int dv = tid & 255;
  float* o = p.out + (size_t)NT * DM + ((size_t)(b * 2 + dir) * 4 + h) * 128 * 256;
  for (int pass = 0; pass < 4; ++pass) {
    const int dk0 = (tid >> 8) * 64 + pass * 16;
    float acc[16] = {};
    for (int s = 0; s < 256; ++s) {
      const int t = b * 256 + s;
      const float w = dir == 0 ? __expf((float)(255 - s) * lg) : __expf((float)s * lg);
      const float v = bf2f(p.proj[(size_t)t * 4096 + 1024 + h * 256 + dv]) * w;
      const u16* kr = p.proj + (size_t)t * 4096 + 512 + h * 128 + dk0;
#pragma unroll
      for (int e = 0; e < 16; ++e) acc[e] += bf2f(kr[e]) * v;
    }
#pragma unroll
    for (int e = 0; e < 16; ++e) o[(dk0 + e) * 256 + dv] = acc[e];
  }
}
__device__ __forceinline__ void gmlp_item_naive(const P& p, int item, float* lds) {
  const int ci = item >> 2, g = item & 3, tid = threadIdx.x, wid = tid >> 6, lane = tid & 63;
  float* zn = lds;
  float* mu = lds + 128 * 128;
  float* rs = mu + 128;
  __syncthreads();
  for (int q = wid; q < 128; q += 8) {
    const u32x4 v = *(const u32x4*)(p.proj + (size_t)(ci * 128 + q) * 4096 + 3584 + lane * 8);
    float s = 0.f, s2 = 0.f;
#pragma unroll
    for (int e = 0; e < 4; ++e) { const float a = __uint_as_float(v[e] << 16), b = __uint_as_float(v[e] & 0xffff0000u); s += a + b; s2 += a * a + b * b; }
    s = wave_sum(s); s2 = wave_sum(s2);
    if (lane == 0) { const float m = s * (1.f / 512.f); const float var = fmaxf(s2 * (1.f / 512.f) - m * m, 0.f); mu[q] = m; rs[q] = rsqrtf(var + EPS); }
  }
  __syncthreads();
  for (int i = tid; i < 128 * 128; i += NTHR) {
    const int q = i >> 7, c = i & 127;
    zn[i] = (bf2f(p.proj[(size_t)(ci * 128 + q) * 4096 + 3584 + g * 128 + c]) - mu[q]) * rs[q];
  }
  __syncthreads();
  const int c = tid & 127, p0 = (tid >> 7) * 32;
  float acc[32] = {};
  const float* W = p.l0_gws + (size_t)g * 128 * 128;
  for (int q = 0; q < 128; ++q) {
    const float z = zn[q * 128 + c];
#pragma unroll
    for (int e = 0; e < 32; ++e) acc[e] += W[(p0 + e) * 128 + q] * z;
  }
#pragma unroll
  for (int e = 0; e < 32; ++e) {
    const int t = ci * 128 + p0 + e;
    const float u = bf2f(p.proj[(size_t)t * 4096 + 3072 + g * 128 + c]);
    p.cat[(size_t)t * 1536 + 1024 + g * 128 + c] = f2bf((acc[e] + p.l0_gb[g * 128 + p0 + e]) * u);
  }
}
__device__ __forceinline__ void phase_mixer_naive(const P& p, float* lds) {
  const int nR = 1536, nS = 128, nG = 192, total = nR + nS + nG;
  for (int it = blockIdx.x; it < total; it += gridDim.x) {
    if (it < nR) ret_item_naive(p, it, lds);
    else if (it < nR + nS) state_item_naive(p, it - nR);
    else gmlp_item_naive(p, it - nR - nS, lds);
  }
}


#define LAS __attribute__((address_space(3)))
typedef short bf16x8 __attribute__((ext_vector_type(8)));
typedef short bf16x4 __attribute__((ext_vector_type(4)));
constexpr int PK = 136;
constexpr int PV = 264;
__device__ __forceinline__ bf16x8 frag_row(const LAS u16* base, int pitch, int r0, int k0, int fr, int fq) {
  return *(const LAS bf16x8*)(base + (r0 + fr) * pitch + k0 + fq * 8);
}
__device__ __forceinline__ bf16x8 frag_tr(const LAS u16* base, int pitch, int k0, int n0, int fr, int fq) {
  const LAS u16* a = base + (k0 + fq * 8 + (fr >> 2)) * pitch + n0 + 4 * (fr & 3);
  const bf16x4 lo = __builtin_amdgcn_ds_read_tr16_b64_v4i16((LAS bf16x4*)a);
  const bf16x4 hi = __builtin_amdgcn_ds_read_tr16_b64_v4i16((LAS bf16x4*)(a + 4 * pitch));
  bf16x8 r; r[0] = lo[0]; r[1] = lo[1]; r[2] = lo[2]; r[3] = lo[3]; r[4] = hi[0]; r[5] = hi[1]; r[6] = hi[2]; r[7] = hi[3];
  return r;
}
__device__ __forceinline__ f32x4 mfma16(bf16x8 a, bf16x8 b, f32x4 c) { return __builtin_amdgcn_mfma_f32_16x16x32_bf16(a, b, c, 0, 0, 0); }
template <int ROWS, int COLS>
__device__ __forceinline__ void tile_to_lds_t(const u16* __restrict__ g, size_t gp, LAS u16* l, int lp) {
  constexpr int CPR = COLS / 8, N = ROWS * CPR / NTHR;
  u32x4 v[N];
#pragma unroll
  for (int k = 0; k < N; ++k) { const int i = threadIdx.x + k * NTHR, r = i / CPR, c = (i % CPR) * 8; v[k] = *(const u32x4*)(g + (size_t)r * gp + c); }
#pragma unroll
  for (int k = 0; k < N; ++k) { const int i = threadIdx.x + k * NTHR, r = i / CPR, c = (i % CPR) * 8; *(LAS u32x4*)(l + r * lp + c) = v[k]; }
}
__device__ __forceinline__ void tile_to_lds(const u16* __restrict__ g, size_t gp, LAS u16* l, int lp, int rows, int cols) {
  if (cols == 128) tile_to_lds_t<128, 128>(g, gp, l, lp); else tile_to_lds_t<128, 256>(g, gp, l, lp);
}

__device__ __forceinline__ void kv_item(const P& p, int item, LAS u16* lds) {
  const int ci = item >> 2, h = item & 3, tid = threadIdx.x, wid = tid >> 6, lane = tid & 63, fr = lane & 15, fq = lane >> 4;
  LAS u16* kbuf = lds; LAS u16* vbuf = lds + 128 * PK;
  __syncthreads();
  tile_to_lds(p.proj + (size_t)ci * 128 * 4096 + 512 + h * 128, 4096, kbuf, PK, 128, 128);
  tile_to_lds(p.proj + (size_t)ci * 128 * 4096 + 1024 + h * 256, 4096, vbuf, PV, 128, 256);
  __syncthreads();
  const int dir = wid >> 2, d0 = (wid & 3) * 32;
  const float lg = log1pf(-exp2f(-p.l0_decay[dir * 4 + h]));
  u16* o = (u16*)p.part + ((size_t)(ci * 4 + h) * 2 + dir) * 128 * 256;
#pragma unroll 1
  for (int nh = 0; nh < 2; ++nh) {
    f32x4 acc[8][2];
#pragma unroll
    for (int m = 0; m < 8; ++m) { acc[m][0] = (f32x4){0.f, 0.f, 0.f, 0.f}; acc[m][1] = (f32x4){0.f, 0.f, 0.f, 0.f}; }
#pragma unroll 1
    for (int ks = 0; ks < 4; ++ks) {
      bf16x8 kb[2];
      kb[0] = frag_tr(kbuf, PK, ks * 32, d0, fr, fq); kb[1] = frag_tr(kbuf, PK, ks * 32, d0 + 16, fr, fq);
#pragma unroll
      for (int j = 0; j < 8; ++j) {
        const int tok = ks * 32 + fq * 8 + j;
        const float w = __expf((float)(dir == 0 ? 127 - tok : tok) * lg);
        kb[0][j] = (short)f2bf(bf2f((u16)kb[0][j]) * w); kb[1][j] = (short)f2bf(bf2f((u16)kb[1][j]) * w);
      }
#pragma unroll
      for (int m = 0; m < 8; ++m) {
        const bf16x8 va = frag_tr(vbuf, PV, ks * 32, nh * 128 + m * 16, fr, fq);
        acc[m][0] = mfma16(va, kb[0], acc[m][0]); acc[m][1] = mfma16(va, kb[1], acc[m][1]);
      }
    }
#pragma unroll
    for (int n = 0; n < 2; ++n) {
      u16* orow = o + (size_t)(d0 + n * 16 + fr) * 256 + nh * 128 + fq * 4;
#pragma unroll
      for (int m = 0; m < 8; ++m) { u32x2 v; v[0] = pk2(acc[m][n][0], acc[m][n][1]); v[1] = pk2(acc[m][n][2], acc[m][n][3]); *(u32x2*)(orow + m * 16) = v; }
    }
  }
}

__device__ __forceinline__ void gmlp_item(const P& p, int item, LAS u16* lds) {
  const int ci = item >> 2, g = item & 3, tid = threadIdx.x, wid = tid >> 6, lane = tid & 63, fr = lane & 15, fq = lane >> 4;
  LAS u16* zn = lds; LAS u16* wsb = lds + 128 * PK; LAS float* mu = (LAS float*)(lds + 2 * 128 * PK); LAS float* rs = mu + 128;
  __syncthreads();
  {
    u32x4 zv[16];
#pragma unroll
    for (int k = 0; k < 16; ++k) zv[k] = *(const u32x4*)(p.proj + (size_t)(ci * 128 + wid + 8 * k) * 4096 + 3584 + lane * 8);
#pragma unroll
    for (int k = 0; k < 16; ++k) {
      float s = 0.f, s2 = 0.f;
#pragma unroll
      for (int e = 0; e < 4; ++e) { const float a = __uint_as_float(zv[k][e] << 16), b = __uint_as_float(zv[k][e] & 0xffff0000u); s += a + b; s2 += a * a + b * b; }
      s = wave_sum(s); s2 = wave_sum(s2);
      if (lane == 0) { const float m = s * (1.f / 512.f); const float var = fmaxf(s2 * (1.f / 512.f) - m * m, 0.f); mu[wid + 8 * k] = m; rs[wid + 8 * k] = rsqrtf(var + EPS); }
    }
  }
  u32x4 zr[4];
#pragma unroll
  for (int k = 0; k < 4; ++k) { const int i = tid + k * NTHR, q = i >> 4, c = (i & 15) * 8; zr[k] = *(const u32x4*)(p.proj + (size_t)(ci * 128 + q) * 4096 + 3584 + g * 128 + c); }
  {
    const float* W = p.l0_gws + (size_t)g * 128 * 128;
    f32x4 wv[8];
#pragma unroll
    for (int k = 0; k < 8; ++k) { const int i = tid + k * NTHR; wv[k] = *(const f32x4*)(W + (i >> 5) * 128 + (i & 31) * 4); }
#pragma unroll
    for (int k = 0; k < 8; ++k) {
      const int i = tid + k * NTHR, r = i >> 5, c = (i & 31) * 4;
      u32x2 o; o[0] = pk2(wv[k][0], wv[k][1]); o[1] = pk2(wv[k][2], wv[k][3]);
      *(LAS u32x2*)(wsb + r * PK + c) = o;
    }
  }
  __syncthreads();
#pragma unroll
  for (int k = 0; k < 4; ++k) {
    const int i = tid + k * NTHR, q = i >> 4, c = (i & 15) * 8;
    const float m = mu[q], r = rs[q];
    u32x4 o;
#pragma unroll
    for (int e = 0; e < 4; ++e) o[e] = pk2((__uint_as_float(zr[k][e] << 16) - m) * r, (__uint_as_float(zr[k][e] & 0xffff0000u) - m) * r);
    *(LAS u32x4*)(zn + q * PK + c) = o;
  }
  __syncthreads();
  f32x4 acc[8];
#pragma unroll
  for (int m = 0; m < 8; ++m) acc[m] = (f32x4){0.f, 0.f, 0.f, 0.f};
#pragma unroll
  for (int ks = 0; ks < 4; ++ks) {
    const bf16x8 wb = frag_row(wsb, PK, wid * 16, ks * 32, fr, fq);
#pragma unroll
    for (int m = 0; m < 8; ++m) acc[m] = mfma16(frag_tr(zn, PK, ks * 32, m * 16, fr, fq), wb, acc[m]);
  }
  {
    const int pr = wid * 16 + fr, t = ci * 128 + pr;
    const float gb = p.l0_gb[g * 128 + pr];
    const u16* urow = p.proj + (size_t)t * 4096 + 3072 + g * 128 + fq * 4;
    u16* orow = p.cat + (size_t)t * 1536 + 1024 + g * 128 + fq * 4;
#pragma unroll
    for (int m = 0; m < 8; ++m) {
      const u32x2 uv = *(const u32x2*)(urow + m * 16);
      u32x2 v;
      v[0] = pk2((acc[m][0] + gb) * __uint_as_float(uv[0] << 16), (acc[m][1] + gb) * __uint_as_float(uv[0] & 0xffff0000u));
      v[1] = pk2((acc[m][2] + gb) * __uint_as_float(uv[1] << 16), (acc[m][3] + gb) * __uint_as_float(uv[1] & 0xffff0000u));
      *(u32x2*)(orow + m * 16) = v;
    }
  }
}
__device__ __forceinline__ void phase_mix_a(const P& p, LAS u16* lds) {
  for (int it = blockIdx.x; it < 384; it += gridDim.x) { if (it < 192) kv_item(p, it, lds); else gmlp_item(p, it - 192, lds); }
}

__device__ __forceinline__ void build_state(const P& p, LAS u16* bbuf, const float* S0, float w0, int cbase, int h, int dir, int c_lo, int c_hi, int c_ref, float lg128) {
  const int tid = threadIdx.x;
#pragma unroll 1
  for (int half = 0; half < 2; ++half) {
    f32x4 a[8];
    const int base = (tid + half * 4096) * 4;
    if (S0) {
#pragma unroll
      for (int k = 0; k < 8; ++k) a[k] = *(const f32x4*)(S0 + base + k * 2048);
#pragma unroll
      for (int k = 0; k < 8; ++k) a[k] = a[k] * w0;
    } else {
#pragma unroll
      for (int k = 0; k < 8; ++k) a[k] = (f32x4){0.f, 0.f, 0.f, 0.f};
    }
#pragma unroll 1
    for (int cc = c_lo; cc < c_hi; ++cc) {
      const int e = dir == 0 ? (c_ref - 1 - cc) : (cc - c_ref - 1);
      const float w = __expf(lg128 * (float)e);
      const float* src = p.part + ((size_t)((cbase + cc) * 4 + h) * 2 + dir) * 128 * 256 + base;
      f32x4 t[8];
#pragma unroll
      for (int k = 0; k < 8; ++k) t[k] = *(const f32x4*)(src + k * 2048);
#pragma unroll
      for (int k = 0; k < 8; ++k) a[k] = a[k] + t[k] * w;
    }
#pragma unroll
    for (int k = 0; k < 8; ++k) {
      const int i = tid + half * 4096 + k * 512, r = i >> 6, c = (i & 63) * 4;
      u32x2 o; o[0] = pk2(a[k][0], a[k][1]); o[1] = pk2(a[k][2], a[k][3]);
      *(LAS u32x2*)(bbuf + r * PV + c) = o;
    }
  }
}
__device__ __forceinline__ void scan_item(const P& p, int item, unsigned* scnt) {
  const int combo = item >> 2, q = item & 3, dir = combo & 1, h = (combo >> 1) & 3, sb = combo >> 3, tid = threadIdx.x;
  const float g = __expf(128.f * log1pf(-exp2f(-p.l0_decay[dir * 4 + h])));
  const float* S0 = p.state + ((size_t)(sb * 2 + dir) * 4 + h) * 128 * 256 + q * 32 * 256;
  const u16* KV = (const u16*)p.part + ((size_t)((32 + sb * 8) * 4 + h) * 2 + dir) * 128 * 256 + q * 32 * 256;
  const __amdgpu_buffer_rsrc_t rs = mk_rsrc(p.stimg, 2u * 4u * 2u * 8u * 128u * 256u * 2u);
  const unsigned obase = (unsigned)((((size_t)combo * 8) * 128 * 256 + q * 32 * 256) * 2);
  float s[2][8]; u32x4 kv[7][2];
#pragma unroll
  for (int k = 0; k < 2; ++k) {
    const f32x4 a = __builtin_nontemporal_load((const f32x4*)(S0 + (tid + 512 * k) * 8)), b2 = __builtin_nontemporal_load((const f32x4*)(S0 + (tid + 512 * k) * 8 + 4));
    s[k][0] = a[0]; s[k][1] = a[1]; s[k][2] = a[2]; s[k][3] = a[3]; s[k][4] = b2[0]; s[k][5] = b2[1]; s[k][6] = b2[2]; s[k][7] = b2[3];
  }
#pragma unroll
  for (int c = 0; c < 7; ++c)
#pragma unroll
    for (int k = 0; k < 2; ++k) kv[c][k] = *(const u32x4*)(KV + (size_t)(c + dir) * (4 * 2 * 128 * 256) + (tid + 512 * k) * 8);
#pragma unroll
  for (int st = 0; st < 8; ++st) {
    const int c = dir == 0 ? st : 7 - st;
#pragma unroll
    for (int k = 0; k < 2; ++k) {
      if (st > 0) {
        const u32x4 t = kv[dir == 0 ? st - 1 : 7 - st][k];
#pragma unroll
        for (int e = 0; e < 4; ++e) { s[k][2 * e] = s[k][2 * e] * g + __uint_as_float(t[e] << 16); s[k][2 * e + 1] = s[k][2 * e + 1] * g + __uint_as_float(t[e] & 0xffff0000u); }
      }
      u32x4 v; v[0] = pk2(s[k][0], s[k][1]); v[1] = pk2(s[k][2], s[k][3]); v[2] = pk2(s[k][4], s[k][5]); v[3] = pk2(s[k][6], s[k][7]);
      __builtin_amdgcn_raw_buffer_store_b128(v, rs, obase + (unsigned)(((size_t)c * 128 * 256 + (tid + 512 * k) * 8) * 2), 0, 16);
    }
  }
  asm volatile("s_waitcnt vmcnt(0)" ::: "memory");
  __syncthreads();
  if (tid == 0) xb_add(&scnt[combo * 16], 1u);
}
__device__ __forceinline__ void ret_item(const P& p, int item, LAS u16* lds, unsigned* scnt, unsigned* rcnt) {
  const int ci = item >> 2, h = item & 3, tid = threadIdx.x, wid = tid >> 6, lane = tid & 63, fr = lane & 15, fq = lane >> 4;
  int sb, lc, n;
  if (ci < 32) { sb = -1; lc = ci & 1; n = 2; } else { sb = (ci - 32) >> 3; lc = (ci - 32) & 7; n = 8; }
  const int cbase = ci - lc;
  const float lgf = log1pf(-exp2f(-p.l0_decay[h])), lgb = log1pf(-exp2f(-p.l0_decay[4 + h]));
  LAS u16* kbuf = lds; LAS u16* bbuf = lds + 128 * PK; LAS float* red = (LAS float*)(lds + 128 * PK + 128 * PV);
  const bool hasF = (sb >= 0) || lc > 0, hasB = (sb >= 0) || lc < n - 1;
  const u16* qg = p.proj + (size_t)ci * 128 * 4096 + h * 128;
  __syncthreads();
  tile_to_lds(p.proj + (size_t)ci * 128 * 4096 + 512 + h * 128, 4096, kbuf, PK, 128, 128);
  __syncthreads();
  {
    f32x4 s[8];
#pragma unroll
    for (int nn = 0; nn < 8; ++nn) s[nn] = (f32x4){0.f, 0.f, 0.f, 0.f};
    bf16x8 qa[4];
#pragma unroll
    for (int ks = 0; ks < 4; ++ks) qa[ks] = *(const bf16x8*)(qg + (size_t)(wid * 16 + fr) * 4096 + ks * 32 + fq * 8);
#pragma unroll
    for (int ks = 0; ks < 4; ++ks) {
#pragma unroll
      for (int nn = 0; nn < 8; ++nn) s[nn] = mfma16(qa[ks], frag_row(kbuf, PK, nn * 16, ks * 32, fr, fq), s[nn]);
    }
    __syncthreads();
    int bd = wid * 16 + fq * 4 - fr;
    asm volatile("" : "+v"(bd));
    LAS u16* prow = kbuf + (wid * 16 + fq * 4) * PK + fr;
#pragma unroll
    for (int nn = 0; nn < 8; ++nn)
#pragma unroll
      for (int j = 0; j < 4; ++j) {
        const int d = bd + j - 16 * nn;
        const float w = d > 0 ? __expf((float)d * lgf) : (d < 0 ? __expf((float)(-d) * lgb) : 2.f);
        prow[j * PK + nn * 16] = f2bf(s[nn][j] * w);
      }
  }
  const int m0 = (wid & 3) * 32, n0 = (wid >> 2) * 128;
  f32x4 acc[2][8];
#pragma unroll
  for (int m = 0; m < 2; ++m)
#pragma unroll
    for (int nn = 0; nn < 8; ++nn) acc[m][nn] = (f32x4){0.f, 0.f, 0.f, 0.f};
  const u16* qrow = qg + (size_t)(m0 + fr) * 4096 + fq * 8;
  if (sb >= 0) {
    if (tid == 0) {
      XB_WAIT(xb_ld(&scnt[((sb * 4 + h) * 2 + 0) * 16]) < 4u || xb_ld(&scnt[((sb * 4 + h) * 2 + 1) * 16]) < 4u, p.bar);
      __builtin_amdgcn_fence(__ATOMIC_ACQUIRE, "agent");
      asm volatile("s_waitcnt vmcnt(0)" ::: "memory");
    }
    __syncthreads();
    tile_to_lds(p.stimg + ((size_t)((sb * 4 + h) * 2 + 0) * 8 + lc) * 128 * 256, 256, bbuf, PV, 128, 256);
    __syncthreads();
  } else if (hasF) {
    tile_to_lds((const u16*)p.part + ((size_t)((cbase + 0) * 4 + h) * 2 + 0) * 128 * 256, 256, bbuf, PV, 128, 256);
    __syncthreads();
  }
  if (hasF) {
    {
      bf16x8 q0[4], q1[4];
#pragma unroll
      for (int ks = 0; ks < 4; ++ks) { q0[ks] = *(const bf16x8*)(qrow + ks * 32); q1[ks] = *(const bf16x8*)(qrow + 16 * 4096 + ks * 32); }
#pragma unroll 1
      for (int ks = 0; ks < 4; ++ks) {
        const bf16x8 a0 = ks == 0 ? q0[0] : (ks == 1 ? q0[1] : (ks == 2 ? q0[2] : q0[3])), a1 = ks == 0 ? q1[0] : (ks == 1 ? q1[1] : (ks == 2 ? q1[2] : q1[3]));
#pragma unroll
        for (int nn = 0; nn < 8; ++nn) {
          const bf16x8 b = frag_tr(bbuf, PV, ks * 32, n0 + nn * 16, fr, fq);
          acc[0][nn] = mfma16(a0, b, acc[0][nn]); acc[1][nn] = mfma16(a1, b, acc[1][nn]);
        }
      }
    }
#pragma unroll
    for (int m = 0; m < 2; ++m)
#pragma unroll
      for (int j = 0; j < 4; ++j) {
        const int il = m0 + m * 16 + fq * 4 + j;
        const float sc = hasB ? __expf((float)(il + 1) * lgf - (float)(128 - il) * lgb) : __expf((float)(il + 1) * lgf);
#pragma unroll
        for (int nn = 0; nn < 8; ++nn) acc[m][nn][j] *= sc;
      }
  }
  if (hasB) {
    __syncthreads();
    if (sb >= 0) tile_to_lds(p.stimg + ((size_t)((sb * 4 + h) * 2 + 1) * 8 + lc) * 128 * 256, 256, bbuf, PV, 128, 256);
    else tile_to_lds((const u16*)p.part + ((size_t)((cbase + 1) * 4 + h) * 2 + 1) * 128 * 256, 256, bbuf, PV, 128, 256);
    __syncthreads();
    {
      bf16x8 q0[4], q1[4];
#pragma unroll
      for (int ks = 0; ks < 4; ++ks) { q0[ks] = *(const bf16x8*)(qrow + ks * 32); q1[ks] = *(const bf16x8*)(qrow + 16 * 4096 + ks * 32); }
#pragma unroll 1
      for (int ks = 0; ks < 4; ++ks) {
        const bf16x8 a0 = ks == 0 ? q0[0] : (ks == 1 ? q0[1] : (ks == 2 ? q0[2] : q0[3])), a1 = ks == 0 ? q1[0] : (ks == 1 ? q1[1] : (ks == 2 ? q1[2] : q1[3]));
#pragma unroll
        for (int nn = 0; nn < 8; ++nn) {
          const bf16x8 b = frag_tr(bbuf, PV, ks * 32, n0 + nn * 16, fr, fq);
          acc[0][nn] = mfma16(a0, b, acc[0][nn]); acc[1][nn] = mfma16(a1, b, acc[1][nn]);
        }
      }
    }
#pragma unroll
    for (int m = 0; m < 2; ++m)
#pragma unroll
      for (int j = 0; j < 4; ++j) {
        const int il = m0 + m * 16 + fq * 4 + j;
        const float sc = __expf((float)(128 - il) * lgb);
#pragma unroll
        for (int nn = 0; nn < 8; ++nn) acc[m][nn][j] *= sc;
      }
  }
  __syncthreads();
  tile_to_lds(p.proj + (size_t)ci * 128 * 4096 + 1024 + h * 256, 4096, bbuf, PV, 128, 256);
  __syncthreads();
#pragma unroll 1
  for (int ks = 0; ks < 4; ++ks) {
    const bf16x8 a0 = frag_row(kbuf, PK, m0, ks * 32, fr, fq), a1 = frag_row(kbuf, PK, m0 + 16, ks * 32, fr, fq);
#pragma unroll
    for (int nn = 0; nn < 8; ++nn) {
      const bf16x8 b = frag_tr(bbuf, PV, ks * 32, n0 + nn * 16, fr, fq);
      acc[0][nn] = mfma16(a0, b, acc[0][nn]); acc[1][nn] = mfma16(a1, b, acc[1][nn]);
    }
  }
#pragma unroll
  for (int m = 0; m < 2; ++m)
#pragma unroll
    for (int j = 0; j < 4; ++j) {
      float s = 0.f;
#pragma unroll
      for (int nn = 0; nn < 8; ++nn) s += acc[m][nn][j] * acc[m][nn][j];
      s += __shfl_xor(s, 1); s += __shfl_xor(s, 2); s += __shfl_xor(s, 4); s += __shfl_xor(s, 8);
      if (fr == 0) red[(wid >> 2) * 128 + m0 + m * 16 + fq * 4 + j] = s;
    }
  __syncthreads();
#pragma unroll
  for (int m = 0; m < 2; ++m)
#pragma unroll
    for (int j = 0; j < 4; ++j) {
      const int il = m0 + m * 16 + fq * 4 + j;
      const float r = rsqrtf((red[il] + red[128 + il]) * (1.f / 256.f) + EPS);
      LAS u16* orow = bbuf + il * PV + n0 + fr;
#pragma unroll
      for (int nn = 0; nn < 8; ++nn) orow[nn * 16] = f2bf(acc[m][nn][j] * r);
    }
  __syncthreads();
  {
    const u16* gbase = p.proj + (size_t)ci * 128 * 4096 + 2048 + h * 256;
    u16* obase = p.cat + (size_t)ci * 128 * 1536 + h * 256;
    u32x4 gv[8];
#pragma unroll
    for (int k = 0; k < 8; ++k) { const int i = tid + k * NTHR, r = i >> 5, c = (i & 31) * 8; gv[k] = *(const u32x4*)(gbase + (size_t)r * 4096 + c); }
#pragma unroll
    for (int k = 0; k < 8; ++k) {
      const int i = tid + k * NTHR, r = i >> 5, c = (i & 31) * 8;
      const u32x4 ov = *(const LAS u32x4*)(bbuf + r * PV + c);
      u32x4 o;
#pragma unroll
      for (int e = 0; e < 4; ++e) o[e] = pk2(__uint_as_float(ov[e] << 16) * __uint_as_float(gv[k][e] << 16), __uint_as_float(ov[e] & 0xffff0000u) * __uint_as_float(gv[k][e] & 0xffff0000u));
      __builtin_amdgcn_raw_buffer_store_b128(o, mk_rsrc(p.cat, (unsigned)NT * 1536u * 2u), (unsigned)((((size_t)ci * 128 + r) * 1536 + h * 256 + c) * 2), 0, 16);
    }
  }
  asm volatile("s_waitcnt vmcnt(0)" ::: "memory");
  __syncthreads();
  if (tid == 0) xb_add(&rcnt[(ci >> 1) * 16], 1u);
}
__device__ __forceinline__ void state_item(const P& p, int item) {
  const int b = item >> 3, h = (item >> 1) & 3, dir = item & 1;
  const float w = __expf(128.f * log1pf(-exp2f(-p.l0_decay[dir * 4 + h])));
  const int c_old = dir == 0 ? 2 * b : 2 * b + 1, c_new = dir == 0 ? 2 * b + 1 : 2 * b;
  const u16* A = (const u16*)p.part + ((size_t)(c_old * 4 + h) * 2 + dir) * 128 * 256;
  const u16* B = (const u16*)p.part + ((size_t)(c_new * 4 + h) * 2 + dir) * 128 * 256;
  float* o = p.out + (size_t)NT * DM + ((size_t)(b * 2 + dir) * 4 + h) * 128 * 256;
  u32x4 av[8], bv[8];
#pragma unroll
  for (int k = 0; k < 8; ++k) { const int i = threadIdx.x + k * NTHR; av[k] = *(const u32x4*)(A + i * 8); bv[k] = *(const u32x4*)(B + i * 8); }
#pragma unroll
  for (int k = 0; k < 8; ++k) {
    const int i = threadIdx.x + k * NTHR;
    f32x4 o0, o1;
    o0[0] = __uint_as_float(av[k][0] << 16) * w + __uint_as_float(bv[k][0] << 16); o0[1] = __uint_as_float(av[k][0] & 0xffff0000u) * w + __uint_as_float(bv[k][0] & 0xffff0000u);
    o0[2] = __uint_as_float(av[k][1] << 16) * w + __uint_as_float(bv[k][1] << 16); o0[3] = __uint_as_float(av[k][1] & 0xffff0000u) * w + __uint_as_float(bv[k][1] & 0xffff0000u);
    o1[0] = __uint_as_float(av[k][2] << 16) * w + __uint_as_float(bv[k][2] << 16); o1[1] = __uint_as_float(av[k][2] & 0xffff0000u) * w + __uint_as_float(bv[k][2] & 0xffff0000u);
    o1[2] = __uint_as_float(av[k][3] << 16) * w + __uint_as_float(bv[k][3] << 16); o1[3] = __uint_as_float(av[k][3] & 0xffff0000u) * w + __uint_as_float(bv[k][3] & 0xffff0000u);
    __builtin_nontemporal_store(o0, (f32x4*)(o + i * 8)); __builtin_nontemporal_store(o1, (f32x4*)(o + i * 8 + 4));
  }
}
__device__ __forceinline__ void phase_mix_b(const P& p, LAS u16* lds, unsigned* scnt, unsigned* rcnt) {
  const int b = (int)blockIdx.x;
  if (b < 64) ret_item(p, 128 + b, lds, scnt, rcnt);
  else if (b < 192) ret_item(p, b - 64, lds, scnt, rcnt);
  else { scan_item(p, b - 192, scnt); state_item(p, 2 * (b - 192)); state_item(p, 2 * (b - 192) + 1); }
}

__device__ __forceinline__ void phase_conv(const P& p) {
  const u16* __restrict__ pj = p.proj;
  const size_t total = (size_t)NT * 256, stride = (size_t)gridDim.x * NTHR;
  for (size_t i0 = (size_t)blockIdx.x * NTHR + threadIdx.x; i0 < total; i0 += 4 * stride) {
    u32x2 av[4][3], bv[4][3], bgv[4]; bool ok[4][3];
#pragma unroll
    for (int u = 0; u < 4; ++u) {
      const size_t i = i0 + u * stride; const bool live = i < total;
      const int t = live ? (int)(i >> 8) : 0, c4 = (int)(i & 255) * 4;
      const int seg = t < NPROMPT_T ? 256 : 64, pos = t < NPROMPT_T ? (t & 255) : ((t - NPROMPT_T) & 63);
#pragma unroll
      for (int d = 0; d < 3; ++d) {
        const int pp = pos + d - 1; ok[u][d] = live && pp >= 0 && pp < seg;
        const u16* r = pj + (size_t)(ok[u][d] ? t + d - 1 : t) * 3072;
        av[u][d] = *(const u32x2*)(r + 1024 + c4); bv[u][d] = *(const u32x2*)(r + 2048 + c4);
      }
      bgv[u] = *(const u32x2*)(pj + (size_t)t * 3072 + c4);
    }
#pragma unroll
    for (int u = 0; u < 4; ++u) {
      const size_t i = i0 + u * stride; if (i >= total) continue;
      const int t = (int)(i >> 8), c4 = (int)(i & 255) * 4;
      f32x4 xc[3];
#pragma unroll
      for (int d = 0; d < 3; ++d) {
        const u32x2 a = av[u][d], b2 = bv[u][d];
        xc[d][0] = __uint_as_float(a[0] << 16) * __uint_as_float(b2[0] << 16); xc[d][1] = __uint_as_float(a[0] & 0xffff0000u) * __uint_as_float(b2[0] & 0xffff0000u);
        xc[d][2] = __uint_as_float(a[1] << 16) * __uint_as_float(b2[1] << 16); xc[d][3] = __uint_as_float(a[1] & 0xffff0000u) * __uint_as_float(b2[1] & 0xffff0000u);
        if (!ok[u][d]) xc[d] = (f32x4){0.f, 0.f, 0.f, 0.f};
      }
      const f32x4 w0 = *(const f32x4*)(p.l1_conv + c4), w1 = *(const f32x4*)(p.l1_conv + 1024 + c4), w2 = *(const f32x4*)(p.l1_conv + 2048 + c4);
      const f32x4 bg = {__uint_as_float(bgv[u][0] << 16), __uint_as_float(bgv[u][0] & 0xffff0000u), __uint_as_float(bgv[u][1] << 16), __uint_as_float(bgv[u][1] & 0xffff0000u)};
      const f32x4 y = bg * (w0 * xc[0] + w1 * xc[1] + w2 * xc[2]);
      u32x2 o; o[0] = pk2(y[0], y[1]); o[1] = pk2(y[2], y[3]);
      *(u32x2*)(p.cat + (size_t)t * 1024 + c4) = o;
    }
  }
}

#define XB_XCNT(j)  (256  + 64 * (j))
#define XB_XSUB(j)  (1280 + 64 * (j))
#define XB_XGEN(j)  (2304 + 64 * (j))
#define XB_TOP      3328
#define XB_TOPGEN   3392
#define XCD_BAR_WORDS 3456
__device__ __forceinline__ unsigned xb_xcc_id() { return (unsigned)__builtin_amdgcn_s_getreg((3 << 11) | 20) & 0xFu; }
struct XcdBarrier { unsigned* bar; unsigned x; volatile __attribute__((address_space(3))) unsigned* st; };
__device__ __forceinline__ XcdBarrier xcd_barrier_post(unsigned* bar, volatile __attribute__((address_space(3))) unsigned* st) {
  XcdBarrier b; b.bar = bar; b.x = xb_xcc_id(); b.st = st;
  if (threadIdx.x == 0) (void)xb_add(&bar[XB_XCNT(b.x)], 1u);
  return b;
}
__device__ __forceinline__ void xcd_barrier_complete(unsigned* bar, unsigned x, unsigned& nloc, unsigned& nx) {
  const unsigned G = gridDim.x * gridDim.y * gridDim.z;
  unsigned sum, cnt, mine, sp = 0u;
  for (;;) {
    sum = 0u; cnt = 0u; mine = 0u;
#pragma unroll
    for (unsigned j = 0; j < 16; ++j) { const unsigned c = xb_ld(&bar[XB_XCNT(j)]); sum += c; cnt += (c > 0u) ? 1u : 0u; mine = (j == x) ? c : mine; }
    if (sum == G) break;
    __builtin_amdgcn_s_sleep(1);
    if ((++sp & 255u) == 0u) { if (xb_ld(&bar[XB_TMO])) break; if (sp > XB_SPIN_CAP) { atomicAdd(&bar[XB_TMO], 1u); break; } }
  }
  nloc = mine > 0u ? mine : 1u; nx = cnt > 0u ? cnt : 1u;
}
__device__ __forceinline__ void xcd_barrier(const XcdBarrier& b) {
  asm volatile("s_waitcnt vmcnt(0)" ::: "memory");
  __syncthreads();
  if (threadIdx.x == 0) {
    unsigned* bar = b.bar;
    __builtin_amdgcn_s_waitcnt(0);
    unsigned nloc = b.st[0], nx = b.st[1];
    if (nloc == 0u) { xcd_barrier_complete(bar, b.x, nloc, nx); b.st[0] = nloc; b.st[1] = nx; }
    const unsigned old = xb_add(&bar[XB_XSUB(b.x)], 1u);
    const unsigned gen = old / nloc;
    if (old + 1u == (gen + 1u) * nloc) {
      __builtin_amdgcn_fence(__ATOMIC_RELEASE, "agent");
      asm volatile("s_waitcnt vmcnt(0)" ::: "memory");
      const unsigned og = xb_add(&bar[XB_TOP], 1u);
      const unsigned tg = og / nx;
      if (og + 1u == (tg + 1u) * nx) xb_add(&bar[XB_TOPGEN], 1u);
      else XB_SPIN(xb_ld(&bar[XB_TOPGEN]) == tg, bar);
      __builtin_amdgcn_fence(__ATOMIC_ACQUIRE, "agent");
      xb_add(&bar[XB_XGEN(b.x)], 1u);
      asm volatile("s_waitcnt vmcnt(0)" ::: "memory");
    } else {
      XB_SPIN(xb_ld(&bar[XB_XGEN(b.x)]) == gen, bar);
      __builtin_amdgcn_fence(__ATOMIC_ACQUIRE, "agent");
      asm volatile("s_waitcnt vmcnt(0)" ::: "memory");
    }
  }
  __syncthreads();
}

__device__ __forceinline__ void phase_norm_fused(const NormArgs& a, unsigned* cnt, unsigned* bar) {
  pg8::Order S; S.init(NT, 1024, 2, (int)gridDim.x, (int)blockIdx.x);
  pg8::Unit u;
  if (!S.next(0, u)) return;
  asm volatile("s_waitcnt vmcnt(0)" ::: "memory");
  __syncthreads();
  if (threadIdx.x == 0) {
    for (int i = 0; S.next(i, u); ++i) xb_add(&cnt[u.pm * 16], 1u);
  }
  const int wid = threadIdx.x >> 6, lane = threadIdx.x & 63;
  for (int i = 0; S.next(i, u); ++i) {
    if (threadIdx.x == 0) {
      XB_WAIT(xb_ld(&cnt[u.pm * 16]) < 8u, bar);
      __builtin_amdgcn_fence(__ATOMIC_ACQUIRE, "agent");
      asm volatile("s_waitcnt vmcnt(0)" ::: "memory");
    }
    __syncthreads();
    const int r0 = u.pm * 256 + (u.pn * 2 + u.ks) * 32 + wid * 4;
    norm_rows<4, 2>(a, r0, lane);
  }
}

__device__ __forceinline__ void phase_ffn(const P& p, const u16* w1t, const u16* w2t, const NormArgs& na, unsigned* cntA, unsigned* cntB, float* lds, unsigned* hin, unsigned* hout) {
  const int c = (int)blockIdx.x, tid = threadIdx.x, wid = tid >> 6, lane = tid & 63, x = c & 7;
  PG8_LAS unsigned char* l3 = (PG8_LAS unsigned char*)lds;
  __syncthreads();
  {
    pg8::FfnOrder1 S1{c}; pg8::Unit t1;
#pragma unroll 1
    for (int i = 0; S1.next(i, t1); ++i) {
      if (hin) {
        if (tid == 0) { XB_WAIT(xb_ld(&hin[t1.pm * 16]) < 8u, p.bar); __builtin_amdgcn_fence(__ATOMIC_ACQUIRE, "agent"); asm volatile("s_waitcnt vmcnt(0)" ::: "memory"); }
        __syncthreads();
      }
      { pg8::Gemm g{p.hA, w1t, NT, 4096, 1024, 1}; pg8::OneUnit S{t1}; EpiRelu2W e{mk_rsrc(p.proj, (unsigned)NT * 4096u * 2u)}; pg8::gemm_phase(l3, g, S, e); }
      asm volatile("s_waitcnt vmcnt(0)" ::: "memory");
      __syncthreads();
      if (tid == 0) xb_add(&cntA[t1.pm * 16], 1u);
    }
  }
  pg8::Unit u; int ksplit;
  if (c >= 128) { const int oj = (c - 128) >> 3; ksplit = 2; u.ks = x & 1; u.pm = 4 * (x >> 1) + (oj >> 2); u.pn = oj & 3; }
  else { const int o = c >> 3; ksplit = 4; u.ks = x & 3; u.pm = 16 + 4 * (x >> 2) + (o >> 2); u.pn = o & 3; }
  if (tid == 0) {
    XB_WAIT(xb_ld(&cntA[u.pm * 16]) < 16u, p.bar);
    __builtin_amdgcn_fence(__ATOMIC_ACQUIRE, "agent");
    asm volatile("s_waitcnt vmcnt(0)" ::: "memory");
  }
  __syncthreads();
  { pg8::Gemm g{p.proj, w2t, NT, 1024, 4096, ksplit}; pg8::OneUnit S{u}; EpiPartW e{mk_rsrc(p.part, 4u * (unsigned)NT * 1024u * 2u)}; pg8::gemm_phase(l3, g, S, e); }
  asm volatile("s_waitcnt vmcnt(0)" ::: "memory");
  __syncthreads();
  if (tid == 0) {
    xb_add(&cntB[u.pm * 16], 1u);
    XB_WAIT(xb_ld(&cntB[u.pm * 16]) < (unsigned)(4 * ksplit), p.bar);
    __builtin_amdgcn_fence(__ATOMIC_ACQUIRE, "agent");
    asm volatile("s_waitcnt vmcnt(0)" ::: "memory");
  }
  __syncthreads();
  if (ksplit == 2) norm_rows<4, 2>(na, u.pm * 256 + (u.pn * 2 + u.ks) * 32 + wid * 4, lane);
  else norm_rows<2, 4>(na, u.pm * 256 + (u.pn * 4 + u.ks) * 16 + wid * 2, lane);
  if (hout) {
    asm volatile("s_waitcnt vmcnt(0)" ::: "memory");
    __syncthreads();
    if (tid == 0) xb_add(&hout[u.pm * 16], 1u);
  }
}

__device__ __forceinline__ void conv_rect(const P& p, int row0, int ch0) {
  const u16* __restrict__ pj = p.proj2;
  const __amdgpu_buffer_rsrc_t rs = mk_rsrc(p.cat, (unsigned)NT * 1024u * 2u);
#pragma unroll 1
  for (int b0 = 0; b0 < 16; b0 += 4) {
    u32x2 xv[4][3], bgv[4]; bool ok[4][3];
#pragma unroll
    for (int u = 0; u < 4; ++u) {
      const int i = threadIdx.x + (b0 + u) * NTHR;
      const int t = row0 + (i >> 7), c4 = ch0 + (i & 127) * 4;
      const int seg = t < NPROMPT_T ? 256 : 64, pos = t < NPROMPT_T ? (t & 255) : ((t - NPROMPT_T) & 63);
#pragma unroll
      for (int d = 0; d < 3; ++d) {
        const int pp = pos + d - 1; ok[u][d] = pp >= 0 && pp < seg;
        xv[u][d] = *(const u32x2*)(pj + (size_t)(ok[u][d] ? t + d - 1 : t) * 2048 + 1024 + c4);
      }
      bgv[u] = *(const u32x2*)(pj + (size_t)t * 2048 + c4);
    }
#pragma unroll
    for (int u = 0; u < 4; ++u) {
      const int i = threadIdx.x + (b0 + u) * NTHR;
      const int t = row0 + (i >> 7), c4 = ch0 + (i & 127) * 4;
      f32x4 xc[3];
#pragma unroll
      for (int d = 0; d < 3; ++d) {
        const u32x2 a = xv[u][d];
        xc[d] = (f32x4){__uint_as_float(a[0] << 16), __uint_as_float(a[0] & 0xffff0000u), __uint_as_float(a[1] << 16), __uint_as_float(a[1] & 0xffff0000u)};
        if (!ok[u][d]) xc[d] = (f32x4){0.f, 0.f, 0.f, 0.f};
      }
      const f32x4 w0 = *(const f32x4*)(p.l1_conv + c4), w1 = *(const f32x4*)(p.l1_conv + 1024 + c4), w2 = *(const f32x4*)(p.l1_conv + 2048 + c4);
      const f32x4 bg = {__uint_as_float(bgv[u][0] << 16), __uint_as_float(bgv[u][0] & 0xffff0000u), __uint_as_float(bgv[u][1] << 16), __uint_as_float(bgv[u][1] & 0xffff0000u)};
      const f32x4 y = bg * (w0 * xc[0] + w1 * xc[1] + w2 * xc[2]);
      const unsigned long long v = (unsigned long long)pk2(y[0], y[1]) | ((unsigned long long)pk2(y[2], y[3]) << 32);
      __hip_atomic_store((unsigned long long*)(p.cat + (size_t)t * 1024 + c4), v, __ATOMIC_RELAXED, __HIP_MEMORY_SCOPE_AGENT);
    }
  }
}

__device__ __forceinline__ void phase_l1(const P& p, const NormArgs& na, unsigned* cntA, unsigned* cntC, unsigned* cntB, float* lds, unsigned* hin, unsigned* hout) {
  const int c = (int)blockIdx.x, tid = threadIdx.x, wid = tid >> 6, lane = tid & 63;
  PG8_LAS unsigned char* l3 = (PG8_LAS unsigned char*)lds;
  __syncthreads();
  {
    pg8::L1InOrder S1{c}; pg8::Unit t1; EpiPlain e{p.proj2};
#pragma unroll 1
    for (int i = 0; S1.next(i, t1); ++i) {
      if (tid == 0) { XB_WAIT(xb_ld(&hin[t1.pm * 16]) < (t1.pm < 16 ? 8u : 16u), p.bar); __builtin_amdgcn_fence(__ATOMIC_ACQUIRE, "agent"); asm volatile("s_waitcnt vmcnt(0)" ::: "memory"); }
      __syncthreads();
      { pg8::Gemm g{p.hA, p.wt1_in, NT, 3072, 1024, 1}; pg8::OneUnit S{t1}; pg8::gemm_phase(l3, g, S, e); }
      asm volatile("s_waitcnt vmcnt(0)" ::: "memory");
      __syncthreads();
      if (tid == 0) xb_add(&cntA[t1.pm * 16], 1u);
    }
  }
  if (c < 40 || c >= 232) return;
  pg8::Unit u;
  { const int j = c - 40; u.pm = j >> 3; u.pn = (j & 7) >> 1; u.ks = j & 1; }
  if (tid == 0) {
    XB_WAIT(xb_ld(&cntA[u.pm * 16]) < 12u, p.bar);
    __builtin_amdgcn_fence(__ATOMIC_ACQUIRE, "agent");
    asm volatile("s_waitcnt vmcnt(0)" ::: "memory");
  }
  __syncthreads();
  conv_rect(p, u.pm * 256 + u.pn * 64, u.ks * 512);
  asm volatile("s_waitcnt vmcnt(0)" ::: "memory");
  __syncthreads();
  if (tid == 0) {
    xb_add(&cntC[(u.pm * 2 + u.ks) * 8], 1u);
    XB_WAIT(xb_ld(&cntC[(u.pm * 2 + u.ks) * 8]) < 4u, p.bar);
    __builtin_amdgcn_fence(__ATOMIC_ACQUIRE, "agent");
    asm volatile("s_waitcnt vmcnt(0)" ::: "memory");
  }
  __syncthreads();
  { pg8::Gemm g{p.cat, p.wt1_out, NT, 1024, 1024, 2}; pg8::OneUnit S{u}; EpiPartW e{mk_rsrc(p.part, 4u * (unsigned)NT * 1024u * 2u)}; pg8::gemm_phase(l3, g, S, e); }
  asm volatile("s_waitcnt vmcnt(0)" ::: "memory");
  __syncthreads();
  if (tid == 0) {
    xb_add(&cntB[u.pm * 16], 1u);
    XB_WAIT(xb_ld(&cntB[u.pm * 16]) < 8u, p.bar);
    __builtin_amdgcn_fence(__ATOMIC_ACQUIRE, "agent");
    asm volatile("s_waitcnt vmcnt(0)" ::: "memory");
  }
  __syncthreads();
  norm_rows<4, 2>(na, u.pm * 256 + (u.pn * 2 + u.ks) * 32 + wid * 4, lane);
  asm volatile("s_waitcnt vmcnt(0)" ::: "memory");
  __syncthreads();
  if (tid == 0) xb_add(&hout[u.pm * 16], 1u);
}

constexpr int NPHASE = 3;
#ifndef REPMASK
#define REPMASK 0
#endif
__global__ void __launch_bounds__(NTHR) mega(P p, int lo, int hi) {
  extern __shared__ __attribute__((aligned(16))) unsigned char smem[];
  float* lds = (float*)smem;
  cg::grid_group grid = cg::this_grid();
  volatile LAS unsigned* xst = (volatile LAS unsigned*)(smem + 131072);
  if (threadIdx.x == 0) { xst[0] = 0u; xst[1] = 0u; }
  __syncthreads();
  const XcdBarrier xb = xcd_barrier_post(p.bar, xst);
  if (hi < 0) grid.sync();
  const float* m0 = p.mod; const float* m1 = p.mod + 3 * 6144;
#define PH(n, ...) if (lo <= (n) && (n) < hi) { if ((n) > lo) xcd_barrier(xb); __VA_ARGS__ if ((REPMASK >> (n)) & 1) { xcd_barrier(xb); __VA_ARGS__ } }
  unsigned* pcnt = p.bar + XCD_BAR_WORDS;
  float* const xs = (float*)((u16*)p.xres + (size_t)NPROMPT_T * DM); float* const pp = p.part;
  PH(0, { phase_prep(p, lds);
          if (threadIdx.x == 0) { XB_WAIT(xb_ld(pcnt + 9 * 384) < 96u, p.bar); __builtin_amdgcn_fence(__ATOMIC_ACQUIRE, "agent"); asm volatile("s_waitcnt vmcnt(0)" ::: "memory"); }
          __syncthreads();
          NormArgs a{p.x_prompt, p.x_sample, nullptr, nullptr, nullptr, nullptr, p.l0_norm1, m0 + 0, m0 + 1024, p.hA, nullptr, 0}; phase_norm(a);
          { asm volatile("s_waitcnt vmcnt(0)" ::: "memory"); __syncthreads();
            if (threadIdx.x == 0 && blockIdx.x < 192) xb_add(pcnt + 14 * 384 + ((int)blockIdx.x >> 3) * 16, 1u); }
          if (threadIdx.x == 0) {
            pg8::Order S; S.init(NT, 4096, 1, (int)gridDim.x, (int)blockIdx.x); pg8::Unit u;
            for (int i = 0; S.next(i, u); ++i) { XB_WAIT(xb_ld(pcnt + 14 * 384 + u.pm * 16) < 8u || xb_ld(pcnt + 15 * 384 + u.pn * 16) < 16u, p.bar); }
            __builtin_amdgcn_fence(__ATOMIC_ACQUIRE, "agent"); asm volatile("s_waitcnt vmcnt(0)" ::: "memory");
          }
          __syncthreads();
          { EpiProj0 e{p.proj}; phase_gemm(p.hA, p.wt0_in, NT, 4096, 1024, 1, e, lds);
          { asm volatile("s_waitcnt vmcnt(0)" ::: "memory"); __syncthreads();
            if (threadIdx.x == 0) { pg8::Order S; S.init(NT, 4096, 1, (int)gridDim.x, (int)blockIdx.x); pg8::Unit u; for (int i = 0; S.next(i, u); ++i) xb_add(pcnt + 11 * 384 + u.pm * 16, 1u); } }
          phase_prep2(p, lds, 0, 128);
          for (int it = blockIdx.x; it < 384; it += gridDim.x) {
            const int item = it < 192 ? it : it - 192;
            if (threadIdx.x == 0) { XB_WAIT(xb_ld(pcnt + 11 * 384 + (item >> 3) * 16) < 16u, p.bar); __builtin_amdgcn_fence(__ATOMIC_ACQUIRE, "agent"); asm volatile("s_waitcnt vmcnt(0)" ::: "memory"); }
            __syncthreads();
            if (it < 192) kv_item(p, item, (LAS u16*)smem); else gmlp_item(p, item, (LAS u16*)smem);
          }
          phase_prep2(p, lds, 2, 128); } })
  PH(1, { phase_mix_b(p, (LAS u16*)smem, pcnt + 6 * 384, pcnt + 10 * 384);
          { pg8::Order S; S.init(NT, 1024, 2, (int)gridDim.x, (int)blockIdx.x); pg8::Unit u;
            if (S.next(0, u)) {
              if (threadIdx.x == 0) { XB_WAIT(xb_ld(pcnt + 10 * 384 + u.pm * 16) < 8u, p.bar); __builtin_amdgcn_fence(__ATOMIC_ACQUIRE, "agent"); asm volatile("s_waitcnt vmcnt(0)" ::: "memory"); }
              __syncthreads();
              pg8::Gemm g{p.cat, p.wt0_out, NT, 1024, 1536, 2}; pg8::OneUnit S1{u}; EpiPartW e{mk_rsrc((u16*)p.part + (size_t)2 * NT * DM, 2u * (unsigned)NT * 1024u * 2u)};
              pg8::gemm_phase((PG8_LAS unsigned char*)lds, g, S1, e);
              __syncthreads();
            } }
          NormArgs a{p.x_prompt, p.x_sample, (float*)((u16*)pp + (size_t)2 * NT * DM), pp, m0 + 2048, p.xres, p.l0_norm2, m0 + 3072, m0 + 4096, p.hA, nullptr, 0}; phase_norm_fused(a, pcnt + 0 * 384, p.bar);
          phase_prep2(p, lds, 1, 192); })
  PH(2, { { NormArgs a{p.xres, xs, pp, pp, m0 + 5120, p.xres, p.l1_norm1, m1 + 0, m1 + 1024, p.hA, nullptr, 1}; phase_ffn(p, p.wt0_f1, p.wt0_f2, a, pcnt + 1 * 384, pcnt + 2 * 384, lds, nullptr, pcnt + 12 * 384); }
          { NormArgs a{p.xres, xs, pp, pp, m1 + 2048, p.xres, p.l1_norm2, m1 + 3072, m1 + 4096, p.hA, nullptr, 1}; phase_l1(p, a, pcnt + 7 * 384, pcnt + 8 * 384, pcnt + 3 * 384, lds, pcnt + 12 * 384, pcnt + 13 * 384); }
          { NormArgs a{p.xres, xs, pp, pp, m1 + 5120, nullptr, p.final_norm, nullptr, nullptr, nullptr, p.out, 1}; phase_ffn(p, p.wt1_f1, p.wt1_f2, a, pcnt + 4 * 384, pcnt + 5 * 384, lds, pcnt + 13 * 384, nullptr); } })
#undef PH
}

constexpr size_t LDS_BYTES = 131072 + 256;
constexpr bool ONE_LAUNCH = true;

extern "C" void kernel_launch(void* const* d_in, const int* in_sizes, int n_in, void* d_out, int out_size, void* d_ws, size_t ws_size, hipStream_t stream) {
  static int grid_blocks = 0;
  if (!grid_blocks) {
    hipFuncSetAttribute((const void*)mega, hipFuncAttributeMaxDynamicSharedMemorySize, (int)LDS_BYTES);
    int dev = 0, cus = 0, per_cu = 0;
    hipGetDevice(&dev);
    hipDeviceGetAttribute(&cus, hipDeviceAttributeMultiprocessorCount, dev);
    hipOccupancyMaxActiveBlocksPerMultiprocessor(&per_cu, mega, NTHR, LDS_BYTES);
    if (per_cu < 1) per_cu = 1;
    if (per_cu > 1) per_cu = 1;
    grid_blocks = 256;
  }
  P p{};
  const float* const* in = (const float* const*)d_in;
  p.x_prompt = in[0]; p.x_sample = in[1]; p.state = in[2]; p.c = in[3]; p.c_ctx = in[4];
  p.l0_norm1 = in[5]; p.l0_w_in = in[6]; p.l0_decay = in[7]; p.l0_gws = in[8]; p.l0_gb = in[9]; p.l0_w_out = in[10]; p.l0_norm2 = in[11];
  p.l0_w_mod = in[12]; p.l0_b_mod = in[13]; p.l0_f1 = in[14]; p.l0_f2 = in[15];
  p.l1_norm1 = in[16]; p.l1_w_in = in[17]; p.l1_conv = in[18]; p.l1_w_out = in[19]; p.l1_norm2 = in[20]; p.l1_w_mod = in[21]; p.l1_b_mod = in[22];
  p.l1_f1 = in[23]; p.l1_f2 = in[24]; p.final_norm = in[25];
  p.out = (float*)d_out;
  unsigned char* w = (unsigned char*)d_ws; size_t off = 0;
  auto take = [&](size_t bytes) { void* r = w + off; off += (bytes + 255) & ~(size_t)255; return r; };
  p.wt0_in = (u16*)take((size_t)4096 * 1024 * 2); p.wt0_out = (u16*)take((size_t)1024 * 1536 * 2);
  p.wt0_f1 = (u16*)take((size_t)4096 * 1024 * 2); p.wt0_f2 = (u16*)take((size_t)4096 * 1024 * 2);
  p.wt1_in = (u16*)take((size_t)3072 * 1024 * 2); p.wt1_out = (u16*)take((size_t)1024 * 1024 * 2);
  p.wt1_f1 = (u16*)take((size_t)4096 * 1024 * 2); p.wt1_f2 = (u16*)take((size_t)4096 * 1024 * 2);
  p.mod = (float*)take((size_t)2 * 3 * 6144 * 4);
  p.hA = (u16*)take((size_t)NT * 1024 * 2);
  p.proj = (u16*)take((size_t)NT * 4096 * 2);
  p.proj2 = (u16*)take((size_t)NT * 2048 * 2);
  p.cat = (u16*)take((size_t)NT * 1536 * 2);
  p.part = (float*)take((size_t)2 * NT * 1024 * 4);
  p.xres = (float*)take((size_t)NT * 1024 * 4);
  p.stimg = (u16*)take((size_t)2 * 4 * 2 * 8 * 128 * 256 * 2);
  p.bar = (unsigned*)take((size_t)(XCD_BAR_WORDS + 16 * 384) * 4);
  hipMemsetAsync(p.bar, 0, (size_t)(XCD_BAR_WORDS + 16 * 384) * 4, stream);
  if (ONE_LAUNCH) {
    int lo = 0, hi = NPHASE; void* args[] = {&p, &lo, &hi};
    hipError_t e = hipLaunchCooperativeKernel((void*)mega, dim3(grid_blocks), dim3(NTHR), args, LDS_BYTES, stream);
    if (e != hipSuccess) fprintf(stderr, "cooperative launch failed: %s (grid %d)\n", hipGetErrorString(e), grid_blocks);
  } else {
    for (int ph = 0; ph < NPHASE; ++ph) hipLaunchKernelGGL(mega, dim3(grid_blocks), dim3(NTHR), LDS_BYTES, stream, p, ph, ph + 1);
  }
}
```

```cpp
#include <hip/hip_runtime.h>
#include <hip/hip_cooperative_groups.h>
#include <cstdio>
namespace cg = cooperative_groups;

typedef unsigned short u16;
typedef float f32x4 __attribute__((ext_vector_type(4)));
typedef unsigned u32x4 __attribute__((ext_vector_type(4)));
typedef unsigned u32x2 __attribute__((ext_vector_type(2)));

constexpr int NT = 6144, DM = 1024, NPROMPT_T = 4096;
constexpr float EPS = 1e-6f;
constexpr int NTHR = 512;

__device__ __forceinline__ float bf2f(u16 b) { return __uint_as_float(((unsigned)b) << 16); }
typedef float f32x2 __attribute__((ext_vector_type(2)));
typedef __bf16 hbf16x2 __attribute__((ext_vector_type(2)));
__device__ __forceinline__ unsigned pk2(float a, float b) { const f32x2 v = {a, b}; const hbf16x2 r = __builtin_convertvector(v, hbf16x2); return __builtin_bit_cast(unsigned, r); }
__device__ __forceinline__ u16 f2bf(float f) { return (u16)(pk2(f, 0.f) & 0xffffu); }
__device__ __forceinline__ float silu_f(float x) { return x * __builtin_amdgcn_rcpf(1.f + __expf(-x)); }
__device__ __forceinline__ float gelu_f(float x) { const float u = -1.5957691216057308f * (x + 0.044715f * x * x * x); return x * __builtin_amdgcn_rcpf(1.f + __expf(u)); }
__device__ __forceinline__ int cond_of(int t) { return t < NPROMPT_T ? 0 : 1 + ((t - NPROMPT_T) >> 10); }
__device__ __forceinline__ float wave_sum(float v) {
#pragma unroll
  for (int o = 32; o > 0; o >>= 1) v += __shfl_xor(v, o);
  return v;
}

struct P {
  const float *x_prompt, *x_sample, *state, *c, *c_ctx;
  const float *l0_norm1, *l0_w_in, *l0_decay, *l0_gws, *l0_gb, *l0_w_out, *l0_norm2, *l0_w_mod, *l0_b_mod, *l0_f1, *l0_f2;
  const float *l1_norm1, *l1_w_in, *l1_conv, *l1_w_out, *l1_norm2, *l1_w_mod, *l1_b_mod, *l1_f1, *l1_f2, *final_norm;
  float* out;
  u16 *wt0_in, *wt0_out, *wt0_f1, *wt0_f2, *wt1_in, *wt1_out, *wt1_f1, *wt1_f2;
  float* mod;
  u16* hA;
  u16* proj;
  u16* proj2;
  u16* cat;
  float* part;
  float* xres;
  u16* stimg;
  unsigned* bar;
};

__device__ __forceinline__ unsigned xb_ld(unsigned* p)              { return __hip_atomic_load(p, __ATOMIC_RELAXED, __HIP_MEMORY_SCOPE_AGENT); }
__device__ __forceinline__ unsigned xb_add(unsigned* p, unsigned v) { return __hip_atomic_fetch_add(p, v, __ATOMIC_RELAXED, __HIP_MEMORY_SCOPE_AGENT); }
#define XB_TMO      128
#define XB_SPIN_CAP (1u << 18)
#define XB_SPIN(cond, bar) do { unsigned _sp = 0; while (cond) { __builtin_amdgcn_s_sleep(1); \
    if ((++_sp & 255u) == 0u) { if (xb_ld(&(bar)[XB_TMO])) break; if (_sp > XB_SPIN_CAP) { atomicAdd(&(bar)[XB_TMO], 1u); break; } } } } while (0)
#define XB_WAIT(cond, bar) do { unsigned _sp = 0; while (cond) { __builtin_amdgcn_s_sleep(16); \
    if ((++_sp & 63u) == 0u) { if (xb_ld(&(bar)[XB_TMO])) break; if (_sp > (1u << 16)) { atomicAdd(&(bar)[XB_TMO], 1u); break; } } } } while (0)

__device__ __forceinline__ __amdgpu_buffer_rsrc_t mk_rsrc(void* p, unsigned bytes) { return __builtin_amdgcn_make_buffer_rsrc(p, 0, (int)bytes, 0x00020000); }

__device__ __forceinline__ int l1_perm(int n) { if (n < 1024) return n; const int hv = n >= 2048, ch = n - (hv ? 2048 : 1024); return 1024 + (ch >> 7) * 256 + hv * 128 + (ch & 127); }
__device__ __forceinline__ void transpose_tile(const float* __restrict__ W, int K, int N, u16* __restrict__ Wt, int tile, float* lds, int perm = 0, unsigned* pub = nullptr) {
  const int tn = N / 256; const int k0 = (tile / tn) * 64, n0 = (tile % tn) * 256;
  const int tid = threadIdx.x;
  float (*T)[257] = (float (*)[257])lds;
  __syncthreads();
  {
    const int r = tid >> 6, c4 = (tid & 63) * 4;
    f32x4 v[8];
#pragma unroll
    for (int i = 0; i < 8; ++i) v[i] = __builtin_nontemporal_load((const f32x4*)(W + (size_t)(k0 + r + 8 * i) * N + n0 + c4));
#pragma unroll
    for (int i = 0; i < 8; ++i) { T[r + 8 * i][c4 + 0] = v[i][0]; T[r + 8 * i][c4 + 1] = v[i][1]; T[r + 8 * i][c4 + 2] = v[i][2]; T[r + 8 * i][c4 + 3] = v[i][3]; }
  }
  __syncthreads();
  {
    const int kk = (tid & 7) * 8;
#pragma unroll
    for (int ps = 0; ps < 4; ++ps) {
      const int nn = (tid >> 3) + 64 * ps;
      u32x4 o;
      o[0] = pk2(T[kk + 0][nn], T[kk + 1][nn]); o[1] = pk2(T[kk + 2][nn], T[kk + 3][nn]);
      o[2] = pk2(T[kk + 4][nn], T[kk + 5][nn]); o[3] = pk2(T[kk + 6][nn], T[kk + 7][nn]);
      if (pub) __builtin_amdgcn_raw_buffer_store_b128(o, mk_rsrc(Wt, (unsigned)((size_t)K * N * 2)), (unsigned)(((size_t)(n0 + nn) * K + k0 + kk) * 2), 0, 16);
      else __builtin_nontemporal_store(o, (u32x4*)(Wt + (size_t)(perm ? l1_perm(n0 + nn) : n0 + nn) * K + k0 + kk));
    }
  }
  if (pub) {
    asm volatile("s_waitcnt vmcnt(0)" ::: "memory");
    __syncthreads();
    if (threadIdx.x == 0) xb_add(&pub[(n0 >> 8) * 16], 1u);
  }
}

__device__ __forceinline__ void adaln_item(const P& p, int item, float* lds) {
  const int l = item / 96, n0 = (item % 96) * 64;
  const float* W = l ? p.l1_w_mod : p.l0_w_mod; const float* B = l ? p.l1_b_mod : p.l0_b_mod;
  const int tid = threadIdx.x;
  float* sc = lds;
  float* red = lds + 3072;
  __syncthreads();
  for (int i = tid; i < 3072; i += NTHR) {
    const int c = i >> 10, k = i & 1023;
    const float v = c == 0 ? p.c_ctx[k] : p.c[(c - 1) * 1024 + k];
    sc[i] = silu_f(v);
  }
  __syncthreads();
  const int cg4 = tid & 15, rg = tid >> 4;
  float acc[3][4] = {};
#pragma unroll 8
  for (int it = 0; it < 32; ++it) {
    const int k = it * 32 + rg;
    const f32x4 w = __builtin_nontemporal_load((const f32x4*)(W + (size_t)k * 6144 + n0 + cg4 * 4));
#pragma unroll
    for (int c = 0; c < 3; ++c) { const float s = sc[c * 1024 + k];
#pragma unroll
      for (int e = 0; e < 4; ++e) acc[c][e] += s * w[e]; }
  }
#pragma unroll
  for (int c = 0; c < 3; ++c)
#pragma unroll
    for (int e = 0; e < 4; ++e) red[(rg * 3 + c) * 64 + cg4 * 4 + e] = acc[c][e];
  __syncthreads();
  if (tid < 192) {
    const int c = tid >> 6, n = tid & 63; float s = B[n0 + n];
    for (int r = 0; r < 32; ++r) s += red[(r * 3 + c) * 64 + n];
    __hip_atomic_store(&p.mod[(size_t)(l * 3 + c) * 6144 + n0 + n], s, __ATOMIC_RELAXED, __HIP_MEMORY_SCOPE_AGENT);
  }
  if (l == 0) {
    asm volatile("s_waitcnt vmcnt(0)" ::: "memory");
    __syncthreads();
    if (tid == 0) xb_add(p.bar + 3456 + 9 * 384, 1u);
  }
}

__device__ __forceinline__ void phase_prep(const P& p, float* lds) {
  for (int it = blockIdx.x; it < 96 + 256; it += gridDim.x) {
    if (it < 96) adaln_item(p, it, lds); else transpose_tile(p.l0_w_in, 1024, 4096, p.wt0_in, it - 96, lds, 0, p.bar + 3456 + 15 * 384);
  }
}
__device__ __forceinline__ void phase_prep2(const P& p, float* lds, int group, int first_want) {
  const int first = (int)gridDim.x >= 256 ? first_want : 0, nblk = (int)gridDim.x - first;
  if ((int)blockIdx.x < first) return;
  const int total = group == 0 ? 96 + 96 + 256 + 256 : (group == 1 ? 192 + 64 + 256 : 256);
  for (int it = (int)blockIdx.x - first; it < total; it += nblk) {
    int i = it;
    if (group == 0) {
      if (i < 96) { adaln_item(p, 96 + i, lds); continue; } i -= 96;
      if (i < 96) { transpose_tile(p.l0_w_out, 1536, 1024, p.wt0_out, i, lds); continue; } i -= 96;
      if (i < 256) { transpose_tile(p.l0_f1, 1024, 4096, p.wt0_f1, i, lds); continue; } i -= 256;
      transpose_tile(p.l0_f2, 4096, 1024, p.wt0_f2, i, lds);
    } else if (group == 1) {
      if (i < 192) { transpose_tile(p.l1_w_in, 1024, 3072, p.wt1_in, i, lds, 1); continue; } i -= 192;
      if (i < 64) { transpose_tile(p.l1_w_out, 1024, 1024, p.wt1_out, i, lds); continue; } i -= 64;
      transpose_tile(p.l1_f2, 4096, 1024, p.wt1_f2, i, lds);
    } else {
      transpose_tile(p.l1_f1, 1024, 4096, p.wt1_f1, i, lds);
    }
  }
}

struct NormArgs {
  const float* xin0; const float* xin1;
  const float* p0; const float* p1; const float* gate;
  float* xout; const float* nw; const float* sh; const float* sc;
  u16* hout; float* fout;
  int xin_bf;
};
template <int R, int NP>
__device__ __forceinline__ void norm_rows(const NormArgs& a, int t0, int lane) {
  const int c = cond_of(t0);
  f32x4 x[R][4];
#pragma unroll
  for (int r = 0; r < R; ++r) {
    const int t = t0 + r;
    if (a.xin_bf) {
      const u16* xr = t < NPROMPT_T ? (const u16*)a.xin0 + (size_t)t * DM : (const u16*)a.xin1 + (size_t)(t - NPROMPT_T) * DM;
#pragma unroll
      for (int i = 0; i < 4; ++i) { const u32x2 v = *(const u32x2*)(xr + lane * 4 + 256 * i);
        x[r][i] = (f32x4){__uint_as_float(v[0] << 16), __uint_as_float(v[0] & 0xffff0000u), __uint_as_float(v[1] << 16), __uint_as_float(v[1] & 0xffff0000u)}; }
    } else {
      const float* xr = t < NPROMPT_T ? a.xin0 + (size_t)t * DM : a.xin1 + (size_t)(t - NPROMPT_T) * DM;
#pragma unroll
      for (int i = 0; i < 4; ++i) x[r][i] = __builtin_nontemporal_load((const f32x4*)(xr + lane * 4 + 256 * i));
    }
  }
  if (a.p0) {
    u32x2 q[R][NP][4];
#pragma unroll
    for (int r = 0; r < R; ++r)
#pragma unroll
      for (int k = 0; k < NP; ++k)
#pragma unroll
        for (int i = 0; i < 4; ++i) q[r][k][i] = *(const u32x2*)((const u16*)a.p0 + ((size_t)k * NT + t0 + r) * DM + lane * 4 + 256 * i);
#pragma unroll
    for (int i = 0; i < 4; ++i) {
      const f32x4 g = *(const f32x4*)(a.gate + (size_t)c * 6144 + lane * 4 + 256 * i);
#pragma unroll
      for (int r = 0; r < R; ++r) {
        f32x4 ps = {0.f, 0.f, 0.f, 0.f};
#pragma unroll
        for (int k = 0; k < NP; ++k) {
          ps[0] += __uint_as_float(q[r][k][i][0] << 16); ps[1] += __uint_as_float(q[r][k][i][0] & 0xffff0000u);
          ps[2] += __uint_as_float(q[r][k][i][1] << 16); ps[3] += __uint_as_float(q[r][k][i][1] & 0xffff0000u);
        }
        x[r][i] = x[r][i] + g * ps;
      }
    }
  }
  float rs[R];
#pragma unroll
  for (int r = 0; r < R; ++r) {
    float ss = 0.f;
#pragma unroll
    for (int i = 0; i < 4; ++i) {
      if (a.xout) { const unsigned long long o = (unsigned long long)pk2(x[r][i][0], x[r][i][1]) | ((unsigned long long)pk2(x[r][i][2], x[r][i][3]) << 32);
        __hip_atomic_store((unsigned long long*)((u16*)a.xout + (size_t)(t0 + r) * DM + lane * 4 + 256 * i), o, __ATOMIC_RELAXED, __HIP_MEMORY_SCOPE_AGENT); }
      ss += x[r][i][0] * x[r][i][0] + x[r][i][1] * x[r][i][1] + x[r][i][2] * x[r][i][2] + x[r][i][3] * x[r][i][3];
    }
    ss = wave_sum(ss);
    rs[r] = rsqrtf(ss * (1.f / 1024.f) + EPS);
  }
#pragma unroll
  for (int i = 0; i < 4; ++i) {
    const int col = lane * 4 + 256 * i;
    const f32x4 w = *(const f32x4*)(a.nw + col);
    f32x4 sh = {0.f, 0.f, 0.f, 0.f}, sc = {0.f, 0.f, 0.f, 0.f};
    if (a.hout) { sh = *(const f32x4*)(a.sh + (size_t)c * 6144 + col); sc = *(const f32x4*)(a.sc + (size_t)c * 6144 + col); }
#pragma unroll
    for (int r = 0; r < R; ++r) {
      f32x4 y = x[r][i] * rs[r] * w;
      if (a.fout) __builtin_nontemporal_store(y, (f32x4*)(a.fout + (size_t)(t0 + r) * DM + col));
      if (a.hout) {
        y = y * (1.f + sc) + sh;
        const unsigned long long o = (unsigned long long)pk2(y[0], y[1]) | ((unsigned long long)pk2(y[2], y[3]) << 32);
        __hip_atomic_store((unsigned long long*)(a.hout + (size_t)(t0 + r) * DM + col), o, __ATOMIC_RELAXED, __HIP_MEMORY_SCOPE_AGENT);
      }
    }
  }
}
template <int R, int NP>
__device__ __forceinline__ void norm_rows_idx(const NormArgs& a, const int (&rows)[R], int lane) {
  f32x4 x[R][4];
#pragma unroll
  for (int r = 0; r < R; ++r) {
    const int t = rows[r];
    if (a.xin_bf) {
      const u16* xr = t < NPROMPT_T ? (const u16*)a.xin0 + (size_t)t * DM : (const u16*)a.xin1 + (size_t)(t - NPROMPT_T) * DM;
#pragma unroll
      for (int i = 0; i < 4; ++i) { const u32x2 v = *(const u32x2*)(xr + lane * 4 + 256 * i);
        x[r][i] = (f32x4){__uint_as_float(v[0] << 16), __uint_as_float(v[0] & 0xffff0000u), __uint_as_float(v[1] << 16), __uint_as_float(v[1] & 0xffff0000u)}; }
    } else {
      const float* xr = t < NPROMPT_T ? a.xin0 + (size_t)t * DM : a.xin1 + (size_t)(t - NPROMPT_T) * DM;
#pragma unroll
      for (int i = 0; i < 4; ++i) x[r][i] = __builtin_nontemporal_load((const f32x4*)(xr + lane * 4 + 256 * i));
    }
  }
  if (a.p0) {
    u32x2 q[R][NP][4];
#pragma unroll
    for (int r = 0; r < R; ++r)
#pragma unroll
      for (int k = 0; k < NP; ++k)
#pragma unroll
        for (int i = 0; i < 4; ++i) q[r][k][i] = *(const u32x2*)((const u16*)a.p0 + ((size_t)k * NT + rows[r]) * DM + lane * 4 + 256 * i);
#pragma unroll
    for (int i = 0; i < 4; ++i) {
#pragma unroll
      for (int r = 0; r < R; ++r) {
        const f32x4 g = *(const f32x4*)(a.gate + (size_t)cond_of(rows[r]) * 6144 + lane * 4 + 256 * i);
        f32x4 ps = {0.f, 0.f, 0.f, 0.f};
#pragma unroll
        for (int k = 0; k < NP; ++k) {
          ps[0] += __uint_as_float(q[r][k][i][0] << 16); ps[1] += __uint_as_float(q[r][k][i][0] & 0xffff0000u);
          ps[2] += __uint_as_float(q[r][k][i][1] << 16); ps[3] += __uint_as_float(q[r][k][i][1] & 0xffff0000u);
        }
        x[r][i] = x[r][i] + g * ps;
      }
    }
  }
  float rs[R];
#pragma unroll
  for (int r = 0; r < R; ++r) {
    float ss = 0.f;
#pragma unroll
    for (int i = 0; i < 4; ++i) {
      if (a.xout) { const unsigned long long o = (unsigned long long)pk2(x[r][i][0], x[r][i][1]) | ((unsigned long long)pk2(x[r][i][2], x[r][i][3]) << 32);
        __hip_atomic_store((unsigned long long*)((u16*)a.xout + (size_t)(rows[r]) * DM + lane * 4 + 256 * i), o, __ATOMIC_RELAXED, __HIP_MEMORY_SCOPE_AGENT); }
      ss += x[r][i][0] * x[r][i][0] + x[r][i][1] * x[r][i][1] + x[r][i][2] * x[r][i][2] + x[r][i][3] * x[r][i][3];
    }
    ss = wave_sum(ss);
    rs[r] = rsqrtf(ss * (1.f / 1024.f) + EPS);
  }
#pragma unroll
  for (int i = 0; i < 4; ++i) {
    const int col = lane * 4 + 256 * i;
    const f32x4 w = *(const f32x4*)(a.nw + col);
#pragma unroll
    for (int r = 0; r < R; ++r) {
      f32x4 sh = {0.f, 0.f, 0.f, 0.f}, sc = {0.f, 0.f, 0.f, 0.f};
      if (a.hout) { const int c = cond_of(rows[r]); sh = *(const f32x4*)(a.sh + (size_t)c * 6144 + col); sc = *(const f32x4*)(a.sc + (size_t)c * 6144 + col); }
      f32x4 y = x[r][i] * rs[r] * w;
      if (a.fout) __builtin_nontemporal_store(y, (f32x4*)(a.fout + (size_t)(rows[r]) * DM + col));
      if (a.hout) {
        y = y * (1.f + sc) + sh;
        const unsigned long long o = (unsigned long long)pk2(y[0], y[1]) | ((unsigned long long)pk2(y[2], y[3]) << 32);
        __hip_atomic_store((unsigned long long*)(a.hout + (size_t)(rows[r]) * DM + col), o, __ATOMIC_RELAXED, __HIP_MEMORY_SCOPE_AGENT);
      }
    }
  }
}
__device__ __forceinline__ void phase_norm(const NormArgs& a) {
  const int wid = threadIdx.x >> 6, lane = threadIdx.x & 63;
  for (int g = blockIdx.x * 8 + wid; g < NT / 4; g += gridDim.x * 8) norm_rows<4, 2>(a, g * 4, lane);
}
struct EpiProj0 {
  static constexpr bool PAIR = false;
  u16* O;
  __device__ __forceinline__ void store8(int row, int col, f32x4 v0, f32x4 v1, int) const {
    if (col >= 3072) {
#pragma unroll
      for (int e = 0; e < 4; ++e) { v0[e] = gelu_f(v0[e]); v1[e] = gelu_f(v1[e]); }
    } else if (col >= 2048) {
#pragma unroll
      for (int e = 0; e < 4; ++e) { v0[e] = silu_f(v0[e]); v1[e] = silu_f(v1[e]); }
    } else if (col >= 512 && col < 1024) { v0 = v0 * 0.08838834764831845f; v1 = v1 * 0.08838834764831845f; }
    u32x4 o; o[0] = pk2(v0[0], v0[1]); o[1] = pk2(v0[2], v0[3]); o[2] = pk2(v1[0], v1[1]); o[3] = pk2(v1[2], v1[3]);
    __builtin_amdgcn_raw_buffer_store_b128(o, mk_rsrc(O, (unsigned)NT * 4096u * 2u), (unsigned)(((size_t)row * 4096 + col) * 2), 0, 16);
  }
  __device__ __forceinline__ void store4(int row, int col, f32x4 v, int) const {
    if (col >= 3072) { v[0] = gelu_f(v[0]); v[1] = gelu_f(v[1]); v[2] = gelu_f(v[2]); v[3] = gelu_f(v[3]); }
    else if (col >= 2048) { v[0] = silu_f(v[0]); v[1] = silu_f(v[1]); v[2] = silu_f(v[2]); v[3] = silu_f(v[3]); }
    else if (col >= 512 && col < 1024) v = v * 0.08838834764831845f;
    u32x2 o; o[0] = pk2(v[0], v[1]); o[1] = pk2(v[2], v[3]);
    *(u32x2*)(O + (size_t)row * 4096 + col) = o;
  }
};
struct EpiPart {
  static constexpr bool PAIR = false;
  float* Pp;
  __device__ __forceinline__ void store8(int row, int col, f32x4 v0, f32x4 v1, int ks) const {
    u32x4 o; o[0] = pk2(v0[0], v0[1]); o[1] = pk2(v0[2], v0[3]); o[2] = pk2(v1[0], v1[1]); o[3] = pk2(v1[2], v1[3]);
    *(u32x4*)((u16*)Pp + ((size_t)ks * NT + row) * DM + col) = o;
  }
};
struct EpiRelu2 {
  static constexpr bool PAIR = false;
  u16* O;
  __device__ __forceinline__ void store8(int row, int col, f32x4 v0, f32x4 v1, int) const {
#pragma unroll
    for (int e = 0; e < 4; ++e) { const float r0 = fmaxf(v0[e], 0.f), r1 = fmaxf(v1[e], 0.f); v0[e] = r0 * r0; v1[e] = r1 * r1; }
    u32x4 o; o[0] = pk2(v0[0], v0[1]); o[1] = pk2(v0[2], v0[3]); o[2] = pk2(v1[0], v1[1]); o[3] = pk2(v1[2], v1[3]);
    *(u32x4*)(O + (size_t)row * 4096 + col) = o;
  }
  __device__ __forceinline__ void store4(int row, int col, f32x4 v, int) const {
#pragma unroll
    for (int e = 0; e < 4; ++e) { const float r = fmaxf(v[e], 0.f); v[e] = r * r; }
    u32x2 o; o[0] = pk2(v[0], v[1]); o[1] = pk2(v[2], v[3]);
    *(u32x2*)(O + (size_t)row * 4096 + col) = o;
  }
};
struct EpiPartW {
  static constexpr bool PAIR = false;
  __amdgpu_buffer_rsrc_t rs;
  __device__ __forceinline__ void store8(int row, int col, f32x4 v0, f32x4 v1, int ks) const {
    u32x4 o; o[0] = pk2(v0[0], v0[1]); o[1] = pk2(v0[2], v0[3]); o[2] = pk2(v1[0], v1[1]); o[3] = pk2(v1[2], v1[3]);
    __builtin_amdgcn_raw_buffer_store_b128(o, rs, (unsigned)((((size_t)ks * NT + row) * DM + col) * 2), 0, 16);
  }
};
struct EpiRelu2W {
  static constexpr bool PAIR = false;
  __amdgpu_buffer_rsrc_t rs;
  __device__ __forceinline__ void store8(int row, int col, f32x4 v0, f32x4 v1, int) const {
#pragma unroll
    for (int e = 0; e < 4; ++e) { const float r0 = fmaxf(v0[e], 0.f), r1 = fmaxf(v1[e], 0.f); v0[e] = r0 * r0; v1[e] = r1 * r1; }
    u32x4 o; o[0] = pk2(v0[0], v0[1]); o[1] = pk2(v0[2], v0[3]); o[2] = pk2(v1[0], v1[1]); o[3] = pk2(v1[2], v1[3]);
    __builtin_amdgcn_raw_buffer_store_b128(o, rs, (unsigned)(((size_t)row * 4096 + col) * 2), 0, 16);
  }
};
struct EpiPlain {
  static constexpr bool PAIR = true;
  u16* O;
  __device__ __forceinline__ void store8(int row, int col, f32x4 v0, f32x4 v1, int) const {
    u32x4 o; o[0] = pk2(v0[0], v0[1]); o[1] = pk2(v0[2], v0[3]); o[2] = pk2(v1[0], v1[1]); o[3] = pk2(v1[2], v1[3]);
    __builtin_amdgcn_raw_buffer_store_b128(o, mk_rsrc(O, (unsigned)NT * 2048u * 2u), (unsigned)(((size_t)row * 2048 + col) * 2), 0, 16);
  }
  __device__ __forceinline__ void store_pair(int row, int ch, f32x4 c0, f32x4 c1, f32x4 h0, f32x4 h1) const {
    const f32x4 x0 = c0 * h0, x1 = c1 * h1;
    u32x4 o; o[0] = pk2(x0[0], x0[1]); o[1] = pk2(x0[2], x0[3]); o[2] = pk2(x1[0], x1[1]); o[3] = pk2(x1[2], x1[3]);
    __builtin_amdgcn_raw_buffer_store_b128(o, mk_rsrc(O, (unsigned)NT * 2048u * 2u), (unsigned)(((size_t)row * 2048 + 1024 + ch) * 2), 0, 16);
  }
};

template <class Epi>
__device__ __forceinline__ void phase_gemm_naive(const u16* __restrict__ A, const u16* __restrict__ Bt, int M, int N, int K, int ksplit, const Epi& E, float* lds) {
  float (*As)[33] = (float (*)[33])lds;
  float (*Bs)[33] = (float (*)[33])(lds + 128 * 33);
  const int tm = M / 128, tn = N / 64, total = tm * tn * ksplit, kper = K / ksplit;
  const int tid = threadIdx.x, r = tid >> 2, cq = tid & 3;
  for (int it = blockIdx.x; it < total; it += gridDim.x) {
    const int ks = it / (tm * tn), rem = it % (tm * tn), m0 = (rem / tn) * 128, n0 = (rem % tn) * 64;
    float acc[4][4] = {};
    for (int k0 = ks * kper; k0 < (ks + 1) * kper; k0 += 32) {
      __syncthreads();
      {
        const int kc = (tid & 3) * 8;
        const u32x4 va = *(const u32x4*)(A + (size_t)(m0 + r) * K + k0 + kc);
#pragma unroll
        for (int e = 0; e < 4; ++e) { As[r][kc + 2 * e] = __uint_as_float(va[e] << 16); As[r][kc + 2 * e + 1] = __uint_as_float(va[e] & 0xffff0000u); }
        if (tid < 256) {
          const u32x4 vb = *(const u32x4*)(Bt + (size_t)(n0 + r) * K + k0 + kc);
#pragma unroll
          for (int e = 0; e < 4; ++e) { Bs[r][kc + 2 * e] = __uint_as_float(vb[e] << 16); Bs[r][kc + 2 * e + 1] = __uint_as_float(vb[e] & 0xffff0000u); }
        }
      }
      __syncthreads();
#pragma unroll 4
      for (int k = 0; k < 32; ++k) {
        const float a = As[r][k];
#pragma unroll
        for (int jj = 0; jj < 4; ++jj)
#pragma unroll
          for (int e = 0; e < 4; ++e) acc[jj][e] += a * Bs[cq * 4 + 16 * jj + e][k];
      }
    }
#pragma unroll
    for (int jj = 0; jj < 4; ++jj) { f32x4 v = {acc[jj][0], acc[jj][1], acc[jj][2], acc[jj][3]}; E.store4(m0 + r, n0 + cq * 4 + 16 * jj, v, ks); }
  }
}


namespace pg8 {
#define PG8_LAS __attribute__((address_space(3)))
typedef short bf16x8 __attribute__((ext_vector_type(8)));
constexpr int BM = 256, BK = 64, HALF = 128, HTB = HALF * BK * 2, STAGE_BYTES = 8 * HTB, NXCD = 8, WGM = 8;
__device__ __forceinline__ int lds_byte(int r, int c) { const int st = (r >> 4) * 2 + (c >> 5), rr = r & 15, cc = c & 31, ob = rr * 64 + cc * 2; return st * 1024 + (ob ^ (((ob >> 9) & 1) << 5)); }
__device__ __forceinline__ int perm32(int rho) { const int n = rho >> 4, i = rho & 15; return 8 * (i >> 2) + 4 * n + (i & 3); }
__device__ __forceinline__ void stage_rc(int b, int& R, int& C) { const int st = b / 1024, sb = b % 1024, swz = sb ^ (((sb >> 9) & 1) << 5); R = (st >> 1) * 16 + swz / 64; C = (st & 1) * 32 + (swz % 64) / 2; }
struct Unit { int pm, pn, ks; };
struct Gemm { const u16* A; const u16* Bt; int M, N, K, ksplit; };
struct Order {
  int nM, nN, ntile, nwg, G, c;
  __device__ __forceinline__ void init(int M, int N, int ksplit, int G_, int c_) { nM = M / BM; nN = N / BM; ntile = nM * nN; nwg = ntile * ksplit; G = G_; c = c_; }
  __device__ __forceinline__ bool next(int i, Unit& u) const {
    const int L = i * G + c; if (L >= nwg) return false;
    u.ks = L / ntile; int wgid = L % ntile;
    { const int q = ntile / NXCD, r = ntile % NXCD, xcd = wgid % NXCD, off = wgid / NXCD; wgid = (xcd < r ? xcd * (q + 1) : r * (q + 1) + (xcd - r) * q) + off; }
    const int nig = WGM * nN, gid = wgid / nig, fm = gid * WGM, gsz = (nM - fm) < WGM ? (nM - fm) : WGM;
    u.pm = fm + ((wgid % nig) % gsz); u.pn = (wgid % nig) / gsz; return true;
  }
};
template <class Epi>
__device__ __forceinline__ void run_epi(const Epi& E, const f32x4 (&acc)[2][2][4][2], const Unit& u, int wr, int wc, int fr, int fq) {
  const int row0 = u.pm * BM + wr * 64 + fr, col0 = u.pn * BM + wc * 32 + 8 * fq;
#pragma unroll
  for (int ai = 0; ai < 2; ++ai)
#pragma unroll
    for (int m = 0; m < 4; ++m)
      {
        if constexpr (Epi::PAIR) {
          if (u.pn >= 4) { E.store_pair(row0 + ai * HALF + m * 16, (u.pn - 4) * HALF + wc * 32 + 8 * fq, acc[ai][0][m][0], acc[ai][0][m][1], acc[ai][1][m][0], acc[ai][1][m][1]); continue; }
        }
#pragma unroll
        for (int bj = 0; bj < 2; ++bj) E.store8(row0 + ai * HALF + m * 16, col0 + bj * HALF, acc[ai][bj][m][0], acc[ai][bj][m][1], u.ks);
      }
}
struct OneUnit { Unit u; __device__ __forceinline__ bool next(int i, Unit& o) const { if (i) return false; o = u; return true; } };
struct FfnOrder1 {
  int c;
  __device__ __forceinline__ bool next(int i, Unit& u) const {
    const int x = c & 7; u.ks = 0;
    if (c >= 128) { if (i) return false; const int oj = (c - 128) >> 3; u.pm = 2 * (x >> 1) + (oj >> 3); u.pn = (x & 1) * 8 + (oj & 7); return true; }
    if (i > 1) return false;
    const int o = c >> 3; u.pm = 8 + 8 * i + 2 * (x >> 1) + (o >> 3); u.pn = (x & 1) * 8 + (o & 7); return true;
  }
};
struct L1InOrder {
  int c;
  __device__ __forceinline__ bool next(int i, Unit& u) const {
    u.ks = 0;
    if (c >= 40) { if (i) return false; const int idx = c - 40; u.pm = idx / 12; u.pn = idx % 12; return true; }
    if (c >= 36 || i > 1) return false;
    const int t = i * 36 + c; u.pm = 18 + t / 12; u.pn = t % 12; return true;
  }
};
template <class Epi, class Sched>
__device__ __forceinline__ void gemm_phase(PG8_LAS unsigned char* lds, const Gemm g, const Sched& S, const Epi& E) {
  int tid_ = threadIdx.x; asm volatile("" : "+v"(tid_));
  const int tid = tid_, wid = __builtin_amdgcn_readfirstlane(tid >> 6), lane = tid & 63, wr = wid >> 2, wc = wid & 3, fr = lane & 15, fq = lane >> 4;
  const int K = g.K, kper = g.K / g.ksplit, nt = kper / BK;
  unsigned voffA[2], voffB[2];
#pragma unroll
  for (int i = 0; i < 2; ++i) { int R, C; stage_rc(tid * 16 + i * 8192, R, C); const int Rb = (R & ~31) + perm32(R & 31);
    voffA[i] = (unsigned)(R * K + C) * 2u; voffB[i] = (unsigned)(Rb * K + C) * 2u; }
  const size_t kstep = (size_t)(BK * 2);
  const size_t hstep = (size_t)HALF * K * 2;
  const size_t tstep = 2 * hstep;
  const size_t ksbytes = (size_t)kper * 2;
  const unsigned ldsw = (unsigned)wid * 1024u;
  const int aoff = lds_byte(wr * 64 + fr, fq * 8), boff = lds_byte(wc * 32 + fr, fq * 8);
#define PG8_SA(b, h) (((b) * 2 + (h)) * HTB)
#define PG8_SB(b, h) ((4 + (b) * 2 + (h)) * HTB)
#define PG8_STAGE(bufoff, gbase, voff) do { _Pragma("unroll") for (int _i = 0; _i < 2; ++_i) \
    __builtin_amdgcn_global_load_lds((const unsigned*)((const char*)(gbase) + (voff)[_i]), (PG8_LAS unsigned*)(lds + (bufoff) + ldsw + _i * 8192), 16, 0, 0); } while (0)
#define PG8_LDA(dst, b, h) do { _Pragma("unroll") for (int m = 0; m < 4; ++m) _Pragma("unroll") for (int k = 0; k < 2; ++k) dst[m][k] = *(const PG8_LAS bf16x8*)(lds + PG8_SA(b, h) + aoff + m * 2048 + k * 1024); } while (0)
#define PG8_LDB(dst, b, h) do { _Pragma("unroll") for (int n = 0; n < 2; ++n) _Pragma("unroll") for (int k = 0; k < 2; ++k) dst[n][k] = *(const PG8_LAS bf16x8*)(lds + PG8_SB(b, h) + boff + n * 2048 + k * 1024); } while (0)
#define PG8_MMA(ai, bj, At, Bt) do { __builtin_amdgcn_s_setprio(1); _Pragma("unroll") for (int m = 0; m < 4; ++m) _Pragma("unroll") for (int n = 0; n < 2; ++n) _Pragma("unroll") for (int k = 0; k < 2; ++k) \
    acc[ai][bj][m][n] = __builtin_amdgcn_mfma_f32_16x16x32_bf16(Bt[n][k], At[m][k], acc[ai][bj][m][n], 0, 0, 0); __builtin_amdgcn_s_setprio(0); } while (0)
#define PG8_WAIT_V(n) asm volatile("s_waitcnt vmcnt(" #n ")" ::: "memory")
#define PG8_WAIT_L(n) asm volatile("s_waitcnt lgkmcnt(" #n ")" ::: "memory")
#define PG8_BAR __builtin_amdgcn_s_barrier()
#define PG8_SCHED __builtin_amdgcn_sched_barrier(0)
  Unit cur, nxt; int ui = 0;
  if (!S.next(0, cur)) return;
  f32x4 acc[2][2][4][2];
#pragma unroll
  for (int a = 0; a < 2; ++a)
#pragma unroll
    for (int b = 0; b < 2; ++b)
#pragma unroll
      for (int m = 0; m < 4; ++m)
#pragma unroll
        for (int n = 0; n < 2; ++n) acc[a][b][m][n] = (f32x4){0.f, 0.f, 0.f, 0.f};
  bf16x8 At[4][2], B0[2][2], B1[2][2];
  const char* cA = (const char*)g.A + (size_t)cur.pm * tstep + (size_t)cur.ks * ksbytes; const char* cB = (const char*)g.Bt + (size_t)cur.pn * tstep + (size_t)cur.ks * ksbytes;
  PG8_STAGE(PG8_SB(0, 0), cB, voffB); PG8_STAGE(PG8_SA(0, 0), cA, voffA); PG8_STAGE(PG8_SB(0, 1), cB + hstep, voffB); PG8_STAGE(PG8_SA(0, 1), cA + hstep, voffA);
  if (wr == 1) PG8_BAR;
  PG8_WAIT_V(4); PG8_BAR;
  PG8_STAGE(PG8_SB(1, 0), cB + kstep, voffB); PG8_STAGE(PG8_SA(1, 0), cA + kstep, voffA); PG8_STAGE(PG8_SB(1, 1), cB + hstep + kstep, voffB);
  PG8_WAIT_V(6); PG8_BAR;
  for (;;) {
    const bool has_next = S.next(ui + 1, nxt);
    const char* nA = has_next ? (const char*)g.A + (size_t)nxt.pm * tstep + (size_t)nxt.ks * ksbytes : cA; const char* nB = has_next ? (const char*)g.Bt + (size_t)nxt.pn * tstep + (size_t)nxt.ks * ksbytes : cB;
    for (int t = 0; t < nt; t += 2) {
      const bool last = (t == nt - 2);
      const char* a1 = cA + (size_t)(t + 1) * kstep;
      const char* a2 = last ? nA : cA + (size_t)(t + 2) * kstep; const char* b2 = last ? nB : cB + (size_t)(t + 2) * kstep;
      const char* a3 = a2 + kstep; const char* b3 = b2 + kstep;
      PG8_LDB(B0, 0, 0); PG8_SCHED; PG8_LDA(At, 0, 0); PG8_STAGE(PG8_SA(1, 1), a1 + hstep, voffA);
      PG8_WAIT_L(8); PG8_BAR; PG8_WAIT_L(0); PG8_MMA(0, 0, At, B0); PG8_BAR; PG8_SCHED;
      PG8_LDB(B1, 0, 1); PG8_STAGE(PG8_SB(0, 0), b2, voffB);
      PG8_BAR; PG8_WAIT_L(0); PG8_MMA(0, 1, At, B1); PG8_BAR;
      PG8_LDA(At, 0, 1); PG8_STAGE(PG8_SA(0, 0), a2, voffA);
      PG8_BAR; PG8_WAIT_L(0); PG8_MMA(1, 0, At, B0); PG8_BAR; PG8_SCHED;
      PG8_STAGE(PG8_SB(0, 1), b2 + hstep, voffB);
      PG8_WAIT_V(6); PG8_BAR; PG8_MMA(1, 1, At, B1); PG8_BAR;
      PG8_LDB(B0, 1, 0); PG8_SCHED; PG8_LDA(At, 1, 0); PG8_STAGE(PG8_SA(0, 1), a2 + hstep, voffA);
      PG8_WAIT_L(8); PG8_BAR; PG8_WAIT_L(0); PG8_MMA(0, 0, At, B0); PG8_BAR; PG8_SCHED;
      PG8_LDB(B1, 1, 1); PG8_STAGE(PG8_SB(1, 0), b3, voffB);
      PG8_BAR; PG8_WAIT_L(0); PG8_MMA(0, 1, At, B1); PG8_BAR;
      PG8_LDA(At, 1, 1); PG8_STAGE(PG8_SA(1, 0), a3, voffA);
      PG8_BAR; PG8_WAIT_L(0); PG8_MMA(1, 0, At, B0); PG8_BAR; PG8_SCHED;
      PG8_STAGE(PG8_SB(1, 1), b3 + hstep, voffB);
      PG8_WAIT_V(6); PG8_BAR; PG8_MMA(1, 1, At, B1); PG8_BAR;
    }
    run_epi(E, acc, cur, wr, wc, fr, fq);
    if (!has_next) break;
#pragma unroll
    for (int a = 0; a < 2; ++a)
#pragma unroll
      for (int b = 0; b < 2; ++b)
#pragma unroll
        for (int m = 0; m < 4; ++m)
#pragma unroll
          for (int n = 0; n < 2; ++n) acc[a][b][m][n] = (f32x4){0.f, 0.f, 0.f, 0.f};
    cur = nxt; cA = nA; cB = nB; ++ui;
  }
  PG8_WAIT_V(0);
  if (wr == 0) PG8_BAR;
  PG8_BAR;
#undef PG8_SA
#undef PG8_SB
#undef PG8_STAGE
#undef PG8_LDA
#undef PG8_LDB
#undef PG8_MMA
#undef PG8_WAIT_V
#undef PG8_WAIT_L
#undef PG8_BAR
#undef PG8_SCHED
}
}
template <class Epi>
__device__ __forceinline__ void phase_gemm(const u16* A, const u16* Bt, int M, int N, int K, int ksplit, const Epi& E, float* lds) {
  __syncthreads();
  pg8::Gemm g{A, Bt, M, N, K, ksplit};
  pg8::Order S; S.init(M, N, ksplit, (int)gridDim.x, (int)blockIdx.x);
  pg8::gemm_phase(( __attribute__((address_space(3))) unsigned char*)lds, g, S, E);
  __syncthreads();
}

__device__ __forceinline__ void seq_of_token(int t, int& s0, int& L, int& sb) {
  if (t < NPROMPT_T) { s0 = t & ~255; L = 256; sb = -1; } else { sb = (t - NPROMPT_T) >> 10; s0 = NPROMPT_T + (sb << 10); L = 1024; }
}
__device__ __forceinline__ void ret_item_naive(const P& p, int item, float* lds) {
  const int tg = item >> 2, h = item & 3, t0 = tg * 16, tid = threadIdx.x;
  int s0, L, sb; seq_of_token(t0, s0, L, sb);
  float* scr = lds;
  float* qs = lds + 16 * 1024;
  float* red = qs + 16 * 128;
  const float lgf = log1pf(-exp2f(-p.l0_decay[h])), lgb = log1pf(-exp2f(-p.l0_decay[4 + h]));
  __syncthreads();
  for (int i = tid; i < 16 * 128; i += NTHR) qs[i] = bf2f(p.proj[(size_t)(t0 + (i >> 7)) * 4096 + h * 128 + (i & 127)]);
  __syncthreads();
  for (int j = tid; j < L; j += NTHR) {
    float acc[16] = {};
    const u16* kr = p.proj + (size_t)(s0 + j) * 4096 + 512 + h * 128;
    for (int d0 = 0; d0 < 128; d0 += 8) {
      const u32x4 kv = *(const u32x4*)(kr + d0);
      float kf[8];
#pragma unroll
      for (int e = 0; e < 4; ++e) { kf[2 * e] = __uint_as_float(kv[e] << 16); kf[2 * e + 1] = __uint_as_float(kv[e] & 0xffff0000u); }
#pragma unroll
      for (int i = 0; i < 16; ++i)
#pragma unroll
        for (int e = 0; e < 8; ++e) acc[i] += qs[i * 128 + d0 + e] * kf[e];
    }
#pragma unroll
    for (int i = 0; i < 16; ++i) {
      const int d = (t0 + i - s0) - j;
      const float w = d > 0 ? __expf((float)d * lgf) : (d < 0 ? __expf((float)(-d) * lgb) : 2.f);
      scr[i * 1024 + j] = acc[i] * w;
    }
  }
  __syncthreads();
  const int dv = tid & 255, ig = tid >> 8;
  float o[8] = {};
  for (int j = 0; j < L; ++j) {
    const float v = bf2f(p.proj[(size_t)(s0 + j) * 4096 + 1024 + h * 256 + dv]);
#pragma unroll
    for (int e = 0; e < 8; ++e) o[e] += scr[(ig * 8 + e) * 1024 + j] * v;
  }
  if (sb >= 0) {
    const float* Sf = p.state + ((size_t)(sb * 2 + 0) * 4 + h) * 128 * 256;
    const float* Sb = p.state + ((size_t)(sb * 2 + 1) * 4 + h) * 128 * 256;
    float af[8] = {}, ab[8] = {};
    for (int dk = 0; dk < 128; ++dk) {
      const float sf = Sf[dk * 256 + dv], sbv = Sb[dk * 256 + dv];
#pragma unroll
      for (int e = 0; e < 8; ++e) { const float q = qs[(ig * 8 + e) * 128 + dk]; af[e] += q * sf; ab[e] += q * sbv; }
    }
#pragma unroll
    for (int e = 0; e < 8; ++e) {
      const int pos = t0 + ig * 8 + e - s0;
      o[e] += __expf((float)(pos + 1) * lgf) * af[e] + __expf((float)(L - pos) * lgb) * ab[e];
    }
  }
  const int wid = tid >> 6, lane = tid & 63;
#pragma unroll
  for (int e = 0; e < 8; ++e) { const float s = wave_sum(o[e] * o[e]); if (lane == 0) red[wid * 8 + e] = s; }
  __syncthreads();
#pragma unroll
  for (int e = 0; e < 8; ++e) {
    const float ss = red[(ig * 4 + 0) * 8 + e] + red[(ig * 4 + 1) * 8 + e] + red[(ig * 4 + 2) * 8 + e] + red[(ig * 4 + 3) * 8 + e];
    const float r = rsqrtf(ss * (1.f / 256.f) + EPS);
    const int t = t0 + ig * 8 + e;
    const float g = bf2f(p.proj[(size_t)t * 4096 + 2048 + h * 256 + dv]);
    p.cat[(size_t)t * 1536 + h * 256 + dv] = f2bf(o[e] * r * g);
  }
}
__device__ __forceinline__ void state_item_naive(const P& p, int item) {
  const int b = item >> 3, h = (item >> 1) & 3, dir = item & 1, tid = threadIdx.x;
  const float lg = log1pf(-exp2f(-p.l0_decay[dir * 4 + h]));
  const int dv = tid & 255;
  float* o = p.out + (size_t)NT * DM + ((size_t)(b * 2 + dir) * 4 + h) * 128 * 256;
  for (int pass = 0; pass < 4; ++pass) {
    const int dk0 = (tid >> 8) * 64 + pass * 16;
    float acc[16] = {};
    for (int s = 0; s < 256; ++s) {
      const int t = b * 256 + s;
      const float w = dir == 0 ? __expf((float)(255 - s) * lg) : __expf((float)s * lg);
      const float v = bf2f(p.proj[(size_t)t * 4096 + 1024 + h * 256 + dv]) * w;
      const u16* kr = p.proj + (size_t)t * 4096 + 512 + h * 128 + dk0;
#pragma unroll
      for (int e = 0; e < 16; ++e) acc[e] += bf2f(kr[e]) * v;
    }
#pragma unroll
    for (int e = 0; e < 16; ++e) o[(dk0 + e) * 256 + dv] = acc[e];
  }
}
__device__ __forceinline__ void gmlp_item_naive(const P& p, int item, float* lds) {
  const int ci = item >> 2, g = item & 3, tid = threadIdx.x, wid = tid >> 6, lane = tid & 63;
  float* zn = lds;
  float* mu = lds + 128 * 128;
  float* rs = mu + 128;
  __syncthreads();
  for (int q = wid; q < 128; q += 8) {
    const u32x4 v = *(const u32x4*)(p.proj + (size_t)(ci * 128 + q) * 4096 + 3584 + lane * 8);
    float s = 0.f, s2 = 0.f;
#pragma unroll
    for (int e = 0; e < 4; ++e) { const float a = __uint_as_float(v[e] << 16), b = __uint_as_float(v[e] & 0xffff0000u); s += a + b; s2 += a * a + b * b; }
    s = wave_sum(s); s2 = wave_sum(s2);
    if (lane == 0) { const float m = s * (1.f / 512.f); const float var = fmaxf(s2 * (1.f / 512.f) - m * m, 0.f); mu[q] = m; rs[q] = rsqrtf(var + EPS); }
  }
  __syncthreads();
  for (int i = tid; i < 128 * 128; i += NTHR) {
    const int q = i >> 7, c = i & 127;
    zn[i] = (bf2f(p.proj[(size_t)(ci * 128 + q) * 4096 + 3584 + g * 128 + c]) - mu[q]) * rs[q];
  }
  __syncthreads();
  const int c = tid & 127, p0 = (tid >> 7) * 32;
  float acc[32] = {};
  const float* W = p.l0_gws + (size_t)g * 128 * 128;
  for (int q = 0; q < 128; ++q) {
    const float z = zn[q * 128 + c];
#pragma unroll
    for (int e = 0; e < 32; ++e) acc[e] += W[(p0 + e) * 128 + q] * z;
  }
#pragma unroll
  for (int e = 0; e < 32; ++e) {
    const int t = ci * 128 + p0 + e;
    const float u = bf2f(p.proj[(size_t)t * 4096 + 3072 + g * 128 + c]);
    p.cat[(size_t)t * 1536 + 1024 + g * 128 + c] = f2bf((acc[e] + p.l0_gb[g * 128 + p0 + e]) * u);
  }
}
__device__ __forceinline__ void phase_mixer_naive(const P& p, float* lds) {
  const int nR = 1536, nS = 128, nG = 192, total = nR + nS + nG;
  for (int it = blockIdx.x; it < total; it += gridDim.x) {
    if (it < nR) ret_item_naive(p, it, lds);
    else if (it < nR + nS) state_item_naive(p, it - nR);
    else gmlp_item_naive(p, it - nR - nS, lds);
  }
}


#define LAS __attribute__((address_space(3)))
typedef short bf16x8 __attribute__((ext_vector_type(8)));
typedef short bf16x4 __attribute__((ext_vector_type(4)));
constexpr int PK = 136;
constexpr int PV = 264;
__device__ __forceinline__ bf16x8 frag_row(const LAS u16* base, int pitch, int r0, int k0, int fr, int fq) {
  return *(const LAS bf16x8*)(base + (r0 + fr) * pitch + k0 + fq * 8);
}
__device__ __forceinline__ bf16x8 frag_tr(const LAS u16* base, int pitch, int k0, int n0, int fr, int fq) {
  const LAS u16* a = base + (k0 + fq * 8 + (fr >> 2)) * pitch + n0 + 4 * (fr & 3);
  const bf16x4 lo = __builtin_amdgcn_ds_read_tr16_b64_v4i16((LAS bf16x4*)a);
  const bf16x4 hi = __builtin_amdgcn_ds_read_tr16_b64_v4i16((LAS bf16x4*)(a + 4 * pitch));
  bf16x8 r; r[0] = lo[0]; r[1] = lo[1]; r[2] = lo[2]; r[3] = lo[3]; r[4] = hi[0]; r[5] = hi[1]; r[6] = hi[2]; r[7] = hi[3];
  return r;
}
__device__ __forceinline__ f32x4 mfma16(bf16x8 a, bf16x8 b, f32x4 c) { return __builtin_amdgcn_mfma_f32_16x16x32_bf16(a, b, c, 0, 0, 0); }
template <int ROWS, int COLS>
__device__ __forceinline__ void tile_to_lds_t(const u16* __restrict__ g, size_t gp, LAS u16* l, int lp) {
  constexpr int CPR = COLS / 8, N = ROWS * CPR / NTHR;
  u32x4 v[N];
#pragma unroll
  for (int k = 0; k < N; ++k) { const int i = threadIdx.x + k * NTHR, r = i / CPR, c = (i % CPR) * 8; v[k] = *(const u32x4*)(g + (size_t)r * gp + c); }
#pragma unroll
  for (int k = 0; k < N; ++k) { const int i = threadIdx.x + k * NTHR, r = i / CPR, c = (i % CPR) * 8; *(LAS u32x4*)(l + r * lp + c) = v[k]; }
}
__device__ __forceinline__ void tile_to_lds(const u16* __restrict__ g, size_t gp, LAS u16* l, int lp, int rows, int cols) {
  if (cols == 128) tile_to_lds_t<128, 128>(g, gp, l, lp); else tile_to_lds_t<128, 256>(g, gp, l, lp);
}

__device__ __forceinline__ void kv_item(const P& p, int item, LAS u16* lds) {
  const int ci = item >> 2, h = item & 3, tid = threadIdx.x, wid = tid >> 6, lane = tid & 63, fr = lane & 15, fq = lane >> 4;
  LAS u16* kbuf = lds; LAS u16* vbuf = lds + 128 * PK;
  __syncthreads();
  tile_to_lds(p.proj + (size_t)ci * 128 * 4096 + 512 + h * 128, 4096, kbuf, PK, 128, 128);
  tile_to_lds(p.proj + (size_t)ci * 128 * 4096 + 1024 + h * 256, 4096, vbuf, PV, 128, 256);
  __syncthreads();
  const int dir = wid >> 2, d0 = (wid & 3) * 32;
  const float lg = log1pf(-exp2f(-p.l0_decay[dir * 4 + h]));
  u16* o = (u16*)p.part + ((size_t)(ci * 4 + h) * 2 + dir) * 128 * 256;
#pragma unroll 1
  for (int nh = 0; nh < 2; ++nh) {
    f32x4 acc[8][2];
#pragma unroll
    for (int m = 0; m < 8; ++m) { acc[m][0] = (f32x4){0.f, 0.f, 0.f, 0.f}; acc[m][1] = (f32x4){0.f, 0.f, 0.f, 0.f}; }
#pragma unroll 1
    for (int ks = 0; ks < 4; ++ks) {
      bf16x8 kb[2];
      kb[0] = frag_tr(kbuf, PK, ks * 32, d0, fr, fq); kb[1] = frag_tr(kbuf, PK, ks * 32, d0 + 16, fr, fq);
#pragma unroll
      for (int j = 0; j < 8; ++j) {
        const int tok = ks * 32 + fq * 8 + j;
        const float w = __expf((float)(dir == 0 ? 127 - tok : tok) * lg);
        kb[0][j] = (short)f2bf(bf2f((u16)kb[0][j]) * w); kb[1][j] = (short)f2bf(bf2f((u16)kb[1][j]) * w);
      }
#pragma unroll
      for (int m = 0; m < 8; ++m) {
        const bf16x8 va = frag_tr(vbuf, PV, ks * 32, nh * 128 + m * 16, fr, fq);
        acc[m][0] = mfma16(va, kb[0], acc[m][0]); acc[m][1] = mfma16(va, kb[1], acc[m][1]);
      }
    }
#pragma unroll
    for (int n = 0; n < 2; ++n) {
      u16* orow = o + (size_t)(d0 + n * 16 + fr) * 256 + nh * 128 + fq * 4;
#pragma unroll
      for (int m = 0; m < 8; ++m) { u32x2 v; v[0] = pk2(acc[m][n][0], acc[m][n][1]); v[1] = pk2(acc[m][n][2], acc[m][n][3]); *(u32x2*)(orow + m * 16) = v; }
    }
  }
}

__device__ __forceinline__ void gmlp_item(const P& p, int item, LAS u16* lds) {
  const int ci = item >> 2, g = item & 3, tid = threadIdx.x, wid = tid >> 6, lane = tid & 63, fr = lane & 15, fq = lane >> 4;
  LAS u16* zn = lds; LAS u16* wsb = lds + 128 * PK; LAS float* mu = (LAS float*)(lds + 2 * 128 * PK); LAS float* rs = mu + 128;
  __syncthreads();
  {
    u32x4 zv[16];
#pragma unroll
    for (int k = 0; k < 16; ++k) zv[k] = *(const u32x4*)(p.proj + (size_t)(ci * 128 + wid + 8 * k) * 4096 + 3584 + lane * 8);
#pragma unroll
    for (int k = 0; k < 16; ++k) {
      float s = 0.f, s2 = 0.f;
#pragma unroll
      for (int e = 0; e < 4; ++e) { const float a = __uint_as_float(zv[k][e] << 16), b = __uint_as_float(zv[k][e] & 0xffff0000u); s += a + b; s2 += a * a + b * b; }
      s = wave_sum(s); s2 = wave_sum(s2);
      if (lane == 0) { const float m = s * (1.f / 512.f); const float var = fmaxf(s2 * (1.f / 512.f) - m * m, 0.f); mu[wid + 8 * k] = m; rs[wid + 8 * k] = rsqrtf(var + EPS); }
    }
  }
  u32x4 zr[4];
#pragma unroll
  for (int k = 0; k < 4; ++k) { const int i = tid + k * NTHR, q = i >> 4, c = (i & 15) * 8; zr[k] = *(const u32x4*)(p.proj + (size_t)(ci * 128 + q) * 4096 + 3584 + g * 128 + c); }
  {
    const float* W = p.l0_gws + (size_t)g * 128 * 128;
    f32x4 wv[8];
#pragma unroll
    for (int k = 0; k < 8; ++k) { const int i = tid + k * NTHR; wv[k] = *(const f32x4*)(W + (i >> 5) * 128 + (i & 31) * 4); }
#pragma unroll
    for (int k = 0; k < 8; ++k) {
      const int i = tid + k * NTHR, r = i >> 5, c = (i & 31) * 4;
      u32x2 o; o[0] = pk2(wv[k][0], wv[k][1]); o[1] = pk2(wv[k][2], wv[k][3]);
      *(LAS u32x2*)(wsb + r * PK + c) = o;
    }
  }
  __syncthreads();
#pragma unroll
  for (int k = 0; k < 4; ++k) {
    const int i = tid + k * NTHR, q = i >> 4, c = (i & 15) * 8;
    const float m = mu[q], r = rs[q];
    u32x4 o;
#pragma unroll
    for (int e = 0; e < 4; ++e) o[e] = pk2((__uint_as_float(zr[k][e] << 16) - m) * r, (__uint_as_float(zr[k][e] & 0xffff0000u) - m) * r);
    *(LAS u32x4*)(zn + q * PK + c) = o;
  }
  __syncthreads();
  f32x4 acc[8];
#pragma unroll
  for (int m = 0; m < 8; ++m) acc[m] = (f32x4){0.f, 0.f, 0.f, 0.f};
#pragma unroll
  for (int ks = 0; ks < 4; ++ks) {
    const bf16x8 wb = frag_row(wsb, PK, wid * 16, ks * 32, fr, fq);
#pragma unroll
    for (int m = 0; m < 8; ++m) acc[m] = mfma16(frag_tr(zn, PK, ks * 32, m * 16, fr, fq), wb, acc[m]);
  }
  {
    const int pr = wid * 16 + fr, t = ci * 128 + pr;
    const float gb = p.l0_gb[g * 128 + pr];
    const u16* urow = p.proj + (size_t)t * 4096 + 3072 + g * 128 + fq * 4;
    u16* orow = p.cat + (size_t)t * 1536 + 1024 + g * 128 + fq * 4;
#pragma unroll
    for (int m = 0; m < 8; ++m) {
      const u32x2 uv = *(const u32x2*)(urow + m * 16);
      u32x2 v;
      v[0] = pk2((acc[m][0] + gb) * __uint_as_float(uv[0] << 16), (acc[m][1] + gb) * __uint_as_float(uv[0] & 0xffff0000u));
      v[1] = pk2((acc[m][2] + gb) * __uint_as_float(uv[1] << 16), (acc[m][3] + gb) * __uint_as_float(uv[1] & 0xffff0000u));
      *(u32x2*)(orow + m * 16) = v;
    }
  }
}
__device__ __forceinline__ void phase_mix_a(const P& p, LAS u16* lds) {
  for (int it = blockIdx.x; it < 384; it += gridDim.x) { if (it < 192) kv_item(p, it, lds); else gmlp_item(p, it - 192, lds); }
}

__device__ __forceinline__ void build_state(const P& p, LAS u16* bbuf, const float* S0, float w0, int cbase, int h, int dir, int c_lo, int c_hi, int c_ref, float lg128) {
  const int tid = threadIdx.x;
#pragma unroll 1
  for (int half = 0; half < 2; ++half) {
    f32x4 a[8];
    const int base = (tid + half * 4096) * 4;
    if (S0) {
#pragma unroll
      for (int k = 0; k < 8; ++k) a[k] = *(const f32x4*)(S0 + base + k * 2048);
#pragma unroll
      for (int k = 0; k < 8; ++k) a[k] = a[k] * w0;
    } else {
#pragma unroll
      for (int k = 0; k < 8; ++k) a[k] = (f32x4){0.f, 0.f, 0.f, 0.f};
    }
#pragma unroll 1
    for (int cc = c_lo; cc < c_hi; ++cc) {
      const int e = dir == 0 ? (c_ref - 1 - cc) : (cc - c_ref - 1);
      const float w = __expf(lg128 * (float)e);
      const float* src = p.part + ((size_t)((cbase + cc) * 4 + h) * 2 + dir) * 128 * 256 + base;
      f32x4 t[8];
#pragma unroll
      for (int k = 0; k < 8; ++k) t[k] = *(const f32x4*)(src + k * 2048);
#pragma unroll
      for (int k = 0; k < 8; ++k) a[k] = a[k] + t[k] * w;
    }
#pragma unroll
    for (int k = 0; k < 8; ++k) {
      const int i = tid + half * 4096 + k * 512, r = i >> 6, c = (i & 63) * 4;
      u32x2 o; o[0] = pk2(a[k][0], a[k][1]); o[1] = pk2(a[k][2], a[k][3]);
      *(LAS u32x2*)(bbuf + r * PV + c) = o;
    }
  }
}
__device__ __forceinline__ void scan_item(const P& p, int item, unsigned* scnt) {
  const int combo = item >> 2, q = item & 3, dir = combo & 1, h = (combo >> 1) & 3, sb = combo >> 3, tid = threadIdx.x;
  const float g = __expf(128.f * log1pf(-exp2f(-p.l0_decay[dir * 4 + h])));
  const float* S0 = p.state + ((size_t)(sb * 2 + dir) * 4 + h) * 128 * 256 + q * 32 * 256;
  const u16* KV = (const u16*)p.part + ((size_t)((32 + sb * 8) * 4 + h) * 2 + dir) * 128 * 256 + q * 32 * 256;
  const __amdgpu_buffer_rsrc_t rs = mk_rsrc(p.stimg, 2u * 4u * 2u * 8u * 128u * 256u * 2u);
  const unsigned obase = (unsigned)((((size_t)combo * 8) * 128 * 256 + q * 32 * 256) * 2);
  float s[2][8]; u32x4 kv[7][2];
#pragma unroll
  for (int k = 0; k < 2; ++k) {
    const f32x4 a = __builtin_nontemporal_load((const f32x4*)(S0 + (tid + 512 * k) * 8)), b2 = __builtin_nontemporal_load((const f32x4*)(S0 + (tid + 512 * k) * 8 + 4));
    s[k][0] = a[0]; s[k][1] = a[1]; s[k][2] = a[2]; s[k][3] = a[3]; s[k][4] = b2[0]; s[k][5] = b2[1]; s[k][6] = b2[2]; s[k][7] = b2[3];
  }
#pragma unroll
  for (int c = 0; c < 7; ++c)
#pragma unroll
    for (int k = 0; k < 2; ++k) kv[c][k] = *(const u32x4*)(KV + (size_t)(c + dir) * (4 * 2 * 128 * 256) + (tid + 512 * k) * 8);
#pragma unroll
  for (int st = 0; st < 8; ++st) {
    const int c = dir == 0 ? st : 7 - st;
#pragma unroll
    for (int k = 0; k < 2; ++k) {
      if (st > 0) {
        const u32x4 t = kv[dir == 0 ? st - 1 : 7 - st][k];
#pragma unroll
        for (int e = 0; e < 4; ++e) { s[k][2 * e] = s[k][2 * e] * g + __uint_as_float(t[e] << 16); s[k][2 * e + 1] = s[k][2 * e + 1] * g + __uint_as_float(t[e] & 0xffff0000u); }
      }
      u32x4 v; v[0] = pk2(s[k][0], s[k][1]); v[1] = pk2(s[k][2], s[k][3]); v[2] = pk2(s[k][4], s[k][5]); v[3] = pk2(s[k][6], s[k][7]);
      __builtin_amdgcn_raw_buffer_store_b128(v, rs, obase + (unsigned)(((size_t)c * 128 * 256 + (tid + 512 * k) * 8) * 2), 0, 16);
    }
  }
  asm volatile("s_waitcnt vmcnt(0)" ::: "memory");
  __syncthreads();
  if (tid == 0) xb_add(&scnt[combo * 16], 1u);
}
__device__ __forceinline__ void ret_item(const P& p, int item, LAS u16* lds, unsigned* scnt, unsigned* rcnt) {
  const int ci = item >> 2, h = item & 3, tid = threadIdx.x, wid = tid >> 6, lane = tid & 63, fr = lane & 15, fq = lane >> 4;
  int sb, lc, n;
  if (ci < 32) { sb = -1; lc = ci & 1; n = 2; } else { sb = (ci - 32) >> 3; lc = (ci - 32) & 7; n = 8; }
  const int cbase = ci - lc;
  const float lgf = log1pf(-exp2f(-p.l0_decay[h])), lgb = log1pf(-exp2f(-p.l0_decay[4 + h]));
  LAS u16* kbuf = lds; LAS u16* bbuf = lds + 128 * PK; LAS float* red = (LAS float*)(lds + 128 * PK + 128 * PV);
  const bool hasF = (sb >= 0) || lc > 0, hasB = (sb >= 0) || lc < n - 1;
  const u16* qg = p.proj + (size_t)ci * 128 * 4096 + h * 128;
  __syncthreads();
  tile_to_lds(p.proj + (size_t)ci * 128 * 4096 + 512 + h * 128, 4096, kbuf, PK, 128, 128);
  __syncthreads();
  {
    f32x4 s[8];
#pragma unroll
    for (int nn = 0; nn < 8; ++nn) s[nn] = (f32x4){0.f, 0.f, 0.f, 0.f};
    bf16x8 qa[4];
#pragma unroll
    for (int ks = 0; ks < 4; ++ks) qa[ks] = *(const bf16x8*)(qg + (size_t)(wid * 16 + fr) * 4096 + ks * 32 + fq * 8);
#pragma unroll
    for (int ks = 0; ks < 4; ++ks) {
#pragma unroll
      for (int nn = 0; nn < 8; ++nn) s[nn] = mfma16(qa[ks], frag_row(kbuf, PK, nn * 16, ks * 32, fr, fq), s[nn]);
    }
    __syncthreads();
    int bd = wid * 16 + fq * 4 - fr;
    asm volatile("" : "+v"(bd));
    LAS u16* prow = kbuf + (wid * 16 + fq * 4) * PK + fr;
#pragma unroll
    for (int nn = 0; nn < 8; ++nn)
#pragma unroll
      for (int j = 0; j < 4; ++j) {
        const int d = bd + j - 16 * nn;
        const float w = d > 0 ? __expf((float)d * lgf) : (d < 0 ? __expf((float)(-d) * lgb) : 2.f);
        prow[j * PK + nn * 16] = f2bf(s[nn][j] * w);
      }
  }
  const int m0 = (wid & 3) * 32, n0 = (wid >> 2) * 128;
  f32x4 acc[2][8];
#pragma unroll
  for (int m = 0; m < 2; ++m)
#pragma unroll
    for (int nn = 0; nn < 8; ++nn) acc[m][nn] = (f32x4){0.f, 0.f, 0.f, 0.f};
  const u16* qrow = qg + (size_t)(m0 + fr) * 4096 + fq * 8;
  if (sb >= 0) {
    if (tid == 0) {
      XB_WAIT(xb_ld(&scnt[((sb * 4 + h) * 2 + 0) * 16]) < 4u || xb_ld(&scnt[((sb * 4 + h) * 2 + 1) * 16]) < 4u, p.bar);
      __builtin_amdgcn_fence(__ATOMIC_ACQUIRE, "agent");
      asm volatile("s_waitcnt vmcnt(0)" ::: "memory");
    }
    __syncthreads();
    tile_to_lds(p.stimg + ((size_t)((sb * 4 + h) * 2 + 0) * 8 + lc) * 128 * 256, 256, bbuf, PV, 128, 256);
    __syncthreads();
  } else if (hasF) {
    tile_to_lds((const u16*)p.part + ((size_t)((cbase + 0) * 4 + h) * 2 + 0) * 128 * 256, 256, bbuf, PV, 128, 256);
    __syncthreads();
  }
  if (hasF) {
    {
      bf16x8 q0[4], q1[4];
#pragma unroll
      for (int ks = 0; ks < 4; ++ks) { q0[ks] = *(const bf16x8*)(qrow + ks * 32); q1[ks] = *(const bf16x8*)(qrow + 16 * 4096 + ks * 32); }
#pragma unroll 1
      for (int ks = 0; ks < 4; ++ks) {
        const bf16x8 a0 = ks == 0 ? q0[0] : (ks == 1 ? q0[1] : (ks == 2 ? q0[2] : q0[3])), a1 = ks == 0 ? q1[0] : (ks == 1 ? q1[1] : (ks == 2 ? q1[2] : q1[3]));
#pragma unroll
        for (int nn = 0; nn < 8; ++nn) {
          const bf16x8 b = frag_tr(bbuf, PV, ks * 32, n0 + nn * 16, fr, fq);
          acc[0][nn] = mfma16(a0, b, acc[0][nn]); acc[1][nn] = mfma16(a1, b, acc[1][nn]);
        }
      }
    }
#pragma unroll
    for (int m = 0; m < 2; ++m)
#pragma unroll
      for (int j = 0; j < 4; ++j) {
        const int il = m0 + m * 16 + fq * 4 + j;
        const float sc = hasB ? __expf((float)(il + 1) * lgf - (float)(128 - il) * lgb) : __expf((float)(il + 1) * lgf);
#pragma unroll
        for (int nn = 0; nn < 8; ++nn) acc[m][nn][j] *= sc;
      }
  }
  if (hasB) {
    __syncthreads();
    if (sb >= 0) tile_to_lds(p.stimg + ((size_t)((sb * 4 + h) * 2 + 1) * 8 + lc) * 128 * 256, 256, bbuf, PV, 128, 256);
    else tile_to_lds((const u16*)p.part + ((size_t)((cbase + 1) * 4 + h) * 2 + 1) * 128 * 256, 256, bbuf, PV, 128, 256);
    __syncthreads();
    {
      bf16x8 q0[4], q1[4];
#pragma unroll
      for (int ks = 0; ks < 4; ++ks) { q0[ks] = *(const bf16x8*)(qrow + ks * 32); q1[ks] = *(const bf16x8*)(qrow + 16 * 4096 + ks * 32); }
#pragma unroll 1
      for (int ks = 0; ks < 4; ++ks) {
        const bf16x8 a0 = ks == 0 ? q0[0] : (ks == 1 ? q0[1] : (ks == 2 ? q0[2] : q0[3])), a1 = ks == 0 ? q1[0] : (ks == 1 ? q1[1] : (ks == 2 ? q1[2] : q1[3]));
#pragma unroll
        for (int nn = 0; nn < 8; ++nn) {
          const bf16x8 b = frag_tr(bbuf, PV, ks * 32, n0 + nn * 16, fr, fq);
          acc[0][nn] = mfma16(a0, b, acc[0][nn]); acc[1][nn] = mfma16(a1, b, acc[1][nn]);
        }
      }
    }
#pragma unroll
    for (int m = 0; m < 2; ++m)
#pragma unroll
      for (int j = 0; j < 4; ++j) {
        const int il = m0 + m * 16 + fq * 4 + j;
        const float sc = __expf((float)(128 - il) * lgb);
#pragma unroll
        for (int nn = 0; nn < 8; ++nn) acc[m][nn][j] *= sc;
      }
  }
  __syncthreads();
  tile_to_lds(p.proj + (size_t)ci * 128 * 4096 + 1024 + h * 256, 4096, bbuf, PV, 128, 256);
  __syncthreads();
#pragma unroll 1
  for (int ks = 0; ks < 4; ++ks) {
    const bf16x8 a0 = frag_row(kbuf, PK, m0, ks * 32, fr, fq), a1 = frag_row(kbuf, PK, m0 + 16, ks * 32, fr, fq);
#pragma unroll
    for (int nn = 0; nn < 8; ++nn) {
      const bf16x8 b = frag_tr(bbuf, PV, ks * 32, n0 + nn * 16, fr, fq);
      acc[0][nn] = mfma16(a0, b, acc[0][nn]); acc[1][nn] = mfma16(a1, b, acc[1][nn]);
    }
  }
#pragma unroll
  for (int m = 0; m < 2; ++m)
#pragma unroll
    for (int j = 0; j < 4; ++j) {
      float s = 0.f;
#pragma unroll
      for (int nn = 0; nn < 8; ++nn) s += acc[m][nn][j] * acc[m][nn][j];
      s += __shfl_xor(s, 1); s += __shfl_xor(s, 2); s += __shfl_xor(s, 4); s += __shfl_xor(s, 8);
      if (fr == 0) red[(wid >> 2) * 128 + m0 + m * 16 + fq * 4 + j] = s;
    }
  __syncthreads();
#pragma unroll
  for (int m = 0; m < 2; ++m)
#pragma unroll
    for (int j = 0; j < 4; ++j) {
      const int il = m0 + m * 16 + fq * 4 + j;
      const float r = rsqrtf((red[il] + red[128 + il]) * (1.f / 256.f) + EPS);
      LAS u16* orow = bbuf + il * PV + n0 + fr;
#pragma unroll
      for (int nn = 0; nn < 8; ++nn) orow[nn * 16] = f2bf(acc[m][nn][j] * r);
    }
  __syncthreads();
  {
    const u16* gbase = p.proj + (size_t)ci * 128 * 4096 + 2048 + h * 256;
    u16* obase = p.cat + (size_t)ci * 128 * 1536 + h * 256;
    u32x4 gv[8];
#pragma unroll
    for (int k = 0; k < 8; ++k) { const int i = tid + k * NTHR, r = i >> 5, c = (i & 31) * 8; gv[k] = *(const u32x4*)(gbase + (size_t)r * 4096 + c); }
#pragma unroll
    for (int k = 0; k < 8; ++k) {
      const int i = tid + k * NTHR, r = i >> 5, c = (i & 31) * 8;
      const u32x4 ov = *(const LAS u32x4*)(bbuf + r * PV + c);
      u32x4 o;
#pragma unroll
      for (int e = 0; e < 4; ++e) o[e] = pk2(__uint_as_float(ov[e] << 16) * __uint_as_float(gv[k][e] << 16), __uint_as_float(ov[e] & 0xffff0000u) * __uint_as_float(gv[k][e] & 0xffff0000u));
      __builtin_amdgcn_raw_buffer_store_b128(o, mk_rsrc(p.cat, (unsigned)NT * 1536u * 2u), (unsigned)((((size_t)ci * 128 + r) * 1536 + h * 256 + c) * 2), 0, 16);
    }
  }
  asm volatile("s_waitcnt vmcnt(0)" ::: "memory");
  __syncthreads();
  if (tid == 0) xb_add(&rcnt[(ci >> 1) * 16], 1u);
}
__device__ __forceinline__ void state_item(const P& p, int item) {
  const int b = item >> 3, h = (item >> 1) & 3, dir = item & 1;
  const float w = __expf(128.f * log1pf(-exp2f(-p.l0_decay[dir * 4 + h])));
  const int c_old = dir == 0 ? 2 * b : 2 * b + 1, c_new = dir == 0 ? 2 * b + 1 : 2 * b;
  const u16* A = (const u16*)p.part + ((size_t)(c_old * 4 + h) * 2 + dir) * 128 * 256;
  const u16* B = (const u16*)p.part + ((size_t)(c_new * 4 + h) * 2 + dir) * 128 * 256;
  float* o = p.out + (size_t)NT * DM + ((size_t)(b * 2 + dir) * 4 + h) * 128 * 256;
  u32x4 av[8], bv[8];
#pragma unroll
  for (int k = 0; k < 8; ++k) { const int i = threadIdx.x + k * NTHR; av[k] = *(const u32x4*)(A + i * 8); bv[k] = *(const u32x4*)(B + i * 8); }
#pragma unroll
  for (int k = 0; k < 8; ++k) {
    const int i = threadIdx.x + k * NTHR;
    f32x4 o0, o1;
    o0[0] = __uint_as_float(av[k][0] << 16) * w + __uint_as_float(bv[k][0] << 16); o0[1] = __uint_as_float(av[k][0] & 0xffff0000u) * w + __uint_as_float(bv[k][0] & 0xffff0000u);
    o0[2] = __uint_as_float(av[k][1] << 16) * w + __uint_as_float(bv[k][1] << 16); o0[3] = __uint_as_float(av[k][1] & 0xffff0000u) * w + __uint_as_float(bv[k][1] & 0xffff0000u);
    o1[0] = __uint_as_float(av[k][2] << 16) * w + __uint_as_float(bv[k][2] << 16); o1[1] = __uint_as_float(av[k][2] & 0xffff0000u) * w + __uint_as_float(bv[k][2] & 0xffff0000u);
    o1[2] = __uint_as_float(av[k][3] << 16) * w + __uint_as_float(bv[k][3] << 16); o1[3] = __uint_as_float(av[k][3] & 0xffff0000u) * w + __uint_as_float(bv[k][3] & 0xffff0000u);
    __builtin_nontemporal_store(o0, (f32x4*)(o + i * 8)); __builtin_nontemporal_store(o1, (f32x4*)(o + i * 8 + 4));
  }
}
__device__ __forceinline__ void phase_mix_b(const P& p, LAS u16* lds, unsigned* scnt, unsigned* rcnt) {
  const int b = (int)blockIdx.x;
  if (b < 64) ret_item(p, 128 + b, lds, scnt, rcnt);
  else if (b < 192) ret_item(p, b - 64, lds, scnt, rcnt);
  else { scan_item(p, b - 192, scnt); state_item(p, 2 * (b - 192)); state_item(p, 2 * (b - 192) + 1); }
}

__device__ __forceinline__ void phase_conv(const P& p) {
  const u16* __restrict__ pj = p.proj;
  const size_t total = (size_t)NT * 256, stride = (size_t)gridDim.x * NTHR;
  for (size_t i0 = (size_t)blockIdx.x * NTHR + threadIdx.x; i0 < total; i0 += 4 * stride) {
    u32x2 av[4][3], bv[4][3], bgv[4]; bool ok[4][3];
#pragma unroll
    for (int u = 0; u < 4; ++u) {
      const size_t i = i0 + u * stride; const bool live = i < total;
      const int t = live ? (int)(i >> 8) : 0, c4 = (int)(i & 255) * 4;
      const int seg = t < NPROMPT_T ? 256 : 64, pos = t < NPROMPT_T ? (t & 255) : ((t - NPROMPT_T) & 63);
#pragma unroll
      for (int d = 0; d < 3; ++d) {
        const int pp = pos + d - 1; ok[u][d] = live && pp >= 0 && pp < seg;
        const u16* r = pj + (size_t)(ok[u][d] ? t + d - 1 : t) * 3072;
        av[u][d] = *(const u32x2*)(r + 1024 + c4); bv[u][d] = *(const u32x2*)(r + 2048 + c4);
      }
      bgv[u] = *(const u32x2*)(pj + (size_t)t * 3072 + c4);
    }
#pragma unroll
    for (int u = 0; u < 4; ++u) {
      const size_t i = i0 + u * stride; if (i >= total) continue;
      const int t = (int)(i >> 8), c4 = (int)(i & 255) * 4;
      f32x4 xc[3];
#pragma unroll
      for (int d = 0; d < 3; ++d) {
        const u32x2 a = av[u][d], b2 = bv[u][d];
        xc[d][0] = __uint_as_float(a[0] << 16) * __uint_as_float(b2[0] << 16); xc[d][1] = __uint_as_float(a[0] & 0xffff0000u) * __uint_as_float(b2[0] & 0xffff0000u);
        xc[d][2] = __uint_as_float(a[1] << 16) * __uint_as_float(b2[1] << 16); xc[d][3] = __uint_as_float(a[1] & 0xffff0000u) * __uint_as_float(b2[1] & 0xffff0000u);
        if (!ok[u][d]) xc[d] = (f32x4){0.f, 0.f, 0.f, 0.f};
      }
      const f32x4 w0 = *(const f32x4*)(p.l1_conv + c4), w1 = *(const f32x4*)(p.l1_conv + 1024 + c4), w2 = *(const f32x4*)(p.l1_conv + 2048 + c4);
      const f32x4 bg = {__uint_as_float(bgv[u][0] << 16), __uint_as_float(bgv[u][0] & 0xffff0000u), __uint_as_float(bgv[u][1] << 16), __uint_as_float(bgv[u][1] & 0xffff0000u)};
      const f32x4 y = bg * (w0 * xc[0] + w1 * xc[1] + w2 * xc[2]);
      u32x2 o; o[0] = pk2(y[0], y[1]); o[1] = pk2(y[2], y[3]);
      *(u32x2*)(p.cat + (size_t)t * 1024 + c4) = o;
    }
  }
}

#define XB_XCNT(j)  (256  + 64 * (j))
#define XB_XSUB(j)  (1280 + 64 * (j))
#define XB_XGEN(j)  (2304 + 64 * (j))
#define XB_TOP      3328
#define XB_TOPGEN   3392
#define XCD_BAR_WORDS 3456
__device__ __forceinline__ unsigned xb_xcc_id() { return (unsigned)__builtin_amdgcn_s_getreg((3 << 11) | 20) & 0xFu; }
struct XcdBarrier { unsigned* bar; unsigned x; volatile __attribute__((address_space(3))) unsigned* st; };
__device__ __forceinline__ XcdBarrier xcd_barrier_post(unsigned* bar, volatile __attribute__((address_space(3))) unsigned* st) {
  XcdBarrier b; b.bar = bar; b.x = xb_xcc_id(); b.st = st;
  if (threadIdx.x == 0) (void)xb_add(&bar[XB_XCNT(b.x)], 1u);
  return b;
}
__device__ __forceinline__ void xcd_barrier_complete(unsigned* bar, unsigned x, unsigned& nloc, unsigned& nx) {
  const unsigned G = gridDim.x * gridDim.y * gridDim.z;
  unsigned sum, cnt, mine, sp = 0u;
  for (;;) {
    sum = 0u; cnt = 0u; mine = 0u;
#pragma unroll
    for (unsigned j = 0; j < 16; ++j) { const unsigned c = xb_ld(&bar[XB_XCNT(j)]); sum += c; cnt += (c > 0u) ? 1u : 0u; mine = (j == x) ? c : mine; }
    if (sum == G) break;
    __builtin_amdgcn_s_sleep(1);
    if ((++sp & 255u) == 0u) { if (xb_ld(&bar[XB_TMO])) break; if (sp > XB_SPIN_CAP) { atomicAdd(&bar[XB_TMO], 1u); break; } }
  }
  nloc = mine > 0u ? mine : 1u; nx = cnt > 0u ? cnt : 1u;
}
__device__ __forceinline__ void xcd_barrier(const XcdBarrier& b) {
  asm volatile("s_waitcnt vmcnt(0)" ::: "memory");
  __syncthreads();
  if (threadIdx.x == 0) {
    unsigned* bar = b.bar;
    __builtin_amdgcn_s_waitcnt(0);
    unsigned nloc = b.st[0], nx = b.st[1];
    if (nloc == 0u) { xcd_barrier_complete(bar, b.x, nloc, nx); b.st[0] = nloc; b.st[1] = nx; }
    const unsigned old = xb_add(&bar[XB_XSUB(b.x)], 1u);
    const unsigned gen = old / nloc;
    if (old + 1u == (gen + 1u) * nloc) {
      __builtin_amdgcn_fence(__ATOMIC_RELEASE, "agent");
      asm volatile("s_waitcnt vmcnt(0)" ::: "memory");
      const unsigned og = xb_add(&bar[XB_TOP], 1u);
      const unsigned tg = og / nx;
      if (og + 1u == (tg + 1u) * nx) xb_add(&bar[XB_TOPGEN], 1u);
      else XB_SPIN(xb_ld(&bar[XB_TOPGEN]) == tg, bar);
      __builtin_amdgcn_fence(__ATOMIC_ACQUIRE, "agent");
      xb_add(&bar[XB_XGEN(b.x)], 1u);
      asm volatile("s_waitcnt vmcnt(0)" ::: "memory");
    } else {
      XB_SPIN(xb_ld(&bar[XB_XGEN(b.x)]) == gen, bar);
      __builtin_amdgcn_fence(__ATOMIC_ACQUIRE, "agent");
      asm volatile("s_waitcnt vmcnt(0)" ::: "memory");
    }
  }
  __syncthreads();
}

__device__ __forceinline__ void phase_norm_fused(const NormArgs& a, unsigned* cnt, unsigned* bar) {
  pg8::Order S; S.init(NT, 1024, 2, (int)gridDim.x, (int)blockIdx.x);
  pg8::Unit u;
  if (!S.next(0, u)) return;
  asm volatile("s_waitcnt vmcnt(0)" ::: "memory");
  __syncthreads();
  if (threadIdx.x == 0) {
    for (int i = 0; S.next(i, u); ++i) xb_add(&cnt[u.pm * 16], 1u);
  }
  const int wid = threadIdx.x >> 6, lane = threadIdx.x & 63;
  for (int i = 0; S.next(i, u); ++i) {
    if (threadIdx.x == 0) {
      XB_WAIT(xb_ld(&cnt[u.pm * 16]) < 8u, bar);
      __builtin_amdgcn_fence(__ATOMIC_ACQUIRE, "agent");
      asm volatile("s_waitcnt vmcnt(0)" ::: "memory");
    }
    __syncthreads();
    const int r0 = u.pm * 256 + (u.pn * 2 + u.ks) * 32 + wid * 4;
    norm_rows<4, 2>(a, r0, lane);
  }
}

__device__ __forceinline__ void phase_ffn(const P& p, const u16* w1t, const u16* w2t, const NormArgs& na, unsigned* cntA, unsigned* cntB, float* lds, unsigned* hin, unsigned* hout) {
  const int c = (int)blockIdx.x, tid = threadIdx.x, wid = tid >> 6, lane = tid & 63, x = c & 7;
  PG8_LAS unsigned char* l3 = (PG8_LAS unsigned char*)lds;
  __syncthreads();
  {
    pg8::FfnOrder1 S1{c}; pg8::Unit t1;
#pragma unroll 1
    for (int i = 0; S1.next(i, t1); ++i) {
      if (hin) {
        if (tid == 0) { XB_WAIT(xb_ld(&hin[t1.pm * 16]) < 8u, p.bar); __builtin_amdgcn_fence(__ATOMIC_ACQUIRE, "agent"); asm volatile("s_waitcnt vmcnt(0)" ::: "memory"); }
        __syncthreads();
      }
      { pg8::Gemm g{p.hA, w1t, NT, 4096, 1024, 1}; pg8::OneUnit S{t1}; EpiRelu2W e{mk_rsrc(p.proj, (unsigned)NT * 4096u * 2u)}; pg8::gemm_phase(l3, g, S, e); }
      asm volatile("s_waitcnt vmcnt(0)" ::: "memory");
      __syncthreads();
      if (tid == 0) xb_add(&cntA[t1.pm * 16], 1u);
    }
  }
  pg8::Unit u; int ksplit;
  if (c >= 128) { const int oj = (c - 128) >> 3; ksplit = 2; u.ks = x & 1; u.pm = 4 * (x >> 1) + (oj >> 2); u.pn = oj & 3; }
  else { const int o = c >> 3; ksplit = 4; u.ks = x & 3; u.pm = 16 + 4 * (x >> 2) + (o >> 2); u.pn = o & 3; }
  if (tid == 0) {
    XB_WAIT(xb_ld(&cntA[u.pm * 16]) < 16u, p.bar);
    __builtin_amdgcn_fence(__ATOMIC_ACQUIRE, "agent");
    asm volatile("s_waitcnt vmcnt(0)" ::: "memory");
  }
  __syncthreads();
  { pg8::Gemm g{p.proj, w2t, NT, 1024, 4096, ksplit}; pg8::OneUnit S{u}; EpiPartW e{mk_rsrc(p.part, 4u * (unsigned)NT * 1024u * 2u)}; pg8::gemm_phase(l3, g, S, e); }
  asm volatile("s_waitcnt vmcnt(0)" ::: "memory");
  __syncthreads();
  if (tid == 0) {
    xb_add(&cntB[u.pm * 16], 1u);
    XB_WAIT(xb_ld(&cntB[u.pm * 16]) < (unsigned)(4 * ksplit), p.bar);
    __builtin_amdgcn_fence(__ATOMIC_ACQUIRE, "agent");
    asm volatile("s_waitcnt vmcnt(0)" ::: "memory");
  }
  __syncthreads();
  if (ksplit == 2) norm_rows<4, 2>(na, u.pm * 256 + (u.pn * 2 + u.ks) * 32 + wid * 4, lane);
  else norm_rows<2, 4>(na, u.pm * 256 + (u.pn * 4 + u.ks) * 16 + wid * 2, lane);
  if (hout) {
    asm volatile("s_waitcnt vmcnt(0)" ::: "memory");
    __syncthreads();
    if (tid == 0) xb_add(&hout[u.pm * 16], 1u);
  }
}

__device__ __forceinline__ void conv_rect(const P& p, int row0, int ch0) {
  const u16* __restrict__ pj = p.proj2;
  const __amdgpu_buffer_rsrc_t rs = mk_rsrc(p.cat, (unsigned)NT * 1024u * 2u);
#pragma unroll 1
  for (int b0 = 0; b0 < 16; b0 += 4) {
    u32x2 xv[4][3], bgv[4]; bool ok[4][3];
#pragma unroll
    for (int u = 0; u < 4; ++u) {
      const int i = threadIdx.x + (b0 + u) * NTHR;
      const int t = row0 + (i >> 7), c4 = ch0 + (i & 127) * 4;
      const int seg = t < NPROMPT_T ? 256 : 64, pos = t < NPROMPT_T ? (t & 255) : ((t - NPROMPT_T) & 63);
#pragma unroll
      for (int d = 0; d < 3; ++d) {
        const int pp = pos + d - 1; ok[u][d] = pp >= 0 && pp < seg;
        xv[u][d] = *(const u32x2*)(pj + (size_t)(ok[u][d] ? t + d - 1 : t) * 2048 + 1024 + c4);
      }
      bgv[u] = *(const u32x2*)(pj + (size_t)t * 2048 + c4);
    }
#pragma unroll
    for (int u = 0; u < 4; ++u) {
      const int i = threadIdx.x + (b0 + u) * NTHR;
      const int t = row0 + (i >> 7), c4 = ch0 + (i & 127) * 4;
      f32x4 xc[3];
#pragma unroll
      for (int d = 0; d < 3; ++d) {
        const u32x2 a = xv[u][d];
        xc[d] = (f32x4){__uint_as_float(a[0] << 16), __uint_as_float(a[0] & 0xffff0000u), __uint_as_float(a[1] << 16), __uint_as_float(a[1] & 0xffff0000u)};
        if (!ok[u][d]) xc[d] = (f32x4){0.f, 0.f, 0.f, 0.f};
      }
      const f32x4 w0 = *(const f32x4*)(p.l1_conv + c4), w1 = *(const f32x4*)(p.l1_conv + 1024 + c4), w2 = *(const f32x4*)(p.l1_conv + 2048 + c4);
      const f32x4 bg = {__uint_as_float(bgv[u][0] << 16), __uint_as_float(bgv[u][0] & 0xffff0000u), __uint_as_float(bgv[u][1] << 16), __uint_as_float(bgv[u][1] & 0xffff0000u)};
      const f32x4 y = bg * (w0 * xc[0] + w1 * xc[1] + w2 * xc[2]);
      const unsigned long long v = (unsigned long long)pk2(y[0], y[1]) | ((unsigned long long)pk2(y[2], y[3]) << 32);
      __hip_atomic_store((unsigned long long*)(p.cat + (size_t)t * 1024 + c4), v, __ATOMIC_RELAXED, __HIP_MEMORY_SCOPE_AGENT);
    }
  }
}

__device__ __forceinline__ void phase_l1(const P& p, const NormArgs& na, unsigned* cntA, unsigned* cntC, unsigned* cntB, float* lds, unsigned* hin, unsigned* hout) {
  const int c = (int)blockIdx.x, tid = threadIdx.x, wid = tid >> 6, lane = tid & 63;
  PG8_LAS unsigned char* l3 = (PG8_LAS unsigned char*)lds;
  __syncthreads();
  {
    pg8::L1InOrder S1{c}; pg8::Unit t1; EpiPlain e{p.proj2};
#pragma unroll 1
    for (int i = 0; S1.next(i, t1); ++i) {
      if (tid == 0) { XB_WAIT(xb_ld(&hin[t1.pm * 16]) < (t1.pm < 16 ? 8u : 16u), p.bar); __builtin_amdgcn_fence(__ATOMIC_ACQUIRE, "agent"); asm volatile("s_waitcnt vmcnt(0)" ::: "memory"); }
      __syncthreads();
      { pg8::Gemm g{p.hA, p.wt1_in, NT, 3072, 1024, 1}; pg8::OneUnit S{t1}; pg8::gemm_phase(l3, g, S, e); }
      asm volatile("s_waitcnt vmcnt(0)" ::: "memory");
      __syncthreads();
      if (tid == 0) xb_add(&cntA[t1.pm * 16], 1u);
    }
  }
  if (c < 40 || c >= 232) return;
  pg8::Unit u;
  { const int j = c - 40; u.pm = j >> 3; u.pn = (j & 7) >> 1; u.ks = j & 1; }
  if (tid == 0) {
    XB_WAIT(xb_ld(&cntA[u.pm * 16]) < 12u, p.bar);
    __builtin_amdgcn_fence(__ATOMIC_ACQUIRE, "agent");
    asm volatile("s_waitcnt vmcnt(0)" ::: "memory");
  }
  __syncthreads();
  conv_rect(p, u.pm * 256 + u.pn * 64, u.ks * 512);
  asm volatile("s_waitcnt vmcnt(0)" ::: "memory");
  __syncthreads();
  if (tid == 0) {
    xb_add(&cntC[(u.pm * 2 + u.ks) * 8], 1u);
    XB_WAIT(xb_ld(&cntC[(u.pm * 2 + u.ks) * 8]) < 4u, p.bar);
    __builtin_amdgcn_fence(__ATOMIC_ACQUIRE, "agent");
    asm volatile("s_waitcnt vmcnt(0)" ::: "memory");
  }
  __syncthreads();
  { pg8::Gemm g{p.cat, p.wt1_out, NT, 1024, 1024, 2}; pg8::OneUnit S{u}; EpiPartW e{mk_rsrc(p.part, 4u * (unsigned)NT * 1024u * 2u)}; pg8::gemm_phase(l3, g, S, e); }
  asm volatile("s_waitcnt vmcnt(0)" ::: "memory");
  __syncthreads();
  if (tid == 0) {
    xb_add(&cntB[u.pm * 16], 1u);
    XB_WAIT(xb_ld(&cntB[u.pm * 16]) < 8u, p.bar);
    __builtin_amdgcn_fence(__ATOMIC_ACQUIRE, "agent");
    asm volatile("s_waitcnt vmcnt(0)" ::: "memory");
  }
  __syncthreads();
  norm_rows<4, 2>(na, u.pm * 256 + (u.pn * 2 + u.ks) * 32 + wid * 4, lane);
  asm volatile("s_waitcnt vmcnt(0)" ::: "memory");
  __syncthreads();
  if (tid == 0) xb_add(&hout[u.pm * 16], 1u);
}

constexpr int NPHASE = 3;
#ifndef REPMASK
#define REPMASK 0
#endif
__global__ void __launch_bounds__(NTHR) mega(P p, int lo, int hi) {
  extern __shared__ __attribute__((aligned(16))) unsigned char smem[];
  float* lds = (float*)smem;
  cg::grid_group grid = cg::this_grid();
  volatile LAS unsigned* xst = (volatile LAS unsigned*)(smem + 131072);
  if (threadIdx.x == 0) { xst[0] = 0u; xst[1] = 0u; }
  __syncthreads();
  const XcdBarrier xb = xcd_barrier_post(p.bar, xst);
  if (hi < 0) grid.sync();
  const float* m0 = p.mod; const float* m1 = p.mod + 3 * 6144;
#define PH(n, ...) if (lo <= (n) && (n) < hi) { if ((n) > lo) xcd_barrier(xb); __VA_ARGS__ if ((REPMASK >> (n)) & 1) { xcd_barrier(xb); __VA_ARGS__ } }
  unsigned* pcnt = p.bar + XCD_BAR_WORDS;
  float* const xs = (float*)((u16*)p.xres + (size_t)NPROMPT_T * DM); float* const pp = p.part;
  PH(0, { phase_prep(p, lds);
          if (threadIdx.x == 0) { XB_WAIT(xb_ld(pcnt + 9 * 384) < 96u, p.bar); __builtin_amdgcn_fence(__ATOMIC_ACQUIRE, "agent"); asm volatile("s_waitcnt vmcnt(0)" ::: "memory"); }
          __syncthreads();
          NormArgs a{p.x_prompt, p.x_sample, nullptr, nullptr, nullptr, nullptr, p.l0_norm1, m0 + 0, m0 + 1024, p.hA, nullptr, 0}; phase_norm(a);
          { asm volatile("s_waitcnt vmcnt(0)" ::: "memory"); __syncthreads();
            if (threadIdx.x == 0 && blockIdx.x < 192) xb_add(pcnt + 14 * 384 + ((int)blockIdx.x >> 3) * 16, 1u); }
          if (threadIdx.x == 0) {
            pg8::Order S; S.init(NT, 4096, 1, (int)gridDim.x, (int)blockIdx.x); pg8::Unit u;
            for (int i = 0; S.next(i, u); ++i) { XB_WAIT(xb_ld(pcnt + 14 * 384 + u.pm * 16) < 8u || xb_ld(pcnt + 15 * 384 + u.pn * 16) < 16u, p.bar); }
            __builtin_amdgcn_fence(__ATOMIC_ACQUIRE, "agent"); asm volatile("s_waitcnt vmcnt(0)" ::: "memory");
          }
          __syncthreads();
          { EpiProj0 e{p.proj}; phase_gemm(p.hA, p.wt0_in, NT, 4096, 1024, 1, e, lds);
          { asm volatile("s_waitcnt vmcnt(0)" ::: "memory"); __syncthreads();
            if (threadIdx.x == 0) { pg8::Order S; S.init(NT, 4096, 1, (int)gridDim.x, (int)blockIdx.x); pg8::Unit u; for (int i = 0; S.next(i, u); ++i) xb_add(pcnt + 11 * 384 + u.pm * 16, 1u); } }
          phase_prep2(p, lds, 0, 128);
          for (int it = blockIdx.x; it < 384; it += gridDim.x) {
            const int item = it < 192 ? it : it - 192;
            if (threadIdx.x == 0) { XB_WAIT(xb_ld(pcnt + 11 * 384 + (item >> 3) * 16) < 16u, p.bar); __builtin_amdgcn_fence(__ATOMIC_ACQUIRE, "agent"); asm volatile("s_waitcnt vmcnt(0)" ::: "memory"); }
            __syncthreads();
            if (it < 192) kv_item(p, item, (LAS u16*)smem); else gmlp_item(p, item, (LAS u16*)smem);
          }
          phase_prep2(p, lds, 2, 128); } })
  PH(1, { phase_mix_b(p, (LAS u16*)smem, pcnt + 6 * 384, pcnt + 10 * 384);
          { pg8::Order S; S.init(NT, 1024, 2, (int)gridDim.x, (int)blockIdx.x); pg8::Unit u;
            if (S.next(0, u)) {
              if (threadIdx.x == 0) { XB_WAIT(xb_ld(pcnt + 10 * 384 + u.pm * 16) < 8u, p.bar); __builtin_amdgcn_fence(__ATOMIC_ACQUIRE, "agent"); asm volatile("s_waitcnt vmcnt(0)" ::: "memory"); }
              __syncthreads();
              pg8::Gemm g{p.cat, p.wt0_out, NT, 1024, 1536, 2}; pg8::OneUnit S1{u}; EpiPartW e{mk_rsrc((u16*)p.part + (size_t)2 * NT * DM, 2u * (unsigned)NT * 1024u * 2u)};
              pg8::gemm_phase((PG8_LAS unsigned char*)lds, g, S1, e);
              __syncthreads();
            } }
          NormArgs a{p.x_prompt, p.x_sample, (float*)((u16*)pp + (size_t)2 * NT * DM), pp, m0 + 2048, p.xres, p.l0_norm2, m0 + 3072, m0 + 4096, p.hA, nullptr, 0}; phase_norm_fused(a, pcnt + 0 * 384, p.bar);
          phase_prep2(p, lds, 1, 192);
          if ((int)blockIdx.x >= 192) {
            const u32x4* w1 = (const u32x4*)p.wt0_f1; const u32x4* w2 = (const u32x4*)p.wt0_f2;
            const int b = (int)blockIdx.x - 192; unsigned acc = 0u;
            _Pragma("unroll 8") for (int i = threadIdx.x; i < 8192; i += NTHR) { const u32x4 a = w1[(size_t)b * 8192 + i], c2 = w2[(size_t)b * 8192 + i]; acc ^= a[0] ^ c2[0]; }
            if (acc == 0x9e3779b9u && p.out == nullptr) p.bar[XB_TMO] = 1u;
          } })
  PH(2, { { NormArgs a{p.xres, xs, pp, pp, m0 + 5120, p.xres, p.l1_norm1, m1 + 0, m1 + 1024, p.hA, nullptr, 1}; phase_ffn(p, p.wt0_f1, p.wt0_f2, a, pcnt + 1 * 384, pcnt + 2 * 384, lds, nullptr, pcnt + 12 * 384); }
          { NormArgs a{p.xres, xs, pp, pp, m1 + 2048, p.xres, p.l1_norm2, m1 + 3072, m1 + 4096, p.hA, nullptr, 1}; phase_l1(p, a, pcnt + 7 * 384, pcnt + 8 * 384, pcnt + 3 * 384, lds, pcnt + 12 * 384, pcnt + 13 * 384); }
          { NormArgs a{p.xres, xs, pp, pp, m1 + 5120, nullptr, p.final_norm, nullptr, nullptr, nullptr, p.out, 1}; phase_ffn(p, p.wt1_f1, p.wt1_f2, a, pcnt + 4 * 384, pcnt + 5 * 384, lds, pcnt + 13 * 384, nullptr); } })
#undef PH
}

constexpr size_t LDS_BYTES = 131072 + 256;
constexpr bool ONE_LAUNCH = true;

extern "C" void kernel_launch(void* const* d_in, const int* in_sizes, int n_in, void* d_out, int out_size, void* d_ws, size_t ws_size, hipStream_t stream) {
  static int grid_blocks = 0;
  if (!grid_blocks) {
    hipFuncSetAttribute((const void*)mega, hipFuncAttributeMaxDynamicSharedMemorySize, (int)LDS_BYTES);
    int dev = 0, cus = 0, per_cu = 0;
    hipGetDevice(&dev);
    hipDeviceGetAttribute(&cus, hipDeviceAttributeMultiprocessorCount, dev);
    hipOccupancyMaxActiveBlocksPerMultiprocessor(&per_cu, mega, NTHR, LDS_BYTES);
    if (per_cu < 1) per_cu = 1;
    if (per_cu > 1) per_cu = 1;
    grid_blocks = 256;
  }
  P p{};
  const float* const* in = (const float* const*)d_in;
  p.x_prompt = in[0]; p.x_sample = in[1]; p.state = in[2]; p.c = in[3]; p.c_ctx = in[4];
  p.l0_norm1 = in[5]; p.l0_w_in = in[6]; p.l0_decay = in[7]; p.l0_gws = in[8]; p.l0_gb = in[9]; p.l0_w_out = in[10]; p.l0_norm2 = in[11];
  p.l0_w_mod = in[12]; p.l0_b_mod = in[13]; p.l0_f1 = in[14]; p.l0_f2 = in[15];
  p.l1_norm1 = in[16]; p.l1_w_in = in[17]; p.l1_conv = in[18]; p.l1_w_out = in[19]; p.l1_norm2 = in[20]; p.l1_w_mod = in[21]; p.l1_b_mod = in[22];
  p.l1_f1 = in[23]; p.l1_f2 = in[24]; p.final_norm = in[25];
  p.out = (float*)d_out;
  unsigned char* w = (unsigned char*)d_ws; size_t off = 0;
  auto take = [&](size_t bytes) { void* r = w + off; off += (bytes + 255) & ~(size_t)255; return r; };
  p.wt0_in = (u16*)take((size_t)4096 * 1024 * 2); p.wt0_out = (u16*)take((size_t)1024 * 1536 * 2);
  p.wt0_f1 = (u16*)take((size_t)4096 * 1024 * 2); p.wt0_f2 = (u16*)take((size_t)4096 * 1024 * 2);
  p.wt1_in = (u16*)take((size_t)3072 * 1024 * 2); p.wt1_out = (u16*)take((size_t)1024 * 1024 * 2);
  p.wt1_f1 = (u16*)take((size_t)4096 * 1024 * 2); p.wt1_f2 = (u16*)take((size_t)4096 * 1024 * 2);
  p.mod = (float*)take((size_t)2 * 3 * 6144 * 4);
  p.hA = (u16*)take((size_t)NT * 1024 * 2);
  p.proj = (u16*)take((size_t)NT * 4096 * 2);
  p.proj2 = (u16*)take((size_t)NT * 2048 * 2);
  p.cat = (u16*)take((size_t)NT * 1536 * 2);
  p.part = (float*)take((size_t)2 * NT * 1024 * 4);
  p.xres = (float*)take((size_t)NT * 1024 * 4);
  p.stimg = (u16*)take((size_t)2 * 4 * 2 * 8 * 128 * 256 * 2);
  p.bar = (unsigned*)take((size_t)(XCD_BAR_WORDS + 16 * 384) * 4);
  hipMemsetAsync(p.bar, 0, (size_t)(XCD_BAR_WORDS + 16 * 384) * 4, stream);
  if (ONE_LAUNCH) {
    int lo = 0, hi = NPHASE; void* args[] = {&p, &lo, &hi};
    hipError_t e = hipLaunchCooperativeKernel((void*)mega, dim3(grid_blocks), dim3(NTHR), args, LDS_BYTES, stream);
    if (e != hipSuccess) fprintf(stderr, "cooperative launch failed: %s (grid %d)\n", hipGetErrorString(e), grid_blocks);
  } else {
    for (int ph = 0; ph < NPHASE; ++ph) hipLaunchKernelGGL(mega, dim3(grid_blocks), dim3(NTHR), LDS_BYTES, stream, p, ph, ph + 1);
  }
}
```
